# Optimizing an MI355X kernel written in HIP

```python
import math
import jax, jax.numpy as jnp
from jax import lax
import numpy as np

D_MODEL = 1024
BATCH = 32
SEQ = 2048
DEPTH = 1

H_A = 4
DK_A = 128
DV_A = 128
W_A = H_A * DV_A
CONV_W = 4
CHUNK = 64
H_B = 4
R_KV = 128
DV_B = 128
W_B = H_B * DV_B
H_IDX = 8
D_IDX = 64
TOPK_MAX = 256
Q_BLOCK = 128
N_BUCKETS = 32
MAX_EXACT = 16
MAX_DIST = 128
EPS = 1e-6
SPLITS = (3 * W_A, W_A, H_A, H_A, H_B * R_KV, R_KV, W_B, H_IDX * D_IDX, D_IDX, H_IDX)
SPLIT_OFFSETS = (3072 // 2, 2048, 2052, 2056, 2568, 2696, 3208, 3720, 3784)
D_IN = 3792

kernel_name = 'hybrid_gdn_dsa_parallel_heads'


def rmsnorm(x, g):
    xf = x.astype(jnp.float32)
    xf = xf * lax.rsqrt(jnp.mean(xf * xf, axis=-1, keepdims=True) + EPS)
    return xf.astype(x.dtype) * g


def l2norm(x):
    return x * lax.rsqrt(jnp.sum(x * x, axis=-1, keepdims=True) + EPS)


def causal_conv(u, w):
    L = u.shape[1]
    up = jnp.pad(u, ((0, 0), (CONV_W - 1, 0), (0, 0)))
    out = up[:, 0:L] * w[0]
    for j in range(1, CONV_W):
        out = out + up[:, j:j + L] * w[j]
    return out


def t5_bucket(dist):
    n = jnp.maximum(dist, 0)
    nf = jnp.maximum(n, 1).astype(jnp.float32)
    large = MAX_EXACT + (jnp.log(nf / MAX_EXACT) / math.log(MAX_DIST / MAX_EXACT)
                         * (N_BUCKETS - MAX_EXACT)).astype(jnp.int32)
    large = jnp.minimum(large, N_BUCKETS - 1)
    return jnp.where(n < MAX_EXACT, n, large)


def gated_deltanet(qkv, z, b, a, conv_w, a_log, dt_bias, g_norm):
    Bsz, L, _ = qkv.shape
    n_chunks = L // CHUNK
    qkv = jax.nn.silu(causal_conv(qkv, conv_w))
    q, k, v = jnp.split(qkv, 3, axis=-1)

    def heads(t, d):
        t = t.reshape(Bsz, L, H_A, d).transpose(0, 2, 1, 3).astype(jnp.float32)
        return t.reshape(Bsz, H_A, n_chunks, CHUNK, d)

    q = l2norm(heads(q, DK_A)) * (DK_A ** -0.5)
    k = l2norm(heads(k, DK_A))
    v = heads(v, DV_A)
    beta = jax.nn.sigmoid(b.astype(jnp.float32)).transpose(0, 2, 1).reshape(Bsz, H_A, n_chunks, CHUNK)
    g = -jnp.exp(a_log.astype(jnp.float32)) * jax.nn.softplus(a.astype(jnp.float32) + dt_bias.astype(jnp.float32))
    g = g.transpose(0, 2, 1).reshape(Bsz, H_A, n_chunks, CHUNK)
    gc = jnp.cumsum(g, axis=-1)
    pos = jnp.arange(CHUNK)
    causal = pos[:, None] >= pos[None, :]
    strict = pos[:, None] > pos[None, :]
    decay = jnp.exp(jnp.where(causal, gc[..., :, None] - gc[..., None, :], -jnp.inf))
    kb = k * beta[..., None]
    vb = v * beta[..., None]
    lmat = jnp.where(strict, jnp.einsum('bhnik,bhnjk->bhnij', kb, k) * decay, 0.0)
    eye = jnp.eye(CHUNK, dtype=jnp.float32)
    tmat = lax.linalg.triangular_solve(lmat + eye, jnp.broadcast_to(eye, lmat.shape),
                                       left_side=True, lower=True, unit_diagonal=True)
    u = jnp.einsum('bhnij,bhnjd->bhnid', tmat, vb)
    w = jnp.einsum('bhnij,bhnjd->bhnid', tmat, kb * jnp.exp(gc)[..., None])
    attn = jnp.einsum('bhnik,bhnjk->bhnij', q, k) * decay
    qg = q * jnp.exp(gc)[..., None]
    kg = k * jnp.exp(gc[..., -1:] - gc)[..., None]
    glast = jnp.exp(gc[..., -1])
    xs = tuple(jnp.moveaxis(t, 2, 0) for t in (qg, kg, u, w, attn, glast))

    def step(S, inp):
        qg_c, kg_c, u_c, w_c, attn_c, gl_c = inp
        v_new = u_c - jnp.einsum('bhck,bhkv->bhcv', w_c, S)
        o = jnp.einsum('bhck,bhkv->bhcv', qg_c, S) + jnp.einsum('bhij,bhjv->bhiv', attn_c, v_new)
        S = S * gl_c[..., None, None] + jnp.einsum('bhck,bhcv->bhkv', kg_c, v_new)
        return S, o

    S0 = jnp.zeros((Bsz, H_A, DK_A, DV_A), jnp.float32)
    _, o = lax.scan(step, S0, xs)
    o = jnp.moveaxis(o, 0, 2).reshape(Bsz, H_A, L, DV_A).transpose(0, 2, 1, 3)
    o = rmsnorm(o, g_norm.astype(jnp.float32))
    o = o.reshape(Bsz, L, W_A) * jax.nn.silu(z.astype(jnp.float32))
    return o.astype(qkv.dtype)


def dsa_sparse_attention(q_b, ckv, iq, ik, iw, g_kv, w_uv, rel_bias, z):
    Bsz, L, _ = q_b.shape
    n_blocks = L // Q_BLOCK
    k_top = min(TOPK_MAX, L // 4)
    ckv = rmsnorm(ckv, g_kv)
    q_b = q_b.reshape(Bsz, L, H_B, R_KV)
    iq = iq.reshape(Bsz, L, H_IDX, D_IDX)
    iw = iw * (H_IDX ** -0.5 * D_IDX ** -0.5)
    key_pos = jnp.arange(L, dtype=jnp.int32)

    def to_blocks(t):
        return jnp.moveaxis(t.reshape((Bsz, n_blocks, Q_BLOCK) + t.shape[2:]), 1, 0)

    def block(args):
        qb, iqb, iwb, t0 = args
        t = t0 + jnp.arange(Q_BLOCK, dtype=jnp.int32)
        rel = jnp.einsum('bqhd,bsd->bqhs', iqb, ik)
        score = jnp.einsum('bqh,bqhs->bqs', iwb.astype(jnp.float32), jax.nn.relu(rel).astype(jnp.float32))
        score = jnp.where(key_pos[None, None, :] <= t[None, :, None], score, -jnp.inf)
        _, sel = lax.top_k(score, k_top)
        kv_sel = jax.vmap(lambda kv, i: kv[i])(ckv, sel)
        dist = t[None, :, None] - sel
        bias = jnp.moveaxis(rel_bias[t5_bucket(dist)], 3, 2)
        logits = (jnp.einsum('bqhr,bqkr->bqhk', qb, kv_sel).astype(jnp.float32) * (R_KV ** -0.5)
                  + bias.astype(jnp.float32))
        logits = jnp.where((dist >= 0)[:, :, None, :], logits, -jnp.inf)
        p = jax.nn.softmax(logits, axis=-1).astype(kv_sel.dtype)
        return jnp.einsum('bqhk,bqkr->bqhr', p, kv_sel)

    t0s = jnp.arange(n_blocks, dtype=jnp.int32) * Q_BLOCK
    o = lax.map(block, (to_blocks(q_b), to_blocks(iq), to_blocks(iw), t0s))
    o = jnp.moveaxis(o, 0, 1).reshape(Bsz, L, H_B, R_KV)
    o = jnp.einsum('blhr,hrd->blhd', o, w_uv).reshape(Bsz, L, W_B)
    return o * jax.nn.silu(z)


def setup_inputs(seed: int = 0) -> dict:
    key = jax.random.key(seed)
    ks = jax.random.split(key, 16)
    nrm = jax.random.normal
    x = nrm(ks[0], (BATCH, SEQ, D_MODEL), jnp.float32)
    c = nrm(ks[1], (BATCH, D_MODEL), jnp.float32)
    w_ada = nrm(ks[2], (DEPTH, D_MODEL, 3 * D_MODEL), jnp.float32) * (0.5 * D_MODEL ** -0.5)
    b_ada = 0.01 * nrm(ks[3], (DEPTH, 3 * D_MODEL), jnp.float32)
    g_pre = 1.0 + 0.05 * nrm(ks[4], (DEPTH, D_MODEL), jnp.float32)
    w_in = nrm(ks[5], (DEPTH, D_MODEL, D_IN), jnp.float32) * (D_MODEL ** -0.5)
    conv_w = nrm(ks[6], (DEPTH, CONV_W, 3 * W_A), jnp.float32) * (CONV_W ** -0.5)
    a_log = jnp.log(jax.random.uniform(ks[7], (DEPTH, H_A), jnp.float32, 1.0, 16.0))
    dt = jnp.exp(jax.random.uniform(ks[8], (DEPTH, H_A), jnp.float32, math.log(1e-3), math.log(1e-1)))
    dt_bias = dt + jnp.log(-jnp.expm1(-dt))
    g_gdn = 1.0 + 0.05 * nrm(ks[9], (DEPTH, DV_A), jnp.float32)
    g_kv = 1.0 + 0.05 * nrm(ks[10], (DEPTH, R_KV), jnp.float32)
    w_uv = nrm(ks[11], (DEPTH, H_B, R_KV, DV_B), jnp.float32) * (R_KV ** -0.5)
    rel_bias = 0.5 * nrm(ks[12], (N_BUCKETS, H_B), jnp.float32)
    w_out = nrm(ks[13], (DEPTH, W_A + W_B, D_MODEL), jnp.float32) * ((W_A + W_B) ** -0.5)
    g_post = 1.0 + 0.05 * nrm(ks[14], (DEPTH, D_MODEL), jnp.float32)
    return {'x': x, 'c': c, 'w_ada': w_ada, 'b_ada': b_ada, 'g_pre': g_pre, 'w_in': w_in,
            'conv_w': conv_w, 'a_log': a_log, 'dt_bias': dt_bias, 'g_gdn': g_gdn, 'g_kv': g_kv,
            'w_uv': w_uv, 'rel_bias': rel_bias, 'w_out': w_out, 'g_post': g_post}


def reference(x, c, w_ada, b_ada, g_pre, w_in, conv_w, a_log, dt_bias, g_gdn, g_kv, w_uv, rel_bias, w_out, g_post):
    for layer in range(DEPTH):
        mod = jax.nn.silu(c) @ w_ada[layer] + b_ada[layer]
        shift, scale, gate = jnp.split(mod, 3, axis=-1)
        h = rmsnorm(x, g_pre[layer]) * (1.0 + scale[:, None, :]) + shift[:, None, :]
        proj = h @ w_in[layer]
        (qkv_a, z_a, b_a, a_a, q_b, ckv, z_b, iq, ik, iw) = jnp.split(proj, list(SPLIT_OFFSETS), axis=-1)
        o_a = gated_deltanet(qkv_a, z_a, b_a, a_a, conv_w[layer], a_log[layer], dt_bias[layer], g_gdn[layer])
        o_b = dsa_sparse_attention(q_b, ckv, iq, ik, iw, g_kv[layer], w_uv[layer], rel_bias, z_b)
        mix = jnp.concatenate([o_a, o_b], axis=-1) @ w_out[layer]
        x = x + gate[:, None, :] * rmsnorm(mix, g_post[layer])
    return x
```

```cpp
#include <hip/hip_runtime.h>
#include <cstdio>
#include <cstdint>
#ifndef MK_N_LAUNCHES
#define MK_N_LAUNCHES 1
#endif
namespace pg8 {
#define PG8_LAS __attribute__((address_space(3)))
typedef unsigned short bf16_t;
typedef short bf16x8 __attribute__((ext_vector_type(8)));
typedef float f32x4 __attribute__((ext_vector_type(4)));
typedef unsigned u32x4 __attribute__((ext_vector_type(4)));
constexpr int BM = 256, BK = 64, HALF = 128, HTB = HALF * BK * 2  , STAGE_BYTES = 8 * HTB, NXCD = 8, WGM = 8;

__host__ __device__ __forceinline__ int lds_byte(int r, int c) { const int st = (r >> 4) * 2 + (c >> 5), rr = r & 15, cc = c & 31, ob = rr * 64 + cc * 2; return st * 1024 + (ob ^ (((ob >> 9) & 1) << 5)); }
__host__ __device__ __forceinline__ void stage_rc(int b, int& R, int& C) { const int st = b / 1024, sb = b % 1024, swz = sb ^ (((sb >> 9) & 1) << 5); R = (st >> 1) * 16 + swz / 64; C = (st & 1) * 32 + (swz % 64) / 2; }
__host__ __device__ __forceinline__ int perm32(int rho) { const int n = rho >> 4, i = rho & 15; return 8 * (i >> 2) + 4 * n + (i & 3); }

struct Unit { int pm, pn; };
struct Gemm { const bf16_t* A; const bf16_t* Bt; int M, N, K; };

struct StaticOrder {
    int nM, nN, nwg, G, c;
    __host__ __device__ void init(int M, int N, int G_, int c_) { nM = M / BM; nN = N / BM; nwg = nM * nN; G = G_; c = c_; }
    __host__ __device__ bool next(int i, Unit& u) const {
        const long L = (long)i * G + c; if (L >= nwg) return false;
        int wgid = (int)L; { const int q = nwg / NXCD, r = nwg % NXCD, xcd = wgid % NXCD, off = wgid / NXCD; wgid = (xcd < r ? xcd * (q + 1) : r * (q + 1) + (xcd - r) * q) + off; }
        const int nig = WGM * nN, gid = wgid / nig, fm = gid * WGM, gsz = (nM - fm) < WGM ? (nM - fm) : WGM;
        u.pm = fm + ((wgid % nig) % gsz); u.pn = (wgid % nig) / gsz; return true;
    }
    __device__ __forceinline__ void a_ready(const Unit&) const {}
    __device__ __forceinline__ void done(const Unit&) const {}
};

typedef float f32x2c __attribute__((ext_vector_type(2))); typedef __bf16 b16x2c __attribute__((ext_vector_type(2)));
__device__ __forceinline__ unsigned cvt_pk_bf16(float lo, float hi) { const f32x2c v = {lo, hi}; return __builtin_bit_cast(unsigned, __builtin_convertvector(v, b16x2c)); }
struct EpiProj {
    static constexpr bool PERM = true, AFTER_DRAIN = false;
    bf16_t* O; float* aux; float* kvss;
    __device__ __forceinline__ void operator()(const f32x4 (&acc)[2][2][4][2], const Unit& u, int wr, int wc, int fr, int fq) const {
        const int row0 = u.pm * BM + wr * 64 + fr, col0 = u.pn * BM + wc * 32 + 8 * fq;
        const bool last = (u.pn == 14);
#pragma unroll
        for (int ai = 0; ai < 2; ++ai)
#pragma unroll
            for (int m = 0; m < 4; ++m) {
                const int row = row0 + ai * HALF + m * 16;
                bf16_t* rowp = O + (size_t)row * 3840 + col0;
#pragma unroll
                for (int bj = 0; bj < 2; ++bj) {
                    const f32x4 v0 = acc[ai][bj][m][0], v1 = acc[ai][bj][m][1];
                    u32x4 w; w.x = cvt_pk_bf16(v0[0], v0[1]); w.y = cvt_pk_bf16(v0[2], v0[3]); w.z = cvt_pk_bf16(v1[0], v1[1]); w.w = cvt_pk_bf16(v1[2], v1[3]);
                    *(u32x4*)(rowp + bj * HALF) = w;
                }
                if (last) {
                    const f32x4 a0 = acc[ai][0][m][0], a1 = acc[ai][0][m][1];
                    float ss = (a0[0] * a0[0] + a0[1] * a0[1]) + (a0[2] * a0[2] + a0[3] * a0[3]) + (a1[0] * a1[0] + a1[1] * a1[1]) + (a1[2] * a1[2] + a1[3] * a1[3]);
                    ss += __shfl_xor(ss, 16); ss += __shfl_xor(ss, 32);
                    if (fq == 0) kvss[(size_t)row * 4 + wc] = ss;
                    if (wc == 2 && fq < 2) { float* ap = aux + (size_t)row * 16 + 8 * fq; *(f32x4*)ap = acc[ai][1][m][0]; *(f32x4*)(ap + 4) = acc[ai][1][m][1]; }
                }
            }
    }
};
struct EpiF32 {
    static constexpr bool PERM = false, AFTER_DRAIN = false;
    float* C; int ldc;
    __device__ __forceinline__ void operator()(const f32x4 (&acc)[2][2][4][2], const Unit& u, int wr, int wc, int fr, int fq) const {
        const int row0 = u.pm * BM + wr * 64 + fr, col0 = u.pn * BM + wc * 32 + 4 * fq;
#pragma unroll
        for (int ai = 0; ai < 2; ++ai)
#pragma unroll
            for (int m = 0; m < 4; ++m) { float* rowp = C + (size_t)(row0 + ai * HALF + m * 16) * ldc + col0;
#pragma unroll
                for (int bj = 0; bj < 2; ++bj)
#pragma unroll
                    for (int n = 0; n < 2; ++n) *(f32x4*)(rowp + bj * HALF + n * 16) = acc[ai][bj][m][n]; }
    }
};
template <class Epi, class Sched, bool ALIGN_EPI = false, bool SP2 = false>
__device__ __forceinline__ void gemm_phase(PG8_LAS unsigned char* lds, const Gemm g, const Sched& S, const Epi& E) {
    const int tid = threadIdx.x, wid = __builtin_amdgcn_readfirstlane(tid >> 6), lane = tid & 63, wr = wid >> 2, wc = wid & 3, fr = lane & 15, fq = lane >> 4;
    const int K = g.K, nt = K / BK;
    unsigned voffA[2], voffB[2];
#pragma unroll
    for (int i = 0; i < 2; ++i) { int R, C; stage_rc(tid * 16 + i * 8192, R, C); const int Rb = Epi::PERM ? ((R & ~31) + perm32(R & 31)) : R;
        voffA[i] = (unsigned)(R * K + C) * 2u; voffB[i] = (unsigned)(Rb * K + C) * 2u; }
    const size_t kstep = (size_t)(BK * 2);
    const size_t hstep = (size_t)HALF * K * 2;
    const size_t tstep = 2 * hstep;
    const unsigned ldsw = (unsigned)wid * 1024u;
    const int aoff = lds_byte(wr * 64 + fr, fq * 8), boff = lds_byte(wc * 32 + fr, fq * 8);
#define PG8_SA(b, h) (((b) * 2 + (h)) * HTB)
#define PG8_SB(b, h) ((4 + (b) * 2 + (h)) * HTB)
#define PG8_STAGE(bufoff, gbase, voff) do { _Pragma("unroll") for (int _i = 0; _i < 2; ++_i) \
        __builtin_amdgcn_global_load_lds((const unsigned*)((const char*)(gbase) + (voff)[_i]), (PG8_LAS unsigned*)(lds + (bufoff) + ldsw + _i * 8192), 16, 0, 0); } while (0)
#define PG8_LDA(dst, b, h) do { _Pragma("unroll") for (int m = 0; m < 4; ++m) _Pragma("unroll") for (int k = 0; k < 2; ++k) dst[m][k] = *(const PG8_LAS bf16x8*)(lds + PG8_SA(b, h) + aoff + m * 2048 + k * 1024); } while (0)
#define PG8_LDB(dst, b, h) do { _Pragma("unroll") for (int n = 0; n < 2; ++n) _Pragma("unroll") for (int k = 0; k < 2; ++k) dst[n][k] = *(const PG8_LAS bf16x8*)(lds + PG8_SB(b, h) + boff + n * 2048 + k * 1024); } while (0)
#define PG8_MMA(ai, bj, At, Bt) do { __builtin_amdgcn_s_setprio(1); _Pragma("unroll") for (int m = 0; m < 4; ++m) _Pragma("unroll") for (int n = 0; n < 2; ++n) _Pragma("unroll") for (int k = 0; k < 2; ++k) \
        acc[ai][bj][m][n] = __builtin_amdgcn_mfma_f32_16x16x32_bf16(Bt[n][k], At[m][k], acc[ai][bj][m][n], 0, 0, 0); __builtin_amdgcn_s_setprio(0); } while (0)
#define PG8_WAIT_V(n) asm volatile("s_waitcnt vmcnt(" #n ")" ::: "memory")
#define PG8_WAIT_L(n) asm volatile("s_waitcnt lgkmcnt(" #n ")" ::: "memory")
#define PG8_BAR __builtin_amdgcn_s_barrier()
#define PG8_SCHED __builtin_amdgcn_sched_barrier(0)
    Unit cur, nxt; int ui = 0;
    if (!S.next(0, cur)) return;
    f32x4 acc[2][2][4][2];
#pragma unroll
    for (int a = 0; a < 2; ++a)
#pragma unroll
        for (int b = 0; b < 2; ++b)
#pragma unroll
            for (int m = 0; m < 4; ++m)
#pragma unroll
                for (int n = 0; n < 2; ++n) acc[a][b][m][n] = (f32x4){0.f, 0.f, 0.f, 0.f};
    bf16x8 At[4][2], B0[2][2], B1[2][2];
    const char* cA = (const char*)g.A + (size_t)cur.pm * tstep; const char* cB = (const char*)g.Bt + (size_t)cur.pn * tstep;
    S.a_ready(cur);
    if constexpr (SP2) {
        PG8_STAGE(PG8_SB(0, 0), cB, voffB); PG8_STAGE(PG8_SB(0, 1), cB + hstep, voffB); PG8_STAGE(PG8_SA(0, 0), cA, voffA); PG8_STAGE(PG8_SA(0, 1), cA + hstep, voffA);
        if (wr == 1) PG8_BAR;
        PG8_WAIT_V(2); PG8_BAR;
        PG8_STAGE(PG8_SB(1, 0), cB + kstep, voffB); PG8_STAGE(PG8_SA(1, 0), cA + kstep, voffA); PG8_STAGE(PG8_SB(1, 1), cB + hstep + kstep, voffB);
        PG8_WAIT_V(6); PG8_BAR;
    } else {
        PG8_STAGE(PG8_SB(0, 0), cB, voffB); PG8_STAGE(PG8_SA(0, 0), cA, voffA); PG8_STAGE(PG8_SB(0, 1), cB + hstep, voffB); PG8_STAGE(PG8_SA(0, 1), cA + hstep, voffA);
        if (wr == 1) PG8_BAR;
        PG8_WAIT_V(4); PG8_BAR;
        PG8_STAGE(PG8_SB(1, 0), cB + kstep, voffB); PG8_STAGE(PG8_SA(1, 0), cA + kstep, voffA); PG8_STAGE(PG8_SB(1, 1), cB + hstep + kstep, voffB);
        PG8_WAIT_V(6); PG8_BAR;
    }
    for (;;) {
        const bool has_next = S.next(ui + 1, nxt);
        const char* nA = has_next ? (const char*)g.A + (size_t)nxt.pm * tstep : cA; const char* nB = has_next ? (const char*)g.Bt + (size_t)nxt.pn * tstep : cB;
        for (int t = 0; t < nt; t += 2) {
            const bool last = (t == nt - 2);
            const char* a1 = cA + (size_t)(t + 1) * kstep;
            const char* a2 = last ? nA : cA + (size_t)(t + 2) * kstep; const char* b2 = last ? nB : cB + (size_t)(t + 2) * kstep;
            const char* a3 = a2 + kstep; const char* b3 = b2 + kstep;
            if (last && has_next) S.a_ready(nxt);
            if constexpr (SP2) {
            PG8_LDB(B0, 0, 0); PG8_LDB(B1, 0, 1); PG8_SCHED; PG8_LDA(At, 0, 0); PG8_STAGE(PG8_SA(1, 1), a1 + hstep, voffA);
            PG8_WAIT_V(8); PG8_WAIT_L(0); PG8_BAR; PG8_MMA(0, 0, At, B0); PG8_MMA(0, 1, At, B1); PG8_BAR; PG8_SCHED;
            PG8_LDA(At, 0, 1); PG8_STAGE(PG8_SB(0, 0), b2, voffB); PG8_STAGE(PG8_SB(0, 1), b2 + hstep, voffB); PG8_STAGE(PG8_SA(0, 0), a2, voffA);
            PG8_WAIT_V(8); PG8_WAIT_L(0); PG8_BAR; PG8_MMA(1, 0, At, B0); PG8_MMA(1, 1, At, B1); PG8_BAR; PG8_SCHED;
            PG8_LDB(B0, 1, 0); PG8_LDB(B1, 1, 1); PG8_SCHED; PG8_LDA(At, 1, 0); PG8_STAGE(PG8_SA(0, 1), a2 + hstep, voffA);
            PG8_WAIT_V(8); PG8_WAIT_L(0); PG8_BAR; PG8_MMA(0, 0, At, B0); PG8_MMA(0, 1, At, B1); PG8_BAR; PG8_SCHED;
            PG8_LDA(At, 1, 1); PG8_STAGE(PG8_SB(1, 0), b3, voffB); PG8_STAGE(PG8_SB(1, 1), b3 + hstep, voffB); PG8_STAGE(PG8_SA(1, 0), a3, voffA);
            PG8_WAIT_V(8); PG8_WAIT_L(0); PG8_BAR; PG8_MMA(1, 0, At, B0); PG8_MMA(1, 1, At, B1); PG8_BAR; PG8_SCHED;
            } else {
            PG8_LDB(B0, 0, 0); PG8_SCHED; PG8_LDA(At, 0, 0); PG8_STAGE(PG8_SA(1, 1), a1 + hstep, voffA);
            PG8_WAIT_L(8); PG8_BAR; PG8_WAIT_L(0); PG8_MMA(0, 0, At, B0); PG8_BAR; PG8_SCHED;
            PG8_LDB(B1, 0, 1); PG8_STAGE(PG8_SB(0, 0), b2, voffB);
            PG8_BAR; PG8_WAIT_L(0); PG8_MMA(0, 1, At, B1); PG8_BAR;
            PG8_LDA(At, 0, 1); PG8_STAGE(PG8_SA(0, 0), a2, voffA);
            PG8_BAR; PG8_WAIT_L(0); PG8_MMA(1, 0, At, B0); PG8_BAR; PG8_SCHED;
            PG8_STAGE(PG8_SB(0, 1), b2 + hstep, voffB);
            PG8_WAIT_V(6); PG8_BAR; PG8_MMA(1, 1, At, B1); PG8_BAR;
            PG8_LDB(B0, 1, 0); PG8_SCHED; PG8_LDA(At, 1, 0); PG8_STAGE(PG8_SA(0, 1), a2 + hstep, voffA);
            PG8_WAIT_L(8); PG8_BAR; PG8_WAIT_L(0); PG8_MMA(0, 0, At, B0); PG8_BAR; PG8_SCHED;
            PG8_LDB(B1, 1, 1); PG8_STAGE(PG8_SB(1, 0), b3, voffB);
            PG8_BAR; PG8_WAIT_L(0); PG8_MMA(0, 1, At, B1); PG8_BAR;
            PG8_LDA(At, 1, 1); PG8_STAGE(PG8_SA(1, 0), a3, voffA);
            PG8_BAR; PG8_WAIT_L(0); PG8_MMA(1, 0, At, B0); PG8_BAR; PG8_SCHED;
            PG8_STAGE(PG8_SB(1, 1), b3 + hstep, voffB);
            PG8_WAIT_V(6); PG8_BAR; PG8_MMA(1, 1, At, B1); PG8_BAR;
            }
        }
        if constexpr (ALIGN_EPI) { if (wr == 0) PG8_BAR; }
        if constexpr (!Epi::AFTER_DRAIN) { E(acc, cur, wr, wc, fr, fq); S.done(cur); }
        if (!has_next) break;
#pragma unroll
        for (int a = 0; a < 2; ++a)
#pragma unroll
            for (int b = 0; b < 2; ++b)
#pragma unroll
                for (int m = 0; m < 4; ++m)
#pragma unroll
                    for (int n = 0; n < 2; ++n) acc[a][b][m][n] = (f32x4){0.f, 0.f, 0.f, 0.f};
        cur = nxt; cA = nA; cB = nB; ++ui;
        if constexpr (ALIGN_EPI) { if (wr == 1) PG8_BAR; }
    }
    PG8_WAIT_V(0);
    if constexpr (!ALIGN_EPI) { if (wr == 0) PG8_BAR; }
    PG8_BAR;
    if constexpr (Epi::AFTER_DRAIN) { E.fused(acc, cur, wr, wc, fr, fq, lds, wid, lane); S.done(cur); }
#undef PG8_SA
#undef PG8_SB
#undef PG8_STAGE
#undef PG8_LDA
#undef PG8_LDB
#undef PG8_MMA
#undef PG8_WAIT_V
#undef PG8_WAIT_L
#undef PG8_BAR
#undef PG8_SCHED
}
}

constexpr int NWAVES = 8;
constexpr int NB = 32, SEQ = 2048, DM = 1024, MROWS = NB * SEQ;
constexpr int NPROJ = 3840;
constexpr int C_ZA = 1536, C_QB = 2048, C_ZB = 2560, C_IQ = 3072, C_CKV = 3584, C_IK = 3712;
constexpr float EPSF = 1e-6f;
constexpr float LOG2E = 1.4426950408889634f;
__host__ __device__ __forceinline__ int proj_src_col(int n) {
    if (n < 2048) return n;
    if (n < 2560) return n - 2048 + 2056;
    if (n < 3072) return n - 2560 + 2696;
    if (n < 3584) return n - 3072 + 3208;
    if (n < 3712) return n - 3584 + 2568;
    if (n < 3776) return n - 3712 + 3720;
    if (n < 3784) return n - 3776 + 2048;
    if (n < 3792) return n;
    return -1;
}
__device__ const unsigned char T5_BUCKET[128] = {0,1,2,3,4,5,6,7,8,9,10,11,12,13,14,15,16,16,16,17,17,18,18,18,19,19,19,20,20,20,20,21,21,21,21,22,22,22,22,22,23,23,23,23,23,23,24,24,24,24,24,24,25,25,25,25,25,25,25,26,26,26,26,26,26,26,26,27,27,27,27,27,27,27,27,27,27,28,28,28,28,28,28,28,28,28,28,29,29,29,29,29,29,29,29,29,29,29,29,30,30,30,30,30,30,30,30,30,30,30,30,30,30,31,31,31,31,31,31,31,31,31,31,31,31,31,31,31};

constexpr size_t MiB = 1u << 20;
constexpr size_t WS_CTL = 0, CTL_ZERO_BYTES = 1 * MiB;
constexpr size_t WS_MOD = 1 * MiB;
constexpr size_t WS_WUV = 2 * MiB;
constexpr size_t WS_WOUT = 3 * MiB;
constexpr size_t WS_WIN = 5 * MiB;
constexpr size_t WS_KVSS = 13 * MiB;
constexpr size_t WS_AUX = 14 * MiB;
constexpr size_t WS_XN = 32 * MiB;
constexpr size_t WS_PROJ = 160 * MiB;
constexpr size_t WS_SCR = 640 * MiB;
constexpr size_t WS_END = 768 * MiB;
constexpr int CW_TMO = 0, CW_QUEUE = 64, CW_BAR = 4096;

constexpr int LDS_BYTES = 163840;
constexpr int MISC_OFF = LDS_BYTES - 256;
constexpr int SCRATCH_BYTES = MISC_OFF;

#define GAS __attribute__((address_space(1)))
#define LAS __attribute__((address_space(3)))
typedef unsigned short bf16;
typedef unsigned v4u __attribute__((ext_vector_type(4)));
typedef unsigned v2u __attribute__((ext_vector_type(2)));
typedef float f32x4 __attribute__((ext_vector_type(4)));
typedef float f32x16 __attribute__((ext_vector_type(16)));
typedef short bf16x8 __attribute__((ext_vector_type(8)));
typedef GAS unsigned gu32;
#define RLX_AGENT __ATOMIC_RELAXED, __HIP_MEMORY_SCOPE_AGENT
#define LDS_WAIT() asm volatile("s_waitcnt lgkmcnt(0)" ::: "memory")
#define MFMA32(a, b, c) __builtin_amdgcn_mfma_f32_32x32x16_bf16((a), (b), (c), 0, 0, 0)
#define MFMA16F(a, b, c) __builtin_amdgcn_mfma_f32_16x16x4f32((a), (b), (c), 0, 0, 0)
__device__ __forceinline__ unsigned f2bf(float f) { unsigned u = __builtin_bit_cast(unsigned, f); return (u + 0x7fffu + ((u >> 16) & 1u)) >> 16; }
__device__ __forceinline__ unsigned pk2(float lo, float hi) { return f2bf(lo) | (f2bf(hi) << 16); }
__device__ __forceinline__ float bf2f(unsigned short b) { return __builtin_bit_cast(float, ((unsigned)b) << 16); }
__device__ __forceinline__ float bflo(unsigned w) { return __builtin_bit_cast(float, w << 16); }
__device__ __forceinline__ float bfhi(unsigned w) { return __builtin_bit_cast(float, w & 0xffff0000u); }
__device__ __forceinline__ float siluf(float x) { return x / (1.0f + __expf(-x)); }
__device__ __forceinline__ float wave_sum(float v) {
#pragma unroll
    for (int o = 1; o < 64; o <<= 1) v += __shfl_xor(v, o);
    return v;
}
#define XB_TMO      128
#define XB_XCNT(j)  (256  + 64 * (j))
#define XB_XSUB(j)  (1280 + 64 * (j))
#define XB_XGEN(j)  (2304 + 64 * (j))
#define XB_TOP      3328
#define XB_TOPGEN   3392
#define XCD_BAR_WORDS 3456
#define XB_SPIN_CAP (1u << 18)

__device__ __forceinline__ unsigned xb_ld(unsigned* p)              { return __hip_atomic_load(p, __ATOMIC_RELAXED, __HIP_MEMORY_SCOPE_AGENT); }
__device__ __forceinline__ unsigned xb_add(unsigned* p, unsigned v) { return __hip_atomic_fetch_add(p, v, __ATOMIC_RELAXED, __HIP_MEMORY_SCOPE_AGENT); }
__device__ __forceinline__ unsigned xb_xcc_id() { return (unsigned)__builtin_amdgcn_s_getreg((3 << 11) | 20) & 0xFu; }
#define XB_SPIN(cond, bar) do { unsigned _sp = 0; while (cond) { __builtin_amdgcn_s_sleep(1); \
    if ((++_sp & 255u) == 0u) { if (xb_ld(&(bar)[XB_TMO])) break; if (_sp > XB_SPIN_CAP) { atomicAdd(&(bar)[XB_TMO], 1u); break; } } } } while (0)

struct XcdBarrier {
    unsigned* bar; unsigned x;
    volatile LAS unsigned* st;
};

__device__ __forceinline__ XcdBarrier xcd_barrier_post(unsigned* bar, volatile LAS unsigned* st) {
    XcdBarrier b; b.bar = bar; b.x = xb_xcc_id(); b.st = st;
    if (threadIdx.x == 0) (void)xb_add(&bar[XB_XCNT(b.x)], 1u);
    return b;
}
__device__ __forceinline__ void xcd_barrier_complete(unsigned* bar, unsigned x, unsigned& nloc, unsigned& nx) {
    const unsigned G = gridDim.x * gridDim.y * gridDim.z;
    unsigned sum, cnt, mine, sp = 0u;
    for (;;) {
        sum = 0u; cnt = 0u; mine = 0u;
#pragma unroll
        for (unsigned j = 0; j < 16; ++j) { const unsigned c = xb_ld(&bar[XB_XCNT(j)]); sum += c; cnt += (c > 0u) ? 1u : 0u; mine = (j == x) ? c : mine; }
        if (sum == G) break;
        __builtin_amdgcn_s_sleep(1);
        if ((++sp & 255u) == 0u) { if (xb_ld(&bar[XB_TMO])) break; if (sp > XB_SPIN_CAP) { atomicAdd(&bar[XB_TMO], 1u); break; } }
    }
    nloc = mine > 0u ? mine : 1u; nx = cnt > 0u ? cnt : 1u;
}

__device__ __forceinline__ void xcd_barrier(const XcdBarrier& b) {
    asm volatile("s_waitcnt vmcnt(0)" ::: "memory");
    __syncthreads();
    if (threadIdx.x == 0) {
        unsigned* bar = b.bar;
        __builtin_amdgcn_s_waitcnt(0);
        unsigned nloc = b.st[0], nx = b.st[1];
        if (nloc == 0u) { xcd_barrier_complete(bar, b.x, nloc, nx); b.st[0] = nloc; b.st[1] = nx; }
        const unsigned old = xb_add(&bar[XB_XSUB(b.x)], 1u);
        const unsigned gen = old / nloc;
        if (old + 1u == (gen + 1u) * nloc) {
            __builtin_amdgcn_fence(__ATOMIC_RELEASE, "agent");
            asm volatile("s_waitcnt vmcnt(0)" ::: "memory");
            const unsigned og = xb_add(&bar[XB_TOP], 1u);
            const unsigned tg = og / nx;
            if (og + 1u == (tg + 1u) * nx) xb_add(&bar[XB_TOPGEN], 1u);
            else XB_SPIN(xb_ld(&bar[XB_TOPGEN]) == tg, bar);
            __builtin_amdgcn_fence(__ATOMIC_ACQUIRE, "agent");
            xb_add(&bar[XB_XGEN(b.x)], 1u);
            asm volatile("s_waitcnt vmcnt(0)" ::: "memory");
        } else {
            XB_SPIN(xb_ld(&bar[XB_XGEN(b.x)]) == gen, bar);
            __builtin_amdgcn_fence(__ATOMIC_ACQUIRE, "agent");
            asm volatile("s_waitcnt vmcnt(0)" ::: "memory");
        }
    }
    __syncthreads();
}

struct Frame {
    LAS unsigned char* lds;
    volatile LAS unsigned* MISC;
    gu32* ctl;
    int tid, lane, wave;
    int vcu, G;
    unsigned char* ws;
};
#define P_X        (args.in[0])
#define P_C        (args.in[1])
#define P_WADA     (args.in[2])
#define P_BADA     (args.in[3])
#define P_GPRE     (args.in[4])
#define P_WIN      (args.in[5])
#define P_CONVW    (args.in[6])
#define P_ALOG     (args.in[7])
#define P_DTB      (args.in[8])
#define P_GGDN     (args.in[9])
#define P_GKV      (args.in[10])
#define P_WUV      (args.in[11])
#define P_RELB     (args.in[12])
#define P_WOUT     (args.in[13])
#define P_GPOST    (args.in[14])
#define P_OUT      (args.out)
#define W_MOD      ((float*)(F.ws + WS_MOD))
#define W_WUVT     ((bf16*)(F.ws + WS_WUV))
#define W_WOUTT    ((bf16*)(F.ws + WS_WOUT))
#define W_WINT     ((bf16*)(F.ws + WS_WIN))
#define W_KVSS     ((float*)(F.ws + WS_KVSS))
#define W_AUX      ((float*)(F.ws + WS_AUX))
#define W_XN       ((bf16*)(F.ws + WS_XN))
#define W_OAB      ((bf16*)(F.ws + WS_XN))
#define W_PROJ     ((bf16*)(F.ws + WS_PROJ))
#define W_MIX      ((float*)(F.ws + WS_PROJ))
#define W_SCR      ((float*)(F.ws + WS_SCR))
struct Args { const float* in[15]; float* out; unsigned char* ws; int ph_lo, ph_hi, li, pad; };

template <class CM>
__device__ __forceinline__ void transpose_item(const float* W, int ldw, bf16* WT, int K, int k0, int n0, LAS float* scr, int lane, CM cm) {
    const int nn = lane & 31, sc = cm(n0 + nn);
#pragma unroll 8
    for (int i = 0; i < 32; ++i) { const int kk = 2 * i + (lane >> 5); scr[kk * 33 + nn] = sc >= 0 ? W[(size_t)(k0 + kk) * ldw + sc] : 0.f; }
    LDS_WAIT(); asm volatile("" ::: "memory");
    const int c = lane & 7;
#pragma unroll
    for (int j = 0; j < 4; ++j) { const int n = (lane >> 3) + 8 * j; const LAS float* s = scr + (8 * c) * 33 + n;
        v4u o; o.x = pk2(s[0 * 33], s[1 * 33]); o.y = pk2(s[2 * 33], s[3 * 33]); o.z = pk2(s[4 * 33], s[5 * 33]); o.w = pk2(s[6 * 33], s[7 * 33]);
        *(GAS v4u*)(WT + (size_t)(n0 + n) * K + k0 + 8 * c) = o; }
    LDS_WAIT(); asm volatile("" ::: "memory");
}
struct CmIdent { __device__ __forceinline__ int operator()(int n) const { return n; } };
struct CmProj { __device__ __forceinline__ int operator()(int n) const { return proj_src_col(n); } };

__device__ __forceinline__ void p0_prologue(Frame& F, const Args& args) {
    LAS float* scr = (LAS float*)(F.lds + F.wave * 16384);
    const int gw = F.vcu * NWAVES + F.wave, NGW = F.G * NWAVES;
    constexpr int I_IN = 16 * (NPROJ / 32), I_OUT = 16 * 32, I_UV = 4 * 2 * 4;
    for (int it = gw; it < I_IN + I_OUT + I_UV; it += NGW) {
        int r = it;
        if (r < I_IN) { const int kb = r / (NPROJ / 32), nb = r % (NPROJ / 32); transpose_item(P_WIN, 3792, W_WINT, 1024, 64 * kb, 32 * nb, scr, F.lane, CmProj()); continue; }
        r -= I_IN;
        if (r < I_OUT) { const int kb = r / 32, nb = r % 32; transpose_item(P_WOUT, 1024, W_WOUTT, 1024, 64 * kb, 32 * nb, scr, F.lane, CmIdent()); continue; }
        r -= I_OUT;
        { const int hd = r >> 3, kb = (r >> 2) & 1, nb = r & 3; transpose_item(P_WUV + (size_t)hd * 16384, 128, W_WUVT + (size_t)hd * 16384, 128, 64 * kb, 32 * nb, scr, F.lane, CmIdent()); }
    }
    __syncthreads();
    if (F.vcu < 192) {
        LAS float* SC = (LAS float*)F.lds;
        for (int e = F.tid; e < NB * 1024; e += NWAVES * 64) { const int b = e >> 10, k = e & 1023; SC[k * 33 + b] = siluf(P_C[e]); }
        __syncthreads();
        const int col = F.tid & 15, ks = F.tid >> 4, n = F.vcu * 16 + col;
        float acc[32];
#pragma unroll
        for (int b = 0; b < 32; ++b) acc[b] = 0.f;
        for (int kk = 0; kk < 32; ++kk) { const int k = ks * 32 + kk; const float w = P_WADA[(size_t)k * 3072 + n];
#pragma unroll
            for (int b = 0; b < 32; ++b) acc[b] += SC[k * 33 + b] * w; }
        __syncthreads();
        LAS float* RED = (LAS float*)F.lds;
#pragma unroll
        for (int b = 0; b < 32; ++b) RED[(ks * 32 + b) * 16 + col] = acc[b];
        __syncthreads();
        { const int b = F.tid >> 4; float s = 0.f;
            for (int k2 = 0; k2 < 32; ++k2) s += RED[(k2 * 32 + b) * 16 + col];
            W_MOD[b * 3072 + n] = s + P_BADA[n]; }
        __syncthreads();
    }
}

__device__ __forceinline__ void p1_norm(Frame& F, const Args& args) {
    const int gw = F.vcu * NWAVES + F.wave, NGW = F.G * NWAVES;
    for (int m = gw; m < MROWS; m += NGW) {
        const int b = m >> 11;
        const GAS f32x4* xr = (const GAS f32x4*)(P_X + (size_t)m * DM) + F.lane;
        f32x4 v[4]; float ss = 0.f;
#pragma unroll
        for (int j = 0; j < 4; ++j) { v[j] = xr[64 * j]; ss += (v[j].x * v[j].x + v[j].y * v[j].y) + (v[j].z * v[j].z + v[j].w * v[j].w); }
        const float rstd = 1.0f / sqrtf(wave_sum(ss) * (1.0f / DM) + EPSF);
        const float* mb = W_MOD + b * 3072;
        GAS unsigned long long* o8 = (GAS unsigned long long*)(W_XN + (size_t)m * DM) + F.lane;
#pragma unroll
        for (int j = 0; j < 4; ++j) { const int col = F.lane * 4 + 256 * j;
            const f32x4 g = *(const f32x4*)(P_GPRE + col), sh = *(const f32x4*)(mb + col), sc = *(const f32x4*)(mb + 1024 + col);
            const f32x4 o = v[j] * rstd * g * (sc + 1.0f) + sh;
            o8[64 * j] = (unsigned long long)pk2(o.x, o.y) | ((unsigned long long)pk2(o.z, o.w) << 32); }
    }
}

__device__ __forceinline__ void p5_final(Frame& F, const Args& args) {
    const int gw = F.vcu * NWAVES + F.wave, NGW = F.G * NWAVES;
    for (int m = gw; m < MROWS; m += NGW) {
        const int b = m >> 11;
        const GAS f32x4* mr = (const GAS f32x4*)(W_MIX + (size_t)m * DM) + F.lane;
        const GAS f32x4* xr = (const GAS f32x4*)(P_X + (size_t)m * DM) + F.lane;
        GAS f32x4* orow = (GAS f32x4*)(P_OUT + (size_t)m * DM) + F.lane;
        f32x4 v[4]; float ss = 0.f;
#pragma unroll
        for (int j = 0; j < 4; ++j) { v[j] = mr[64 * j]; ss += (v[j].x * v[j].x + v[j].y * v[j].y) + (v[j].z * v[j].z + v[j].w * v[j].w); }
        const float rstd = 1.0f / sqrtf(wave_sum(ss) * (1.0f / DM) + EPSF);
        const float* gt = W_MOD + b * 3072 + 2048;
#pragma unroll
        for (int j = 0; j < 4; ++j) { const int col = F.lane * 4 + 256 * j;
            const f32x4 g = *(const f32x4*)(P_GPOST + col), ga = *(const f32x4*)(gt + col);
            orow[64 * j] = xr[64 * j] + ga * (v[j] * rstd * g); }
    }
}

__device__ __forceinline__ unsigned cvtpk(float lo, float hi) { return pg8::cvt_pk_bf16(lo, hi); }
__device__ __forceinline__ v2u pack4(float a, float b, float c, float d) { v2u r; r.x = cvtpk(a, b); r.y = cvtpk(c, d); return r; }
__device__ __forceinline__ bf16x8 pack8(float a, float b, float c, float d, float e, float f, float g, float h) { v4u r; r.x = cvtpk(a, b); r.y = cvtpk(c, d); r.z = cvtpk(e, f); r.w = cvtpk(g, h); return __builtin_bit_cast(bf16x8, r); }
__device__ __forceinline__ bf16x8 lds16(const LAS unsigned char* p) { return *(const LAS bf16x8*)p; }
__device__ __forceinline__ bf16x8 lds8x2(const LAS unsigned char* p) { const v2u lo = *(const LAS v2u*)p, hi = *(const LAS v2u*)(p + 16); v4u r; r.x = lo.x; r.y = lo.y; r.z = hi.x; r.w = hi.y; return __builtin_bit_cast(bf16x8, r); }
template <int S> __device__ __forceinline__ bf16x8 acc_frag(const f32x16& a) { return pack8(a[8 * S + 0], a[8 * S + 1], a[8 * S + 2], a[8 * S + 3], a[8 * S + 4], a[8 * S + 5], a[8 * S + 6], a[8 * S + 7]); }

__device__ __forceinline__ void gdn_unit(Frame& F, const Args& args, const int b, const int h) {
    LAS unsigned char* const L = F.lds;
    const int tid = F.tid, lane = F.lane, wv = F.wave, l31_0 = lane & 31, hh_0 = lane >> 5;
    constexpr int P128 = 272, P64 = 144;
    constexpr int O_KH = 0, O_QH = 18432, O_KGT = O_QH + 17408, O_VBT = O_KGT + 18432, O_KBGT = O_VBT + 18432, O_LM = O_KBGT + 18432, O_T = O_LM + 17408,
                  O_TB = O_T + 17408, O_AT = O_TB + 9216, O_PS = O_AT + 9216, O_SM = O_PS + 8192, O_P2 = O_SM + 2560, O_END = O_P2 + 4608;
    static_assert(O_END <= SCRATCH_BYTES, "gdn LDS map");
    constexpr int O_VNT = O_KH, O_W = O_T, O_OF = O_VBT;
    LAS float* const SMb = (LAS float*)(L + O_SM);
    LAS float* const LM = (LAS float*)(L + O_LM);
    LAS float* const TT = (LAS float*)(L + O_T);
    LAS float* const PS = (LAS float*)(L + O_PS);
    LAS float* const P2 = (LAS float*)(L + O_P2);
    LAS float* const OF = (LAS float*)(L + O_OF);
    const int mt = wv >> 2, nt = wv & 3;
    f32x16 S[4];
#pragma unroll
    for (int k = 0; k < 4; ++k)
#pragma unroll
        for (int r = 0; r < 16; ++r) S[k][r] = 0.f;
    const float alog_e = __expf(P_ALOG[h]), dtb = P_DTB[h];
#define GDN_GATES(n_) do { LAS float* _sm = SMb + ((n_) & 1) * 320; const float* _ap = W_AUX + (size_t)(b * SEQ + (n_) * 64 + lane) * 16; \
        const float _bb = _ap[h], _aa = _ap[4 + h]; const float _beta = 1.0f / (1.0f + __expf(-_bb)); const float _xs = _aa + dtb; \
        const float _sp = _xs > 20.f ? _xs : log1pf(__expf(_xs)); float _gc = -alog_e * _sp; \
        _Pragma("unroll") for (int _o = 1; _o < 64; _o <<= 1) { const float _t = __shfl_up(_gc, _o); if (lane >= _o) _gc += _t; } \
        const float _gl = __shfl(_gc, 63); _sm[lane] = _gc; _sm[64 + lane] = _beta; _sm[128 + lane] = __expf(_gc); _sm[192 + lane] = __expf(_gl - _gc); \
        if (lane == 0) _sm[256] = __expf(_gl); } while (0)
    if (wv == 6) GDN_GATES(0);
    __syncthreads();
    const int ts = tid >> 8, cg_0 = (tid & 255) >> 4, tp_0 = tid & 15;

    for (int n = 0; n < 32; ++n) {
        const int rowbase = b * SEQ + n * 64;
        LAS float* const SMf = SMb + (n & 1) * 320;
        int l31 = l31_0, hh = hh_0, cg = cg_0, tp = tp_0;
        asm volatile("" : "+v"(l31), "+v"(hh), "+v"(cg), "+v"(tp));
        float val[4][8];
#define GDN_CONV(chan_) do { float _cw[4][8]; \
            _Pragma("unroll") for (int _tap = 0; _tap < 4; ++_tap) { const f32x4 _c0 = *(const f32x4*)(P_CONVW + _tap * 1536 + (chan_)), _c1 = *(const f32x4*)(P_CONVW + _tap * 1536 + (chan_) + 4); \
                _cw[_tap][0] = _c0.x; _cw[_tap][1] = _c0.y; _cw[_tap][2] = _c0.z; _cw[_tap][3] = _c0.w; _cw[_tap][4] = _c1.x; _cw[_tap][5] = _c1.y; _cw[_tap][6] = _c1.z; _cw[_tap][7] = _c1.w; } \
            _Pragma("unroll") for (int _j = 0; _j < 4; ++_j) _Pragma("unroll") for (int _e = 0; _e < 8; ++_e) val[_j][_e] = 0.f; \
            const bf16* _src = W_PROJ + (size_t)(rowbase + 4 * tp - 3) * NPROJ + (chan_); \
            _Pragma("unroll") for (int _i = 0; _i < 7; ++_i) { const bool _ok = (n > 0) || (4 * tp - 3 + _i >= 0); \
                v4u _raw; _raw.x = 0u; _raw.y = 0u; _raw.z = 0u; _raw.w = 0u; if (_ok) _raw = *(const GAS v4u*)(_src + (size_t)_i * NPROJ); \
                float _in[8]; _in[0] = bflo(_raw.x); _in[1] = bfhi(_raw.x); _in[2] = bflo(_raw.y); _in[3] = bfhi(_raw.y); _in[4] = bflo(_raw.z); _in[5] = bfhi(_raw.z); _in[6] = bflo(_raw.w); _in[7] = bfhi(_raw.w); \
                _Pragma("unroll") for (int _j = 0; _j < 4; ++_j) { const int _tap = _i - _j; if (_tap >= 0 && _tap < 4) { _Pragma("unroll") for (int _e = 0; _e < 8; ++_e) val[_j][_e] += _in[_e] * _cw[_tap][_e]; } } } \
            _Pragma("unroll") for (int _j = 0; _j < 4; ++_j) _Pragma("unroll") for (int _e = 0; _e < 8; ++_e) val[_j][_e] = siluf(val[_j][_e]); } while (0)
        if (wv < 4) {
            const int chan = 1024 + h * 128 + cg * 8;
            GDN_CONV(chan);
            float be[4];
#pragma unroll
            for (int j = 0; j < 4; ++j) be[j] = SMf[64 + 4 * tp + j];
#pragma unroll
            for (int e = 0; e < 8; ++e) *(LAS v2u*)(L + O_VBT + (cg * 8 + e) * P64 + tp * 8) = pack4(val[0][e] * be[0], val[1][e] * be[1], val[2][e] * be[2], val[3][e] * be[3]);
        }
        {
            const int chan = ts * 512 + h * 128 + cg * 8;
            GDN_CONV(chan);
#pragma unroll
            for (int j = 0; j < 4; ++j) { float ss = 0.f;
#pragma unroll
                for (int e = 0; e < 8; ++e) ss += val[j][e] * val[j][e];
                PS[(ts * 64 + 4 * tp + j) * 16 + cg] = ss; }
        }
        __syncthreads();
        {
#pragma unroll
            for (int j = 0; j < 4; ++j) { const LAS f32x4* pp = (const LAS f32x4*)(PS + (ts * 64 + 4 * tp + j) * 16);
                const f32x4 a = pp[0], bq = pp[1], c = pp[2], d = pp[3];
                const float ss = ((a.x + a.y) + (a.z + a.w)) + ((bq.x + bq.y) + (bq.z + bq.w)) + ((c.x + c.y) + (c.z + c.w)) + ((d.x + d.y) + (d.z + d.w));
                float r = 1.0f / sqrtf(ss + EPSF); if (ts == 0) r *= 0.08838834764831845f;
#pragma unroll
                for (int e = 0; e < 8; ++e) val[j][e] *= r; }
            if (ts == 0) {
#pragma unroll
                for (int j = 0; j < 4; ++j) *(LAS bf16x8*)(L + O_QH + (4 * tp + j) * P128 + cg * 16) = pack8(val[j][0], val[j][1], val[j][2], val[j][3], val[j][4], val[j][5], val[j][6], val[j][7]);
            } else {
                float ek[4], bg[4];
#pragma unroll
                for (int j = 0; j < 4; ++j) { ek[j] = SMf[192 + 4 * tp + j]; bg[j] = SMf[64 + 4 * tp + j] * SMf[128 + 4 * tp + j]; }
#pragma unroll
                for (int j = 0; j < 4; ++j) *(LAS bf16x8*)(L + O_KH + (4 * tp + j) * P128 + cg * 16) = pack8(val[j][0], val[j][1], val[j][2], val[j][3], val[j][4], val[j][5], val[j][6], val[j][7]);
#pragma unroll
                for (int e = 0; e < 8; ++e) {
                    *(LAS v2u*)(L + O_KGT + (cg * 8 + e) * P64 + tp * 8) = pack4(val[0][e] * ek[0], val[1][e] * ek[1], val[2][e] * ek[2], val[3][e] * ek[3]);
                    *(LAS v2u*)(L + O_KBGT + (cg * 8 + e) * P64 + tp * 8) = pack4(val[0][e] * bg[0], val[1][e] * bg[1], val[2][e] * bg[2], val[3][e] * bg[3]); }
            }
        }
        for (int e = tid; e < 64 * 68; e += NWAVES * 64) TT[e] = 0.f;
        __syncthreads();
        if (wv < 4) {
            const int ti = wv >> 1, tj = wv & 1;
            f32x16 C;
#pragma unroll
            for (int r = 0; r < 16; ++r) C[r] = 0.f;
            if (ti >= tj) {
#pragma unroll
                for (int s = 0; s < 8; ++s) C = MFMA32(lds16(L + O_KH + (32 * ti + l31) * P128 + (16 * s + 8 * hh) * 2), lds16(L + O_KH + (32 * tj + l31) * P128 + (16 * s + 8 * hh) * 2), C);
            }
            const int j = 32 * tj + l31; const float gcj = SMf[j];
#pragma unroll
            for (int g = 0; g < 4; ++g) { const int ib = 32 * ti + 8 * g + 4 * hh; const f32x4 gci = *(const LAS f32x4*)(SMf + ib), bei = *(const LAS f32x4*)(SMf + 64 + ib);
#pragma unroll
                for (int e = 0; e < 4; ++e) { const int i = ib + e; LM[i * 68 + j] = (i > j) ? bei[e] * C[4 * g + e] * __expf(gci[e] - gcj) : 0.f; } }
        } else {
            const int w4 = wv - 4, tj = w4 >> 1, ti = w4 & 1;
            f32x16 C;
#pragma unroll
            for (int r = 0; r < 16; ++r) C[r] = 0.f;
            if (ti >= tj) {
#pragma unroll
                for (int s = 0; s < 8; ++s) C = MFMA32(lds16(L + O_KH + (32 * tj + l31) * P128 + (16 * s + 8 * hh) * 2), lds16(L + O_QH + (32 * ti + l31) * P128 + (16 * s + 8 * hh) * 2), C);
            }
            const int i = 32 * ti + l31; const float gci = SMf[i];
#pragma unroll
            for (int g = 0; g < 4; ++g) { const int jb = 32 * tj + 8 * g + 4 * hh; const f32x4 gcj = *(const LAS f32x4*)(SMf + jb); float v[4];
#pragma unroll
                for (int e = 0; e < 4; ++e) v[e] = (i >= jb + e) ? C[4 * g + e] * __expf(gci - gcj[e]) : 0.f;
                *(LAS v2u*)(L + O_AT + i * P64 + jb * 2) = pack4(v[0], v[1], v[2], v[3]); }
        }
        __syncthreads();
        if (wv == 0) {
            const int blk = lane >> 4, c = lane & 15; float x[16];
#pragma unroll
            for (int i = 0; i < 16; ++i) { const LAS float* lr = LM + (16 * blk + i) * 68 + 16 * blk; float a = (i == c) ? 1.f : 0.f;
#pragma unroll
                for (int j = 0; j < i; ++j) a -= lr[j] * x[j];
                x[i] = a; TT[(16 * blk + i) * 68 + 16 * blk + c] = a; }
        }
        __syncthreads();
        {
            const int m = lane & 15, q = lane >> 4;
            if (wv < 2) {
                const int a = 2 * wv, bq = 2 * wv + 1; f32x4 P = {0.f, 0.f, 0.f, 0.f}, R = {0.f, 0.f, 0.f, 0.f};
#pragma unroll
                for (int s = 0; s < 4; ++s) { const int k = q + 4 * s; P = MFMA16F(LM[(16 * bq + m) * 68 + 16 * a + k], TT[(16 * a + k) * 68 + 16 * a + m], P); }
#pragma unroll
                for (int rg = 0; rg < 4; ++rg) { const int k = 4 * q + rg; R = MFMA16F(TT[(16 * bq + m) * 68 + 16 * bq + k], P[rg], R); }
#pragma unroll
                for (int rg = 0; rg < 4; ++rg) TT[(16 * bq + 4 * q + rg) * 68 + 16 * a + m] = -R[rg];
            }
            __syncthreads();
            const int mi = (wv >> 1) & 1, ni = wv & 1;
            if (wv < 4) {
                f32x4 P = {0.f, 0.f, 0.f, 0.f};
#pragma unroll
                for (int s = 0; s < 8; ++s) { const int k = q + 4 * s; P = MFMA16F(LM[(32 + 16 * mi + m) * 68 + k], TT[k * 68 + 16 * ni + m], P); }
#pragma unroll
                for (int rg = 0; rg < 4; ++rg) P2[(16 * mi + 4 * q + rg) * 36 + 16 * ni + m] = P[rg];
            }
            __syncthreads();
            if (wv < 4) {
                f32x4 R = {0.f, 0.f, 0.f, 0.f};
#pragma unroll
                for (int s = 0; s < 8; ++s) { const int k = q + 4 * s; R = MFMA16F(TT[(32 + 16 * mi + m) * 68 + 32 + k], P2[k * 36 + 16 * ni + m], R); }
#pragma unroll
                for (int rg = 0; rg < 4; ++rg) TT[(32 + 16 * mi + 4 * q + rg) * 68 + 16 * ni + m] = -R[rg];
            }
            __syncthreads();
        }
        { const int i = tid >> 3, j0 = (tid & 7) * 8; const LAS f32x4* tp4 = (const LAS f32x4*)(TT + i * 68 + j0); const f32x4 a = tp4[0], c = tp4[1];
            *(LAS bf16x8*)(L + O_TB + i * P64 + j0 * 2) = pack8(a.x, a.y, a.z, a.w, c.x, c.y, c.z, c.w); }
        __syncthreads();
        f32x16 U, WT_;
#pragma unroll
        for (int r = 0; r < 16; ++r) { U[r] = 0.f; WT_[r] = 0.f; }
#pragma unroll
        for (int s = 0; s < 4; ++s) { const bf16x8 a = lds16(L + O_TB + (32 * mt + l31) * P64 + (16 * s + 8 * hh) * 2);
            U = MFMA32(a, lds16(L + O_VBT + (32 * nt + l31) * P64 + (16 * s + 8 * hh) * 2), U);
            WT_ = MFMA32(lds16(L + O_KBGT + (32 * nt + l31) * P64 + (16 * s + 8 * hh) * 2), a, WT_); }
#pragma unroll
        for (int g = 0; g < 4; ++g) *(LAS v2u*)(L + O_W + (32 * mt + l31) * P128 + (32 * nt + 8 * g + 4 * hh) * 2) = pack4(-WT_[4 * g], -WT_[4 * g + 1], -WT_[4 * g + 2], -WT_[4 * g + 3]);
        __syncthreads();
        bf16x8 sf[4][2];
#pragma unroll
        for (int kt = 0; kt < 4; ++kt) { sf[kt][0] = acc_frag<0>(S[kt]); sf[kt][1] = acc_frag<1>(S[kt]); }
#pragma unroll
        for (int kt = 0; kt < 4; ++kt)
#pragma unroll
            for (int s = 0; s < 2; ++s) U = MFMA32(lds8x2(L + O_W + (32 * mt + l31) * P128 + (32 * kt + 16 * s + 4 * hh) * 2), sf[kt][s], U);
#pragma unroll
        for (int g = 0; g < 4; ++g) *(LAS v2u*)(L + O_VNT + (32 * nt + l31) * P64 + (32 * mt + 8 * g + 4 * hh) * 2) = pack4(U[4 * g], U[4 * g + 1], U[4 * g + 2], U[4 * g + 3]);
        __syncthreads();
        {
            f32x16 Oa;
#pragma unroll
            for (int r = 0; r < 16; ++r) Oa[r] = 0.f;
#pragma unroll
            for (int kt = 0; kt < 4; ++kt)
#pragma unroll
                for (int s = 0; s < 2; ++s) Oa = MFMA32(lds8x2(L + O_QH + (32 * mt + l31) * P128 + (32 * kt + 16 * s + 4 * hh) * 2), sf[kt][s], Oa);
#pragma unroll
            for (int g = 0; g < 4; ++g) { const f32x4 e4 = *(const LAS f32x4*)(SMf + 128 + 32 * mt + 8 * g + 4 * hh);
#pragma unroll
                for (int e = 0; e < 4; ++e) Oa[4 * g + e] *= e4[e]; }
            bf16x8 vn[4];
#pragma unroll
            for (int s = 0; s < 4; ++s) vn[s] = lds16(L + O_VNT + (32 * nt + l31) * P64 + (16 * s + 8 * hh) * 2);
#pragma unroll
            for (int s = 0; s < 4; ++s) Oa = MFMA32(lds16(L + O_AT + (32 * mt + l31) * P64 + (16 * s + 8 * hh) * 2), vn[s], Oa);
#pragma unroll
            for (int r = 0; r < 16; ++r) OF[(32 * mt + 8 * (r >> 2) + 4 * hh + (r & 3)) * 132 + 32 * nt + l31] = Oa[r];
            const float glast = SMf[256];
#pragma unroll
            for (int kt = 0; kt < 4; ++kt) {
#pragma unroll
                for (int r = 0; r < 16; ++r) S[kt][r] *= glast;
#pragma unroll
                for (int s = 0; s < 4; ++s) S[kt] = MFMA32(lds16(L + O_KGT + (32 * kt + l31) * P64 + (16 * s + 8 * hh) * 2), vn[s], S[kt]);
            }
        }
        __syncthreads();
        if (wv == 6 && n + 1 < 32) GDN_GATES(n + 1);
        {
            const int tok = tid >> 3, dv0 = (tid & 7) * 16; const size_t row = (size_t)rowbase + tok;
            const LAS f32x4* op = (const LAS f32x4*)(OF + tok * 132 + dv0);
            f32x4 o[4]; float ss = 0.f;
#pragma unroll
            for (int k = 0; k < 4; ++k) { o[k] = op[k]; ss += (o[k].x * o[k].x + o[k].y * o[k].y) + (o[k].z * o[k].z + o[k].w * o[k].w); }
            ss += __shfl_xor(ss, 1); ss += __shfl_xor(ss, 2); ss += __shfl_xor(ss, 4);
            const float rstd = 1.0f / sqrtf(ss * (1.0f / 128.0f) + EPSF);
            const bf16* zp = W_PROJ + row * NPROJ + C_ZA + h * 128 + dv0;
            const v4u z0 = *(const GAS v4u*)zp, z1 = *(const GAS v4u*)(zp + 8);
            const unsigned zw[8] = {z0.x, z0.y, z0.z, z0.w, z1.x, z1.y, z1.z, z1.w};
            unsigned ow[8];
#pragma unroll
            for (int k = 0; k < 4; ++k) { const f32x4 g = *(const f32x4*)(P_GGDN + dv0 + 4 * k);
                ow[2 * k] = cvtpk(o[k].x * rstd * g.x * siluf(bflo(zw[2 * k])), o[k].y * rstd * g.y * siluf(bfhi(zw[2 * k])));
                ow[2 * k + 1] = cvtpk(o[k].z * rstd * g.z * siluf(bflo(zw[2 * k + 1])), o[k].w * rstd * g.w * siluf(bfhi(zw[2 * k + 1]))); }
            bf16* dst = W_OAB + row * DM + h * 128 + dv0;
            v4u w0, w1; w0.x = ow[0]; w0.y = ow[1]; w0.z = ow[2]; w0.w = ow[3]; w1.x = ow[4]; w1.y = ow[5]; w1.z = ow[6]; w1.w = ow[7];
            *(GAS v4u*)dst = w0; *(GAS v4u*)(dst + 8) = w1;
        }
        __syncthreads();
    }
#undef GDN_GATES
#undef GDN_CONV
}

__device__ __forceinline__ void dsa_unit(Frame& F, const Args& args, const int b, const int qb) {
    LAS unsigned char* const L = F.lds;
    const int tid = F.tid, lane = F.lane, wv = F.wave, l31_0 = lane & 31, hh_0 = lane >> 5;
    int l31 = l31_0, hh = hh_0;
    constexpr int PK = 272, PV = 144;
    constexpr int O_K0 = 0, O_V0 = 17408, BUFSZ = 35840, O_MASK = 2 * BUFSZ, O_RS = O_MASK + 16384, O_BT = O_RS + 8192, O_END = O_BT + 2048, O_OA = 0;
    static_assert(O_END <= SCRATCH_BYTES && 4 * 17408 <= 2 * BUFSZ, "dsa LDS map");
    const int t0 = 64 * qb, nk = 64 * (qb + 1);
    const size_t rb = (size_t)b * SEQ;
    LAS unsigned* const MASK = (LAS unsigned*)(L + O_MASK);
    LAS float* const RS = (LAS float*)(L + O_RS);
    LAS float* const BT = (LAS float*)(L + O_BT);
    const float NINF = -__builtin_inff();
    for (int key = tid; key < nk; key += NWAVES * 64) { const f32x4 s4 = *(const f32x4*)(W_KVSS + (rb + key) * 4); RS[key] = 1.0f / sqrtf(((s4.x + s4.y) + (s4.z + s4.w)) * (1.0f / 128.0f) + EPSF); }
    BT[tid] = P_RELB[T5_BUCKET[tid >> 2] * 4 + (tid & 3)] * LOG2E;
    float* const scw = W_SCR + (size_t)(blockIdx.x * NWAVES + wv) * 8 * 2048;
    {
        bf16x8 aq[2][4]; f32x4 wts[2][4];
#pragma unroll
        for (int rt = 0; rt < 2; ++rt) {
            const bf16* p = W_PROJ + (rb + t0 + 8 * wv + 4 * rt + (l31 >> 3)) * NPROJ + C_IQ + (l31 & 7) * 64 + 8 * hh;
#pragma unroll
            for (int s = 0; s < 4; ++s) aq[rt][s] = *(const GAS bf16x8*)(p + 16 * s);
#pragma unroll
            for (int g = 0; g < 4; ++g) wts[rt][g] = *(const f32x4*)(W_AUX + (rb + t0 + 8 * wv + 4 * rt + g) * 16 + 8 + 4 * hh);
        }
        for (int kt = 0; kt < nk / 32; ++kt) {
            const bf16* pk = W_PROJ + (rb + 32 * kt + l31) * NPROJ + C_IK + 8 * hh;
            bf16x8 bk[4];
#pragma unroll
            for (int s = 0; s < 4; ++s) bk[s] = *(const GAS bf16x8*)(pk + 16 * s);
            const int key = 32 * kt + l31;
#pragma unroll
            for (int rt = 0; rt < 2; ++rt) {
                f32x16 C;
#pragma unroll
                for (int r = 0; r < 16; ++r) C[r] = 0.f;
#pragma unroll
                for (int s = 0; s < 4; ++s) C = MFMA32(aq[rt][s], bk[s], C);
#pragma unroll
                for (int g = 0; g < 4; ++g) {
                    float p = wts[rt][g].x * fmaxf(C[4 * g], 0.f) + wts[rt][g].y * fmaxf(C[4 * g + 1], 0.f) + wts[rt][g].z * fmaxf(C[4 * g + 2], 0.f) + wts[rt][g].w * fmaxf(C[4 * g + 3], 0.f);
                    p += __shfl_xor(p, 32);
                    const int ql = 4 * rt + g;
                    if (key > t0 + 8 * wv + ql) p = NINF;
                    if ((g >> 1) == hh) scw[ql * 2048 + key] = p;
                }
            }
        }
    }
    __builtin_amdgcn_fence(__ATOMIC_SEQ_CST, "workgroup");
    asm volatile("s_waitcnt vmcnt(0)" ::: "memory");
    const unsigned long long lt_mask = (1ull << lane) - 1ull;
#pragma unroll 1
    for (int ql = 0; ql < 8; ++ql) {
        const int tq = t0 + 8 * wv + ql;
        LAS unsigned* const mrow = MASK + (8 * wv + ql) * 64;
        if (tq + 1 > 256) {
            unsigned u[32];
#pragma unroll
            for (int i = 0; i < 32; ++i) { const int key = i * 64 + lane; float x = NINF; if (key < nk) x = __hip_atomic_load(scw + ql * 2048 + key, __ATOMIC_RELAXED, __HIP_MEMORY_SCOPE_AGENT);
                const unsigned bits = __builtin_bit_cast(unsigned, x); u[i] = (bits & 0x80000000u) ? ~bits : (bits | 0x80000000u); }
            unsigned prefix = 0u;
#pragma unroll 1
            for (int bit = 31; bit >= 0; --bit) { const unsigned cand = prefix | (1u << bit); int cnt = 0;
#pragma unroll
                for (int i = 0; i < 32; ++i) cnt += __popcll(__ballot(u[i] >= cand));
                if (cnt >= 256) prefix = cand; }
            int cgt = 0;
#pragma unroll
            for (int i = 0; i < 32; ++i) cgt += __popcll(__ballot(u[i] > prefix));
            const int need = 256 - cgt; int before = 0;
#pragma unroll
            for (int i = 0; i < 32; ++i) { const bool eq = (u[i] == prefix); const unsigned long long be = __ballot(eq);
                const int rank = before + __popcll(be & lt_mask); const bool sel = (u[i] > prefix) || (eq && rank < need); before += __popcll(be);
                const unsigned long long bs = __ballot(sel);
                if (lane == 0) { v2u w; w.x = (unsigned)bs; w.y = (unsigned)(bs >> 32); *(LAS v2u*)(mrow + 2 * i) = w; } }
        } else {
#pragma unroll
            for (int i = 0; i < 32; ++i) { const unsigned long long bs = __ballot(i * 64 + lane <= tq);
                if (lane == 0) { v2u w; w.x = (unsigned)bs; w.y = (unsigned)(bs >> 32); *(LAS v2u*)(mrow + 2 * i) = w; } }
        }
    }
    __syncthreads();
    const int qj = l31 >> 2, hd = l31 & 3;
    const int tql = t0 + 8 * wv + qj;
    bf16x8 qf[8]; float qn2 = 0.f;
    {
        const bf16* p = W_PROJ + (rb + tql) * NPROJ + C_QB + hd * 128 + 8 * hh; const float cs = 0.08838834764831845f * LOG2E;
#pragma unroll
        for (int s = 0; s < 8; ++s) { const v4u raw = *(const GAS v4u*)(p + 16 * s); const f32x4 g0 = *(const f32x4*)(P_GKV + 16 * s + 8 * hh), g1 = *(const f32x4*)(P_GKV + 16 * s + 8 * hh + 4);
            v4u o; o.x = cvtpk(bflo(raw.x) * g0.x * cs, bfhi(raw.x) * g0.y * cs); o.y = cvtpk(bflo(raw.y) * g0.z * cs, bfhi(raw.y) * g0.w * cs);
            o.z = cvtpk(bflo(raw.z) * g1.x * cs, bfhi(raw.z) * g1.y * cs); o.w = cvtpk(bflo(raw.w) * g1.z * cs, bfhi(raw.w) * g1.w * cs);
            qn2 += (bflo(o.x) * bflo(o.x) + bfhi(o.x) * bfhi(o.x)) + (bflo(o.y) * bflo(o.y) + bfhi(o.y) * bfhi(o.y)) + (bflo(o.z) * bflo(o.z) + bfhi(o.z) * bfhi(o.z)) + (bflo(o.w) * bflo(o.w) + bfhi(o.w) * bfhi(o.w));
            qf[s] = __builtin_bit_cast(bf16x8, o); }
    }
    qn2 += __shfl_xor(qn2, 32);
    float mb = P_RELB[hd];
    for (int k = 1; k < 32; ++k) mb = fmaxf(mb, P_RELB[k * 4 + hd]);
    const float c0 = -(sqrtf(qn2) * 11.313708499f * 1.01f + mb * LOG2E + 1.0f);
    const float biasfar = BT[127 * 4 + hd];
    f32x16 oacc[4];
#pragma unroll
    for (int d = 0; d < 4; ++d)
#pragma unroll
        for (int r = 0; r < 16; ++r) oacc[d][r] = 0.f;
    float lsum = 0.f;
    v4u st0, st1;
#define DSA_GLOAD(kt) do { const bf16* _p = W_PROJ + (rb + 64 * (kt) + lane) * NPROJ + C_CKV + wv * 16; st0 = *(const GAS v4u*)_p; st1 = *(const GAS v4u*)(_p + 8); } while (0)
#define DSA_SWRITE(buf) do { LAS unsigned char* _kb = L + (buf) * BUFSZ; *(LAS v4u*)(_kb + O_K0 + lane * PK + wv * 32) = st0; *(LAS v4u*)(_kb + O_K0 + lane * PK + wv * 32 + 16) = st1; \
        LAS unsigned short* _vt = (LAS unsigned short*)(_kb + O_V0) + (wv * 16) * 72 + lane; \
        _vt[0 * 72] = (unsigned short)st0.x; _vt[1 * 72] = (unsigned short)(st0.x >> 16); _vt[2 * 72] = (unsigned short)st0.y; _vt[3 * 72] = (unsigned short)(st0.y >> 16); \
        _vt[4 * 72] = (unsigned short)st0.z; _vt[5 * 72] = (unsigned short)(st0.z >> 16); _vt[6 * 72] = (unsigned short)st0.w; _vt[7 * 72] = (unsigned short)(st0.w >> 16); \
        _vt[8 * 72] = (unsigned short)st1.x; _vt[9 * 72] = (unsigned short)(st1.x >> 16); _vt[10 * 72] = (unsigned short)st1.y; _vt[11 * 72] = (unsigned short)(st1.y >> 16); \
        _vt[12 * 72] = (unsigned short)st1.z; _vt[13 * 72] = (unsigned short)(st1.z >> 16); _vt[14 * 72] = (unsigned short)st1.w; _vt[15 * 72] = (unsigned short)(st1.w >> 16); } while (0)
    DSA_GLOAD(0); DSA_SWRITE(0);
    __syncthreads();
    for (int kt = 0; kt <= qb; ++kt) {
        const int buf = kt & 1;
        l31 = l31_0; hh = hh_0; asm volatile("" : "+v"(l31), "+v"(hh));
        if (kt < qb) DSA_GLOAD(kt + 1);
        const LAS unsigned char* kb = L + buf * BUFSZ;
#pragma unroll 1
        for (int st = 0; st < 2; ++st) {
            f32x16 Sa;
#pragma unroll
            for (int r = 0; r < 16; ++r) Sa[r] = 0.f;
#pragma unroll
            for (int s = 0; s < 8; ++s) Sa = MFMA32(lds16(kb + O_K0 + (32 * st + l31) * PK + (16 * s + 8 * hh) * 2), qf[s], Sa);
            const int kbase = 64 * kt + 32 * st;
            const unsigned mw = MASK[(8 * wv + qj) * 64 + 2 * kt + st] >> (4 * hh);
            const bool far = (t0 + 8 * wv) - (kbase + 31) >= 113;
            float pn[16];
#pragma unroll
            for (int g = 0; g < 4; ++g) { const f32x4 rs4 = *(const LAS f32x4*)(RS + kbase + 8 * g + 4 * hh);
#pragma unroll
                for (int e = 0; e < 4; ++e) { const int r = 4 * g + e; float bias = biasfar;
                    if (!far) { int dist = tql - (kbase + 8 * g + 4 * hh + e); dist = dist < 0 ? 0 : (dist > 127 ? 127 : dist); bias = BT[dist * 4 + hd]; }
                    const float lg = Sa[r] * rs4[e] + (bias + c0);
                    const float p = ((mw >> (8 * g + e)) & 1u) ? __builtin_amdgcn_exp2f(lg) : 0.f;
                    lsum += p; pn[r] = p * rs4[e]; } }
            const bf16x8 pf0 = pack8(pn[0], pn[1], pn[2], pn[3], pn[4], pn[5], pn[6], pn[7]), pf1 = pack8(pn[8], pn[9], pn[10], pn[11], pn[12], pn[13], pn[14], pn[15]);
#pragma unroll
            for (int dt = 0; dt < 4; ++dt) { const LAS unsigned char* vp = kb + O_V0 + (32 * dt + l31) * PV + (32 * st + 4 * hh) * 2;
                oacc[dt] = MFMA32(lds8x2(vp), pf0, oacc[dt]); oacc[dt] = MFMA32(lds8x2(vp + 32), pf1, oacc[dt]); }
        }
        if (kt < qb) DSA_SWRITE(buf ^ 1);
        __syncthreads();
    }
#undef DSA_GLOAD
#undef DSA_SWRITE
    lsum += __shfl_xor(lsum, 32);
    {
        const float inv = 1.0f / lsum;
#pragma unroll
        for (int dt = 0; dt < 4; ++dt)
#pragma unroll
            for (int g = 0; g < 4; ++g) { const int d = 32 * dt + 8 * g + 4 * hh; const f32x4 gk = *(const f32x4*)(P_GKV + d);
                *(LAS v2u*)(L + O_OA + hd * 17408 + (8 * wv + qj) * PK + d * 2) = pack4(oacc[dt][4 * g] * inv * gk.x, oacc[dt][4 * g + 1] * inv * gk.y, oacc[dt][4 * g + 2] * inv * gk.z, oacc[dt][4 * g + 3] * inv * gk.w); }
    }
    __syncthreads();
#pragma unroll 1
    for (int x = 0; x < 4; ++x) {
        const int ti = wv * 4 + x, hd2 = ti >> 3, mt2 = (ti >> 2) & 1, et = ti & 3;
        f32x16 C;
#pragma unroll
        for (int r = 0; r < 16; ++r) C[r] = 0.f;
        const bf16* wp = W_WUVT + (size_t)hd2 * 16384 + (32 * et + l31) * 128 + 8 * hh;
#pragma unroll
        for (int s = 0; s < 8; ++s) C = MFMA32(lds16(L + O_OA + hd2 * 17408 + (32 * mt2 + l31) * PK + (16 * s + 8 * hh) * 2), *(const GAS bf16x8*)(wp + 16 * s), C);
        const int ecol = 32 * et + l31;
#pragma unroll
        for (int r = 0; r < 16; ++r) { const size_t row = rb + t0 + 32 * mt2 + 8 * (r >> 2) + 4 * hh + (r & 3);
            const float z = bf2f(W_PROJ[row * NPROJ + C_ZB + hd2 * 128 + ecol]);
            W_OAB[row * DM + 512 + hd2 * 128 + ecol] = (bf16)f2bf(C[r] * siluf(z)); }
    }
    __syncthreads();
}

constexpr int N_GDN = NB * 4, N_DSA = NB * 32, N_ITEMS = N_GDN + N_DSA;
constexpr int N_PHASES = 6;
__global__ void __launch_bounds__(NWAVES * 64, 2) hyb_fwd(Args args) {
    extern __shared__ __attribute__((aligned(16))) unsigned char lds[];
    Frame F;
    F.lds = (LAS unsigned char*)lds;
    F.MISC = (volatile LAS unsigned*)(F.lds + MISC_OFF);
    F.tid = threadIdx.x; F.lane = F.tid & 63; F.wave = __builtin_amdgcn_readfirstlane(F.tid >> 6);
    F.G = gridDim.x; { const int bx = blockIdx.x; F.vcu = (F.G % 8 == 0) ? (bx % 8) * (F.G / 8) + bx / 8 : bx; }
    unsigned char* ws = args.ws;
    F.ctl = (gu32*)(ws + WS_CTL);
    F.ws = ws;
    for (int u = F.tid; u < 64; u += NWAVES * 64) F.MISC[u] = 0u;
    __syncthreads();
    const int lo = args.ph_lo, hi = args.ph_hi;
    const bool multi = (hi - lo) > 1;
    XcdBarrier bar; bar.bar = (unsigned*)(F.ctl + CW_BAR) + args.li * XCD_BAR_WORDS; bar.x = 0; bar.st = nullptr;
    if (multi) bar = xcd_barrier_post((unsigned*)(F.ctl + CW_BAR) + args.li * XCD_BAR_WORDS, F.MISC + 8);
#define IN(k) (lo <= (k) && (k) < hi)
#define BOTH(k) (IN(k) && IN((k) + 1))
    if (IN(0)) { p0_prologue(F, args); if (BOTH(0)) xcd_barrier(bar); }
    if (IN(1)) { p1_norm(F, args); if (BOTH(1)) xcd_barrier(bar); }
    if (IN(2)) {
        pg8::Gemm g{W_XN, W_WINT, MROWS, NPROJ, DM}; pg8::StaticOrder S; S.init(MROWS, NPROJ, F.G, (int)blockIdx.x);
        pg8::EpiProj E{W_PROJ, W_AUX, W_KVSS};
        pg8::gemm_phase<pg8::EpiProj, pg8::StaticOrder, true, true>(F.lds, g, S, E);
        if (BOTH(2)) xcd_barrier(bar);
    }
    if (IN(3)) {
#define NEXT_ITEM(dst) do { if (F.tid == 0) F.MISC[4] = __hip_atomic_fetch_add(F.ctl + CW_QUEUE, 1u, RLX_AGENT); __syncthreads(); dst = (int)F.MISC[4]; __syncthreads(); } while (0)
        int item; NEXT_ITEM(item);
#ifndef NO_GDN
        while (item < N_GDN) { gdn_unit(F, args, item >> 2, item & 3); NEXT_ITEM(item); }
#endif
#ifdef NO_GDN
        while (item < N_GDN) { const int b_ = item >> 2, h_ = item & 3;
            for (int e = F.tid; e < SEQ * 16; e += NWAVES * 64) { const size_t row = (size_t)b_ * SEQ + (e >> 4); const int c8 = (e & 15) * 8;
                *(GAS v4u*)(W_OAB + row * DM + h_ * 128 + c8) = *(const GAS v4u*)(W_PROJ + row * NPROJ + h_ * 128 + c8);
                *(GAS v4u*)(W_OAB + row * DM + 512 + h_ * 128 + c8) = *(const GAS v4u*)(W_PROJ + row * NPROJ + C_QB + h_ * 128 + c8); }
            NEXT_ITEM(item); }
        while (item < N_ITEMS) { NEXT_ITEM(item); }
#endif
#ifndef NO_DSA
        while (item < N_ITEMS) { if (item >= N_GDN) { const int idx = item - N_GDN; dsa_unit(F, args, idx & 31, 31 - (idx >> 5)); } NEXT_ITEM(item); }
#endif
#if defined(NO_DSA) && !defined(NO_GDN)
        while (item < N_ITEMS) { if (item >= N_GDN) { const int idx = item - N_GDN; const int b_ = idx & 31, qb_ = 31 - (idx >> 5);
            for (int e = F.tid; e < 64 * 64; e += NWAVES * 64) { const size_t row = (size_t)b_ * SEQ + 64 * qb_ + (e >> 6); v4u z; z.x = 0u; z.y = 0u; z.z = 0u; z.w = 0u; *(GAS v4u*)(W_OAB + row * DM + 512 + (e & 63) * 8) = z; } } NEXT_ITEM(item); }
#endif
#undef NEXT_ITEM
        if (BOTH(3)) xcd_barrier(bar);
    }
    if (IN(4)) {
        pg8::Gemm g{W_OAB, W_WOUTT, MROWS, DM, DM}; pg8::StaticOrder S; S.init(MROWS, DM, F.G, (int)blockIdx.x);
        pg8::EpiF32 E{W_MIX, DM};
        pg8::gemm_phase<pg8::EpiF32, pg8::StaticOrder, true, true>(F.lds, g, S, E);
        if (BOTH(4)) xcd_barrier(bar);
    }
    if (IN(5)) { p5_final(F, args); }
#undef IN
#undef BOTH
}

extern "C" void kernel_launch(void* const* d_in, const int* in_sizes, int n_in, void* d_out, int out_size, void* d_ws, size_t ws_size, hipStream_t stream) {
    static int grid = 0;
    if (grid == 0) {
        if (n_in != 15 || in_sizes[0] != MROWS * DM || out_size != MROWS * DM || ws_size < WS_END) { fprintf(stderr, "kernel_launch: unexpected shapes (n_in %d, in0 %d, out %d, ws %zu); nothing launched\n", n_in, n_in > 0 ? in_sizes[0] : -1, out_size, ws_size); grid = -1; return; }
        int dev = 0, cus = 0, per_cu = 0;
        if (hipGetDevice(&dev) != hipSuccess || hipDeviceGetAttribute(&cus, hipDeviceAttributeMultiprocessorCount, dev) != hipSuccess) { fprintf(stderr, "kernel_launch: device query failed\n"); grid = -1; return; }
        if (hipFuncSetAttribute((const void*)hyb_fwd, hipFuncAttributeMaxDynamicSharedMemorySize, LDS_BYTES) != hipSuccess) { fprintf(stderr, "kernel_launch: hipFuncSetAttribute failed\n"); grid = -1; return; }
        if (hipOccupancyMaxActiveBlocksPerMultiprocessor(&per_cu, (const void*)hyb_fwd, NWAVES * 64, LDS_BYTES) != hipSuccess || per_cu < 1)
            fprintf(stderr, "kernel_launch: note: occupancy query reports %d workgroups per CU\n", per_cu);
        (void)hipGetLastError();
        grid = cus;
    }
    if (grid < 0) return;
    if (hipMemsetAsync((char*)d_ws + WS_CTL, 0, CTL_ZERO_BYTES, stream) != hipSuccess) { fprintf(stderr, "kernel_launch: memset failed\n"); return; }
    Args a{};
    for (int i = 0; i < 15; ++i) a.in[i] = (const float*)d_in[i];
    a.out = (float*)d_out; a.ws = (unsigned char*)d_ws;
    constexpr int NL = MK_N_LAUNCHES;
    static_assert(NL == 1 || NL == 2 || NL == 3 || NL == N_PHASES, "MK_N_LAUNCHES");
    const int cuts1[2] = {0, 6}, cuts2[3] = {0, 3, 6}, cuts3[4] = {0, 3, 4, 6}, cuts6[7] = {0, 1, 2, 3, 4, 5, 6};
    const int* cuts = NL == 1 ? cuts1 : NL == 2 ? cuts2 : NL == 3 ? cuts3 : cuts6;
    for (int li = 0; li < NL; ++li) {
        a.ph_lo = cuts[li]; a.ph_hi = cuts[li + 1]; a.li = li;
        hipLaunchKernelGGL(hyb_fwd, dim3(grid), dim3(NWAVES * 64), LDS_BYTES, stream, a);
        const hipError_t le = hipPeekAtLastError();
        if (le != hipSuccess) { fprintf(stderr, "kernel_launch: launch %d failed: %s\n", li, hipGetErrorName(le)); break; }
    }
}
```

```cpp
#include <hip/hip_runtime.h>
#include <cstdio>
#include <cstdint>
#ifndef MK_N_LAUNCHES
#define MK_N_LAUNCHES 1
#endif
#ifndef PROBE_DUP
#define PROBE_DUP 0
#endif
namespace pg8 {
#define PG8_LAS __attribute__((address_space(3)))
typedef unsigned short bf16_t;
typedef short bf16x8 __attribute__((ext_vector_type(8)));
typedef float f32x4 __attribute__((ext_vector_type(4)));
typedef unsigned u32x4 __attribute__((ext_vector_type(4)));
constexpr int BM = 256, BK = 64, HALF = 128, HTB = HALF * BK * 2  , STAGE_BYTES = 8 * HTB, NXCD = 8, WGM = 8;

__host__ __device__ __forceinline__ int lds_byte(int r, int c) { const int st = (r >> 4) * 2 + (c >> 5), rr = r & 15, cc = c & 31, ob = rr * 64 + cc * 2; return st * 1024 + (ob ^ (((ob >> 9) & 1) << 5)); }
__host__ __device__ __forceinline__ void stage_rc(int b, int& R, int& C) { const int st = b / 1024, sb = b % 1024, swz = sb ^ (((sb >> 9) & 1) << 5); R = (st >> 1) * 16 + swz / 64; C = (st & 1) * 32 + (swz % 64) / 2; }
__host__ __device__ __forceinline__ int perm32(int rho) { const int n = rho >> 4, i = rho & 15; return 8 * (i >> 2) + 4 * n + (i & 3); }

struct Unit { int pm, pn; };
struct Gemm { const bf16_t* A; const bf16_t* Bt; int M, N, K; };

struct StaticOrder {
    int nM, nN, nwg, G, c;
    __host__ __device__ void init(int M, int N, int G_, int c_) { nM = M / BM; nN = N / BM; nwg = nM * nN; G = G_; c = c_; }
    __host__ __device__ bool next(int i, Unit& u) const {
        const long L = (long)i * G + c; if (L >= nwg) return false;
        int wgid = (int)L; { const int q = nwg / NXCD, r = nwg % NXCD, xcd = wgid % NXCD, off = wgid / NXCD; wgid = (xcd < r ? xcd * (q + 1) : r * (q + 1) + (xcd - r) * q) + off; }
        const int nig = WGM * nN, gid = wgid / nig, fm = gid * WGM, gsz = (nM - fm) < WGM ? (nM - fm) : WGM;
        u.pm = fm + ((wgid % nig) % gsz); u.pn = (wgid % nig) / gsz; return true;
    }
    __device__ __forceinline__ void a_ready(const Unit&) const {}
    __device__ __forceinline__ void done(const Unit&) const {}
};

typedef float f32x2c __attribute__((ext_vector_type(2))); typedef __bf16 b16x2c __attribute__((ext_vector_type(2)));
__device__ __forceinline__ unsigned cvt_pk_bf16(float lo, float hi) { const f32x2c v = {lo, hi}; return __builtin_bit_cast(unsigned, __builtin_convertvector(v, b16x2c)); }
struct EpiProj {
    static constexpr bool PERM = true, AFTER_DRAIN = false;
    bf16_t* O; float* aux; float* kvss;
    __device__ __forceinline__ void operator()(const f32x4 (&acc)[2][2][4][2], const Unit& u, int wr, int wc, int fr, int fq) const {
        const int row0 = u.pm * BM + wr * 64 + fr, col0 = u.pn * BM + wc * 32 + 8 * fq;
        const bool last = (u.pn == 14);
#pragma unroll
        for (int ai = 0; ai < 2; ++ai)
#pragma unroll
            for (int m = 0; m < 4; ++m) {
                const int row = row0 + ai * HALF + m * 16;
                bf16_t* rowp = O + (size_t)row * 3840 + col0;
#pragma unroll
                for (int bj = 0; bj < 2; ++bj) {
                    const f32x4 v0 = acc[ai][bj][m][0], v1 = acc[ai][bj][m][1];
                    u32x4 w; w.x = cvt_pk_bf16(v0[0], v0[1]); w.y = cvt_pk_bf16(v0[2], v0[3]); w.z = cvt_pk_bf16(v1[0], v1[1]); w.w = cvt_pk_bf16(v1[2], v1[3]);
                    *(u32x4*)(rowp + bj * HALF) = w;
                }
                if (last) {
                    const f32x4 a0 = acc[ai][0][m][0], a1 = acc[ai][0][m][1];
                    float ss = (a0[0] * a0[0] + a0[1] * a0[1]) + (a0[2] * a0[2] + a0[3] * a0[3]) + (a1[0] * a1[0] + a1[1] * a1[1]) + (a1[2] * a1[2] + a1[3] * a1[3]);
                    ss += __shfl_xor(ss, 16); ss += __shfl_xor(ss, 32);
                    if (fq == 0) kvss[(size_t)row * 4 + wc] = ss;
                    if (wc == 2 && fq < 2) { float* ap = aux + (size_t)row * 16 + 8 * fq; *(f32x4*)ap = acc[ai][1][m][0]; *(f32x4*)(ap + 4) = acc[ai][1][m][1]; }
                }
            }
    }
};
struct EpiF32 {
    static constexpr bool PERM = false, AFTER_DRAIN = false;
    float* C; int ldc;
    __device__ __forceinline__ void operator()(const f32x4 (&acc)[2][2][4][2], const Unit& u, int wr, int wc, int fr, int fq) const {
        const int row0 = u.pm * BM + wr * 64 + fr, col0 = u.pn * BM + wc * 32 + 4 * fq;
#pragma unroll
        for (int ai = 0; ai < 2; ++ai)
#pragma unroll
            for (int m = 0; m < 4; ++m) { float* rowp = C + (size_t)(row0 + ai * HALF + m * 16) * ldc + col0;
#pragma unroll
                for (int bj = 0; bj < 2; ++bj)
#pragma unroll
                    for (int n = 0; n < 2; ++n) *(f32x4*)(rowp + bj * HALF + n * 16) = acc[ai][bj][m][n]; }
    }
};
template <class Epi, class Sched, bool ALIGN_EPI = false, bool SP2 = false>
__device__ __forceinline__ void gemm_phase(PG8_LAS unsigned char* lds, const Gemm g, const Sched& S, const Epi& E) {
    const int tid = threadIdx.x, wid = __builtin_amdgcn_readfirstlane(tid >> 6), lane = tid & 63, wr = wid >> 2, wc = wid & 3, fr = lane & 15, fq = lane >> 4;
    const int K = g.K, nt = K / BK;
    unsigned voffA[2], voffB[2];
#pragma unroll
    for (int i = 0; i < 2; ++i) { int R, C; stage_rc(tid * 16 + i * 8192, R, C); const int Rb = Epi::PERM ? ((R & ~31) + perm32(R & 31)) : R;
        voffA[i] = (unsigned)(R * K + C) * 2u; voffB[i] = (unsigned)(Rb * K + C) * 2u; }
    const size_t kstep = (size_t)(BK * 2);
    const size_t hstep = (size_t)HALF * K * 2;
    const size_t tstep = 2 * hstep;
    const unsigned ldsw = (unsigned)wid * 1024u;
    const int aoff = lds_byte(wr * 64 + fr, fq * 8), boff = lds_byte(wc * 32 + fr, fq * 8);
#define PG8_SA(b, h) (((b) * 2 + (h)) * HTB)
#define PG8_SB(b, h) ((4 + (b) * 2 + (h)) * HTB)
#define PG8_STAGE(bufoff, gbase, voff) do { _Pragma("unroll") for (int _i = 0; _i < 2; ++_i) \
        __builtin_amdgcn_global_load_lds((const unsigned*)((const char*)(gbase) + (voff)[_i]), (PG8_LAS unsigned*)(lds + (bufoff) + ldsw + _i * 8192), 16, 0, 0); } while (0)
#define PG8_LDA(dst, b, h) do { _Pragma("unroll") for (int m = 0; m < 4; ++m) _Pragma("unroll") for (int k = 0; k < 2; ++k) dst[m][k] = *(const PG8_LAS bf16x8*)(lds + PG8_SA(b, h) + aoff + m * 2048 + k * 1024); } while (0)
#define PG8_LDB(dst, b, h) do { _Pragma("unroll") for (int n = 0; n < 2; ++n) _Pragma("unroll") for (int k = 0; k < 2; ++k) dst[n][k] = *(const PG8_LAS bf16x8*)(lds + PG8_SB(b, h) + boff + n * 2048 + k * 1024); } while (0)
#define PG8_MMA(ai, bj, At, Bt) do { __builtin_amdgcn_s_setprio(1); _Pragma("unroll") for (int m = 0; m < 4; ++m) _Pragma("unroll") for (int n = 0; n < 2; ++n) _Pragma("unroll") for (int k = 0; k < 2; ++k) \
        acc[ai][bj][m][n] = __builtin_amdgcn_mfma_f32_16x16x32_bf16(Bt[n][k], At[m][k], acc[ai][bj][m][n], 0, 0, 0); __builtin_amdgcn_s_setprio(0); } while (0)
#define PG8_WAIT_V(n) asm volatile("s_waitcnt vmcnt(" #n ")" ::: "memory")
#define PG8_WAIT_L(n) asm volatile("s_waitcnt lgkmcnt(" #n ")" ::: "memory")
#define PG8_BAR __builtin_amdgcn_s_barrier()
#define PG8_SCHED __builtin_amdgcn_sched_barrier(0)
    Unit cur, nxt; int ui = 0;
    if (!S.next(0, cur)) return;
    f32x4 acc[2][2][4][2];
#pragma unroll
    for (int a = 0; a < 2; ++a)
#pragma unroll
        for (int b = 0; b < 2; ++b)
#pragma unroll
            for (int m = 0; m < 4; ++m)
#pragma unroll
                for (int n = 0; n < 2; ++n) acc[a][b][m][n] = (f32x4){0.f, 0.f, 0.f, 0.f};
    bf16x8 At[4][2], B0[2][2], B1[2][2];
    const char* cA = (const char*)g.A + (size_t)cur.pm * tstep; const char* cB = (const char*)g.Bt + (size_t)cur.pn * tstep;
    S.a_ready(cur);
    if constexpr (SP2) {
        PG8_STAGE(PG8_SB(0, 0), cB, voffB); PG8_STAGE(PG8_SB(0, 1), cB + hstep, voffB); PG8_STAGE(PG8_SA(0, 0), cA, voffA); PG8_STAGE(PG8_SA(0, 1), cA + hstep, voffA);
        if (wr == 1) PG8_BAR;
        PG8_WAIT_V(2); PG8_BAR;
        PG8_STAGE(PG8_SB(1, 0), cB + kstep, voffB); PG8_STAGE(PG8_SA(1, 0), cA + kstep, voffA); PG8_STAGE(PG8_SB(1, 1), cB + hstep + kstep, voffB);
        PG8_WAIT_V(6); PG8_BAR;
    } else {
        PG8_STAGE(PG8_SB(0, 0), cB, voffB); PG8_STAGE(PG8_SA(0, 0), cA, voffA); PG8_STAGE(PG8_SB(0, 1), cB + hstep, voffB); PG8_STAGE(PG8_SA(0, 1), cA + hstep, voffA);
        if (wr == 1) PG8_BAR;
        PG8_WAIT_V(4); PG8_BAR;
        PG8_STAGE(PG8_SB(1, 0), cB + kstep, voffB); PG8_STAGE(PG8_SA(1, 0), cA + kstep, voffA); PG8_STAGE(PG8_SB(1, 1), cB + hstep + kstep, voffB);
        PG8_WAIT_V(6); PG8_BAR;
    }
    for (;;) {
        const bool has_next = S.next(ui + 1, nxt);
        const char* nA = has_next ? (const char*)g.A + (size_t)nxt.pm * tstep : cA; const char* nB = has_next ? (const char*)g.Bt + (size_t)nxt.pn * tstep : cB;
        for (int t = 0; t < nt; t += 2) {
            const bool last = (t == nt - 2);
            const char* a1 = cA + (size_t)(t + 1) * kstep;
            const char* a2 = last ? nA : cA + (size_t)(t + 2) * kstep; const char* b2 = last ? nB : cB + (size_t)(t + 2) * kstep;
            const char* a3 = a2 + kstep; const char* b3 = b2 + kstep;
            if (last && has_next) S.a_ready(nxt);
            if constexpr (SP2) {
            PG8_LDB(B0, 0, 0); PG8_LDB(B1, 0, 1); PG8_SCHED; PG8_LDA(At, 0, 0); PG8_STAGE(PG8_SA(1, 1), a1 + hstep, voffA);
            PG8_WAIT_V(8); PG8_WAIT_L(0); PG8_BAR; PG8_MMA(0, 0, At, B0); PG8_MMA(0, 1, At, B1); PG8_BAR; PG8_SCHED;
            PG8_LDA(At, 0, 1); PG8_STAGE(PG8_SB(0, 0), b2, voffB); PG8_STAGE(PG8_SB(0, 1), b2 + hstep, voffB); PG8_STAGE(PG8_SA(0, 0), a2, voffA);
            PG8_WAIT_V(8); PG8_WAIT_L(0); PG8_BAR; PG8_MMA(1, 0, At, B0); PG8_MMA(1, 1, At, B1); PG8_BAR; PG8_SCHED;
            PG8_LDB(B0, 1, 0); PG8_LDB(B1, 1, 1); PG8_SCHED; PG8_LDA(At, 1, 0); PG8_STAGE(PG8_SA(0, 1), a2 + hstep, voffA);
            PG8_WAIT_V(8); PG8_WAIT_L(0); PG8_BAR; PG8_MMA(0, 0, At, B0); PG8_MMA(0, 1, At, B1); PG8_BAR; PG8_SCHED;
            PG8_LDA(At, 1, 1); PG8_STAGE(PG8_SB(1, 0), b3, voffB); PG8_STAGE(PG8_SB(1, 1), b3 + hstep, voffB); PG8_STAGE(PG8_SA(1, 0), a3, voffA);
            PG8_WAIT_V(8); PG8_WAIT_L(0); PG8_BAR; PG8_MMA(1, 0, At, B0); PG8_MMA(1, 1, At, B1); PG8_BAR; PG8_SCHED;
            } else {
            PG8_LDB(B0, 0, 0); PG8_SCHED; PG8_LDA(At, 0, 0); PG8_STAGE(PG8_SA(1, 1), a1 + hstep, voffA);
            PG8_WAIT_L(8); PG8_BAR; PG8_WAIT_L(0); PG8_MMA(0, 0, At, B0); PG8_BAR; PG8_SCHED;
            PG8_LDB(B1, 0, 1); PG8_STAGE(PG8_SB(0, 0), b2, voffB);
            PG8_BAR; PG8_WAIT_L(0); PG8_MMA(0, 1, At, B1); PG8_BAR;
            PG8_LDA(At, 0, 1); PG8_STAGE(PG8_SA(0, 0), a2, voffA);
            PG8_BAR; PG8_WAIT_L(0); PG8_MMA(1, 0, At, B0); PG8_BAR; PG8_SCHED;
            PG8_STAGE(PG8_SB(0, 1), b2 + hstep, voffB);
            PG8_WAIT_V(6); PG8_BAR; PG8_MMA(1, 1, At, B1); PG8_BAR;
            PG8_LDB(B0, 1, 0); PG8_SCHED; PG8_LDA(At, 1, 0); PG8_STAGE(PG8_SA(0, 1), a2 + hstep, voffA);
            PG8_WAIT_L(8); PG8_BAR; PG8_WAIT_L(0); PG8_MMA(0, 0, At, B0); PG8_BAR; PG8_SCHED;
            PG8_LDB(B1, 1, 1); PG8_STAGE(PG8_SB(1, 0), b3, voffB);
            PG8_BAR; PG8_WAIT_L(0); PG8_MMA(0, 1, At, B1); PG8_BAR;
            PG8_LDA(At, 1, 1); PG8_STAGE(PG8_SA(1, 0), a3, voffA);
            PG8_BAR; PG8_WAIT_L(0); PG8_MMA(1, 0, At, B0); PG8_BAR; PG8_SCHED;
            PG8_STAGE(PG8_SB(1, 1), b3 + hstep, voffB);
            PG8_WAIT_V(6); PG8_BAR; PG8_MMA(1, 1, At, B1); PG8_BAR;
            }
        }
        if constexpr (ALIGN_EPI) { if (wr == 0) PG8_BAR; }
        if constexpr (!Epi::AFTER_DRAIN) { E(acc, cur, wr, wc, fr, fq); S.done(cur); }
        if (!has_next) break;
#pragma unroll
        for (int a = 0; a < 2; ++a)
#pragma unroll
            for (int b = 0; b < 2; ++b)
#pragma unroll
                for (int m = 0; m < 4; ++m)
#pragma unroll
                    for (int n = 0; n < 2; ++n) acc[a][b][m][n] = (f32x4){0.f, 0.f, 0.f, 0.f};
        cur = nxt; cA = nA; cB = nB; ++ui;
        if constexpr (ALIGN_EPI) { if (wr == 1) PG8_BAR; }
    }
    PG8_WAIT_V(0);
    if constexpr (!ALIGN_EPI) { if (wr == 0) PG8_BAR; }
    PG8_BAR;
    if constexpr (Epi::AFTER_DRAIN) { E.fused(acc, cur, wr, wc, fr, fq, lds, wid, lane); S.done(cur); }
#undef PG8_SA
#undef PG8_SB
#undef PG8_STAGE
#undef PG8_LDA
#undef PG8_LDB
#undef PG8_MMA
#undef PG8_WAIT_V
#undef PG8_WAIT_L
#undef PG8_BAR
#undef PG8_SCHED
}
}

constexpr int NWAVES = 8;
constexpr int NB = 32, SEQ = 2048, DM = 1024, MROWS = NB * SEQ;
constexpr int NPROJ = 3840;
constexpr int C_ZA = 1536, C_QB = 2048, C_ZB = 2560, C_IQ = 3072, C_CKV = 3584, C_IK = 3712;
constexpr float EPSF = 1e-6f;
constexpr float LOG2E = 1.4426950408889634f;
__host__ __device__ __forceinline__ int proj_src_col(int n) {
    if (n < 2048) return n;
    if (n < 2560) return n - 2048 + 2056;
    if (n < 3072) return n - 2560 + 2696;
    if (n < 3584) return n - 3072 + 3208;
    if (n < 3712) return n - 3584 + 2568;
    if (n < 3776) return n - 3712 + 3720;
    if (n < 3784) return n - 3776 + 2048;
    if (n < 3792) return n;
    return -1;
}
__device__ const unsigned char T5_BUCKET[128] = {0,1,2,3,4,5,6,7,8,9,10,11,12,13,14,15,16,16,16,17,17,18,18,18,19,19,19,20,20,20,20,21,21,21,21,22,22,22,22,22,23,23,23,23,23,23,24,24,24,24,24,24,25,25,25,25,25,25,25,26,26,26,26,26,26,26,26,27,27,27,27,27,27,27,27,27,27,28,28,28,28,28,28,28,28,28,28,29,29,29,29,29,29,29,29,29,29,29,29,30,30,30,30,30,30,30,30,30,30,30,30,30,30,31,31,31,31,31,31,31,31,31,31,31,31,31,31,31};

constexpr size_t MiB = 1u << 20;
constexpr size_t WS_CTL = 0, CTL_ZERO_BYTES = 1 * MiB;
constexpr size_t WS_MOD = 1 * MiB;
constexpr size_t WS_WUV = 2 * MiB;
constexpr size_t WS_WOUT = 3 * MiB;
constexpr size_t WS_WIN = 5 * MiB;
constexpr size_t WS_KVSS = 13 * MiB;
constexpr size_t WS_AUX = 14 * MiB;
constexpr size_t WS_XN = 32 * MiB;
constexpr size_t WS_PROJ = 160 * MiB;
constexpr size_t WS_SCR = 640 * MiB;
constexpr size_t WS_END = 768 * MiB;
constexpr int CW_TMO = 0, CW_QUEUE = 64, CW_BAR = 4096;

constexpr int LDS_BYTES = 163840;
constexpr int MISC_OFF = LDS_BYTES - 256;
constexpr int SCRATCH_BYTES = MISC_OFF;

#define GAS __attribute__((address_space(1)))
#define LAS __attribute__((address_space(3)))
typedef unsigned short bf16;
typedef unsigned v4u __attribute__((ext_vector_type(4)));
typedef unsigned v2u __attribute__((ext_vector_type(2)));
typedef float f32x4 __attribute__((ext_vector_type(4)));
typedef float f32x16 __attribute__((ext_vector_type(16)));
typedef short bf16x8 __attribute__((ext_vector_type(8)));
typedef GAS unsigned gu32;
#define RLX_AGENT __ATOMIC_RELAXED, __HIP_MEMORY_SCOPE_AGENT
#define LDS_WAIT() asm volatile("s_waitcnt lgkmcnt(0)" ::: "memory")
#define MFMA32(a, b, c) __builtin_amdgcn_mfma_f32_32x32x16_bf16((a), (b), (c), 0, 0, 0)
#define MFMA16F(a, b, c) __builtin_amdgcn_mfma_f32_16x16x4f32((a), (b), (c), 0, 0, 0)
__device__ __forceinline__ unsigned f2bf(float f) { unsigned u = __builtin_bit_cast(unsigned, f); return (u + 0x7fffu + ((u >> 16) & 1u)) >> 16; }
__device__ __forceinline__ unsigned pk2(float lo, float hi) { return f2bf(lo) | (f2bf(hi) << 16); }
__device__ __forceinline__ float bf2f(unsigned short b) { return __builtin_bit_cast(float, ((unsigned)b) << 16); }
__device__ __forceinline__ float bflo(unsigned w) { return __builtin_bit_cast(float, w << 16); }
__device__ __forceinline__ float bfhi(unsigned w) { return __builtin_bit_cast(float, w & 0xffff0000u); }
__device__ __forceinline__ float rcpf_(float x) { return __builtin_amdgcn_rcpf(x); }
__device__ __forceinline__ float rsqf_(float x) { return __builtin_amdgcn_rsqf(x); }
__device__ __forceinline__ float siluf(float x) { return x * __builtin_amdgcn_rcpf(1.0f + __builtin_amdgcn_exp2f(-1.4426950408889634f * x)); }
__device__ __forceinline__ float wave_sum(float v) {
#pragma unroll
    for (int o = 1; o < 64; o <<= 1) v += __shfl_xor(v, o);
    return v;
}

__device__ __forceinline__ int wave_sum_i(int v) {
    v += __builtin_amdgcn_update_dpp(0, v, 0x111, 0xf, 0xf, false);
    v += __builtin_amdgcn_update_dpp(0, v, 0x112, 0xf, 0xf, false);
    v += __builtin_amdgcn_update_dpp(0, v, 0x114, 0xf, 0xe, false);
    v += __builtin_amdgcn_update_dpp(0, v, 0x118, 0xf, 0xc, false);
    v += __builtin_amdgcn_update_dpp(0, v, 0x142, 0xa, 0xf, false);
    v += __builtin_amdgcn_update_dpp(0, v, 0x143, 0xc, 0xf, false);
    return __builtin_amdgcn_readlane(v, 63);
}
__device__ __forceinline__ float wave_max(float v) {
    const int ninf = (int)0xff800000u;
#define WM_STEP(ctrl, rm, bm) v = fmaxf(v, __builtin_bit_cast(float, __builtin_amdgcn_update_dpp(ninf, __builtin_bit_cast(int, v), ctrl, rm, bm, false)))
    WM_STEP(0x111, 0xf, 0xf); WM_STEP(0x112, 0xf, 0xf); WM_STEP(0x114, 0xf, 0xe); WM_STEP(0x118, 0xf, 0xc); WM_STEP(0x142, 0xa, 0xf); WM_STEP(0x143, 0xc, 0xf);
#undef WM_STEP
    return __builtin_bit_cast(float, __builtin_amdgcn_readlane(__builtin_bit_cast(int, v), 63));
}
#define XB_TMO      128
#define XB_XCNT(j)  (256  + 64 * (j))
#define XB_XSUB(j)  (1280 + 64 * (j))
#define XB_XGEN(j)  (2304 + 64 * (j))
#define XB_TOP      3328
#define XB_TOPGEN   3392
#define XCD_BAR_WORDS 3456
#define XB_SPIN_CAP (1u << 18)

__device__ __forceinline__ unsigned xb_ld(unsigned* p)              { return __hip_atomic_load(p, __ATOMIC_RELAXED, __HIP_MEMORY_SCOPE_AGENT); }
__device__ __forceinline__ unsigned xb_add(unsigned* p, unsigned v) { return __hip_atomic_fetch_add(p, v, __ATOMIC_RELAXED, __HIP_MEMORY_SCOPE_AGENT); }
__device__ __forceinline__ unsigned xb_xcc_id() { return (unsigned)__builtin_amdgcn_s_getreg((3 << 11) | 20) & 0xFu; }
#define XB_SPIN(cond, bar) do { unsigned _sp = 0; while (cond) { __builtin_amdgcn_s_sleep(1); \
    if ((++_sp & 255u) == 0u) { if (xb_ld(&(bar)[XB_TMO])) break; if (_sp > XB_SPIN_CAP) { atomicAdd(&(bar)[XB_TMO], 1u); break; } } } } while (0)

struct XcdBarrier {
    unsigned* bar; unsigned x;
    volatile LAS unsigned* st;
};

__device__ __forceinline__ XcdBarrier xcd_barrier_post(unsigned* bar, volatile LAS unsigned* st) {
    XcdBarrier b; b.bar = bar; b.x = xb_xcc_id(); b.st = st;
    if (threadIdx.x == 0) (void)xb_add(&bar[XB_XCNT(b.x)], 1u);
    return b;
}
__device__ __forceinline__ void xcd_barrier_complete(unsigned* bar, unsigned x, unsigned& nloc, unsigned& nx) {
    const unsigned G = gridDim.x * gridDim.y * gridDim.z;
    unsigned sum, cnt, mine, sp = 0u;
    for (;;) {
        sum = 0u; cnt = 0u; mine = 0u;
#pragma unroll
        for (unsigned j = 0; j < 16; ++j) { const unsigned c = xb_ld(&bar[XB_XCNT(j)]); sum += c; cnt += (c > 0u) ? 1u : 0u; mine = (j == x) ? c : mine; }
        if (sum == G) break;
        __builtin_amdgcn_s_sleep(1);
        if ((++sp & 255u) == 0u) { if (xb_ld(&bar[XB_TMO])) break; if (sp > XB_SPIN_CAP) { atomicAdd(&bar[XB_TMO], 1u); break; } }
    }
    nloc = mine > 0u ? mine : 1u; nx = cnt > 0u ? cnt : 1u;
}

__device__ __forceinline__ void xcd_barrier(const XcdBarrier& b) {
    asm volatile("s_waitcnt vmcnt(0)" ::: "memory");
    __syncthreads();
    if (threadIdx.x == 0) {
        unsigned* bar = b.bar;
        __builtin_amdgcn_s_waitcnt(0);
        unsigned nloc = b.st[0], nx = b.st[1];
        if (nloc == 0u) { xcd_barrier_complete(bar, b.x, nloc, nx); b.st[0] = nloc; b.st[1] = nx; }
        const unsigned old = xb_add(&bar[XB_XSUB(b.x)], 1u);
        const unsigned gen = old / nloc;
        if (old + 1u == (gen + 1u) * nloc) {
            __builtin_amdgcn_fence(__ATOMIC_RELEASE, "agent");
            asm volatile("s_waitcnt vmcnt(0)" ::: "memory");
            const unsigned og = xb_add(&bar[XB_TOP], 1u);
            const unsigned tg = og / nx;
            if (og + 1u == (tg + 1u) * nx) xb_add(&bar[XB_TOPGEN], 1u);
            else XB_SPIN(xb_ld(&bar[XB_TOPGEN]) == tg, bar);
            __builtin_amdgcn_fence(__ATOMIC_ACQUIRE, "agent");
            xb_add(&bar[XB_XGEN(b.x)], 1u);
            asm volatile("s_waitcnt vmcnt(0)" ::: "memory");
        } else {
            XB_SPIN(xb_ld(&bar[XB_XGEN(b.x)]) == gen, bar);
            __builtin_amdgcn_fence(__ATOMIC_ACQUIRE, "agent");
            asm volatile("s_waitcnt vmcnt(0)" ::: "memory");
        }
    }
    __syncthreads();
}

struct Frame {
    LAS unsigned char* lds;
    volatile LAS unsigned* MISC;
    gu32* ctl;
    int tid, lane, wave;
    int vcu, G;
    unsigned char* ws;
};
#define P_X        (args.in[0])
#define P_C        (args.in[1])
#define P_WADA     (args.in[2])
#define P_BADA     (args.in[3])
#define P_GPRE     (args.in[4])
#define P_WIN      (args.in[5])
#define P_CONVW    (args.in[6])
#define P_ALOG     (args.in[7])
#define P_DTB      (args.in[8])
#define P_GGDN     (args.in[9])
#define P_GKV      (args.in[10])
#define P_WUV      (args.in[11])
#define P_RELB     (args.in[12])
#define P_WOUT     (args.in[13])
#define P_GPOST    (args.in[14])
#define P_OUT      (args.out)
#define W_MOD      ((float*)(F.ws + WS_MOD))
#define W_WUVT     ((bf16*)(F.ws + WS_WUV))
#define W_WOUTT    ((bf16*)(F.ws + WS_WOUT))
#define W_WINT     ((bf16*)(F.ws + WS_WIN))
#define W_KVSS     ((float*)(F.ws + WS_KVSS))
#define W_AUX      ((float*)(F.ws + WS_AUX))
#define W_XN       ((bf16*)(F.ws + WS_XN))
#define W_OAB      ((bf16*)(F.ws + WS_XN))
#define W_PROJ     ((bf16*)(F.ws + WS_PROJ))
#define W_MIX      ((float*)(F.ws + WS_PROJ))
#define W_SCR      ((float*)(F.ws + WS_SCR))
struct Args { const float* in[15]; float* out; unsigned char* ws; int ph_lo, ph_hi, li, pad; };

template <class CM>
__device__ __forceinline__ void transpose_item(const float* W, int ldw, bf16* WT, int K, int k0, int n0, LAS float* scr, int lane, CM cm) {
    const int nn = lane & 31, sc = cm(n0 + nn);
#pragma unroll 8
    for (int i = 0; i < 32; ++i) { const int kk = 2 * i + (lane >> 5); scr[kk * 33 + nn] = sc >= 0 ? W[(size_t)(k0 + kk) * ldw + sc] : 0.f; }
    LDS_WAIT(); asm volatile("" ::: "memory");
    const int c = lane & 7;
#pragma unroll
    for (int j = 0; j < 4; ++j) { const int n = (lane >> 3) + 8 * j; const LAS float* s = scr + (8 * c) * 33 + n;
        v4u o; o.x = pk2(s[0 * 33], s[1 * 33]); o.y = pk2(s[2 * 33], s[3 * 33]); o.z = pk2(s[4 * 33], s[5 * 33]); o.w = pk2(s[6 * 33], s[7 * 33]);
        *(GAS v4u*)(WT + (size_t)(n0 + n) * K + k0 + 8 * c) = o; }
    LDS_WAIT(); asm volatile("" ::: "memory");
}
struct CmIdent { __device__ __forceinline__ int operator()(int n) const { return n; } };
struct CmProj { __device__ __forceinline__ int operator()(int n) const { return proj_src_col(n); } };

__device__ __forceinline__ void p0_prologue(Frame& F, const Args& args) {
    LAS float* scr = (LAS float*)(F.lds + F.wave * 16384);
    const int gw = F.vcu * NWAVES + F.wave, NGW = F.G * NWAVES;
    constexpr int I_IN = 16 * (NPROJ / 32), I_OUT = 16 * 32, I_UV = 4 * 2 * 4;
    for (int it = gw; it < I_IN + I_OUT + I_UV; it += NGW) {
        int r = it;
        if (r < I_IN) { const int kb = r / (NPROJ / 32), nb = r % (NPROJ / 32); transpose_item(P_WIN, 3792, W_WINT, 1024, 64 * kb, 32 * nb, scr, F.lane, CmProj()); continue; }
        r -= I_IN;
        if (r < I_OUT) { const int kb = r / 32, nb = r % 32; transpose_item(P_WOUT, 1024, W_WOUTT, 1024, 64 * kb, 32 * nb, scr, F.lane, CmIdent()); continue; }
        r -= I_OUT;
        { const int hd = r >> 3, kb = (r >> 2) & 1, nb = r & 3; transpose_item(P_WUV + (size_t)hd * 16384, 128, W_WUVT + (size_t)hd * 16384, 128, 64 * kb, 32 * nb, scr, F.lane, CmIdent()); }
    }
    __syncthreads();
    if (F.vcu < 192) {
        LAS float* SC = (LAS float*)F.lds;
        for (int e = F.tid; e < NB * 1024; e += NWAVES * 64) { const int b = e >> 10, k = e & 1023; SC[k * 33 + b] = siluf(P_C[e]); }
        __syncthreads();
        const int col = F.tid & 15, ks = F.tid >> 4, n = F.vcu * 16 + col;
        float acc[32];
#pragma unroll
        for (int b = 0; b < 32; ++b) acc[b] = 0.f;
        for (int kk = 0; kk < 32; ++kk) { const int k = ks * 32 + kk; const float w = P_WADA[(size_t)k * 3072 + n];
#pragma unroll
            for (int b = 0; b < 32; ++b) acc[b] += SC[k * 33 + b] * w; }
        __syncthreads();
        LAS float* RED = (LAS float*)F.lds;
#pragma unroll
        for (int b = 0; b < 32; ++b) RED[(ks * 32 + b) * 16 + col] = acc[b];
        __syncthreads();
        { const int b = F.tid >> 4; float s = 0.f;
            for (int k2 = 0; k2 < 32; ++k2) s += RED[(k2 * 32 + b) * 16 + col];
            W_MOD[b * 3072 + n] = s + P_BADA[n]; }
        __syncthreads();
    }
}

__device__ __forceinline__ void p1_norm(Frame& F, const Args& args) {
    const int gw = F.vcu * NWAVES + F.wave, NGW = F.G * NWAVES;
    for (int m = gw; m < MROWS; m += NGW) {
        const int b = m >> 11;
        const GAS f32x4* xr = (const GAS f32x4*)(P_X + (size_t)m * DM) + F.lane;
        f32x4 v[4]; float ss = 0.f;
#pragma unroll
        for (int j = 0; j < 4; ++j) { v[j] = xr[64 * j]; ss += (v[j].x * v[j].x + v[j].y * v[j].y) + (v[j].z * v[j].z + v[j].w * v[j].w); }
        const float rstd = rsqf_(wave_sum(ss) * (1.0f / DM) + EPSF);
        const float* mb = W_MOD + b * 3072;
        GAS unsigned long long* o8 = (GAS unsigned long long*)(W_XN + (size_t)m * DM) + F.lane;
#pragma unroll
        for (int j = 0; j < 4; ++j) { const int col = F.lane * 4 + 256 * j;
            const f32x4 g = *(const f32x4*)(P_GPRE + col), sh = *(const f32x4*)(mb + col), sc = *(const f32x4*)(mb + 1024 + col);
            const f32x4 o = v[j] * rstd * g * (sc + 1.0f) + sh;
            o8[64 * j] = (unsigned long long)pk2(o.x, o.y) | ((unsigned long long)pk2(o.z, o.w) << 32); }
    }
}

__device__ __forceinline__ void p5_final(Frame& F, const Args& args) {
    const int gw = F.vcu * NWAVES + F.wave, NGW = F.G * NWAVES;
    for (int m = gw; m < MROWS; m += NGW) {
        const int b = m >> 11;
        const GAS f32x4* mr = (const GAS f32x4*)(W_MIX + (size_t)m * DM) + F.lane;
        const GAS f32x4* xr = (const GAS f32x4*)(P_X + (size_t)m * DM) + F.lane;
        GAS f32x4* orow = (GAS f32x4*)(P_OUT + (size_t)m * DM) + F.lane;
        f32x4 v[4]; float ss = 0.f;
#pragma unroll
        for (int j = 0; j < 4; ++j) { v[j] = mr[64 * j]; ss += (v[j].x * v[j].x + v[j].y * v[j].y) + (v[j].z * v[j].z + v[j].w * v[j].w); }
        const float rstd = rsqf_(wave_sum(ss) * (1.0f / DM) + EPSF);
        const float* gt = W_MOD + b * 3072 + 2048;
#pragma unroll
        for (int j = 0; j < 4; ++j) { const int col = F.lane * 4 + 256 * j;
            const f32x4 g = *(const f32x4*)(P_GPOST + col), ga = *(const f32x4*)(gt + col);
            orow[64 * j] = xr[64 * j] + ga * (v[j] * rstd * g); }
    }
}

__device__ __forceinline__ unsigned cvtpk(float lo, float hi) { return pg8::cvt_pk_bf16(lo, hi); }
__device__ __forceinline__ v2u pack4(float a, float b, float c, float d) { v2u r; r.x = cvtpk(a, b); r.y = cvtpk(c, d); return r; }
__device__ __forceinline__ bf16x8 pack8(float a, float b, float c, float d, float e, float f, float g, float h) { v4u r; r.x = cvtpk(a, b); r.y = cvtpk(c, d); r.z = cvtpk(e, f); r.w = cvtpk(g, h); return __builtin_bit_cast(bf16x8, r); }
__device__ __forceinline__ bf16x8 lds16(const LAS unsigned char* p) { return *(const LAS bf16x8*)p; }
__device__ __forceinline__ bf16x8 lds8x2(const LAS unsigned char* p) { const v2u lo = *(const LAS v2u*)p, hi = *(const LAS v2u*)(p + 16); v4u r; r.x = lo.x; r.y = lo.y; r.z = hi.x; r.w = hi.y; return __builtin_bit_cast(bf16x8, r); }
template <int S> __device__ __forceinline__ bf16x8 acc_frag(const f32x16& a) { return pack8(a[8 * S + 0], a[8 * S + 1], a[8 * S + 2], a[8 * S + 3], a[8 * S + 4], a[8 * S + 5], a[8 * S + 6], a[8 * S + 7]); }

__device__ __forceinline__ float row16_sum(float v) {
#define R16_STEP(ctrl) v += __builtin_bit_cast(float, __builtin_amdgcn_update_dpp(0, __builtin_bit_cast(int, v), ctrl, 0xf, 0xf, false))
    R16_STEP(0x121); R16_STEP(0x122); R16_STEP(0x124); R16_STEP(0x128);
#undef R16_STEP
    return v;
}

__device__ __forceinline__ void gdn_unit(Frame& F, const Args& args, const int b, const int h) {
    LAS unsigned char* const L = F.lds;
    const int tid = F.tid, lane = F.lane, wv = F.wave, l31_0 = lane & 31, hh_0 = lane >> 5;
    int tidv = tid, lanev = lane;
    constexpr int P128 = 272, P64 = 144;
    constexpr int O_KH = 0, O_QH = O_KH + 17408, O_KGT = O_QH + 17408, O_VBT = O_KGT + 18432, O_KBGT = O_VBT + 18432, O_LM = O_KBGT + 18432, O_T = O_LM + 17408,
                  O_AT = O_T + 17408, O_CW = O_AT + 9216, O_SM = O_CW + 6144, O_PSO = O_SM + 2560, O_OF = O_PSO + 2048, O_END = O_OF + 17408;
    static_assert(O_END <= SCRATCH_BYTES, "gdn LDS map");
    constexpr int O_W = O_LM, O_VNT = O_VBT;
    LAS float* const SMb = (LAS float*)(L + O_SM);
    LAS float* const LM = (LAS float*)(L + O_LM);
    LAS float* const TT = (LAS float*)(L + O_T);
    LAS float* const CW = (LAS float*)(L + O_CW);
    LAS float* const PSO = (LAS float*)(L + O_PSO);
    const int mt = wv >> 2, nt = wv & 3;
    f32x16 S[4];
#pragma unroll
    for (int k = 0; k < 4; ++k)
#pragma unroll
        for (int r = 0; r < 16; ++r) S[k][r] = 0.f;
    const float alog_e = __expf(P_ALOG[h]), dtb = P_DTB[h];
#define GDN_GATES(n_) do { LAS float* _sm = SMb + ((n_) & 1) * 320; const float* _ap = W_AUX + (size_t)(b * SEQ + (n_) * 64 + lanev) * 16; \
        const float _bb = _ap[h], _aa = _ap[4 + h]; const float _beta = rcpf_(1.0f + __expf(-_bb)); const float _xs = _aa + dtb; \
        const float _sp = _xs > 20.f ? _xs : log1pf(__expf(_xs)); float _gc = -alog_e * _sp; \
        _Pragma("unroll") for (int _o = 1; _o < 64; _o <<= 1) { const float _t = __shfl_up(_gc, _o); if (lanev >= _o) _gc += _t; } \
        const float _gl = __shfl(_gc, 63); _sm[lanev] = _gc; _sm[64 + lanev] = _beta; _sm[128 + lanev] = __expf(_gc); _sm[192 + lanev] = __expf(_gl - _gc); \
        if (lanev == 0) _sm[256] = __expf(_gl); } while (0)
    if (wv == 6) GDN_GATES(0);
    for (int e = tidv; e < 3 * 4 * 128; e += NWAVES * 64) { const int ts_ = e >> 9, tap = (e >> 7) & 3, ch = e & 127; CW[e] = P_CONVW[tap * 1536 + ts_ * 512 + h * 128 + ch]; }
    const int ts = tid >> 8;
    int cgv = tid & 15, tpv = (tid >> 4) & 15;
#define GDN_ROWS(dst_, n_, chan_) do { const bf16* _src = W_PROJ + (size_t)(b * SEQ + (n_) * 64 + 4 * tpv - 3) * NPROJ + (chan_); \
        _Pragma("unroll") for (int _i = 0; _i < 7; ++_i) { v4u _z; _z.x = 0u; _z.y = 0u; _z.z = 0u; _z.w = 0u; dst_[_i] = _z; \
            if ((n_) > 0 || 4 * tpv - 3 + _i >= 0) dst_[_i] = *(const GAS v4u*)(_src + (size_t)_i * NPROJ); } } while (0)
#define GDN_OUT(rowb_) do { const int _tok = tidv >> 3, _dv0 = (tidv & 7) * 16; const size_t _row = (size_t)(rowb_) + _tok; \
        const LAS v4u* _op = (const LAS v4u*)(L + O_OF + _tok * P128 + _dv0 * 2); const v4u _o0 = _op[0], _o1 = _op[1]; \
        const LAS f32x4* _pp = (const LAS f32x4*)(PSO + _tok * 8); const f32x4 _a = _pp[0], _c = _pp[1]; \
        const float _rstd = rsqf_((((_a.x + _a.y) + (_a.z + _a.w)) + ((_c.x + _c.y) + (_c.z + _c.w))) * (1.0f / 128.0f) + EPSF); \
        const bf16* _zp = W_PROJ + _row * NPROJ + C_ZA + h * 128 + _dv0; const v4u _z0 = *(const GAS v4u*)_zp, _z1 = *(const GAS v4u*)(_zp + 8); \
        const unsigned _ow[8] = {_o0.x, _o0.y, _o0.z, _o0.w, _o1.x, _o1.y, _o1.z, _o1.w}, _zw[8] = {_z0.x, _z0.y, _z0.z, _z0.w, _z1.x, _z1.y, _z1.z, _z1.w}; unsigned _rw[8]; \
        _Pragma("unroll") for (int _k = 0; _k < 4; ++_k) { const f32x4 _g = *(const f32x4*)(P_GGDN + _dv0 + 4 * _k); \
            _rw[2 * _k] = cvtpk(bflo(_ow[2 * _k]) * _rstd * _g.x * siluf(bflo(_zw[2 * _k])), bfhi(_ow[2 * _k]) * _rstd * _g.y * siluf(bfhi(_zw[2 * _k]))); \
            _rw[2 * _k + 1] = cvtpk(bflo(_ow[2 * _k + 1]) * _rstd * _g.z * siluf(bflo(_zw[2 * _k + 1])), bfhi(_ow[2 * _k + 1]) * _rstd * _g.w * siluf(bfhi(_zw[2 * _k + 1]))); } \
        bf16* _dst = W_OAB + _row * DM + h * 128 + _dv0; v4u _w0, _w1; _w0.x = _rw[0]; _w0.y = _rw[1]; _w0.z = _rw[2]; _w0.w = _rw[3]; _w1.x = _rw[4]; _w1.y = _rw[5]; _w1.z = _rw[6]; _w1.w = _rw[7]; \
        *(GAS v4u*)_dst = _w0; *(GAS v4u*)(_dst + 8) = _w1; } while (0)
    __syncthreads();

    unsigned pf_sink = 0u;
    for (int n = 0; n < 32; ++n) {
        const int rowbase = b * SEQ + n * 64;
        LAS float* const SMf = SMb + (n & 1) * 320;
        tidv = tid; lanev = lane; cgv = tid & 15; tpv = (tid >> 4) & 15;
        asm volatile("" : "+v"(tidv), "+v"(lanev), "+v"(cgv), "+v"(tpv));
        int l31 = lanev & 31, hh = lanev >> 5, cg = cgv, tp = tpv;
        if (wv == 6 && n + 1 < 32) GDN_GATES(n + 1);
        float val[4][8];
#define GDN_CONV(rows_, tsel_) do { \
            _Pragma("unroll") for (int _j = 0; _j < 4; ++_j) _Pragma("unroll") for (int _e = 0; _e < 8; ++_e) val[_j][_e] = 0.f; \
            _Pragma("unroll") for (int _tap = 0; _tap < 4; ++_tap) { const LAS f32x4* _cp = (const LAS f32x4*)(CW + ((tsel_) * 4 + _tap) * 128 + cg * 8); const f32x4 _c0 = _cp[0], _c1 = _cp[1]; \
                const float _cw[8] = {_c0.x, _c0.y, _c0.z, _c0.w, _c1.x, _c1.y, _c1.z, _c1.w}; \
                _Pragma("unroll") for (int _j = 0; _j < 4; ++_j) { const v4u _raw = rows_[_j + _tap]; \
                    const float _in[8] = {bflo(_raw.x), bfhi(_raw.x), bflo(_raw.y), bfhi(_raw.y), bflo(_raw.z), bfhi(_raw.z), bflo(_raw.w), bfhi(_raw.w)}; \
                    _Pragma("unroll") for (int _e = 0; _e < 8; ++_e) val[_j][_e] += _in[_e] * _cw[_e]; } } \
            _Pragma("unroll") for (int _j = 0; _j < 4; ++_j) _Pragma("unroll") for (int _e = 0; _e < 8; ++_e) val[_j][_e] = siluf(val[_j][_e]); } while (0)
        v4u rq[7], rv[7];
        GDN_ROWS(rq, n, ts * 512 + h * 128 + cgv * 8);
        if (wv < 4) GDN_ROWS(rv, n, 1024 + h * 128 + cgv * 8);
        if (n + 1 < 32) {
            const bf16* pq = W_PROJ + (size_t)(rowbase + 64 + 4 * tpv - 3) * NPROJ + ts * 512 + h * 128 + cgv * 8;
#pragma unroll
            for (int i = 0; i < 7; ++i) asm volatile("global_load_dword %0, %1, off" : "+v"(pf_sink) : "v"(pq + (size_t)i * NPROJ) : "memory");
            if (wv < 4) { const bf16* pv = W_PROJ + (size_t)(rowbase + 64 + 4 * tpv - 3) * NPROJ + 1024 + h * 128 + cgv * 8;
#pragma unroll
                for (int i = 0; i < 7; ++i) asm volatile("global_load_dword %0, %1, off" : "+v"(pf_sink) : "v"(pv + (size_t)i * NPROJ) : "memory"); }
            { const bf16* pz = W_PROJ + (size_t)(rowbase + (tidv >> 3)) * NPROJ + C_ZA + h * 128 + (tidv & 7) * 16;
                asm volatile("global_load_dword %0, %1, off" : "+v"(pf_sink) : "v"(pz) : "memory"); }
        }
        {
            GDN_CONV(rq, ts);
#pragma unroll
            for (int j = 0; j < 4; ++j) { float ss = 0.f;
#pragma unroll
                for (int e = 0; e < 8; ++e) ss += val[j][e] * val[j][e];
                ss = row16_sum(ss);
                float r = rsqf_(ss + EPSF); if (ts == 0) r *= 0.08838834764831845f;
#pragma unroll
                for (int e = 0; e < 8; ++e) val[j][e] *= r; }
            if (ts == 0) {
#pragma unroll
                for (int j = 0; j < 4; ++j) *(LAS bf16x8*)(L + O_QH + (4 * tp + j) * P128 + cg * 16) = pack8(val[j][0], val[j][1], val[j][2], val[j][3], val[j][4], val[j][5], val[j][6], val[j][7]);
            } else {
                float ek[4], bg[4];
#pragma unroll
                for (int j = 0; j < 4; ++j) { ek[j] = SMf[192 + 4 * tp + j]; bg[j] = SMf[64 + 4 * tp + j] * SMf[128 + 4 * tp + j]; }
#pragma unroll
                for (int j = 0; j < 4; ++j) *(LAS bf16x8*)(L + O_KH + (4 * tp + j) * P128 + cg * 16) = pack8(val[j][0], val[j][1], val[j][2], val[j][3], val[j][4], val[j][5], val[j][6], val[j][7]);
#pragma unroll
                for (int e = 0; e < 8; ++e) {
                    *(LAS v2u*)(L + O_KGT + (cg * 8 + e) * P64 + tp * 8) = pack4(val[0][e] * ek[0], val[1][e] * ek[1], val[2][e] * ek[2], val[3][e] * ek[3]);
                    *(LAS v2u*)(L + O_KBGT + (cg * 8 + e) * P64 + tp * 8) = pack4(val[0][e] * bg[0], val[1][e] * bg[1], val[2][e] * bg[2], val[3][e] * bg[3]); }
            }
        }
        if (n > 0) GDN_OUT(rowbase - 64);
        if (wv < 4) {
            GDN_CONV(rv, 2);
            float be[4];
#pragma unroll
            for (int j = 0; j < 4; ++j) be[j] = SMf[64 + 4 * tp + j];
#pragma unroll
            for (int e = 0; e < 8; ++e) *(LAS v2u*)(L + O_VBT + (cg * 8 + e) * P64 + tp * 8) = pack4(val[0][e] * be[0], val[1][e] * be[1], val[2][e] * be[2], val[3][e] * be[3]);
        }
        for (int e = tidv; e < 64 * 68; e += NWAVES * 64) TT[e] = 0.f;
        __syncthreads();
        if (wv < 4) {
            const int ti = wv >> 1, tj = wv & 1;
            f32x16 C;
#pragma unroll
            for (int r = 0; r < 16; ++r) C[r] = 0.f;
            if (ti >= tj) {
#pragma unroll
                for (int s = 0; s < 8; ++s) C = MFMA32(lds16(L + O_KH + (32 * ti + l31) * P128 + (16 * s + 8 * hh) * 2), lds16(L + O_KH + (32 * tj + l31) * P128 + (16 * s + 8 * hh) * 2), C);
            }
            const int j = 32 * tj + l31; const float gcj = SMf[j];
#pragma unroll
            for (int g = 0; g < 4; ++g) { const int ib = 32 * ti + 8 * g + 4 * hh; const f32x4 gci = *(const LAS f32x4*)(SMf + ib), bei = *(const LAS f32x4*)(SMf + 64 + ib);
#pragma unroll
                for (int e = 0; e < 4; ++e) { const int i = ib + e; LM[i * 68 + j] = (i > j) ? bei[e] * C[4 * g + e] * __expf(gci[e] - gcj) : 0.f; } }
        } else {
            const int w4 = wv - 4, tj = w4 >> 1, ti = w4 & 1;
            f32x16 C;
#pragma unroll
            for (int r = 0; r < 16; ++r) C[r] = 0.f;
            if (ti >= tj) {
#pragma unroll
                for (int s = 0; s < 8; ++s) C = MFMA32(lds16(L + O_KH + (32 * tj + l31) * P128 + (16 * s + 8 * hh) * 2), lds16(L + O_QH + (32 * ti + l31) * P128 + (16 * s + 8 * hh) * 2), C);
            }
            const int i = 32 * ti + l31; const float gci = SMf[i];
#pragma unroll
            for (int g = 0; g < 4; ++g) { const int jb = 32 * tj + 8 * g + 4 * hh; const f32x4 gcj = *(const LAS f32x4*)(SMf + jb); float v[4];
#pragma unroll
                for (int e = 0; e < 4; ++e) v[e] = (i >= jb + e) ? C[4 * g + e] * __expf(gci - gcj[e]) : 0.f;
                *(LAS v2u*)(L + O_AT + i * P64 + jb * 2) = pack4(v[0], v[1], v[2], v[3]); }
        }
        __syncthreads();
        if (wv < 2) {
            const int a = 2 * wv, bq = 2 * wv + 1;
            if (lanev < 32) {
                const int blk = a + (lanev >> 4), c = lanev & 15; float x[16];
#pragma unroll
                for (int i = 0; i < 16; ++i) { const LAS float* lr = LM + (16 * blk + i) * 68 + 16 * blk; float acc = (i == c) ? 1.f : 0.f;
#pragma unroll
                    for (int j = 0; j < i; ++j) acc -= lr[j] * x[j];
                    x[i] = acc; TT[(16 * blk + i) * 68 + 16 * blk + c] = acc; }
            }
            asm volatile("s_waitcnt lgkmcnt(0)" ::: "memory");
            const int m = lanev & 15, q = lanev >> 4;
            f32x4 P = {0.f, 0.f, 0.f, 0.f}, R = {0.f, 0.f, 0.f, 0.f};
#pragma unroll
            for (int s = 0; s < 4; ++s) { const int k = q + 4 * s; P = MFMA16F(LM[(16 * bq + m) * 68 + 16 * a + k], TT[(16 * a + k) * 68 + 16 * a + m], P); }
#pragma unroll
            for (int rg = 0; rg < 4; ++rg) { const int k = 4 * q + rg; R = MFMA16F(TT[(16 * bq + m) * 68 + 16 * bq + k], P[rg], R); }
#pragma unroll
            for (int rg = 0; rg < 4; ++rg) TT[(16 * bq + 4 * q + rg) * 68 + 16 * a + m] = -R[rg];
        }
        __syncthreads();
        if (wv < 4) {
            const int m = lanev & 15, q = lanev >> 4, mi = wv >> 1, ni = wv & 1;
            f32x4 P0 = {0.f, 0.f, 0.f, 0.f}, P1 = {0.f, 0.f, 0.f, 0.f}, R = {0.f, 0.f, 0.f, 0.f};
#pragma unroll
            for (int s = 0; s < 8; ++s) { const int k = q + 4 * s; const float bt = TT[k * 68 + 16 * ni + m];
                P0 = MFMA16F(LM[(32 + m) * 68 + k], bt, P0); P1 = MFMA16F(LM[(48 + m) * 68 + k], bt, P1); }
#pragma unroll
            for (int rg = 0; rg < 4; ++rg) { R = MFMA16F(TT[(32 + 16 * mi + m) * 68 + 32 + 4 * q + rg], P0[rg], R); R = MFMA16F(TT[(32 + 16 * mi + m) * 68 + 48 + 4 * q + rg], P1[rg], R); }
#pragma unroll
            for (int rg = 0; rg < 4; ++rg) TT[(32 + 16 * mi + 4 * q + rg) * 68 + 16 * ni + m] = -R[rg];
        }
        __syncthreads();
        f32x16 U, WT_;
#pragma unroll
        for (int r = 0; r < 16; ++r) { U[r] = 0.f; WT_[r] = 0.f; }
#pragma unroll
        for (int s = 0; s < 4; ++s) { const LAS f32x4* tp4 = (const LAS f32x4*)(TT + (32 * mt + l31) * 68 + 16 * s + 8 * hh); const f32x4 t0 = tp4[0], t1 = tp4[1];
            const bf16x8 a = pack8(t0.x, t0.y, t0.z, t0.w, t1.x, t1.y, t1.z, t1.w);
            U = MFMA32(a, lds16(L + O_VBT + (32 * nt + l31) * P64 + (16 * s + 8 * hh) * 2), U);
            WT_ = MFMA32(lds16(L + O_KBGT + (32 * nt + l31) * P64 + (16 * s + 8 * hh) * 2), a, WT_); }
#pragma unroll
        for (int g = 0; g < 4; ++g) *(LAS v2u*)(L + O_W + (32 * mt + l31) * P128 + (32 * nt + 8 * g + 4 * hh) * 2) = pack4(-WT_[4 * g], -WT_[4 * g + 1], -WT_[4 * g + 2], -WT_[4 * g + 3]);
        __syncthreads();
        bf16x8 sf[4][2];
#pragma unroll
        for (int kt = 0; kt < 4; ++kt) { sf[kt][0] = acc_frag<0>(S[kt]); sf[kt][1] = acc_frag<1>(S[kt]); }
#pragma unroll
        for (int kt = 0; kt < 4; ++kt)
#pragma unroll
            for (int s = 0; s < 2; ++s) U = MFMA32(lds8x2(L + O_W + (32 * mt + l31) * P128 + (32 * kt + 16 * s + 4 * hh) * 2), sf[kt][s], U);
#pragma unroll
        for (int g = 0; g < 4; ++g) *(LAS v2u*)(L + O_VNT + (32 * nt + l31) * P64 + (32 * mt + 8 * g + 4 * hh) * 2) = pack4(U[4 * g], U[4 * g + 1], U[4 * g + 2], U[4 * g + 3]);
        __syncthreads();
        {
            f32x16 Oa;
#pragma unroll
            for (int r = 0; r < 16; ++r) Oa[r] = 0.f;
#pragma unroll
            for (int kt = 0; kt < 4; ++kt)
#pragma unroll
                for (int s = 0; s < 2; ++s) Oa = MFMA32(lds8x2(L + O_QH + (32 * mt + l31) * P128 + (32 * kt + 16 * s + 4 * hh) * 2), sf[kt][s], Oa);
#pragma unroll
            for (int g = 0; g < 4; ++g) { const f32x4 e4 = *(const LAS f32x4*)(SMf + 128 + 32 * mt + 8 * g + 4 * hh);
#pragma unroll
                for (int e = 0; e < 4; ++e) Oa[4 * g + e] *= e4[e]; }
            bf16x8 vn[4];
#pragma unroll
            for (int s = 0; s < 4; ++s) vn[s] = lds16(L + O_VNT + (32 * nt + l31) * P64 + (16 * s + 8 * hh) * 2);
#pragma unroll
            for (int s = 0; s < 4; ++s) Oa = MFMA32(lds16(L + O_AT + (32 * mt + l31) * P64 + (16 * s + 8 * hh) * 2), vn[s], Oa);
            const float glast = SMf[256];
#pragma unroll
            for (int kt = 0; kt < 4; ++kt) {
#pragma unroll
                for (int r = 0; r < 16; ++r) S[kt][r] *= glast;
#pragma unroll
                for (int s = 0; s < 4; ++s) S[kt] = MFMA32(lds16(L + O_KGT + (32 * kt + l31) * P64 + (16 * s + 8 * hh) * 2), vn[s], S[kt]);
            }
#pragma unroll
            for (int r = 0; r < 16; ++r) { const float q2 = row16_sum(Oa[r] * Oa[r]);
                if ((lanev & 15) == 0) PSO[(32 * mt + 8 * (r >> 2) + 4 * hh + (r & 3)) * 8 + 2 * nt + ((lanev >> 4) & 1)] = q2;
                *(LAS unsigned short*)(L + O_OF + (32 * mt + 8 * (r >> 2) + 4 * hh + (r & 3)) * P128 + (32 * nt + l31) * 2) = (unsigned short)cvtpk(Oa[r], 0.f); }
        }
        asm volatile("s_waitcnt vmcnt(0)" : "+v"(pf_sink) :: "memory");
        __syncthreads();
    }
    GDN_OUT(b * SEQ + 31 * 64);
    __syncthreads();
#undef GDN_GATES
#undef GDN_CONV
#undef GDN_ROWS
#undef GDN_OUT
}

__device__ __forceinline__ void dsa_unit(Frame& F, const Args& args, const int b, const int qb) {
    LAS unsigned char* const L = F.lds;
    const int tid = F.tid, lane = F.lane, wv = F.wave, l31_0 = lane & 31, hh_0 = lane >> 5;
    int l31 = l31_0, hh = hh_0;
    constexpr int PK = 272, PV = 144;
    constexpr int O_K0 = 0, O_V0 = 17408, BUFSZ = 35840, O_MASK = 2 * BUFSZ, O_RS = O_MASK + 16384, O_BT = O_RS + 8192, O_END = O_BT + 2048, O_OA = 0;
    static_assert(O_END <= SCRATCH_BYTES && 4 * 17408 <= 2 * BUFSZ, "dsa LDS map");
    const int t0 = 64 * qb, nk = 64 * (qb + 1);
    const size_t rb = (size_t)b * SEQ;
    LAS unsigned* const MASK = (LAS unsigned*)(L + O_MASK);
    LAS float* const RS = (LAS float*)(L + O_RS);
    LAS float* const BT = (LAS float*)(L + O_BT);
    const float NINF = -__builtin_inff();
    for (int key = tid; key < nk; key += NWAVES * 64) { const f32x4 s4 = *(const f32x4*)(W_KVSS + (rb + key) * 4); RS[key] = rsqf_(((s4.x + s4.y) + (s4.z + s4.w)) * (1.0f / 128.0f) + EPSF); }
    BT[tid] = P_RELB[T5_BUCKET[tid >> 2] * 4 + (tid & 3)] * LOG2E;
    float* const scw = W_SCR + (size_t)(blockIdx.x * NWAVES + wv) * 8 * 2048;
#pragma unroll 1
    for (int rep_a = 0; rep_a < (PROBE_DUP == 41 ? 2 : 1); ++rep_a) {
        bf16x8 aq[2][4]; f32x4 wts[2][4];
#pragma unroll
        for (int rt = 0; rt < 2; ++rt) {
            const bf16* p = W_PROJ + (rb + t0 + 8 * wv + 4 * rt + (l31 >> 3)) * NPROJ + C_IQ + (l31 & 7) * 64 + 8 * hh;
#pragma unroll
            for (int s = 0; s < 4; ++s) aq[rt][s] = *(const GAS bf16x8*)(p + 16 * s);
#pragma unroll
            for (int g = 0; g < 4; ++g) wts[rt][g] = *(const f32x4*)(W_AUX + (rb + t0 + 8 * wv + 4 * rt + g) * 16 + 8 + 4 * hh) * 0.5f;
        }
        constexpr int O_IK = 0, IKB = 9216, PIK = 144;
        v4u sti;
#define IK_GLOAD(kt_) sti = *(const GAS v4u*)(W_PROJ + (rb + 64 * (kt_) + (tid >> 3)) * NPROJ + C_IK + (tid & 7) * 8)
#define IK_SWRITE(buf_) *(LAS v4u*)(L + O_IK + (buf_) * IKB + (tid >> 3) * PIK + (tid & 7) * 16) = sti
        IK_GLOAD(0); IK_SWRITE(0);
        __syncthreads();
#pragma unroll 1
        for (int kt6 = 0; kt6 <= qb; ++kt6) {
          const int ibuf = kt6 & 1;
          if (kt6 < qb) IK_GLOAD(kt6 + 1);
#pragma unroll
          for (int st = 0; st < 2; ++st) {
            bf16x8 bk[4];
#pragma unroll
            for (int s = 0; s < 4; ++s) bk[s] = lds16(L + O_IK + ibuf * IKB + (32 * st + l31) * PIK + (16 * s + 8 * hh) * 2);
            const int kt = 2 * kt6 + st;
            const int key = 32 * kt + l31;
            f32x16 C0, C1;
#pragma unroll
            for (int r = 0; r < 16; ++r) { C0[r] = 0.f; C1[r] = 0.f; }
#pragma unroll
            for (int s = 0; s < 4; ++s) C0 = MFMA32(aq[0][s], bk[s], C0);
#pragma unroll
            for (int s = 0; s < 4; ++s) C1 = MFMA32(aq[1][s], bk[s], C1);
            float pp[2][4];
#pragma unroll
            for (int g = 0; g < 4; ++g) {
                float p0 = 0.f, p1 = 0.f;
#pragma unroll
                for (int e2 = 0; e2 < 4; ++e2) { const float w0 = wts[0][g][e2], w1 = wts[1][g][e2], x0 = C0[4 * g + e2], x1 = C1[4 * g + e2];
                    p0 = __builtin_fmaf(w0, x0, p0); p0 = __builtin_fmaf(w0, __builtin_fabsf(x0), p0); p1 = __builtin_fmaf(w1, x1, p1); p1 = __builtin_fmaf(w1, __builtin_fabsf(x1), p1); }
                pp[0][g] = p0; pp[1][g] = p1;
            }
            float snd[2][2], rcv[2][2];
#pragma unroll
            for (int rt = 0; rt < 2; ++rt)
#pragma unroll
                for (int g2 = 0; g2 < 2; ++g2) snd[rt][g2] = hh ? pp[rt][g2] : pp[rt][g2 + 2];
#pragma unroll
            for (int rt = 0; rt < 2; ++rt)
#pragma unroll
                for (int g2 = 0; g2 < 2; ++g2) rcv[rt][g2] = __shfl_xor(snd[rt][g2], 32);
#pragma unroll
            for (int rt = 0; rt < 2; ++rt)
#pragma unroll
                for (int g2 = 0; g2 < 2; ++g2) { const int ql = 4 * rt + g2 + 2 * hh; float p = (hh ? pp[rt][g2 + 2] : pp[rt][g2]) + rcv[rt][g2];
                    if (key > t0 + 8 * wv + ql) p = NINF;
                    scw[ql * 2048 + key] = p; }
          }
          if (kt6 < qb) IK_SWRITE(ibuf ^ 1);
          __syncthreads();
        }
#undef IK_GLOAD
#undef IK_SWRITE
    }
    __builtin_amdgcn_fence(__ATOMIC_SEQ_CST, "workgroup");
    asm volatile("s_waitcnt vmcnt(0)" ::: "memory");
    const unsigned long long lt_mask = (1ull << lane) - 1ull;
    float xn[32];
#pragma unroll
    for (int i = 0; i < 32; ++i) xn[i] = __hip_atomic_load(scw + i * 64 + lane, __ATOMIC_RELAXED, __HIP_MEMORY_SCOPE_AGENT);
#pragma unroll 1
    for (int ql_ = 0; ql_ < (PROBE_DUP == 42 ? 16 : 8); ++ql_) {
        const int ql = ql_ & 7;
        const int tq = t0 + 8 * wv + ql;
        LAS unsigned* const mrow = MASK + (8 * wv + ql) * 64;
        float x[32];
#pragma unroll
        for (int i = 0; i < 32; ++i) x[i] = (i * 64 + lane < nk) ? xn[i] : NINF;
        if (ql_ + 1 < (PROBE_DUP == 42 ? 16 : 8)) {
#pragma unroll
            for (int i = 0; i < 32; ++i) xn[i] = __hip_atomic_load(scw + ((ql_ + 1) & 7) * 2048 + i * 64 + lane, __ATOMIC_RELAXED, __HIP_MEMORY_SCOPE_AGENT);
        }
        if (tq + 1 > 256) {
            float vmin = __builtin_inff(), vmax = NINF;
#pragma unroll
            for (int i = 0; i < 32; ++i) { vmax = fmaxf(vmax, x[i]); vmin = fminf(vmin, x[i] == NINF ? __builtin_inff() : x[i]); }
            vmin = -wave_max(-vmin); vmax = wave_max(vmax);
#define CNT_GE(p_, dst_) do { int _c0 = 0, _c1 = 0, _c2 = 0, _c3 = 0; \
                _Pragma("unroll") for (int _i = 0; _i < 32; _i += 4) { _c0 += (x[_i] >= (p_)) ? 1 : 0; _c1 += (x[_i + 1] >= (p_)) ? 1 : 0; _c2 += (x[_i + 2] >= (p_)) ? 1 : 0; _c3 += (x[_i + 3] >= (p_)) ? 1 : 0; } \
                dst_ = wave_sum_i((_c0 + _c1) + (_c2 + _c3)); } while (0)
            float lo = vmin, hi = vmax, thr; int chi; bool tie = false;
            CNT_GE(hi, chi);
            if (chi == 256) thr = hi;
            else if (chi > 256) { tie = true; lo = hi; chi = 0; hi = __builtin_inff(); }
            else {
#pragma unroll 1
                for (;;) {
                    const float mid = 0.5f * (lo + hi);
                    if (!(mid > lo && mid < hi)) { tie = true; break; }
                    int c; CNT_GE(mid, c);
                    if (c == 256) { thr = mid; break; }
                    if (c > 256) lo = mid; else { hi = mid; chi = c; }
                }
            }
#undef CNT_GE
            if (!tie) {
#pragma unroll
                for (int i = 0; i < 32; ++i) { const unsigned long long bs = __ballot(x[i] >= thr);
                    if (lane == 0) { v2u w; w.x = (unsigned)bs; w.y = (unsigned)(bs >> 32); *(LAS v2u*)(mrow + 2 * i) = w; } }
            } else {
                const int need = 256 - chi; int before = 0;
#pragma unroll
                for (int i = 0; i < 32; ++i) { const bool eq = (x[i] == lo); const unsigned long long be = __ballot(eq);
                    const int rank = before + __popcll(be & lt_mask); const bool sel = (x[i] >= hi) || (eq && rank < need); before += __popcll(be);
                    const unsigned long long bs = __ballot(sel);
                    if (lane == 0) { v2u w; w.x = (unsigned)bs; w.y = (unsigned)(bs >> 32); *(LAS v2u*)(mrow + 2 * i) = w; } }
            }
        } else {
#pragma unroll
            for (int i = 0; i < 32; ++i) { const unsigned long long bs = __ballot(i * 64 + lane <= tq);
                if (lane == 0) { v2u w; w.x = (unsigned)bs; w.y = (unsigned)(bs >> 32); *(LAS v2u*)(mrow + 2 * i) = w; } }
        }
    }
    __syncthreads();
    const int qj = l31 >> 2, hd = l31 & 3;
    const int tql = t0 + 8 * wv + qj;
    bf16x8 qf[8]; float qn2 = 0.f;
    {
        const bf16* p = W_PROJ + (rb + tql) * NPROJ + C_QB + hd * 128 + 8 * hh; const float cs = 0.08838834764831845f * LOG2E;
#pragma unroll
        for (int s = 0; s < 8; ++s) { const v4u raw = *(const GAS v4u*)(p + 16 * s); const f32x4 g0 = *(const f32x4*)(P_GKV + 16 * s + 8 * hh), g1 = *(const f32x4*)(P_GKV + 16 * s + 8 * hh + 4);
            v4u o; o.x = cvtpk(bflo(raw.x) * g0.x * cs, bfhi(raw.x) * g0.y * cs); o.y = cvtpk(bflo(raw.y) * g0.z * cs, bfhi(raw.y) * g0.w * cs);
            o.z = cvtpk(bflo(raw.z) * g1.x * cs, bfhi(raw.z) * g1.y * cs); o.w = cvtpk(bflo(raw.w) * g1.z * cs, bfhi(raw.w) * g1.w * cs);
            qn2 += (bflo(o.x) * bflo(o.x) + bfhi(o.x) * bfhi(o.x)) + (bflo(o.y) * bflo(o.y) + bfhi(o.y) * bfhi(o.y)) + (bflo(o.z) * bflo(o.z) + bfhi(o.z) * bfhi(o.z)) + (bflo(o.w) * bflo(o.w) + bfhi(o.w) * bfhi(o.w));
            qf[s] = __builtin_bit_cast(bf16x8, o); }
    }
    qn2 += __shfl_xor(qn2, 32);
    float mb = P_RELB[hd];
    for (int k = 1; k < 32; ++k) mb = fmaxf(mb, P_RELB[k * 4 + hd]);
    const float c0 = -(sqrtf(qn2) * 11.313708499f * 1.01f + mb * LOG2E + 1.0f);
    const float cfar = BT[127 * 4 + hd] + c0;
    f32x16 oacc[4];
#pragma unroll
    for (int d = 0; d < 4; ++d)
#pragma unroll
        for (int r = 0; r < 16; ++r) oacc[d][r] = 0.f;
    float lsum = 0.f;
    v4u st0, st1;
#define DSA_GLOAD(kt) do { const bf16* _p = W_PROJ + (rb + 64 * (kt) + lane) * NPROJ + C_CKV + wv * 16; st0 = *(const GAS v4u*)_p; st1 = *(const GAS v4u*)(_p + 8); } while (0)
#define DSA_SWRITE(buf, ktt) do { LAS unsigned char* _kb = L + (buf) * BUFSZ; const float _r = RS[64 * (ktt) + lane]; \
        v4u _n0, _n1; _n0.x = cvtpk(bflo(st0.x) * _r, bfhi(st0.x) * _r); _n0.y = cvtpk(bflo(st0.y) * _r, bfhi(st0.y) * _r); _n0.z = cvtpk(bflo(st0.z) * _r, bfhi(st0.z) * _r); _n0.w = cvtpk(bflo(st0.w) * _r, bfhi(st0.w) * _r); \
        _n1.x = cvtpk(bflo(st1.x) * _r, bfhi(st1.x) * _r); _n1.y = cvtpk(bflo(st1.y) * _r, bfhi(st1.y) * _r); _n1.z = cvtpk(bflo(st1.z) * _r, bfhi(st1.z) * _r); _n1.w = cvtpk(bflo(st1.w) * _r, bfhi(st1.w) * _r); \
        *(LAS v4u*)(_kb + O_K0 + lane * PK + wv * 32) = _n0; *(LAS v4u*)(_kb + O_K0 + lane * PK + wv * 32 + 16) = _n1; \
        LAS unsigned short* _vt = (LAS unsigned short*)(_kb + O_V0) + (wv * 16) * 72 + lane; \
        _vt[0 * 72] = (unsigned short)_n0.x; _vt[1 * 72] = (unsigned short)(_n0.x >> 16); _vt[2 * 72] = (unsigned short)_n0.y; _vt[3 * 72] = (unsigned short)(_n0.y >> 16); \
        _vt[4 * 72] = (unsigned short)_n0.z; _vt[5 * 72] = (unsigned short)(_n0.z >> 16); _vt[6 * 72] = (unsigned short)_n0.w; _vt[7 * 72] = (unsigned short)(_n0.w >> 16); \
        _vt[8 * 72] = (unsigned short)_n1.x; _vt[9 * 72] = (unsigned short)(_n1.x >> 16); _vt[10 * 72] = (unsigned short)_n1.y; _vt[11 * 72] = (unsigned short)(_n1.y >> 16); \
        _vt[12 * 72] = (unsigned short)_n1.z; _vt[13 * 72] = (unsigned short)(_n1.z >> 16); _vt[14 * 72] = (unsigned short)_n1.w; _vt[15 * 72] = (unsigned short)(_n1.w >> 16); } while (0)
    DSA_GLOAD(0); DSA_SWRITE(0, 0);
    __syncthreads();
    for (int kt = 0; kt <= qb; ++kt) {
        const int buf = kt & 1;
        l31 = l31_0; hh = hh_0; asm volatile("" : "+v"(l31), "+v"(hh));
        if (kt < qb) DSA_GLOAD(kt + 1);
        const LAS unsigned char* kb = L + buf * BUFSZ;
#pragma unroll 1
        for (int st = 0; st < 2; ++st) {
            f32x16 Sa;
#pragma unroll
            for (int r = 0; r < 16; ++r) Sa[r] = 0.f;
#pragma unroll
            for (int s = 0; s < 8; ++s) Sa = MFMA32(lds16(kb + O_K0 + (32 * st + l31) * PK + (16 * s + 8 * hh) * 2), qf[s], Sa);
            const int kbase = 64 * kt + 32 * st;
            const int mwi = (int)(MASK[(8 * wv + qj) * 64 + 2 * kt + st] >> (4 * hh));
            const bool far = (t0 + 8 * wv) - (kbase + 31) >= 113;
            float pn[16];
            if (far) {
#pragma unroll
                for (int r = 0; r < 16; ++r) { const float p = __builtin_bit_cast(float, __builtin_bit_cast(int, __builtin_amdgcn_exp2f(Sa[r] + cfar)) & __builtin_amdgcn_sbfe(mwi, 8 * (r >> 2) + (r & 3), 1));
                    lsum += p; pn[r] = p; }
            } else {
#pragma unroll
                for (int r = 0; r < 16; ++r) { int dist = tql - (kbase + 8 * (r >> 2) + 4 * hh + (r & 3)); dist = dist < 0 ? 0 : (dist > 127 ? 127 : dist);
                    const float p = __builtin_bit_cast(float, __builtin_bit_cast(int, __builtin_amdgcn_exp2f(Sa[r] + (BT[dist * 4 + hd] + c0))) & __builtin_amdgcn_sbfe(mwi, 8 * (r >> 2) + (r & 3), 1));
                    lsum += p; pn[r] = p; }
            }
            const bf16x8 pf0 = pack8(pn[0], pn[1], pn[2], pn[3], pn[4], pn[5], pn[6], pn[7]), pf1 = pack8(pn[8], pn[9], pn[10], pn[11], pn[12], pn[13], pn[14], pn[15]);
#pragma unroll
            for (int dt = 0; dt < 4; ++dt) { const LAS unsigned char* vp = kb + O_V0 + (32 * dt + l31) * PV + (32 * st + 4 * hh) * 2;
                oacc[dt] = MFMA32(lds8x2(vp), pf0, oacc[dt]); oacc[dt] = MFMA32(lds8x2(vp + 32), pf1, oacc[dt]); }
        }
        if (kt < qb) DSA_SWRITE(buf ^ 1, kt + 1);
        __syncthreads();
    }
#undef DSA_GLOAD
#undef DSA_SWRITE
    lsum += __shfl_xor(lsum, 32);
    {
        const float inv = rcpf_(lsum);
#pragma unroll
        for (int dt = 0; dt < 4; ++dt)
#pragma unroll
            for (int g = 0; g < 4; ++g) { const int d = 32 * dt + 8 * g + 4 * hh; const f32x4 gk = *(const f32x4*)(P_GKV + d);
                *(LAS v2u*)(L + O_OA + hd * 17408 + (8 * wv + qj) * PK + d * 2) = pack4(oacc[dt][4 * g] * inv * gk.x, oacc[dt][4 * g + 1] * inv * gk.y, oacc[dt][4 * g + 2] * inv * gk.z, oacc[dt][4 * g + 3] * inv * gk.w); }
    }
    __syncthreads();
#pragma unroll 1
    for (int x = 0; x < 4; ++x) {
        const int ti = wv * 4 + x, hd2 = ti >> 3, mt2 = (ti >> 2) & 1, et = ti & 3;
        f32x16 C;
#pragma unroll
        for (int r = 0; r < 16; ++r) C[r] = 0.f;
        const bf16* wp = W_WUVT + (size_t)hd2 * 16384 + (32 * et + l31) * 128 + 8 * hh;
#pragma unroll
        for (int s = 0; s < 8; ++s) C = MFMA32(lds16(L + O_OA + hd2 * 17408 + (32 * mt2 + l31) * PK + (16 * s + 8 * hh) * 2), *(const GAS bf16x8*)(wp + 16 * s), C);
        const int ecol = 32 * et + l31;
#pragma unroll
        for (int r = 0; r < 16; ++r) { const size_t row = rb + t0 + 32 * mt2 + 8 * (r >> 2) + 4 * hh + (r & 3);
            const float z = bf2f(W_PROJ[row * NPROJ + C_ZB + hd2 * 128 + ecol]);
            W_OAB[row * DM + 512 + hd2 * 128 + ecol] = (bf16)f2bf(C[r] * siluf(z)); }
    }
    __syncthreads();
}

constexpr int N_GDN = NB * 4, N_DSA = NB * 32, N_ITEMS = N_GDN + N_DSA;
constexpr int N_PHASES = 6;
__global__ void __launch_bounds__(NWAVES * 64, 2) hyb_fwd(Args args) {
    extern __shared__ __attribute__((aligned(16))) unsigned char lds[];
    Frame F;
    F.lds = (LAS unsigned char*)lds;
    F.MISC = (volatile LAS unsigned*)(F.lds + MISC_OFF);
    F.tid = threadIdx.x; F.lane = F.tid & 63; F.wave = __builtin_amdgcn_readfirstlane(F.tid >> 6);
    F.G = gridDim.x; { const int bx = blockIdx.x; F.vcu = (F.G % 8 == 0) ? (bx % 8) * (F.G / 8) + bx / 8 : bx; }
    unsigned char* ws = args.ws;
    F.ctl = (gu32*)(ws + WS_CTL);
    F.ws = ws;
    for (int u = F.tid; u < 64; u += NWAVES * 64) F.MISC[u] = 0u;
    __syncthreads();
    const int lo = args.ph_lo, hi = args.ph_hi;
    const bool multi = (hi - lo) > 1;
    XcdBarrier bar; bar.bar = (unsigned*)(F.ctl + CW_BAR) + args.li * XCD_BAR_WORDS; bar.x = 0; bar.st = nullptr;
    if (multi) bar = xcd_barrier_post((unsigned*)(F.ctl + CW_BAR) + args.li * XCD_BAR_WORDS, F.MISC + 8);
#define IN(k) (lo <= (k) && (k) < hi)
#define BOTH(k) (IN(k) && IN((k) + 1))
    if (IN(0)) { p0_prologue(F, args); if (PROBE_DUP == 7) { __syncthreads(); p0_prologue(F, args); } if (BOTH(0)) xcd_barrier(bar); }
    if (IN(1)) { p1_norm(F, args); if (PROBE_DUP == 1) p1_norm(F, args); if (BOTH(1)) xcd_barrier(bar); }
    if (IN(2)) {
        pg8::Gemm g{W_XN, W_WINT, MROWS, NPROJ, DM}; pg8::StaticOrder S; S.init(MROWS, NPROJ, F.G, (int)blockIdx.x);
        pg8::EpiProj E{W_PROJ, W_AUX, W_KVSS};
        pg8::gemm_phase<pg8::EpiProj, pg8::StaticOrder, true, true>(F.lds, g, S, E);
        if (PROBE_DUP == 2) pg8::gemm_phase<pg8::EpiProj, pg8::StaticOrder, true, true>(F.lds, g, S, E);
        if (BOTH(2)) xcd_barrier(bar);
    }
    if (IN(3)) {
#define NEXT_ITEM(dst, qw) do { if (F.tid == 0) F.MISC[4] = __hip_atomic_fetch_add(F.ctl + (qw), 1u, RLX_AGENT); __syncthreads(); dst = (int)F.MISC[4]; __syncthreads(); } while (0)
        int item; NEXT_ITEM(item, CW_QUEUE);
#pragma unroll 1
        for (int pass = 0; pass < (PROBE_DUP == 3 ? 2 : 1); ++pass) {
            if (pass) NEXT_ITEM(item, CW_QUEUE + 64);
            while (item < N_GDN) { gdn_unit(F, args, item >> 2, item & 3); NEXT_ITEM(item, CW_QUEUE + 64 * pass); }
        }
#pragma unroll 1
        for (int pass = 0; pass < (PROBE_DUP == 4 ? 2 : 1); ++pass) {
            if (pass) NEXT_ITEM(item, CW_QUEUE + 128);
            while (item < N_ITEMS) { if (item >= N_GDN) { const int idx = item - N_GDN; dsa_unit(F, args, idx & 31, 31 - (idx >> 5)); } NEXT_ITEM(item, pass ? CW_QUEUE + 128 : CW_QUEUE); }
        }
#undef NEXT_ITEM
        if (BOTH(3)) xcd_barrier(bar);
    }
    if (IN(4)) {
        pg8::Gemm g{W_OAB, W_WOUTT, MROWS, DM, DM}; pg8::StaticOrder S; S.init(MROWS, DM, F.G, (int)blockIdx.x);
        pg8::EpiF32 E{W_MIX, DM};
        pg8::gemm_phase<pg8::EpiF32, pg8::StaticOrder, true, true>(F.lds, g, S, E);
        if (PROBE_DUP == 5) pg8::gemm_phase<pg8::EpiF32, pg8::StaticOrder, true, true>(F.lds, g, S, E);
        if (BOTH(4)) xcd_barrier(bar);
    }
    if (IN(5)) { p5_final(F, args); if (PROBE_DUP == 6) p5_final(F, args); }
#undef IN
#undef BOTH
}

extern "C" void kernel_launch(void* const* d_in, const int* in_sizes, int n_in, void* d_out, int out_size, void* d_ws, size_t ws_size, hipStream_t stream) {
    static int grid = 0;
    if (grid == 0) {
        if (n_in != 15 || in_sizes[0] != MROWS * DM || out_size != MROWS * DM || ws_size < WS_END) { fprintf(stderr, "kernel_launch: unexpected shapes (n_in %d, in0 %d, out %d, ws %zu); nothing launched\n", n_in, n_in > 0 ? in_sizes[0] : -1, out_size, ws_size); grid = -1; return; }
        int dev = 0, cus = 0, per_cu = 0;
        if (hipGetDevice(&dev) != hipSuccess || hipDeviceGetAttribute(&cus, hipDeviceAttributeMultiprocessorCount, dev) != hipSuccess) { fprintf(stderr, "kernel_launch: device query failed\n"); grid = -1; return; }
        if (hipFuncSetAttribute((const void*)hyb_fwd, hipFuncAttributeMaxDynamicSharedMemorySize, LDS_BYTES) != hipSuccess) { fprintf(stderr, "kernel_launch: hipFuncSetAttribute failed\n"); grid = -1; return; }
        if (hipOccupancyMaxActiveBlocksPerMultiprocessor(&per_cu, (const void*)hyb_fwd, NWAVES * 64, LDS_BYTES) != hipSuccess || per_cu < 1)
            fprintf(stderr, "kernel_launch: note: occupancy query reports %d workgroups per CU\n", per_cu);
        (void)hipGetLastError();
        grid = cus;
    }
    if (grid < 0) return;
    if (hipMemsetAsync((char*)d_ws + WS_CTL, 0, CTL_ZERO_BYTES, stream) != hipSuccess) { fprintf(stderr, "kernel_launch: memset failed\n"); return; }
    Args a{};
    for (int i = 0; i < 15; ++i) a.in[i] = (const float*)d_in[i];
    a.out = (float*)d_out; a.ws = (unsigned char*)d_ws;
    constexpr int NL = MK_N_LAUNCHES;
    static_assert(NL == 1 || NL == 2 || NL == 3 || NL == N_PHASES, "MK_N_LAUNCHES");
    const int cuts1[2] = {0, 6}, cuts2[3] = {0, 3, 6}, cuts3[4] = {0, 3, 4, 6}, cuts6[7] = {0, 1, 2, 3, 4, 5, 6};
    const int* cuts = NL == 1 ? cuts1 : NL == 2 ? cuts2 : NL == 3 ? cuts3 : cuts6;
    for (int li = 0; li < NL; ++li) {
        a.ph_lo = cuts[li]; a.ph_hi = cuts[li + 1]; a.li = li;
        hipLaunchKernelGGL(hyb_fwd, dim3(grid), dim3(NWAVES * 64), LDS_BYTES, stream, a);
        const hipError_t le = hipPeekAtLastError();
        if (le != hipSuccess) { fprintf(stderr, "kernel_launch: launch %d failed: %s\n", li, hipGetErrorName(le)); break; }
    }
}
```

```cpp
#include <hip/hip_runtime.h>
#include <cstdio>
#include <cstdint>
#ifndef MK_N_LAUNCHES
#define MK_N_LAUNCHES 1
#endif
#ifndef PROBE_DUP
#define PROBE_DUP 0
#endif
namespace pg8 {
#define PG8_LAS __attribute__((address_space(3)))
typedef unsigned short bf16_t;
typedef short bf16x8 __attribute__((ext_vector_type(8)));
typedef float f32x4 __attribute__((ext_vector_type(4)));
typedef unsigned u32x4 __attribute__((ext_vector_type(4)));
constexpr int BM = 256, BK = 64, HALF = 128, HTB = HALF * BK * 2  , STAGE_BYTES = 8 * HTB, NXCD = 8, WGM = 8;

__host__ __device__ __forceinline__ int lds_byte(int r, int c) { const int st = (r >> 4) * 2 + (c >> 5), rr = r & 15, cc = c & 31, ob = rr * 64 + cc * 2; return st * 1024 + (ob ^ (((ob >> 9) & 1) << 5)); }
__host__ __device__ __forceinline__ void stage_rc(int b, int& R, int& C) { const int st = b / 1024, sb = b % 1024, swz = sb ^ (((sb >> 9) & 1) << 5); R = (st >> 1) * 16 + swz / 64; C = (st & 1) * 32 + (swz % 64) / 2; }
__host__ __device__ __forceinline__ int perm32(int rho) { const int n = rho >> 4, i = rho & 15; return 8 * (i >> 2) + 4 * n + (i & 3); }

struct Unit { int pm, pn; };
struct Gemm { const bf16_t* A; const bf16_t* Bt; int M, N, K; };

struct StaticOrder {
    int nM, nN, nwg, G, c;
    __host__ __device__ void init(int M, int N, int G_, int c_) { nM = M / BM; nN = N / BM; nwg = nM * nN; G = G_; c = c_; }
    __host__ __device__ bool next(int i, Unit& u) const {
        const long L = (long)i * G + c; if (L >= nwg) return false;
        int wgid = (int)L; { const int q = nwg / NXCD, r = nwg % NXCD, xcd = wgid % NXCD, off = wgid / NXCD; wgid = (xcd < r ? xcd * (q + 1) : r * (q + 1) + (xcd - r) * q) + off; }
        const int nig = WGM * nN, gid = wgid / nig, fm = gid * WGM, gsz = (nM - fm) < WGM ? (nM - fm) : WGM;
        u.pm = fm + ((wgid % nig) % gsz); u.pn = (wgid % nig) / gsz; return true;
    }
    __device__ __forceinline__ void a_ready(const Unit&) const {}
    __device__ __forceinline__ void done(const Unit&) const {}
};

typedef float f32x2c __attribute__((ext_vector_type(2))); typedef __bf16 b16x2c __attribute__((ext_vector_type(2)));
__device__ __forceinline__ unsigned cvt_pk_bf16(float lo, float hi) { const f32x2c v = {lo, hi}; return __builtin_bit_cast(unsigned, __builtin_convertvector(v, b16x2c)); }
struct EpiProj {
    static constexpr bool PERM = true, AFTER_DRAIN = false;
    bf16_t* O; float* aux; float* kvss;
    __device__ __forceinline__ void operator()(const f32x4 (&acc)[2][2][4][2], const Unit& u, int wr, int wc, int fr, int fq) const {
        const int row0 = u.pm * BM + wr * 64 + fr, col0 = u.pn * BM + wc * 32 + 8 * fq;
        const bool last = (u.pn == 14);
#pragma unroll
        for (int ai = 0; ai < 2; ++ai)
#pragma unroll
            for (int m = 0; m < 4; ++m) {
                const int row = row0 + ai * HALF + m * 16;
                bf16_t* rowp = O + (size_t)row * 3840 + col0;
#pragma unroll
                for (int bj = 0; bj < 2; ++bj) {
                    const f32x4 v0 = acc[ai][bj][m][0], v1 = acc[ai][bj][m][1];
                    u32x4 w; w.x = cvt_pk_bf16(v0[0], v0[1]); w.y = cvt_pk_bf16(v0[2], v0[3]); w.z = cvt_pk_bf16(v1[0], v1[1]); w.w = cvt_pk_bf16(v1[2], v1[3]);
                    *(u32x4*)(rowp + bj * HALF) = w;
                }
                if (last) {
                    const f32x4 a0 = acc[ai][0][m][0], a1 = acc[ai][0][m][1];
                    float ss = (a0[0] * a0[0] + a0[1] * a0[1]) + (a0[2] * a0[2] + a0[3] * a0[3]) + (a1[0] * a1[0] + a1[1] * a1[1]) + (a1[2] * a1[2] + a1[3] * a1[3]);
                    ss += __shfl_xor(ss, 16); ss += __shfl_xor(ss, 32);
                    if (fq == 0) kvss[(size_t)row * 4 + wc] = ss;
                    if (wc == 2 && fq < 2) { float* ap = aux + (size_t)row * 16 + 8 * fq; *(f32x4*)ap = acc[ai][1][m][0]; *(f32x4*)(ap + 4) = acc[ai][1][m][1]; }
                }
            }
    }
};
struct EpiF32 {
    static constexpr bool PERM = false, AFTER_DRAIN = false;
    float* C; int ldc;
    __device__ __forceinline__ void operator()(const f32x4 (&acc)[2][2][4][2], const Unit& u, int wr, int wc, int fr, int fq) const {
        const int row0 = u.pm * BM + wr * 64 + fr, col0 = u.pn * BM + wc * 32 + 4 * fq;
#pragma unroll
        for (int ai = 0; ai < 2; ++ai)
#pragma unroll
            for (int m = 0; m < 4; ++m) { float* rowp = C + (size_t)(row0 + ai * HALF + m * 16) * ldc + col0;
#pragma unroll
                for (int bj = 0; bj < 2; ++bj)
#pragma unroll
                    for (int n = 0; n < 2; ++n) *(f32x4*)(rowp + bj * HALF + n * 16) = acc[ai][bj][m][n]; }
    }
};
struct EpiMix {
    static constexpr bool PERM = true, AFTER_DRAIN = false;
    bf16_t* O; int ldc;
    __device__ __forceinline__ void operator()(const f32x4 (&acc)[2][2][4][2], const Unit& u, int wr, int wc, int fr, int fq) const {
        const int row0 = u.pm * BM + wr * 64 + fr, col0 = u.pn * BM + wc * 32 + 8 * fq;
#pragma unroll
        for (int ai = 0; ai < 2; ++ai)
#pragma unroll
            for (int m = 0; m < 4; ++m) { bf16_t* rowp = O + (size_t)(row0 + ai * HALF + m * 16) * ldc + col0;
#pragma unroll
                for (int bj = 0; bj < 2; ++bj) { const f32x4 v0 = acc[ai][bj][m][0], v1 = acc[ai][bj][m][1];
                    u32x4 w; w.x = cvt_pk_bf16(v0[0], v0[1]); w.y = cvt_pk_bf16(v0[2], v0[3]); w.z = cvt_pk_bf16(v1[0], v1[1]); w.w = cvt_pk_bf16(v1[2], v1[3]);
                    *(u32x4*)(rowp + bj * HALF) = w; } }
    }
};
template <class Epi, class Sched, bool ALIGN_EPI = false, bool SP2 = false>
__device__ __forceinline__ void gemm_phase(PG8_LAS unsigned char* lds, const Gemm g, const Sched& S, const Epi& E) {
    const int tid = threadIdx.x, wid = __builtin_amdgcn_readfirstlane(tid >> 6), lane = tid & 63, wr = wid >> 2, wc = wid & 3, fr = lane & 15, fq = lane >> 4;
    const int K = g.K, nt = K / BK;
    unsigned voffA[2], voffB[2];
#pragma unroll
    for (int i = 0; i < 2; ++i) { int R, C; stage_rc(tid * 16 + i * 8192, R, C); const int Rb = Epi::PERM ? ((R & ~31) + perm32(R & 31)) : R;
        voffA[i] = (unsigned)(R * K + C) * 2u; voffB[i] = (unsigned)(Rb * K + C) * 2u; }
    const size_t kstep = (size_t)(BK * 2);
    const size_t hstep = (size_t)HALF * K * 2;
    const size_t tstep = 2 * hstep;
    const unsigned ldsw = (unsigned)wid * 1024u;
    const int aoff = lds_byte(wr * 64 + fr, fq * 8), boff = lds_byte(wc * 32 + fr, fq * 8);
#define PG8_SA(b, h) (((b) * 2 + (h)) * HTB)
#define PG8_SB(b, h) ((4 + (b) * 2 + (h)) * HTB)
#define PG8_STAGE(bufoff, gbase, voff) do { _Pragma("unroll") for (int _i = 0; _i < 2; ++_i) \
        __builtin_amdgcn_global_load_lds((const unsigned*)((const char*)(gbase) + (voff)[_i]), (PG8_LAS unsigned*)(lds + (bufoff) + ldsw + _i * 8192), 16, 0, 0); } while (0)
#define PG8_LDA(dst, b, h) do { _Pragma("unroll") for (int m = 0; m < 4; ++m) _Pragma("unroll") for (int k = 0; k < 2; ++k) dst[m][k] = *(const PG8_LAS bf16x8*)(lds + PG8_SA(b, h) + aoff + m * 2048 + k * 1024); } while (0)
#define PG8_LDB(dst, b, h) do { _Pragma("unroll") for (int n = 0; n < 2; ++n) _Pragma("unroll") for (int k = 0; k < 2; ++k) dst[n][k] = *(const PG8_LAS bf16x8*)(lds + PG8_SB(b, h) + boff + n * 2048 + k * 1024); } while (0)
#define PG8_MMA(ai, bj, At, Bt) do { __builtin_amdgcn_s_setprio(1); _Pragma("unroll") for (int m = 0; m < 4; ++m) _Pragma("unroll") for (int n = 0; n < 2; ++n) _Pragma("unroll") for (int k = 0; k < 2; ++k) \
        acc[ai][bj][m][n] = __builtin_amdgcn_mfma_f32_16x16x32_bf16(Bt[n][k], At[m][k], acc[ai][bj][m][n], 0, 0, 0); __builtin_amdgcn_s_setprio(0); } while (0)
#define PG8_WAIT_V(n) asm volatile("s_waitcnt vmcnt(" #n ")" ::: "memory")
#define PG8_WAIT_L(n) asm volatile("s_waitcnt lgkmcnt(" #n ")" ::: "memory")
#define PG8_BAR __builtin_amdgcn_s_barrier()
#define PG8_SCHED __builtin_amdgcn_sched_barrier(0)
    Unit cur, nxt; int ui = 0;
    if (!S.next(0, cur)) return;
    f32x4 acc[2][2][4][2];
#pragma unroll
    for (int a = 0; a < 2; ++a)
#pragma unroll
        for (int b = 0; b < 2; ++b)
#pragma unroll
            for (int m = 0; m < 4; ++m)
#pragma unroll
                for (int n = 0; n < 2; ++n) acc[a][b][m][n] = (f32x4){0.f, 0.f, 0.f, 0.f};
    bf16x8 At[4][2], B0[2][2], B1[2][2];
    const char* cA = (const char*)g.A + (size_t)cur.pm * tstep; const char* cB = (const char*)g.Bt + (size_t)cur.pn * tstep;
    S.a_ready(cur);
    if constexpr (SP2) {
        PG8_STAGE(PG8_SB(0, 0), cB, voffB); PG8_STAGE(PG8_SB(0, 1), cB + hstep, voffB); PG8_STAGE(PG8_SA(0, 0), cA, voffA); PG8_STAGE(PG8_SA(0, 1), cA + hstep, voffA);
        if (wr == 1) PG8_BAR;
        PG8_WAIT_V(2); PG8_BAR;
        PG8_STAGE(PG8_SB(1, 0), cB + kstep, voffB); PG8_STAGE(PG8_SA(1, 0), cA + kstep, voffA); PG8_STAGE(PG8_SB(1, 1), cB + hstep + kstep, voffB);
        PG8_WAIT_V(6); PG8_BAR;
    } else {
        PG8_STAGE(PG8_SB(0, 0), cB, voffB); PG8_STAGE(PG8_SA(0, 0), cA, voffA); PG8_STAGE(PG8_SB(0, 1), cB + hstep, voffB); PG8_STAGE(PG8_SA(0, 1), cA + hstep, voffA);
        if (wr == 1) PG8_BAR;
        PG8_WAIT_V(4); PG8_BAR;
        PG8_STAGE(PG8_SB(1, 0), cB + kstep, voffB); PG8_STAGE(PG8_SA(1, 0), cA + kstep, voffA); PG8_STAGE(PG8_SB(1, 1), cB + hstep + kstep, voffB);
        PG8_WAIT_V(6); PG8_BAR;
    }
    for (;;) {
        const bool has_next = S.next(ui + 1, nxt);
        const char* nA = has_next ? (const char*)g.A + (size_t)nxt.pm * tstep : cA; const char* nB = has_next ? (const char*)g.Bt + (size_t)nxt.pn * tstep : cB;
        for (int t = 0; t < nt; t += 2) {
            const bool last = (t == nt - 2);
            const char* a1 = cA + (size_t)(t + 1) * kstep;
            const char* a2 = last ? nA : cA + (size_t)(t + 2) * kstep; const char* b2 = last ? nB : cB + (size_t)(t + 2) * kstep;
            const char* a3 = a2 + kstep; const char* b3 = b2 + kstep;
            if (last && has_next) S.a_ready(nxt);
            if constexpr (SP2) {
            PG8_LDB(B0, 0, 0); PG8_LDB(B1, 0, 1); PG8_SCHED; PG8_LDA(At, 0, 0); PG8_STAGE(PG8_SA(1, 1), a1 + hstep, voffA);
            PG8_WAIT_V(8); PG8_WAIT_L(0); PG8_BAR; PG8_MMA(0, 0, At, B0); PG8_MMA(0, 1, At, B1); PG8_BAR; PG8_SCHED;
            PG8_LDA(At, 0, 1); PG8_STAGE(PG8_SB(0, 0), b2, voffB); PG8_STAGE(PG8_SB(0, 1), b2 + hstep, voffB); PG8_STAGE(PG8_SA(0, 0), a2, voffA);
            PG8_WAIT_V(8); PG8_WAIT_L(0); PG8_BAR; PG8_MMA(1, 0, At, B0); PG8_MMA(1, 1, At, B1); PG8_BAR; PG8_SCHED;
            PG8_LDB(B0, 1, 0); PG8_LDB(B1, 1, 1); PG8_SCHED; PG8_LDA(At, 1, 0); PG8_STAGE(PG8_SA(0, 1), a2 + hstep, voffA);
            PG8_WAIT_V(8); PG8_WAIT_L(0); PG8_BAR; PG8_MMA(0, 0, At, B0); PG8_MMA(0, 1, At, B1); PG8_BAR; PG8_SCHED;
            PG8_LDA(At, 1, 1); PG8_STAGE(PG8_SB(1, 0), b3, voffB); PG8_STAGE(PG8_SB(1, 1), b3 + hstep, voffB); PG8_STAGE(PG8_SA(1, 0), a3, voffA);
            PG8_WAIT_V(8); PG8_WAIT_L(0); PG8_BAR; PG8_MMA(1, 0, At, B0); PG8_MMA(1, 1, At, B1); PG8_BAR; PG8_SCHED;
            } else {
            PG8_LDB(B0, 0, 0); PG8_SCHED; PG8_LDA(At, 0, 0); PG8_STAGE(PG8_SA(1, 1), a1 + hstep, voffA);
            PG8_WAIT_L(8); PG8_BAR; PG8_WAIT_L(0); PG8_MMA(0, 0, At, B0); PG8_BAR; PG8_SCHED;
            PG8_LDB(B1, 0, 1); PG8_STAGE(PG8_SB(0, 0), b2, voffB);
            PG8_BAR; PG8_WAIT_L(0); PG8_MMA(0, 1, At, B1); PG8_BAR;
            PG8_LDA(At, 0, 1); PG8_STAGE(PG8_SA(0, 0), a2, voffA);
            PG8_BAR; PG8_WAIT_L(0); PG8_MMA(1, 0, At, B0); PG8_BAR; PG8_SCHED;
            PG8_STAGE(PG8_SB(0, 1), b2 + hstep, voffB);
            PG8_WAIT_V(6); PG8_BAR; PG8_MMA(1, 1, At, B1); PG8_BAR;
            PG8_LDB(B0, 1, 0); PG8_SCHED; PG8_LDA(At, 1, 0); PG8_STAGE(PG8_SA(0, 1), a2 + hstep, voffA);
            PG8_WAIT_L(8); PG8_BAR; PG8_WAIT_L(0); PG8_MMA(0, 0, At, B0); PG8_BAR; PG8_SCHED;
            PG8_LDB(B1, 1, 1); PG8_STAGE(PG8_SB(1, 0), b3, voffB);
            PG8_BAR; PG8_WAIT_L(0); PG8_MMA(0, 1, At, B1); PG8_BAR;
            PG8_LDA(At, 1, 1); PG8_STAGE(PG8_SA(1, 0), a3, voffA);
            PG8_BAR; PG8_WAIT_L(0); PG8_MMA(1, 0, At, B0); PG8_BAR; PG8_SCHED;
            PG8_STAGE(PG8_SB(1, 1), b3 + hstep, voffB);
            PG8_WAIT_V(6); PG8_BAR; PG8_MMA(1, 1, At, B1); PG8_BAR;
            }
        }
        if constexpr (ALIGN_EPI) { if (wr == 0) PG8_BAR; }
        if constexpr (!Epi::AFTER_DRAIN) { E(acc, cur, wr, wc, fr, fq); S.done(cur); }
        if (!has_next) break;
#pragma unroll
        for (int a = 0; a < 2; ++a)
#pragma unroll
            for (int b = 0; b < 2; ++b)
#pragma unroll
                for (int m = 0; m < 4; ++m)
#pragma unroll
                    for (int n = 0; n < 2; ++n) acc[a][b][m][n] = (f32x4){0.f, 0.f, 0.f, 0.f};
        cur = nxt; cA = nA; cB = nB; ++ui;
        if constexpr (ALIGN_EPI) { if (wr == 1) PG8_BAR; }
    }
    PG8_WAIT_V(0);
    if constexpr (!ALIGN_EPI) { if (wr == 0) PG8_BAR; }
    PG8_BAR;
    if constexpr (Epi::AFTER_DRAIN) { E.fused(acc, cur, wr, wc, fr, fq, lds, wid, lane); S.done(cur); }
#undef PG8_SA
#undef PG8_SB
#undef PG8_STAGE
#undef PG8_LDA
#undef PG8_LDB
#undef PG8_MMA
#undef PG8_WAIT_V
#undef PG8_WAIT_L
#undef PG8_BAR
#undef PG8_SCHED
}
}

constexpr int NWAVES = 8;
constexpr int NB = 32, SEQ = 2048, DM = 1024, MROWS = NB * SEQ;
constexpr int NPROJ = 3840;
constexpr int C_ZA = 1536, C_QB = 2048, C_ZB = 2560, C_IQ = 3072, C_CKV = 3584, C_IK = 3712;
constexpr float EPSF = 1e-6f;
constexpr float LOG2E = 1.4426950408889634f;
__host__ __device__ __forceinline__ int proj_src_col(int n) {
    if (n < 2048) return n;
    if (n < 2560) return n - 2048 + 2056;
    if (n < 3072) return n - 2560 + 2696;
    if (n < 3584) return n - 3072 + 3208;
    if (n < 3712) return n - 3584 + 2568;
    if (n < 3776) return n - 3712 + 3720;
    if (n < 3784) return n - 3776 + 2048;
    if (n < 3792) return n;
    return -1;
}
__device__ const unsigned char T5_BUCKET[128] = {0,1,2,3,4,5,6,7,8,9,10,11,12,13,14,15,16,16,16,17,17,18,18,18,19,19,19,20,20,20,20,21,21,21,21,22,22,22,22,22,23,23,23,23,23,23,24,24,24,24,24,24,25,25,25,25,25,25,25,26,26,26,26,26,26,26,26,27,27,27,27,27,27,27,27,27,27,28,28,28,28,28,28,28,28,28,28,29,29,29,29,29,29,29,29,29,29,29,29,30,30,30,30,30,30,30,30,30,30,30,30,30,30,31,31,31,31,31,31,31,31,31,31,31,31,31,31,31};

constexpr size_t MiB = 1u << 20;
constexpr size_t WS_CTL = 0, CTL_ZERO_BYTES = 1 * MiB;
constexpr size_t WS_MOD = 1 * MiB;
constexpr size_t WS_WUV = 2 * MiB;
constexpr size_t WS_WOUT = 3 * MiB;
constexpr size_t WS_WIN = 5 * MiB;
constexpr size_t WS_KVSS = 13 * MiB;
constexpr size_t WS_AUX = 14 * MiB;
constexpr size_t WS_XN = 32 * MiB;
constexpr size_t WS_PROJ = 160 * MiB;
constexpr size_t WS_SCR = 640 * MiB;
constexpr size_t WS_END = 768 * MiB;
constexpr int CW_TMO = 0, CW_QUEUE = 64, CW_BAR = 4096;

constexpr int LDS_BYTES = 163840;
constexpr int MISC_OFF = LDS_BYTES - 256;
constexpr int SCRATCH_BYTES = MISC_OFF;

#define GAS __attribute__((address_space(1)))
#define LAS __attribute__((address_space(3)))
typedef unsigned short bf16;
typedef unsigned v4u __attribute__((ext_vector_type(4)));
typedef unsigned v2u __attribute__((ext_vector_type(2)));
typedef float f32x4 __attribute__((ext_vector_type(4)));
typedef float f32x16 __attribute__((ext_vector_type(16)));
typedef short bf16x8 __attribute__((ext_vector_type(8)));
typedef GAS unsigned gu32;
#define RLX_AGENT __ATOMIC_RELAXED, __HIP_MEMORY_SCOPE_AGENT
#define LDS_WAIT() asm volatile("s_waitcnt lgkmcnt(0)" ::: "memory")
#define MFMA32(a, b, c) __builtin_amdgcn_mfma_f32_32x32x16_bf16((a), (b), (c), 0, 0, 0)
#define MFMA16F(a, b, c) __builtin_amdgcn_mfma_f32_16x16x4f32((a), (b), (c), 0, 0, 0)
__device__ __forceinline__ unsigned f2bf(float f) { unsigned u = __builtin_bit_cast(unsigned, f); return (u + 0x7fffu + ((u >> 16) & 1u)) >> 16; }
__device__ __forceinline__ unsigned pk2(float lo, float hi) { return f2bf(lo) | (f2bf(hi) << 16); }
__device__ __forceinline__ float bf2f(unsigned short b) { return __builtin_bit_cast(float, ((unsigned)b) << 16); }
__device__ __forceinline__ float bflo(unsigned w) { return __builtin_bit_cast(float, w << 16); }
__device__ __forceinline__ float bfhi(unsigned w) { return __builtin_bit_cast(float, w & 0xffff0000u); }
__device__ __forceinline__ float rcpf_(float x) { return __builtin_amdgcn_rcpf(x); }
__device__ __forceinline__ float rsqf_(float x) { return __builtin_amdgcn_rsqf(x); }
__device__ __forceinline__ float siluf(float x) { return x * __builtin_amdgcn_rcpf(1.0f + __builtin_amdgcn_exp2f(-1.4426950408889634f * x)); }
__device__ __forceinline__ float wave_sum(float v) {
#pragma unroll
    for (int o = 1; o < 64; o <<= 1) v += __shfl_xor(v, o);
    return v;
}

__device__ __forceinline__ int wave_sum_i(int v) {
    v += __builtin_amdgcn_update_dpp(0, v, 0x111, 0xf, 0xf, false);
    v += __builtin_amdgcn_update_dpp(0, v, 0x112, 0xf, 0xf, false);
    v += __builtin_amdgcn_update_dpp(0, v, 0x114, 0xf, 0xe, false);
    v += __builtin_amdgcn_update_dpp(0, v, 0x118, 0xf, 0xc, false);
    v += __builtin_amdgcn_update_dpp(0, v, 0x142, 0xa, 0xf, false);
    v += __builtin_amdgcn_update_dpp(0, v, 0x143, 0xc, 0xf, false);
    return __builtin_amdgcn_readlane(v, 63);
}
__device__ __forceinline__ float wave_max(float v) {
    const int ninf = (int)0xff800000u;
#define WM_STEP(ctrl, rm, bm) v = fmaxf(v, __builtin_bit_cast(float, __builtin_amdgcn_update_dpp(ninf, __builtin_bit_cast(int, v), ctrl, rm, bm, false)))
    WM_STEP(0x111, 0xf, 0xf); WM_STEP(0x112, 0xf, 0xf); WM_STEP(0x114, 0xf, 0xe); WM_STEP(0x118, 0xf, 0xc); WM_STEP(0x142, 0xa, 0xf); WM_STEP(0x143, 0xc, 0xf);
#undef WM_STEP
    return __builtin_bit_cast(float, __builtin_amdgcn_readlane(__builtin_bit_cast(int, v), 63));
}
#define XB_TMO      128
#define XB_XCNT(j)  (256  + 64 * (j))
#define XB_XSUB(j)  (1280 + 64 * (j))
#define XB_XGEN(j)  (2304 + 64 * (j))
#define XB_TOP      3328
#define XB_TOPGEN   3392
#define XCD_BAR_WORDS 3456
#define XB_SPIN_CAP (1u << 18)

__device__ __forceinline__ unsigned xb_ld(unsigned* p)              { return __hip_atomic_load(p, __ATOMIC_RELAXED, __HIP_MEMORY_SCOPE_AGENT); }
__device__ __forceinline__ unsigned xb_add(unsigned* p, unsigned v) { return __hip_atomic_fetch_add(p, v, __ATOMIC_RELAXED, __HIP_MEMORY_SCOPE_AGENT); }
__device__ __forceinline__ unsigned xb_xcc_id() { return (unsigned)__builtin_amdgcn_s_getreg((3 << 11) | 20) & 0xFu; }
#define XB_SPIN(cond, bar) do { unsigned _sp = 0; while (cond) { __builtin_amdgcn_s_sleep(1); \
    if ((++_sp & 255u) == 0u) { if (xb_ld(&(bar)[XB_TMO])) break; if (_sp > XB_SPIN_CAP) { atomicAdd(&(bar)[XB_TMO], 1u); break; } } } } while (0)

struct XcdBarrier {
    unsigned* bar; unsigned x;
    volatile LAS unsigned* st;
};

__device__ __forceinline__ XcdBarrier xcd_barrier_post(unsigned* bar, volatile LAS unsigned* st) {
    XcdBarrier b; b.bar = bar; b.x = xb_xcc_id(); b.st = st;
    if (threadIdx.x == 0) (void)xb_add(&bar[XB_XCNT(b.x)], 1u);
    return b;
}
__device__ __forceinline__ void xcd_barrier_complete(unsigned* bar, unsigned x, unsigned& nloc, unsigned& nx) {
    const unsigned G = gridDim.x * gridDim.y * gridDim.z;
    unsigned sum, cnt, mine, sp = 0u;
    for (;;) {
        sum = 0u; cnt = 0u; mine = 0u;
#pragma unroll
        for (unsigned j = 0; j < 16; ++j) { const unsigned c = xb_ld(&bar[XB_XCNT(j)]); sum += c; cnt += (c > 0u) ? 1u : 0u; mine = (j == x) ? c : mine; }
        if (sum == G) break;
        __builtin_amdgcn_s_sleep(1);
        if ((++sp & 255u) == 0u) { if (xb_ld(&bar[XB_TMO])) break; if (sp > XB_SPIN_CAP) { atomicAdd(&bar[XB_TMO], 1u); break; } }
    }
    nloc = mine > 0u ? mine : 1u; nx = cnt > 0u ? cnt : 1u;
}

__device__ __forceinline__ void xcd_barrier(const XcdBarrier& b) {
    asm volatile("s_waitcnt vmcnt(0)" ::: "memory");
    __syncthreads();
    if (threadIdx.x == 0) {
        unsigned* bar = b.bar;
        __builtin_amdgcn_s_waitcnt(0);
        unsigned nloc = b.st[0], nx = b.st[1];
        if (nloc == 0u) { xcd_barrier_complete(bar, b.x, nloc, nx); b.st[0] = nloc; b.st[1] = nx; }
        const unsigned old = xb_add(&bar[XB_XSUB(b.x)], 1u);
        const unsigned gen = old / nloc;
        if (old + 1u == (gen + 1u) * nloc) {
            __builtin_amdgcn_fence(__ATOMIC_RELEASE, "agent");
            asm volatile("s_waitcnt vmcnt(0)" ::: "memory");
            const unsigned og = xb_add(&bar[XB_TOP], 1u);
            const unsigned tg = og / nx;
            if (og + 1u == (tg + 1u) * nx) xb_add(&bar[XB_TOPGEN], 1u);
            else XB_SPIN(xb_ld(&bar[XB_TOPGEN]) == tg, bar);
            __builtin_amdgcn_fence(__ATOMIC_ACQUIRE, "agent");
            xb_add(&bar[XB_XGEN(b.x)], 1u);
            asm volatile("s_waitcnt vmcnt(0)" ::: "memory");
        } else {
            XB_SPIN(xb_ld(&bar[XB_XGEN(b.x)]) == gen, bar);
            __builtin_amdgcn_fence(__ATOMIC_ACQUIRE, "agent");
            asm volatile("s_waitcnt vmcnt(0)" ::: "memory");
        }
    }
    __syncthreads();
}

struct Frame {
    LAS unsigned char* lds;
    volatile LAS unsigned* MISC;
    gu32* ctl;
    int tid, lane, wave;
    int vcu, G;
    unsigned char* ws;
};
#define P_X        (args.in[0])
#define P_C        (args.in[1])
#define P_WADA     (args.in[2])
#define P_BADA     (args.in[3])
#define P_GPRE     (args.in[4])
#define P_WIN      (args.in[5])
#define P_CONVW    (args.in[6])
#define P_ALOG     (args.in[7])
#define P_DTB      (args.in[8])
#define P_GGDN     (args.in[9])
#define P_GKV      (args.in[10])
#define P_WUV      (args.in[11])
#define P_RELB     (args.in[12])
#define P_WOUT     (args.in[13])
#define P_GPOST    (args.in[14])
#define P_OUT      (args.out)
#define W_MOD      ((float*)(F.ws + WS_MOD))
#define W_WUVT     ((bf16*)(F.ws + WS_WUV))
#define W_WOUTT    ((bf16*)(F.ws + WS_WOUT))
#define W_WINT     ((bf16*)(F.ws + WS_WIN))
#define W_KVSS     ((float*)(F.ws + WS_KVSS))
#define W_AUX      ((float*)(F.ws + WS_AUX))
#define W_XN       ((bf16*)(F.ws + WS_XN))
#define W_OAB      ((bf16*)(F.ws + WS_XN))
#define W_PROJ     ((bf16*)(F.ws + WS_PROJ))
#define W_MIX      ((bf16*)(F.ws + WS_PROJ))
#define W_SCR      ((float*)(F.ws + WS_SCR))
struct Args { const float* in[15]; float* out; unsigned char* ws; int ph_lo, ph_hi, li, pad; };

template <class CM>
__device__ __forceinline__ void transpose_item(const float* W, int ldw, bf16* WT, int K, int k0, int n0, LAS float* scr, int lane, CM cm) {
    const int nn = lane & 31, sc = cm(n0 + nn);
#pragma unroll 8
    for (int i = 0; i < 32; ++i) { const int kk = 2 * i + (lane >> 5); scr[kk * 33 + nn] = sc >= 0 ? W[(size_t)(k0 + kk) * ldw + sc] : 0.f; }
    LDS_WAIT(); asm volatile("" ::: "memory");
    const int c = lane & 7;
#pragma unroll
    for (int j = 0; j < 4; ++j) { const int n = (lane >> 3) + 8 * j; const LAS float* s = scr + (8 * c) * 33 + n;
        v4u o; o.x = pk2(s[0 * 33], s[1 * 33]); o.y = pk2(s[2 * 33], s[3 * 33]); o.z = pk2(s[4 * 33], s[5 * 33]); o.w = pk2(s[6 * 33], s[7 * 33]);
        *(GAS v4u*)(WT + (size_t)(n0 + n) * K + k0 + 8 * c) = o; }
    LDS_WAIT(); asm volatile("" ::: "memory");
}
struct CmIdent { __device__ __forceinline__ int operator()(int n) const { return n; } };
struct CmProj { __device__ __forceinline__ int operator()(int n) const { return proj_src_col(n); } };

__device__ __forceinline__ void p0_prologue(Frame& F, const Args& args) {
    LAS float* scr = (LAS float*)(F.lds + F.wave * 16384);
    const int gw = F.vcu * NWAVES + F.wave, NGW = F.G * NWAVES;
    constexpr int I_IN = 16 * (NPROJ / 32), I_OUT = 16 * 32, I_UV = 4 * 2 * 4;
    for (int it = gw; it < I_IN + I_OUT + I_UV; it += NGW) {
        int r = it;
        if (r < I_IN) { const int kb = r / (NPROJ / 32), nb = r % (NPROJ / 32); transpose_item(P_WIN, 3792, W_WINT, 1024, 64 * kb, 32 * nb, scr, F.lane, CmProj()); continue; }
        r -= I_IN;
        if (r < I_OUT) { const int kb = r / 32, nb = r % 32; transpose_item(P_WOUT, 1024, W_WOUTT, 1024, 64 * kb, 32 * nb, scr, F.lane, CmIdent()); continue; }
        r -= I_OUT;
        { const int hd = r >> 3, kb = (r >> 2) & 1, nb = r & 3; transpose_item(P_WUV + (size_t)hd * 16384, 128, W_WUVT + (size_t)hd * 16384, 128, 64 * kb, 32 * nb, scr, F.lane, CmIdent()); }
    }
    __syncthreads();
    if (F.vcu < 192) {
        LAS float* SC = (LAS float*)F.lds;
        for (int e = F.tid; e < NB * 1024; e += NWAVES * 64) { const int b = e >> 10, k = e & 1023; SC[k * 33 + b] = siluf(P_C[e]); }
        __syncthreads();
        const int col = F.tid & 15, ks = F.tid >> 4, n = F.vcu * 16 + col;
        float acc[32];
#pragma unroll
        for (int b = 0; b < 32; ++b) acc[b] = 0.f;
        for (int kk = 0; kk < 32; ++kk) { const int k = ks * 32 + kk; const float w = P_WADA[(size_t)k * 3072 + n];
#pragma unroll
            for (int b = 0; b < 32; ++b) acc[b] += SC[k * 33 + b] * w; }
        __syncthreads();
        LAS float* RED = (LAS float*)F.lds;
#pragma unroll
        for (int b = 0; b < 32; ++b) RED[(ks * 32 + b) * 16 + col] = acc[b];
        __syncthreads();
        { const int b = F.tid >> 4; float s = 0.f;
            for (int k2 = 0; k2 < 32; ++k2) s += RED[(k2 * 32 + b) * 16 + col];
            W_MOD[b * 3072 + n] = s + P_BADA[n]; }
        __syncthreads();
    }
}

__device__ __forceinline__ void p1_norm(Frame& F, const Args& args) {
    const int gw = F.vcu * NWAVES + F.wave, NGW = F.G * NWAVES;
    for (int m = gw; m < MROWS; m += NGW) {
        const int b = m >> 11;
        const GAS f32x4* xr = (const GAS f32x4*)(P_X + (size_t)m * DM) + F.lane;
        f32x4 v[4]; float ss = 0.f;
#pragma unroll
        for (int j = 0; j < 4; ++j) { v[j] = xr[64 * j]; ss += (v[j].x * v[j].x + v[j].y * v[j].y) + (v[j].z * v[j].z + v[j].w * v[j].w); }
        const float rstd = rsqf_(wave_sum(ss) * (1.0f / DM) + EPSF);
        const float* mb = W_MOD + b * 3072;
        GAS unsigned long long* o8 = (GAS unsigned long long*)(W_XN + (size_t)m * DM) + F.lane;
#pragma unroll
        for (int j = 0; j < 4; ++j) { const int col = F.lane * 4 + 256 * j;
            const f32x4 g = *(const f32x4*)(P_GPRE + col), sh = *(const f32x4*)(mb + col), sc = *(const f32x4*)(mb + 1024 + col);
            const f32x4 o = v[j] * rstd * g * (sc + 1.0f) + sh;
            o8[64 * j] = (unsigned long long)pk2(o.x, o.y) | ((unsigned long long)pk2(o.z, o.w) << 32); }
    }
}

__device__ __forceinline__ void p5_final(Frame& F, const Args& args) {
    const int gw = F.vcu * NWAVES + F.wave, NGW = F.G * NWAVES;
    for (int m = gw; m < MROWS; m += NGW) {
        const int b = m >> 11;
        const GAS v2u* mr = (const GAS v2u*)(W_MIX + (size_t)m * DM) + F.lane;
        const GAS f32x4* xr = (const GAS f32x4*)(P_X + (size_t)m * DM) + F.lane;
        GAS f32x4* orow = (GAS f32x4*)(P_OUT + (size_t)m * DM) + F.lane;
        f32x4 v[4]; float ss = 0.f;
#pragma unroll
        for (int j = 0; j < 4; ++j) { const v2u w = mr[64 * j]; v[j].x = bflo(w.x); v[j].y = bfhi(w.x); v[j].z = bflo(w.y); v[j].w = bfhi(w.y); ss += (v[j].x * v[j].x + v[j].y * v[j].y) + (v[j].z * v[j].z + v[j].w * v[j].w); }
        const float rstd = rsqf_(wave_sum(ss) * (1.0f / DM) + EPSF);
        const float* gt = W_MOD + b * 3072 + 2048;
#pragma unroll
        for (int j = 0; j < 4; ++j) { const int col = F.lane * 4 + 256 * j;
            const f32x4 g = *(const f32x4*)(P_GPOST + col), ga = *(const f32x4*)(gt + col);
            orow[64 * j] = xr[64 * j] + ga * (v[j] * rstd * g); }
    }
}

__device__ __forceinline__ unsigned cvtpk(float lo, float hi) { return pg8::cvt_pk_bf16(lo, hi); }
__device__ __forceinline__ v2u pack4(float a, float b, float c, float d) { v2u r; r.x = cvtpk(a, b); r.y = cvtpk(c, d); return r; }
__device__ __forceinline__ bf16x8 pack8(float a, float b, float c, float d, float e, float f, float g, float h) { v4u r; r.x = cvtpk(a, b); r.y = cvtpk(c, d); r.z = cvtpk(e, f); r.w = cvtpk(g, h); return __builtin_bit_cast(bf16x8, r); }
__device__ __forceinline__ bf16x8 lds16(const LAS unsigned char* p) { return *(const LAS bf16x8*)p; }
__device__ __forceinline__ bf16x8 lds8x2(const LAS unsigned char* p) { const v2u lo = *(const LAS v2u*)p, hi = *(const LAS v2u*)(p + 16); v4u r; r.x = lo.x; r.y = lo.y; r.z = hi.x; r.w = hi.y; return __builtin_bit_cast(bf16x8, r); }
template <int S> __device__ __forceinline__ bf16x8 acc_frag(const f32x16& a) { return pack8(a[8 * S + 0], a[8 * S + 1], a[8 * S + 2], a[8 * S + 3], a[8 * S + 4], a[8 * S + 5], a[8 * S + 6], a[8 * S + 7]); }

__device__ __forceinline__ float row16_sum(float v) {
#define R16_STEP(ctrl) v += __builtin_bit_cast(float, __builtin_amdgcn_update_dpp(0, __builtin_bit_cast(int, v), ctrl, 0xf, 0xf, false))
    R16_STEP(0x121); R16_STEP(0x122); R16_STEP(0x124); R16_STEP(0x128);
#undef R16_STEP
    return v;
}

__device__ __forceinline__ void gdn_unit(Frame& F, const Args& args, const int b, const int h) {
    LAS unsigned char* const L = F.lds;
    const int tid = F.tid, lane = F.lane, wv = F.wave, l31_0 = lane & 31, hh_0 = lane >> 5;
    int tidv = tid, lanev = lane;
    constexpr int P128 = 272, P64 = 144;
    constexpr int O_KH = 0, O_QH = O_KH + 17408, O_KGT = O_QH + 17408, O_VBT = O_KGT + 18432, O_KBGT = O_VBT + 18432, O_LM = O_KBGT + 18432, O_T = O_LM + 17408,
                  O_AT = O_T + 17408, O_CW = O_AT + 9216, O_SM = O_CW + 6144, O_PSO = O_SM + 2560, O_OF = O_PSO + 2048, O_END = O_OF + 17408;
    static_assert(O_END <= SCRATCH_BYTES, "gdn LDS map");
    constexpr int O_W = O_LM, O_VNT = O_VBT;
    LAS float* const SMb = (LAS float*)(L + O_SM);
    LAS float* const LM = (LAS float*)(L + O_LM);
    LAS float* const TT = (LAS float*)(L + O_T);
    LAS float* const CW = (LAS float*)(L + O_CW);
    LAS float* const PSO = (LAS float*)(L + O_PSO);
    const int mt = wv >> 2, nt = wv & 3;
    f32x16 S[4];
#pragma unroll
    for (int k = 0; k < 4; ++k)
#pragma unroll
        for (int r = 0; r < 16; ++r) S[k][r] = 0.f;
    const float alog_e = __expf(P_ALOG[h]), dtb = P_DTB[h];
#define GDN_GATES(n_) do { LAS float* _sm = SMb + ((n_) & 1) * 320; const float* _ap = W_AUX + (size_t)(b * SEQ + (n_) * 64 + lanev) * 16; \
        const float _bb = _ap[h], _aa = _ap[4 + h]; const float _beta = rcpf_(1.0f + __expf(-_bb)); const float _xs = _aa + dtb; \
        const float _sp = _xs > 20.f ? _xs : log1pf(__expf(_xs)); float _gc = -alog_e * _sp; \
        _Pragma("unroll") for (int _o = 1; _o < 64; _o <<= 1) { const float _t = __shfl_up(_gc, _o); if (lanev >= _o) _gc += _t; } \
        const float _gl = __shfl(_gc, 63); _sm[lanev] = _gc; _sm[64 + lanev] = _beta; _sm[128 + lanev] = __expf(_gc); _sm[192 + lanev] = __expf(_gl - _gc); \
        if (lanev == 0) _sm[256] = __expf(_gl); } while (0)
    if (wv == 6) GDN_GATES(0);
    for (int e = tidv; e < 3 * 4 * 128; e += NWAVES * 64) { const int ts_ = e >> 9, tap = (e >> 7) & 3, ch = e & 127; CW[e] = P_CONVW[tap * 1536 + ts_ * 512 + h * 128 + ch]; }
    const int ts = tid >> 8;
    int cgv = tid & 15, tpv = (tid >> 4) & 15;
#define GDN_ROWS(dst_, n_, chan_) do { const bf16* _src = W_PROJ + (size_t)(b * SEQ + (n_) * 64 + 4 * tpv - 3) * NPROJ + (chan_); \
        _Pragma("unroll") for (int _i = 0; _i < 7; ++_i) { v4u _z; _z.x = 0u; _z.y = 0u; _z.z = 0u; _z.w = 0u; dst_[_i] = _z; \
            if ((n_) > 0 || 4 * tpv - 3 + _i >= 0) dst_[_i] = *(const GAS v4u*)(_src + (size_t)_i * NPROJ); } } while (0)
#define GDN_OUT(rowb_) do { const int _tok = tidv >> 3, _dv0 = (tidv & 7) * 16; const size_t _row = (size_t)(rowb_) + _tok; \
        const LAS v4u* _op = (const LAS v4u*)(L + O_OF + _tok * P128 + _dv0 * 2); const v4u _o0 = _op[0], _o1 = _op[1]; \
        const LAS f32x4* _pp = (const LAS f32x4*)(PSO + _tok * 8); const f32x4 _a = _pp[0], _c = _pp[1]; \
        const float _rstd = rsqf_((((_a.x + _a.y) + (_a.z + _a.w)) + ((_c.x + _c.y) + (_c.z + _c.w))) * (1.0f / 128.0f) + EPSF); \
        const bf16* _zp = W_PROJ + _row * NPROJ + C_ZA + h * 128 + _dv0; const v4u _z0 = *(const GAS v4u*)_zp, _z1 = *(const GAS v4u*)(_zp + 8); \
        const unsigned _ow[8] = {_o0.x, _o0.y, _o0.z, _o0.w, _o1.x, _o1.y, _o1.z, _o1.w}, _zw[8] = {_z0.x, _z0.y, _z0.z, _z0.w, _z1.x, _z1.y, _z1.z, _z1.w}; unsigned _rw[8]; \
        _Pragma("unroll") for (int _k = 0; _k < 4; ++_k) { const f32x4 _g = *(const f32x4*)(P_GGDN + _dv0 + 4 * _k); \
            _rw[2 * _k] = cvtpk(bflo(_ow[2 * _k]) * _rstd * _g.x * siluf(bflo(_zw[2 * _k])), bfhi(_ow[2 * _k]) * _rstd * _g.y * siluf(bfhi(_zw[2 * _k]))); \
            _rw[2 * _k + 1] = cvtpk(bflo(_ow[2 * _k + 1]) * _rstd * _g.z * siluf(bflo(_zw[2 * _k + 1])), bfhi(_ow[2 * _k + 1]) * _rstd * _g.w * siluf(bfhi(_zw[2 * _k + 1]))); } \
        bf16* _dst = W_OAB + _row * DM + h * 128 + _dv0; v4u _w0, _w1; _w0.x = _rw[0]; _w0.y = _rw[1]; _w0.z = _rw[2]; _w0.w = _rw[3]; _w1.x = _rw[4]; _w1.y = _rw[5]; _w1.z = _rw[6]; _w1.w = _rw[7]; \
        *(GAS v4u*)_dst = _w0; *(GAS v4u*)(_dst + 8) = _w1; } while (0)
    __syncthreads();

    unsigned pf_sink = 0u;
    for (int n = 0; n < 32; ++n) {
        const int rowbase = b * SEQ + n * 64;
        LAS float* const SMf = SMb + (n & 1) * 320;
        tidv = tid; lanev = lane; cgv = tid & 15; tpv = (tid >> 4) & 15;
        asm volatile("" : "+v"(tidv), "+v"(lanev), "+v"(cgv), "+v"(tpv));
        int l31 = lanev & 31, hh = lanev >> 5, cg = cgv, tp = tpv;
        if (wv == 6 && n + 1 < 32) GDN_GATES(n + 1);
        float val[4][8];
#define GDN_CONV(rows_, tsel_) do { \
            _Pragma("unroll") for (int _j = 0; _j < 4; ++_j) _Pragma("unroll") for (int _e = 0; _e < 8; ++_e) val[_j][_e] = 0.f; \
            _Pragma("unroll") for (int _tap = 0; _tap < 4; ++_tap) { const LAS f32x4* _cp = (const LAS f32x4*)(CW + ((tsel_) * 4 + _tap) * 128 + cg * 8); const f32x4 _c0 = _cp[0], _c1 = _cp[1]; \
                const float _cw[8] = {_c0.x, _c0.y, _c0.z, _c0.w, _c1.x, _c1.y, _c1.z, _c1.w}; \
                _Pragma("unroll") for (int _j = 0; _j < 4; ++_j) { const v4u _raw = rows_[_j + _tap]; \
                    const float _in[8] = {bflo(_raw.x), bfhi(_raw.x), bflo(_raw.y), bfhi(_raw.y), bflo(_raw.z), bfhi(_raw.z), bflo(_raw.w), bfhi(_raw.w)}; \
                    _Pragma("unroll") for (int _e = 0; _e < 8; ++_e) val[_j][_e] += _in[_e] * _cw[_e]; } } \
            _Pragma("unroll") for (int _j = 0; _j < 4; ++_j) _Pragma("unroll") for (int _e = 0; _e < 8; ++_e) val[_j][_e] = siluf(val[_j][_e]); } while (0)
        v4u rq[7], rv[7];
        GDN_ROWS(rq, n, ts * 512 + h * 128 + cgv * 8);
        if (wv < 4) GDN_ROWS(rv, n, 1024 + h * 128 + cgv * 8);
        if (n + 1 < 32) {
            const bf16* pq = W_PROJ + (size_t)(rowbase + 64 + 4 * tpv - 3) * NPROJ + ts * 512 + h * 128 + cgv * 8;
#pragma unroll
            for (int i = 0; i < 7; ++i) asm volatile("global_load_dword %0, %1, off" : "+v"(pf_sink) : "v"(pq + (size_t)i * NPROJ) : "memory");
            if (wv < 4) { const bf16* pv = W_PROJ + (size_t)(rowbase + 64 + 4 * tpv - 3) * NPROJ + 1024 + h * 128 + cgv * 8;
#pragma unroll
                for (int i = 0; i < 7; ++i) asm volatile("global_load_dword %0, %1, off" : "+v"(pf_sink) : "v"(pv + (size_t)i * NPROJ) : "memory"); }
            { const bf16* pz = W_PROJ + (size_t)(rowbase + (tidv >> 3)) * NPROJ + C_ZA + h * 128 + (tidv & 7) * 16;
                asm volatile("global_load_dword %0, %1, off" : "+v"(pf_sink) : "v"(pz) : "memory"); }
        }
        {
            GDN_CONV(rq, ts);
#pragma unroll
            for (int j = 0; j < 4; ++j) { float ss = 0.f;
#pragma unroll
                for (int e = 0; e < 8; ++e) ss += val[j][e] * val[j][e];
                ss = row16_sum(ss);
                float r = rsqf_(ss + EPSF); if (ts == 0) r *= 0.08838834764831845f;
#pragma unroll
                for (int e = 0; e < 8; ++e) val[j][e] *= r; }
            if (ts == 0) {
#pragma unroll
                for (int j = 0; j < 4; ++j) *(LAS bf16x8*)(L + O_QH + (4 * tp + j) * P128 + cg * 16) = pack8(val[j][0], val[j][1], val[j][2], val[j][3], val[j][4], val[j][5], val[j][6], val[j][7]);
            } else {
                float ek[4], bg[4];
#pragma unroll
                for (int j = 0; j < 4; ++j) { ek[j] = SMf[192 + 4 * tp + j]; bg[j] = SMf[64 + 4 * tp + j] * SMf[128 + 4 * tp + j]; }
#pragma unroll
                for (int j = 0; j < 4; ++j) *(LAS bf16x8*)(L + O_KH + (4 * tp + j) * P128 + cg * 16) = pack8(val[j][0], val[j][1], val[j][2], val[j][3], val[j][4], val[j][5], val[j][6], val[j][7]);
#pragma unroll
                for (int e = 0; e < 8; ++e) {
                    *(LAS v2u*)(L + O_KGT + (cg * 8 + e) * P64 + tp * 8) = pack4(val[0][e] * ek[0], val[1][e] * ek[1], val[2][e] * ek[2], val[3][e] * ek[3]);
                    *(LAS v2u*)(L + O_KBGT + (cg * 8 + e) * P64 + tp * 8) = pack4(val[0][e] * bg[0], val[1][e] * bg[1], val[2][e] * bg[2], val[3][e] * bg[3]); }
            }
        }
        if (n > 0) GDN_OUT(rowbase - 64);
        if (wv < 4) {
            GDN_CONV(rv, 2);
            float be[4];
#pragma unroll
            for (int j = 0; j < 4; ++j) be[j] = SMf[64 + 4 * tp + j];
#pragma unroll
            for (int e = 0; e < 8; ++e) *(LAS v2u*)(L + O_VBT + (cg * 8 + e) * P64 + tp * 8) = pack4(val[0][e] * be[0], val[1][e] * be[1], val[2][e] * be[2], val[3][e] * be[3]);
        }
        for (int e = tidv; e < 64 * 68; e += NWAVES * 64) TT[e] = 0.f;
        __syncthreads();
        if (wv < 4) {
            const int ti = wv >> 1, tj = wv & 1;
            f32x16 C;
#pragma unroll
            for (int r = 0; r < 16; ++r) C[r] = 0.f;
            if (ti >= tj) {
#pragma unroll
                for (int s = 0; s < 8; ++s) C = MFMA32(lds16(L + O_KH + (32 * ti + l31) * P128 + (16 * s + 8 * hh) * 2), lds16(L + O_KH + (32 * tj + l31) * P128 + (16 * s + 8 * hh) * 2), C);
            }
            const int j = 32 * tj + l31; const float gcj = SMf[j];
#pragma unroll
            for (int g = 0; g < 4; ++g) { const int ib = 32 * ti + 8 * g + 4 * hh; const f32x4 gci = *(const LAS f32x4*)(SMf + ib), bei = *(const LAS f32x4*)(SMf + 64 + ib);
#pragma unroll
                for (int e = 0; e < 4; ++e) { const int i = ib + e; LM[i * 68 + j] = (i > j) ? bei[e] * C[4 * g + e] * __expf(gci[e] - gcj) : 0.f; } }
        } else {
            const int w4 = wv - 4, tj = w4 >> 1, ti = w4 & 1;
            f32x16 C;
#pragma unroll
            for (int r = 0; r < 16; ++r) C[r] = 0.f;
            if (ti >= tj) {
#pragma unroll
                for (int s = 0; s < 8; ++s) C = MFMA32(lds16(L + O_KH + (32 * tj + l31) * P128 + (16 * s + 8 * hh) * 2), lds16(L + O_QH + (32 * ti + l31) * P128 + (16 * s + 8 * hh) * 2), C);
            }
            const int i = 32 * ti + l31; const float gci = SMf[i];
#pragma unroll
            for (int g = 0; g < 4; ++g) { const int jb = 32 * tj + 8 * g + 4 * hh; const f32x4 gcj = *(const LAS f32x4*)(SMf + jb); float v[4];
#pragma unroll
                for (int e = 0; e < 4; ++e) v[e] = (i >= jb + e) ? C[4 * g + e] * __expf(gci - gcj[e]) : 0.f;
                *(LAS v2u*)(L + O_AT + i * P64 + jb * 2) = pack4(v[0], v[1], v[2], v[3]); }
        }
        __syncthreads();
        if (wv < 2) {
            const int a = 2 * wv, bq = 2 * wv + 1;
            if (lanev < 32) {
                const int blk = a + (lanev >> 4), c = lanev & 15; float x[16];
#pragma unroll
                for (int i = 0; i < 16; ++i) { const LAS float* lr = LM + (16 * blk + i) * 68 + 16 * blk; float acc = (i == c) ? 1.f : 0.f;
#pragma unroll
                    for (int j = 0; j < i; ++j) acc -= lr[j] * x[j];
                    x[i] = acc; TT[(16 * blk + i) * 68 + 16 * blk + c] = acc; }
            }
            asm volatile("s_waitcnt lgkmcnt(0)" ::: "memory");
            const int m = lanev & 15, q = lanev >> 4;
            f32x4 P = {0.f, 0.f, 0.f, 0.f}, R = {0.f, 0.f, 0.f, 0.f};
#pragma unroll
            for (int s = 0; s < 4; ++s) { const int k = q + 4 * s; P = MFMA16F(LM[(16 * bq + m) * 68 + 16 * a + k], TT[(16 * a + k) * 68 + 16 * a + m], P); }
#pragma unroll
            for (int rg = 0; rg < 4; ++rg) { const int k = 4 * q + rg; R = MFMA16F(TT[(16 * bq + m) * 68 + 16 * bq + k], P[rg], R); }
#pragma unroll
            for (int rg = 0; rg < 4; ++rg) TT[(16 * bq + 4 * q + rg) * 68 + 16 * a + m] = -R[rg];
        }
        __syncthreads();
        if (wv < 4) {
            const int m = lanev & 15, q = lanev >> 4, mi = wv >> 1, ni = wv & 1;
            f32x4 P0 = {0.f, 0.f, 0.f, 0.f}, P1 = {0.f, 0.f, 0.f, 0.f}, R = {0.f, 0.f, 0.f, 0.f};
#pragma unroll
            for (int s = 0; s < 8; ++s) { const int k = q + 4 * s; const float bt = TT[k * 68 + 16 * ni + m];
                P0 = MFMA16F(LM[(32 + m) * 68 + k], bt, P0); P1 = MFMA16F(LM[(48 + m) * 68 + k], bt, P1); }
#pragma unroll
            for (int rg = 0; rg < 4; ++rg) { R = MFMA16F(TT[(32 + 16 * mi + m) * 68 + 32 + 4 * q + rg], P0[rg], R); R = MFMA16F(TT[(32 + 16 * mi + m) * 68 + 48 + 4 * q + rg], P1[rg], R); }
#pragma unroll
            for (int rg = 0; rg < 4; ++rg) TT[(32 + 16 * mi + 4 * q + rg) * 68 + 16 * ni + m] = -R[rg];
        }
        __syncthreads();
        f32x16 U, WT_;
#pragma unroll
        for (int r = 0; r < 16; ++r) { U[r] = 0.f; WT_[r] = 0.f; }
#pragma unroll
        for (int s = 0; s < 4; ++s) { const LAS f32x4* tp4 = (const LAS f32x4*)(TT + (32 * mt + l31) * 68 + 16 * s + 8 * hh); const f32x4 t0 = tp4[0], t1 = tp4[1];
            const bf16x8 a = pack8(t0.x, t0.y, t0.z, t0.w, t1.x, t1.y, t1.z, t1.w);
            U = MFMA32(a, lds16(L + O_VBT + (32 * nt + l31) * P64 + (16 * s + 8 * hh) * 2), U);
            WT_ = MFMA32(lds16(L + O_KBGT + (32 * nt + l31) * P64 + (16 * s + 8 * hh) * 2), a, WT_); }
#pragma unroll
        for (int g = 0; g < 4; ++g) *(LAS v2u*)(L + O_W + (32 * mt + l31) * P128 + (32 * nt + 8 * g + 4 * hh) * 2) = pack4(-WT_[4 * g], -WT_[4 * g + 1], -WT_[4 * g + 2], -WT_[4 * g + 3]);
        __syncthreads();
        bf16x8 sf[4][2];
#pragma unroll
        for (int kt = 0; kt < 4; ++kt) { sf[kt][0] = acc_frag<0>(S[kt]); sf[kt][1] = acc_frag<1>(S[kt]); }
#pragma unroll
        for (int kt = 0; kt < 4; ++kt)
#pragma unroll
            for (int s = 0; s < 2; ++s) U = MFMA32(lds8x2(L + O_W + (32 * mt + l31) * P128 + (32 * kt + 16 * s + 4 * hh) * 2), sf[kt][s], U);
#pragma unroll
        for (int g = 0; g < 4; ++g) *(LAS v2u*)(L + O_VNT + (32 * nt + l31) * P64 + (32 * mt + 8 * g + 4 * hh) * 2) = pack4(U[4 * g], U[4 * g + 1], U[4 * g + 2], U[4 * g + 3]);
        __syncthreads();
        {
            f32x16 Oa;
#pragma unroll
            for (int r = 0; r < 16; ++r) Oa[r] = 0.f;
#pragma unroll
            for (int kt = 0; kt < 4; ++kt)
#pragma unroll
                for (int s = 0; s < 2; ++s) Oa = MFMA32(lds8x2(L + O_QH + (32 * mt + l31) * P128 + (32 * kt + 16 * s + 4 * hh) * 2), sf[kt][s], Oa);
#pragma unroll
            for (int g = 0; g < 4; ++g) { const f32x4 e4 = *(const LAS f32x4*)(SMf + 128 + 32 * mt + 8 * g + 4 * hh);
#pragma unroll
                for (int e = 0; e < 4; ++e) Oa[4 * g + e] *= e4[e]; }
            bf16x8 vn[4];
#pragma unroll
            for (int s = 0; s < 4; ++s) vn[s] = lds16(L + O_VNT + (32 * nt + l31) * P64 + (16 * s + 8 * hh) * 2);
#pragma unroll
            for (int s = 0; s < 4; ++s) Oa = MFMA32(lds16(L + O_AT + (32 * mt + l31) * P64 + (16 * s + 8 * hh) * 2), vn[s], Oa);
            const float glast = SMf[256];
#pragma unroll
            for (int kt = 0; kt < 4; ++kt) {
#pragma unroll
                for (int r = 0; r < 16; ++r) S[kt][r] *= glast;
#pragma unroll
                for (int s = 0; s < 4; ++s) S[kt] = MFMA32(lds16(L + O_KGT + (32 * kt + l31) * P64 + (16 * s + 8 * hh) * 2), vn[s], S[kt]);
            }
#pragma unroll
            for (int r = 0; r < 16; ++r) { const float q2 = row16_sum(Oa[r] * Oa[r]);
                if ((lanev & 15) == 0) PSO[(32 * mt + 8 * (r >> 2) + 4 * hh + (r & 3)) * 8 + 2 * nt + ((lanev >> 4) & 1)] = q2;
                *(LAS unsigned short*)(L + O_OF + (32 * mt + 8 * (r >> 2) + 4 * hh + (r & 3)) * P128 + (32 * nt + l31) * 2) = (unsigned short)cvtpk(Oa[r], 0.f); }
        }
        asm volatile("s_waitcnt vmcnt(0)" : "+v"(pf_sink) :: "memory");
        __syncthreads();
    }
    GDN_OUT(b * SEQ + 31 * 64);
    __syncthreads();
#undef GDN_GATES
#undef GDN_CONV
#undef GDN_ROWS
#undef GDN_OUT
}

template <int NREG>
__device__ __forceinline__ void dsa_select(const float* const scw, LAS unsigned* const MASK, const int wv, const int lane, const int t0, const int nk) {
    const float NINF = -__builtin_inff();
    const unsigned long long lt_mask = (1ull << lane) - 1ull;
    float xn[NREG];
#pragma unroll
    for (int i = 0; i < NREG; ++i) xn[i] = __hip_atomic_load(scw + i * 64 + lane, __ATOMIC_RELAXED, __HIP_MEMORY_SCOPE_AGENT);
#pragma unroll 1
    for (int ql_ = 0; ql_ < 8; ++ql_) {
        const int ql = ql_ & 7;
        const int tq = t0 + 8 * wv + ql;
        LAS unsigned* const mrow = MASK + (8 * wv + ql) * 64;
        float x[NREG];
#pragma unroll
        for (int i = 0; i < NREG; ++i) x[i] = (i * 64 + lane < nk) ? xn[i] : NINF;
        if (ql_ + 1 < 8) {
#pragma unroll
            for (int i = 0; i < NREG; ++i) xn[i] = __hip_atomic_load(scw + ((ql_ + 1) & 7) * 2048 + i * 64 + lane, __ATOMIC_RELAXED, __HIP_MEMORY_SCOPE_AGENT);
        }
        if (tq + 1 > 256) {
            float vmin = __builtin_inff(), vmax = NINF;
#pragma unroll
            for (int i = 0; i < NREG; ++i) { vmax = fmaxf(vmax, x[i]); vmin = fminf(vmin, x[i] == NINF ? __builtin_inff() : x[i]); }
            vmin = -wave_max(-vmin); vmax = wave_max(vmax);
#define CNT_GE(p_, dst_) do { int _c0 = 0, _c1 = 0, _c2 = 0, _c3 = 0; \
                _Pragma("unroll") for (int _i = 0; _i < NREG; _i += 4) { _c0 += (x[_i] >= (p_)) ? 1 : 0; _c1 += (x[_i + 1] >= (p_)) ? 1 : 0; _c2 += (x[_i + 2] >= (p_)) ? 1 : 0; _c3 += (x[_i + 3] >= (p_)) ? 1 : 0; } \
                dst_ = wave_sum_i((_c0 + _c1) + (_c2 + _c3)); } while (0)
            float lo = vmin, hi = vmax, thr; int chi; bool tie = false;
            CNT_GE(hi, chi);
            if (chi == 256) thr = hi;
            else if (chi > 256) { tie = true; lo = hi; chi = 0; hi = __builtin_inff(); }
            else {
#pragma unroll 1
                for (;;) {
                    const float mid = 0.5f * (lo + hi);
                    if (!(mid > lo && mid < hi)) { tie = true; break; }
                    int c; CNT_GE(mid, c);
                    if (c == 256) { thr = mid; break; }
                    if (c > 256) lo = mid; else { hi = mid; chi = c; }
                }
            }
#undef CNT_GE
            if (!tie) {
#pragma unroll
                for (int i = 0; i < NREG; ++i) { const unsigned long long bs = __ballot(x[i] >= thr);
                    if (lane == 0) { v2u w; w.x = (unsigned)bs; w.y = (unsigned)(bs >> 32); *(LAS v2u*)(mrow + 2 * i) = w; } }
            } else {
                const int need = 256 - chi; int before = 0;
#pragma unroll
                for (int i = 0; i < NREG; ++i) { const bool eq = (x[i] == lo); const unsigned long long be = __ballot(eq);
                    const int rank = before + __popcll(be & lt_mask); const bool sel = (x[i] >= hi) || (eq && rank < need); before += __popcll(be);
                    const unsigned long long bs = __ballot(sel);
                    if (lane == 0) { v2u w; w.x = (unsigned)bs; w.y = (unsigned)(bs >> 32); *(LAS v2u*)(mrow + 2 * i) = w; } }
            }
        } else {
#pragma unroll
            for (int i = 0; i < NREG; ++i) { const unsigned long long bs = __ballot(i * 64 + lane <= tq);
                if (lane == 0) { v2u w; w.x = (unsigned)bs; w.y = (unsigned)(bs >> 32); *(LAS v2u*)(mrow + 2 * i) = w; } }
        }
    }
}

__device__ __forceinline__ void dsa_unit(Frame& F, const Args& args, const int b, const int qb) {
    LAS unsigned char* const L = F.lds;
    const int tid = F.tid, lane = F.lane, wv = F.wave, l31_0 = lane & 31, hh_0 = lane >> 5;
    int l31 = l31_0, hh = hh_0;
    constexpr int PK = 272, PV = 144;
    constexpr int O_K0 = 0, O_V0 = 17408, BUFSZ = 35840, O_MASK = 2 * BUFSZ, O_RS = O_MASK + 16384, O_BT = O_RS + 8192, O_END = O_BT + 2048, O_OA = 0;
    static_assert(O_END <= SCRATCH_BYTES && 4 * 17408 <= 2 * BUFSZ, "dsa LDS map");
    const int t0 = 64 * qb, nk = 64 * (qb + 1);
    const size_t rb = (size_t)b * SEQ;
    LAS unsigned* const MASK = (LAS unsigned*)(L + O_MASK);
    LAS float* const RS = (LAS float*)(L + O_RS);
    LAS float* const BT = (LAS float*)(L + O_BT);
    const float NINF = -__builtin_inff();
    for (int key = tid; key < nk; key += NWAVES * 64) { const f32x4 s4 = *(const f32x4*)(W_KVSS + (rb + key) * 4); RS[key] = rsqf_(((s4.x + s4.y) + (s4.z + s4.w)) * (1.0f / 128.0f) + EPSF); }
    BT[tid] = P_RELB[T5_BUCKET[tid >> 2] * 4 + (tid & 3)] * LOG2E;
    float* const scw = W_SCR + (size_t)(blockIdx.x * NWAVES + wv) * 8 * 2048;
#pragma unroll 1
    for (int rep_a = 0; rep_a < (PROBE_DUP == 41 ? 2 : 1); ++rep_a) {
        bf16x8 aq[2][4]; f32x4 wts[2][4];
#pragma unroll
        for (int rt = 0; rt < 2; ++rt) {
            const bf16* p = W_PROJ + (rb + t0 + 8 * wv + 4 * rt + (l31 >> 3)) * NPROJ + C_IQ + (l31 & 7) * 64 + 8 * hh;
#pragma unroll
            for (int s = 0; s < 4; ++s) aq[rt][s] = *(const GAS bf16x8*)(p + 16 * s);
#pragma unroll
            for (int g = 0; g < 4; ++g) wts[rt][g] = *(const f32x4*)(W_AUX + (rb + t0 + 8 * wv + 4 * rt + g) * 16 + 8 + 4 * hh) * 0.5f;
        }
        constexpr int O_IK = 0, IKB = 9216, PIK = 144;
        v4u sti;
#define IK_GLOAD(kt_) sti = *(const GAS v4u*)(W_PROJ + (rb + 64 * (kt_) + (tid >> 3)) * NPROJ + C_IK + (tid & 7) * 8)
#define IK_SWRITE(buf_) *(LAS v4u*)(L + O_IK + (buf_) * IKB + (tid >> 3) * PIK + (tid & 7) * 16) = sti
        IK_GLOAD(0); IK_SWRITE(0);
        __syncthreads();
#pragma unroll 1
        for (int kt6 = 0; kt6 <= qb; ++kt6) {
          const int ibuf = kt6 & 1;
          if (kt6 < qb) IK_GLOAD(kt6 + 1);
#pragma unroll
          for (int st = 0; st < 2; ++st) {
            bf16x8 bk[4];
#pragma unroll
            for (int s = 0; s < 4; ++s) bk[s] = lds16(L + O_IK + ibuf * IKB + (32 * st + l31) * PIK + (16 * s + 8 * hh) * 2);
            const int kt = 2 * kt6 + st;
            const int key = 32 * kt + l31;
            f32x16 C0, C1;
#pragma unroll
            for (int r = 0; r < 16; ++r) { C0[r] = 0.f; C1[r] = 0.f; }
#pragma unroll
            for (int s = 0; s < 4; ++s) C0 = MFMA32(aq[0][s], bk[s], C0);
#pragma unroll
            for (int s = 0; s < 4; ++s) C1 = MFMA32(aq[1][s], bk[s], C1);
            float pp[2][4];
#pragma unroll
            for (int g = 0; g < 4; ++g) {
                float p0 = 0.f, p1 = 0.f;
#pragma unroll
                for (int e2 = 0; e2 < 4; ++e2) { const float w0 = wts[0][g][e2], w1 = wts[1][g][e2], x0 = C0[4 * g + e2], x1 = C1[4 * g + e2];
                    p0 = __builtin_fmaf(w0, x0, p0); p0 = __builtin_fmaf(w0, __builtin_fabsf(x0), p0); p1 = __builtin_fmaf(w1, x1, p1); p1 = __builtin_fmaf(w1, __builtin_fabsf(x1), p1); }
                pp[0][g] = p0; pp[1][g] = p1;
            }
            float snd[2][2], rcv[2][2];
#pragma unroll
            for (int rt = 0; rt < 2; ++rt)
#pragma unroll
                for (int g2 = 0; g2 < 2; ++g2) snd[rt][g2] = hh ? pp[rt][g2] : pp[rt][g2 + 2];
#pragma unroll
            for (int rt = 0; rt < 2; ++rt)
#pragma unroll
                for (int g2 = 0; g2 < 2; ++g2) rcv[rt][g2] = __shfl_xor(snd[rt][g2], 32);
#pragma unroll
            for (int rt = 0; rt < 2; ++rt)
#pragma unroll
                for (int g2 = 0; g2 < 2; ++g2) { const int ql = 4 * rt + g2 + 2 * hh; float p = (hh ? pp[rt][g2 + 2] : pp[rt][g2]) + rcv[rt][g2];
                    if (key > t0 + 8 * wv + ql) p = NINF;
                    scw[ql * 2048 + key] = p; }
          }
          if (kt6 < qb) IK_SWRITE(ibuf ^ 1);
          __syncthreads();
        }
#undef IK_GLOAD
#undef IK_SWRITE
    }
    __builtin_amdgcn_fence(__ATOMIC_SEQ_CST, "workgroup");
    asm volatile("s_waitcnt vmcnt(0)" ::: "memory");
    int lanev = lane; asm volatile("" : "+v"(lanev));
    if (qb < 8) dsa_select<8>(scw, MASK, wv, lanev, t0, nk);
    else if (qb < 16) dsa_select<16>(scw, MASK, wv, lanev, t0, nk);
    else if (qb < 24) dsa_select<24>(scw, MASK, wv, lanev, t0, nk);
    else dsa_select<32>(scw, MASK, wv, lanev, t0, nk);
    __syncthreads();
    const int qj = l31 >> 2, hd = l31 & 3;
    const int tql = t0 + 8 * wv + qj;
    bf16x8 qf[8]; float qn2 = 0.f;
    {
        const bf16* p = W_PROJ + (rb + tql) * NPROJ + C_QB + hd * 128 + 8 * hh; const float cs = 0.08838834764831845f * LOG2E;
#pragma unroll
        for (int s = 0; s < 8; ++s) { const v4u raw = *(const GAS v4u*)(p + 16 * s); const f32x4 g0 = *(const f32x4*)(P_GKV + 16 * s + 8 * hh), g1 = *(const f32x4*)(P_GKV + 16 * s + 8 * hh + 4);
            v4u o; o.x = cvtpk(bflo(raw.x) * g0.x * cs, bfhi(raw.x) * g0.y * cs); o.y = cvtpk(bflo(raw.y) * g0.z * cs, bfhi(raw.y) * g0.w * cs);
            o.z = cvtpk(bflo(raw.z) * g1.x * cs, bfhi(raw.z) * g1.y * cs); o.w = cvtpk(bflo(raw.w) * g1.z * cs, bfhi(raw.w) * g1.w * cs);
            qn2 += (bflo(o.x) * bflo(o.x) + bfhi(o.x) * bfhi(o.x)) + (bflo(o.y) * bflo(o.y) + bfhi(o.y) * bfhi(o.y)) + (bflo(o.z) * bflo(o.z) + bfhi(o.z) * bfhi(o.z)) + (bflo(o.w) * bflo(o.w) + bfhi(o.w) * bfhi(o.w));
            qf[s] = __builtin_bit_cast(bf16x8, o); }
    }
    qn2 += __shfl_xor(qn2, 32);
    float mb = P_RELB[hd];
    for (int k = 1; k < 32; ++k) mb = fmaxf(mb, P_RELB[k * 4 + hd]);
    const float c0 = -(sqrtf(qn2) * 11.313708499f * 1.01f + mb * LOG2E + 1.0f);
    const float cfar = BT[127 * 4 + hd] + c0;
    f32x16 oacc[4];
#pragma unroll
    for (int d = 0; d < 4; ++d)
#pragma unroll
        for (int r = 0; r < 16; ++r) oacc[d][r] = 0.f;
    float lsum = 0.f;
    v4u st0, st1;
#define DSA_GLOAD(kt) do { const bf16* _p = W_PROJ + (rb + 64 * (kt) + lane) * NPROJ + C_CKV + wv * 16; st0 = *(const GAS v4u*)_p; st1 = *(const GAS v4u*)(_p + 8); } while (0)
#define DSA_SWRITE(buf, ktt) do { LAS unsigned char* _kb = L + (buf) * BUFSZ; const float _r = RS[64 * (ktt) + lane]; \
        v4u _n0, _n1; _n0.x = cvtpk(bflo(st0.x) * _r, bfhi(st0.x) * _r); _n0.y = cvtpk(bflo(st0.y) * _r, bfhi(st0.y) * _r); _n0.z = cvtpk(bflo(st0.z) * _r, bfhi(st0.z) * _r); _n0.w = cvtpk(bflo(st0.w) * _r, bfhi(st0.w) * _r); \
        _n1.x = cvtpk(bflo(st1.x) * _r, bfhi(st1.x) * _r); _n1.y = cvtpk(bflo(st1.y) * _r, bfhi(st1.y) * _r); _n1.z = cvtpk(bflo(st1.z) * _r, bfhi(st1.z) * _r); _n1.w = cvtpk(bflo(st1.w) * _r, bfhi(st1.w) * _r); \
        *(LAS v4u*)(_kb + O_K0 + lane * PK + wv * 32) = _n0; *(LAS v4u*)(_kb + O_K0 + lane * PK + wv * 32 + 16) = _n1; \
        LAS unsigned short* _vt = (LAS unsigned short*)(_kb + O_V0) + (wv * 16) * 72 + lane; \
        _vt[0 * 72] = (unsigned short)_n0.x; _vt[1 * 72] = (unsigned short)(_n0.x >> 16); _vt[2 * 72] = (unsigned short)_n0.y; _vt[3 * 72] = (unsigned short)(_n0.y >> 16); \
        _vt[4 * 72] = (unsigned short)_n0.z; _vt[5 * 72] = (unsigned short)(_n0.z >> 16); _vt[6 * 72] = (unsigned short)_n0.w; _vt[7 * 72] = (unsigned short)(_n0.w >> 16); \
        _vt[8 * 72] = (unsigned short)_n1.x; _vt[9 * 72] = (unsigned short)(_n1.x >> 16); _vt[10 * 72] = (unsigned short)_n1.y; _vt[11 * 72] = (unsigned short)(_n1.y >> 16); \
        _vt[12 * 72] = (unsigned short)_n1.z; _vt[13 * 72] = (unsigned short)(_n1.z >> 16); _vt[14 * 72] = (unsigned short)_n1.w; _vt[15 * 72] = (unsigned short)(_n1.w >> 16); } while (0)
    DSA_GLOAD(0); DSA_SWRITE(0, 0);
    __syncthreads();
    for (int kt = 0; kt <= qb; ++kt) {
        const int buf = kt & 1;
        l31 = l31_0; hh = hh_0; asm volatile("" : "+v"(l31), "+v"(hh));
        if (kt < qb) DSA_GLOAD(kt + 1);
        const LAS unsigned char* kb = L + buf * BUFSZ;
#pragma unroll 1
        for (int st = 0; st < 2; ++st) {
            f32x16 Sa;
#pragma unroll
            for (int r = 0; r < 16; ++r) Sa[r] = 0.f;
#pragma unroll
            for (int s = 0; s < 8; ++s) Sa = MFMA32(lds16(kb + O_K0 + (32 * st + l31) * PK + (16 * s + 8 * hh) * 2), qf[s], Sa);
            const int kbase = 64 * kt + 32 * st;
            const int mwi = (int)(MASK[(8 * wv + qj) * 64 + 2 * kt + st] >> (4 * hh));
            const bool far = (t0 + 8 * wv) - (kbase + 31) >= 113;
            float pn[16];
            if (far) {
#pragma unroll
                for (int r = 0; r < 16; ++r) { const float p = __builtin_bit_cast(float, __builtin_bit_cast(int, __builtin_amdgcn_exp2f(Sa[r] + cfar)) & __builtin_amdgcn_sbfe(mwi, 8 * (r >> 2) + (r & 3), 1));
                    lsum += p; pn[r] = p; }
            } else {
#pragma unroll
                for (int r = 0; r < 16; ++r) { int dist = tql - (kbase + 8 * (r >> 2) + 4 * hh + (r & 3)); dist = dist < 0 ? 0 : (dist > 127 ? 127 : dist);
                    const float p = __builtin_bit_cast(float, __builtin_bit_cast(int, __builtin_amdgcn_exp2f(Sa[r] + (BT[dist * 4 + hd] + c0))) & __builtin_amdgcn_sbfe(mwi, 8 * (r >> 2) + (r & 3), 1));
                    lsum += p; pn[r] = p; }
            }
            const bf16x8 pf0 = pack8(pn[0], pn[1], pn[2], pn[3], pn[4], pn[5], pn[6], pn[7]), pf1 = pack8(pn[8], pn[9], pn[10], pn[11], pn[12], pn[13], pn[14], pn[15]);
#pragma unroll
            for (int dt = 0; dt < 4; ++dt) { const LAS unsigned char* vp = kb + O_V0 + (32 * dt + l31) * PV + (32 * st + 4 * hh) * 2;
                oacc[dt] = MFMA32(lds8x2(vp), pf0, oacc[dt]); oacc[dt] = MFMA32(lds8x2(vp + 32), pf1, oacc[dt]); }
        }
        if (kt < qb) DSA_SWRITE(buf ^ 1, kt + 1);
        __syncthreads();
    }
#undef DSA_GLOAD
#undef DSA_SWRITE
    lsum += __shfl_xor(lsum, 32);
    {
        const float inv = rcpf_(lsum);
#pragma unroll
        for (int dt = 0; dt < 4; ++dt)
#pragma unroll
            for (int g = 0; g < 4; ++g) { const int d = 32 * dt + 8 * g + 4 * hh; const f32x4 gk = *(const f32x4*)(P_GKV + d);
                *(LAS v2u*)(L + O_OA + hd * 17408 + (8 * wv + qj) * PK + d * 2) = pack4(oacc[dt][4 * g] * inv * gk.x, oacc[dt][4 * g + 1] * inv * gk.y, oacc[dt][4 * g + 2] * inv * gk.z, oacc[dt][4 * g + 3] * inv * gk.w); }
    }
    __syncthreads();
#pragma unroll 1
    for (int x = 0; x < 4; ++x) {
        const int ti = wv * 4 + x, hd2 = ti >> 3, mt2 = (ti >> 2) & 1, et = ti & 3;
        f32x16 C;
#pragma unroll
        for (int r = 0; r < 16; ++r) C[r] = 0.f;
        const bf16* wp = W_WUVT + (size_t)hd2 * 16384 + (32 * et + l31) * 128 + 8 * hh;
#pragma unroll
        for (int s = 0; s < 8; ++s) C = MFMA32(lds16(L + O_OA + hd2 * 17408 + (32 * mt2 + l31) * PK + (16 * s + 8 * hh) * 2), *(const GAS bf16x8*)(wp + 16 * s), C);
        const int ecol = 32 * et + l31;
#pragma unroll
        for (int r = 0; r < 16; ++r) { const size_t row = rb + t0 + 32 * mt2 + 8 * (r >> 2) + 4 * hh + (r & 3);
            const float z = bf2f(W_PROJ[row * NPROJ + C_ZB + hd2 * 128 + ecol]);
            W_OAB[row * DM + 512 + hd2 * 128 + ecol] = (bf16)f2bf(C[r] * siluf(z)); }
    }
    __syncthreads();
}

constexpr int N_GDN = NB * 4, N_DSA = NB * 32, N_ITEMS = N_GDN + N_DSA;
constexpr int N_PHASES = 6;
__global__ void __launch_bounds__(NWAVES * 64, 2) hyb_fwd(Args args) {
    extern __shared__ __attribute__((aligned(16))) unsigned char lds[];
    Frame F;
    F.lds = (LAS unsigned char*)lds;
    F.MISC = (volatile LAS unsigned*)(F.lds + MISC_OFF);
    F.tid = threadIdx.x; F.lane = F.tid & 63; F.wave = __builtin_amdgcn_readfirstlane(F.tid >> 6);
    F.G = gridDim.x; { const int bx = blockIdx.x; F.vcu = (F.G % 8 == 0) ? (bx % 8) * (F.G / 8) + bx / 8 : bx; }
    unsigned char* ws = args.ws;
    F.ctl = (gu32*)(ws + WS_CTL);
    F.ws = ws;
    for (int u = F.tid; u < 64; u += NWAVES * 64) F.MISC[u] = 0u;
    __syncthreads();
    const int lo = args.ph_lo, hi = args.ph_hi;
    const bool multi = (hi - lo) > 1;
    XcdBarrier bar; bar.bar = (unsigned*)(F.ctl + CW_BAR) + args.li * XCD_BAR_WORDS; bar.x = 0; bar.st = nullptr;
    if (multi) bar = xcd_barrier_post((unsigned*)(F.ctl + CW_BAR) + args.li * XCD_BAR_WORDS, F.MISC + 8);
#define IN(k) (lo <= (k) && (k) < hi)
#define BOTH(k) (IN(k) && IN((k) + 1))
    if (IN(0)) { p0_prologue(F, args); if (PROBE_DUP == 7) { __syncthreads(); p0_prologue(F, args); } if (BOTH(0)) xcd_barrier(bar); }
    if (IN(1)) { p1_norm(F, args); if (PROBE_DUP == 1) p1_norm(F, args); if (BOTH(1)) xcd_barrier(bar); }
    if (IN(2)) {
        pg8::Gemm g{W_XN, W_WINT, MROWS, NPROJ, DM}; pg8::StaticOrder S; S.init(MROWS, NPROJ, F.G, (int)blockIdx.x);
        pg8::EpiProj E{W_PROJ, W_AUX, W_KVSS};
        pg8::gemm_phase<pg8::EpiProj, pg8::StaticOrder, true, true>(F.lds, g, S, E);
        if (PROBE_DUP == 2) pg8::gemm_phase<pg8::EpiProj, pg8::StaticOrder, true, true>(F.lds, g, S, E);
        if (BOTH(2)) xcd_barrier(bar);
    }
    if (IN(3)) {
#define NEXT_ITEM(dst, qw) do { if (F.tid == 0) F.MISC[4] = __hip_atomic_fetch_add(F.ctl + (qw), 1u, RLX_AGENT); __syncthreads(); dst = (int)F.MISC[4]; __syncthreads(); } while (0)
        int item; NEXT_ITEM(item, CW_QUEUE);
#pragma unroll 1
        for (int pass = 0; pass < (PROBE_DUP == 3 ? 2 : 1); ++pass) {
            if (pass) NEXT_ITEM(item, CW_QUEUE + 64);
            while (item < N_GDN) { gdn_unit(F, args, item >> 2, item & 3); NEXT_ITEM(item, CW_QUEUE + 64 * pass); }
        }
#pragma unroll 1
        for (int pass = 0; pass < (PROBE_DUP == 4 ? 2 : 1); ++pass) {
            if (pass) NEXT_ITEM(item, CW_QUEUE + 128);
            while (item < N_ITEMS) { if (item >= N_GDN) { const int idx = item - N_GDN; dsa_unit(F, args, idx & 31, 31 - (idx >> 5)); } NEXT_ITEM(item, pass ? CW_QUEUE + 128 : CW_QUEUE); }
        }
#undef NEXT_ITEM
        if (BOTH(3)) xcd_barrier(bar);
    }
    if (IN(4)) {
        pg8::Gemm g{W_OAB, W_WOUTT, MROWS, DM, DM}; pg8::StaticOrder S; S.init(MROWS, DM, F.G, (int)blockIdx.x);
        pg8::EpiMix E{W_MIX, DM};
        pg8::gemm_phase<pg8::EpiMix, pg8::StaticOrder, true, true>(F.lds, g, S, E);
        if (PROBE_DUP == 5) pg8::gemm_phase<pg8::EpiMix, pg8::StaticOrder, true, true>(F.lds, g, S, E);
        if (BOTH(4)) xcd_barrier(bar);
    }
    if (IN(5)) { p5_final(F, args); if (PROBE_DUP == 6) p5_final(F, args); }
#undef IN
#undef BOTH
}

extern "C" void kernel_launch(void* const* d_in, const int* in_sizes, int n_in, void* d_out, int out_size, void* d_ws, size_t ws_size, hipStream_t stream) {
    static int grid = 0;
    if (grid == 0) {
        if (n_in != 15 || in_sizes[0] != MROWS * DM || out_size != MROWS * DM || ws_size < WS_END) { fprintf(stderr, "kernel_launch: unexpected shapes (n_in %d, in0 %d, out %d, ws %zu); nothing launched\n", n_in, n_in > 0 ? in_sizes[0] : -1, out_size, ws_size); grid = -1; return; }
        int dev = 0, cus = 0, per_cu = 0;
        if (hipGetDevice(&dev) != hipSuccess || hipDeviceGetAttribute(&cus, hipDeviceAttributeMultiprocessorCount, dev) != hipSuccess) { fprintf(stderr, "kernel_launch: device query failed\n"); grid = -1; return; }
        if (hipFuncSetAttribute((const void*)hyb_fwd, hipFuncAttributeMaxDynamicSharedMemorySize, LDS_BYTES) != hipSuccess) { fprintf(stderr, "kernel_launch: hipFuncSetAttribute failed\n"); grid = -1; return; }
        if (hipOccupancyMaxActiveBlocksPerMultiprocessor(&per_cu, (const void*)hyb_fwd, NWAVES * 64, LDS_BYTES) != hipSuccess || per_cu < 1)
            fprintf(stderr, "kernel_launch: note: occupancy query reports %d workgroups per CU\n", per_cu);
        (void)hipGetLastError();
        grid = cus;
    }
    if (grid < 0) return;
    if (hipMemsetAsync((char*)d_ws + WS_CTL, 0, CTL_ZERO_BYTES, stream) != hipSuccess) { fprintf(stderr, "kernel_launch: memset failed\n"); return; }
    Args a{};
    for (int i = 0; i < 15; ++i) a.in[i] = (const float*)d_in[i];
    a.out = (float*)d_out; a.ws = (unsigned char*)d_ws;
    constexpr int NL = MK_N_LAUNCHES;
    static_assert(NL == 1 || NL == 2 || NL == 3 || NL == N_PHASES, "MK_N_LAUNCHES");
    const int cuts1[2] = {0, 6}, cuts2[3] = {0, 3, 6}, cuts3[4] = {0, 3, 4, 6}, cuts6[7] = {0, 1, 2, 3, 4, 5, 6};
    const int* cuts = NL == 1 ? cuts1 : NL == 2 ? cuts2 : NL == 3 ? cuts3 : cuts6;
    for (int li = 0; li < NL; ++li) {
        a.ph_lo = cuts[li]; a.ph_hi = cuts[li + 1]; a.li = li;
        hipLaunchKernelGGL(hyb_fwd, dim3(grid), dim3(NWAVES * 64), LDS_BYTES, stream, a);
        const hipError_t le = hipPeekAtLastError();
        if (le != hipSuccess) { fprintf(stderr, "kernel_launch: launch %d failed: %s\n", li, hipGetErrorName(le)); break; }
    }
}
```

```cpp
#include <hip/hip_runtime.h>
#include <cstdio>
#include <cstdint>
#ifndef MK_N_LAUNCHES
#define MK_N_LAUNCHES 1
#endif
#ifndef PROBE_DUP
#define PROBE_DUP 0
#endif
namespace pg8 {
#define PG8_LAS __attribute__((address_space(3)))
typedef unsigned short bf16_t;
typedef short bf16x8 __attribute__((ext_vector_type(8)));
typedef float f32x4 __attribute__((ext_vector_type(4)));
typedef unsigned u32x4 __attribute__((ext_vector_type(4)));
constexpr int BM = 256, BK = 64, HALF = 128, HTB = HALF * BK * 2  , STAGE_BYTES = 8 * HTB, NXCD = 8, WGM = 8;

__host__ __device__ __forceinline__ int lds_byte(int r, int c) { const int st = (r >> 4) * 2 + (c >> 5), rr = r & 15, cc = c & 31, ob = rr * 64 + cc * 2; return st * 1024 + (ob ^ (((ob >> 9) & 1) << 5)); }
__host__ __device__ __forceinline__ void stage_rc(int b, int& R, int& C) { const int st = b / 1024, sb = b % 1024, swz = sb ^ (((sb >> 9) & 1) << 5); R = (st >> 1) * 16 + swz / 64; C = (st & 1) * 32 + (swz % 64) / 2; }
__host__ __device__ __forceinline__ int perm32(int rho) { const int n = rho >> 4, i = rho & 15; return 8 * (i >> 2) + 4 * n + (i & 3); }

struct Unit { int pm, pn; };
struct Gemm { const bf16_t* A; const bf16_t* Bt; int M, N, K; };

struct StaticOrder {
    int nM, nN, nwg, G, c;
    __host__ __device__ void init(int M, int N, int G_, int c_) { nM = M / BM; nN = N / BM; nwg = nM * nN; G = G_; c = c_; }
    __host__ __device__ bool next(int i, Unit& u) const {
        const long L = (long)i * G + c; if (L >= nwg) return false;
        int wgid = (int)L; { const int q = nwg / NXCD, r = nwg % NXCD, xcd = wgid % NXCD, off = wgid / NXCD; wgid = (xcd < r ? xcd * (q + 1) : r * (q + 1) + (xcd - r) * q) + off; }
        const int nig = WGM * nN, gid = wgid / nig, fm = gid * WGM, gsz = (nM - fm) < WGM ? (nM - fm) : WGM;
        u.pm = fm + ((wgid % nig) % gsz); u.pn = (wgid % nig) / gsz; return true;
    }
    __device__ __forceinline__ void a_ready(const Unit&) const {}
    __device__ __forceinline__ void done(const Unit&) const {}
};

typedef float f32x2c __attribute__((ext_vector_type(2))); typedef __bf16 b16x2c __attribute__((ext_vector_type(2)));
__device__ __forceinline__ unsigned cvt_pk_bf16(float lo, float hi) { const f32x2c v = {lo, hi}; return __builtin_bit_cast(unsigned, __builtin_convertvector(v, b16x2c)); }
struct EpiProj {
    static constexpr bool PERM = true, AFTER_DRAIN = false;
    bf16_t* O; float* aux; float* kvss;
    __device__ __forceinline__ void operator()(const f32x4 (&acc)[2][2][4][2], const Unit& u, int wr, int wc, int fr, int fq) const {
        const int row0 = u.pm * BM + wr * 64 + fr, col0 = u.pn * BM + wc * 32 + 8 * fq;
        const bool last = (u.pn == 14);
#pragma unroll
        for (int ai = 0; ai < 2; ++ai)
#pragma unroll
            for (int m = 0; m < 4; ++m) {
                const int row = row0 + ai * HALF + m * 16;
                bf16_t* rowp = O + (size_t)row * 3840 + col0;
#pragma unroll
                for (int bj = 0; bj < 2; ++bj) {
                    const f32x4 v0 = acc[ai][bj][m][0], v1 = acc[ai][bj][m][1];
                    u32x4 w; w.x = cvt_pk_bf16(v0[0], v0[1]); w.y = cvt_pk_bf16(v0[2], v0[3]); w.z = cvt_pk_bf16(v1[0], v1[1]); w.w = cvt_pk_bf16(v1[2], v1[3]);
                    *(u32x4*)(rowp + bj * HALF) = w;
                }
                if (last) {
                    const f32x4 a0 = acc[ai][0][m][0], a1 = acc[ai][0][m][1];
                    float ss = (a0[0] * a0[0] + a0[1] * a0[1]) + (a0[2] * a0[2] + a0[3] * a0[3]) + (a1[0] * a1[0] + a1[1] * a1[1]) + (a1[2] * a1[2] + a1[3] * a1[3]);
                    ss += __shfl_xor(ss, 16); ss += __shfl_xor(ss, 32);
                    if (fq == 0) kvss[(size_t)row * 4 + wc] = ss;
                    if (wc == 2 && fq < 2) { float* ap = aux + (size_t)row * 16 + 8 * fq; *(f32x4*)ap = acc[ai][1][m][0]; *(f32x4*)(ap + 4) = acc[ai][1][m][1]; }
                }
            }
    }
};
struct EpiF32 {
    static constexpr bool PERM = false, AFTER_DRAIN = false;
    float* C; int ldc;
    __device__ __forceinline__ void operator()(const f32x4 (&acc)[2][2][4][2], const Unit& u, int wr, int wc, int fr, int fq) const {
        const int row0 = u.pm * BM + wr * 64 + fr, col0 = u.pn * BM + wc * 32 + 4 * fq;
#pragma unroll
        for (int ai = 0; ai < 2; ++ai)
#pragma unroll
            for (int m = 0; m < 4; ++m) { float* rowp = C + (size_t)(row0 + ai * HALF + m * 16) * ldc + col0;
#pragma unroll
                for (int bj = 0; bj < 2; ++bj)
#pragma unroll
                    for (int n = 0; n < 2; ++n) *(f32x4*)(rowp + bj * HALF + n * 16) = acc[ai][bj][m][n]; }
    }
};
struct EpiMix {
    static constexpr bool PERM = true, AFTER_DRAIN = false;
    bf16_t* O; int ldc;
    __device__ __forceinline__ void operator()(const f32x4 (&acc)[2][2][4][2], const Unit& u, int wr, int wc, int fr, int fq) const {
        const int row0 = u.pm * BM + wr * 64 + fr, col0 = u.pn * BM + wc * 32 + 8 * fq;
#pragma unroll
        for (int ai = 0; ai < 2; ++ai)
#pragma unroll
            for (int m = 0; m < 4; ++m) { bf16_t* rowp = O + (size_t)(row0 + ai * HALF + m * 16) * ldc + col0;
#pragma unroll
                for (int bj = 0; bj < 2; ++bj) { const f32x4 v0 = acc[ai][bj][m][0], v1 = acc[ai][bj][m][1];
                    u32x4 w; w.x = cvt_pk_bf16(v0[0], v0[1]); w.y = cvt_pk_bf16(v0[2], v0[3]); w.z = cvt_pk_bf16(v1[0], v1[1]); w.w = cvt_pk_bf16(v1[2], v1[3]);
                    *(u32x4*)(rowp + bj * HALF) = w; } }
    }
};
template <class Epi, class Sched, bool ALIGN_EPI = false, bool SP2 = false>
__device__ __forceinline__ void gemm_phase(PG8_LAS unsigned char* lds, const Gemm g, const Sched& S, const Epi& E) {
    const int tid = threadIdx.x, wid = __builtin_amdgcn_readfirstlane(tid >> 6), lane = tid & 63, wr = wid >> 2, wc = wid & 3, fr = lane & 15, fq = lane >> 4;
    const int K = g.K, nt = K / BK;
    unsigned voffA[2], voffB[2];
#pragma unroll
    for (int i = 0; i < 2; ++i) { int R, C; stage_rc(tid * 16 + i * 8192, R, C); const int Rb = Epi::PERM ? ((R & ~31) + perm32(R & 31)) : R;
        voffA[i] = (unsigned)(R * K + C) * 2u; voffB[i] = (unsigned)(Rb * K + C) * 2u; }
    const size_t kstep = (size_t)(BK * 2);
    const size_t hstep = (size_t)HALF * K * 2;
    const size_t tstep = 2 * hstep;
    const unsigned ldsw = (unsigned)wid * 1024u;
    const int aoff = lds_byte(wr * 64 + fr, fq * 8), boff = lds_byte(wc * 32 + fr, fq * 8);
#define PG8_SA(b, h) (((b) * 2 + (h)) * HTB)
#define PG8_SB(b, h) ((4 + (b) * 2 + (h)) * HTB)
#define PG8_STAGE(bufoff, gbase, voff) do { _Pragma("unroll") for (int _i = 0; _i < 2; ++_i) \
        __builtin_amdgcn_global_load_lds((const unsigned*)((const char*)(gbase) + (voff)[_i]), (PG8_LAS unsigned*)(lds + (bufoff) + ldsw + _i * 8192), 16, 0, 0); } while (0)
#define PG8_LDA(dst, b, h) do { _Pragma("unroll") for (int m = 0; m < 4; ++m) _Pragma("unroll") for (int k = 0; k < 2; ++k) dst[m][k] = *(const PG8_LAS bf16x8*)(lds + PG8_SA(b, h) + aoff + m * 2048 + k * 1024); } while (0)
#define PG8_LDB(dst, b, h) do { _Pragma("unroll") for (int n = 0; n < 2; ++n) _Pragma("unroll") for (int k = 0; k < 2; ++k) dst[n][k] = *(const PG8_LAS bf16x8*)(lds + PG8_SB(b, h) + boff + n * 2048 + k * 1024); } while (0)
#define PG8_MMA(ai, bj, At, Bt) do { __builtin_amdgcn_s_setprio(1); _Pragma("unroll") for (int m = 0; m < 4; ++m) _Pragma("unroll") for (int n = 0; n < 2; ++n) _Pragma("unroll") for (int k = 0; k < 2; ++k) \
        acc[ai][bj][m][n] = __builtin_amdgcn_mfma_f32_16x16x32_bf16(Bt[n][k], At[m][k], acc[ai][bj][m][n], 0, 0, 0); __builtin_amdgcn_s_setprio(0); } while (0)
#define PG8_WAIT_V(n) asm volatile("s_waitcnt vmcnt(" #n ")" ::: "memory")
#define PG8_WAIT_L(n) asm volatile("s_waitcnt lgkmcnt(" #n ")" ::: "memory")
#define PG8_BAR __builtin_amdgcn_s_barrier()
#define PG8_SCHED __builtin_amdgcn_sched_barrier(0)
    Unit cur, nxt; int ui = 0;
    if (!S.next(0, cur)) return;
    f32x4 acc[2][2][4][2];
#pragma unroll
    for (int a = 0; a < 2; ++a)
#pragma unroll
        for (int b = 0; b < 2; ++b)
#pragma unroll
            for (int m = 0; m < 4; ++m)
#pragma unroll
                for (int n = 0; n < 2; ++n) acc[a][b][m][n] = (f32x4){0.f, 0.f, 0.f, 0.f};
    bf16x8 At[4][2], B0[2][2], B1[2][2];
    const char* cA = (const char*)g.A + (size_t)cur.pm * tstep; const char* cB = (const char*)g.Bt + (size_t)cur.pn * tstep;
    S.a_ready(cur);
    if constexpr (SP2) {
        PG8_STAGE(PG8_SB(0, 0), cB, voffB); PG8_STAGE(PG8_SB(0, 1), cB + hstep, voffB); PG8_STAGE(PG8_SA(0, 0), cA, voffA); PG8_STAGE(PG8_SA(0, 1), cA + hstep, voffA);
        if (wr == 1) PG8_BAR;
        PG8_WAIT_V(2); PG8_BAR;
        PG8_STAGE(PG8_SB(1, 0), cB + kstep, voffB); PG8_STAGE(PG8_SA(1, 0), cA + kstep, voffA); PG8_STAGE(PG8_SB(1, 1), cB + hstep + kstep, voffB);
        PG8_WAIT_V(6); PG8_BAR;
    } else {
        PG8_STAGE(PG8_SB(0, 0), cB, voffB); PG8_STAGE(PG8_SA(0, 0), cA, voffA); PG8_STAGE(PG8_SB(0, 1), cB + hstep, voffB); PG8_STAGE(PG8_SA(0, 1), cA + hstep, voffA);
        if (wr == 1) PG8_BAR;
        PG8_WAIT_V(4); PG8_BAR;
        PG8_STAGE(PG8_SB(1, 0), cB + kstep, voffB); PG8_STAGE(PG8_SA(1, 0), cA + kstep, voffA); PG8_STAGE(PG8_SB(1, 1), cB + hstep + kstep, voffB);
        PG8_WAIT_V(6); PG8_BAR;
    }
    for (;;) {
        const bool has_next = S.next(ui + 1, nxt);
        const char* nA = has_next ? (const char*)g.A + (size_t)nxt.pm * tstep : cA; const char* nB = has_next ? (const char*)g.Bt + (size_t)nxt.pn * tstep : cB;
        for (int t = 0; t < nt; t += 2) {
            const bool last = (t == nt - 2);
            const char* a1 = cA + (size_t)(t + 1) * kstep;
            const char* a2 = last ? nA : cA + (size_t)(t + 2) * kstep; const char* b2 = last ? nB : cB + (size_t)(t + 2) * kstep;
            const char* a3 = a2 + kstep; const char* b3 = b2 + kstep;
            if (last && has_next) S.a_ready(nxt);
            if constexpr (SP2) {
            PG8_LDB(B0, 0, 0); PG8_LDB(B1, 0, 1); PG8_SCHED; PG8_LDA(At, 0, 0); PG8_STAGE(PG8_SA(1, 1), a1 + hstep, voffA);
            PG8_WAIT_V(8); PG8_WAIT_L(0); PG8_BAR; PG8_MMA(0, 0, At, B0); PG8_MMA(0, 1, At, B1); PG8_BAR; PG8_SCHED;
            PG8_LDA(At, 0, 1); PG8_STAGE(PG8_SB(0, 0), b2, voffB); PG8_STAGE(PG8_SB(0, 1), b2 + hstep, voffB); PG8_STAGE(PG8_SA(0, 0), a2, voffA);
            PG8_WAIT_V(8); PG8_WAIT_L(0); PG8_BAR; PG8_MMA(1, 0, At, B0); PG8_MMA(1, 1, At, B1); PG8_BAR; PG8_SCHED;
            PG8_LDB(B0, 1, 0); PG8_LDB(B1, 1, 1); PG8_SCHED; PG8_LDA(At, 1, 0); PG8_STAGE(PG8_SA(0, 1), a2 + hstep, voffA);
            PG8_WAIT_V(8); PG8_WAIT_L(0); PG8_BAR; PG8_MMA(0, 0, At, B0); PG8_MMA(0, 1, At, B1); PG8_BAR; PG8_SCHED;
            PG8_LDA(At, 1, 1); PG8_STAGE(PG8_SB(1, 0), b3, voffB); PG8_STAGE(PG8_SB(1, 1), b3 + hstep, voffB); PG8_STAGE(PG8_SA(1, 0), a3, voffA);
            PG8_WAIT_V(8); PG8_WAIT_L(0); PG8_BAR; PG8_MMA(1, 0, At, B0); PG8_MMA(1, 1, At, B1); PG8_BAR; PG8_SCHED;
            } else {
            PG8_LDB(B0, 0, 0); PG8_SCHED; PG8_LDA(At, 0, 0); PG8_STAGE(PG8_SA(1, 1), a1 + hstep, voffA);
            PG8_WAIT_L(8); PG8_BAR; PG8_WAIT_L(0); PG8_MMA(0, 0, At, B0); PG8_BAR; PG8_SCHED;
            PG8_LDB(B1, 0, 1); PG8_STAGE(PG8_SB(0, 0), b2, voffB);
            PG8_BAR; PG8_WAIT_L(0); PG8_MMA(0, 1, At, B1); PG8_BAR;
            PG8_LDA(At, 0, 1); PG8_STAGE(PG8_SA(0, 0), a2, voffA);
            PG8_BAR; PG8_WAIT_L(0); PG8_MMA(1, 0, At, B0); PG8_BAR; PG8_SCHED;
            PG8_STAGE(PG8_SB(0, 1), b2 + hstep, voffB);
            PG8_WAIT_V(6); PG8_BAR; PG8_MMA(1, 1, At, B1); PG8_BAR;
            PG8_LDB(B0, 1, 0); PG8_SCHED; PG8_LDA(At, 1, 0); PG8_STAGE(PG8_SA(0, 1), a2 + hstep, voffA);
            PG8_WAIT_L(8); PG8_BAR; PG8_WAIT_L(0); PG8_MMA(0, 0, At, B0); PG8_BAR; PG8_SCHED;
            PG8_LDB(B1, 1, 1); PG8_STAGE(PG8_SB(1, 0), b3, voffB);
            PG8_BAR; PG8_WAIT_L(0); PG8_MMA(0, 1, At, B1); PG8_BAR;
            PG8_LDA(At, 1, 1); PG8_STAGE(PG8_SA(1, 0), a3, voffA);
            PG8_BAR; PG8_WAIT_L(0); PG8_MMA(1, 0, At, B0); PG8_BAR; PG8_SCHED;
            PG8_STAGE(PG8_SB(1, 1), b3 + hstep, voffB);
            PG8_WAIT_V(6); PG8_BAR; PG8_MMA(1, 1, At, B1); PG8_BAR;
            }
        }
        if constexpr (ALIGN_EPI) { if (wr == 0) PG8_BAR; }
        if constexpr (!Epi::AFTER_DRAIN) { E(acc, cur, wr, wc, fr, fq); S.done(cur); }
        if (!has_next) break;
#pragma unroll
        for (int a = 0; a < 2; ++a)
#pragma unroll
            for (int b = 0; b < 2; ++b)
#pragma unroll
                for (int m = 0; m < 4; ++m)
#pragma unroll
                    for (int n = 0; n < 2; ++n) acc[a][b][m][n] = (f32x4){0.f, 0.f, 0.f, 0.f};
        cur = nxt; cA = nA; cB = nB; ++ui;
        if constexpr (ALIGN_EPI) { if (wr == 1) PG8_BAR; }
    }
    PG8_WAIT_V(0);
    if constexpr (!ALIGN_EPI) { if (wr == 0) PG8_BAR; }
    PG8_BAR;
    if constexpr (Epi::AFTER_DRAIN) { E.fused(acc, cur, wr, wc, fr, fq, lds, wid, lane); S.done(cur); }
#undef PG8_SA
#undef PG8_SB
#undef PG8_STAGE
#undef PG8_LDA
#undef PG8_LDB
#undef PG8_MMA
#undef PG8_WAIT_V
#undef PG8_WAIT_L
#undef PG8_BAR
#undef PG8_SCHED
}
}

constexpr int NWAVES = 8;
constexpr int NB = 32, SEQ = 2048, DM = 1024, MROWS = NB * SEQ;
constexpr int NPROJ = 3840;
constexpr int C_ZA = 1536, C_QB = 2048, C_ZB = 2560, C_IQ = 3072, C_CKV = 3584, C_IK = 3712;
constexpr float EPSF = 1e-6f;
constexpr float LOG2E = 1.4426950408889634f;
__host__ __device__ __forceinline__ int proj_src_col(int n) {
    if (n < 2048) return n;
    if (n < 2560) return n - 2048 + 2056;
    if (n < 3072) return n - 2560 + 2696;
    if (n < 3584) return n - 3072 + 3208;
    if (n < 3712) return n - 3584 + 2568;
    if (n < 3776) return n - 3712 + 3720;
    if (n < 3784) return n - 3776 + 2048;
    if (n < 3792) return n;
    return -1;
}
__device__ const unsigned char T5_BUCKET[128] = {0,1,2,3,4,5,6,7,8,9,10,11,12,13,14,15,16,16,16,17,17,18,18,18,19,19,19,20,20,20,20,21,21,21,21,22,22,22,22,22,23,23,23,23,23,23,24,24,24,24,24,24,25,25,25,25,25,25,25,26,26,26,26,26,26,26,26,27,27,27,27,27,27,27,27,27,27,28,28,28,28,28,28,28,28,28,28,29,29,29,29,29,29,29,29,29,29,29,29,30,30,30,30,30,30,30,30,30,30,30,30,30,30,31,31,31,31,31,31,31,31,31,31,31,31,31,31,31};

constexpr size_t MiB = 1u << 20;
constexpr size_t WS_CTL = 0, CTL_ZERO_BYTES = 1 * MiB;
constexpr size_t WS_MOD = 1 * MiB;
constexpr size_t WS_WUV = 2 * MiB;
constexpr size_t WS_WOUT = 3 * MiB;
constexpr size_t WS_WIN = 5 * MiB;
constexpr size_t WS_KVSS = 13 * MiB;
constexpr size_t WS_AUX = 14 * MiB;
constexpr size_t WS_XN = 32 * MiB;
constexpr size_t WS_PROJ = 160 * MiB;
constexpr size_t WS_SCR = 640 * MiB;
constexpr size_t WS_END = 768 * MiB;
constexpr int CW_TMO = 0, CW_QUEUE = 64, CW_BAR = 4096;

constexpr int LDS_BYTES = 163840;
constexpr int MISC_OFF = LDS_BYTES - 256;
constexpr int SCRATCH_BYTES = MISC_OFF;

#define GAS __attribute__((address_space(1)))
#define LAS __attribute__((address_space(3)))
typedef unsigned short bf16;
typedef unsigned v4u __attribute__((ext_vector_type(4)));
typedef unsigned v2u __attribute__((ext_vector_type(2)));
typedef float f32x4 __attribute__((ext_vector_type(4)));
typedef float f32x16 __attribute__((ext_vector_type(16)));
typedef short bf16x8 __attribute__((ext_vector_type(8)));
typedef GAS unsigned gu32;
#define RLX_AGENT __ATOMIC_RELAXED, __HIP_MEMORY_SCOPE_AGENT
#define LDS_WAIT() asm volatile("s_waitcnt lgkmcnt(0)" ::: "memory")
#define MFMA32(a, b, c) __builtin_amdgcn_mfma_f32_32x32x16_bf16((a), (b), (c), 0, 0, 0)
#define MFMA16F(a, b, c) __builtin_amdgcn_mfma_f32_16x16x4f32((a), (b), (c), 0, 0, 0)
__device__ __forceinline__ unsigned f2bf(float f) { unsigned u = __builtin_bit_cast(unsigned, f); return (u + 0x7fffu + ((u >> 16) & 1u)) >> 16; }
__device__ __forceinline__ unsigned pk2(float lo, float hi) { return f2bf(lo) | (f2bf(hi) << 16); }
__device__ __forceinline__ float bf2f(unsigned short b) { return __builtin_bit_cast(float, ((unsigned)b) << 16); }
__device__ __forceinline__ float bflo(unsigned w) { return __builtin_bit_cast(float, w << 16); }
__device__ __forceinline__ float bfhi(unsigned w) { return __builtin_bit_cast(float, w & 0xffff0000u); }
__device__ __forceinline__ float rcpf_(float x) { return __builtin_amdgcn_rcpf(x); }
__device__ __forceinline__ float rsqf_(float x) { return __builtin_amdgcn_rsqf(x); }
__device__ __forceinline__ float siluf(float x) { return x * __builtin_amdgcn_rcpf(1.0f + __builtin_amdgcn_exp2f(-1.4426950408889634f * x)); }
__device__ __forceinline__ float wave_sum(float v) {
#pragma unroll
    for (int o = 1; o < 64; o <<= 1) v += __shfl_xor(v, o);
    return v;
}

__device__ __forceinline__ int wave_sum_i(int v) {
    v += __builtin_amdgcn_update_dpp(0, v, 0x111, 0xf, 0xf, false);
    v += __builtin_amdgcn_update_dpp(0, v, 0x112, 0xf, 0xf, false);
    v += __builtin_amdgcn_update_dpp(0, v, 0x114, 0xf, 0xe, false);
    v += __builtin_amdgcn_update_dpp(0, v, 0x118, 0xf, 0xc, false);
    v += __builtin_amdgcn_update_dpp(0, v, 0x142, 0xa, 0xf, false);
    v += __builtin_amdgcn_update_dpp(0, v, 0x143, 0xc, 0xf, false);
    return __builtin_amdgcn_readlane(v, 63);
}
__device__ __forceinline__ float wave_max(float v) {
    const int ninf = (int)0xff800000u;
#define WM_STEP(ctrl, rm, bm) v = fmaxf(v, __builtin_bit_cast(float, __builtin_amdgcn_update_dpp(ninf, __builtin_bit_cast(int, v), ctrl, rm, bm, false)))
    WM_STEP(0x111, 0xf, 0xf); WM_STEP(0x112, 0xf, 0xf); WM_STEP(0x114, 0xf, 0xe); WM_STEP(0x118, 0xf, 0xc); WM_STEP(0x142, 0xa, 0xf); WM_STEP(0x143, 0xc, 0xf);
#undef WM_STEP
    return __builtin_bit_cast(float, __builtin_amdgcn_readlane(__builtin_bit_cast(int, v), 63));
}
#define XB_TMO      128
#define XB_XCNT(j)  (256  + 64 * (j))
#define XB_XSUB(j)  (1280 + 64 * (j))
#define XB_XGEN(j)  (2304 + 64 * (j))
#define XB_TOP      3328
#define XB_TOPGEN   3392
#define XCD_BAR_WORDS 3456
#define XB_SPIN_CAP (1u << 18)

__device__ __forceinline__ unsigned xb_ld(unsigned* p)              { return __hip_atomic_load(p, __ATOMIC_RELAXED, __HIP_MEMORY_SCOPE_AGENT); }
__device__ __forceinline__ unsigned xb_add(unsigned* p, unsigned v) { return __hip_atomic_fetch_add(p, v, __ATOMIC_RELAXED, __HIP_MEMORY_SCOPE_AGENT); }
__device__ __forceinline__ unsigned xb_xcc_id() { return (unsigned)__builtin_amdgcn_s_getreg((3 << 11) | 20) & 0xFu; }
#define XB_SPIN(cond, bar) do { unsigned _sp = 0; while (cond) { __builtin_amdgcn_s_sleep(1); \
    if ((++_sp & 255u) == 0u) { if (xb_ld(&(bar)[XB_TMO])) break; if (_sp > XB_SPIN_CAP) { atomicAdd(&(bar)[XB_TMO], 1u); break; } } } } while (0)

struct XcdBarrier {
    unsigned* bar; unsigned x;
    volatile LAS unsigned* st;
};

__device__ __forceinline__ XcdBarrier xcd_barrier_post(unsigned* bar, volatile LAS unsigned* st) {
    XcdBarrier b; b.bar = bar; b.x = xb_xcc_id(); b.st = st;
    if (threadIdx.x == 0) (void)xb_add(&bar[XB_XCNT(b.x)], 1u);
    return b;
}
__device__ __forceinline__ void xcd_barrier_complete(unsigned* bar, unsigned x, unsigned& nloc, unsigned& nx) {
    const unsigned G = gridDim.x * gridDim.y * gridDim.z;
    unsigned sum, cnt, mine, sp = 0u;
    for (;;) {
        sum = 0u; cnt = 0u; mine = 0u;
#pragma unroll
        for (unsigned j = 0; j < 16; ++j) { const unsigned c = xb_ld(&bar[XB_XCNT(j)]); sum += c; cnt += (c > 0u) ? 1u : 0u; mine = (j == x) ? c : mine; }
        if (sum == G) break;
        __builtin_amdgcn_s_sleep(1);
        if ((++sp & 255u) == 0u) { if (xb_ld(&bar[XB_TMO])) break; if (sp > XB_SPIN_CAP) { atomicAdd(&bar[XB_TMO], 1u); break; } }
    }
    nloc = mine > 0u ? mine : 1u; nx = cnt > 0u ? cnt : 1u;
}

__device__ __forceinline__ void xcd_barrier(const XcdBarrier& b) {
    asm volatile("s_waitcnt vmcnt(0)" ::: "memory");
    __syncthreads();
    if (threadIdx.x == 0) {
        unsigned* bar = b.bar;
        __builtin_amdgcn_s_waitcnt(0);
        unsigned nloc = b.st[0], nx = b.st[1];
        if (nloc == 0u) { xcd_barrier_complete(bar, b.x, nloc, nx); b.st[0] = nloc; b.st[1] = nx; }
        const unsigned old = xb_add(&bar[XB_XSUB(b.x)], 1u);
        const unsigned gen = old / nloc;
        if (old + 1u == (gen + 1u) * nloc) {
            __builtin_amdgcn_fence(__ATOMIC_RELEASE, "agent");
            asm volatile("s_waitcnt vmcnt(0)" ::: "memory");
            const unsigned og = xb_add(&bar[XB_TOP], 1u);
            const unsigned tg = og / nx;
            if (og + 1u == (tg + 1u) * nx) xb_add(&bar[XB_TOPGEN], 1u);
            else XB_SPIN(xb_ld(&bar[XB_TOPGEN]) == tg, bar);
            __builtin_amdgcn_fence(__ATOMIC_ACQUIRE, "agent");
            xb_add(&bar[XB_XGEN(b.x)], 1u);
            asm volatile("s_waitcnt vmcnt(0)" ::: "memory");
        } else {
            XB_SPIN(xb_ld(&bar[XB_XGEN(b.x)]) == gen, bar);
            __builtin_amdgcn_fence(__ATOMIC_ACQUIRE, "agent");
            asm volatile("s_waitcnt vmcnt(0)" ::: "memory");
        }
    }
    __syncthreads();
}

struct Frame {
    LAS unsigned char* lds;
    volatile LAS unsigned* MISC;
    gu32* ctl;
    int tid, lane, wave;
    int vcu, G;
    unsigned char* ws;
};
#define P_X        (args.in[0])
#define P_C        (args.in[1])
#define P_WADA     (args.in[2])
#define P_BADA     (args.in[3])
#define P_GPRE     (args.in[4])
#define P_WIN      (args.in[5])
#define P_CONVW    (args.in[6])
#define P_ALOG     (args.in[7])
#define P_DTB      (args.in[8])
#define P_GGDN     (args.in[9])
#define P_GKV      (args.in[10])
#define P_WUV      (args.in[11])
#define P_RELB     (args.in[12])
#define P_WOUT     (args.in[13])
#define P_GPOST    (args.in[14])
#define P_OUT      (args.out)
#define W_MOD      ((float*)(F.ws + WS_MOD))
#define W_WUVT     ((bf16*)(F.ws + WS_WUV))
#define W_WOUTT    ((bf16*)(F.ws + WS_WOUT))
#define W_WINT     ((bf16*)(F.ws + WS_WIN))
#define W_KVSS     ((float*)(F.ws + WS_KVSS))
#define W_AUX      ((float*)(F.ws + WS_AUX))
#define W_XN       ((bf16*)(F.ws + WS_XN))
#define W_OAB      ((bf16*)(F.ws + WS_XN))
#define W_PROJ     ((bf16*)(F.ws + WS_PROJ))
#define W_MIX      ((bf16*)(F.ws + WS_PROJ))
#define W_SCR      ((float*)(F.ws + WS_SCR))
struct Args { const float* in[15]; float* out; unsigned char* ws; int ph_lo, ph_hi, li, pad; };

template <class CM>
__device__ __forceinline__ void transpose_item(const float* W, int ldw, bf16* WT, int K, int k0, int n0, LAS float* scr, int lane, CM cm) {
    const int nn = lane & 31, sc = cm(n0 + nn);
#pragma unroll 8
    for (int i = 0; i < 32; ++i) { const int kk = 2 * i + (lane >> 5); scr[kk * 33 + nn] = sc >= 0 ? W[(size_t)(k0 + kk) * ldw + sc] : 0.f; }
    LDS_WAIT(); asm volatile("" ::: "memory");
    const int c = lane & 7;
#pragma unroll
    for (int j = 0; j < 4; ++j) { const int n = (lane >> 3) + 8 * j; const LAS float* s = scr + (8 * c) * 33 + n;
        v4u o; o.x = pk2(s[0 * 33], s[1 * 33]); o.y = pk2(s[2 * 33], s[3 * 33]); o.z = pk2(s[4 * 33], s[5 * 33]); o.w = pk2(s[6 * 33], s[7 * 33]);
        *(GAS v4u*)(WT + (size_t)(n0 + n) * K + k0 + 8 * c) = o; }
    LDS_WAIT(); asm volatile("" ::: "memory");
}
struct CmIdent { __device__ __forceinline__ int operator()(int n) const { return n; } };
struct CmProj { __device__ __forceinline__ int operator()(int n) const { return proj_src_col(n); } };

__device__ __forceinline__ void p0_prologue(Frame& F, const Args& args) {
    LAS float* scr = (LAS float*)(F.lds + F.wave * 16384);
    const int gw = F.vcu * NWAVES + F.wave, NGW = F.G * NWAVES;
    constexpr int I_IN = 16 * (NPROJ / 32), I_OUT = 16 * 32, I_UV = 4 * 2 * 4;
    for (int it = gw; it < I_IN + I_OUT + I_UV; it += NGW) {
        int r = it;
        if (r < I_IN) { const int kb = r / (NPROJ / 32), nb = r % (NPROJ / 32); transpose_item(P_WIN, 3792, W_WINT, 1024, 64 * kb, 32 * nb, scr, F.lane, CmProj()); continue; }
        r -= I_IN;
        if (r < I_OUT) { const int kb = r / 32, nb = r % 32; transpose_item(P_WOUT, 1024, W_WOUTT, 1024, 64 * kb, 32 * nb, scr, F.lane, CmIdent()); continue; }
        r -= I_OUT;
        { const int hd = r >> 3, kb = (r >> 2) & 1, nb = r & 3; transpose_item(P_WUV + (size_t)hd * 16384, 128, W_WUVT + (size_t)hd * 16384, 128, 64 * kb, 32 * nb, scr, F.lane, CmIdent()); }
    }
    __syncthreads();
    if (F.vcu < 192) {
        LAS float* SC = (LAS float*)F.lds;
        for (int e = F.tid; e < NB * 1024; e += NWAVES * 64) { const int b = e >> 10, k = e & 1023; SC[k * 33 + b] = siluf(P_C[e]); }
        __syncthreads();
        const int col = F.tid & 15, ks = F.tid >> 4, n = F.vcu * 16 + col;
        float acc[32];
#pragma unroll
        for (int b = 0; b < 32; ++b) acc[b] = 0.f;
        for (int kk = 0; kk < 32; ++kk) { const int k = ks * 32 + kk; const float w = P_WADA[(size_t)k * 3072 + n];
#pragma unroll
            for (int b = 0; b < 32; ++b) acc[b] += SC[k * 33 + b] * w; }
        __syncthreads();
        LAS float* RED = (LAS float*)F.lds;
#pragma unroll
        for (int b = 0; b < 32; ++b) RED[(ks * 32 + b) * 16 + col] = acc[b];
        __syncthreads();
        { const int b = F.tid >> 4; float s = 0.f;
            for (int k2 = 0; k2 < 32; ++k2) s += RED[(k2 * 32 + b) * 16 + col];
            W_MOD[b * 3072 + n] = s + P_BADA[n]; }
        __syncthreads();
    }
}

__device__ __forceinline__ void p1_norm(Frame& F, const Args& args) {
    const int gw = F.vcu * NWAVES + F.wave, NGW = F.G * NWAVES;
    for (int m = 2 * gw; m < MROWS; m += 2 * NGW) {
        const int b = m >> 11;
        const GAS f32x4* xr = (const GAS f32x4*)(P_X + (size_t)m * DM) + F.lane;
        f32x4 v[2][4]; float ss[2] = {0.f, 0.f};
#pragma unroll
        for (int q = 0; q < 2; ++q)
#pragma unroll
            for (int j = 0; j < 4; ++j) v[q][j] = xr[q * 256 + 64 * j];
#pragma unroll
        for (int q = 0; q < 2; ++q)
#pragma unroll
            for (int j = 0; j < 4; ++j) ss[q] += (v[q][j].x * v[q][j].x + v[q][j].y * v[q][j].y) + (v[q][j].z * v[q][j].z + v[q][j].w * v[q][j].w);
        const float rstd0 = rsqf_(wave_sum(ss[0]) * (1.0f / DM) + EPSF), rstd1 = rsqf_(wave_sum(ss[1]) * (1.0f / DM) + EPSF);
        const float* mb = W_MOD + b * 3072;
        GAS unsigned long long* o8 = (GAS unsigned long long*)(W_XN + (size_t)m * DM) + F.lane;
#pragma unroll
        for (int j = 0; j < 4; ++j) { const int col = F.lane * 4 + 256 * j;
            const f32x4 g = *(const f32x4*)(P_GPRE + col), sh = *(const f32x4*)(mb + col), sc = *(const f32x4*)(mb + 1024 + col);
            const f32x4 gs = g * (sc + 1.0f);
            const f32x4 o0 = v[0][j] * rstd0 * gs + sh, o1 = v[1][j] * rstd1 * gs + sh;
            o8[64 * j] = (unsigned long long)pg8::cvt_pk_bf16(o0.x, o0.y) | ((unsigned long long)pg8::cvt_pk_bf16(o0.z, o0.w) << 32);
            o8[256 + 64 * j] = (unsigned long long)pg8::cvt_pk_bf16(o1.x, o1.y) | ((unsigned long long)pg8::cvt_pk_bf16(o1.z, o1.w) << 32); }
    }
}

__device__ __forceinline__ void p5_final(Frame& F, const Args& args) {
    const int gw = F.vcu * NWAVES + F.wave, NGW = F.G * NWAVES;
    for (int m = 2 * gw; m < MROWS; m += 2 * NGW) {
        const int b = m >> 11;
        const GAS v2u* mr = (const GAS v2u*)(W_MIX + (size_t)m * DM) + F.lane;
        const GAS f32x4* xr = (const GAS f32x4*)(P_X + (size_t)m * DM) + F.lane;
        GAS f32x4* orow = (GAS f32x4*)(P_OUT + (size_t)m * DM) + F.lane;
        v2u w[2][4]; f32x4 xv[2][4];
#pragma unroll
        for (int q = 0; q < 2; ++q)
#pragma unroll
            for (int j = 0; j < 4; ++j) { w[q][j] = mr[q * 256 + 64 * j]; xv[q][j] = xr[q * 256 + 64 * j]; }
        f32x4 v[2][4]; float ss[2] = {0.f, 0.f};
#pragma unroll
        for (int q = 0; q < 2; ++q)
#pragma unroll
            for (int j = 0; j < 4; ++j) { v[q][j].x = bflo(w[q][j].x); v[q][j].y = bfhi(w[q][j].x); v[q][j].z = bflo(w[q][j].y); v[q][j].w = bfhi(w[q][j].y);
                ss[q] += (v[q][j].x * v[q][j].x + v[q][j].y * v[q][j].y) + (v[q][j].z * v[q][j].z + v[q][j].w * v[q][j].w); }
        const float rstd0 = rsqf_(wave_sum(ss[0]) * (1.0f / DM) + EPSF), rstd1 = rsqf_(wave_sum(ss[1]) * (1.0f / DM) + EPSF);
        const float* gt = W_MOD + b * 3072 + 2048;
#pragma unroll
        for (int j = 0; j < 4; ++j) { const int col = F.lane * 4 + 256 * j;
            const f32x4 g = *(const f32x4*)(P_GPOST + col), ga = *(const f32x4*)(gt + col);
            const f32x4 gg = g * ga;
            orow[64 * j] = xv[0][j] + gg * (v[0][j] * rstd0);
            orow[256 + 64 * j] = xv[1][j] + gg * (v[1][j] * rstd1); }
    }
}

__device__ __forceinline__ unsigned cvtpk(float lo, float hi) { return pg8::cvt_pk_bf16(lo, hi); }
__device__ __forceinline__ v2u pack4(float a, float b, float c, float d) { v2u r; r.x = cvtpk(a, b); r.y = cvtpk(c, d); return r; }
__device__ __forceinline__ bf16x8 pack8(float a, float b, float c, float d, float e, float f, float g, float h) { v4u r; r.x = cvtpk(a, b); r.y = cvtpk(c, d); r.z = cvtpk(e, f); r.w = cvtpk(g, h); return __builtin_bit_cast(bf16x8, r); }
__device__ __forceinline__ bf16x8 lds16(const LAS unsigned char* p) { return *(const LAS bf16x8*)p; }
__device__ __forceinline__ bf16x8 lds8x2(const LAS unsigned char* p) { const v2u lo = *(const LAS v2u*)p, hi = *(const LAS v2u*)(p + 16); v4u r; r.x = lo.x; r.y = lo.y; r.z = hi.x; r.w = hi.y; return __builtin_bit_cast(bf16x8, r); }
template <int S> __device__ __forceinline__ bf16x8 acc_frag(const f32x16& a) { return pack8(a[8 * S + 0], a[8 * S + 1], a[8 * S + 2], a[8 * S + 3], a[8 * S + 4], a[8 * S + 5], a[8 * S + 6], a[8 * S + 7]); }

__device__ __forceinline__ float row16_sum(float v) {
#define R16_STEP(ctrl) v += __builtin_bit_cast(float, __builtin_amdgcn_update_dpp(0, __builtin_bit_cast(int, v), ctrl, 0xf, 0xf, false))
    R16_STEP(0x121); R16_STEP(0x122); R16_STEP(0x124); R16_STEP(0x128);
#undef R16_STEP
    return v;
}

__device__ __forceinline__ void gdn_unit(Frame& F, const Args& args, const int b, const int h) {
    LAS unsigned char* const L = F.lds;
    const int tid = F.tid, lane = F.lane, wv = F.wave, l31_0 = lane & 31, hh_0 = lane >> 5;
    int tidv = tid, lanev = lane;
    constexpr int P128 = 272, P64 = 144;
    constexpr int O_KH = 0, O_QH = O_KH + 17408, O_KGT = O_QH + 17408, O_VBT = O_KGT + 18432, O_KBGT = O_VBT + 18432, O_LM = O_KBGT + 18432, O_T = O_LM + 17408,
                  O_AT = O_T + 17408, O_CW = O_AT + 9216, O_SM = O_CW + 6144, O_PSO = O_SM + 2560, O_OF = O_PSO + 2048, O_END = O_OF + 17408;
    static_assert(O_END <= SCRATCH_BYTES, "gdn LDS map");
    constexpr int O_W = O_LM, O_VNT = O_VBT;
    LAS float* const SMb = (LAS float*)(L + O_SM);
    LAS float* const LM = (LAS float*)(L + O_LM);
    LAS float* const TT = (LAS float*)(L + O_T);
    LAS float* const CW = (LAS float*)(L + O_CW);
    LAS float* const PSO = (LAS float*)(L + O_PSO);
    const int mt = wv >> 2, nt = wv & 3;
    f32x16 S[4];
#pragma unroll
    for (int k = 0; k < 4; ++k)
#pragma unroll
        for (int r = 0; r < 16; ++r) S[k][r] = 0.f;
    const float alog_e = __expf(P_ALOG[h]), dtb = P_DTB[h];
#define GDN_GATES(n_) do { LAS float* _sm = SMb + ((n_) & 1) * 320; const float* _ap = W_AUX + (size_t)(b * SEQ + (n_) * 64 + lanev) * 16; \
        const float _bb = _ap[h], _aa = _ap[4 + h]; const float _beta = rcpf_(1.0f + __expf(-_bb)); const float _xs = _aa + dtb; \
        const float _sp = _xs > 20.f ? _xs : log1pf(__expf(_xs)); float _gc = -alog_e * _sp; \
        _Pragma("unroll") for (int _o = 1; _o < 64; _o <<= 1) { const float _t = __shfl_up(_gc, _o); if (lanev >= _o) _gc += _t; } \
        const float _gl = __shfl(_gc, 63); _sm[lanev] = _gc; _sm[64 + lanev] = _beta; _sm[128 + lanev] = __expf(_gc); _sm[192 + lanev] = __expf(_gl - _gc); \
        if (lanev == 0) _sm[256] = __expf(_gl); } while (0)
    if (wv == 6) GDN_GATES(0);
    for (int e = tidv; e < 3 * 4 * 128; e += NWAVES * 64) { const int ts_ = e >> 9, tap = (e >> 7) & 3, ch = e & 127; CW[e] = P_CONVW[tap * 1536 + ts_ * 512 + h * 128 + ch]; }
    const int ts = tid >> 8;
    int cgv = tid & 15, tpv = (tid >> 4) & 15;
#define GDN_ROWS(dst_, n_, chan_) do { const bf16* _src = W_PROJ + (size_t)(b * SEQ + (n_) * 64 + 4 * tpv - 3) * NPROJ + (chan_); \
        _Pragma("unroll") for (int _i = 0; _i < 7; ++_i) { v4u _z; _z.x = 0u; _z.y = 0u; _z.z = 0u; _z.w = 0u; dst_[_i] = _z; \
            if ((n_) > 0 || 4 * tpv - 3 + _i >= 0) dst_[_i] = *(const GAS v4u*)(_src + (size_t)_i * NPROJ); } } while (0)
#define GDN_OUT(rowb_) do { const int _tok = tidv >> 3, _dv0 = (tidv & 7) * 16; const size_t _row = (size_t)(rowb_) + _tok; \
        const LAS v4u* _op = (const LAS v4u*)(L + O_OF + _tok * P128 + _dv0 * 2); const v4u _o0 = _op[0], _o1 = _op[1]; \
        const LAS f32x4* _pp = (const LAS f32x4*)(PSO + _tok * 8); const f32x4 _a = _pp[0], _c = _pp[1]; \
        const float _rstd = rsqf_((((_a.x + _a.y) + (_a.z + _a.w)) + ((_c.x + _c.y) + (_c.z + _c.w))) * (1.0f / 128.0f) + EPSF); \
        const bf16* _zp = W_PROJ + _row * NPROJ + C_ZA + h * 128 + _dv0; const v4u _z0 = *(const GAS v4u*)_zp, _z1 = *(const GAS v4u*)(_zp + 8); \
        const unsigned _ow[8] = {_o0.x, _o0.y, _o0.z, _o0.w, _o1.x, _o1.y, _o1.z, _o1.w}, _zw[8] = {_z0.x, _z0.y, _z0.z, _z0.w, _z1.x, _z1.y, _z1.z, _z1.w}; unsigned _rw[8]; \
        _Pragma("unroll") for (int _k = 0; _k < 4; ++_k) { const f32x4 _g = *(const f32x4*)(P_GGDN + _dv0 + 4 * _k); \
            _rw[2 * _k] = cvtpk(bflo(_ow[2 * _k]) * _rstd * _g.x * siluf(bflo(_zw[2 * _k])), bfhi(_ow[2 * _k]) * _rstd * _g.y * siluf(bfhi(_zw[2 * _k]))); \
            _rw[2 * _k + 1] = cvtpk(bflo(_ow[2 * _k + 1]) * _rstd * _g.z * siluf(bflo(_zw[2 * _k + 1])), bfhi(_ow[2 * _k + 1]) * _rstd * _g.w * siluf(bfhi(_zw[2 * _k + 1]))); } \
        bf16* _dst = W_OAB + _row * DM + h * 128 + _dv0; v4u _w0, _w1; _w0.x = _rw[0]; _w0.y = _rw[1]; _w0.z = _rw[2]; _w0.w = _rw[3]; _w1.x = _rw[4]; _w1.y = _rw[5]; _w1.z = _rw[6]; _w1.w = _rw[7]; \
        *(GAS v4u*)_dst = _w0; *(GAS v4u*)(_dst + 8) = _w1; } while (0)
    __syncthreads();

    unsigned pf_sink = 0u;
    for (int n = 0; n < 32; ++n) {
        const int rowbase = b * SEQ + n * 64;
        LAS float* const SMf = SMb + (n & 1) * 320;
        tidv = tid; lanev = lane; cgv = tid & 15; tpv = (tid >> 4) & 15;
        asm volatile("" : "+v"(tidv), "+v"(lanev), "+v"(cgv), "+v"(tpv));
        int l31 = lanev & 31, hh = lanev >> 5, cg = cgv, tp = tpv;
        if (wv == 6 && n + 1 < 32) GDN_GATES(n + 1);
        float val[4][8];
#define GDN_CONV(rows_, tsel_) do { \
            _Pragma("unroll") for (int _j = 0; _j < 4; ++_j) _Pragma("unroll") for (int _e = 0; _e < 8; ++_e) val[_j][_e] = 0.f; \
            _Pragma("unroll") for (int _tap = 0; _tap < 4; ++_tap) { const LAS f32x4* _cp = (const LAS f32x4*)(CW + ((tsel_) * 4 + _tap) * 128 + cg * 8); const f32x4 _c0 = _cp[0], _c1 = _cp[1]; \
                const float _cw[8] = {_c0.x, _c0.y, _c0.z, _c0.w, _c1.x, _c1.y, _c1.z, _c1.w}; \
                _Pragma("unroll") for (int _j = 0; _j < 4; ++_j) { const v4u _raw = rows_[_j + _tap]; \
                    const float _in[8] = {bflo(_raw.x), bfhi(_raw.x), bflo(_raw.y), bfhi(_raw.y), bflo(_raw.z), bfhi(_raw.z), bflo(_raw.w), bfhi(_raw.w)}; \
                    _Pragma("unroll") for (int _e = 0; _e < 8; ++_e) val[_j][_e] += _in[_e] * _cw[_e]; } } \
            _Pragma("unroll") for (int _j = 0; _j < 4; ++_j) _Pragma("unroll") for (int _e = 0; _e < 8; ++_e) val[_j][_e] = siluf(val[_j][_e]); } while (0)
        v4u rq[7], rv[7];
        GDN_ROWS(rq, n, ts * 512 + h * 128 + cgv * 8);
        if (wv < 4) GDN_ROWS(rv, n, 1024 + h * 128 + cgv * 8);
        if (wv == 7 && n + 1 < 32) {
#pragma unroll
            for (int i = 0; i < 9; ++i) { const int idx = i * 64 + lanev; const int rr = idx >> 3, ln = idx & 7;
                if (idx < 67 * 8) { const bf16* pt = W_PROJ + (size_t)(rowbase + 61 + rr) * NPROJ + (ln >> 1) * 512 + h * 128 + (ln & 1) * 64;
                    asm volatile("global_load_dword %0, %1, off" : "+v"(pf_sink) : "v"(pt) : "memory"); } }
        }
        {
            GDN_CONV(rq, ts);
#pragma unroll
            for (int j = 0; j < 4; ++j) { float ss = 0.f;
#pragma unroll
                for (int e = 0; e < 8; ++e) ss += val[j][e] * val[j][e];
                ss = row16_sum(ss);
                float r = rsqf_(ss + EPSF); if (ts == 0) r *= 0.08838834764831845f;
#pragma unroll
                for (int e = 0; e < 8; ++e) val[j][e] *= r; }
            if (ts == 0) {
#pragma unroll
                for (int j = 0; j < 4; ++j) *(LAS bf16x8*)(L + O_QH + (4 * tp + j) * P128 + cg * 16) = pack8(val[j][0], val[j][1], val[j][2], val[j][3], val[j][4], val[j][5], val[j][6], val[j][7]);
            } else {
                float ek[4], bg[4];
#pragma unroll
                for (int j = 0; j < 4; ++j) { ek[j] = SMf[192 + 4 * tp + j]; bg[j] = SMf[64 + 4 * tp + j] * SMf[128 + 4 * tp + j]; }
#pragma unroll
                for (int j = 0; j < 4; ++j) *(LAS bf16x8*)(L + O_KH + (4 * tp + j) * P128 + cg * 16) = pack8(val[j][0], val[j][1], val[j][2], val[j][3], val[j][4], val[j][5], val[j][6], val[j][7]);
#pragma unroll
                for (int e = 0; e < 8; ++e) {
                    *(LAS v2u*)(L + O_KGT + (cg * 8 + e) * P64 + tp * 8) = pack4(val[0][e] * ek[0], val[1][e] * ek[1], val[2][e] * ek[2], val[3][e] * ek[3]);
                    *(LAS v2u*)(L + O_KBGT + (cg * 8 + e) * P64 + tp * 8) = pack4(val[0][e] * bg[0], val[1][e] * bg[1], val[2][e] * bg[2], val[3][e] * bg[3]); }
            }
        }
        if (n > 0) GDN_OUT(rowbase - 64);
        if (wv < 4) {
            GDN_CONV(rv, 2);
            float be[4];
#pragma unroll
            for (int j = 0; j < 4; ++j) be[j] = SMf[64 + 4 * tp + j];
#pragma unroll
            for (int e = 0; e < 8; ++e) *(LAS v2u*)(L + O_VBT + (cg * 8 + e) * P64 + tp * 8) = pack4(val[0][e] * be[0], val[1][e] * be[1], val[2][e] * be[2], val[3][e] * be[3]);
        }
        for (int e = tidv; e < 64 * 68; e += NWAVES * 64) TT[e] = 0.f;
        __syncthreads();
        if (wv < 4) {
            const int ti = wv >> 1, tj = wv & 1;
            f32x16 C;
#pragma unroll
            for (int r = 0; r < 16; ++r) C[r] = 0.f;
            if (ti >= tj) {
#pragma unroll
                for (int s = 0; s < 8; ++s) C = MFMA32(lds16(L + O_KH + (32 * ti + l31) * P128 + (16 * s + 8 * hh) * 2), lds16(L + O_KH + (32 * tj + l31) * P128 + (16 * s + 8 * hh) * 2), C);
            }
            const int j = 32 * tj + l31; const float gcj = SMf[j];
#pragma unroll
            for (int g = 0; g < 4; ++g) { const int ib = 32 * ti + 8 * g + 4 * hh; const f32x4 gci = *(const LAS f32x4*)(SMf + ib), bei = *(const LAS f32x4*)(SMf + 64 + ib);
#pragma unroll
                for (int e = 0; e < 4; ++e) { const int i = ib + e; LM[i * 68 + j] = (i > j) ? bei[e] * C[4 * g + e] * __expf(gci[e] - gcj) : 0.f; } }
        } else {
            const int w4 = wv - 4, tj = w4 >> 1, ti = w4 & 1;
            f32x16 C;
#pragma unroll
            for (int r = 0; r < 16; ++r) C[r] = 0.f;
            if (ti >= tj) {
#pragma unroll
                for (int s = 0; s < 8; ++s) C = MFMA32(lds16(L + O_KH + (32 * tj + l31) * P128 + (16 * s + 8 * hh) * 2), lds16(L + O_QH + (32 * ti + l31) * P128 + (16 * s + 8 * hh) * 2), C);
            }
            const int i = 32 * ti + l31; const float gci = SMf[i];
#pragma unroll
            for (int g = 0; g < 4; ++g) { const int jb = 32 * tj + 8 * g + 4 * hh; const f32x4 gcj = *(const LAS f32x4*)(SMf + jb); float v[4];
#pragma unroll
                for (int e = 0; e < 4; ++e) v[e] = (i >= jb + e) ? C[4 * g + e] * __expf(gci - gcj[e]) : 0.f;
                *(LAS v2u*)(L + O_AT + i * P64 + jb * 2) = pack4(v[0], v[1], v[2], v[3]); }
        }
        __syncthreads();
        if (wv < 2) {
            const int a = 2 * wv, bq = 2 * wv + 1;
            if (lanev < 32) {
                const int blk = a + (lanev >> 4), c = lanev & 15; float x[16];
#pragma unroll
                for (int i = 0; i < 16; ++i) { const LAS float* lr = LM + (16 * blk + i) * 68 + 16 * blk; float acc = (i == c) ? 1.f : 0.f;
#pragma unroll
                    for (int j = 0; j < i; ++j) acc -= lr[j] * x[j];
                    x[i] = acc; TT[(16 * blk + i) * 68 + 16 * blk + c] = acc; }
            }
            asm volatile("s_waitcnt lgkmcnt(0)" ::: "memory");
            const int m = lanev & 15, q = lanev >> 4;
            f32x4 P = {0.f, 0.f, 0.f, 0.f}, R = {0.f, 0.f, 0.f, 0.f};
#pragma unroll
            for (int s = 0; s < 4; ++s) { const int k = q + 4 * s; P = MFMA16F(LM[(16 * bq + m) * 68 + 16 * a + k], TT[(16 * a + k) * 68 + 16 * a + m], P); }
#pragma unroll
            for (int rg = 0; rg < 4; ++rg) { const int k = 4 * q + rg; R = MFMA16F(TT[(16 * bq + m) * 68 + 16 * bq + k], P[rg], R); }
#pragma unroll
            for (int rg = 0; rg < 4; ++rg) TT[(16 * bq + 4 * q + rg) * 68 + 16 * a + m] = -R[rg];
        }
        __syncthreads();
        if (wv < 4) {
            const int m = lanev & 15, q = lanev >> 4, mi = wv >> 1, ni = wv & 1;
            f32x4 P0 = {0.f, 0.f, 0.f, 0.f}, P1 = {0.f, 0.f, 0.f, 0.f}, R = {0.f, 0.f, 0.f, 0.f};
#pragma unroll
            for (int s = 0; s < 8; ++s) { const int k = q + 4 * s; const float bt = TT[k * 68 + 16 * ni + m];
                P0 = MFMA16F(LM[(32 + m) * 68 + k], bt, P0); P1 = MFMA16F(LM[(48 + m) * 68 + k], bt, P1); }
#pragma unroll
            for (int rg = 0; rg < 4; ++rg) { R = MFMA16F(TT[(32 + 16 * mi + m) * 68 + 32 + 4 * q + rg], P0[rg], R); R = MFMA16F(TT[(32 + 16 * mi + m) * 68 + 48 + 4 * q + rg], P1[rg], R); }
#pragma unroll
            for (int rg = 0; rg < 4; ++rg) TT[(32 + 16 * mi + 4 * q + rg) * 68 + 16 * ni + m] = -R[rg];
        }
        __syncthreads();
        f32x16 U, WT_;
#pragma unroll
        for (int r = 0; r < 16; ++r) { U[r] = 0.f; WT_[r] = 0.f; }
#pragma unroll
        for (int s = 0; s < 4; ++s) { const LAS f32x4* tp4 = (const LAS f32x4*)(TT + (32 * mt + l31) * 68 + 16 * s + 8 * hh); const f32x4 t0 = tp4[0], t1 = tp4[1];
            const bf16x8 a = pack8(t0.x, t0.y, t0.z, t0.w, t1.x, t1.y, t1.z, t1.w);
            U = MFMA32(a, lds16(L + O_VBT + (32 * nt + l31) * P64 + (16 * s + 8 * hh) * 2), U);
            WT_ = MFMA32(lds16(L + O_KBGT + (32 * nt + l31) * P64 + (16 * s + 8 * hh) * 2), a, WT_); }
#pragma unroll
        for (int g = 0; g < 4; ++g) *(LAS v2u*)(L + O_W + (32 * mt + l31) * P128 + (32 * nt + 8 * g + 4 * hh) * 2) = pack4(-WT_[4 * g], -WT_[4 * g + 1], -WT_[4 * g + 2], -WT_[4 * g + 3]);
        __syncthreads();
        bf16x8 sf[4][2];
#pragma unroll
        for (int kt = 0; kt < 4; ++kt) { sf[kt][0] = acc_frag<0>(S[kt]); sf[kt][1] = acc_frag<1>(S[kt]); }
#pragma unroll
        for (int kt = 0; kt < 4; ++kt)
#pragma unroll
            for (int s = 0; s < 2; ++s) U = MFMA32(lds8x2(L + O_W + (32 * mt + l31) * P128 + (32 * kt + 16 * s + 4 * hh) * 2), sf[kt][s], U);
#pragma unroll
        for (int g = 0; g < 4; ++g) *(LAS v2u*)(L + O_VNT + (32 * nt + l31) * P64 + (32 * mt + 8 * g + 4 * hh) * 2) = pack4(U[4 * g], U[4 * g + 1], U[4 * g + 2], U[4 * g + 3]);
        __syncthreads();
        {
            f32x16 Oa;
#pragma unroll
            for (int r = 0; r < 16; ++r) Oa[r] = 0.f;
#pragma unroll
            for (int kt = 0; kt < 4; ++kt)
#pragma unroll
                for (int s = 0; s < 2; ++s) Oa = MFMA32(lds8x2(L + O_QH + (32 * mt + l31) * P128 + (32 * kt + 16 * s + 4 * hh) * 2), sf[kt][s], Oa);
#pragma unroll
            for (int g = 0; g < 4; ++g) { const f32x4 e4 = *(const LAS f32x4*)(SMf + 128 + 32 * mt + 8 * g + 4 * hh);
#pragma unroll
                for (int e = 0; e < 4; ++e) Oa[4 * g + e] *= e4[e]; }
            bf16x8 vn[4];
#pragma unroll
            for (int s = 0; s < 4; ++s) vn[s] = lds16(L + O_VNT + (32 * nt + l31) * P64 + (16 * s + 8 * hh) * 2);
#pragma unroll
            for (int s = 0; s < 4; ++s) Oa = MFMA32(lds16(L + O_AT + (32 * mt + l31) * P64 + (16 * s + 8 * hh) * 2), vn[s], Oa);
            const float glast = SMf[256];
#pragma unroll
            for (int kt = 0; kt < 4; ++kt) {
#pragma unroll
                for (int r = 0; r < 16; ++r) S[kt][r] *= glast;
#pragma unroll
                for (int s = 0; s < 4; ++s) S[kt] = MFMA32(lds16(L + O_KGT + (32 * kt + l31) * P64 + (16 * s + 8 * hh) * 2), vn[s], S[kt]);
            }
#pragma unroll
            for (int r = 0; r < 16; ++r) { const float q2 = row16_sum(Oa[r] * Oa[r]);
                if ((lanev & 15) == 0) PSO[(32 * mt + 8 * (r >> 2) + 4 * hh + (r & 3)) * 8 + 2 * nt + ((lanev >> 4) & 1)] = q2;
                *(LAS unsigned short*)(L + O_OF + (32 * mt + 8 * (r >> 2) + 4 * hh + (r & 3)) * P128 + (32 * nt + l31) * 2) = (unsigned short)cvtpk(Oa[r], 0.f); }
        }
        asm volatile("s_waitcnt vmcnt(0)" : "+v"(pf_sink) :: "memory");
        __syncthreads();
    }
    GDN_OUT(b * SEQ + 31 * 64);
    __syncthreads();
#undef GDN_GATES
#undef GDN_CONV
#undef GDN_ROWS
#undef GDN_OUT
}

template <int NREG>
__device__ __forceinline__ void dsa_select(const float* const scw, LAS unsigned* const MASK, const int wv, const int lane, const int t0, const int nk) {
    const float NINF = -__builtin_inff();
    const unsigned long long lt_mask = (1ull << lane) - 1ull;
    float xn[NREG];
#pragma unroll
    for (int i = 0; i < NREG; ++i) xn[i] = __hip_atomic_load(scw + i * 64 + lane, __ATOMIC_RELAXED, __HIP_MEMORY_SCOPE_AGENT);
#pragma unroll 1
    for (int ql_ = 0; ql_ < 8; ++ql_) {
        const int ql = ql_ & 7;
        const int tq = t0 + 8 * wv + ql;
        LAS unsigned* const mrow = MASK + (8 * wv + ql) * 64;
        float x[NREG];
#pragma unroll
        for (int i = 0; i < NREG; ++i) x[i] = (i * 64 + lane < nk) ? xn[i] : NINF;
        if (ql_ + 1 < 8) {
#pragma unroll
            for (int i = 0; i < NREG; ++i) xn[i] = __hip_atomic_load(scw + ((ql_ + 1) & 7) * 2048 + i * 64 + lane, __ATOMIC_RELAXED, __HIP_MEMORY_SCOPE_AGENT);
        }
        if (tq + 1 > 256) {
            float vmin = __builtin_inff(), vmax = NINF;
#pragma unroll
            for (int i = 0; i < NREG; ++i) { vmax = fmaxf(vmax, x[i]); vmin = fminf(vmin, x[i] == NINF ? __builtin_inff() : x[i]); }
            vmin = -wave_max(-vmin); vmax = wave_max(vmax);
#define CNT_GE(p_, dst_) do { int _c0 = 0, _c1 = 0, _c2 = 0, _c3 = 0; \
                _Pragma("unroll") for (int _i = 0; _i < NREG; _i += 4) { _c0 += (x[_i] >= (p_)) ? 1 : 0; _c1 += (x[_i + 1] >= (p_)) ? 1 : 0; _c2 += (x[_i + 2] >= (p_)) ? 1 : 0; _c3 += (x[_i + 3] >= (p_)) ? 1 : 0; } \
                dst_ = wave_sum_i((_c0 + _c1) + (_c2 + _c3)); } while (0)
            float lo = vmin, hi = vmax, thr; int chi; bool tie = false;
            CNT_GE(hi, chi);
            if (chi == 256) thr = hi;
            else if (chi > 256) { tie = true; lo = hi; chi = 0; hi = __builtin_inff(); }
            else {
#pragma unroll 1
                for (;;) {
                    const float mid = 0.5f * (lo + hi);
                    if (!(mid > lo && mid < hi)) { tie = true; break; }
                    int c; CNT_GE(mid, c);
                    if (c == 256) { thr = mid; break; }
                    if (c > 256) lo = mid; else { hi = mid; chi = c; }
                }
            }
#undef CNT_GE
            if (!tie) {
#pragma unroll
                for (int i = 0; i < NREG; ++i) { const unsigned long long bs = __ballot(x[i] >= thr);
                    if (lane == 0) { v2u w; w.x = (unsigned)bs; w.y = (unsigned)(bs >> 32); *(LAS v2u*)(mrow + 2 * i) = w; } }
            } else {
                const int need = 256 - chi; int before = 0;
#pragma unroll
                for (int i = 0; i < NREG; ++i) { const bool eq = (x[i] == lo); const unsigned long long be = __ballot(eq);
                    const int rank = before + __popcll(be & lt_mask); const bool sel = (x[i] >= hi) || (eq && rank < need); before += __popcll(be);
                    const unsigned long long bs = __ballot(sel);
                    if (lane == 0) { v2u w; w.x = (unsigned)bs; w.y = (unsigned)(bs >> 32); *(LAS v2u*)(mrow + 2 * i) = w; } }
            }
        } else {
#pragma unroll
            for (int i = 0; i < NREG; ++i) { const unsigned long long bs = __ballot(i * 64 + lane <= tq);
                if (lane == 0) { v2u w; w.x = (unsigned)bs; w.y = (unsigned)(bs >> 32); *(LAS v2u*)(mrow + 2 * i) = w; } }
        }
    }
}

__device__ __forceinline__ void dsa_unit(Frame& F, const Args& args, const int b, const int qb, const float mb2) {
    LAS unsigned char* const L = F.lds;
    const int tid = F.tid, lane = F.lane, wv = F.wave, l31_0 = lane & 31, hh_0 = lane >> 5;
    int l31 = l31_0, hh = hh_0;
    constexpr int PK = 272, PV = 144;
    constexpr int O_K0 = 0, O_V0 = 17408, BUFSZ = 35840, O_MASK = 2 * BUFSZ, O_RS = O_MASK + 16384, O_BT = O_RS + 8192, O_END = O_BT + 2048, O_OA = 0;
    static_assert(O_END <= SCRATCH_BYTES && 4 * 17408 <= 2 * BUFSZ, "dsa LDS map");
    const int t0 = 64 * qb, nk = 64 * (qb + 1);
    const size_t rb = (size_t)b * SEQ;
    LAS unsigned* const MASK = (LAS unsigned*)(L + O_MASK);
    LAS float* const RS = (LAS float*)(L + O_RS);
    LAS float* const BT = (LAS float*)(L + O_BT);
    const float NINF = -__builtin_inff();
    for (int key = tid; key < nk; key += NWAVES * 64) { const f32x4 s4 = *(const f32x4*)(W_KVSS + (rb + key) * 4); RS[key] = rsqf_(((s4.x + s4.y) + (s4.z + s4.w)) * (1.0f / 128.0f) + EPSF); }
    BT[tid] = P_RELB[T5_BUCKET[tid >> 2] * 4 + (tid & 3)] * LOG2E;
    float* const scw = W_SCR + (size_t)(blockIdx.x * NWAVES + wv) * 8 * 2048;
#pragma unroll 1
    for (int rep_a = 0; rep_a < (PROBE_DUP == 41 ? 2 : 1); ++rep_a) {
        bf16x8 aq[2][4]; f32x4 wts[2][4];
#pragma unroll
        for (int rt = 0; rt < 2; ++rt) {
            const bf16* p = W_PROJ + (rb + t0 + 8 * wv + 4 * rt + (l31 >> 3)) * NPROJ + C_IQ + (l31 & 7) * 64 + 8 * hh;
#pragma unroll
            for (int s = 0; s < 4; ++s) aq[rt][s] = *(const GAS bf16x8*)(p + 16 * s);
#pragma unroll
            for (int g = 0; g < 4; ++g) wts[rt][g] = *(const f32x4*)(W_AUX + (rb + t0 + 8 * wv + 4 * rt + g) * 16 + 8 + 4 * hh) * 0.5f;
        }
        constexpr int O_IK = 0, IKB = 9216, PIK = 144;
        v4u sti;
#define IK_GLOAD(kt_) sti = *(const GAS v4u*)(W_PROJ + (rb + 64 * (kt_) + (tid >> 3)) * NPROJ + C_IK + (tid & 7) * 8)
#define IK_SWRITE(buf_) *(LAS v4u*)(L + O_IK + (buf_) * IKB + (tid >> 3) * PIK + (tid & 7) * 16) = sti
        IK_GLOAD(0); IK_SWRITE(0);
        __syncthreads();
#pragma unroll 1
        for (int kt6 = 0; kt6 <= qb; ++kt6) {
          const int ibuf = kt6 & 1;
          if (kt6 < qb) IK_GLOAD(kt6 + 1);
#pragma unroll
          for (int st = 0; st < 2; ++st) {
            bf16x8 bk[4];
#pragma unroll
            for (int s = 0; s < 4; ++s) bk[s] = lds16(L + O_IK + ibuf * IKB + (32 * st + l31) * PIK + (16 * s + 8 * hh) * 2);
            const int kt = 2 * kt6 + st;
            const int key = 32 * kt + l31;
            f32x16 C0, C1;
#pragma unroll
            for (int r = 0; r < 16; ++r) { C0[r] = 0.f; C1[r] = 0.f; }
#pragma unroll
            for (int s = 0; s < 4; ++s) C0 = MFMA32(aq[0][s], bk[s], C0);
#pragma unroll
            for (int s = 0; s < 4; ++s) C1 = MFMA32(aq[1][s], bk[s], C1);
            float pp[2][4];
#pragma unroll
            for (int g = 0; g < 4; ++g) {
                float p0 = 0.f, p1 = 0.f;
#pragma unroll
                for (int e2 = 0; e2 < 4; ++e2) { const float w0 = wts[0][g][e2], w1 = wts[1][g][e2], x0 = C0[4 * g + e2], x1 = C1[4 * g + e2];
                    p0 = __builtin_fmaf(w0, x0, p0); p0 = __builtin_fmaf(w0, __builtin_fabsf(x0), p0); p1 = __builtin_fmaf(w1, x1, p1); p1 = __builtin_fmaf(w1, __builtin_fabsf(x1), p1); }
                pp[0][g] = p0; pp[1][g] = p1;
            }
            float snd[2][2], rcv[2][2];
#pragma unroll
            for (int rt = 0; rt < 2; ++rt)
#pragma unroll
                for (int g2 = 0; g2 < 2; ++g2) snd[rt][g2] = hh ? pp[rt][g2] : pp[rt][g2 + 2];
#pragma unroll
            for (int rt = 0; rt < 2; ++rt)
#pragma unroll
                for (int g2 = 0; g2 < 2; ++g2) rcv[rt][g2] = __shfl_xor(snd[rt][g2], 32);
#pragma unroll
            for (int rt = 0; rt < 2; ++rt)
#pragma unroll
                for (int g2 = 0; g2 < 2; ++g2) { const int ql = 4 * rt + g2 + 2 * hh; float p = (hh ? pp[rt][g2 + 2] : pp[rt][g2]) + rcv[rt][g2];
                    if (key > t0 + 8 * wv + ql) p = NINF;
                    scw[ql * 2048 + key] = p; }
          }
          if (kt6 < qb) IK_SWRITE(ibuf ^ 1);
          __syncthreads();
        }
#undef IK_GLOAD
#undef IK_SWRITE
    }
    __builtin_amdgcn_fence(__ATOMIC_SEQ_CST, "workgroup");
    asm volatile("s_waitcnt vmcnt(0)" ::: "memory");
    int lanev = lane; asm volatile("" : "+v"(lanev));
    if (qb < 8) dsa_select<8>(scw, MASK, wv, lanev, t0, nk);
    else if (qb < 16) dsa_select<16>(scw, MASK, wv, lanev, t0, nk);
    else if (qb < 24) dsa_select<24>(scw, MASK, wv, lanev, t0, nk);
    else dsa_select<32>(scw, MASK, wv, lanev, t0, nk);
    __syncthreads();
    const int qj = l31 >> 2, hd = l31 & 3;
    const int tql = t0 + 8 * wv + qj;
    bf16x8 qf[8]; float qn2 = 0.f;
    {
        const bf16* p = W_PROJ + (rb + tql) * NPROJ + C_QB + hd * 128 + 8 * hh; const float cs = 0.08838834764831845f * LOG2E;
#pragma unroll
        for (int s = 0; s < 8; ++s) { const v4u raw = *(const GAS v4u*)(p + 16 * s); const f32x4 g0 = *(const f32x4*)(P_GKV + 16 * s + 8 * hh), g1 = *(const f32x4*)(P_GKV + 16 * s + 8 * hh + 4);
            v4u o; o.x = cvtpk(bflo(raw.x) * g0.x * cs, bfhi(raw.x) * g0.y * cs); o.y = cvtpk(bflo(raw.y) * g0.z * cs, bfhi(raw.y) * g0.w * cs);
            o.z = cvtpk(bflo(raw.z) * g1.x * cs, bfhi(raw.z) * g1.y * cs); o.w = cvtpk(bflo(raw.w) * g1.z * cs, bfhi(raw.w) * g1.w * cs);
            qn2 += (bflo(o.x) * bflo(o.x) + bfhi(o.x) * bfhi(o.x)) + (bflo(o.y) * bflo(o.y) + bfhi(o.y) * bfhi(o.y)) + (bflo(o.z) * bflo(o.z) + bfhi(o.z) * bfhi(o.z)) + (bflo(o.w) * bflo(o.w) + bfhi(o.w) * bfhi(o.w));
            qf[s] = __builtin_bit_cast(bf16x8, o); }
    }
    qn2 += __shfl_xor(qn2, 32);
    const float c0 = -(sqrtf(qn2) * 11.313708499f * 1.01f + mb2 + 1.0f);
    const float cfar = BT[127 * 4 + hd] + c0;
    f32x16 oacc[4];
#pragma unroll
    for (int d = 0; d < 4; ++d)
#pragma unroll
        for (int r = 0; r < 16; ++r) oacc[d][r] = 0.f;
    float lsum = 0.f;
    v4u st0, st1;
#define DSA_GLOAD(kt) do { const bf16* _p = W_PROJ + (rb + 64 * (kt) + lane) * NPROJ + C_CKV + wv * 16; st0 = *(const GAS v4u*)_p; st1 = *(const GAS v4u*)(_p + 8); } while (0)
#define DSA_SWRITE(buf, ktt) do { LAS unsigned char* _kb = L + (buf) * BUFSZ; const float _r = RS[64 * (ktt) + lane]; \
        v4u _n0, _n1; _n0.x = cvtpk(bflo(st0.x) * _r, bfhi(st0.x) * _r); _n0.y = cvtpk(bflo(st0.y) * _r, bfhi(st0.y) * _r); _n0.z = cvtpk(bflo(st0.z) * _r, bfhi(st0.z) * _r); _n0.w = cvtpk(bflo(st0.w) * _r, bfhi(st0.w) * _r); \
        _n1.x = cvtpk(bflo(st1.x) * _r, bfhi(st1.x) * _r); _n1.y = cvtpk(bflo(st1.y) * _r, bfhi(st1.y) * _r); _n1.z = cvtpk(bflo(st1.z) * _r, bfhi(st1.z) * _r); _n1.w = cvtpk(bflo(st1.w) * _r, bfhi(st1.w) * _r); \
        *(LAS v4u*)(_kb + O_K0 + lane * PK + wv * 32) = _n0; *(LAS v4u*)(_kb + O_K0 + lane * PK + wv * 32 + 16) = _n1; \
        LAS unsigned short* _vt = (LAS unsigned short*)(_kb + O_V0) + (wv * 16) * 72 + lane; \
        _vt[0 * 72] = (unsigned short)_n0.x; _vt[1 * 72] = (unsigned short)(_n0.x >> 16); _vt[2 * 72] = (unsigned short)_n0.y; _vt[3 * 72] = (unsigned short)(_n0.y >> 16); \
        _vt[4 * 72] = (unsigned short)_n0.z; _vt[5 * 72] = (unsigned short)(_n0.z >> 16); _vt[6 * 72] = (unsigned short)_n0.w; _vt[7 * 72] = (unsigned short)(_n0.w >> 16); \
        _vt[8 * 72] = (unsigned short)_n1.x; _vt[9 * 72] = (unsigned short)(_n1.x >> 16); _vt[10 * 72] = (unsigned short)_n1.y; _vt[11 * 72] = (unsigned short)(_n1.y >> 16); \
        _vt[12 * 72] = (unsigned short)_n1.z; _vt[13 * 72] = (unsigned short)(_n1.z >> 16); _vt[14 * 72] = (unsigned short)_n1.w; _vt[15 * 72] = (unsigned short)(_n1.w >> 16); } while (0)
    DSA_GLOAD(0); DSA_SWRITE(0, 0);
    __syncthreads();
    for (int kt = 0; kt <= qb; ++kt) {
        const int buf = kt & 1;
        l31 = l31_0; hh = hh_0; asm volatile("" : "+v"(l31), "+v"(hh));
        if (kt < qb) DSA_GLOAD(kt + 1);
        const LAS unsigned char* kb = L + buf * BUFSZ;
#pragma unroll
        for (int st = 0; st < 2; ++st) {
            f32x16 Sa;
#pragma unroll
            for (int r = 0; r < 16; ++r) Sa[r] = 0.f;
#pragma unroll
            for (int s = 0; s < 8; ++s) Sa = MFMA32(lds16(kb + O_K0 + (32 * st + l31) * PK + (16 * s + 8 * hh) * 2), qf[s], Sa);
            const int kbase = 64 * kt + 32 * st;
            const int mwi = (int)(MASK[(8 * wv + qj) * 64 + 2 * kt + st] >> (4 * hh));
            const bool far = (t0 + 8 * wv) - (kbase + 31) >= 113;
            float pn[16];
            if (far) {
#pragma unroll
                for (int r = 0; r < 16; ++r) { const float p = __builtin_bit_cast(float, __builtin_bit_cast(int, __builtin_amdgcn_exp2f(Sa[r] + cfar)) & __builtin_amdgcn_sbfe(mwi, 8 * (r >> 2) + (r & 3), 1));
                    lsum += p; pn[r] = p; }
            } else {
#pragma unroll
                for (int r = 0; r < 16; ++r) { int dist = tql - (kbase + 8 * (r >> 2) + 4 * hh + (r & 3)); dist = dist < 0 ? 0 : (dist > 127 ? 127 : dist);
                    const float p = __builtin_bit_cast(float, __builtin_bit_cast(int, __builtin_amdgcn_exp2f(Sa[r] + (BT[dist * 4 + hd] + c0))) & __builtin_amdgcn_sbfe(mwi, 8 * (r >> 2) + (r & 3), 1));
                    lsum += p; pn[r] = p; }
            }
            const bf16x8 pf0 = pack8(pn[0], pn[1], pn[2], pn[3], pn[4], pn[5], pn[6], pn[7]), pf1 = pack8(pn[8], pn[9], pn[10], pn[11], pn[12], pn[13], pn[14], pn[15]);
#pragma unroll
            for (int dt = 0; dt < 4; ++dt) { const LAS unsigned char* vp = kb + O_V0 + (32 * dt + l31) * PV + (32 * st + 4 * hh) * 2;
                oacc[dt] = MFMA32(lds8x2(vp), pf0, oacc[dt]); oacc[dt] = MFMA32(lds8x2(vp + 32), pf1, oacc[dt]); }
        }
        if (kt < qb) DSA_SWRITE(buf ^ 1, kt + 1);
        __syncthreads();
    }
#undef DSA_GLOAD
#undef DSA_SWRITE
    lsum += __shfl_xor(lsum, 32);
    {
        const float inv = rcpf_(lsum);
#pragma unroll
        for (int dt = 0; dt < 4; ++dt)
#pragma unroll
            for (int g = 0; g < 4; ++g) { const int d = 32 * dt + 8 * g + 4 * hh; const f32x4 gk = *(const f32x4*)(P_GKV + d);
                *(LAS v2u*)(L + O_OA + hd * 17408 + (8 * wv + qj) * PK + d * 2) = pack4(oacc[dt][4 * g] * inv * gk.x, oacc[dt][4 * g + 1] * inv * gk.y, oacc[dt][4 * g + 2] * inv * gk.z, oacc[dt][4 * g + 3] * inv * gk.w); }
    }
    __syncthreads();
    {
        const int hd2 = wv >> 1, mt2 = wv & 1;
        const size_t row = rb + t0 + 32 * mt2 + l31;
        bf16x8 of[8];
#pragma unroll
        for (int s = 0; s < 8; ++s) of[s] = lds16(L + O_OA + hd2 * 17408 + (32 * mt2 + l31) * PK + (16 * s + 8 * hh) * 2);
#pragma unroll 1
        for (int et = 0; et < 4; ++et) {
            v2u zw[4];
#pragma unroll
            for (int g = 0; g < 4; ++g) zw[g] = *(const GAS v2u*)(W_PROJ + row * NPROJ + C_ZB + hd2 * 128 + 32 * et + 8 * g + 4 * hh);
            f32x16 C;
#pragma unroll
            for (int r = 0; r < 16; ++r) C[r] = 0.f;
            const bf16* wp = W_WUVT + (size_t)hd2 * 16384 + (32 * et + l31) * 128 + 8 * hh;
#pragma unroll
            for (int s = 0; s < 8; ++s) C = MFMA32(*(const GAS bf16x8*)(wp + 16 * s), of[s], C);
#pragma unroll
            for (int g = 0; g < 4; ++g)
                *(GAS v2u*)(W_OAB + row * DM + 512 + hd2 * 128 + 32 * et + 8 * g + 4 * hh) =
                    pack4(C[4 * g] * siluf(bflo(zw[g].x)), C[4 * g + 1] * siluf(bfhi(zw[g].x)), C[4 * g + 2] * siluf(bflo(zw[g].y)), C[4 * g + 3] * siluf(bfhi(zw[g].y)));
        }
    }
    __syncthreads();
}

constexpr int N_GDN = NB * 4, N_DSA = NB * 32, N_ITEMS = N_GDN + N_DSA;
constexpr int N_PHASES = 6;
__global__ void __launch_bounds__(NWAVES * 64, 2) hyb_fwd(Args args) {
    extern __shared__ __attribute__((aligned(16))) unsigned char lds[];
    Frame F;
    F.lds = (LAS unsigned char*)lds;
    F.MISC = (volatile LAS unsigned*)(F.lds + MISC_OFF);
    F.tid = threadIdx.x; F.lane = F.tid & 63; F.wave = __builtin_amdgcn_readfirstlane(F.tid >> 6);
    F.G = gridDim.x; { const int bx = blockIdx.x; F.vcu = (F.G % 8 == 0) ? (bx % 8) * (F.G / 8) + bx / 8 : bx; }
    unsigned char* ws = args.ws;
    F.ctl = (gu32*)(ws + WS_CTL);
    F.ws = ws;
    for (int u = F.tid; u < 64; u += NWAVES * 64) F.MISC[u] = 0u;
    __syncthreads();
    const int lo = args.ph_lo, hi = args.ph_hi;
    const bool multi = (hi - lo) > 1;
    XcdBarrier bar; bar.bar = (unsigned*)(F.ctl + CW_BAR) + args.li * XCD_BAR_WORDS; bar.x = 0; bar.st = nullptr;
    if (multi) bar = xcd_barrier_post((unsigned*)(F.ctl + CW_BAR) + args.li * XCD_BAR_WORDS, F.MISC + 8);
#define IN(k) (lo <= (k) && (k) < hi)
#define BOTH(k) (IN(k) && IN((k) + 1))
    if (IN(0)) { p0_prologue(F, args); if (PROBE_DUP == 7) { __syncthreads(); p0_prologue(F, args); } if (BOTH(0)) xcd_barrier(bar); }
    if (IN(1)) { p1_norm(F, args); if (PROBE_DUP == 1) p1_norm(F, args); if (BOTH(1)) xcd_barrier(bar); }
    if (IN(2)) {
        pg8::Gemm g{W_XN, W_WINT, MROWS, NPROJ, DM}; pg8::StaticOrder S; S.init(MROWS, NPROJ, F.G, (int)blockIdx.x);
        pg8::EpiProj E{W_PROJ, W_AUX, W_KVSS};
        pg8::gemm_phase<pg8::EpiProj, pg8::StaticOrder, true, true>(F.lds, g, S, E);
        if (PROBE_DUP == 2) pg8::gemm_phase<pg8::EpiProj, pg8::StaticOrder, true, true>(F.lds, g, S, E);
        if (BOTH(2)) xcd_barrier(bar);
    }
    if (IN(3)) {
#define NEXT_ITEM(dst, qw) do { if (F.tid == 0) F.MISC[4] = __hip_atomic_fetch_add(F.ctl + (qw), 1u, RLX_AGENT); __syncthreads(); dst = (int)F.MISC[4]; __syncthreads(); } while (0)
        float mb2; { const int hd_ = F.lane & 3; float m_ = P_RELB[hd_]; for (int k = 1; k < 32; ++k) m_ = fmaxf(m_, P_RELB[k * 4 + hd_]); mb2 = m_ * LOG2E; }
        int item; NEXT_ITEM(item, CW_QUEUE);
#pragma unroll 1
        for (int pass = 0; pass < (PROBE_DUP == 3 ? 2 : 1); ++pass) {
            if (pass) NEXT_ITEM(item, CW_QUEUE + 64);
            while (item < N_GDN) { gdn_unit(F, args, item >> 2, item & 3); NEXT_ITEM(item, CW_QUEUE + 64 * pass); }
        }
#pragma unroll 1
        for (int pass = 0; pass < (PROBE_DUP == 4 ? 2 : 1); ++pass) {
            if (pass) NEXT_ITEM(item, CW_QUEUE + 128);
            while (item < N_ITEMS) { if (item >= N_GDN) { const int idx = item - N_GDN; dsa_unit(F, args, idx & 31, 31 - (idx >> 5), mb2); } NEXT_ITEM(item, pass ? CW_QUEUE + 128 : CW_QUEUE); }
        }
#undef NEXT_ITEM
        if (BOTH(3)) xcd_barrier(bar);
    }
    if (IN(4)) {
        pg8::Gemm g{W_OAB, W_WOUTT, MROWS, DM, DM}; pg8::StaticOrder S; S.init(MROWS, DM, F.G, (int)blockIdx.x);
        pg8::EpiMix E{W_MIX, DM};
        pg8::gemm_phase<pg8::EpiMix, pg8::StaticOrder, true, true>(F.lds, g, S, E);
        if (PROBE_DUP == 5) pg8::gemm_phase<pg8::EpiMix, pg8::StaticOrder, true, true>(F.lds, g, S, E);
        if (BOTH(4)) xcd_barrier(bar);
    }
    if (IN(5)) { p5_final(F, args); if (PROBE_DUP == 6) p5_final(F, args); }
#undef IN
#undef BOTH
}

extern "C" void kernel_launch(void* const* d_in, const int* in_sizes, int n_in, void* d_out, int out_size, void* d_ws, size_t ws_size, hipStream_t stream) {
    static int grid = 0;
    if (grid == 0) {
        if (n_in != 15 || in_sizes[0] != MROWS * DM || out_size != MROWS * DM || ws_size < WS_END) { fprintf(stderr, "kernel_launch: unexpected shapes (n_in %d, in0 %d, out %d, ws %zu); nothing launched\n", n_in, n_in > 0 ? in_sizes[0] : -1, out_size, ws_size); grid = -1; return; }
        int dev = 0, cus = 0, per_cu = 0;
        if (hipGetDevice(&dev) != hipSuccess || hipDeviceGetAttribute(&cus, hipDeviceAttributeMultiprocessorCount, dev) != hipSuccess) { fprintf(stderr, "kernel_launch: device query failed\n"); grid = -1; return; }
        if (hipFuncSetAttribute((const void*)hyb_fwd, hipFuncAttributeMaxDynamicSharedMemorySize, LDS_BYTES) != hipSuccess) { fprintf(stderr, "kernel_launch: hipFuncSetAttribute failed\n"); grid = -1; return; }
        if (hipOccupancyMaxActiveBlocksPerMultiprocessor(&per_cu, (const void*)hyb_fwd, NWAVES * 64, LDS_BYTES) != hipSuccess || per_cu < 1)
            fprintf(stderr, "kernel_launch: note: occupancy query reports %d workgroups per CU\n", per_cu);
        (void)hipGetLastError();
        grid = cus;
    }
    if (grid < 0) return;
    if (hipMemsetAsync((char*)d_ws + WS_CTL, 0, CTL_ZERO_BYTES, stream) != hipSuccess) { fprintf(stderr, "kernel_launch: memset failed\n"); return; }
    Args a{};
    for (int i = 0; i < 15; ++i) a.in[i] = (const float*)d_in[i];
    a.out = (float*)d_out; a.ws = (unsigned char*)d_ws;
    constexpr int NL = MK_N_LAUNCHES;
    static_assert(NL == 1 || NL == 2 || NL == 3 || NL == N_PHASES, "MK_N_LAUNCHES");
    const int cuts1[2] = {0, 6}, cuts2[3] = {0, 3, 6}, cuts3[4] = {0, 3, 4, 6}, cuts6[7] = {0, 1, 2, 3, 4, 5, 6};
    const int* cuts = NL == 1 ? cuts1 : NL == 2 ? cuts2 : NL == 3 ? cuts3 : cuts6;
    for (int li = 0; li < NL; ++li) {
        a.ph_lo = cuts[li]; a.ph_hi = cuts[li + 1]; a.li = li;
        hipLaunchKernelGGL(hyb_fwd, dim3(grid), dim3(NWAVES * 64), LDS_BYTES, stream, a);
        const hipError_t le = hipPeekAtLastError();
        if (le != hipSuccess) { fprintf(stderr, "kernel_launch: launch %d failed: %s\n", li, hipGetErrorName(le)); break; }
    }
}
```

```cpp
#include <hip/hip_runtime.h>
#include <cstdio>
#include <cstdint>
#ifndef MK_N_LAUNCHES
#define MK_N_LAUNCHES 1
#endif
#ifndef PROBE_DUP
#define PROBE_DUP 0
#endif
namespace pg8 {
#define PG8_LAS __attribute__((address_space(3)))
typedef unsigned short bf16_t;
typedef short bf16x8 __attribute__((ext_vector_type(8)));
typedef float f32x4 __attribute__((ext_vector_type(4)));
typedef unsigned u32x4 __attribute__((ext_vector_type(4)));
constexpr int BM = 256, BK = 64, HALF = 128, HTB = HALF * BK * 2  , STAGE_BYTES = 8 * HTB, NXCD = 8, WGM = 8;

__host__ __device__ __forceinline__ int lds_byte(int r, int c) { const int st = (r >> 4) * 2 + (c >> 5), rr = r & 15, cc = c & 31, ob = rr * 64 + cc * 2; return st * 1024 + (ob ^ (((ob >> 9) & 1) << 5)); }
__host__ __device__ __forceinline__ void stage_rc(int b, int& R, int& C) { const int st = b / 1024, sb = b % 1024, swz = sb ^ (((sb >> 9) & 1) << 5); R = (st >> 1) * 16 + swz / 64; C = (st & 1) * 32 + (swz % 64) / 2; }
__host__ __device__ __forceinline__ int perm32(int rho) { const int n = rho >> 4, i = rho & 15; return 8 * (i >> 2) + 4 * n + (i & 3); }

struct Unit { int pm, pn; };
struct Gemm { const bf16_t* A; const bf16_t* Bt; int M, N, K; };

struct StaticOrder {
    int nM, nN, nwg, G, c;
    __host__ __device__ void init(int M, int N, int G_, int c_) { nM = M / BM; nN = N / BM; nwg = nM * nN; G = G_; c = c_; }
    __host__ __device__ bool next(int i, Unit& u) const {
        const long L = (long)i * G + c; if (L >= nwg) return false;
        int wgid = (int)L; { const int q = nwg / NXCD, r = nwg % NXCD, xcd = wgid % NXCD, off = wgid / NXCD; wgid = (xcd < r ? xcd * (q + 1) : r * (q + 1) + (xcd - r) * q) + off; }
        const int nig = WGM * nN, gid = wgid / nig, fm = gid * WGM, gsz = (nM - fm) < WGM ? (nM - fm) : WGM;
        u.pm = fm + ((wgid % nig) % gsz); u.pn = (wgid % nig) / gsz; return true;
    }
    __device__ __forceinline__ void a_ready(const Unit&) const {}
    __device__ __forceinline__ void done(const Unit&) const {}
};

typedef float f32x2c __attribute__((ext_vector_type(2))); typedef __bf16 b16x2c __attribute__((ext_vector_type(2)));
__device__ __forceinline__ unsigned cvt_pk_bf16(float lo, float hi) { const f32x2c v = {lo, hi}; return __builtin_bit_cast(unsigned, __builtin_convertvector(v, b16x2c)); }
struct EpiProj {
    static constexpr bool PERM = true, AFTER_DRAIN = false;
    bf16_t* O; float* aux; float* kvss;
    __device__ __forceinline__ void operator()(const f32x4 (&acc)[2][2][4][2], const Unit& u, int wr, int wc, int fr, int fq) const {
        const int row0 = u.pm * BM + wr * 64 + fr, col0 = u.pn * BM + wc * 32 + 8 * fq;
        const bool last = (u.pn == 14);
#pragma unroll
        for (int ai = 0; ai < 2; ++ai)
#pragma unroll
            for (int m = 0; m < 4; ++m) {
                const int row = row0 + ai * HALF + m * 16;
                bf16_t* rowp = O + (size_t)row * 3840 + col0;
#pragma unroll
                for (int bj = 0; bj < 2; ++bj) {
                    const f32x4 v0 = acc[ai][bj][m][0], v1 = acc[ai][bj][m][1];
                    u32x4 w; w.x = cvt_pk_bf16(v0[0], v0[1]); w.y = cvt_pk_bf16(v0[2], v0[3]); w.z = cvt_pk_bf16(v1[0], v1[1]); w.w = cvt_pk_bf16(v1[2], v1[3]);
                    *(u32x4*)(rowp + bj * HALF) = w;
                }
                if (last) {
                    const f32x4 a0 = acc[ai][0][m][0], a1 = acc[ai][0][m][1];
                    float ss = (a0[0] * a0[0] + a0[1] * a0[1]) + (a0[2] * a0[2] + a0[3] * a0[3]) + (a1[0] * a1[0] + a1[1] * a1[1]) + (a1[2] * a1[2] + a1[3] * a1[3]);
                    ss += __shfl_xor(ss, 16); ss += __shfl_xor(ss, 32);
                    if (fq == 0) kvss[(size_t)row * 4 + wc] = ss;
                    if (wc == 2 && fq < 2) { float* ap = aux + (size_t)row * 16 + 8 * fq; *(f32x4*)ap = acc[ai][1][m][0]; *(f32x4*)(ap + 4) = acc[ai][1][m][1]; }
                }
            }
    }
};
struct EpiF32 {
    static constexpr bool PERM = false, AFTER_DRAIN = false;
    float* C; int ldc;
    __device__ __forceinline__ void operator()(const f32x4 (&acc)[2][2][4][2], const Unit& u, int wr, int wc, int fr, int fq) const {
        const int row0 = u.pm * BM + wr * 64 + fr, col0 = u.pn * BM + wc * 32 + 4 * fq;
#pragma unroll
        for (int ai = 0; ai < 2; ++ai)
#pragma unroll
            for (int m = 0; m < 4; ++m) { float* rowp = C + (size_t)(row0 + ai * HALF + m * 16) * ldc + col0;
#pragma unroll
                for (int bj = 0; bj < 2; ++bj)
#pragma unroll
                    for (int n = 0; n < 2; ++n) *(f32x4*)(rowp + bj * HALF + n * 16) = acc[ai][bj][m][n]; }
    }
};
struct EpiMix {
    static constexpr bool PERM = true, AFTER_DRAIN = false;
    bf16_t* O; int ldc;
    __device__ __forceinline__ void operator()(const f32x4 (&acc)[2][2][4][2], const Unit& u, int wr, int wc, int fr, int fq) const {
        const int row0 = u.pm * BM + wr * 64 + fr, col0 = u.pn * BM + wc * 32 + 8 * fq;
#pragma unroll
        for (int ai = 0; ai < 2; ++ai)
#pragma unroll
            for (int m = 0; m < 4; ++m) { bf16_t* rowp = O + (size_t)(row0 + ai * HALF + m * 16) * ldc + col0;
#pragma unroll
                for (int bj = 0; bj < 2; ++bj) { const f32x4 v0 = acc[ai][bj][m][0], v1 = acc[ai][bj][m][1];
                    u32x4 w; w.x = cvt_pk_bf16(v0[0], v0[1]); w.y = cvt_pk_bf16(v0[2], v0[3]); w.z = cvt_pk_bf16(v1[0], v1[1]); w.w = cvt_pk_bf16(v1[2], v1[3]);
                    *(u32x4*)(rowp + bj * HALF) = w; } }
    }
};
template <class Epi, class Sched, bool ALIGN_EPI = false, bool SP2 = false>
__device__ __forceinline__ void gemm_phase(PG8_LAS unsigned char* lds, const Gemm g, const Sched& S, const Epi& E) {
    const int tid = threadIdx.x, wid = __builtin_amdgcn_readfirstlane(tid >> 6), lane = tid & 63, wr = wid >> 2, wc = wid & 3, fr = lane & 15, fq = lane >> 4;
    const int K = g.K, nt = K / BK;
    unsigned voffA[2], voffB[2];
#pragma unroll
    for (int i = 0; i < 2; ++i) { int R, C; stage_rc(tid * 16 + i * 8192, R, C); const int Rb = Epi::PERM ? ((R & ~31) + perm32(R & 31)) : R;
        voffA[i] = (unsigned)(R * K + C) * 2u; voffB[i] = (unsigned)(Rb * K + C) * 2u; }
    const size_t kstep = (size_t)(BK * 2);
    const size_t hstep = (size_t)HALF * K * 2;
    const size_t tstep = 2 * hstep;
    const unsigned ldsw = (unsigned)wid * 1024u;
    const int aoff = lds_byte(wr * 64 + fr, fq * 8), boff = lds_byte(wc * 32 + fr, fq * 8);
#define PG8_SA(b, h) (((b) * 2 + (h)) * HTB)
#define PG8_SB(b, h) ((4 + (b) * 2 + (h)) * HTB)
#define PG8_STAGE(bufoff, gbase, voff) do { _Pragma("unroll") for (int _i = 0; _i < 2; ++_i) \
        __builtin_amdgcn_global_load_lds((const unsigned*)((const char*)(gbase) + (voff)[_i]), (PG8_LAS unsigned*)(lds + (bufoff) + ldsw + _i * 8192), 16, 0, 0); } while (0)
#define PG8_LDA(dst, b, h) do { _Pragma("unroll") for (int m = 0; m < 4; ++m) _Pragma("unroll") for (int k = 0; k < 2; ++k) dst[m][k] = *(const PG8_LAS bf16x8*)(lds + PG8_SA(b, h) + aoff + m * 2048 + k * 1024); } while (0)
#define PG8_LDB(dst, b, h) do { _Pragma("unroll") for (int n = 0; n < 2; ++n) _Pragma("unroll") for (int k = 0; k < 2; ++k) dst[n][k] = *(const PG8_LAS bf16x8*)(lds + PG8_SB(b, h) + boff + n * 2048 + k * 1024); } while (0)
#define PG8_MMA(ai, bj, At, Bt) do { __builtin_amdgcn_s_setprio(1); _Pragma("unroll") for (int m = 0; m < 4; ++m) _Pragma("unroll") for (int n = 0; n < 2; ++n) _Pragma("unroll") for (int k = 0; k < 2; ++k) \
        acc[ai][bj][m][n] = __builtin_amdgcn_mfma_f32_16x16x32_bf16(Bt[n][k], At[m][k], acc[ai][bj][m][n], 0, 0, 0); __builtin_amdgcn_s_setprio(0); } while (0)
#define PG8_WAIT_V(n) asm volatile("s_waitcnt vmcnt(" #n ")" ::: "memory")
#define PG8_WAIT_L(n) asm volatile("s_waitcnt lgkmcnt(" #n ")" ::: "memory")
#define PG8_BAR __builtin_amdgcn_s_barrier()
#define PG8_SCHED __builtin_amdgcn_sched_barrier(0)
    Unit cur, nxt; int ui = 0;
    if (!S.next(0, cur)) return;
    f32x4 acc[2][2][4][2];
#pragma unroll
    for (int a = 0; a < 2; ++a)
#pragma unroll
        for (int b = 0; b < 2; ++b)
#pragma unroll
            for (int m = 0; m < 4; ++m)
#pragma unroll
                for (int n = 0; n < 2; ++n) acc[a][b][m][n] = (f32x4){0.f, 0.f, 0.f, 0.f};
    bf16x8 At[4][2], B0[2][2], B1[2][2];
    const char* cA = (const char*)g.A + (size_t)cur.pm * tstep; const char* cB = (const char*)g.Bt + (size_t)cur.pn * tstep;
    S.a_ready(cur);
    if constexpr (SP2) {
        PG8_STAGE(PG8_SB(0, 0), cB, voffB); PG8_STAGE(PG8_SB(0, 1), cB + hstep, voffB); PG8_STAGE(PG8_SA(0, 0), cA, voffA); PG8_STAGE(PG8_SA(0, 1), cA + hstep, voffA);
        if (wr == 1) PG8_BAR;
        PG8_WAIT_V(2); PG8_BAR;
        PG8_STAGE(PG8_SB(1, 0), cB + kstep, voffB); PG8_STAGE(PG8_SA(1, 0), cA + kstep, voffA); PG8_STAGE(PG8_SB(1, 1), cB + hstep + kstep, voffB);
        PG8_WAIT_V(6); PG8_BAR;
    } else {
        PG8_STAGE(PG8_SB(0, 0), cB, voffB); PG8_STAGE(PG8_SA(0, 0), cA, voffA); PG8_STAGE(PG8_SB(0, 1), cB + hstep, voffB); PG8_STAGE(PG8_SA(0, 1), cA + hstep, voffA);
        if (wr == 1) PG8_BAR;
        PG8_WAIT_V(4); PG8_BAR;
        PG8_STAGE(PG8_SB(1, 0), cB + kstep, voffB); PG8_STAGE(PG8_SA(1, 0), cA + kstep, voffA); PG8_STAGE(PG8_SB(1, 1), cB + hstep + kstep, voffB);
        PG8_WAIT_V(6); PG8_BAR;
    }
    for (;;) {
        const bool has_next = S.next(ui + 1, nxt);
        const char* nA = has_next ? (const char*)g.A + (size_t)nxt.pm * tstep : cA; const char* nB = has_next ? (const char*)g.Bt + (size_t)nxt.pn * tstep : cB;
        for (int t = 0; t < nt; t += 2) {
            const bool last = (t == nt - 2);
            const char* a1 = cA + (size_t)(t + 1) * kstep;
            const char* a2 = last ? nA : cA + (size_t)(t + 2) * kstep; const char* b2 = last ? nB : cB + (size_t)(t + 2) * kstep;
            const char* a3 = a2 + kstep; const char* b3 = b2 + kstep;
            if (last && has_next) S.a_ready(nxt);
            if constexpr (SP2) {
            PG8_LDB(B0, 0, 0); PG8_LDB(B1, 0, 1); PG8_SCHED; PG8_LDA(At, 0, 0); PG8_STAGE(PG8_SA(1, 1), a1 + hstep, voffA);
            PG8_WAIT_V(8); PG8_WAIT_L(0); PG8_BAR; PG8_MMA(0, 0, At, B0); PG8_MMA(0, 1, At, B1); PG8_BAR; PG8_SCHED;
            PG8_LDA(At, 0, 1); PG8_STAGE(PG8_SB(0, 0), b2, voffB); PG8_STAGE(PG8_SB(0, 1), b2 + hstep, voffB); PG8_STAGE(PG8_SA(0, 0), a2, voffA);
            PG8_WAIT_V(8); PG8_WAIT_L(0); PG8_BAR; PG8_MMA(1, 0, At, B0); PG8_MMA(1, 1, At, B1); PG8_BAR; PG8_SCHED;
            PG8_LDB(B0, 1, 0); PG8_LDB(B1, 1, 1); PG8_SCHED; PG8_LDA(At, 1, 0); PG8_STAGE(PG8_SA(0, 1), a2 + hstep, voffA);
            PG8_WAIT_V(8); PG8_WAIT_L(0); PG8_BAR; PG8_MMA(0, 0, At, B0); PG8_MMA(0, 1, At, B1); PG8_BAR; PG8_SCHED;
            PG8_LDA(At, 1, 1); PG8_STAGE(PG8_SB(1, 0), b3, voffB); PG8_STAGE(PG8_SB(1, 1), b3 + hstep, voffB); PG8_STAGE(PG8_SA(1, 0), a3, voffA);
            PG8_WAIT_V(8); PG8_WAIT_L(0); PG8_BAR; PG8_MMA(1, 0, At, B0); PG8_MMA(1, 1, At, B1); PG8_BAR; PG8_SCHED;
            } else {
            PG8_LDB(B0, 0, 0); PG8_SCHED; PG8_LDA(At, 0, 0); PG8_STAGE(PG8_SA(1, 1), a1 + hstep, voffA);
            PG8_WAIT_L(8); PG8_BAR; PG8_WAIT_L(0); PG8_MMA(0, 0, At, B0); PG8_BAR; PG8_SCHED;
            PG8_LDB(B1, 0, 1); PG8_STAGE(PG8_SB(0, 0), b2, voffB);
            PG8_BAR; PG8_WAIT_L(0); PG8_MMA(0, 1, At, B1); PG8_BAR;
            PG8_LDA(At, 0, 1); PG8_STAGE(PG8_SA(0, 0), a2, voffA);
            PG8_BAR; PG8_WAIT_L(0); PG8_MMA(1, 0, At, B0); PG8_BAR; PG8_SCHED;
            PG8_STAGE(PG8_SB(0, 1), b2 + hstep, voffB);
            PG8_WAIT_V(6); PG8_BAR; PG8_MMA(1, 1, At, B1); PG8_BAR;
            PG8_LDB(B0, 1, 0); PG8_SCHED; PG8_LDA(At, 1, 0); PG8_STAGE(PG8_SA(0, 1), a2 + hstep, voffA);
            PG8_WAIT_L(8); PG8_BAR; PG8_WAIT_L(0); PG8_MMA(0, 0, At, B0); PG8_BAR; PG8_SCHED;
            PG8_LDB(B1, 1, 1); PG8_STAGE(PG8_SB(1, 0), b3, voffB);
            PG8_BAR; PG8_WAIT_L(0); PG8_MMA(0, 1, At, B1); PG8_BAR;
            PG8_LDA(At, 1, 1); PG8_STAGE(PG8_SA(1, 0), a3, voffA);
            PG8_BAR; PG8_WAIT_L(0); PG8_MMA(1, 0, At, B0); PG8_BAR; PG8_SCHED;
            PG8_STAGE(PG8_SB(1, 1), b3 + hstep, voffB);
            PG8_WAIT_V(6); PG8_BAR; PG8_MMA(1, 1, At, B1); PG8_BAR;
            }
        }
        if constexpr (ALIGN_EPI) { if (wr == 0) PG8_BAR; }
        if constexpr (!Epi::AFTER_DRAIN) { E(acc, cur, wr, wc, fr, fq); S.done(cur); }
        if (!has_next) break;
#pragma unroll
        for (int a = 0; a < 2; ++a)
#pragma unroll
            for (int b = 0; b < 2; ++b)
#pragma unroll
                for (int m = 0; m < 4; ++m)
#pragma unroll
                    for (int n = 0; n < 2; ++n) acc[a][b][m][n] = (f32x4){0.f, 0.f, 0.f, 0.f};
        cur = nxt; cA = nA; cB = nB; ++ui;
        if constexpr (ALIGN_EPI) { if (wr == 1) PG8_BAR; }
    }
    PG8_WAIT_V(0);
    if constexpr (!ALIGN_EPI) { if (wr == 0) PG8_BAR; }
    PG8_BAR;
    if constexpr (Epi::AFTER_DRAIN) { E.fused(acc, cur, wr, wc, fr, fq, lds, wid, lane); S.done(cur); }
#undef PG8_SA
#undef PG8_SB
#undef PG8_STAGE
#undef PG8_LDA
#undef PG8_LDB
#undef PG8_MMA
#undef PG8_WAIT_V
#undef PG8_WAIT_L
#undef PG8_BAR
#undef PG8_SCHED
}
}

constexpr int NWAVES = 8;
constexpr int NB = 32, SEQ = 2048, DM = 1024, MROWS = NB * SEQ;
constexpr int NPROJ = 3840;
constexpr int C_ZA = 1536, C_QB = 2048, C_ZB = 2560, C_IQ = 3072, C_CKV = 3584, C_IK = 3712;
constexpr float EPSF = 1e-6f;
constexpr float LOG2E = 1.4426950408889634f;
__host__ __device__ __forceinline__ int proj_src_col(int n) {
    if (n < 2048) return n;
    if (n < 2560) return n - 2048 + 2056;
    if (n < 3072) return n - 2560 + 2696;
    if (n < 3584) return n - 3072 + 3208;
    if (n < 3712) return n - 3584 + 2568;
    if (n < 3776) return n - 3712 + 3720;
    if (n < 3784) return n - 3776 + 2048;
    if (n < 3792) return n;
    return -1;
}
__device__ const unsigned char T5_BUCKET[128] = {0,1,2,3,4,5,6,7,8,9,10,11,12,13,14,15,16,16,16,17,17,18,18,18,19,19,19,20,20,20,20,21,21,21,21,22,22,22,22,22,23,23,23,23,23,23,24,24,24,24,24,24,25,25,25,25,25,25,25,26,26,26,26,26,26,26,26,27,27,27,27,27,27,27,27,27,27,28,28,28,28,28,28,28,28,28,28,29,29,29,29,29,29,29,29,29,29,29,29,30,30,30,30,30,30,30,30,30,30,30,30,30,30,31,31,31,31,31,31,31,31,31,31,31,31,31,31,31};

constexpr size_t MiB = 1u << 20;
constexpr size_t WS_CTL = 0, CTL_ZERO_BYTES = 1 * MiB;
constexpr size_t WS_MOD = 1 * MiB;
constexpr size_t WS_WUV = 2 * MiB;
constexpr size_t WS_WOUT = 3 * MiB;
constexpr size_t WS_WIN = 5 * MiB;
constexpr size_t WS_KVSS = 13 * MiB;
constexpr size_t WS_AUX = 14 * MiB;
constexpr size_t WS_XN = 32 * MiB;
constexpr size_t WS_PROJ = 160 * MiB;
constexpr size_t WS_SCR = 640 * MiB;
constexpr size_t WS_END = 768 * MiB;
constexpr int CW_TMO = 0, CW_QUEUE = 64, CW_BAR = 4096;

constexpr int LDS_BYTES = 163840;
constexpr int MISC_OFF = LDS_BYTES - 256;
constexpr int SCRATCH_BYTES = MISC_OFF;

#define GAS __attribute__((address_space(1)))
#define LAS __attribute__((address_space(3)))
typedef unsigned short bf16;
typedef unsigned v4u __attribute__((ext_vector_type(4)));
typedef unsigned v2u __attribute__((ext_vector_type(2)));
typedef float f32x4 __attribute__((ext_vector_type(4)));
typedef float f32x16 __attribute__((ext_vector_type(16)));
typedef short bf16x8 __attribute__((ext_vector_type(8)));
typedef GAS unsigned gu32;
#define RLX_AGENT __ATOMIC_RELAXED, __HIP_MEMORY_SCOPE_AGENT
#define LDS_WAIT() asm volatile("s_waitcnt lgkmcnt(0)" ::: "memory")
#define MFMA32(a, b, c) __builtin_amdgcn_mfma_f32_32x32x16_bf16((a), (b), (c), 0, 0, 0)
#define MFMA16F(a, b, c) __builtin_amdgcn_mfma_f32_16x16x4f32((a), (b), (c), 0, 0, 0)
__device__ __forceinline__ unsigned f2bf(float f) { unsigned u = __builtin_bit_cast(unsigned, f); return (u + 0x7fffu + ((u >> 16) & 1u)) >> 16; }
__device__ __forceinline__ unsigned pk2(float lo, float hi) { return f2bf(lo) | (f2bf(hi) << 16); }
__device__ __forceinline__ float bf2f(unsigned short b) { return __builtin_bit_cast(float, ((unsigned)b) << 16); }
__device__ __forceinline__ float bflo(unsigned w) { return __builtin_bit_cast(float, w << 16); }
__device__ __forceinline__ float bfhi(unsigned w) { return __builtin_bit_cast(float, w & 0xffff0000u); }
__device__ __forceinline__ float rcpf_(float x) { return __builtin_amdgcn_rcpf(x); }
__device__ __forceinline__ float rsqf_(float x) { return __builtin_amdgcn_rsqf(x); }
__device__ __forceinline__ float siluf(float x) { return x * __builtin_amdgcn_rcpf(1.0f + __builtin_amdgcn_exp2f(-1.4426950408889634f * x)); }
__device__ __forceinline__ float wave_sum(float v) {
#pragma unroll
    for (int o = 1; o < 64; o <<= 1) v += __shfl_xor(v, o);
    return v;
}

__device__ __forceinline__ int wave_sum_i(int v) {
    v += __builtin_amdgcn_update_dpp(0, v, 0x111, 0xf, 0xf, false);
    v += __builtin_amdgcn_update_dpp(0, v, 0x112, 0xf, 0xf, false);
    v += __builtin_amdgcn_update_dpp(0, v, 0x114, 0xf, 0xe, false);
    v += __builtin_amdgcn_update_dpp(0, v, 0x118, 0xf, 0xc, false);
    v += __builtin_amdgcn_update_dpp(0, v, 0x142, 0xa, 0xf, false);
    v += __builtin_amdgcn_update_dpp(0, v, 0x143, 0xc, 0xf, false);
    return __builtin_amdgcn_readlane(v, 63);
}
__device__ __forceinline__ float wave_max(float v) {
    const int ninf = (int)0xff800000u;
#define WM_STEP(ctrl, rm, bm) v = fmaxf(v, __builtin_bit_cast(float, __builtin_amdgcn_update_dpp(ninf, __builtin_bit_cast(int, v), ctrl, rm, bm, false)))
    WM_STEP(0x111, 0xf, 0xf); WM_STEP(0x112, 0xf, 0xf); WM_STEP(0x114, 0xf, 0xe); WM_STEP(0x118, 0xf, 0xc); WM_STEP(0x142, 0xa, 0xf); WM_STEP(0x143, 0xc, 0xf);
#undef WM_STEP
    return __builtin_bit_cast(float, __builtin_amdgcn_readlane(__builtin_bit_cast(int, v), 63));
}
#define XB_TMO      128
#define XB_XCNT(j)  (256  + 64 * (j))
#define XB_XSUB(j)  (1280 + 64 * (j))
#define XB_XGEN(j)  (2304 + 64 * (j))
#define XB_TOP      3328
#define XB_TOPGEN   3392
#define XCD_BAR_WORDS 3456
#define XB_SPIN_CAP (1u << 18)

__device__ __forceinline__ unsigned xb_ld(unsigned* p)              { return __hip_atomic_load(p, __ATOMIC_RELAXED, __HIP_MEMORY_SCOPE_AGENT); }
__device__ __forceinline__ unsigned xb_add(unsigned* p, unsigned v) { return __hip_atomic_fetch_add(p, v, __ATOMIC_RELAXED, __HIP_MEMORY_SCOPE_AGENT); }
__device__ __forceinline__ unsigned xb_xcc_id() { return (unsigned)__builtin_amdgcn_s_getreg((3 << 11) | 20) & 0xFu; }
#define XB_SPIN(cond, bar) do { unsigned _sp = 0; while (cond) { __builtin_amdgcn_s_sleep(1); \
    if ((++_sp & 255u) == 0u) { if (xb_ld(&(bar)[XB_TMO])) break; if (_sp > XB_SPIN_CAP) { atomicAdd(&(bar)[XB_TMO], 1u); break; } } } } while (0)

struct XcdBarrier {
    unsigned* bar; unsigned x;
    volatile LAS unsigned* st;
};

__device__ __forceinline__ XcdBarrier xcd_barrier_post(unsigned* bar, volatile LAS unsigned* st) {
    XcdBarrier b; b.bar = bar; b.x = xb_xcc_id(); b.st = st;
    if (threadIdx.x == 0) (void)xb_add(&bar[XB_XCNT(b.x)], 1u);
    return b;
}
__device__ __forceinline__ void xcd_barrier_complete(unsigned* bar, unsigned x, unsigned& nloc, unsigned& nx) {
    const unsigned G = gridDim.x * gridDim.y * gridDim.z;
    unsigned sum, cnt, mine, sp = 0u;
    for (;;) {
        sum = 0u; cnt = 0u; mine = 0u;
#pragma unroll
        for (unsigned j = 0; j < 16; ++j) { const unsigned c = xb_ld(&bar[XB_XCNT(j)]); sum += c; cnt += (c > 0u) ? 1u : 0u; mine = (j == x) ? c : mine; }
        if (sum == G) break;
        __builtin_amdgcn_s_sleep(1);
        if ((++sp & 255u) == 0u) { if (xb_ld(&bar[XB_TMO])) break; if (sp > XB_SPIN_CAP) { atomicAdd(&bar[XB_TMO], 1u); break; } }
    }
    nloc = mine > 0u ? mine : 1u; nx = cnt > 0u ? cnt : 1u;
}

__device__ __forceinline__ void xcd_barrier(const XcdBarrier& b) {
    asm volatile("s_waitcnt vmcnt(0)" ::: "memory");
    __syncthreads();
    if (threadIdx.x == 0) {
        unsigned* bar = b.bar;
        __builtin_amdgcn_s_waitcnt(0);
        unsigned nloc = b.st[0], nx = b.st[1];
        if (nloc == 0u) { xcd_barrier_complete(bar, b.x, nloc, nx); b.st[0] = nloc; b.st[1] = nx; }
        const unsigned old = xb_add(&bar[XB_XSUB(b.x)], 1u);
        const unsigned gen = old / nloc;
        if (old + 1u == (gen + 1u) * nloc) {
            __builtin_amdgcn_fence(__ATOMIC_RELEASE, "agent");
            asm volatile("s_waitcnt vmcnt(0)" ::: "memory");
            const unsigned og = xb_add(&bar[XB_TOP], 1u);
            const unsigned tg = og / nx;
            if (og + 1u == (tg + 1u) * nx) xb_add(&bar[XB_TOPGEN], 1u);
            else XB_SPIN(xb_ld(&bar[XB_TOPGEN]) == tg, bar);
            __builtin_amdgcn_fence(__ATOMIC_ACQUIRE, "agent");
            xb_add(&bar[XB_XGEN(b.x)], 1u);
            asm volatile("s_waitcnt vmcnt(0)" ::: "memory");
        } else {
            XB_SPIN(xb_ld(&bar[XB_XGEN(b.x)]) == gen, bar);
            __builtin_amdgcn_fence(__ATOMIC_ACQUIRE, "agent");
            asm volatile("s_waitcnt vmcnt(0)" ::: "memory");
        }
    }
    __syncthreads();
}

struct Frame {
    LAS unsigned char* lds;
    volatile LAS unsigned* MISC;
    gu32* ctl;
    int tid, lane, wave;
    int vcu, G;
    unsigned char* ws;
};
#define P_X        (args.in[0])
#define P_C        (args.in[1])
#define P_WADA     (args.in[2])
#define P_BADA     (args.in[3])
#define P_GPRE     (args.in[4])
#define P_WIN      (args.in[5])
#define P_CONVW    (args.in[6])
#define P_ALOG     (args.in[7])
#define P_DTB      (args.in[8])
#define P_GGDN     (args.in[9])
#define P_GKV      (args.in[10])
#define P_WUV      (args.in[11])
#define P_RELB     (args.in[12])
#define P_WOUT     (args.in[13])
#define P_GPOST    (args.in[14])
#define P_OUT      (args.out)
#define W_MOD      ((float*)(F.ws + WS_MOD))
#define W_WUVT     ((bf16*)(F.ws + WS_WUV))
#define W_WOUTT    ((bf16*)(F.ws + WS_WOUT))
#define W_WINT     ((bf16*)(F.ws + WS_WIN))
#define W_KVSS     ((float*)(F.ws + WS_KVSS))
#define W_AUX      ((float*)(F.ws + WS_AUX))
#define W_XN       ((bf16*)(F.ws + WS_XN))
#define W_OAB      ((bf16*)(F.ws + WS_XN))
#define W_PROJ     ((bf16*)(F.ws + WS_PROJ))
#define W_MIX      ((bf16*)(F.ws + WS_PROJ))
#define W_SCR      ((float*)(F.ws + WS_SCR))
struct Args { const float* in[15]; float* out; unsigned char* ws; int ph_lo, ph_hi, li, pad; };

template <class CM>
__device__ __forceinline__ void transpose_item(const float* W, int ldw, bf16* WT, int K, int k0, int n0, LAS float* scr, int lane, CM cm) {
    const int nn = lane & 31, sc = cm(n0 + nn);
#pragma unroll 8
    for (int i = 0; i < 32; ++i) { const int kk = 2 * i + (lane >> 5); scr[kk * 33 + nn] = sc >= 0 ? W[(size_t)(k0 + kk) * ldw + sc] : 0.f; }
    LDS_WAIT(); asm volatile("" ::: "memory");
    const int c = lane & 7;
#pragma unroll
    for (int j = 0; j < 4; ++j) { const int n = (lane >> 3) + 8 * j; const LAS float* s = scr + (8 * c) * 33 + n;
        v4u o; o.x = pk2(s[0 * 33], s[1 * 33]); o.y = pk2(s[2 * 33], s[3 * 33]); o.z = pk2(s[4 * 33], s[5 * 33]); o.w = pk2(s[6 * 33], s[7 * 33]);
        *(GAS v4u*)(WT + (size_t)(n0 + n) * K + k0 + 8 * c) = o; }
    LDS_WAIT(); asm volatile("" ::: "memory");
}
struct CmIdent { __device__ __forceinline__ int operator()(int n) const { return n; } };
struct CmProj { __device__ __forceinline__ int operator()(int n) const { return proj_src_col(n); } };

__device__ __forceinline__ void p0_prologue(Frame& F, const Args& args) {
    LAS float* scr = (LAS float*)(F.lds + F.wave * 16384);
    const int gw = F.vcu * NWAVES + F.wave, NGW = F.G * NWAVES;
    constexpr int I_IN = 16 * (NPROJ / 32), I_OUT = 16 * 32, I_UV = 4 * 2 * 4;
    for (int it = gw; it < I_IN + I_OUT + I_UV; it += NGW) {
        int r = it;
        if (r < I_IN) { const int kb = r / (NPROJ / 32), nb = r % (NPROJ / 32); transpose_item(P_WIN, 3792, W_WINT, 1024, 64 * kb, 32 * nb, scr, F.lane, CmProj()); continue; }
        r -= I_IN;
        if (r < I_OUT) { const int kb = r / 32, nb = r % 32; transpose_item(P_WOUT, 1024, W_WOUTT, 1024, 64 * kb, 32 * nb, scr, F.lane, CmIdent()); continue; }
        r -= I_OUT;
        { const int hd = r >> 3, kb = (r >> 2) & 1, nb = r & 3; transpose_item(P_WUV + (size_t)hd * 16384, 128, W_WUVT + (size_t)hd * 16384, 128, 64 * kb, 32 * nb, scr, F.lane, CmIdent()); }
    }
    __syncthreads();
    if (F.vcu < 192) {
        LAS float* SC = (LAS float*)F.lds;
        for (int e = F.tid; e < NB * 1024; e += NWAVES * 64) { const int b = e >> 10, k = e & 1023; SC[k * 33 + b] = siluf(P_C[e]); }
        __syncthreads();
        const int col = F.tid & 15, ks = F.tid >> 4, n = F.vcu * 16 + col;
        float acc[32];
#pragma unroll
        for (int b = 0; b < 32; ++b) acc[b] = 0.f;
        for (int kk = 0; kk < 32; ++kk) { const int k = ks * 32 + kk; const float w = P_WADA[(size_t)k * 3072 + n];
#pragma unroll
            for (int b = 0; b < 32; ++b) acc[b] += SC[k * 33 + b] * w; }
        __syncthreads();
        LAS float* RED = (LAS float*)F.lds;
#pragma unroll
        for (int b = 0; b < 32; ++b) RED[(ks * 32 + b) * 16 + col] = acc[b];
        __syncthreads();
        { const int b = F.tid >> 4; float s = 0.f;
            for (int k2 = 0; k2 < 32; ++k2) s += RED[(k2 * 32 + b) * 16 + col];
            W_MOD[b * 3072 + n] = s + P_BADA[n]; }
        __syncthreads();
    }
}

__device__ __forceinline__ void p1_norm(Frame& F, const Args& args) {
    const int gw = F.vcu * NWAVES + F.wave, NGW = F.G * NWAVES;
    for (int m = 2 * gw; m < MROWS; m += 2 * NGW) {
        const int b = m >> 11;
        const GAS f32x4* xr = (const GAS f32x4*)(P_X + (size_t)m * DM) + F.lane;
        f32x4 v[2][4]; float ss[2] = {0.f, 0.f};
#pragma unroll
        for (int q = 0; q < 2; ++q)
#pragma unroll
            for (int j = 0; j < 4; ++j) v[q][j] = xr[q * 256 + 64 * j];
#pragma unroll
        for (int q = 0; q < 2; ++q)
#pragma unroll
            for (int j = 0; j < 4; ++j) ss[q] += (v[q][j].x * v[q][j].x + v[q][j].y * v[q][j].y) + (v[q][j].z * v[q][j].z + v[q][j].w * v[q][j].w);
        const float rstd0 = rsqf_(wave_sum(ss[0]) * (1.0f / DM) + EPSF), rstd1 = rsqf_(wave_sum(ss[1]) * (1.0f / DM) + EPSF);
        const float* mb = W_MOD + b * 3072;
        GAS unsigned long long* o8 = (GAS unsigned long long*)(W_XN + (size_t)m * DM) + F.lane;
#pragma unroll
        for (int j = 0; j < 4; ++j) { const int col = F.lane * 4 + 256 * j;
            const f32x4 g = *(const f32x4*)(P_GPRE + col), sh = *(const f32x4*)(mb + col), sc = *(const f32x4*)(mb + 1024 + col);
            const f32x4 gs = g * (sc + 1.0f);
            const f32x4 o0 = v[0][j] * rstd0 * gs + sh, o1 = v[1][j] * rstd1 * gs + sh;
            o8[64 * j] = (unsigned long long)pg8::cvt_pk_bf16(o0.x, o0.y) | ((unsigned long long)pg8::cvt_pk_bf16(o0.z, o0.w) << 32);
            o8[256 + 64 * j] = (unsigned long long)pg8::cvt_pk_bf16(o1.x, o1.y) | ((unsigned long long)pg8::cvt_pk_bf16(o1.z, o1.w) << 32); }
    }
}

__device__ __forceinline__ void p5_final(Frame& F, const Args& args) {
    const int gw = F.vcu * NWAVES + F.wave, NGW = F.G * NWAVES;
    for (int m = 2 * gw; m < MROWS; m += 2 * NGW) {
        const int b = m >> 11;
        const GAS v2u* mr = (const GAS v2u*)(W_MIX + (size_t)m * DM) + F.lane;
        const GAS f32x4* xr = (const GAS f32x4*)(P_X + (size_t)m * DM) + F.lane;
        GAS f32x4* orow = (GAS f32x4*)(P_OUT + (size_t)m * DM) + F.lane;
        v2u w[2][4]; f32x4 xv[2][4];
#pragma unroll
        for (int q = 0; q < 2; ++q)
#pragma unroll
            for (int j = 0; j < 4; ++j) { w[q][j] = mr[q * 256 + 64 * j]; xv[q][j] = xr[q * 256 + 64 * j]; }
        f32x4 v[2][4]; float ss[2] = {0.f, 0.f};
#pragma unroll
        for (int q = 0; q < 2; ++q)
#pragma unroll
            for (int j = 0; j < 4; ++j) { v[q][j].x = bflo(w[q][j].x); v[q][j].y = bfhi(w[q][j].x); v[q][j].z = bflo(w[q][j].y); v[q][j].w = bfhi(w[q][j].y);
                ss[q] += (v[q][j].x * v[q][j].x + v[q][j].y * v[q][j].y) + (v[q][j].z * v[q][j].z + v[q][j].w * v[q][j].w); }
        const float rstd0 = rsqf_(wave_sum(ss[0]) * (1.0f / DM) + EPSF), rstd1 = rsqf_(wave_sum(ss[1]) * (1.0f / DM) + EPSF);
        const float* gt = W_MOD + b * 3072 + 2048;
#pragma unroll
        for (int j = 0; j < 4; ++j) { const int col = F.lane * 4 + 256 * j;
            const f32x4 g = *(const f32x4*)(P_GPOST + col), ga = *(const f32x4*)(gt + col);
            const f32x4 gg = g * ga;
            orow[64 * j] = xv[0][j] + gg * (v[0][j] * rstd0);
            orow[256 + 64 * j] = xv[1][j] + gg * (v[1][j] * rstd1); }
    }
}

__device__ __forceinline__ unsigned cvtpk(float lo, float hi) { return pg8::cvt_pk_bf16(lo, hi); }
__device__ __forceinline__ v2u pack4(float a, float b, float c, float d) { v2u r; r.x = cvtpk(a, b); r.y = cvtpk(c, d); return r; }
__device__ __forceinline__ bf16x8 pack8(float a, float b, float c, float d, float e, float f, float g, float h) { v4u r; r.x = cvtpk(a, b); r.y = cvtpk(c, d); r.z = cvtpk(e, f); r.w = cvtpk(g, h); return __builtin_bit_cast(bf16x8, r); }
__device__ __forceinline__ bf16x8 lds16(const LAS unsigned char* p) { return *(const LAS bf16x8*)p; }
__device__ __forceinline__ bf16x8 lds8x2(const LAS unsigned char* p) { const v2u lo = *(const LAS v2u*)p, hi = *(const LAS v2u*)(p + 16); v4u r; r.x = lo.x; r.y = lo.y; r.z = hi.x; r.w = hi.y; return __builtin_bit_cast(bf16x8, r); }
template <int S> __device__ __forceinline__ bf16x8 acc_frag(const f32x16& a) { return pack8(a[8 * S + 0], a[8 * S + 1], a[8 * S + 2], a[8 * S + 3], a[8 * S + 4], a[8 * S + 5], a[8 * S + 6], a[8 * S + 7]); }

__device__ __forceinline__ float row16_sum(float v) {
#define R16_STEP(ctrl) v += __builtin_bit_cast(float, __builtin_amdgcn_update_dpp(0, __builtin_bit_cast(int, v), ctrl, 0xf, 0xf, false))
    R16_STEP(0x121); R16_STEP(0x122); R16_STEP(0x124); R16_STEP(0x128);
#undef R16_STEP
    return v;
}

__device__ __forceinline__ void gdn_unit(Frame& F, const Args& args, const int b, const int h) {
    LAS unsigned char* const L = F.lds;
    const int tid = F.tid, lane = F.lane, wv = F.wave, l31_0 = lane & 31, hh_0 = lane >> 5;
    int tidv = tid, lanev = lane;
    constexpr int P128 = 272, P64 = 144;
    constexpr int O_KH = 0, O_QH = O_KH + 17408, O_KGT = O_QH + 17408, O_VBT = O_KGT + 18432, O_KBGT = O_VBT + 18432, O_LM = O_KBGT + 18432, O_T = O_LM + 17408,
                  O_AT = O_T + 17408, O_CW = O_AT + 9216, O_SM = O_CW + 6144, O_PSO = O_SM + 2560, O_OF = O_PSO + 2048, O_END = O_OF + 17408;
    static_assert(O_END <= SCRATCH_BYTES, "gdn LDS map");
    constexpr int O_W = O_LM, O_VNT = O_VBT;
    LAS float* const SMb = (LAS float*)(L + O_SM);
    LAS float* const LM = (LAS float*)(L + O_LM);
    LAS float* const TT = (LAS float*)(L + O_T);
    LAS float* const CW = (LAS float*)(L + O_CW);
    LAS float* const PSO = (LAS float*)(L + O_PSO);
    const int mt = wv >> 2, nt = wv & 3;
    f32x16 S[4];
#pragma unroll
    for (int k = 0; k < 4; ++k)
#pragma unroll
        for (int r = 0; r < 16; ++r) S[k][r] = 0.f;
    const float alog_e = __expf(P_ALOG[h]), dtb = P_DTB[h];
#define GDN_GATES(n_) do { LAS float* _sm = SMb + ((n_) & 1) * 320; const float* _ap = W_AUX + (size_t)(b * SEQ + (n_) * 64 + lanev) * 16; \
        const float _bb = _ap[h], _aa = _ap[4 + h]; const float _beta = rcpf_(1.0f + __expf(-_bb)); const float _xs = _aa + dtb; \
        const float _sp = _xs > 20.f ? _xs : log1pf(__expf(_xs)); float _gc = -alog_e * _sp; \
        _Pragma("unroll") for (int _o = 1; _o < 64; _o <<= 1) { const float _t = __shfl_up(_gc, _o); if (lanev >= _o) _gc += _t; } \
        const float _gl = __shfl(_gc, 63); _sm[lanev] = _gc; _sm[64 + lanev] = _beta; _sm[128 + lanev] = __expf(_gc); _sm[192 + lanev] = __expf(_gl - _gc); \
        if (lanev == 0) _sm[256] = __expf(_gl); } while (0)
    if (wv == 6) GDN_GATES(0);
    for (int e = tidv; e < 3 * 4 * 128; e += NWAVES * 64) { const int ts_ = e >> 9, tap = (e >> 7) & 3, ch = e & 127; CW[e] = P_CONVW[tap * 1536 + ts_ * 512 + h * 128 + ch]; }
    const int ts = tid >> 8;
    int cgv = tid & 15, tpv = (tid >> 4) & 15;
#define GDN_ROWS(dst_, n_, chan_) do { const bf16* _src = W_PROJ + (size_t)(b * SEQ + (n_) * 64 + 4 * tpv - 3) * NPROJ + (chan_); \
        _Pragma("unroll") for (int _i = 0; _i < 7; ++_i) { v4u _z; _z.x = 0u; _z.y = 0u; _z.z = 0u; _z.w = 0u; dst_[_i] = _z; \
            if ((n_) > 0 || 4 * tpv - 3 + _i >= 0) dst_[_i] = *(const GAS v4u*)(_src + (size_t)_i * NPROJ); } } while (0)
#define GDN_OUT(rowb_) do { const int _tok = tidv >> 3, _dv0 = (tidv & 7) * 16; const size_t _row = (size_t)(rowb_) + _tok; \
        const LAS v4u* _op = (const LAS v4u*)(L + O_OF + _tok * P128 + _dv0 * 2); const v4u _o0 = _op[0], _o1 = _op[1]; \
        const LAS f32x4* _pp = (const LAS f32x4*)(PSO + _tok * 8); const f32x4 _a = _pp[0], _c = _pp[1]; \
        const float _rstd = rsqf_((((_a.x + _a.y) + (_a.z + _a.w)) + ((_c.x + _c.y) + (_c.z + _c.w))) * (1.0f / 128.0f) + EPSF); \
        const bf16* _zp = W_PROJ + _row * NPROJ + C_ZA + h * 128 + _dv0; const v4u _z0 = *(const GAS v4u*)_zp, _z1 = *(const GAS v4u*)(_zp + 8); \
        const unsigned _ow[8] = {_o0.x, _o0.y, _o0.z, _o0.w, _o1.x, _o1.y, _o1.z, _o1.w}, _zw[8] = {_z0.x, _z0.y, _z0.z, _z0.w, _z1.x, _z1.y, _z1.z, _z1.w}; unsigned _rw[8]; \
        _Pragma("unroll") for (int _k = 0; _k < 4; ++_k) { const f32x4 _g = *(const f32x4*)(P_GGDN + _dv0 + 4 * _k); \
            _rw[2 * _k] = cvtpk(bflo(_ow[2 * _k]) * _rstd * _g.x * siluf(bflo(_zw[2 * _k])), bfhi(_ow[2 * _k]) * _rstd * _g.y * siluf(bfhi(_zw[2 * _k]))); \
            _rw[2 * _k + 1] = cvtpk(bflo(_ow[2 * _k + 1]) * _rstd * _g.z * siluf(bflo(_zw[2 * _k + 1])), bfhi(_ow[2 * _k + 1]) * _rstd * _g.w * siluf(bfhi(_zw[2 * _k + 1]))); } \
        bf16* _dst = W_OAB + _row * DM + h * 128 + _dv0; v4u _w0, _w1; _w0.x = _rw[0]; _w0.y = _rw[1]; _w0.z = _rw[2]; _w0.w = _rw[3]; _w1.x = _rw[4]; _w1.y = _rw[5]; _w1.z = _rw[6]; _w1.w = _rw[7]; \
        *(GAS v4u*)_dst = _w0; *(GAS v4u*)(_dst + 8) = _w1; } while (0)
    __syncthreads();

    unsigned pf_sink = 0u;
    for (int n = 0; n < 32; ++n) {
        const int rowbase = b * SEQ + n * 64;
        LAS float* const SMf = SMb + (n & 1) * 320;
        tidv = tid; lanev = lane; cgv = tid & 15; tpv = (tid >> 4) & 15;
        asm volatile("" : "+v"(tidv), "+v"(lanev), "+v"(cgv), "+v"(tpv));
        int l31 = lanev & 31, hh = lanev >> 5, cg = cgv, tp = tpv;
        if (wv == 6 && n + 1 < 32) GDN_GATES(n + 1);
        float val[4][8];
#define GDN_CONV(rows_, tsel_) do { \
            _Pragma("unroll") for (int _j = 0; _j < 4; ++_j) _Pragma("unroll") for (int _e = 0; _e < 8; ++_e) val[_j][_e] = 0.f; \
            _Pragma("unroll") for (int _tap = 0; _tap < 4; ++_tap) { const LAS f32x4* _cp = (const LAS f32x4*)(CW + ((tsel_) * 4 + _tap) * 128 + cg * 8); const f32x4 _c0 = _cp[0], _c1 = _cp[1]; \
                const float _cw[8] = {_c0.x, _c0.y, _c0.z, _c0.w, _c1.x, _c1.y, _c1.z, _c1.w}; \
                _Pragma("unroll") for (int _j = 0; _j < 4; ++_j) { const v4u _raw = rows_[_j + _tap]; \
                    const float _in[8] = {bflo(_raw.x), bfhi(_raw.x), bflo(_raw.y), bfhi(_raw.y), bflo(_raw.z), bfhi(_raw.z), bflo(_raw.w), bfhi(_raw.w)}; \
                    _Pragma("unroll") for (int _e = 0; _e < 8; ++_e) val[_j][_e] += _in[_e] * _cw[_e]; } } \
            _Pragma("unroll") for (int _j = 0; _j < 4; ++_j) _Pragma("unroll") for (int _e = 0; _e < 8; ++_e) val[_j][_e] = siluf(val[_j][_e]); } while (0)
        v4u rq[7], rv[7];
        GDN_ROWS(rq, n, ts * 512 + h * 128 + cgv * 8);
        if (wv < 4) GDN_ROWS(rv, n, 1024 + h * 128 + cgv * 8);
        if (wv == 7 && n + 1 < 32) {
#pragma unroll
            for (int i = 0; i < 9; ++i) { const int idx = i * 64 + lanev; const int rr = idx >> 3, ln = idx & 7;
                if (idx < 67 * 8) { const bf16* pt = W_PROJ + (size_t)(rowbase + 61 + rr) * NPROJ + (ln >> 1) * 512 + h * 128 + (ln & 1) * 64;
                    asm volatile("global_load_dword %0, %1, off" : "+v"(pf_sink) : "v"(pt) : "memory"); } }
        }
        {
            GDN_CONV(rq, ts);
#pragma unroll
            for (int j = 0; j < 4; ++j) { float ss = 0.f;
#pragma unroll
                for (int e = 0; e < 8; ++e) ss += val[j][e] * val[j][e];
                ss = row16_sum(ss);
                float r = rsqf_(ss + EPSF); if (ts == 0) r *= 0.08838834764831845f;
#pragma unroll
                for (int e = 0; e < 8; ++e) val[j][e] *= r; }
            if (ts == 0) {
#pragma unroll
                for (int j = 0; j < 4; ++j) *(LAS bf16x8*)(L + O_QH + (4 * tp + j) * P128 + cg * 16) = pack8(val[j][0], val[j][1], val[j][2], val[j][3], val[j][4], val[j][5], val[j][6], val[j][7]);
            } else {
                float ek[4], bg[4];
#pragma unroll
                for (int j = 0; j < 4; ++j) { ek[j] = SMf[192 + 4 * tp + j]; bg[j] = SMf[64 + 4 * tp + j] * SMf[128 + 4 * tp + j]; }
#pragma unroll
                for (int j = 0; j < 4; ++j) *(LAS bf16x8*)(L + O_KH + (4 * tp + j) * P128 + cg * 16) = pack8(val[j][0], val[j][1], val[j][2], val[j][3], val[j][4], val[j][5], val[j][6], val[j][7]);
#pragma unroll
                for (int e = 0; e < 8; ++e) {
                    *(LAS v2u*)(L + O_KGT + (cg * 8 + e) * P64 + tp * 8) = pack4(val[0][e] * ek[0], val[1][e] * ek[1], val[2][e] * ek[2], val[3][e] * ek[3]);
                    *(LAS v2u*)(L + O_KBGT + (cg * 8 + e) * P64 + tp * 8) = pack4(val[0][e] * bg[0], val[1][e] * bg[1], val[2][e] * bg[2], val[3][e] * bg[3]); }
            }
        }
        if (n > 0) GDN_OUT(rowbase - 64);
        if (wv < 4) {
            GDN_CONV(rv, 2);
            float be[4];
#pragma unroll
            for (int j = 0; j < 4; ++j) be[j] = SMf[64 + 4 * tp + j];
#pragma unroll
            for (int e = 0; e < 8; ++e) *(LAS v2u*)(L + O_VBT + (cg * 8 + e) * P64 + tp * 8) = pack4(val[0][e] * be[0], val[1][e] * be[1], val[2][e] * be[2], val[3][e] * be[3]);
        }
        for (int e = tidv; e < 64 * 68; e += NWAVES * 64) TT[e] = 0.f;
        __syncthreads();
        if (wv < 4) {
            const int ti = wv >> 1, tj = wv & 1;
            f32x16 C;
#pragma unroll
            for (int r = 0; r < 16; ++r) C[r] = 0.f;
            if (ti >= tj) {
#pragma unroll
                for (int s = 0; s < 8; ++s) C = MFMA32(lds16(L + O_KH + (32 * ti + l31) * P128 + (16 * s + 8 * hh) * 2), lds16(L + O_KH + (32 * tj + l31) * P128 + (16 * s + 8 * hh) * 2), C);
            }
            const int j = 32 * tj + l31; const float gcj = SMf[j];
#pragma unroll
            for (int g = 0; g < 4; ++g) { const int ib = 32 * ti + 8 * g + 4 * hh; const f32x4 gci = *(const LAS f32x4*)(SMf + ib), bei = *(const LAS f32x4*)(SMf + 64 + ib);
#pragma unroll
                for (int e = 0; e < 4; ++e) { const int i = ib + e; LM[i * 68 + j] = (i > j) ? bei[e] * C[4 * g + e] * __expf(gci[e] - gcj) : 0.f; } }
        } else {
            const int w4 = wv - 4, tj = w4 >> 1, ti = w4 & 1;
            f32x16 C;
#pragma unroll
            for (int r = 0; r < 16; ++r) C[r] = 0.f;
            if (ti >= tj) {
#pragma unroll
                for (int s = 0; s < 8; ++s) C = MFMA32(lds16(L + O_KH + (32 * tj + l31) * P128 + (16 * s + 8 * hh) * 2), lds16(L + O_QH + (32 * ti + l31) * P128 + (16 * s + 8 * hh) * 2), C);
            }
            const int i = 32 * ti + l31; const float gci = SMf[i];
#pragma unroll
            for (int g = 0; g < 4; ++g) { const int jb = 32 * tj + 8 * g + 4 * hh; const f32x4 gcj = *(const LAS f32x4*)(SMf + jb); float v[4];
#pragma unroll
                for (int e = 0; e < 4; ++e) v[e] = (i >= jb + e) ? C[4 * g + e] * __expf(gci - gcj[e]) : 0.f;
                *(LAS v2u*)(L + O_AT + i * P64 + jb * 2) = pack4(v[0], v[1], v[2], v[3]); }
        }
        __syncthreads();
        if (wv < 2) {
            const int a = 2 * wv, bq = 2 * wv + 1;
            if (lanev < 32) {
                const int blk = a + (lanev >> 4), c = lanev & 15; float x[16];
#pragma unroll
                for (int i = 0; i < 16; ++i) { const LAS float* lr = LM + (16 * blk + i) * 68 + 16 * blk; float acc = (i == c) ? 1.f : 0.f;
#pragma unroll
                    for (int j = 0; j < i; ++j) acc -= lr[j] * x[j];
                    x[i] = acc; TT[(16 * blk + i) * 68 + 16 * blk + c] = acc; }
            }
            asm volatile("s_waitcnt lgkmcnt(0)" ::: "memory");
            const int m = lanev & 15, q = lanev >> 4;
            f32x4 P = {0.f, 0.f, 0.f, 0.f}, R = {0.f, 0.f, 0.f, 0.f};
#pragma unroll
            for (int s = 0; s < 4; ++s) { const int k = q + 4 * s; P = MFMA16F(LM[(16 * bq + m) * 68 + 16 * a + k], TT[(16 * a + k) * 68 + 16 * a + m], P); }
#pragma unroll
            for (int rg = 0; rg < 4; ++rg) { const int k = 4 * q + rg; R = MFMA16F(TT[(16 * bq + m) * 68 + 16 * bq + k], P[rg], R); }
#pragma unroll
            for (int rg = 0; rg < 4; ++rg) TT[(16 * bq + 4 * q + rg) * 68 + 16 * a + m] = -R[rg];
        }
        __syncthreads();
        if (wv < 4) {
            const int m = lanev & 15, q = lanev >> 4, mi = wv >> 1, ni = wv & 1;
            f32x4 P0 = {0.f, 0.f, 0.f, 0.f}, P1 = {0.f, 0.f, 0.f, 0.f}, R = {0.f, 0.f, 0.f, 0.f};
#pragma unroll
            for (int s = 0; s < 8; ++s) { const int k = q + 4 * s; const float bt = TT[k * 68 + 16 * ni + m];
                P0 = MFMA16F(LM[(32 + m) * 68 + k], bt, P0); P1 = MFMA16F(LM[(48 + m) * 68 + k], bt, P1); }
#pragma unroll
            for (int rg = 0; rg < 4; ++rg) { R = MFMA16F(TT[(32 + 16 * mi + m) * 68 + 32 + 4 * q + rg], P0[rg], R); R = MFMA16F(TT[(32 + 16 * mi + m) * 68 + 48 + 4 * q + rg], P1[rg], R); }
#pragma unroll
            for (int rg = 0; rg < 4; ++rg) TT[(32 + 16 * mi + 4 * q + rg) * 68 + 16 * ni + m] = -R[rg];
        }
        __syncthreads();
        f32x16 U, WT_;
#pragma unroll
        for (int r = 0; r < 16; ++r) { U[r] = 0.f; WT_[r] = 0.f; }
#pragma unroll
        for (int s = 0; s < 4; ++s) { const LAS f32x4* tp4 = (const LAS f32x4*)(TT + (32 * mt + l31) * 68 + 16 * s + 8 * hh); const f32x4 t0 = tp4[0], t1 = tp4[1];
            const bf16x8 a = pack8(t0.x, t0.y, t0.z, t0.w, t1.x, t1.y, t1.z, t1.w);
            U = MFMA32(a, lds16(L + O_VBT + (32 * nt + l31) * P64 + (16 * s + 8 * hh) * 2), U);
            WT_ = MFMA32(lds16(L + O_KBGT + (32 * nt + l31) * P64 + (16 * s + 8 * hh) * 2), a, WT_); }
#pragma unroll
        for (int g = 0; g < 4; ++g) *(LAS v2u*)(L + O_W + (32 * mt + l31) * P128 + (32 * nt + 8 * g + 4 * hh) * 2) = pack4(-WT_[4 * g], -WT_[4 * g + 1], -WT_[4 * g + 2], -WT_[4 * g + 3]);
        __syncthreads();
        bf16x8 sf[4][2];
#pragma unroll
        for (int kt = 0; kt < 4; ++kt) { sf[kt][0] = acc_frag<0>(S[kt]); sf[kt][1] = acc_frag<1>(S[kt]); }
#pragma unroll
        for (int kt = 0; kt < 4; ++kt)
#pragma unroll
            for (int s = 0; s < 2; ++s) U = MFMA32(lds8x2(L + O_W + (32 * mt + l31) * P128 + (32 * kt + 16 * s + 4 * hh) * 2), sf[kt][s], U);
#pragma unroll
        for (int g = 0; g < 4; ++g) *(LAS v2u*)(L + O_VNT + (32 * nt + l31) * P64 + (32 * mt + 8 * g + 4 * hh) * 2) = pack4(U[4 * g], U[4 * g + 1], U[4 * g + 2], U[4 * g + 3]);
        __syncthreads();
        {
            f32x16 Oa;
#pragma unroll
            for (int r = 0; r < 16; ++r) Oa[r] = 0.f;
#pragma unroll
            for (int kt = 0; kt < 4; ++kt)
#pragma unroll
                for (int s = 0; s < 2; ++s) Oa = MFMA32(lds8x2(L + O_QH + (32 * mt + l31) * P128 + (32 * kt + 16 * s + 4 * hh) * 2), sf[kt][s], Oa);
#pragma unroll
            for (int g = 0; g < 4; ++g) { const f32x4 e4 = *(const LAS f32x4*)(SMf + 128 + 32 * mt + 8 * g + 4 * hh);
#pragma unroll
                for (int e = 0; e < 4; ++e) Oa[4 * g + e] *= e4[e]; }
            bf16x8 vn[4];
#pragma unroll
            for (int s = 0; s < 4; ++s) vn[s] = lds16(L + O_VNT + (32 * nt + l31) * P64 + (16 * s + 8 * hh) * 2);
#pragma unroll
            for (int s = 0; s < 4; ++s) Oa = MFMA32(lds16(L + O_AT + (32 * mt + l31) * P64 + (16 * s + 8 * hh) * 2), vn[s], Oa);
            const float glast = SMf[256];
#pragma unroll
            for (int kt = 0; kt < 4; ++kt) {
#pragma unroll
                for (int r = 0; r < 16; ++r) S[kt][r] *= glast;
#pragma unroll
                for (int s = 0; s < 4; ++s) S[kt] = MFMA32(lds16(L + O_KGT + (32 * kt + l31) * P64 + (16 * s + 8 * hh) * 2), vn[s], S[kt]);
            }
#pragma unroll
            for (int r = 0; r < 16; ++r) { const float q2 = row16_sum(Oa[r] * Oa[r]);
                if ((lanev & 15) == 0) PSO[(32 * mt + 8 * (r >> 2) + 4 * hh + (r & 3)) * 8 + 2 * nt + ((lanev >> 4) & 1)] = q2;
                *(LAS unsigned short*)(L + O_OF + (32 * mt + 8 * (r >> 2) + 4 * hh + (r & 3)) * P128 + (32 * nt + l31) * 2) = (unsigned short)cvtpk(Oa[r], 0.f); }
        }
        asm volatile("s_waitcnt vmcnt(0)" : "+v"(pf_sink) :: "memory");
        __syncthreads();
    }
    GDN_OUT(b * SEQ + 31 * 64);
    __syncthreads();
#undef GDN_GATES
#undef GDN_CONV
#undef GDN_ROWS
#undef GDN_OUT
}

template <int NREG>
__device__ __forceinline__ void dsa_select(const float* const scw, LAS unsigned* const MASK, const int wv, const int lane, const int t0, const int nk) {
    const float NINF = -__builtin_inff();
    const unsigned long long lt_mask = (1ull << lane) - 1ull;
    float xn[NREG];
#pragma unroll
    for (int i = 0; i < NREG; ++i) xn[i] = __hip_atomic_load(scw + i * 64 + lane, __ATOMIC_RELAXED, __HIP_MEMORY_SCOPE_AGENT);
#pragma unroll 1
    for (int ql_ = 0; ql_ < 8; ++ql_) {
        const int ql = ql_ & 7;
        const int tq = t0 + 8 * wv + ql;
        LAS unsigned* const mrow = MASK + (8 * wv + ql) * 64;
        float x[NREG];
#pragma unroll
        for (int i = 0; i < NREG; ++i) x[i] = (i * 64 + lane < nk) ? xn[i] : NINF;
        if (ql_ + 1 < 8) {
#pragma unroll
            for (int i = 0; i < NREG; ++i) xn[i] = __hip_atomic_load(scw + ((ql_ + 1) & 7) * 2048 + i * 64 + lane, __ATOMIC_RELAXED, __HIP_MEMORY_SCOPE_AGENT);
        }
        if (tq + 1 > 256) {
            float vmin = __builtin_inff(), vmax = NINF;
#pragma unroll
            for (int i = 0; i < NREG; ++i) { vmax = fmaxf(vmax, x[i]); vmin = fminf(vmin, x[i] == NINF ? __builtin_inff() : x[i]); }
            vmin = -wave_max(-vmin); vmax = wave_max(vmax);
#define CNT_GE(p_, dst_) do { int _c0 = 0, _c1 = 0, _c2 = 0, _c3 = 0; const float _p = (p_); \
                _Pragma("unroll") for (int _i = 0; _i < NREG; _i += 4) \
                    asm volatile("v_cmp_le_f32_e64 s[90:91], %8, %4\n\tv_cmp_le_f32_e64 s[92:93], %8, %5\n\tv_cmp_le_f32_e64 s[94:95], %8, %6\n\tv_cmp_le_f32_e64 s[96:97], %8, %7\n\t" \
                                 "v_addc_co_u32_e64 %0, s[90:91], 0, %0, s[90:91]\n\tv_addc_co_u32_e64 %1, s[92:93], 0, %1, s[92:93]\n\tv_addc_co_u32_e64 %2, s[94:95], 0, %2, s[94:95]\n\tv_addc_co_u32_e64 %3, s[96:97], 0, %3, s[96:97]" \
                                 : "+v"(_c0), "+v"(_c1), "+v"(_c2), "+v"(_c3) : "v"(x[_i]), "v"(x[_i + 1]), "v"(x[_i + 2]), "v"(x[_i + 3]), "s"(_p) : "s90", "s91", "s92", "s93", "s94", "s95", "s96", "s97"); \
                dst_ = wave_sum_i((_c0 + _c1) + (_c2 + _c3)); } while (0)
            float lo = vmin, hi = vmax, thr; int chi; bool tie = false;
            CNT_GE(hi, chi);
            if (chi == 256) thr = hi;
            else if (chi > 256) { tie = true; lo = hi; chi = 0; hi = __builtin_inff(); }
            else {
#pragma unroll 1
                for (;;) {
                    const float mid = 0.5f * (lo + hi);
                    if (!(mid > lo && mid < hi)) { tie = true; break; }
                    int c; CNT_GE(mid, c);
                    if (c == 256) { thr = mid; break; }
                    if (c > 256) lo = mid; else { hi = mid; chi = c; }
                }
            }
#undef CNT_GE
            if (!tie) {
#pragma unroll
                for (int i = 0; i < NREG; ++i) { const unsigned long long bs = __ballot(x[i] >= thr);
                    if (lane == 0) { v2u w; w.x = (unsigned)bs; w.y = (unsigned)(bs >> 32); *(LAS v2u*)(mrow + 2 * i) = w; } }
            } else {
                const int need = 256 - chi; int before = 0;
#pragma unroll
                for (int i = 0; i < NREG; ++i) { const bool eq = (x[i] == lo); const unsigned long long be = __ballot(eq);
                    const int rank = before + __popcll(be & lt_mask); const bool sel = (x[i] >= hi) || (eq && rank < need); before += __popcll(be);
                    const unsigned long long bs = __ballot(sel);
                    if (lane == 0) { v2u w; w.x = (unsigned)bs; w.y = (unsigned)(bs >> 32); *(LAS v2u*)(mrow + 2 * i) = w; } }
            }
        } else {
#pragma unroll
            for (int i = 0; i < NREG; ++i) { const unsigned long long bs = __ballot(i * 64 + lane <= tq);
                if (lane == 0) { v2u w; w.x = (unsigned)bs; w.y = (unsigned)(bs >> 32); *(LAS v2u*)(mrow + 2 * i) = w; } }
        }
    }
}

__device__ __forceinline__ void dsa_unit(Frame& F, const Args& args, const int b, const int qb, const float mb2) {
    LAS unsigned char* const L = F.lds;
    const int tid = F.tid, lane = F.lane, wv = F.wave, l31_0 = lane & 31, hh_0 = lane >> 5;
    int l31 = l31_0, hh = hh_0;
    constexpr int PK = 272, PV = 144;
    constexpr int O_K0 = 0, O_V0 = 17408, BUFSZ = 35840, O_MASK = 2 * BUFSZ, O_RS = O_MASK + 16384, O_BT = O_RS + 8192, O_END = O_BT + 2048, O_OA = 0;
    static_assert(O_END <= SCRATCH_BYTES && 4 * 17408 <= 2 * BUFSZ, "dsa LDS map");
    const int t0 = 64 * qb, nk = 64 * (qb + 1);
    const size_t rb = (size_t)b * SEQ;
    LAS unsigned* const MASK = (LAS unsigned*)(L + O_MASK);
    LAS float* const RS = (LAS float*)(L + O_RS);
    LAS float* const BT = (LAS float*)(L + O_BT);
    const float NINF = -__builtin_inff();
    for (int key = tid; key < nk; key += NWAVES * 64) { const f32x4 s4 = *(const f32x4*)(W_KVSS + (rb + key) * 4); RS[key] = rsqf_(((s4.x + s4.y) + (s4.z + s4.w)) * (1.0f / 128.0f) + EPSF); }
    BT[tid] = P_RELB[T5_BUCKET[tid >> 2] * 4 + (tid & 3)] * LOG2E;
    float* const scw = W_SCR + (size_t)(blockIdx.x * NWAVES + wv) * 8 * 2048;
#pragma unroll 1
    for (int rep_a = 0; rep_a < (PROBE_DUP == 41 ? 2 : 1); ++rep_a) {
        bf16x8 aq[2][4]; f32x4 wts[2][4];
#pragma unroll
        for (int rt = 0; rt < 2; ++rt) {
            const bf16* p = W_PROJ + (rb + t0 + 8 * wv + 4 * rt + (l31 >> 3)) * NPROJ + C_IQ + (l31 & 7) * 64 + 8 * hh;
#pragma unroll
            for (int s = 0; s < 4; ++s) aq[rt][s] = *(const GAS bf16x8*)(p + 16 * s);
#pragma unroll
            for (int g = 0; g < 4; ++g) wts[rt][g] = *(const f32x4*)(W_AUX + (rb + t0 + 8 * wv + 4 * rt + g) * 16 + 8 + 4 * hh) * 0.5f;
        }
        constexpr int O_IK = 0, IKB = 9216, PIK = 144;
        v4u sti;
#define IK_GLOAD(kt_) sti = *(const GAS v4u*)(W_PROJ + (rb + 64 * (kt_) + (tid >> 3)) * NPROJ + C_IK + (tid & 7) * 8)
#define IK_SWRITE(buf_) *(LAS v4u*)(L + O_IK + (buf_) * IKB + (tid >> 3) * PIK + (tid & 7) * 16) = sti
        IK_GLOAD(0); IK_SWRITE(0);
        __syncthreads();
#pragma unroll 1
        for (int kt6 = 0; kt6 <= qb; ++kt6) {
          const int ibuf = kt6 & 1;
          if (kt6 < qb) IK_GLOAD(kt6 + 1);
#pragma unroll
          for (int st = 0; st < 2; ++st) {
            bf16x8 bk[4];
#pragma unroll
            for (int s = 0; s < 4; ++s) bk[s] = lds16(L + O_IK + ibuf * IKB + (32 * st + l31) * PIK + (16 * s + 8 * hh) * 2);
            const int kt = 2 * kt6 + st;
            const int key = 32 * kt + l31;
            f32x16 C0, C1;
#pragma unroll
            for (int r = 0; r < 16; ++r) { C0[r] = 0.f; C1[r] = 0.f; }
#pragma unroll
            for (int s = 0; s < 4; ++s) C0 = MFMA32(aq[0][s], bk[s], C0);
#pragma unroll
            for (int s = 0; s < 4; ++s) C1 = MFMA32(aq[1][s], bk[s], C1);
            float pp[2][4];
#pragma unroll
            for (int g = 0; g < 4; ++g) {
                float p0 = 0.f, p1 = 0.f;
#pragma unroll
                for (int e2 = 0; e2 < 4; ++e2) { const float w0 = wts[0][g][e2], w1 = wts[1][g][e2], x0 = C0[4 * g + e2], x1 = C1[4 * g + e2];
                    p0 = __builtin_fmaf(w0, x0, p0); p0 = __builtin_fmaf(w0, __builtin_fabsf(x0), p0); p1 = __builtin_fmaf(w1, x1, p1); p1 = __builtin_fmaf(w1, __builtin_fabsf(x1), p1); }
                pp[0][g] = p0; pp[1][g] = p1;
            }
            float snd[2][2], rcv[2][2];
#pragma unroll
            for (int rt = 0; rt < 2; ++rt)
#pragma unroll
                for (int g2 = 0; g2 < 2; ++g2) snd[rt][g2] = hh ? pp[rt][g2] : pp[rt][g2 + 2];
#pragma unroll
            for (int rt = 0; rt < 2; ++rt)
#pragma unroll
                for (int g2 = 0; g2 < 2; ++g2) rcv[rt][g2] = __shfl_xor(snd[rt][g2], 32);
#pragma unroll
            for (int rt = 0; rt < 2; ++rt)
#pragma unroll
                for (int g2 = 0; g2 < 2; ++g2) { const int ql = 4 * rt + g2 + 2 * hh; float p = (hh ? pp[rt][g2 + 2] : pp[rt][g2]) + rcv[rt][g2];
                    if (key > t0 + 8 * wv + ql) p = NINF;
                    scw[ql * 2048 + key] = p; }
          }
          if (kt6 < qb) IK_SWRITE(ibuf ^ 1);
          __syncthreads();
        }
#undef IK_GLOAD
#undef IK_SWRITE
    }
    __builtin_amdgcn_fence(__ATOMIC_SEQ_CST, "workgroup");
    asm volatile("s_waitcnt vmcnt(0)" ::: "memory");
    int lanev = lane; asm volatile("" : "+v"(lanev));
    if (qb < 8) dsa_select<8>(scw, MASK, wv, lanev, t0, nk);
    else if (qb < 16) dsa_select<16>(scw, MASK, wv, lanev, t0, nk);
    else if (qb < 24) dsa_select<24>(scw, MASK, wv, lanev, t0, nk);
    else dsa_select<32>(scw, MASK, wv, lanev, t0, nk);
    __syncthreads();
    const int qj = l31 >> 2, hd = l31 & 3;
    const int tql = t0 + 8 * wv + qj;
    bf16x8 qf[8]; float qn2 = 0.f;
    {
        const bf16* p = W_PROJ + (rb + tql) * NPROJ + C_QB + hd * 128 + 8 * hh; const float cs = 0.08838834764831845f * LOG2E;
#pragma unroll
        for (int s = 0; s < 8; ++s) { const v4u raw = *(const GAS v4u*)(p + 16 * s); const f32x4 g0 = *(const f32x4*)(P_GKV + 16 * s + 8 * hh), g1 = *(const f32x4*)(P_GKV + 16 * s + 8 * hh + 4);
            v4u o; o.x = cvtpk(bflo(raw.x) * g0.x * cs, bfhi(raw.x) * g0.y * cs); o.y = cvtpk(bflo(raw.y) * g0.z * cs, bfhi(raw.y) * g0.w * cs);
            o.z = cvtpk(bflo(raw.z) * g1.x * cs, bfhi(raw.z) * g1.y * cs); o.w = cvtpk(bflo(raw.w) * g1.z * cs, bfhi(raw.w) * g1.w * cs);
            qn2 += (bflo(o.x) * bflo(o.x) + bfhi(o.x) * bfhi(o.x)) + (bflo(o.y) * bflo(o.y) + bfhi(o.y) * bfhi(o.y)) + (bflo(o.z) * bflo(o.z) + bfhi(o.z) * bfhi(o.z)) + (bflo(o.w) * bflo(o.w) + bfhi(o.w) * bfhi(o.w));
            qf[s] = __builtin_bit_cast(bf16x8, o); }
    }
    qn2 += __shfl_xor(qn2, 32);
    const float c0 = -(sqrtf(qn2) * 11.313708499f * 1.01f + mb2 + 1.0f);
    const float cfar = BT[127 * 4 + hd] + c0;
    f32x16 oacc[4];
#pragma unroll
    for (int d = 0; d < 4; ++d)
#pragma unroll
        for (int r = 0; r < 16; ++r) oacc[d][r] = 0.f;
    float lsum = 0.f;
    v4u st0, st1;
#define DSA_GLOAD(kt) do { const bf16* _p = W_PROJ + (rb + 64 * (kt) + lane) * NPROJ + C_CKV + wv * 16; st0 = *(const GAS v4u*)_p; st1 = *(const GAS v4u*)(_p + 8); } while (0)
#define DSA_SWRITE(buf, ktt) do { LAS unsigned char* _kb = L + (buf) * BUFSZ; const float _r = RS[64 * (ktt) + lane]; \
        v4u _n0, _n1; _n0.x = cvtpk(bflo(st0.x) * _r, bfhi(st0.x) * _r); _n0.y = cvtpk(bflo(st0.y) * _r, bfhi(st0.y) * _r); _n0.z = cvtpk(bflo(st0.z) * _r, bfhi(st0.z) * _r); _n0.w = cvtpk(bflo(st0.w) * _r, bfhi(st0.w) * _r); \
        _n1.x = cvtpk(bflo(st1.x) * _r, bfhi(st1.x) * _r); _n1.y = cvtpk(bflo(st1.y) * _r, bfhi(st1.y) * _r); _n1.z = cvtpk(bflo(st1.z) * _r, bfhi(st1.z) * _r); _n1.w = cvtpk(bflo(st1.w) * _r, bfhi(st1.w) * _r); \
        *(LAS v4u*)(_kb + O_K0 + lane * PK + wv * 32) = _n0; *(LAS v4u*)(_kb + O_K0 + lane * PK + wv * 32 + 16) = _n1; \
        LAS unsigned short* _vt = (LAS unsigned short*)(_kb + O_V0) + (wv * 16) * 72 + lane; \
        _vt[0 * 72] = (unsigned short)_n0.x; _vt[1 * 72] = (unsigned short)(_n0.x >> 16); _vt[2 * 72] = (unsigned short)_n0.y; _vt[3 * 72] = (unsigned short)(_n0.y >> 16); \
        _vt[4 * 72] = (unsigned short)_n0.z; _vt[5 * 72] = (unsigned short)(_n0.z >> 16); _vt[6 * 72] = (unsigned short)_n0.w; _vt[7 * 72] = (unsigned short)(_n0.w >> 16); \
        _vt[8 * 72] = (unsigned short)_n1.x; _vt[9 * 72] = (unsigned short)(_n1.x >> 16); _vt[10 * 72] = (unsigned short)_n1.y; _vt[11 * 72] = (unsigned short)(_n1.y >> 16); \
        _vt[12 * 72] = (unsigned short)_n1.z; _vt[13 * 72] = (unsigned short)(_n1.z >> 16); _vt[14 * 72] = (unsigned short)_n1.w; _vt[15 * 72] = (unsigned short)(_n1.w >> 16); } while (0)
    DSA_GLOAD(0); DSA_SWRITE(0, 0);
    __syncthreads();
    for (int kt = 0; kt <= qb; ++kt) {
        const int buf = kt & 1;
        l31 = l31_0; hh = hh_0; asm volatile("" : "+v"(l31), "+v"(hh));
        if (kt < qb) DSA_GLOAD(kt + 1);
        const LAS unsigned char* kb = L + buf * BUFSZ;
#pragma unroll
        for (int st = 0; st < 2; ++st) {
            f32x16 Sa;
#pragma unroll
            for (int r = 0; r < 16; ++r) Sa[r] = 0.f;
#pragma unroll
            for (int s = 0; s < 8; ++s) Sa = MFMA32(lds16(kb + O_K0 + (32 * st + l31) * PK + (16 * s + 8 * hh) * 2), qf[s], Sa);
            const int kbase = 64 * kt + 32 * st;
            const int mwi = (int)(MASK[(8 * wv + qj) * 64 + 2 * kt + st] >> (4 * hh));
            const bool far = (t0 + 8 * wv) - (kbase + 31) >= 113;
            float pn[16];
            if (far) {
#pragma unroll
                for (int r = 0; r < 16; ++r) { const float p = __builtin_bit_cast(float, __builtin_bit_cast(int, __builtin_amdgcn_exp2f(Sa[r] + cfar)) & __builtin_amdgcn_sbfe(mwi, 8 * (r >> 2) + (r & 3), 1));
                    lsum += p; pn[r] = p; }
            } else {
#pragma unroll
                for (int r = 0; r < 16; ++r) { int dist = tql - (kbase + 8 * (r >> 2) + 4 * hh + (r & 3)); dist = dist < 0 ? 0 : (dist > 127 ? 127 : dist);
                    const float p = __builtin_bit_cast(float, __builtin_bit_cast(int, __builtin_amdgcn_exp2f(Sa[r] + (BT[dist * 4 + hd] + c0))) & __builtin_amdgcn_sbfe(mwi, 8 * (r >> 2) + (r & 3), 1));
                    lsum += p; pn[r] = p; }
            }
            const bf16x8 pf0 = pack8(pn[0], pn[1], pn[2], pn[3], pn[4], pn[5], pn[6], pn[7]), pf1 = pack8(pn[8], pn[9], pn[10], pn[11], pn[12], pn[13], pn[14], pn[15]);
#pragma unroll
            for (int dt = 0; dt < 4; ++dt) { const LAS unsigned char* vp = kb + O_V0 + (32 * dt + l31) * PV + (32 * st + 4 * hh) * 2;
                oacc[dt] = MFMA32(lds8x2(vp), pf0, oacc[dt]); oacc[dt] = MFMA32(lds8x2(vp + 32), pf1, oacc[dt]); }
        }
        if (kt < qb) DSA_SWRITE(buf ^ 1, kt + 1);
        __syncthreads();
    }
#undef DSA_GLOAD
#undef DSA_SWRITE
    lsum += __shfl_xor(lsum, 32);
    {
        const float inv = rcpf_(lsum);
#pragma unroll
        for (int dt = 0; dt < 4; ++dt)
#pragma unroll
            for (int g = 0; g < 4; ++g) { const int d = 32 * dt + 8 * g + 4 * hh; const f32x4 gk = *(const f32x4*)(P_GKV + d);
                *(LAS v2u*)(L + O_OA + hd * 17408 + (8 * wv + qj) * PK + d * 2) = pack4(oacc[dt][4 * g] * inv * gk.x, oacc[dt][4 * g + 1] * inv * gk.y, oacc[dt][4 * g + 2] * inv * gk.z, oacc[dt][4 * g + 3] * inv * gk.w); }
    }
    __syncthreads();
    {
        const int hd2 = wv >> 1, mt2 = wv & 1;
        const size_t row = rb + t0 + 32 * mt2 + l31;
        bf16x8 of[8];
#pragma unroll
        for (int s = 0; s < 8; ++s) of[s] = lds16(L + O_OA + hd2 * 17408 + (32 * mt2 + l31) * PK + (16 * s + 8 * hh) * 2);
#pragma unroll 1
        for (int et = 0; et < 4; ++et) {
            v2u zw[4];
#pragma unroll
            for (int g = 0; g < 4; ++g) zw[g] = *(const GAS v2u*)(W_PROJ + row * NPROJ + C_ZB + hd2 * 128 + 32 * et + 8 * g + 4 * hh);
            f32x16 C;
#pragma unroll
            for (int r = 0; r < 16; ++r) C[r] = 0.f;
            const bf16* wp = W_WUVT + (size_t)hd2 * 16384 + (32 * et + l31) * 128 + 8 * hh;
#pragma unroll
            for (int s = 0; s < 8; ++s) C = MFMA32(*(const GAS bf16x8*)(wp + 16 * s), of[s], C);
#pragma unroll
            for (int g = 0; g < 4; ++g)
                *(GAS v2u*)(W_OAB + row * DM + 512 + hd2 * 128 + 32 * et + 8 * g + 4 * hh) =
                    pack4(C[4 * g] * siluf(bflo(zw[g].x)), C[4 * g + 1] * siluf(bfhi(zw[g].x)), C[4 * g + 2] * siluf(bflo(zw[g].y)), C[4 * g + 3] * siluf(bfhi(zw[g].y)));
        }
    }
    __syncthreads();
}

constexpr int N_GDN = NB * 4, N_DSA = NB * 32, N_ITEMS = N_GDN + N_DSA;
constexpr int N_PHASES = 6;
__global__ void __launch_bounds__(NWAVES * 64, 2) hyb_fwd(Args args) {
    extern __shared__ __attribute__((aligned(16))) unsigned char lds[];
    Frame F;
    F.lds = (LAS unsigned char*)lds;
    F.MISC = (volatile LAS unsigned*)(F.lds + MISC_OFF);
    F.tid = threadIdx.x; F.lane = F.tid & 63; F.wave = __builtin_amdgcn_readfirstlane(F.tid >> 6);
    F.G = gridDim.x; { const int bx = blockIdx.x; F.vcu = (F.G % 8 == 0) ? (bx % 8) * (F.G / 8) + bx / 8 : bx; }
    unsigned char* ws = args.ws;
    F.ctl = (gu32*)(ws + WS_CTL);
    F.ws = ws;
    for (int u = F.tid; u < 64; u += NWAVES * 64) F.MISC[u] = 0u;
    __syncthreads();
    const int lo = args.ph_lo, hi = args.ph_hi;
    const bool multi = (hi - lo) > 1;
    XcdBarrier bar; bar.bar = (unsigned*)(F.ctl + CW_BAR) + args.li * XCD_BAR_WORDS; bar.x = 0; bar.st = nullptr;
    if (multi) bar = xcd_barrier_post((unsigned*)(F.ctl + CW_BAR) + args.li * XCD_BAR_WORDS, F.MISC + 8);
#define IN(k) (lo <= (k) && (k) < hi)
#define BOTH(k) (IN(k) && IN((k) + 1))
    if (IN(0)) { p0_prologue(F, args); if (PROBE_DUP == 7) { __syncthreads(); p0_prologue(F, args); } if (BOTH(0)) xcd_barrier(bar); }
    if (IN(1)) { p1_norm(F, args); if (PROBE_DUP == 1) p1_norm(F, args); if (BOTH(1)) xcd_barrier(bar); }
    if (IN(2)) {
        pg8::Gemm g{W_XN, W_WINT, MROWS, NPROJ, DM}; pg8::StaticOrder S; S.init(MROWS, NPROJ, F.G, (int)blockIdx.x);
        pg8::EpiProj E{W_PROJ, W_AUX, W_KVSS};
        pg8::gemm_phase<pg8::EpiProj, pg8::StaticOrder, true, true>(F.lds, g, S, E);
        if (PROBE_DUP == 2) pg8::gemm_phase<pg8::EpiProj, pg8::StaticOrder, true, true>(F.lds, g, S, E);
        if (BOTH(2)) xcd_barrier(bar);
    }
    if (IN(3)) {
#define NEXT_ITEM(dst, qw) do { if (F.tid == 0) F.MISC[4] = __hip_atomic_fetch_add(F.ctl + (qw), 1u, RLX_AGENT); __syncthreads(); dst = (int)F.MISC[4]; __syncthreads(); } while (0)
        float mb2; { const int hd_ = F.lane & 3; float m_ = P_RELB[hd_]; for (int k = 1; k < 32; ++k) m_ = fmaxf(m_, P_RELB[k * 4 + hd_]); mb2 = m_ * LOG2E; }
        int item; NEXT_ITEM(item, CW_QUEUE);
#pragma unroll 1
        for (int pass = 0; pass < (PROBE_DUP == 3 ? 2 : 1); ++pass) {
            if (pass) NEXT_ITEM(item, CW_QUEUE + 64);
            while (item < N_GDN) { gdn_unit(F, args, item >> 2, item & 3); NEXT_ITEM(item, CW_QUEUE + 64 * pass); }
        }
#pragma unroll 1
        for (int pass = 0; pass < (PROBE_DUP == 4 ? 2 : 1); ++pass) {
            if (pass) NEXT_ITEM(item, CW_QUEUE + 128);
            while (item < N_ITEMS) { if (item >= N_GDN) { const int idx = item - N_GDN; dsa_unit(F, args, idx & 31, 31 - (idx >> 5), mb2); } NEXT_ITEM(item, pass ? CW_QUEUE + 128 : CW_QUEUE); }
        }
#undef NEXT_ITEM
        if (BOTH(3)) xcd_barrier(bar);
    }
    if (IN(4)) {
        pg8::Gemm g{W_OAB, W_WOUTT, MROWS, DM, DM}; pg8::StaticOrder S; S.init(MROWS, DM, F.G, (int)blockIdx.x);
        pg8::EpiMix E{W_MIX, DM};
        pg8::gemm_phase<pg8::EpiMix, pg8::StaticOrder, true, true>(F.lds, g, S, E);
        if (PROBE_DUP == 5) pg8::gemm_phase<pg8::EpiMix, pg8::StaticOrder, true, true>(F.lds, g, S, E);
        if (BOTH(4)) xcd_barrier(bar);
    }
    if (IN(5)) { p5_final(F, args); if (PROBE_DUP == 6) p5_final(F, args); }
#undef IN
#undef BOTH
}

extern "C" void kernel_launch(void* const* d_in, const int* in_sizes, int n_in, void* d_out, int out_size, void* d_ws, size_t ws_size, hipStream_t stream) {
    static int grid = 0;
    if (grid == 0) {
        if (n_in != 15 || in_sizes[0] != MROWS * DM || out_size != MROWS * DM || ws_size < WS_END) { fprintf(stderr, "kernel_launch: unexpected shapes (n_in %d, in0 %d, out %d, ws %zu); nothing launched\n", n_in, n_in > 0 ? in_sizes[0] : -1, out_size, ws_size); grid = -1; return; }
        int dev = 0, cus = 0, per_cu = 0;
        if (hipGetDevice(&dev) != hipSuccess || hipDeviceGetAttribute(&cus, hipDeviceAttributeMultiprocessorCount, dev) != hipSuccess) { fprintf(stderr, "kernel_launch: device query failed\n"); grid = -1; return; }
        if (hipFuncSetAttribute((const void*)hyb_fwd, hipFuncAttributeMaxDynamicSharedMemorySize, LDS_BYTES) != hipSuccess) { fprintf(stderr, "kernel_launch: hipFuncSetAttribute failed\n"); grid = -1; return; }
        if (hipOccupancyMaxActiveBlocksPerMultiprocessor(&per_cu, (const void*)hyb_fwd, NWAVES * 64, LDS_BYTES) != hipSuccess || per_cu < 1)
            fprintf(stderr, "kernel_launch: note: occupancy query reports %d workgroups per CU\n", per_cu);
        (void)hipGetLastError();
        grid = cus;
    }
    if (grid < 0) return;
    if (hipMemsetAsync((char*)d_ws + WS_CTL, 0, CTL_ZERO_BYTES, stream) != hipSuccess) { fprintf(stderr, "kernel_launch: memset failed\n"); return; }
    Args a{};
    for (int i = 0; i < 15; ++i) a.in[i] = (const float*)d_in[i];
    a.out = (float*)d_out; a.ws = (unsigned char*)d_ws;
    constexpr int NL = MK_N_LAUNCHES;
    static_assert(NL == 1 || NL == 2 || NL == 3 || NL == N_PHASES, "MK_N_LAUNCHES");
    const int cuts1[2] = {0, 6}, cuts2[3] = {0, 3, 6}, cuts3[4] = {0, 3, 4, 6}, cuts6[7] = {0, 1, 2, 3, 4, 5, 6};
    const int* cuts = NL == 1 ? cuts1 : NL == 2 ? cuts2 : NL == 3 ? cuts3 : cuts6;
    for (int li = 0; li < NL; ++li) {
        a.ph_lo = cuts[li]; a.ph_hi = cuts[li + 1]; a.li = li;
        hipLaunchKernelGGL(hyb_fwd, dim3(grid), dim3(NWAVES * 64), LDS_BYTES, stream, a);
        const hipError_t le = hipPeekAtLastError();
        if (le != hipSuccess) { fprintf(stderr, "kernel_launch: launch %d failed: %s\n", li, hipGetErrorName(le)); break; }
    }
}
```

```cpp
#include <hip/hip_runtime.h>
#include <cstdio>
#include <cstdint>
#ifndef MK_N_LAUNCHES
#define MK_N_LAUNCHES 1
#endif
#ifndef PROBE_DUP
#define PROBE_DUP 0
#endif
namespace pg8 {
#define PG8_LAS __attribute__((address_space(3)))
typedef unsigned short bf16_t;
typedef short bf16x8 __attribute__((ext_vector_type(8)));
typedef float f32x4 __attribute__((ext_vector_type(4)));
typedef unsigned u32x4 __attribute__((ext_vector_type(4)));
constexpr int BM = 256, BK = 64, HALF = 128, HTB = HALF * BK * 2  , STAGE_BYTES = 8 * HTB, NXCD = 8, WGM = 8;

__host__ __device__ __forceinline__ int lds_byte(int r, int c) { const int st = (r >> 4) * 2 + (c >> 5), rr = r & 15, cc = c & 31, ob = rr * 64 + cc * 2; return st * 1024 + (ob ^ (((ob >> 9) & 1) << 5)); }
__host__ __device__ __forceinline__ void stage_rc(int b, int& R, int& C) { const int st = b / 1024, sb = b % 1024, swz = sb ^ (((sb >> 9) & 1) << 5); R = (st >> 1) * 16 + swz / 64; C = (st & 1) * 32 + (swz % 64) / 2; }
__host__ __device__ __forceinline__ int perm32(int rho) { const int n = rho >> 4, i = rho & 15; return 8 * (i >> 2) + 4 * n + (i & 3); }

struct Unit { int pm, pn; };
struct Gemm { const bf16_t* A; const bf16_t* Bt; int M, N, K; };

struct StaticOrder {
    int nM, nN, nwg, G, c;
    __host__ __device__ void init(int M, int N, int G_, int c_) { nM = M / BM; nN = N / BM; nwg = nM * nN; G = G_; c = c_; }
    __host__ __device__ bool next(int i, Unit& u) const {
        const long L = (long)i * G + c; if (L >= nwg) return false;
        int wgid = (int)L; { const int q = nwg / NXCD, r = nwg % NXCD, xcd = wgid % NXCD, off = wgid / NXCD; wgid = (xcd < r ? xcd * (q + 1) : r * (q + 1) + (xcd - r) * q) + off; }
        const int nig = WGM * nN, gid = wgid / nig, fm = gid * WGM, gsz = (nM - fm) < WGM ? (nM - fm) : WGM;
        u.pm = fm + ((wgid % nig) % gsz); u.pn = (wgid % nig) / gsz; return true;
    }
    __device__ __forceinline__ void a_ready(const Unit&) const {}
    __device__ __forceinline__ void done(const Unit&) const {}
};

typedef float f32x2c __attribute__((ext_vector_type(2))); typedef __bf16 b16x2c __attribute__((ext_vector_type(2)));
__device__ __forceinline__ unsigned cvt_pk_bf16(float lo, float hi) { const f32x2c v = {lo, hi}; return __builtin_bit_cast(unsigned, __builtin_convertvector(v, b16x2c)); }
struct EpiProj {
    static constexpr bool PERM = true, AFTER_DRAIN = false;
    bf16_t* O; float* aux; float* kvss;
    __device__ __forceinline__ void operator()(const f32x4 (&acc)[2][2][4][2], const Unit& u, int wr, int wc, int fr, int fq) const {
        const int row0 = u.pm * BM + wr * 64 + fr, col0 = u.pn * BM + wc * 32 + 8 * fq;
        const bool last = (u.pn == 14);
#pragma unroll
        for (int ai = 0; ai < 2; ++ai)
#pragma unroll
            for (int m = 0; m < 4; ++m) {
                const int row = row0 + ai * HALF + m * 16;
                bf16_t* rowp = O + (size_t)row * 3840 + col0;
#pragma unroll
                for (int bj = 0; bj < 2; ++bj) {
                    const f32x4 v0 = acc[ai][bj][m][0], v1 = acc[ai][bj][m][1];
                    u32x4 w; w.x = cvt_pk_bf16(v0[0], v0[1]); w.y = cvt_pk_bf16(v0[2], v0[3]); w.z = cvt_pk_bf16(v1[0], v1[1]); w.w = cvt_pk_bf16(v1[2], v1[3]);
                    *(u32x4*)(rowp + bj * HALF) = w;
                }
                if (last) {
                    const f32x4 a0 = acc[ai][0][m][0], a1 = acc[ai][0][m][1];
                    float ss = (a0[0] * a0[0] + a0[1] * a0[1]) + (a0[2] * a0[2] + a0[3] * a0[3]) + (a1[0] * a1[0] + a1[1] * a1[1]) + (a1[2] * a1[2] + a1[3] * a1[3]);
                    ss += __shfl_xor(ss, 16); ss += __shfl_xor(ss, 32);
                    if (fq == 0) kvss[(size_t)row * 4 + wc] = ss;
                    if (wc == 2 && fq < 2) { float* ap = aux + (size_t)row * 16 + 8 * fq; *(f32x4*)ap = acc[ai][1][m][0]; *(f32x4*)(ap + 4) = acc[ai][1][m][1]; }
                }
            }
    }
};
struct EpiF32 {
    static constexpr bool PERM = false, AFTER_DRAIN = false;
    float* C; int ldc;
    __device__ __forceinline__ void operator()(const f32x4 (&acc)[2][2][4][2], const Unit& u, int wr, int wc, int fr, int fq) const {
        const int row0 = u.pm * BM + wr * 64 + fr, col0 = u.pn * BM + wc * 32 + 4 * fq;
#pragma unroll
        for (int ai = 0; ai < 2; ++ai)
#pragma unroll
            for (int m = 0; m < 4; ++m) { float* rowp = C + (size_t)(row0 + ai * HALF + m * 16) * ldc + col0;
#pragma unroll
                for (int bj = 0; bj < 2; ++bj)
#pragma unroll
                    for (int n = 0; n < 2; ++n) *(f32x4*)(rowp + bj * HALF + n * 16) = acc[ai][bj][m][n]; }
    }
};
struct EpiMix {
    static constexpr bool PERM = true, AFTER_DRAIN = false;
    bf16_t* O; int ldc;
    __device__ __forceinline__ void operator()(const f32x4 (&acc)[2][2][4][2], const Unit& u, int wr, int wc, int fr, int fq) const {
        const int row0 = u.pm * BM + wr * 64 + fr, col0 = u.pn * BM + wc * 32 + 8 * fq;
#pragma unroll
        for (int ai = 0; ai < 2; ++ai)
#pragma unroll
            for (int m = 0; m < 4; ++m) { bf16_t* rowp = O + (size_t)(row0 + ai * HALF + m * 16) * ldc + col0;
#pragma unroll
                for (int bj = 0; bj < 2; ++bj) { const f32x4 v0 = acc[ai][bj][m][0], v1 = acc[ai][bj][m][1];
                    u32x4 w; w.x = cvt_pk_bf16(v0[0], v0[1]); w.y = cvt_pk_bf16(v0[2], v0[3]); w.z = cvt_pk_bf16(v1[0], v1[1]); w.w = cvt_pk_bf16(v1[2], v1[3]);
                    *(u32x4*)(rowp + bj * HALF) = w; } }
    }
};
template <class Epi, class Sched, bool ALIGN_EPI = false, bool SP2 = false>
__device__ __forceinline__ void gemm_phase(PG8_LAS unsigned char* lds, const Gemm g, const Sched& S, const Epi& E) {
    const int tid = threadIdx.x, wid = __builtin_amdgcn_readfirstlane(tid >> 6), lane = tid & 63, wr = wid >> 2, wc = wid & 3, fr = lane & 15, fq = lane >> 4;
    const int K = g.K, nt = K / BK;
    unsigned voffA[2], voffB[2];
#pragma unroll
    for (int i = 0; i < 2; ++i) { int R, C; stage_rc(tid * 16 + i * 8192, R, C); const int Rb = Epi::PERM ? ((R & ~31) + perm32(R & 31)) : R;
        voffA[i] = (unsigned)(R * K + C) * 2u; voffB[i] = (unsigned)(Rb * K + C) * 2u; }
    const size_t kstep = (size_t)(BK * 2);
    const size_t hstep = (size_t)HALF * K * 2;
    const size_t tstep = 2 * hstep;
    const unsigned ldsw = (unsigned)wid * 1024u;
    const int aoff = lds_byte(wr * 64 + fr, fq * 8), boff = lds_byte(wc * 32 + fr, fq * 8);
#define PG8_SA(b, h) (((b) * 2 + (h)) * HTB)
#define PG8_SB(b, h) ((4 + (b) * 2 + (h)) * HTB)
#define PG8_STAGE(bufoff, gbase, voff) do { _Pragma("unroll") for (int _i = 0; _i < 2; ++_i) \
        __builtin_amdgcn_global_load_lds((const unsigned*)((const char*)(gbase) + (voff)[_i]), (PG8_LAS unsigned*)(lds + (bufoff) + ldsw + _i * 8192), 16, 0, 0); } while (0)
#define PG8_LDA(dst, b, h) do { _Pragma("unroll") for (int m = 0; m < 4; ++m) _Pragma("unroll") for (int k = 0; k < 2; ++k) dst[m][k] = *(const PG8_LAS bf16x8*)(lds + PG8_SA(b, h) + aoff + m * 2048 + k * 1024); } while (0)
#define PG8_LDB(dst, b, h) do { _Pragma("unroll") for (int n = 0; n < 2; ++n) _Pragma("unroll") for (int k = 0; k < 2; ++k) dst[n][k] = *(const PG8_LAS bf16x8*)(lds + PG8_SB(b, h) + boff + n * 2048 + k * 1024); } while (0)
#define PG8_MMA(ai, bj, At, Bt) do { __builtin_amdgcn_s_setprio(1); _Pragma("unroll") for (int m = 0; m < 4; ++m) _Pragma("unroll") for (int n = 0; n < 2; ++n) _Pragma("unroll") for (int k = 0; k < 2; ++k) \
        acc[ai][bj][m][n] = __builtin_amdgcn_mfma_f32_16x16x32_bf16(Bt[n][k], At[m][k], acc[ai][bj][m][n], 0, 0, 0); __builtin_amdgcn_s_setprio(0); } while (0)
#define PG8_WAIT_V(n) asm volatile("s_waitcnt vmcnt(" #n ")" ::: "memory")
#define PG8_WAIT_L(n) asm volatile("s_waitcnt lgkmcnt(" #n ")" ::: "memory")
#define PG8_BAR __builtin_amdgcn_s_barrier()
#define PG8_SCHED __builtin_amdgcn_sched_barrier(0)
    Unit cur, nxt; int ui = 0;
    if (!S.next(0, cur)) return;
    f32x4 acc[2][2][4][2];
#pragma unroll
    for (int a = 0; a < 2; ++a)
#pragma unroll
        for (int b = 0; b < 2; ++b)
#pragma unroll
            for (int m = 0; m < 4; ++m)
#pragma unroll
                for (int n = 0; n < 2; ++n) acc[a][b][m][n] = (f32x4){0.f, 0.f, 0.f, 0.f};
    bf16x8 At[4][2], B0[2][2], B1[2][2];
    const char* cA = (const char*)g.A + (size_t)cur.pm * tstep; const char* cB = (const char*)g.Bt + (size_t)cur.pn * tstep;
    S.a_ready(cur);
    if constexpr (SP2) {
        PG8_STAGE(PG8_SB(0, 0), cB, voffB); PG8_STAGE(PG8_SB(0, 1), cB + hstep, voffB); PG8_STAGE(PG8_SA(0, 0), cA, voffA); PG8_STAGE(PG8_SA(0, 1), cA + hstep, voffA);
        if (wr == 1) PG8_BAR;
        PG8_WAIT_V(2); PG8_BAR;
        PG8_STAGE(PG8_SB(1, 0), cB + kstep, voffB); PG8_STAGE(PG8_SA(1, 0), cA + kstep, voffA); PG8_STAGE(PG8_SB(1, 1), cB + hstep + kstep, voffB);
        PG8_WAIT_V(6); PG8_BAR;
    } else {
        PG8_STAGE(PG8_SB(0, 0), cB, voffB); PG8_STAGE(PG8_SA(0, 0), cA, voffA); PG8_STAGE(PG8_SB(0, 1), cB + hstep, voffB); PG8_STAGE(PG8_SA(0, 1), cA + hstep, voffA);
        if (wr == 1) PG8_BAR;
        PG8_WAIT_V(4); PG8_BAR;
        PG8_STAGE(PG8_SB(1, 0), cB + kstep, voffB); PG8_STAGE(PG8_SA(1, 0), cA + kstep, voffA); PG8_STAGE(PG8_SB(1, 1), cB + hstep + kstep, voffB);
        PG8_WAIT_V(6); PG8_BAR;
    }
    for (;;) {
        const bool has_next = S.next(ui + 1, nxt);
        const char* nA = has_next ? (const char*)g.A + (size_t)nxt.pm * tstep : cA; const char* nB = has_next ? (const char*)g.Bt + (size_t)nxt.pn * tstep : cB;
        for (int t = 0; t < nt; t += 2) {
            const bool last = (t == nt - 2);
            const char* a1 = cA + (size_t)(t + 1) * kstep;
            const char* a2 = last ? nA : cA + (size_t)(t + 2) * kstep; const char* b2 = last ? nB : cB + (size_t)(t + 2) * kstep;
            const char* a3 = a2 + kstep; const char* b3 = b2 + kstep;
            if (last && has_next) S.a_ready(nxt);
            if constexpr (SP2) {
            PG8_LDB(B0, 0, 0); PG8_LDB(B1, 0, 1); PG8_SCHED; PG8_LDA(At, 0, 0); PG8_STAGE(PG8_SA(1, 1), a1 + hstep, voffA);
            PG8_WAIT_V(8); PG8_WAIT_L(0); PG8_BAR; PG8_MMA(0, 0, At, B0); PG8_MMA(0, 1, At, B1); PG8_BAR; PG8_SCHED;
            PG8_LDA(At, 0, 1); PG8_STAGE(PG8_SB(0, 0), b2, voffB); PG8_STAGE(PG8_SB(0, 1), b2 + hstep, voffB); PG8_STAGE(PG8_SA(0, 0), a2, voffA);
            PG8_WAIT_V(8); PG8_WAIT_L(0); PG8_BAR; PG8_MMA(1, 0, At, B0); PG8_MMA(1, 1, At, B1); PG8_BAR; PG8_SCHED;
            PG8_LDB(B0, 1, 0); PG8_LDB(B1, 1, 1); PG8_SCHED; PG8_LDA(At, 1, 0); PG8_STAGE(PG8_SA(0, 1), a2 + hstep, voffA);
            PG8_WAIT_V(8); PG8_WAIT_L(0); PG8_BAR; PG8_MMA(0, 0, At, B0); PG8_MMA(0, 1, At, B1); PG8_BAR; PG8_SCHED;
            PG8_LDA(At, 1, 1); PG8_STAGE(PG8_SB(1, 0), b3, voffB); PG8_STAGE(PG8_SB(1, 1), b3 + hstep, voffB); PG8_STAGE(PG8_SA(1, 0), a3, voffA);
            PG8_WAIT_V(8); PG8_WAIT_L(0); PG8_BAR; PG8_MMA(1, 0, At, B0); PG8_MMA(1, 1, At, B1); PG8_BAR; PG8_SCHED;
            } else {
            PG8_LDB(B0, 0, 0); PG8_SCHED; PG8_LDA(At, 0, 0); PG8_STAGE(PG8_SA(1, 1), a1 + hstep, voffA);
            PG8_WAIT_L(8); PG8_BAR; PG8_WAIT_L(0); PG8_MMA(0, 0, At, B0); PG8_BAR; PG8_SCHED;
            PG8_LDB(B1, 0, 1); PG8_STAGE(PG8_SB(0, 0), b2, voffB);
            PG8_BAR; PG8_WAIT_L(0); PG8_MMA(0, 1, At, B1); PG8_BAR;
            PG8_LDA(At, 0, 1); PG8_STAGE(PG8_SA(0, 0), a2, voffA);
            PG8_BAR; PG8_WAIT_L(0); PG8_MMA(1, 0, At, B0); PG8_BAR; PG8_SCHED;
            PG8_STAGE(PG8_SB(0, 1), b2 + hstep, voffB);
            PG8_WAIT_V(6); PG8_BAR; PG8_MMA(1, 1, At, B1); PG8_BAR;
            PG8_LDB(B0, 1, 0); PG8_SCHED; PG8_LDA(At, 1, 0); PG8_STAGE(PG8_SA(0, 1), a2 + hstep, voffA);
            PG8_WAIT_L(8); PG8_BAR; PG8_WAIT_L(0); PG8_MMA(0, 0, At, B0); PG8_BAR; PG8_SCHED;
            PG8_LDB(B1, 1, 1); PG8_STAGE(PG8_SB(1, 0), b3, voffB);
            PG8_BAR; PG8_WAIT_L(0); PG8_MMA(0, 1, At, B1); PG8_BAR;
            PG8_LDA(At, 1, 1); PG8_STAGE(PG8_SA(1, 0), a3, voffA);
            PG8_BAR; PG8_WAIT_L(0); PG8_MMA(1, 0, At, B0); PG8_BAR; PG8_SCHED;
            PG8_STAGE(PG8_SB(1, 1), b3 + hstep, voffB);
            PG8_WAIT_V(6); PG8_BAR; PG8_MMA(1, 1, At, B1); PG8_BAR;
            }
        }
        if constexpr (ALIGN_EPI) { if (wr == 0) PG8_BAR; }
        if constexpr (!Epi::AFTER_DRAIN) { E(acc, cur, wr, wc, fr, fq); S.done(cur); }
        if (!has_next) break;
#pragma unroll
        for (int a = 0; a < 2; ++a)
#pragma unroll
            for (int b = 0; b < 2; ++b)
#pragma unroll
                for (int m = 0; m < 4; ++m)
#pragma unroll
                    for (int n = 0; n < 2; ++n) acc[a][b][m][n] = (f32x4){0.f, 0.f, 0.f, 0.f};
        cur = nxt; cA = nA; cB = nB; ++ui;
        if constexpr (ALIGN_EPI) { if (wr == 1) PG8_BAR; }
    }
    PG8_WAIT_V(0);
    if constexpr (!ALIGN_EPI) { if (wr == 0) PG8_BAR; }
    PG8_BAR;
    if constexpr (Epi::AFTER_DRAIN) { E.fused(acc, cur, wr, wc, fr, fq, lds, wid, lane); S.done(cur); }
#undef PG8_SA
#undef PG8_SB
#undef PG8_STAGE
#undef PG8_LDA
#undef PG8_LDB
#undef PG8_MMA
#undef PG8_WAIT_V
#undef PG8_WAIT_L
#undef PG8_BAR
#undef PG8_SCHED
}
}

constexpr int NWAVES = 8;
constexpr int NB = 32, SEQ = 2048, DM = 1024, MROWS = NB * SEQ;
constexpr int NPROJ = 3840;
constexpr int C_ZA = 1536, C_QB = 2048, C_ZB = 2560, C_IQ = 3072, C_CKV = 3584, C_IK = 3712;
constexpr float EPSF = 1e-6f;
constexpr float LOG2E = 1.4426950408889634f;
__host__ __device__ __forceinline__ int proj_src_col(int n) {
    if (n < 2048) return n;
    if (n < 2560) return n - 2048 + 2056;
    if (n < 3072) return n - 2560 + 2696;
    if (n < 3584) return n - 3072 + 3208;
    if (n < 3712) return n - 3584 + 2568;
    if (n < 3776) return n - 3712 + 3720;
    if (n < 3784) return n - 3776 + 2048;
    if (n < 3792) return n;
    return -1;
}
__device__ const unsigned char T5_BUCKET[128] = {0,1,2,3,4,5,6,7,8,9,10,11,12,13,14,15,16,16,16,17,17,18,18,18,19,19,19,20,20,20,20,21,21,21,21,22,22,22,22,22,23,23,23,23,23,23,24,24,24,24,24,24,25,25,25,25,25,25,25,26,26,26,26,26,26,26,26,27,27,27,27,27,27,27,27,27,27,28,28,28,28,28,28,28,28,28,28,29,29,29,29,29,29,29,29,29,29,29,29,30,30,30,30,30,30,30,30,30,30,30,30,30,30,31,31,31,31,31,31,31,31,31,31,31,31,31,31,31};

constexpr size_t MiB = 1u << 20;
constexpr size_t WS_CTL = 0, CTL_ZERO_BYTES = 1 * MiB;
constexpr size_t WS_MOD = 1 * MiB;
constexpr size_t WS_WUV = 2 * MiB;
constexpr size_t WS_WOUT = 3 * MiB;
constexpr size_t WS_WIN = 5 * MiB;
constexpr size_t WS_KVSS = 13 * MiB;
constexpr size_t WS_AUX = 14 * MiB;
constexpr size_t WS_XN = 32 * MiB;
constexpr size_t WS_PROJ = 160 * MiB;
constexpr size_t WS_SCR = 640 * MiB;
constexpr size_t WS_END = 768 * MiB;
constexpr int CW_TMO = 0, CW_QUEUE = 64, CW_BAR = 4096;

constexpr int LDS_BYTES = 163840;
constexpr int MISC_OFF = LDS_BYTES - 256;
constexpr int SCRATCH_BYTES = MISC_OFF;

#define GAS __attribute__((address_space(1)))
#define LAS __attribute__((address_space(3)))
typedef unsigned short bf16;
typedef unsigned v4u __attribute__((ext_vector_type(4)));
typedef unsigned v2u __attribute__((ext_vector_type(2)));
typedef float f32x4 __attribute__((ext_vector_type(4)));
typedef float f32x16 __attribute__((ext_vector_type(16)));
typedef short bf16x8 __attribute__((ext_vector_type(8)));
typedef GAS unsigned gu32;
#define RLX_AGENT __ATOMIC_RELAXED, __HIP_MEMORY_SCOPE_AGENT
#define LDS_WAIT() asm volatile("s_waitcnt lgkmcnt(0)" ::: "memory")
#define MFMA32(a, b, c) __builtin_amdgcn_mfma_f32_32x32x16_bf16((a), (b), (c), 0, 0, 0)
#define MFMA16F(a, b, c) __builtin_amdgcn_mfma_f32_16x16x4f32((a), (b), (c), 0, 0, 0)
__device__ __forceinline__ unsigned f2bf(float f) { unsigned u = __builtin_bit_cast(unsigned, f); return (u + 0x7fffu + ((u >> 16) & 1u)) >> 16; }
__device__ __forceinline__ unsigned pk2(float lo, float hi) { return f2bf(lo) | (f2bf(hi) << 16); }
__device__ __forceinline__ float bf2f(unsigned short b) { return __builtin_bit_cast(float, ((unsigned)b) << 16); }
__device__ __forceinline__ float bflo(unsigned w) { return __builtin_bit_cast(float, w << 16); }
__device__ __forceinline__ float bfhi(unsigned w) { return __builtin_bit_cast(float, w & 0xffff0000u); }
__device__ __forceinline__ float rcpf_(float x) { return __builtin_amdgcn_rcpf(x); }
__device__ __forceinline__ float rsqf_(float x) { return __builtin_amdgcn_rsqf(x); }
__device__ __forceinline__ float siluf(float x) { return x * __builtin_amdgcn_rcpf(1.0f + __builtin_amdgcn_exp2f(-1.4426950408889634f * x)); }
__device__ __forceinline__ float wave_sum(float v) {
#pragma unroll
    for (int o = 1; o < 64; o <<= 1) v += __shfl_xor(v, o);
    return v;
}

__device__ __forceinline__ int wave_sum_i(int v) {
    v += __builtin_amdgcn_update_dpp(0, v, 0x111, 0xf, 0xf, false);
    v += __builtin_amdgcn_update_dpp(0, v, 0x112, 0xf, 0xf, false);
    v += __builtin_amdgcn_update_dpp(0, v, 0x114, 0xf, 0xe, false);
    v += __builtin_amdgcn_update_dpp(0, v, 0x118, 0xf, 0xc, false);
    v += __builtin_amdgcn_update_dpp(0, v, 0x142, 0xa, 0xf, false);
    v += __builtin_amdgcn_update_dpp(0, v, 0x143, 0xc, 0xf, false);
    return __builtin_amdgcn_readlane(v, 63);
}
__device__ __forceinline__ float wave_max(float v) {
    const int ninf = (int)0xff800000u;
#define WM_STEP(ctrl, rm, bm) v = fmaxf(v, __builtin_bit_cast(float, __builtin_amdgcn_update_dpp(ninf, __builtin_bit_cast(int, v), ctrl, rm, bm, false)))
    WM_STEP(0x111, 0xf, 0xf); WM_STEP(0x112, 0xf, 0xf); WM_STEP(0x114, 0xf, 0xe); WM_STEP(0x118, 0xf, 0xc); WM_STEP(0x142, 0xa, 0xf); WM_STEP(0x143, 0xc, 0xf);
#undef WM_STEP
    return __builtin_bit_cast(float, __builtin_amdgcn_readlane(__builtin_bit_cast(int, v), 63));
}
#define XB_TMO      128
#define XB_XCNT(j)  (256  + 64 * (j))
#define XB_XSUB(j)  (1280 + 64 * (j))
#define XB_XGEN(j)  (2304 + 64 * (j))
#define XB_TOP      3328
#define XB_TOPGEN   3392
#define XCD_BAR_WORDS 3456
#define XB_SPIN_CAP (1u << 18)

__device__ __forceinline__ unsigned xb_ld(unsigned* p)              { return __hip_atomic_load(p, __ATOMIC_RELAXED, __HIP_MEMORY_SCOPE_AGENT); }
__device__ __forceinline__ unsigned xb_add(unsigned* p, unsigned v) { return __hip_atomic_fetch_add(p, v, __ATOMIC_RELAXED, __HIP_MEMORY_SCOPE_AGENT); }
__device__ __forceinline__ unsigned xb_xcc_id() { return (unsigned)__builtin_amdgcn_s_getreg((3 << 11) | 20) & 0xFu; }
#define XB_SPIN(cond, bar) do { unsigned _sp = 0; while (cond) { __builtin_amdgcn_s_sleep(1); \
    if ((++_sp & 255u) == 0u) { if (xb_ld(&(bar)[XB_TMO])) break; if (_sp > XB_SPIN_CAP) { atomicAdd(&(bar)[XB_TMO], 1u); break; } } } } while (0)

struct XcdBarrier {
    unsigned* bar; unsigned x;
    volatile LAS unsigned* st;
};

__device__ __forceinline__ XcdBarrier xcd_barrier_post(unsigned* bar, volatile LAS unsigned* st) {
    XcdBarrier b; b.bar = bar; b.x = xb_xcc_id(); b.st = st;
    if (threadIdx.x == 0) (void)xb_add(&bar[XB_XCNT(b.x)], 1u);
    return b;
}
__device__ __forceinline__ void xcd_barrier_complete(unsigned* bar, unsigned x, unsigned& nloc, unsigned& nx) {
    const unsigned G = gridDim.x * gridDim.y * gridDim.z;
    unsigned sum, cnt, mine, sp = 0u;
    for (;;) {
        sum = 0u; cnt = 0u; mine = 0u;
#pragma unroll
        for (unsigned j = 0; j < 16; ++j) { const unsigned c = xb_ld(&bar[XB_XCNT(j)]); sum += c; cnt += (c > 0u) ? 1u : 0u; mine = (j == x) ? c : mine; }
        if (sum == G) break;
        __builtin_amdgcn_s_sleep(1);
        if ((++sp & 255u) == 0u) { if (xb_ld(&bar[XB_TMO])) break; if (sp > XB_SPIN_CAP) { atomicAdd(&bar[XB_TMO], 1u); break; } }
    }
    nloc = mine > 0u ? mine : 1u; nx = cnt > 0u ? cnt : 1u;
}

__device__ __forceinline__ void xcd_barrier(const XcdBarrier& b) {
    asm volatile("s_waitcnt vmcnt(0)" ::: "memory");
    __syncthreads();
    if (threadIdx.x == 0) {
        unsigned* bar = b.bar;
        __builtin_amdgcn_s_waitcnt(0);
        unsigned nloc = b.st[0], nx = b.st[1];
        if (nloc == 0u) { xcd_barrier_complete(bar, b.x, nloc, nx); b.st[0] = nloc; b.st[1] = nx; }
        const unsigned old = xb_add(&bar[XB_XSUB(b.x)], 1u);
        const unsigned gen = old / nloc;
        if (old + 1u == (gen + 1u) * nloc) {
            __builtin_amdgcn_fence(__ATOMIC_RELEASE, "agent");
            asm volatile("s_waitcnt vmcnt(0)" ::: "memory");
            const unsigned og = xb_add(&bar[XB_TOP], 1u);
            const unsigned tg = og / nx;
            if (og + 1u == (tg + 1u) * nx) xb_add(&bar[XB_TOPGEN], 1u);
            else XB_SPIN(xb_ld(&bar[XB_TOPGEN]) == tg, bar);
            __builtin_amdgcn_fence(__ATOMIC_ACQUIRE, "agent");
            xb_add(&bar[XB_XGEN(b.x)], 1u);
            asm volatile("s_waitcnt vmcnt(0)" ::: "memory");
        } else {
            XB_SPIN(xb_ld(&bar[XB_XGEN(b.x)]) == gen, bar);
            __builtin_amdgcn_fence(__ATOMIC_ACQUIRE, "agent");
            asm volatile("s_waitcnt vmcnt(0)" ::: "memory");
        }
    }
    __syncthreads();
}

struct Frame {
    LAS unsigned char* lds;
    volatile LAS unsigned* MISC;
    gu32* ctl;
    int tid, lane, wave;
    int vcu, G;
    unsigned char* ws;
};
#define P_X        (args.in[0])
#define P_C        (args.in[1])
#define P_WADA     (args.in[2])
#define P_BADA     (args.in[3])
#define P_GPRE     (args.in[4])
#define P_WIN      (args.in[5])
#define P_CONVW    (args.in[6])
#define P_ALOG     (args.in[7])
#define P_DTB      (args.in[8])
#define P_GGDN     (args.in[9])
#define P_GKV      (args.in[10])
#define P_WUV      (args.in[11])
#define P_RELB     (args.in[12])
#define P_WOUT     (args.in[13])
#define P_GPOST    (args.in[14])
#define P_OUT      (args.out)
#define W_MOD      ((float*)(F.ws + WS_MOD))
#define W_WUVT     ((bf16*)(F.ws + WS_WUV))
#define W_WOUTT    ((bf16*)(F.ws + WS_WOUT))
#define W_WINT     ((bf16*)(F.ws + WS_WIN))
#define W_KVSS     ((float*)(F.ws + WS_KVSS))
#define W_AUX      ((float*)(F.ws + WS_AUX))
#define W_XN       ((bf16*)(F.ws + WS_XN))
#define W_OAB      ((bf16*)(F.ws + WS_XN))
#define W_PROJ     ((bf16*)(F.ws + WS_PROJ))
#define W_MIX      ((bf16*)(F.ws + WS_PROJ))
#define W_SCR      ((float*)(F.ws + WS_SCR))
struct Args { const float* in[15]; float* out; unsigned char* ws; int ph_lo, ph_hi, li, pad; };

template <class CM>
__device__ __forceinline__ void transpose_item(const float* W, int ldw, bf16* WT, int K, int k0, int n0, LAS float* scr, int lane, CM cm) {
    const int nn = lane & 31, sc = cm(n0 + nn);
#pragma unroll 8
    for (int i = 0; i < 32; ++i) { const int kk = 2 * i + (lane >> 5); scr[kk * 33 + nn] = sc >= 0 ? W[(size_t)(k0 + kk) * ldw + sc] : 0.f; }
    LDS_WAIT(); asm volatile("" ::: "memory");
    const int c = lane & 7;
#pragma unroll
    for (int j = 0; j < 4; ++j) { const int n = (lane >> 3) + 8 * j; const LAS float* s = scr + (8 * c) * 33 + n;
        v4u o; o.x = pk2(s[0 * 33], s[1 * 33]); o.y = pk2(s[2 * 33], s[3 * 33]); o.z = pk2(s[4 * 33], s[5 * 33]); o.w = pk2(s[6 * 33], s[7 * 33]);
        *(GAS v4u*)(WT + (size_t)(n0 + n) * K + k0 + 8 * c) = o; }
    LDS_WAIT(); asm volatile("" ::: "memory");
}
struct CmIdent { __device__ __forceinline__ int operator()(int n) const { return n; } };
struct CmProj { __device__ __forceinline__ int operator()(int n) const { return proj_src_col(n); } };

__device__ __forceinline__ void p0_prologue(Frame& F, const Args& args) {
    LAS float* scr = (LAS float*)(F.lds + F.wave * 16384);
    const int gw = F.vcu * NWAVES + F.wave, NGW = F.G * NWAVES;
    constexpr int I_IN = 16 * (NPROJ / 32), I_OUT = 16 * 32, I_UV = 4 * 2 * 4;
    for (int it = gw; it < I_IN + I_OUT + I_UV; it += NGW) {
        int r = it;
        if (r < I_IN) { const int kb = r / (NPROJ / 32), nb = r % (NPROJ / 32); transpose_item(P_WIN, 3792, W_WINT, 1024, 64 * kb, 32 * nb, scr, F.lane, CmProj()); continue; }
        r -= I_IN;
        if (r < I_OUT) { const int kb = r / 32, nb = r % 32; transpose_item(P_WOUT, 1024, W_WOUTT, 1024, 64 * kb, 32 * nb, scr, F.lane, CmIdent()); continue; }
        r -= I_OUT;
        { const int hd = r >> 3, kb = (r >> 2) & 1, nb = r & 3; transpose_item(P_WUV + (size_t)hd * 16384, 128, W_WUVT + (size_t)hd * 16384, 128, 64 * kb, 32 * nb, scr, F.lane, CmIdent()); }
    }
    __syncthreads();
    if (F.vcu < 192) {
        LAS float* SC = (LAS float*)F.lds;
        for (int e = F.tid; e < NB * 1024; e += NWAVES * 64) { const int b = e >> 10, k = e & 1023; SC[k * 33 + b] = siluf(P_C[e]); }
        __syncthreads();
        const int col = F.tid & 15, ks = F.tid >> 4, n = F.vcu * 16 + col;
        float acc[32];
#pragma unroll
        for (int b = 0; b < 32; ++b) acc[b] = 0.f;
        for (int kk = 0; kk < 32; ++kk) { const int k = ks * 32 + kk; const float w = P_WADA[(size_t)k * 3072 + n];
#pragma unroll
            for (int b = 0; b < 32; ++b) acc[b] += SC[k * 33 + b] * w; }
        __syncthreads();
        LAS float* RED = (LAS float*)F.lds;
#pragma unroll
        for (int b = 0; b < 32; ++b) RED[(ks * 32 + b) * 16 + col] = acc[b];
        __syncthreads();
        { const int b = F.tid >> 4; float s = 0.f;
            for (int k2 = 0; k2 < 32; ++k2) s += RED[(k2 * 32 + b) * 16 + col];
            W_MOD[b * 3072 + n] = s + P_BADA[n]; }
        __syncthreads();
    }
}

__device__ __forceinline__ void p1_norm(Frame& F, const Args& args) {
    const int gw = F.vcu * NWAVES + F.wave, NGW = F.G * NWAVES;
    for (int m = 2 * gw; m < MROWS; m += 2 * NGW) {
        const int b = m >> 11;
        const GAS f32x4* xr = (const GAS f32x4*)(P_X + (size_t)m * DM) + F.lane;
        f32x4 v[2][4]; float ss[2] = {0.f, 0.f};
#pragma unroll
        for (int q = 0; q < 2; ++q)
#pragma unroll
            for (int j = 0; j < 4; ++j) v[q][j] = xr[q * 256 + 64 * j];
#pragma unroll
        for (int q = 0; q < 2; ++q)
#pragma unroll
            for (int j = 0; j < 4; ++j) ss[q] += (v[q][j].x * v[q][j].x + v[q][j].y * v[q][j].y) + (v[q][j].z * v[q][j].z + v[q][j].w * v[q][j].w);
        const float rstd0 = rsqf_(wave_sum(ss[0]) * (1.0f / DM) + EPSF), rstd1 = rsqf_(wave_sum(ss[1]) * (1.0f / DM) + EPSF);
        const float* mb = W_MOD + b * 3072;
        GAS unsigned long long* o8 = (GAS unsigned long long*)(W_XN + (size_t)m * DM) + F.lane;
#pragma unroll
        for (int j = 0; j < 4; ++j) { const int col = F.lane * 4 + 256 * j;
            const f32x4 g = *(const f32x4*)(P_GPRE + col), sh = *(const f32x4*)(mb + col), sc = *(const f32x4*)(mb + 1024 + col);
            const f32x4 gs = g * (sc + 1.0f);
            const f32x4 o0 = v[0][j] * rstd0 * gs + sh, o1 = v[1][j] * rstd1 * gs + sh;
            o8[64 * j] = (unsigned long long)pg8::cvt_pk_bf16(o0.x, o0.y) | ((unsigned long long)pg8::cvt_pk_bf16(o0.z, o0.w) << 32);
            o8[256 + 64 * j] = (unsigned long long)pg8::cvt_pk_bf16(o1.x, o1.y) | ((unsigned long long)pg8::cvt_pk_bf16(o1.z, o1.w) << 32); }
    }
}

__device__ __forceinline__ void p5_final(Frame& F, const Args& args) {
    const int gw = F.vcu * NWAVES + F.wave, NGW = F.G * NWAVES;
    for (int m = 2 * gw; m < MROWS; m += 2 * NGW) {
        const int b = m >> 11;
        const GAS v2u* mr = (const GAS v2u*)(W_MIX + (size_t)m * DM) + F.lane;
        const GAS f32x4* xr = (const GAS f32x4*)(P_X + (size_t)m * DM) + F.lane;
        GAS f32x4* orow = (GAS f32x4*)(P_OUT + (size_t)m * DM) + F.lane;
        v2u w[2][4]; f32x4 xv[2][4];
#pragma unroll
        for (int q = 0; q < 2; ++q)
#pragma unroll
            for (int j = 0; j < 4; ++j) { w[q][j] = mr[q * 256 + 64 * j]; xv[q][j] = xr[q * 256 + 64 * j]; }
        f32x4 v[2][4]; float ss[2] = {0.f, 0.f};
#pragma unroll
        for (int q = 0; q < 2; ++q)
#pragma unroll
            for (int j = 0; j < 4; ++j) { v[q][j].x = bflo(w[q][j].x); v[q][j].y = bfhi(w[q][j].x); v[q][j].z = bflo(w[q][j].y); v[q][j].w = bfhi(w[q][j].y);
                ss[q] += (v[q][j].x * v[q][j].x + v[q][j].y * v[q][j].y) + (v[q][j].z * v[q][j].z + v[q][j].w * v[q][j].w); }
        const float rstd0 = rsqf_(wave_sum(ss[0]) * (1.0f / DM) + EPSF), rstd1 = rsqf_(wave_sum(ss[1]) * (1.0f / DM) + EPSF);
        const float* gt = W_MOD + b * 3072 + 2048;
#pragma unroll
        for (int j = 0; j < 4; ++j) { const int col = F.lane * 4 + 256 * j;
            const f32x4 g = *(const f32x4*)(P_GPOST + col), ga = *(const f32x4*)(gt + col);
            const f32x4 gg = g * ga;
            orow[64 * j] = xv[0][j] + gg * (v[0][j] * rstd0);
            orow[256 + 64 * j] = xv[1][j] + gg * (v[1][j] * rstd1); }
    }
}

__device__ __forceinline__ unsigned cvtpk(float lo, float hi) { return pg8::cvt_pk_bf16(lo, hi); }
__device__ __forceinline__ v2u pack4(float a, float b, float c, float d) { v2u r; r.x = cvtpk(a, b); r.y = cvtpk(c, d); return r; }
__device__ __forceinline__ bf16x8 pack8(float a, float b, float c, float d, float e, float f, float g, float h) { v4u r; r.x = cvtpk(a, b); r.y = cvtpk(c, d); r.z = cvtpk(e, f); r.w = cvtpk(g, h); return __builtin_bit_cast(bf16x8, r); }
__device__ __forceinline__ bf16x8 lds16(const LAS unsigned char* p) { return *(const LAS bf16x8*)p; }
__device__ __forceinline__ bf16x8 lds8x2(const LAS unsigned char* p) { const v2u lo = *(const LAS v2u*)p, hi = *(const LAS v2u*)(p + 16); v4u r; r.x = lo.x; r.y = lo.y; r.z = hi.x; r.w = hi.y; return __builtin_bit_cast(bf16x8, r); }
template <int S> __device__ __forceinline__ bf16x8 acc_frag(const f32x16& a) { return pack8(a[8 * S + 0], a[8 * S + 1], a[8 * S + 2], a[8 * S + 3], a[8 * S + 4], a[8 * S + 5], a[8 * S + 6], a[8 * S + 7]); }

__device__ __forceinline__ float row16_sum(float v) {
#define R16_STEP(ctrl) v += __builtin_bit_cast(float, __builtin_amdgcn_update_dpp(0, __builtin_bit_cast(int, v), ctrl, 0xf, 0xf, false))
    R16_STEP(0x121); R16_STEP(0x122); R16_STEP(0x124); R16_STEP(0x128);
#undef R16_STEP
    return v;
}

__device__ __forceinline__ void gdn_unit(Frame& F, const Args& args, const int b, const int h) {
    LAS unsigned char* const L = F.lds;
    const int tid = F.tid, lane = F.lane, wv = F.wave, l31_0 = lane & 31, hh_0 = lane >> 5;
    int tidv = tid, lanev = lane;
    constexpr int P128 = 272, P64 = 144;
    constexpr int O_KH = 0, O_QH = O_KH + 17408, O_KGT = O_QH + 17408, O_VBT = O_KGT + 18432, O_KBGT = O_VBT + 18432, O_LM = O_KBGT + 18432, O_T = O_LM + 17408,
                  O_AT = O_T + 17408, O_CW = O_AT + 9216, O_SM = O_CW + 6144, O_PSO = O_SM + 2560, O_OF = O_PSO + 2048, O_END = O_OF + 17408;
    static_assert(O_END <= SCRATCH_BYTES, "gdn LDS map");
    constexpr int O_W = O_LM, O_VNT = O_VBT;
    LAS float* const SMb = (LAS float*)(L + O_SM);
    LAS float* const LM = (LAS float*)(L + O_LM);
    LAS float* const TT = (LAS float*)(L + O_T);
    LAS float* const CW = (LAS float*)(L + O_CW);
    LAS float* const PSO = (LAS float*)(L + O_PSO);
    const int mt = wv >> 2, nt = wv & 3;
    f32x16 S[4];
#pragma unroll
    for (int k = 0; k < 4; ++k)
#pragma unroll
        for (int r = 0; r < 16; ++r) S[k][r] = 0.f;
    const float alog_e = __expf(P_ALOG[h]), dtb = P_DTB[h];
#define GDN_GATES(n_) do { LAS float* _sm = SMb + ((n_) & 1) * 320; const float* _ap = W_AUX + (size_t)(b * SEQ + (n_) * 64 + lanev) * 16; \
        const float _bb = _ap[h], _aa = _ap[4 + h]; const float _beta = rcpf_(1.0f + __expf(-_bb)); const float _xs = _aa + dtb; \
        const float _sp = _xs > 20.f ? _xs : log1pf(__expf(_xs)); float _gc = -alog_e * _sp; \
        _Pragma("unroll") for (int _o = 1; _o < 64; _o <<= 1) { const float _t = __shfl_up(_gc, _o); if (lanev >= _o) _gc += _t; } \
        const float _gl = __shfl(_gc, 63); _sm[lanev] = _gc; _sm[64 + lanev] = _beta; _sm[128 + lanev] = __expf(_gc); _sm[192 + lanev] = __expf(_gl - _gc); \
        if (lanev == 0) _sm[256] = __expf(_gl); } while (0)
    if (wv == 6) GDN_GATES(0);
    for (int e = tidv; e < 3 * 4 * 128; e += NWAVES * 64) { const int ts_ = e >> 9, tap = (e >> 7) & 3, ch = e & 127; CW[e] = P_CONVW[tap * 1536 + ts_ * 512 + h * 128 + ch]; }
    const int ts = tid >> 8;
    int cgv = tid & 15, tpv = (tid >> 4) & 15;
#define GDN_ROWS(dst_, n_, chan_) do { const bf16* _src = W_PROJ + (size_t)(b * SEQ + (n_) * 64 + 4 * tpv - 3) * NPROJ + (chan_); \
        _Pragma("unroll") for (int _i = 0; _i < 7; ++_i) { v4u _z; _z.x = 0u; _z.y = 0u; _z.z = 0u; _z.w = 0u; dst_[_i] = _z; \
            if ((n_) > 0 || 4 * tpv - 3 + _i >= 0) dst_[_i] = *(const GAS v4u*)(_src + (size_t)_i * NPROJ); } } while (0)
#define GDN_OUT(rowb_) do { const int _tok = tidv >> 3, _dv0 = (tidv & 7) * 16; const size_t _row = (size_t)(rowb_) + _tok; \
        const LAS v4u* _op = (const LAS v4u*)(L + O_OF + _tok * P128 + _dv0 * 2); const v4u _o0 = _op[0], _o1 = _op[1]; \
        const LAS f32x4* _pp = (const LAS f32x4*)(PSO + _tok * 8); const f32x4 _a = _pp[0], _c = _pp[1]; \
        const float _rstd = rsqf_((((_a.x + _a.y) + (_a.z + _a.w)) + ((_c.x + _c.y) + (_c.z + _c.w))) * (1.0f / 128.0f) + EPSF); \
        const bf16* _zp = W_PROJ + _row * NPROJ + C_ZA + h * 128 + _dv0; const v4u _z0 = *(const GAS v4u*)_zp, _z1 = *(const GAS v4u*)(_zp + 8); \
        const unsigned _ow[8] = {_o0.x, _o0.y, _o0.z, _o0.w, _o1.x, _o1.y, _o1.z, _o1.w}, _zw[8] = {_z0.x, _z0.y, _z0.z, _z0.w, _z1.x, _z1.y, _z1.z, _z1.w}; unsigned _rw[8]; \
        _Pragma("unroll") for (int _k = 0; _k < 4; ++_k) { const f32x4 _g = *(const f32x4*)(P_GGDN + _dv0 + 4 * _k); \
            _rw[2 * _k] = cvtpk(bflo(_ow[2 * _k]) * _rstd * _g.x * siluf(bflo(_zw[2 * _k])), bfhi(_ow[2 * _k]) * _rstd * _g.y * siluf(bfhi(_zw[2 * _k]))); \
            _rw[2 * _k + 1] = cvtpk(bflo(_ow[2 * _k + 1]) * _rstd * _g.z * siluf(bflo(_zw[2 * _k + 1])), bfhi(_ow[2 * _k + 1]) * _rstd * _g.w * siluf(bfhi(_zw[2 * _k + 1]))); } \
        bf16* _dst = W_OAB + _row * DM + h * 128 + _dv0; v4u _w0, _w1; _w0.x = _rw[0]; _w0.y = _rw[1]; _w0.z = _rw[2]; _w0.w = _rw[3]; _w1.x = _rw[4]; _w1.y = _rw[5]; _w1.z = _rw[6]; _w1.w = _rw[7]; \
        *(GAS v4u*)_dst = _w0; *(GAS v4u*)(_dst + 8) = _w1; } while (0)
    __syncthreads();

    unsigned pf_sink = 0u;
    for (int n = 0; n < 32; ++n) {
        const int rowbase = b * SEQ + n * 64;
        LAS float* const SMf = SMb + (n & 1) * 320;
        tidv = tid; lanev = lane; cgv = tid & 15; tpv = (tid >> 4) & 15;
        asm volatile("" : "+v"(tidv), "+v"(lanev), "+v"(cgv), "+v"(tpv));
        int l31 = lanev & 31, hh = lanev >> 5, cg = cgv, tp = tpv;
        if (wv == 6 && n + 1 < 32) GDN_GATES(n + 1);
        float val[4][8];
#define GDN_CONV(rows_, tsel_) do { \
            _Pragma("unroll") for (int _j = 0; _j < 4; ++_j) _Pragma("unroll") for (int _e = 0; _e < 8; ++_e) val[_j][_e] = 0.f; \
            _Pragma("unroll") for (int _tap = 0; _tap < 4; ++_tap) { const LAS f32x4* _cp = (const LAS f32x4*)(CW + ((tsel_) * 4 + _tap) * 128 + cg * 8); const f32x4 _c0 = _cp[0], _c1 = _cp[1]; \
                const float _cw[8] = {_c0.x, _c0.y, _c0.z, _c0.w, _c1.x, _c1.y, _c1.z, _c1.w}; \
                _Pragma("unroll") for (int _j = 0; _j < 4; ++_j) { const v4u _raw = rows_[_j + _tap]; \
                    const float _in[8] = {bflo(_raw.x), bfhi(_raw.x), bflo(_raw.y), bfhi(_raw.y), bflo(_raw.z), bfhi(_raw.z), bflo(_raw.w), bfhi(_raw.w)}; \
                    _Pragma("unroll") for (int _e = 0; _e < 8; ++_e) val[_j][_e] += _in[_e] * _cw[_e]; } } \
            _Pragma("unroll") for (int _j = 0; _j < 4; ++_j) _Pragma("unroll") for (int _e = 0; _e < 8; ++_e) val[_j][_e] = siluf(val[_j][_e]); } while (0)
        v4u rq[7], rv[7];
        GDN_ROWS(rq, n, ts * 512 + h * 128 + cgv * 8);
        if (wv < 4) GDN_ROWS(rv, n, 1024 + h * 128 + cgv * 8);
        if (wv == 7 && n + 1 < 32) {
#pragma unroll
            for (int i = 0; i < 9; ++i) { const int idx = i * 64 + lanev; const int rr = idx >> 3, ln = idx & 7;
                if (idx < 67 * 8) { const bf16* pt = W_PROJ + (size_t)(rowbase + 61 + rr) * NPROJ + (ln >> 1) * 512 + h * 128 + (ln & 1) * 64;
                    asm volatile("global_load_dword %0, %1, off" : "+v"(pf_sink) : "v"(pt) : "memory"); } }
        }
        {
            GDN_CONV(rq, ts);
#pragma unroll
            for (int j = 0; j < 4; ++j) { float ss = 0.f;
#pragma unroll
                for (int e = 0; e < 8; ++e) ss += val[j][e] * val[j][e];
                ss = row16_sum(ss);
                float r = rsqf_(ss + EPSF); if (ts == 0) r *= 0.08838834764831845f;
#pragma unroll
                for (int e = 0; e < 8; ++e) val[j][e] *= r; }
            if (ts == 0) {
#pragma unroll
                for (int j = 0; j < 4; ++j) *(LAS bf16x8*)(L + O_QH + (4 * tp + j) * P128 + cg * 16) = pack8(val[j][0], val[j][1], val[j][2], val[j][3], val[j][4], val[j][5], val[j][6], val[j][7]);
            } else {
                float ek[4], bg[4];
#pragma unroll
                for (int j = 0; j < 4; ++j) { ek[j] = SMf[192 + 4 * tp + j]; bg[j] = SMf[64 + 4 * tp + j] * SMf[128 + 4 * tp + j]; }
#pragma unroll
                for (int j = 0; j < 4; ++j) *(LAS bf16x8*)(L + O_KH + (4 * tp + j) * P128 + cg * 16) = pack8(val[j][0], val[j][1], val[j][2], val[j][3], val[j][4], val[j][5], val[j][6], val[j][7]);
#pragma unroll
                for (int e = 0; e < 8; ++e) {
                    *(LAS v2u*)(L + O_KGT + (cg * 8 + e) * P64 + tp * 8) = pack4(val[0][e] * ek[0], val[1][e] * ek[1], val[2][e] * ek[2], val[3][e] * ek[3]);
                    *(LAS v2u*)(L + O_KBGT + (cg * 8 + e) * P64 + tp * 8) = pack4(val[0][e] * bg[0], val[1][e] * bg[1], val[2][e] * bg[2], val[3][e] * bg[3]); }
            }
        }
        if (n > 0) GDN_OUT(rowbase - 64);
        if (wv < 4) {
            GDN_CONV(rv, 2);
            float be[4];
#pragma unroll
            for (int j = 0; j < 4; ++j) be[j] = SMf[64 + 4 * tp + j];
#pragma unroll
            for (int e = 0; e < 8; ++e) *(LAS v2u*)(L + O_VBT + (cg * 8 + e) * P64 + tp * 8) = pack4(val[0][e] * be[0], val[1][e] * be[1], val[2][e] * be[2], val[3][e] * be[3]);
        }
        for (int e = tidv; e < 64 * 68; e += NWAVES * 64) TT[e] = 0.f;
        __syncthreads();
        if (wv < 4) {
            const int ti = wv >> 1, tj = wv & 1;
            f32x16 C;
#pragma unroll
            for (int r = 0; r < 16; ++r) C[r] = 0.f;
            if (ti >= tj) {
#pragma unroll
                for (int s = 0; s < 8; ++s) C = MFMA32(lds16(L + O_KH + (32 * ti + l31) * P128 + (16 * s + 8 * hh) * 2), lds16(L + O_KH + (32 * tj + l31) * P128 + (16 * s + 8 * hh) * 2), C);
            }
            const int j = 32 * tj + l31; const float gcj = SMf[j];
#pragma unroll
            for (int g = 0; g < 4; ++g) { const int ib = 32 * ti + 8 * g + 4 * hh; const f32x4 gci = *(const LAS f32x4*)(SMf + ib), bei = *(const LAS f32x4*)(SMf + 64 + ib);
#pragma unroll
                for (int e = 0; e < 4; ++e) { const int i = ib + e; LM[i * 68 + j] = (i > j) ? bei[e] * C[4 * g + e] * __expf(gci[e] - gcj) : 0.f; } }
        } else {
            const int w4 = wv - 4, tj = w4 >> 1, ti = w4 & 1;
            f32x16 C;
#pragma unroll
            for (int r = 0; r < 16; ++r) C[r] = 0.f;
            if (ti >= tj) {
#pragma unroll
                for (int s = 0; s < 8; ++s) C = MFMA32(lds16(L + O_KH + (32 * tj + l31) * P128 + (16 * s + 8 * hh) * 2), lds16(L + O_QH + (32 * ti + l31) * P128 + (16 * s + 8 * hh) * 2), C);
            }
            const int i = 32 * ti + l31; const float gci = SMf[i];
#pragma unroll
            for (int g = 0; g < 4; ++g) { const int jb = 32 * tj + 8 * g + 4 * hh; const f32x4 gcj = *(const LAS f32x4*)(SMf + jb); float v[4];
#pragma unroll
                for (int e = 0; e < 4; ++e) v[e] = (i >= jb + e) ? C[4 * g + e] * __expf(gci - gcj[e]) : 0.f;
                *(LAS v2u*)(L + O_AT + i * P64 + jb * 2) = pack4(v[0], v[1], v[2], v[3]); }
        }
        __syncthreads();
        if (wv < 2) {
            const int a = 2 * wv, bq = 2 * wv + 1;
            if (lanev < 32) {
                const int blk = a + (lanev >> 4), c = lanev & 15; float x[16];
#pragma unroll
                for (int i = 0; i < 16; ++i) { const LAS float* lr = LM + (16 * blk + i) * 68 + 16 * blk; float acc = (i == c) ? 1.f : 0.f;
#pragma unroll
                    for (int j = 0; j < i; ++j) acc -= lr[j] * x[j];
                    x[i] = acc; TT[(16 * blk + i) * 68 + 16 * blk + c] = acc; }
            }
            asm volatile("s_waitcnt lgkmcnt(0)" ::: "memory");
            const int m = lanev & 15, q = lanev >> 4;
            f32x4 P = {0.f, 0.f, 0.f, 0.f}, R = {0.f, 0.f, 0.f, 0.f};
#pragma unroll
            for (int s = 0; s < 4; ++s) { const int k = q + 4 * s; P = MFMA16F(LM[(16 * bq + m) * 68 + 16 * a + k], TT[(16 * a + k) * 68 + 16 * a + m], P); }
#pragma unroll
            for (int rg = 0; rg < 4; ++rg) { const int k = 4 * q + rg; R = MFMA16F(TT[(16 * bq + m) * 68 + 16 * bq + k], P[rg], R); }
#pragma unroll
            for (int rg = 0; rg < 4; ++rg) TT[(16 * bq + 4 * q + rg) * 68 + 16 * a + m] = -R[rg];
        }
        __syncthreads();
        if (wv < 4) {
            const int m = lanev & 15, q = lanev >> 4, mi = wv >> 1, ni = wv & 1;
            f32x4 P0 = {0.f, 0.f, 0.f, 0.f}, P1 = {0.f, 0.f, 0.f, 0.f}, R = {0.f, 0.f, 0.f, 0.f};
#pragma unroll
            for (int s = 0; s < 8; ++s) { const int k = q + 4 * s; const float bt = TT[k * 68 + 16 * ni + m];
                P0 = MFMA16F(LM[(32 + m) * 68 + k], bt, P0); P1 = MFMA16F(LM[(48 + m) * 68 + k], bt, P1); }
#pragma unroll
            for (int rg = 0; rg < 4; ++rg) { R = MFMA16F(TT[(32 + 16 * mi + m) * 68 + 32 + 4 * q + rg], P0[rg], R); R = MFMA16F(TT[(32 + 16 * mi + m) * 68 + 48 + 4 * q + rg], P1[rg], R); }
#pragma unroll
            for (int rg = 0; rg < 4; ++rg) TT[(32 + 16 * mi + 4 * q + rg) * 68 + 16 * ni + m] = -R[rg];
        }
        __syncthreads();
        f32x16 U, WT_;
#pragma unroll
        for (int r = 0; r < 16; ++r) { U[r] = 0.f; WT_[r] = 0.f; }
#pragma unroll
        for (int s = 0; s < 4; ++s) { const LAS f32x4* tp4 = (const LAS f32x4*)(TT + (32 * mt + l31) * 68 + 16 * s + 8 * hh); const f32x4 t0 = tp4[0], t1 = tp4[1];
            const bf16x8 a = pack8(t0.x, t0.y, t0.z, t0.w, t1.x, t1.y, t1.z, t1.w);
            U = MFMA32(a, lds16(L + O_VBT + (32 * nt + l31) * P64 + (16 * s + 8 * hh) * 2), U);
            WT_ = MFMA32(lds16(L + O_KBGT + (32 * nt + l31) * P64 + (16 * s + 8 * hh) * 2), a, WT_); }
#pragma unroll
        for (int g = 0; g < 4; ++g) *(LAS v2u*)(L + O_W + (32 * mt + l31) * P128 + (32 * nt + 8 * g + 4 * hh) * 2) = pack4(-WT_[4 * g], -WT_[4 * g + 1], -WT_[4 * g + 2], -WT_[4 * g + 3]);
        __syncthreads();
        bf16x8 sf[4][2];
#pragma unroll
        for (int kt = 0; kt < 4; ++kt) { sf[kt][0] = acc_frag<0>(S[kt]); sf[kt][1] = acc_frag<1>(S[kt]); }
#pragma unroll
        for (int kt = 0; kt < 4; ++kt)
#pragma unroll
            for (int s = 0; s < 2; ++s) U = MFMA32(lds8x2(L + O_W + (32 * mt + l31) * P128 + (32 * kt + 16 * s + 4 * hh) * 2), sf[kt][s], U);
#pragma unroll
        for (int g = 0; g < 4; ++g) *(LAS v2u*)(L + O_VNT + (32 * nt + l31) * P64 + (32 * mt + 8 * g + 4 * hh) * 2) = pack4(U[4 * g], U[4 * g + 1], U[4 * g + 2], U[4 * g + 3]);
        __syncthreads();
        {
            f32x16 Oa;
#pragma unroll
            for (int r = 0; r < 16; ++r) Oa[r] = 0.f;
#pragma unroll
            for (int kt = 0; kt < 4; ++kt)
#pragma unroll
                for (int s = 0; s < 2; ++s) Oa = MFMA32(lds8x2(L + O_QH + (32 * mt + l31) * P128 + (32 * kt + 16 * s + 4 * hh) * 2), sf[kt][s], Oa);
#pragma unroll
            for (int g = 0; g < 4; ++g) { const f32x4 e4 = *(const LAS f32x4*)(SMf + 128 + 32 * mt + 8 * g + 4 * hh);
#pragma unroll
                for (int e = 0; e < 4; ++e) Oa[4 * g + e] *= e4[e]; }
            bf16x8 vn[4];
#pragma unroll
            for (int s = 0; s < 4; ++s) vn[s] = lds16(L + O_VNT + (32 * nt + l31) * P64 + (16 * s + 8 * hh) * 2);
#pragma unroll
            for (int s = 0; s < 4; ++s) Oa = MFMA32(lds16(L + O_AT + (32 * mt + l31) * P64 + (16 * s + 8 * hh) * 2), vn[s], Oa);
            const float glast = SMf[256];
#pragma unroll
            for (int kt = 0; kt < 4; ++kt) {
#pragma unroll
                for (int r = 0; r < 16; ++r) S[kt][r] *= glast;
#pragma unroll
                for (int s = 0; s < 4; ++s) S[kt] = MFMA32(lds16(L + O_KGT + (32 * kt + l31) * P64 + (16 * s + 8 * hh) * 2), vn[s], S[kt]);
            }
#pragma unroll
            for (int r = 0; r < 16; ++r) { const float q2 = row16_sum(Oa[r] * Oa[r]);
                if ((lanev & 15) == 0) PSO[(32 * mt + 8 * (r >> 2) + 4 * hh + (r & 3)) * 8 + 2 * nt + ((lanev >> 4) & 1)] = q2;
                *(LAS unsigned short*)(L + O_OF + (32 * mt + 8 * (r >> 2) + 4 * hh + (r & 3)) * P128 + (32 * nt + l31) * 2) = (unsigned short)cvtpk(Oa[r], 0.f); }
        }
        asm volatile("s_waitcnt vmcnt(0)" : "+v"(pf_sink) :: "memory");
        __syncthreads();
    }
    GDN_OUT(b * SEQ + 31 * 64);
    __syncthreads();
#undef GDN_GATES
#undef GDN_CONV
#undef GDN_ROWS
#undef GDN_OUT
}

template <int NREG>
__device__ __forceinline__ void dsa_select(const float* const scw, LAS unsigned* const MASK, const int wv, const int lane, const int t0, const int nk) {
    const float NINF = -__builtin_inff();
    const unsigned long long lt_mask = (1ull << lane) - 1ull;
    float xn[NREG];
#pragma unroll
    for (int i = 0; i < NREG; ++i) xn[i] = __hip_atomic_load(scw + i * 64 + lane, __ATOMIC_RELAXED, __HIP_MEMORY_SCOPE_AGENT);
#pragma unroll 1
    for (int ql_ = 0; ql_ < 8; ++ql_) {
        const int ql = ql_ & 7;
        const int tq = t0 + 8 * wv + ql;
        LAS unsigned* const mrow = MASK + (8 * wv + ql) * 64;
        float x[NREG];
#pragma unroll
        for (int i = 0; i < NREG; ++i) x[i] = (i * 64 + lane < nk) ? xn[i] : NINF;
        if (ql_ + 1 < 8) {
#pragma unroll
            for (int i = 0; i < NREG; ++i) xn[i] = __hip_atomic_load(scw + ((ql_ + 1) & 7) * 2048 + i * 64 + lane, __ATOMIC_RELAXED, __HIP_MEMORY_SCOPE_AGENT);
        }
        if (tq + 1 > 256) {
            float vmin = __builtin_inff(), vmax = NINF;
#pragma unroll
            for (int i = 0; i < NREG; ++i) { vmax = fmaxf(vmax, x[i]); vmin = fminf(vmin, x[i] == NINF ? __builtin_inff() : x[i]); }
            vmin = -wave_max(-vmin); vmax = wave_max(vmax);
#define CNT_GE(p_, dst_) do { int _c0 = 0, _c1 = 0, _c2 = 0, _c3 = 0; const float _p = (p_); \
                _Pragma("unroll") for (int _i = 0; _i < NREG; _i += 4) \
                    asm volatile("v_cmp_le_f32_e64 s[90:91], %8, %4\n\tv_cmp_le_f32_e64 s[92:93], %8, %5\n\tv_cmp_le_f32_e64 s[94:95], %8, %6\n\tv_cmp_le_f32_e64 s[96:97], %8, %7\n\t" \
                                 "v_addc_co_u32_e64 %0, s[90:91], 0, %0, s[90:91]\n\tv_addc_co_u32_e64 %1, s[92:93], 0, %1, s[92:93]\n\tv_addc_co_u32_e64 %2, s[94:95], 0, %2, s[94:95]\n\tv_addc_co_u32_e64 %3, s[96:97], 0, %3, s[96:97]" \
                                 : "+v"(_c0), "+v"(_c1), "+v"(_c2), "+v"(_c3) : "v"(x[_i]), "v"(x[_i + 1]), "v"(x[_i + 2]), "v"(x[_i + 3]), "s"(_p) : "s90", "s91", "s92", "s93", "s94", "s95", "s96", "s97"); \
                dst_ = wave_sum_i((_c0 + _c1) + (_c2 + _c3)); } while (0)
            float lo = vmin, hi = vmax, thr; int chi; bool tie = false;
            CNT_GE(hi, chi);
            if (chi == 256) thr = hi;
            else if (chi > 256) { tie = true; lo = hi; chi = 0; hi = __builtin_inff(); }
            else {
#pragma unroll 1
                for (;;) {
                    const float mid = 0.5f * (lo + hi);
                    if (!(mid > lo && mid < hi)) { tie = true; break; }
                    int c; CNT_GE(mid, c);
                    if (c == 256) { thr = mid; break; }
                    if (c > 256) lo = mid; else { hi = mid; chi = c; }
                }
            }
#undef CNT_GE
            if (!tie) {
#pragma unroll
                for (int i = 0; i < NREG; ++i) { const unsigned long long bs = __ballot(x[i] >= thr);
                    if (lane == 0) { v2u w; w.x = (unsigned)bs; w.y = (unsigned)(bs >> 32); *(LAS v2u*)(mrow + 2 * i) = w; } }
            } else {
                const int need = 256 - chi; int before = 0;
#pragma unroll
                for (int i = 0; i < NREG; ++i) { const bool eq = (x[i] == lo); const unsigned long long be = __ballot(eq);
                    const int rank = before + __popcll(be & lt_mask); const bool sel = (x[i] >= hi) || (eq && rank < need); before += __popcll(be);
                    const unsigned long long bs = __ballot(sel);
                    if (lane == 0) { v2u w; w.x = (unsigned)bs; w.y = (unsigned)(bs >> 32); *(LAS v2u*)(mrow + 2 * i) = w; } }
            }
        } else {
#pragma unroll
            for (int i = 0; i < NREG; ++i) { const unsigned long long bs = __ballot(i * 64 + lane <= tq);
                if (lane == 0) { v2u w; w.x = (unsigned)bs; w.y = (unsigned)(bs >> 32); *(LAS v2u*)(mrow + 2 * i) = w; } }
        }
    }
}

__device__ __forceinline__ void dsa_unit(Frame& F, const Args& args, const int b, const int qb, const float mb2) {
    LAS unsigned char* const L = F.lds;
    const int tid = F.tid, lane = F.lane, wv = F.wave, l31_0 = lane & 31, hh_0 = lane >> 5;
    int l31 = l31_0, hh = hh_0;
    constexpr int PK = 272, PV = 144;
    constexpr int O_K0 = 0, O_V0 = 17408, BUFSZ = 35840, O_MASK = 2 * BUFSZ, O_RS = O_MASK + 16384, O_BT = O_RS + 8192, O_END = O_BT + 2048, O_OA = 0;
    static_assert(O_END <= SCRATCH_BYTES && 4 * 17408 <= 2 * BUFSZ, "dsa LDS map");
    const int t0 = 64 * qb, nk = 64 * (qb + 1);
    const size_t rb = (size_t)b * SEQ;
    LAS unsigned* const MASK = (LAS unsigned*)(L + O_MASK);
    LAS float* const RS = (LAS float*)(L + O_RS);
    LAS float* const BT = (LAS float*)(L + O_BT);
    const float NINF = -__builtin_inff();
    for (int key = tid; key < nk; key += NWAVES * 64) { const f32x4 s4 = *(const f32x4*)(W_KVSS + (rb + key) * 4); RS[key] = rsqf_(((s4.x + s4.y) + (s4.z + s4.w)) * (1.0f / 128.0f) + EPSF); }
    BT[tid] = P_RELB[T5_BUCKET[tid >> 2] * 4 + (tid & 3)] * LOG2E;
    float* const scw = W_SCR + (size_t)(blockIdx.x * NWAVES + wv) * 8 * 2048;
#pragma unroll 1
    for (int rep_a = 0; rep_a < (PROBE_DUP == 41 ? 2 : 1); ++rep_a) {
        bf16x8 aq[2][4]; f32x4 wts[2][4];
#pragma unroll
        for (int rt = 0; rt < 2; ++rt) {
            const bf16* p = W_PROJ + (rb + t0 + 8 * wv + 4 * rt + (l31 >> 3)) * NPROJ + C_IQ + (l31 & 7) * 64 + 8 * hh;
#pragma unroll
            for (int s = 0; s < 4; ++s) aq[rt][s] = *(const GAS bf16x8*)(p + 16 * s);
#pragma unroll
            for (int g = 0; g < 4; ++g) wts[rt][g] = *(const f32x4*)(W_AUX + (rb + t0 + 8 * wv + 4 * rt + g) * 16 + 8 + 4 * hh) * 0.5f;
        }
        constexpr int O_IK = 0, IKB = 9216, PIK = 144;
        v4u sti;
#define IK_GLOAD(kt_) sti = *(const GAS v4u*)(W_PROJ + (rb + 64 * (kt_) + (tid >> 3)) * NPROJ + C_IK + (tid & 7) * 8)
#define IK_SWRITE(buf_) *(LAS v4u*)(L + O_IK + (buf_) * IKB + (tid >> 3) * PIK + (tid & 7) * 16) = sti
        IK_GLOAD(0); IK_SWRITE(0);
        __syncthreads();
#pragma unroll 1
        for (int kt6 = 0; kt6 <= qb; ++kt6) {
          const int ibuf = kt6 & 1;
          if (kt6 < qb) IK_GLOAD(kt6 + 1);
#pragma unroll
          for (int st = 0; st < 2; ++st) {
            bf16x8 bk[4];
#pragma unroll
            for (int s = 0; s < 4; ++s) bk[s] = lds16(L + O_IK + ibuf * IKB + (32 * st + l31) * PIK + (16 * s + 8 * hh) * 2);
            const int kt = 2 * kt6 + st;
            const int key = 32 * kt + l31;
            f32x16 C0, C1;
#pragma unroll
            for (int r = 0; r < 16; ++r) { C0[r] = 0.f; C1[r] = 0.f; }
#pragma unroll
            for (int s = 0; s < 4; ++s) C0 = MFMA32(aq[0][s], bk[s], C0);
#pragma unroll
            for (int s = 0; s < 4; ++s) C1 = MFMA32(aq[1][s], bk[s], C1);
            float pp[2][4];
#pragma unroll
            for (int g = 0; g < 4; ++g) {
                float p0 = 0.f, p1 = 0.f;
#pragma unroll
                for (int e2 = 0; e2 < 4; ++e2) { const float w0 = wts[0][g][e2], w1 = wts[1][g][e2], x0 = C0[4 * g + e2], x1 = C1[4 * g + e2];
                    p0 = __builtin_fmaf(w0, x0, p0); p0 = __builtin_fmaf(w0, __builtin_fabsf(x0), p0); p1 = __builtin_fmaf(w1, x1, p1); p1 = __builtin_fmaf(w1, __builtin_fabsf(x1), p1); }
                pp[0][g] = p0; pp[1][g] = p1;
            }
            float snd[2][2], rcv[2][2];
#pragma unroll
            for (int rt = 0; rt < 2; ++rt)
#pragma unroll
                for (int g2 = 0; g2 < 2; ++g2) snd[rt][g2] = hh ? pp[rt][g2] : pp[rt][g2 + 2];
#pragma unroll
            for (int rt = 0; rt < 2; ++rt)
#pragma unroll
                for (int g2 = 0; g2 < 2; ++g2) rcv[rt][g2] = __shfl_xor(snd[rt][g2], 32);
#pragma unroll
            for (int rt = 0; rt < 2; ++rt)
#pragma unroll
                for (int g2 = 0; g2 < 2; ++g2) { const int ql = 4 * rt + g2 + 2 * hh; float p = (hh ? pp[rt][g2 + 2] : pp[rt][g2]) + rcv[rt][g2];
                    if (key > t0 + 8 * wv + ql) p = NINF;
                    scw[ql * 2048 + key] = p; }
          }
          if (kt6 < qb) IK_SWRITE(ibuf ^ 1);
          __syncthreads();
        }
#undef IK_GLOAD
#undef IK_SWRITE
    }
    __builtin_amdgcn_fence(__ATOMIC_SEQ_CST, "workgroup");
    asm volatile("s_waitcnt vmcnt(0)" ::: "memory");
    int lanev = lane; asm volatile("" : "+v"(lanev));
    if (qb < 8) dsa_select<8>(scw, MASK, wv, lanev, t0, nk);
    else if (qb < 16) dsa_select<16>(scw, MASK, wv, lanev, t0, nk);
    else if (qb < 24) dsa_select<24>(scw, MASK, wv, lanev, t0, nk);
    else dsa_select<32>(scw, MASK, wv, lanev, t0, nk);
    __syncthreads();
    const int qj = l31 >> 2, hd = l31 & 3;
    const int tql = t0 + 8 * wv + qj;
    bf16x8 qf[8]; float qn2 = 0.f;
    {
        const bf16* p = W_PROJ + (rb + tql) * NPROJ + C_QB + hd * 128 + 8 * hh; const float cs = 0.08838834764831845f * LOG2E;
#pragma unroll
        for (int s = 0; s < 8; ++s) { const v4u raw = *(const GAS v4u*)(p + 16 * s); const f32x4 g0 = *(const f32x4*)(P_GKV + 16 * s + 8 * hh), g1 = *(const f32x4*)(P_GKV + 16 * s + 8 * hh + 4);
            v4u o; o.x = cvtpk(bflo(raw.x) * g0.x * cs, bfhi(raw.x) * g0.y * cs); o.y = cvtpk(bflo(raw.y) * g0.z * cs, bfhi(raw.y) * g0.w * cs);
            o.z = cvtpk(bflo(raw.z) * g1.x * cs, bfhi(raw.z) * g1.y * cs); o.w = cvtpk(bflo(raw.w) * g1.z * cs, bfhi(raw.w) * g1.w * cs);
            qn2 += (bflo(o.x) * bflo(o.x) + bfhi(o.x) * bfhi(o.x)) + (bflo(o.y) * bflo(o.y) + bfhi(o.y) * bfhi(o.y)) + (bflo(o.z) * bflo(o.z) + bfhi(o.z) * bfhi(o.z)) + (bflo(o.w) * bflo(o.w) + bfhi(o.w) * bfhi(o.w));
            qf[s] = __builtin_bit_cast(bf16x8, o); }
    }
    qn2 += __shfl_xor(qn2, 32);
    const float c0 = -(sqrtf(qn2) * 11.313708499f * 1.01f + mb2 + 1.0f);
    const float cfar = BT[127 * 4 + hd] + c0;
    f32x16 oacc[4];
#pragma unroll
    for (int d = 0; d < 4; ++d)
#pragma unroll
        for (int r = 0; r < 16; ++r) oacc[d][r] = 0.f;
    float lsum = 0.f;
    v4u st0, st1;
#define DSA_GLOAD(kt) do { const bf16* _p = W_PROJ + (rb + 64 * (kt) + lane) * NPROJ + C_CKV + wv * 16; st0 = *(const GAS v4u*)_p; st1 = *(const GAS v4u*)(_p + 8); } while (0)
#define DSA_SWRITE(buf, ktt) do { LAS unsigned char* _kb = L + (buf) * BUFSZ; const float _r = RS[64 * (ktt) + lane]; \
        v4u _n0, _n1; _n0.x = cvtpk(bflo(st0.x) * _r, bfhi(st0.x) * _r); _n0.y = cvtpk(bflo(st0.y) * _r, bfhi(st0.y) * _r); _n0.z = cvtpk(bflo(st0.z) * _r, bfhi(st0.z) * _r); _n0.w = cvtpk(bflo(st0.w) * _r, bfhi(st0.w) * _r); \
        _n1.x = cvtpk(bflo(st1.x) * _r, bfhi(st1.x) * _r); _n1.y = cvtpk(bflo(st1.y) * _r, bfhi(st1.y) * _r); _n1.z = cvtpk(bflo(st1.z) * _r, bfhi(st1.z) * _r); _n1.w = cvtpk(bflo(st1.w) * _r, bfhi(st1.w) * _r); \
        *(LAS v4u*)(_kb + O_K0 + lane * PK + wv * 32) = _n0; *(LAS v4u*)(_kb + O_K0 + lane * PK + wv * 32 + 16) = _n1; \
        LAS unsigned short* _vt = (LAS unsigned short*)(_kb + O_V0) + (wv * 16) * 72 + lane; \
        _vt[0 * 72] = (unsigned short)_n0.x; _vt[1 * 72] = (unsigned short)(_n0.x >> 16); _vt[2 * 72] = (unsigned short)_n0.y; _vt[3 * 72] = (unsigned short)(_n0.y >> 16); \
        _vt[4 * 72] = (unsigned short)_n0.z; _vt[5 * 72] = (unsigned short)(_n0.z >> 16); _vt[6 * 72] = (unsigned short)_n0.w; _vt[7 * 72] = (unsigned short)(_n0.w >> 16); \
        _vt[8 * 72] = (unsigned short)_n1.x; _vt[9 * 72] = (unsigned short)(_n1.x >> 16); _vt[10 * 72] = (unsigned short)_n1.y; _vt[11 * 72] = (unsigned short)(_n1.y >> 16); \
        _vt[12 * 72] = (unsigned short)_n1.z; _vt[13 * 72] = (unsigned short)(_n1.z >> 16); _vt[14 * 72] = (unsigned short)_n1.w; _vt[15 * 72] = (unsigned short)(_n1.w >> 16); } while (0)
    DSA_GLOAD(0); DSA_SWRITE(0, 0);
    __syncthreads();
    for (int kt = 0; kt <= qb; ++kt) {
        const int buf = kt & 1;
        l31 = l31_0; hh = hh_0; asm volatile("" : "+v"(l31), "+v"(hh));
        if (kt < qb) DSA_GLOAD(kt + 1);
        const LAS unsigned char* kb = L + buf * BUFSZ;
#pragma unroll
        for (int st = 0; st < 2; ++st) {
            f32x16 Sa;
#pragma unroll
            for (int r = 0; r < 16; ++r) Sa[r] = 0.f;
#pragma unroll
            for (int s = 0; s < 8; ++s) Sa = MFMA32(lds16(kb + O_K0 + (32 * st + l31) * PK + (16 * s + 8 * hh) * 2), qf[s], Sa);
            const int kbase = 64 * kt + 32 * st;
            const int mwi = (int)(MASK[(8 * wv + qj) * 64 + 2 * kt + st] >> (4 * hh));
            const bool far = (t0 + 8 * wv) - (kbase + 31) >= 113;
            float pn[16];
            if (far) {
#pragma unroll
                for (int r = 0; r < 16; ++r) { const float p = __builtin_bit_cast(float, __builtin_bit_cast(int, __builtin_amdgcn_exp2f(Sa[r] + cfar)) & __builtin_amdgcn_sbfe(mwi, 8 * (r >> 2) + (r & 3), 1));
                    lsum += p; pn[r] = p; }
            } else {
#pragma unroll
                for (int r = 0; r < 16; ++r) { int dist = tql - (kbase + 8 * (r >> 2) + 4 * hh + (r & 3)); dist = dist < 0 ? 0 : (dist > 127 ? 127 : dist);
                    const float p = __builtin_bit_cast(float, __builtin_bit_cast(int, __builtin_amdgcn_exp2f(Sa[r] + (BT[dist * 4 + hd] + c0))) & __builtin_amdgcn_sbfe(mwi, 8 * (r >> 2) + (r & 3), 1));
                    lsum += p; pn[r] = p; }
            }
            const bf16x8 pf0 = pack8(pn[0], pn[1], pn[2], pn[3], pn[4], pn[5], pn[6], pn[7]), pf1 = pack8(pn[8], pn[9], pn[10], pn[11], pn[12], pn[13], pn[14], pn[15]);
#pragma unroll
            for (int dt = 0; dt < 4; ++dt) { const LAS unsigned char* vp = kb + O_V0 + (32 * dt + l31) * PV + (32 * st + 4 * hh) * 2;
                oacc[dt] = MFMA32(lds8x2(vp), pf0, oacc[dt]); oacc[dt] = MFMA32(lds8x2(vp + 32), pf1, oacc[dt]); }
        }
        if (kt < qb) DSA_SWRITE(buf ^ 1, kt + 1);
        __syncthreads();
    }
#undef DSA_GLOAD
#undef DSA_SWRITE
    lsum += __shfl_xor(lsum, 32);
    {
        const float inv = rcpf_(lsum);
#pragma unroll
        for (int dt = 0; dt < 4; ++dt)
#pragma unroll
            for (int g = 0; g < 4; ++g) { const int d = 32 * dt + 8 * g + 4 * hh; const f32x4 gk = *(const f32x4*)(P_GKV + d);
                *(LAS v2u*)(L + O_OA + hd * 17408 + (8 * wv + qj) * PK + d * 2) = pack4(oacc[dt][4 * g] * inv * gk.x, oacc[dt][4 * g + 1] * inv * gk.y, oacc[dt][4 * g + 2] * inv * gk.z, oacc[dt][4 * g + 3] * inv * gk.w); }
    }
    __syncthreads();
    {
        const int hd2 = wv >> 1, mt2 = wv & 1;
        const size_t row = rb + t0 + 32 * mt2 + l31;
        bf16x8 of[8];
#pragma unroll
        for (int s = 0; s < 8; ++s) of[s] = lds16(L + O_OA + hd2 * 17408 + (32 * mt2 + l31) * PK + (16 * s + 8 * hh) * 2);
#pragma unroll 1
        for (int et = 0; et < 4; ++et) {
            v2u zw[4];
#pragma unroll
            for (int g = 0; g < 4; ++g) zw[g] = *(const GAS v2u*)(W_PROJ + row * NPROJ + C_ZB + hd2 * 128 + 32 * et + 8 * g + 4 * hh);
            f32x16 C;
#pragma unroll
            for (int r = 0; r < 16; ++r) C[r] = 0.f;
            const bf16* wp = W_WUVT + (size_t)hd2 * 16384 + (32 * et + l31) * 128 + 8 * hh;
#pragma unroll
            for (int s = 0; s < 8; ++s) C = MFMA32(*(const GAS bf16x8*)(wp + 16 * s), of[s], C);
#pragma unroll
            for (int g = 0; g < 4; ++g)
                *(GAS v2u*)(W_OAB + row * DM + 512 + hd2 * 128 + 32 * et + 8 * g + 4 * hh) =
                    pack4(C[4 * g] * siluf(bflo(zw[g].x)), C[4 * g + 1] * siluf(bfhi(zw[g].x)), C[4 * g + 2] * siluf(bflo(zw[g].y)), C[4 * g + 3] * siluf(bfhi(zw[g].y)));
        }
    }
    __syncthreads();
}

constexpr int N_GDN = NB * 4, N_DSA = NB * 32, N_ITEMS = N_GDN + N_DSA;
constexpr int N_PHASES = 6;
__global__ void __launch_bounds__(NWAVES * 64, 2) hyb_fwd(Args args) {
    extern __shared__ __attribute__((aligned(16))) unsigned char lds[];
    Frame F;
    F.lds = (LAS unsigned char*)lds;
    F.MISC = (volatile LAS unsigned*)(F.lds + MISC_OFF);
    F.tid = threadIdx.x; F.lane = F.tid & 63; F.wave = __builtin_amdgcn_readfirstlane(F.tid >> 6);
    F.G = gridDim.x; { const int bx = blockIdx.x; F.vcu = (F.G % 8 == 0) ? (bx % 8) * (F.G / 8) + bx / 8 : bx; }
    unsigned char* ws = args.ws;
    F.ctl = (gu32*)(ws + WS_CTL);
    F.ws = ws;
    for (int u = F.tid; u < 64; u += NWAVES * 64) F.MISC[u] = 0u;
    __syncthreads();
    const int lo = args.ph_lo, hi = args.ph_hi;
    const bool multi = (hi - lo) > 1;
    XcdBarrier bar; bar.bar = (unsigned*)(F.ctl + CW_BAR) + args.li * XCD_BAR_WORDS; bar.x = 0; bar.st = nullptr;
    if (multi) bar = xcd_barrier_post((unsigned*)(F.ctl + CW_BAR) + args.li * XCD_BAR_WORDS, F.MISC + 8);
#define IN(k) (lo <= (k) && (k) < hi)
#define BOTH(k) (IN(k) && IN((k) + 1))
    if (IN(0)) { p0_prologue(F, args); if (PROBE_DUP == 7) { __syncthreads(); p0_prologue(F, args); } if (BOTH(0)) xcd_barrier(bar); }
    if (IN(1)) { p1_norm(F, args); if (PROBE_DUP == 1) p1_norm(F, args); if (BOTH(1)) xcd_barrier(bar); }
    if (IN(2)) {
        pg8::Gemm g{W_XN, W_WINT, MROWS, NPROJ, DM}; pg8::StaticOrder S; S.init(MROWS, NPROJ, F.G, (int)blockIdx.x);
        pg8::EpiProj E{W_PROJ, W_AUX, W_KVSS};
        pg8::gemm_phase<pg8::EpiProj, pg8::StaticOrder, true, true>(F.lds, g, S, E);
        if (PROBE_DUP == 2) pg8::gemm_phase<pg8::EpiProj, pg8::StaticOrder, true, true>(F.lds, g, S, E);
        if (BOTH(2)) xcd_barrier(bar);
    }
    if (IN(3)) {
#define NEXT_ITEM(dst, qw) do { if (F.tid == 0) F.MISC[4] = __hip_atomic_fetch_add(F.ctl + (qw), 1u, RLX_AGENT); __syncthreads(); dst = (int)F.MISC[4]; __syncthreads(); } while (0)
        float mb2; { const int hd_ = F.lane & 3; float m_ = P_RELB[hd_]; for (int k = 1; k < 32; ++k) m_ = fmaxf(m_, P_RELB[k * 4 + hd_]); mb2 = m_ * LOG2E; }
        int item; NEXT_ITEM(item, CW_QUEUE);
#pragma unroll 1
        for (int pass = 0; pass < (PROBE_DUP == 3 ? 2 : 1); ++pass) {
            if (pass) NEXT_ITEM(item, CW_QUEUE + 64);
            while (item < N_GDN) { gdn_unit(F, args, item >> 2, item & 3); NEXT_ITEM(item, CW_QUEUE + 64 * pass); }
        }
#pragma unroll 1
        for (int pass = 0; pass < (PROBE_DUP == 4 ? 2 : 1); ++pass) {
            if (pass) NEXT_ITEM(item, CW_QUEUE + 128);
            while (item < N_ITEMS) { if (item >= N_GDN) { const int idx = item - N_GDN; dsa_unit(F, args, idx & 31, 31 - (idx >> 5), mb2); } NEXT_ITEM(item, pass ? CW_QUEUE + 128 : CW_QUEUE); }
        }
#undef NEXT_ITEM
        if (BOTH(3)) xcd_barrier(bar);
    }
    if (IN(4)) {
        pg8::Gemm g{W_OAB, W_WOUTT, MROWS, DM, DM}; pg8::StaticOrder S; S.init(MROWS, DM, F.G, (int)blockIdx.x);
        pg8::EpiMix E{W_MIX, DM};
        pg8::gemm_phase<pg8::EpiMix, pg8::StaticOrder, true, true>(F.lds, g, S, E);
        if (PROBE_DUP == 5) pg8::gemm_phase<pg8::EpiMix, pg8::StaticOrder, true, true>(F.lds, g, S, E);
        if (BOTH(4)) xcd_barrier(bar);
    }
    if (IN(5)) { p5_final(F, args); if (PROBE_DUP == 6) p5_final(F, args); }
#undef IN
#undef BOTH
}

extern "C" void kernel_launch(void* const* d_in, const int* in_sizes, int n_in, void* d_out, int out_size, void* d_ws, size_t ws_size, hipStream_t stream) {
    static int grid = 0;
    if (grid == 0) {
        if (n_in != 15 || in_sizes[0] != MROWS * DM || out_size != MROWS * DM || ws_size < WS_END) { fprintf(stderr, "kernel_launch: unexpected shapes (n_in %d, in0 %d, out %d, ws %zu); nothing launched\n", n_in, n_in > 0 ? in_sizes[0] : -1, out_size, ws_size); grid = -1; return; }
        int dev = 0, cus = 0, per_cu = 0;
        if (hipGetDevice(&dev) != hipSuccess || hipDeviceGetAttribute(&cus, hipDeviceAttributeMultiprocessorCount, dev) != hipSuccess) { fprintf(stderr, "kernel_launch: device query failed\n"); grid = -1; return; }
        if (hipFuncSetAttribute((const void*)hyb_fwd, hipFuncAttributeMaxDynamicSharedMemorySize, LDS_BYTES) != hipSuccess) { fprintf(stderr, "kernel_launch: hipFuncSetAttribute failed\n"); grid = -1; return; }
        if (hipOccupancyMaxActiveBlocksPerMultiprocessor(&per_cu, (const void*)hyb_fwd, NWAVES * 64, LDS_BYTES) != hipSuccess || per_cu < 1)
            fprintf(stderr, "kernel_launch: note: occupancy query reports %d workgroups per CU\n", per_cu);
        (void)hipGetLastError();
        grid = cus < 256 ? cus : 256;
    }
    if (grid < 0) return;
    if (hipMemsetAsync((char*)d_ws + WS_CTL, 0, CTL_ZERO_BYTES, stream) != hipSuccess) { fprintf(stderr, "kernel_launch: memset failed\n"); return; }
    Args a{};
    for (int i = 0; i < 15; ++i) a.in[i] = (const float*)d_in[i];
    a.out = (float*)d_out; a.ws = (unsigned char*)d_ws;
    constexpr int NL = MK_N_LAUNCHES;
    static_assert(NL == 1 || NL == 2 || NL == 3 || NL == N_PHASES, "MK_N_LAUNCHES");
    const int cuts1[2] = {0, 6}, cuts2[3] = {0, 3, 6}, cuts3[4] = {0, 3, 4, 6}, cuts6[7] = {0, 1, 2, 3, 4, 5, 6};
    const int* cuts = NL == 1 ? cuts1 : NL == 2 ? cuts2 : NL == 3 ? cuts3 : cuts6;
    for (int li = 0; li < NL; ++li) {
        a.ph_lo = cuts[li]; a.ph_hi = cuts[li + 1]; a.li = li;
        hipLaunchKernelGGL(hyb_fwd, dim3(grid), dim3(NWAVES * 64), LDS_BYTES, stream, a);
        const hipError_t le = hipPeekAtLastError();
        if (le != hipSuccess) { fprintf(stderr, "kernel_launch: launch %d failed: %s\n", li, hipGetErrorName(le)); break; }
    }
}
```

```cpp
#include <hip/hip_runtime.h>
#include <cstdio>
#include <cstdint>
#ifndef MK_N_LAUNCHES
#define MK_N_LAUNCHES 1
#endif
#ifndef PROBE_DUP
#define PROBE_DUP 0
#endif
namespace pg8 {
#define PG8_LAS __attribute__((address_space(3)))
typedef unsigned short bf16_t;
typedef short bf16x8 __attribute__((ext_vector_type(8)));
typedef float f32x4 __attribute__((ext_vector_type(4)));
typedef unsigned u32x4 __attribute__((ext_vector_type(4)));
constexpr int BM = 256, BK = 64, HALF = 128, HTB = HALF * BK * 2  , STAGE_BYTES = 8 * HTB, NXCD = 8, WGM = 8;

__host__ __device__ __forceinline__ int lds_byte(int r, int c) { const int st = (r >> 4) * 2 + (c >> 5), rr = r & 15, cc = c & 31, ob = rr * 64 + cc * 2; return st * 1024 + (ob ^ (((ob >> 9) & 1) << 5)); }
__host__ __device__ __forceinline__ void stage_rc(int b, int& R, int& C) { const int st = b / 1024, sb = b % 1024, swz = sb ^ (((sb >> 9) & 1) << 5); R = (st >> 1) * 16 + swz / 64; C = (st & 1) * 32 + (swz % 64) / 2; }
__host__ __device__ __forceinline__ int perm32(int rho) { const int n = rho >> 4, i = rho & 15; return 8 * (i >> 2) + 4 * n + (i & 3); }

struct Unit { int pm, pn; };
struct Gemm { const bf16_t* A; const bf16_t* Bt; int M, N, K; };

struct StaticOrder {
    int nM, nN, nwg, G, c;
    __host__ __device__ void init(int M, int N, int G_, int c_) { nM = M / BM; nN = N / BM; nwg = nM * nN; G = G_; c = c_; }
    __host__ __device__ bool next(int i, Unit& u) const {
        const long L = (long)i * G + c; if (L >= nwg) return false;
        int wgid = (int)L; { const int q = nwg / NXCD, r = nwg % NXCD, xcd = wgid % NXCD, off = wgid / NXCD; wgid = (xcd < r ? xcd * (q + 1) : r * (q + 1) + (xcd - r) * q) + off; }
        const int nig = WGM * nN, gid = wgid / nig, fm = gid * WGM, gsz = (nM - fm) < WGM ? (nM - fm) : WGM;
        u.pm = fm + ((wgid % nig) % gsz); u.pn = (wgid % nig) / gsz; return true;
    }
    __device__ __forceinline__ void a_ready(const Unit&) const {}
    __device__ __forceinline__ void done(const Unit&) const {}
};

typedef float f32x2c __attribute__((ext_vector_type(2))); typedef __bf16 b16x2c __attribute__((ext_vector_type(2)));
__device__ __forceinline__ unsigned cvt_pk_bf16(float lo, float hi) { const f32x2c v = {lo, hi}; return __builtin_bit_cast(unsigned, __builtin_convertvector(v, b16x2c)); }
struct EpiProj {
    static constexpr bool PERM = true, AFTER_DRAIN = false;
    bf16_t* O; float* aux; float* kvss;
    __device__ __forceinline__ void operator()(const f32x4 (&acc)[2][2][4][2], const Unit& u, int wr, int wc, int fr, int fq) const {
        const int row0 = u.pm * BM + wr * 64 + fr, col0 = u.pn * BM + wc * 32 + 8 * fq;
        const bool last = (u.pn == 14);
#pragma unroll
        for (int ai = 0; ai < 2; ++ai)
#pragma unroll
            for (int m = 0; m < 4; ++m) {
                const int row = row0 + ai * HALF + m * 16;
                bf16_t* rowp = O + (size_t)row * 3840 + col0;
#pragma unroll
                for (int bj = 0; bj < 2; ++bj) {
                    const f32x4 v0 = acc[ai][bj][m][0], v1 = acc[ai][bj][m][1];
                    u32x4 w; w.x = cvt_pk_bf16(v0[0], v0[1]); w.y = cvt_pk_bf16(v0[2], v0[3]); w.z = cvt_pk_bf16(v1[0], v1[1]); w.w = cvt_pk_bf16(v1[2], v1[3]);
                    *(u32x4*)(rowp + bj * HALF) = w;
                }
                if (last) {
                    const f32x4 a0 = acc[ai][0][m][0], a1 = acc[ai][0][m][1];
                    float ss = (a0[0] * a0[0] + a0[1] * a0[1]) + (a0[2] * a0[2] + a0[3] * a0[3]) + (a1[0] * a1[0] + a1[1] * a1[1]) + (a1[2] * a1[2] + a1[3] * a1[3]);
                    ss += __shfl_xor(ss, 16); ss += __shfl_xor(ss, 32);
                    if (fq == 0) kvss[(size_t)row * 4 + wc] = ss;
                    if (wc == 2 && fq < 2) { float* ap = aux + (size_t)row * 16 + 8 * fq; *(f32x4*)ap = acc[ai][1][m][0]; *(f32x4*)(ap + 4) = acc[ai][1][m][1]; }
                }
            }
    }
};
struct EpiF32 {
    static constexpr bool PERM = false, AFTER_DRAIN = false;
    float* C; int ldc;
    __device__ __forceinline__ void operator()(const f32x4 (&acc)[2][2][4][2], const Unit& u, int wr, int wc, int fr, int fq) const {
        const int row0 = u.pm * BM + wr * 64 + fr, col0 = u.pn * BM + wc * 32 + 4 * fq;
#pragma unroll
        for (int ai = 0; ai < 2; ++ai)
#pragma unroll
            for (int m = 0; m < 4; ++m) { float* rowp = C + (size_t)(row0 + ai * HALF + m * 16) * ldc + col0;
#pragma unroll
                for (int bj = 0; bj < 2; ++bj)
#pragma unroll
                    for (int n = 0; n < 2; ++n) *(f32x4*)(rowp + bj * HALF + n * 16) = acc[ai][bj][m][n]; }
    }
};
struct EpiMix {
    static constexpr bool PERM = true, AFTER_DRAIN = false;
    bf16_t* O; int ldc;
    __device__ __forceinline__ void operator()(const f32x4 (&acc)[2][2][4][2], const Unit& u, int wr, int wc, int fr, int fq) const {
        const int row0 = u.pm * BM + wr * 64 + fr, col0 = u.pn * BM + wc * 32 + 8 * fq;
#pragma unroll
        for (int ai = 0; ai < 2; ++ai)
#pragma unroll
            for (int m = 0; m < 4; ++m) { bf16_t* rowp = O + (size_t)(row0 + ai * HALF + m * 16) * ldc + col0;
#pragma unroll
                for (int bj = 0; bj < 2; ++bj) { const f32x4 v0 = acc[ai][bj][m][0], v1 = acc[ai][bj][m][1];
                    u32x4 w; w.x = cvt_pk_bf16(v0[0], v0[1]); w.y = cvt_pk_bf16(v0[2], v0[3]); w.z = cvt_pk_bf16(v1[0], v1[1]); w.w = cvt_pk_bf16(v1[2], v1[3]);
                    *(u32x4*)(rowp + bj * HALF) = w; } }
    }
};
template <class Epi, class Sched, bool ALIGN_EPI = false, bool SP2 = false>
__device__ __forceinline__ void gemm_phase(PG8_LAS unsigned char* lds, const Gemm g, const Sched& S, const Epi& E) {
    const int tid = threadIdx.x, wid = __builtin_amdgcn_readfirstlane(tid >> 6), lane = tid & 63, wr = wid >> 2, wc = wid & 3, fr = lane & 15, fq = lane >> 4;
    const int K = g.K, nt = K / BK;
    unsigned voffA[2], voffB[2];
#pragma unroll
    for (int i = 0; i < 2; ++i) { int R, C; stage_rc(tid * 16 + i * 8192, R, C); const int Rb = Epi::PERM ? ((R & ~31) + perm32(R & 31)) : R;
        voffA[i] = (unsigned)(R * K + C) * 2u; voffB[i] = (unsigned)(Rb * K + C) * 2u; }
    const size_t kstep = (size_t)(BK * 2);
    const size_t hstep = (size_t)HALF * K * 2;
    const size_t tstep = 2 * hstep;
    const unsigned ldsw = (unsigned)wid * 1024u;
    const int aoff = lds_byte(wr * 64 + fr, fq * 8), boff = lds_byte(wc * 32 + fr, fq * 8);
#define PG8_SA(b, h) (((b) * 2 + (h)) * HTB)
#define PG8_SB(b, h) ((4 + (b) * 2 + (h)) * HTB)
#define PG8_STAGE(bufoff, gbase, voff) do { _Pragma("unroll") for (int _i = 0; _i < 2; ++_i) \
        __builtin_amdgcn_global_load_lds((const unsigned*)((const char*)(gbase) + (voff)[_i]), (PG8_LAS unsigned*)(lds + (bufoff) + ldsw + _i * 8192), 16, 0, 0); } while (0)
#define PG8_LDA(dst, b, h) do { _Pragma("unroll") for (int m = 0; m < 4; ++m) _Pragma("unroll") for (int k = 0; k < 2; ++k) dst[m][k] = *(const PG8_LAS bf16x8*)(lds + PG8_SA(b, h) + aoff + m * 2048 + k * 1024); } while (0)
#define PG8_LDB(dst, b, h) do { _Pragma("unroll") for (int n = 0; n < 2; ++n) _Pragma("unroll") for (int k = 0; k < 2; ++k) dst[n][k] = *(const PG8_LAS bf16x8*)(lds + PG8_SB(b, h) + boff + n * 2048 + k * 1024); } while (0)
#define PG8_MMA(ai, bj, At, Bt) do { __builtin_amdgcn_s_setprio(1); _Pragma("unroll") for (int m = 0; m < 4; ++m) _Pragma("unroll") for (int n = 0; n < 2; ++n) _Pragma("unroll") for (int k = 0; k < 2; ++k) \
        acc[ai][bj][m][n] = __builtin_amdgcn_mfma_f32_16x16x32_bf16(Bt[n][k], At[m][k], acc[ai][bj][m][n], 0, 0, 0); __builtin_amdgcn_s_setprio(0); } while (0)
#define PG8_WAIT_V(n) asm volatile("s_waitcnt vmcnt(" #n ")" ::: "memory")
#define PG8_WAIT_L(n) asm volatile("s_waitcnt lgkmcnt(" #n ")" ::: "memory")
#define PG8_BAR __builtin_amdgcn_s_barrier()
#define PG8_SCHED __builtin_amdgcn_sched_barrier(0)
    Unit cur, nxt; int ui = 0;
    if (!S.next(0, cur)) return;
    f32x4 acc[2][2][4][2];
#pragma unroll
    for (int a = 0; a < 2; ++a)
#pragma unroll
        for (int b = 0; b < 2; ++b)
#pragma unroll
            for (int m = 0; m < 4; ++m)
#pragma unroll
                for (int n = 0; n < 2; ++n) acc[a][b][m][n] = (f32x4){0.f, 0.f, 0.f, 0.f};
    bf16x8 At[4][2], B0[2][2], B1[2][2];
    const char* cA = (const char*)g.A + (size_t)cur.pm * tstep; const char* cB = (const char*)g.Bt + (size_t)cur.pn * tstep;
    S.a_ready(cur);
    if constexpr (SP2) {
        PG8_STAGE(PG8_SB(0, 0), cB, voffB); PG8_STAGE(PG8_SB(0, 1), cB + hstep, voffB); PG8_STAGE(PG8_SA(0, 0), cA, voffA); PG8_STAGE(PG8_SA(0, 1), cA + hstep, voffA);
        if (wr == 1) PG8_BAR;
        PG8_WAIT_V(2); PG8_BAR;
        PG8_STAGE(PG8_SB(1, 0), cB + kstep, voffB); PG8_STAGE(PG8_SA(1, 0), cA + kstep, voffA); PG8_STAGE(PG8_SB(1, 1), cB + hstep + kstep, voffB);
        PG8_WAIT_V(6); PG8_BAR;
    } else {
        PG8_STAGE(PG8_SB(0, 0), cB, voffB); PG8_STAGE(PG8_SA(0, 0), cA, voffA); PG8_STAGE(PG8_SB(0, 1), cB + hstep, voffB); PG8_STAGE(PG8_SA(0, 1), cA + hstep, voffA);
        if (wr == 1) PG8_BAR;
        PG8_WAIT_V(4); PG8_BAR;
        PG8_STAGE(PG8_SB(1, 0), cB + kstep, voffB); PG8_STAGE(PG8_SA(1, 0), cA + kstep, voffA); PG8_STAGE(PG8_SB(1, 1), cB + hstep + kstep, voffB);
        PG8_WAIT_V(6); PG8_BAR;
    }
    for (;;) {
        const bool has_next = S.next(ui + 1, nxt);
        const char* nA = has_next ? (const char*)g.A + (size_t)nxt.pm * tstep : cA; const char* nB = has_next ? (const char*)g.Bt + (size_t)nxt.pn * tstep : cB;
        for (int t = 0; t < nt; t += 2) {
            const bool last = (t == nt - 2);
            const char* a1 = cA + (size_t)(t + 1) * kstep;
            const char* a2 = last ? nA : cA + (size_t)(t + 2) * kstep; const char* b2 = last ? nB : cB + (size_t)(t + 2) * kstep;
            const char* a3 = a2 + kstep; const char* b3 = b2 + kstep;
            if (last && has_next) S.a_ready(nxt);
            if constexpr (SP2) {
            PG8_LDB(B0, 0, 0); PG8_LDB(B1, 0, 1); PG8_SCHED; PG8_LDA(At, 0, 0); PG8_STAGE(PG8_SA(1, 1), a1 + hstep, voffA);
            PG8_WAIT_V(8); PG8_WAIT_L(0); PG8_BAR; PG8_MMA(0, 0, At, B0); PG8_MMA(0, 1, At, B1); PG8_BAR; PG8_SCHED;
            PG8_LDA(At, 0, 1); PG8_STAGE(PG8_SB(0, 0), b2, voffB); PG8_STAGE(PG8_SB(0, 1), b2 + hstep, voffB); PG8_STAGE(PG8_SA(0, 0), a2, voffA);
            PG8_WAIT_V(8); PG8_WAIT_L(0); PG8_BAR; PG8_MMA(1, 0, At, B0); PG8_MMA(1, 1, At, B1); PG8_BAR; PG8_SCHED;
            PG8_LDB(B0, 1, 0); PG8_LDB(B1, 1, 1); PG8_SCHED; PG8_LDA(At, 1, 0); PG8_STAGE(PG8_SA(0, 1), a2 + hstep, voffA);
            PG8_WAIT_V(8); PG8_WAIT_L(0); PG8_BAR; PG8_MMA(0, 0, At, B0); PG8_MMA(0, 1, At, B1); PG8_BAR; PG8_SCHED;
            PG8_LDA(At, 1, 1); PG8_STAGE(PG8_SB(1, 0), b3, voffB); PG8_STAGE(PG8_SB(1, 1), b3 + hstep, voffB); PG8_STAGE(PG8_SA(1, 0), a3, voffA);
            PG8_WAIT_V(8); PG8_WAIT_L(0); PG8_BAR; PG8_MMA(1, 0, At, B0); PG8_MMA(1, 1, At, B1); PG8_BAR; PG8_SCHED;
            } else {
            PG8_LDB(B0, 0, 0); PG8_SCHED; PG8_LDA(At, 0, 0); PG8_STAGE(PG8_SA(1, 1), a1 + hstep, voffA);
            PG8_WAIT_L(8); PG8_BAR; PG8_WAIT_L(0); PG8_MMA(0, 0, At, B0); PG8_BAR; PG8_SCHED;
            PG8_LDB(B1, 0, 1); PG8_STAGE(PG8_SB(0, 0), b2, voffB);
            PG8_BAR; PG8_WAIT_L(0); PG8_MMA(0, 1, At, B1); PG8_BAR;
            PG8_LDA(At, 0, 1); PG8_STAGE(PG8_SA(0, 0), a2, voffA);
            PG8_BAR; PG8_WAIT_L(0); PG8_MMA(1, 0, At, B0); PG8_BAR; PG8_SCHED;
            PG8_STAGE(PG8_SB(0, 1), b2 + hstep, voffB);
            PG8_WAIT_V(6); PG8_BAR; PG8_MMA(1, 1, At, B1); PG8_BAR;
            PG8_LDB(B0, 1, 0); PG8_SCHED; PG8_LDA(At, 1, 0); PG8_STAGE(PG8_SA(0, 1), a2 + hstep, voffA);
            PG8_WAIT_L(8); PG8_BAR; PG8_WAIT_L(0); PG8_MMA(0, 0, At, B0); PG8_BAR; PG8_SCHED;
            PG8_LDB(B1, 1, 1); PG8_STAGE(PG8_SB(1, 0), b3, voffB);
            PG8_BAR; PG8_WAIT_L(0); PG8_MMA(0, 1, At, B1); PG8_BAR;
            PG8_LDA(At, 1, 1); PG8_STAGE(PG8_SA(1, 0), a3, voffA);
            PG8_BAR; PG8_WAIT_L(0); PG8_MMA(1, 0, At, B0); PG8_BAR; PG8_SCHED;
            PG8_STAGE(PG8_SB(1, 1), b3 + hstep, voffB);
            PG8_WAIT_V(6); PG8_BAR; PG8_MMA(1, 1, At, B1); PG8_BAR;
            }
        }
        if constexpr (ALIGN_EPI) { if (wr == 0) PG8_BAR; }
        if constexpr (!Epi::AFTER_DRAIN) { E(acc, cur, wr, wc, fr, fq); S.done(cur); }
        if (!has_next) break;
#pragma unroll
        for (int a = 0; a < 2; ++a)
#pragma unroll
            for (int b = 0; b < 2; ++b)
#pragma unroll
                for (int m = 0; m < 4; ++m)
#pragma unroll
                    for (int n = 0; n < 2; ++n) acc[a][b][m][n] = (f32x4){0.f, 0.f, 0.f, 0.f};
        cur = nxt; cA = nA; cB = nB; ++ui;
        if constexpr (ALIGN_EPI) { if (wr == 1) PG8_BAR; }
    }
    PG8_WAIT_V(0);
    if constexpr (!ALIGN_EPI) { if (wr == 0) PG8_BAR; }
    PG8_BAR;
    if constexpr (Epi::AFTER_DRAIN) { E.fused(acc, cur, wr, wc, fr, fq, lds, wid, lane); S.done(cur); }
#undef PG8_SA
#undef PG8_SB
#undef PG8_STAGE
#undef PG8_LDA
#undef PG8_LDB
#undef PG8_MMA
#undef PG8_WAIT_V
#undef PG8_WAIT_L
#undef PG8_BAR
#undef PG8_SCHED
}
}

constexpr int NWAVES = 8;
constexpr int NB = 32, SEQ = 2048, DM = 1024, MROWS = NB * SEQ;
constexpr int NPROJ = 3840;
constexpr int C_ZA = 1536, C_QB = 2048, C_ZB = 2560, C_IQ = 3072, C_CKV = 3584, C_IK = 3712;
constexpr float EPSF = 1e-6f;
constexpr float LOG2E = 1.4426950408889634f;
__host__ __device__ __forceinline__ int proj_src_col(int n) {
    if (n < 2048) return n;
    if (n < 2560) return n - 2048 + 2056;
    if (n < 3072) return n - 2560 + 2696;
    if (n < 3584) return n - 3072 + 3208;
    if (n < 3712) return n - 3584 + 2568;
    if (n < 3776) return n - 3712 + 3720;
    if (n < 3784) return n - 3776 + 2048;
    if (n < 3792) return n;
    return -1;
}
__device__ const unsigned char T5_BUCKET[128] = {0,1,2,3,4,5,6,7,8,9,10,11,12,13,14,15,16,16,16,17,17,18,18,18,19,19,19,20,20,20,20,21,21,21,21,22,22,22,22,22,23,23,23,23,23,23,24,24,24,24,24,24,25,25,25,25,25,25,25,26,26,26,26,26,26,26,26,27,27,27,27,27,27,27,27,27,27,28,28,28,28,28,28,28,28,28,28,29,29,29,29,29,29,29,29,29,29,29,29,30,30,30,30,30,30,30,30,30,30,30,30,30,30,31,31,31,31,31,31,31,31,31,31,31,31,31,31,31};

constexpr size_t MiB = 1u << 20;
constexpr size_t WS_CTL = 0, CTL_ZERO_BYTES = 1 * MiB;
constexpr size_t WS_MOD = 1 * MiB;
constexpr size_t WS_WUV = 2 * MiB;
constexpr size_t WS_WOUT = 3 * MiB;
constexpr size_t WS_WIN = 5 * MiB;
constexpr size_t WS_KVSS = 13 * MiB;
constexpr size_t WS_AUX = 14 * MiB;
constexpr size_t WS_XN = 32 * MiB;
constexpr size_t WS_PROJ = 160 * MiB;
constexpr size_t WS_SCR = 640 * MiB;
constexpr size_t WS_END = 768 * MiB;
constexpr int CW_TMO = 0, CW_QUEUE = 64, CW_BAR = 4096;

constexpr int LDS_BYTES = 163840;
constexpr int MISC_OFF = LDS_BYTES - 256;
constexpr int SCRATCH_BYTES = MISC_OFF;

#define GAS __attribute__((address_space(1)))
#define LAS __attribute__((address_space(3)))
typedef unsigned short bf16;
typedef unsigned v4u __attribute__((ext_vector_type(4)));
typedef unsigned v2u __attribute__((ext_vector_type(2)));
typedef float f32x4 __attribute__((ext_vector_type(4)));
typedef float f32x16 __attribute__((ext_vector_type(16)));
typedef short bf16x8 __attribute__((ext_vector_type(8)));
typedef GAS unsigned gu32;
#define RLX_AGENT __ATOMIC_RELAXED, __HIP_MEMORY_SCOPE_AGENT
#define LDS_WAIT() asm volatile("s_waitcnt lgkmcnt(0)" ::: "memory")
#define MFMA32(a, b, c) __builtin_amdgcn_mfma_f32_32x32x16_bf16((a), (b), (c), 0, 0, 0)
#define MFMA16F(a, b, c) __builtin_amdgcn_mfma_f32_16x16x4f32((a), (b), (c), 0, 0, 0)
__device__ __forceinline__ unsigned f2bf(float f) { unsigned u = __builtin_bit_cast(unsigned, f); return (u + 0x7fffu + ((u >> 16) & 1u)) >> 16; }
__device__ __forceinline__ unsigned pk2(float lo, float hi) { return f2bf(lo) | (f2bf(hi) << 16); }
__device__ __forceinline__ float bf2f(unsigned short b) { return __builtin_bit_cast(float, ((unsigned)b) << 16); }
__device__ __forceinline__ float bflo(unsigned w) { return __builtin_bit_cast(float, w << 16); }
__device__ __forceinline__ float bfhi(unsigned w) { return __builtin_bit_cast(float, w & 0xffff0000u); }
__device__ __forceinline__ float rcpf_(float x) { return __builtin_amdgcn_rcpf(x); }
__device__ __forceinline__ float rsqf_(float x) { return __builtin_amdgcn_rsqf(x); }
__device__ __forceinline__ float siluf(float x) { return x * __builtin_amdgcn_rcpf(1.0f + __builtin_amdgcn_exp2f(-1.4426950408889634f * x)); }
__device__ __forceinline__ float wave_sum(float v) {
#pragma unroll
    for (int o = 1; o < 64; o <<= 1) v += __shfl_xor(v, o);
    return v;
}

__device__ __forceinline__ int wave_sum_i(int v) {
    v += __builtin_amdgcn_update_dpp(0, v, 0x111, 0xf, 0xf, false);
    v += __builtin_amdgcn_update_dpp(0, v, 0x112, 0xf, 0xf, false);
    v += __builtin_amdgcn_update_dpp(0, v, 0x114, 0xf, 0xe, false);
    v += __builtin_amdgcn_update_dpp(0, v, 0x118, 0xf, 0xc, false);
    v += __builtin_amdgcn_update_dpp(0, v, 0x142, 0xa, 0xf, false);
    v += __builtin_amdgcn_update_dpp(0, v, 0x143, 0xc, 0xf, false);
    return __builtin_amdgcn_readlane(v, 63);
}
__device__ __forceinline__ float wave_max(float v) {
    const int ninf = (int)0xff800000u;
#define WM_STEP(ctrl, rm, bm) v = fmaxf(v, __builtin_bit_cast(float, __builtin_amdgcn_update_dpp(ninf, __builtin_bit_cast(int, v), ctrl, rm, bm, false)))
    WM_STEP(0x111, 0xf, 0xf); WM_STEP(0x112, 0xf, 0xf); WM_STEP(0x114, 0xf, 0xe); WM_STEP(0x118, 0xf, 0xc); WM_STEP(0x142, 0xa, 0xf); WM_STEP(0x143, 0xc, 0xf);
#undef WM_STEP
    return __builtin_bit_cast(float, __builtin_amdgcn_readlane(__builtin_bit_cast(int, v), 63));
}
#define XB_TMO      128
#define XB_XCNT(j)  (256  + 64 * (j))
#define XB_XSUB(j)  (1280 + 64 * (j))
#define XB_XGEN(j)  (2304 + 64 * (j))
#define XB_TOP      3328
#define XB_TOPGEN   3392
#define XCD_BAR_WORDS 3456
#define XB_SPIN_CAP (1u << 18)

__device__ __forceinline__ unsigned xb_ld(unsigned* p)              { return __hip_atomic_load(p, __ATOMIC_RELAXED, __HIP_MEMORY_SCOPE_AGENT); }
__device__ __forceinline__ unsigned xb_add(unsigned* p, unsigned v) { return __hip_atomic_fetch_add(p, v, __ATOMIC_RELAXED, __HIP_MEMORY_SCOPE_AGENT); }
__device__ __forceinline__ unsigned xb_xcc_id() { return (unsigned)__builtin_amdgcn_s_getreg((3 << 11) | 20) & 0xFu; }
#define XB_SPIN(cond, bar) do { unsigned _sp = 0; while (cond) { __builtin_amdgcn_s_sleep(1); \
    if ((++_sp & 255u) == 0u) { if (xb_ld(&(bar)[XB_TMO])) break; if (_sp > XB_SPIN_CAP) { atomicAdd(&(bar)[XB_TMO], 1u); break; } } } } while (0)

struct XcdBarrier {
    unsigned* bar; unsigned x;
    volatile LAS unsigned* st;
};

__device__ __forceinline__ XcdBarrier xcd_barrier_post(unsigned* bar, volatile LAS unsigned* st) {
    XcdBarrier b; b.bar = bar; b.x = xb_xcc_id(); b.st = st;
    if (threadIdx.x == 0) (void)xb_add(&bar[XB_XCNT(b.x)], 1u);
    return b;
}
__device__ __forceinline__ void xcd_barrier_complete(unsigned* bar, unsigned x, unsigned& nloc, unsigned& nx) {
    const unsigned G = gridDim.x * gridDim.y * gridDim.z;
    unsigned sum, cnt, mine, sp = 0u;
    for (;;) {
        sum = 0u; cnt = 0u; mine = 0u;
#pragma unroll
        for (unsigned j = 0; j < 16; ++j) { const unsigned c = xb_ld(&bar[XB_XCNT(j)]); sum += c; cnt += (c > 0u) ? 1u : 0u; mine = (j == x) ? c : mine; }
        if (sum == G) break;
        __builtin_amdgcn_s_sleep(1);
        if ((++sp & 255u) == 0u) { if (xb_ld(&bar[XB_TMO])) break; if (sp > XB_SPIN_CAP) { atomicAdd(&bar[XB_TMO], 1u); break; } }
    }
    nloc = mine > 0u ? mine : 1u; nx = cnt > 0u ? cnt : 1u;
}

__device__ __forceinline__ void xcd_barrier(const XcdBarrier& b) {
    asm volatile("s_waitcnt vmcnt(0)" ::: "memory");
    __syncthreads();
    if (threadIdx.x == 0) {
        unsigned* bar = b.bar;
        __builtin_amdgcn_s_waitcnt(0);
        unsigned nloc = b.st[0], nx = b.st[1];
        if (nloc == 0u) { xcd_barrier_complete(bar, b.x, nloc, nx); b.st[0] = nloc; b.st[1] = nx; }
        const unsigned old = xb_add(&bar[XB_XSUB(b.x)], 1u);
        const unsigned gen = old / nloc;
        if (old + 1u == (gen + 1u) * nloc) {
            __builtin_amdgcn_fence(__ATOMIC_RELEASE, "agent");
            asm volatile("s_waitcnt vmcnt(0)" ::: "memory");
            const unsigned og = xb_add(&bar[XB_TOP], 1u);
            const unsigned tg = og / nx;
            if (og + 1u == (tg + 1u) * nx) xb_add(&bar[XB_TOPGEN], 1u);
            else XB_SPIN(xb_ld(&bar[XB_TOPGEN]) == tg, bar);
            __builtin_amdgcn_fence(__ATOMIC_ACQUIRE, "agent");
            xb_add(&bar[XB_XGEN(b.x)], 1u);
            asm volatile("s_waitcnt vmcnt(0)" ::: "memory");
        } else {
            XB_SPIN(xb_ld(&bar[XB_XGEN(b.x)]) == gen, bar);
            __builtin_amdgcn_fence(__ATOMIC_ACQUIRE, "agent");
            asm volatile("s_waitcnt vmcnt(0)" ::: "memory");
        }
    }
    __syncthreads();
}

struct Frame {
    LAS unsigned char* lds;
    volatile LAS unsigned* MISC;
    gu32* ctl;
    int tid, lane, wave;
    int vcu, G;
    unsigned char* ws;
};
#define P_X        (args.in[0])
#define P_C        (args.in[1])
#define P_WADA     (args.in[2])
#define P_BADA     (args.in[3])
#define P_GPRE     (args.in[4])
#define P_WIN      (args.in[5])
#define P_CONVW    (args.in[6])
#define P_ALOG     (args.in[7])
#define P_DTB      (args.in[8])
#define P_GGDN     (args.in[9])
#define P_GKV      (args.in[10])
#define P_WUV      (args.in[11])
#define P_RELB     (args.in[12])
#define P_WOUT     (args.in[13])
#define P_GPOST    (args.in[14])
#define P_OUT      (args.out)
#define W_MOD      ((float*)(F.ws + WS_MOD))
#define W_WUVT     ((bf16*)(F.ws + WS_WUV))
#define W_WOUTT    ((bf16*)(F.ws + WS_WOUT))
#define W_WINT     ((bf16*)(F.ws + WS_WIN))
#define W_KVSS     ((float*)(F.ws + WS_KVSS))
#define W_AUX      ((float*)(F.ws + WS_AUX))
#define W_XN       ((bf16*)(F.ws + WS_XN))
#define W_OAB      ((bf16*)(F.ws + WS_XN))
#define W_PROJ     ((bf16*)(F.ws + WS_PROJ))
#define W_MIX      ((bf16*)(F.ws + WS_PROJ))
#define W_SCR      ((float*)(F.ws + WS_SCR))
struct Args { const float* in[15]; float* out; unsigned char* ws; int ph_lo, ph_hi, li, pad; };

template <class CM>
__device__ __forceinline__ void transpose_item(const float* W, int ldw, bf16* WT, int K, int k0, int n0, LAS float* scr, int lane, CM cm) {
    const int nn = lane & 31, sc = cm(n0 + nn);
#pragma unroll 8
    for (int i = 0; i < 32; ++i) { const int kk = 2 * i + (lane >> 5); scr[kk * 33 + nn] = sc >= 0 ? W[(size_t)(k0 + kk) * ldw + sc] : 0.f; }
    LDS_WAIT(); asm volatile("" ::: "memory");
    const int c = lane & 7;
#pragma unroll
    for (int j = 0; j < 4; ++j) { const int n = (lane >> 3) + 8 * j; const LAS float* s = scr + (8 * c) * 33 + n;
        v4u o; o.x = pk2(s[0 * 33], s[1 * 33]); o.y = pk2(s[2 * 33], s[3 * 33]); o.z = pk2(s[4 * 33], s[5 * 33]); o.w = pk2(s[6 * 33], s[7 * 33]);
        *(GAS v4u*)(WT + (size_t)(n0 + n) * K + k0 + 8 * c) = o; }
    LDS_WAIT(); asm volatile("" ::: "memory");
}
struct CmIdent { __device__ __forceinline__ int operator()(int n) const { return n; } };
struct CmProj { __device__ __forceinline__ int operator()(int n) const { return proj_src_col(n); } };

__device__ __forceinline__ void p0_prologue(Frame& F, const Args& args) {
    LAS float* scr = (LAS float*)(F.lds + F.wave * 16384);
    const int gw = F.vcu * NWAVES + F.wave, NGW = F.G * NWAVES;
    constexpr int I_IN = 16 * (NPROJ / 32), I_OUT = 16 * 32, I_UV = 4 * 2 * 4;
    for (int it = gw; it < I_IN + I_OUT + I_UV; it += NGW) {
        int r = it;
        if (r < I_IN) { const int kb = r / (NPROJ / 32), nb = r % (NPROJ / 32); transpose_item(P_WIN, 3792, W_WINT, 1024, 64 * kb, 32 * nb, scr, F.lane, CmProj()); continue; }
        r -= I_IN;
        if (r < I_OUT) { const int kb = r / 32, nb = r % 32; transpose_item(P_WOUT, 1024, W_WOUTT, 1024, 64 * kb, 32 * nb, scr, F.lane, CmIdent()); continue; }
        r -= I_OUT;
        { const int hd = r >> 3, kb = (r >> 2) & 1, nb = r & 3; transpose_item(P_WUV + (size_t)hd * 16384, 128, W_WUVT + (size_t)hd * 16384, 128, 64 * kb, 32 * nb, scr, F.lane, CmIdent()); }
    }
    __syncthreads();
    if (F.vcu < 192) {
        LAS float* SC = (LAS float*)F.lds;
        for (int e = F.tid; e < NB * 1024; e += NWAVES * 64) { const int b = e >> 10, k = e & 1023; SC[k * 33 + b] = siluf(P_C[e]); }
        __syncthreads();
        const int col = F.tid & 15, ks = F.tid >> 4, n = F.vcu * 16 + col;
        float acc[32];
#pragma unroll
        for (int b = 0; b < 32; ++b) acc[b] = 0.f;
        for (int kk = 0; kk < 32; ++kk) { const int k = ks * 32 + kk; const float w = P_WADA[(size_t)k * 3072 + n];
#pragma unroll
            for (int b = 0; b < 32; ++b) acc[b] += SC[k * 33 + b] * w; }
        __syncthreads();
        LAS float* RED = (LAS float*)F.lds;
#pragma unroll
        for (int b = 0; b < 32; ++b) RED[(ks * 32 + b) * 16 + col] = acc[b];
        __syncthreads();
        { const int b = F.tid >> 4; float s = 0.f;
            for (int k2 = 0; k2 < 32; ++k2) s += RED[(k2 * 32 + b) * 16 + col];
            W_MOD[b * 3072 + n] = s + P_BADA[n]; }
        __syncthreads();
    }
}

__device__ __forceinline__ void p1_norm(Frame& F, const Args& args) {
    const int gw = F.vcu * NWAVES + F.wave, NGW = F.G * NWAVES;
    for (int m = 2 * gw; m < MROWS; m += 2 * NGW) {
        const int b = m >> 11;
        const GAS f32x4* xr = (const GAS f32x4*)(P_X + (size_t)m * DM) + F.lane;
        f32x4 v[2][4]; float ss[2] = {0.f, 0.f};
#pragma unroll
        for (int q = 0; q < 2; ++q)
#pragma unroll
            for (int j = 0; j < 4; ++j) v[q][j] = xr[q * 256 + 64 * j];
#pragma unroll
        for (int q = 0; q < 2; ++q)
#pragma unroll
            for (int j = 0; j < 4; ++j) ss[q] += (v[q][j].x * v[q][j].x + v[q][j].y * v[q][j].y) + (v[q][j].z * v[q][j].z + v[q][j].w * v[q][j].w);
        const float rstd0 = rsqf_(wave_sum(ss[0]) * (1.0f / DM) + EPSF), rstd1 = rsqf_(wave_sum(ss[1]) * (1.0f / DM) + EPSF);
        const float* mb = W_MOD + b * 3072;
        GAS unsigned long long* o8 = (GAS unsigned long long*)(W_XN + (size_t)m * DM) + F.lane;
#pragma unroll
        for (int j = 0; j < 4; ++j) { const int col = F.lane * 4 + 256 * j;
            const f32x4 g = *(const f32x4*)(P_GPRE + col), sh = *(const f32x4*)(mb + col), sc = *(const f32x4*)(mb + 1024 + col);
            const f32x4 gs = g * (sc + 1.0f);
            const f32x4 o0 = v[0][j] * rstd0 * gs + sh, o1 = v[1][j] * rstd1 * gs + sh;
            o8[64 * j] = (unsigned long long)pg8::cvt_pk_bf16(o0.x, o0.y) | ((unsigned long long)pg8::cvt_pk_bf16(o0.z, o0.w) << 32);
            o8[256 + 64 * j] = (unsigned long long)pg8::cvt_pk_bf16(o1.x, o1.y) | ((unsigned long long)pg8::cvt_pk_bf16(o1.z, o1.w) << 32); }
    }
}

__device__ __forceinline__ void p5_final(Frame& F, const Args& args) {
    const int gw = F.vcu * NWAVES + F.wave, NGW = F.G * NWAVES;
    for (int m = 2 * gw; m < MROWS; m += 2 * NGW) {
        const int b = m >> 11;
        const GAS v2u* mr = (const GAS v2u*)(W_MIX + (size_t)m * DM) + F.lane;
        const GAS f32x4* xr = (const GAS f32x4*)(P_X + (size_t)m * DM) + F.lane;
        GAS f32x4* orow = (GAS f32x4*)(P_OUT + (size_t)m * DM) + F.lane;
        v2u w[2][4]; f32x4 xv[2][4];
#pragma unroll
        for (int q = 0; q < 2; ++q)
#pragma unroll
            for (int j = 0; j < 4; ++j) { w[q][j] = mr[q * 256 + 64 * j]; xv[q][j] = xr[q * 256 + 64 * j]; }
        f32x4 v[2][4]; float ss[2] = {0.f, 0.f};
#pragma unroll
        for (int q = 0; q < 2; ++q)
#pragma unroll
            for (int j = 0; j < 4; ++j) { v[q][j].x = bflo(w[q][j].x); v[q][j].y = bfhi(w[q][j].x); v[q][j].z = bflo(w[q][j].y); v[q][j].w = bfhi(w[q][j].y);
                ss[q] += (v[q][j].x * v[q][j].x + v[q][j].y * v[q][j].y) + (v[q][j].z * v[q][j].z + v[q][j].w * v[q][j].w); }
        const float rstd0 = rsqf_(wave_sum(ss[0]) * (1.0f / DM) + EPSF), rstd1 = rsqf_(wave_sum(ss[1]) * (1.0f / DM) + EPSF);
        const float* gt = W_MOD + b * 3072 + 2048;
#pragma unroll
        for (int j = 0; j < 4; ++j) { const int col = F.lane * 4 + 256 * j;
            const f32x4 g = *(const f32x4*)(P_GPOST + col), ga = *(const f32x4*)(gt + col);
            const f32x4 gg = g * ga;
            orow[64 * j] = xv[0][j] + gg * (v[0][j] * rstd0);
            orow[256 + 64 * j] = xv[1][j] + gg * (v[1][j] * rstd1); }
    }
}

__device__ __forceinline__ unsigned cvtpk(float lo, float hi) { return pg8::cvt_pk_bf16(lo, hi); }
__device__ __forceinline__ v2u pack4(float a, float b, float c, float d) { v2u r; r.x = cvtpk(a, b); r.y = cvtpk(c, d); return r; }
__device__ __forceinline__ bf16x8 pack8(float a, float b, float c, float d, float e, float f, float g, float h) { v4u r; r.x = cvtpk(a, b); r.y = cvtpk(c, d); r.z = cvtpk(e, f); r.w = cvtpk(g, h); return __builtin_bit_cast(bf16x8, r); }
__device__ __forceinline__ bf16x8 lds16(const LAS unsigned char* p) { return *(const LAS bf16x8*)p; }
__device__ __forceinline__ bf16x8 lds8x2(const LAS unsigned char* p) { const v2u lo = *(const LAS v2u*)p, hi = *(const LAS v2u*)(p + 16); v4u r; r.x = lo.x; r.y = lo.y; r.z = hi.x; r.w = hi.y; return __builtin_bit_cast(bf16x8, r); }
template <int S> __device__ __forceinline__ bf16x8 acc_frag(const f32x16& a) { return pack8(a[8 * S + 0], a[8 * S + 1], a[8 * S + 2], a[8 * S + 3], a[8 * S + 4], a[8 * S + 5], a[8 * S + 6], a[8 * S + 7]); }

__device__ __forceinline__ float row16_sum(float v) {
#define R16_STEP(ctrl) v += __builtin_bit_cast(float, __builtin_amdgcn_update_dpp(0, __builtin_bit_cast(int, v), ctrl, 0xf, 0xf, false))
    R16_STEP(0x121); R16_STEP(0x122); R16_STEP(0x124); R16_STEP(0x128);
#undef R16_STEP
    return v;
}

__device__ __forceinline__ void gdn_unit(Frame& F, const Args& args, const int b, const int h) {
    LAS unsigned char* const L = F.lds;
    const int tid = F.tid, lane = F.lane, wv = F.wave, l31_0 = lane & 31, hh_0 = lane >> 5;
    int tidv = tid, lanev = lane;
    constexpr int P128 = 272, P64 = 144;
    constexpr int O_KH = 0, O_QH = O_KH + 17408, O_KGT = O_QH + 17408, O_VBT = O_KGT + 18432, O_KBGT = O_VBT + 18432, O_LM = O_KBGT + 18432, O_T = O_LM + 17408,
                  O_AT = O_T + 17408, O_CW = O_AT + 9216, O_SM = O_CW + 6144, O_PSO = O_SM + 2560, O_OF = O_PSO + 2048, O_END = O_OF + 17408;
    static_assert(O_END <= SCRATCH_BYTES, "gdn LDS map");
    constexpr int O_W = O_LM, O_VNT = O_VBT;
    LAS float* const SMb = (LAS float*)(L + O_SM);
    LAS float* const LM = (LAS float*)(L + O_LM);
    LAS float* const TT = (LAS float*)(L + O_T);
    LAS float* const CW = (LAS float*)(L + O_CW);
    LAS float* const PSO = (LAS float*)(L + O_PSO);
    const int mt = wv >> 2, nt = wv & 3;
    f32x16 S[4];
#pragma unroll
    for (int k = 0; k < 4; ++k)
#pragma unroll
        for (int r = 0; r < 16; ++r) S[k][r] = 0.f;
    const float alog_e = __expf(P_ALOG[h]), dtb = P_DTB[h];
#define GDN_GATES(n_) do { LAS float* _sm = SMb + ((n_) & 1) * 320; const float* _ap = W_AUX + (size_t)(b * SEQ + (n_) * 64 + lanev) * 16; \
        const float _bb = _ap[h], _aa = _ap[4 + h]; const float _beta = rcpf_(1.0f + __expf(-_bb)); const float _xs = _aa + dtb; \
        const float _sp = _xs > 20.f ? _xs : log1pf(__expf(_xs)); float _gc = -alog_e * _sp; \
        _Pragma("unroll") for (int _o = 1; _o < 64; _o <<= 1) { const float _t = __shfl_up(_gc, _o); if (lanev >= _o) _gc += _t; } \
        const float _gl = __shfl(_gc, 63); _sm[lanev] = _gc; _sm[64 + lanev] = _beta; _sm[128 + lanev] = __expf(_gc); _sm[192 + lanev] = __expf(_gl - _gc); \
        if (lanev == 0) _sm[256] = __expf(_gl); } while (0)
    if (wv == 6) GDN_GATES(0);
    for (int e = tidv; e < 3 * 4 * 128; e += NWAVES * 64) { const int ts_ = e >> 9, tap = (e >> 7) & 3, ch = e & 127; CW[e] = P_CONVW[tap * 1536 + ts_ * 512 + h * 128 + ch]; }
    const int ts = tid >> 8;
    int cgv = tid & 15, tpv = (tid >> 4) & 15;
#define GDN_ROWS(dst_, n_, chan_) do { const bf16* _src = W_PROJ + (size_t)(b * SEQ + (n_) * 64 + 4 * tpv - 3) * NPROJ + (chan_); \
        _Pragma("unroll") for (int _i = 0; _i < 7; ++_i) { v4u _z; _z.x = 0u; _z.y = 0u; _z.z = 0u; _z.w = 0u; dst_[_i] = _z; \
            if ((n_) > 0 || 4 * tpv - 3 + _i >= 0) dst_[_i] = *(const GAS v4u*)(_src + (size_t)_i * NPROJ); } } while (0)
#define GDN_OUT(rowb_) do { const int _tok = tidv >> 3, _dv0 = (tidv & 7) * 16; const size_t _row = (size_t)(rowb_) + _tok; \
        const LAS v4u* _op = (const LAS v4u*)(L + O_OF + _tok * P128 + _dv0 * 2); const v4u _o0 = _op[0], _o1 = _op[1]; \
        const LAS f32x4* _pp = (const LAS f32x4*)(PSO + _tok * 8); const f32x4 _a = _pp[0], _c = _pp[1]; \
        const float _rstd = rsqf_((((_a.x + _a.y) + (_a.z + _a.w)) + ((_c.x + _c.y) + (_c.z + _c.w))) * (1.0f / 128.0f) + EPSF); \
        const bf16* _zp = W_PROJ + _row * NPROJ + C_ZA + h * 128 + _dv0; const v4u _z0 = *(const GAS v4u*)_zp, _z1 = *(const GAS v4u*)(_zp + 8); \
        const unsigned _ow[8] = {_o0.x, _o0.y, _o0.z, _o0.w, _o1.x, _o1.y, _o1.z, _o1.w}, _zw[8] = {_z0.x, _z0.y, _z0.z, _z0.w, _z1.x, _z1.y, _z1.z, _z1.w}; unsigned _rw[8]; \
        _Pragma("unroll") for (int _k = 0; _k < 4; ++_k) { const f32x4 _g = *(const f32x4*)(P_GGDN + _dv0 + 4 * _k); \
            _rw[2 * _k] = cvtpk(bflo(_ow[2 * _k]) * _rstd * _g.x * siluf(bflo(_zw[2 * _k])), bfhi(_ow[2 * _k]) * _rstd * _g.y * siluf(bfhi(_zw[2 * _k]))); \
            _rw[2 * _k + 1] = cvtpk(bflo(_ow[2 * _k + 1]) * _rstd * _g.z * siluf(bflo(_zw[2 * _k + 1])), bfhi(_ow[2 * _k + 1]) * _rstd * _g.w * siluf(bfhi(_zw[2 * _k + 1]))); } \
        bf16* _dst = W_OAB + _row * DM + h * 128 + _dv0; v4u _w0, _w1; _w0.x = _rw[0]; _w0.y = _rw[1]; _w0.z = _rw[2]; _w0.w = _rw[3]; _w1.x = _rw[4]; _w1.y = _rw[5]; _w1.z = _rw[6]; _w1.w = _rw[7]; \
        *(GAS v4u*)_dst = _w0; *(GAS v4u*)(_dst + 8) = _w1; } while (0)
    __syncthreads();

    unsigned pf_sink = 0u;
    for (int n = 0; n < 32; ++n) {
        const int rowbase = b * SEQ + n * 64;
        LAS float* const SMf = SMb + (n & 1) * 320;
        tidv = tid; lanev = lane; cgv = tid & 15; tpv = (tid >> 4) & 15;
        asm volatile("" : "+v"(tidv), "+v"(lanev), "+v"(cgv), "+v"(tpv));
        int l31 = lanev & 31, hh = lanev >> 5, cg = cgv, tp = tpv;
        if (wv == 6 && n + 1 < 32) GDN_GATES(n + 1);
        float val[4][8];
#define GDN_CONV(rows_, tsel_) do { \
            _Pragma("unroll") for (int _j = 0; _j < 4; ++_j) _Pragma("unroll") for (int _e = 0; _e < 8; ++_e) val[_j][_e] = 0.f; \
            _Pragma("unroll") for (int _tap = 0; _tap < 4; ++_tap) { const LAS f32x4* _cp = (const LAS f32x4*)(CW + ((tsel_) * 4 + _tap) * 128 + cg * 8); const f32x4 _c0 = _cp[0], _c1 = _cp[1]; \
                const float _cw[8] = {_c0.x, _c0.y, _c0.z, _c0.w, _c1.x, _c1.y, _c1.z, _c1.w}; \
                _Pragma("unroll") for (int _j = 0; _j < 4; ++_j) { const v4u _raw = rows_[_j + _tap]; \
                    const float _in[8] = {bflo(_raw.x), bfhi(_raw.x), bflo(_raw.y), bfhi(_raw.y), bflo(_raw.z), bfhi(_raw.z), bflo(_raw.w), bfhi(_raw.w)}; \
                    _Pragma("unroll") for (int _e = 0; _e < 8; ++_e) val[_j][_e] += _in[_e] * _cw[_e]; } } \
            _Pragma("unroll") for (int _j = 0; _j < 4; ++_j) _Pragma("unroll") for (int _e = 0; _e < 8; ++_e) val[_j][_e] = siluf(val[_j][_e]); } while (0)
        v4u rq[7], rv[7];
        GDN_ROWS(rq, n, ts * 512 + h * 128 + cgv * 8);
        if (wv < 4) GDN_ROWS(rv, n, 1024 + h * 128 + cgv * 8);
        if (wv == 7 && n + 1 < 32) {
#pragma unroll
            for (int i = 0; i < 9; ++i) { const int idx = i * 64 + lanev; const int rr = idx >> 3, ln = idx & 7;
                if (idx < 67 * 8) { const bf16* pt = W_PROJ + (size_t)(rowbase + 61 + rr) * NPROJ + (ln >> 1) * 512 + h * 128 + (ln & 1) * 64;
                    asm volatile("global_load_dword %0, %1, off" : "+v"(pf_sink) : "v"(pt) : "memory"); } }
        }
        {
            GDN_CONV(rq, ts);
#pragma unroll
            for (int j = 0; j < 4; ++j) { float ss = 0.f;
#pragma unroll
                for (int e = 0; e < 8; ++e) ss += val[j][e] * val[j][e];
                ss = row16_sum(ss);
                float r = rsqf_(ss + EPSF); if (ts == 0) r *= 0.08838834764831845f;
#pragma unroll
                for (int e = 0; e < 8; ++e) val[j][e] *= r; }
            if (ts == 0) {
#pragma unroll
                for (int j = 0; j < 4; ++j) *(LAS bf16x8*)(L + O_QH + (4 * tp + j) * P128 + cg * 16) = pack8(val[j][0], val[j][1], val[j][2], val[j][3], val[j][4], val[j][5], val[j][6], val[j][7]);
            } else {
                float ek[4], bg[4];
#pragma unroll
                for (int j = 0; j < 4; ++j) { ek[j] = SMf[192 + 4 * tp + j]; bg[j] = SMf[64 + 4 * tp + j] * SMf[128 + 4 * tp + j]; }
#pragma unroll
                for (int j = 0; j < 4; ++j) *(LAS bf16x8*)(L + O_KH + (4 * tp + j) * P128 + cg * 16) = pack8(val[j][0], val[j][1], val[j][2], val[j][3], val[j][4], val[j][5], val[j][6], val[j][7]);
#pragma unroll
                for (int e = 0; e < 8; ++e) {
                    *(LAS v2u*)(L + O_KGT + (cg * 8 + e) * P64 + tp * 8) = pack4(val[0][e] * ek[0], val[1][e] * ek[1], val[2][e] * ek[2], val[3][e] * ek[3]);
                    *(LAS v2u*)(L + O_KBGT + (cg * 8 + e) * P64 + tp * 8) = pack4(val[0][e] * bg[0], val[1][e] * bg[1], val[2][e] * bg[2], val[3][e] * bg[3]); }
            }
        }
        if (n > 0) GDN_OUT(rowbase - 64);
        if (wv < 4) {
            GDN_CONV(rv, 2);
            float be[4];
#pragma unroll
            for (int j = 0; j < 4; ++j) be[j] = SMf[64 + 4 * tp + j];
#pragma unroll
            for (int e = 0; e < 8; ++e) *(LAS v2u*)(L + O_VBT + (cg * 8 + e) * P64 + tp * 8) = pack4(val[0][e] * be[0], val[1][e] * be[1], val[2][e] * be[2], val[3][e] * be[3]);
        }
        for (int e = tidv; e < 64 * 68; e += NWAVES * 64) TT[e] = 0.f;
        __syncthreads();
        if (wv < 4) {
            const int ti = wv >> 1, tj = wv & 1;
            f32x16 C;
#pragma unroll
            for (int r = 0; r < 16; ++r) C[r] = 0.f;
            if (ti >= tj) {
#pragma unroll
                for (int s = 0; s < 8; ++s) C = MFMA32(lds16(L + O_KH + (32 * ti + l31) * P128 + (16 * s + 8 * hh) * 2), lds16(L + O_KH + (32 * tj + l31) * P128 + (16 * s + 8 * hh) * 2), C);
            }
            const int j = 32 * tj + l31; const float gcj = SMf[j];
#pragma unroll
            for (int g = 0; g < 4; ++g) { const int ib = 32 * ti + 8 * g + 4 * hh; const f32x4 gci = *(const LAS f32x4*)(SMf + ib), bei = *(const LAS f32x4*)(SMf + 64 + ib);
#pragma unroll
                for (int e = 0; e < 4; ++e) { const int i = ib + e; LM[i * 68 + j] = (i > j) ? bei[e] * C[4 * g + e] * __expf(gci[e] - gcj) : 0.f; } }
            if (ti == tj) {
                asm volatile("s_waitcnt lgkmcnt(0)" ::: "memory");
                const int a = 2 * ti, bq = 2 * ti + 1;
                if (lanev < 32) {
                    const int blk = a + (lanev >> 4), c = lanev & 15; float x[16];
    #pragma unroll
                    for (int i = 0; i < 16; ++i) { const LAS float* lr = LM + (16 * blk + i) * 68 + 16 * blk; float acc = (i == c) ? 1.f : 0.f;
    #pragma unroll
                        for (int j = 0; j < i; ++j) acc -= lr[j] * x[j];
                        x[i] = acc; TT[(16 * blk + i) * 68 + 16 * blk + c] = acc; }
                }
                asm volatile("s_waitcnt lgkmcnt(0)" ::: "memory");
                const int m = lanev & 15, q = lanev >> 4;
                f32x4 P = {0.f, 0.f, 0.f, 0.f}, R = {0.f, 0.f, 0.f, 0.f};
    #pragma unroll
                for (int s = 0; s < 4; ++s) { const int k = q + 4 * s; P = MFMA16F(LM[(16 * bq + m) * 68 + 16 * a + k], TT[(16 * a + k) * 68 + 16 * a + m], P); }
    #pragma unroll
                for (int rg = 0; rg < 4; ++rg) { const int k = 4 * q + rg; R = MFMA16F(TT[(16 * bq + m) * 68 + 16 * bq + k], P[rg], R); }
    #pragma unroll
                for (int rg = 0; rg < 4; ++rg) TT[(16 * bq + 4 * q + rg) * 68 + 16 * a + m] = -R[rg];
            }
        } else {
            const int w4 = wv - 4, tj = w4 >> 1, ti = w4 & 1;
            f32x16 C;
#pragma unroll
            for (int r = 0; r < 16; ++r) C[r] = 0.f;
            if (ti >= tj) {
#pragma unroll
                for (int s = 0; s < 8; ++s) C = MFMA32(lds16(L + O_KH + (32 * tj + l31) * P128 + (16 * s + 8 * hh) * 2), lds16(L + O_QH + (32 * ti + l31) * P128 + (16 * s + 8 * hh) * 2), C);
            }
            const int i = 32 * ti + l31; const float gci = SMf[i];
#pragma unroll
            for (int g = 0; g < 4; ++g) { const int jb = 32 * tj + 8 * g + 4 * hh; const f32x4 gcj = *(const LAS f32x4*)(SMf + jb); float v[4];
#pragma unroll
                for (int e = 0; e < 4; ++e) v[e] = (i >= jb + e) ? C[4 * g + e] * __expf(gci - gcj[e]) : 0.f;
                *(LAS v2u*)(L + O_AT + i * P64 + jb * 2) = pack4(v[0], v[1], v[2], v[3]); }
        }
        __syncthreads();
        if (wv < 4) {
            const int m = lanev & 15, q = lanev >> 4, mi = wv >> 1, ni = wv & 1;
            f32x4 P0 = {0.f, 0.f, 0.f, 0.f}, P1 = {0.f, 0.f, 0.f, 0.f}, R = {0.f, 0.f, 0.f, 0.f};
#pragma unroll
            for (int s = 0; s < 8; ++s) { const int k = q + 4 * s; const float bt = TT[k * 68 + 16 * ni + m];
                P0 = MFMA16F(LM[(32 + m) * 68 + k], bt, P0); P1 = MFMA16F(LM[(48 + m) * 68 + k], bt, P1); }
#pragma unroll
            for (int rg = 0; rg < 4; ++rg) { R = MFMA16F(TT[(32 + 16 * mi + m) * 68 + 32 + 4 * q + rg], P0[rg], R); R = MFMA16F(TT[(32 + 16 * mi + m) * 68 + 48 + 4 * q + rg], P1[rg], R); }
#pragma unroll
            for (int rg = 0; rg < 4; ++rg) TT[(32 + 16 * mi + 4 * q + rg) * 68 + 16 * ni + m] = -R[rg];
        }
        __syncthreads();
        f32x16 U, WT_;
#pragma unroll
        for (int r = 0; r < 16; ++r) { U[r] = 0.f; WT_[r] = 0.f; }
#pragma unroll
        for (int s = 0; s < 4; ++s) { const LAS f32x4* tp4 = (const LAS f32x4*)(TT + (32 * mt + l31) * 68 + 16 * s + 8 * hh); const f32x4 t0 = tp4[0], t1 = tp4[1];
            const bf16x8 a = pack8(t0.x, t0.y, t0.z, t0.w, t1.x, t1.y, t1.z, t1.w);
            U = MFMA32(a, lds16(L + O_VBT + (32 * nt + l31) * P64 + (16 * s + 8 * hh) * 2), U);
            WT_ = MFMA32(lds16(L + O_KBGT + (32 * nt + l31) * P64 + (16 * s + 8 * hh) * 2), a, WT_); }
#pragma unroll
        for (int g = 0; g < 4; ++g) *(LAS v2u*)(L + O_W + (32 * mt + l31) * P128 + (32 * nt + 8 * g + 4 * hh) * 2) = pack4(-WT_[4 * g], -WT_[4 * g + 1], -WT_[4 * g + 2], -WT_[4 * g + 3]);
        __syncthreads();
        bf16x8 sf[4][2];
#pragma unroll
        for (int kt = 0; kt < 4; ++kt) { sf[kt][0] = acc_frag<0>(S[kt]); sf[kt][1] = acc_frag<1>(S[kt]); }
#pragma unroll
        for (int kt = 0; kt < 4; ++kt)
#pragma unroll
            for (int s = 0; s < 2; ++s) U = MFMA32(lds8x2(L + O_W + (32 * mt + l31) * P128 + (32 * kt + 16 * s + 4 * hh) * 2), sf[kt][s], U);
#pragma unroll
        for (int g = 0; g < 4; ++g) *(LAS v2u*)(L + O_VNT + (32 * nt + l31) * P64 + (32 * mt + 8 * g + 4 * hh) * 2) = pack4(U[4 * g], U[4 * g + 1], U[4 * g + 2], U[4 * g + 3]);
        __syncthreads();
        {
            f32x16 Oa;
#pragma unroll
            for (int r = 0; r < 16; ++r) Oa[r] = 0.f;
#pragma unroll
            for (int kt = 0; kt < 4; ++kt)
#pragma unroll
                for (int s = 0; s < 2; ++s) Oa = MFMA32(lds8x2(L + O_QH + (32 * mt + l31) * P128 + (32 * kt + 16 * s + 4 * hh) * 2), sf[kt][s], Oa);
#pragma unroll
            for (int g = 0; g < 4; ++g) { const f32x4 e4 = *(const LAS f32x4*)(SMf + 128 + 32 * mt + 8 * g + 4 * hh);
#pragma unroll
                for (int e = 0; e < 4; ++e) Oa[4 * g + e] *= e4[e]; }
            bf16x8 vn[4];
#pragma unroll
            for (int s = 0; s < 4; ++s) vn[s] = lds16(L + O_VNT + (32 * nt + l31) * P64 + (16 * s + 8 * hh) * 2);
#pragma unroll
            for (int s = 0; s < 4; ++s) Oa = MFMA32(lds16(L + O_AT + (32 * mt + l31) * P64 + (16 * s + 8 * hh) * 2), vn[s], Oa);
            const float glast = SMf[256];
#pragma unroll
            for (int kt = 0; kt < 4; ++kt) {
#pragma unroll
                for (int r = 0; r < 16; ++r) S[kt][r] *= glast;
#pragma unroll
                for (int s = 0; s < 4; ++s) S[kt] = MFMA32(lds16(L + O_KGT + (32 * kt + l31) * P64 + (16 * s + 8 * hh) * 2), vn[s], S[kt]);
            }
#pragma unroll
            for (int r = 0; r < 16; ++r) { const float q2 = row16_sum(Oa[r] * Oa[r]);
                if ((lanev & 15) == 0) PSO[(32 * mt + 8 * (r >> 2) + 4 * hh + (r & 3)) * 8 + 2 * nt + ((lanev >> 4) & 1)] = q2;
                *(LAS unsigned short*)(L + O_OF + (32 * mt + 8 * (r >> 2) + 4 * hh + (r & 3)) * P128 + (32 * nt + l31) * 2) = (unsigned short)cvtpk(Oa[r], 0.f); }
        }
        asm volatile("s_waitcnt vmcnt(0)" : "+v"(pf_sink) :: "memory");
        __syncthreads();
    }
    GDN_OUT(b * SEQ + 31 * 64);
    __syncthreads();
#undef GDN_GATES
#undef GDN_CONV
#undef GDN_ROWS
#undef GDN_OUT
}

template <int NREG>
__device__ __forceinline__ void dsa_select(const float* const scw, LAS unsigned* const MASK, const int wv, const int lane, const int t0, const int nk) {
    const float NINF = -__builtin_inff();
    const unsigned long long lt_mask = (1ull << lane) - 1ull;
    float xn[NREG];
#pragma unroll
    for (int i = 0; i < NREG; ++i) xn[i] = __hip_atomic_load(scw + i * 64 + lane, __ATOMIC_RELAXED, __HIP_MEMORY_SCOPE_AGENT);
#pragma unroll 1
    for (int ql_ = 0; ql_ < 8; ++ql_) {
        const int ql = ql_ & 7;
        const int tq = t0 + 8 * wv + ql;
        LAS unsigned* const mrow = MASK + (8 * wv + ql) * 64;
        float x[NREG];
#pragma unroll
        for (int i = 0; i < NREG; ++i) x[i] = (i * 64 + lane < nk) ? xn[i] : NINF;
        if (ql_ + 1 < 8) {
#pragma unroll
            for (int i = 0; i < NREG; ++i) xn[i] = __hip_atomic_load(scw + ((ql_ + 1) & 7) * 2048 + i * 64 + lane, __ATOMIC_RELAXED, __HIP_MEMORY_SCOPE_AGENT);
        }
        if (tq + 1 > 256) {
            float vmin = __builtin_inff(), vmax = NINF;
#pragma unroll
            for (int i = 0; i < NREG; ++i) { vmax = fmaxf(vmax, x[i]); vmin = fminf(vmin, x[i] == NINF ? __builtin_inff() : x[i]); }
            vmin = -wave_max(-vmin); vmax = wave_max(vmax);
#define CNT_GE(p_, dst_) do { int _c0 = 0, _c1 = 0, _c2 = 0, _c3 = 0; const float _p = (p_); \
                _Pragma("unroll") for (int _i = 0; _i < NREG; _i += 4) \
                    asm volatile("v_cmp_le_f32_e64 s[90:91], %8, %4\n\tv_cmp_le_f32_e64 s[92:93], %8, %5\n\tv_cmp_le_f32_e64 s[94:95], %8, %6\n\tv_cmp_le_f32_e64 s[96:97], %8, %7\n\t" \
                                 "v_addc_co_u32_e64 %0, s[90:91], 0, %0, s[90:91]\n\tv_addc_co_u32_e64 %1, s[92:93], 0, %1, s[92:93]\n\tv_addc_co_u32_e64 %2, s[94:95], 0, %2, s[94:95]\n\tv_addc_co_u32_e64 %3, s[96:97], 0, %3, s[96:97]" \
                                 : "+v"(_c0), "+v"(_c1), "+v"(_c2), "+v"(_c3) : "v"(x[_i]), "v"(x[_i + 1]), "v"(x[_i + 2]), "v"(x[_i + 3]), "s"(_p) : "s90", "s91", "s92", "s93", "s94", "s95", "s96", "s97"); \
                dst_ = wave_sum_i((_c0 + _c1) + (_c2 + _c3)); } while (0)
            float lo = vmin, hi = vmax, thr; int chi; bool tie = false;
            CNT_GE(hi, chi);
            if (chi == 256) thr = hi;
            else if (chi > 256) { tie = true; lo = hi; chi = 0; hi = __builtin_inff(); }
            else {
#pragma unroll 1
                for (;;) {
                    const float mid = 0.5f * (lo + hi);
                    if (!(mid > lo && mid < hi)) { tie = true; break; }
                    int c; CNT_GE(mid, c);
                    if (c == 256) { thr = mid; break; }
                    if (c > 256) lo = mid; else { hi = mid; chi = c; }
                }
            }
#undef CNT_GE
            if (!tie) {
#pragma unroll
                for (int i = 0; i < NREG; ++i) { const unsigned long long bs = __ballot(x[i] >= thr);
                    if (lane == 0) { v2u w; w.x = (unsigned)bs; w.y = (unsigned)(bs >> 32); *(LAS v2u*)(mrow + 2 * i) = w; } }
            } else {
                const int need = 256 - chi; int before = 0;
#pragma unroll
                for (int i = 0; i < NREG; ++i) { const bool eq = (x[i] == lo); const unsigned long long be = __ballot(eq);
                    const int rank = before + __popcll(be & lt_mask); const bool sel = (x[i] >= hi) || (eq && rank < need); before += __popcll(be);
                    const unsigned long long bs = __ballot(sel);
                    if (lane == 0) { v2u w; w.x = (unsigned)bs; w.y = (unsigned)(bs >> 32); *(LAS v2u*)(mrow + 2 * i) = w; } }
            }
        } else {
#pragma unroll
            for (int i = 0; i < NREG; ++i) { const unsigned long long bs = __ballot(i * 64 + lane <= tq);
                if (lane == 0) { v2u w; w.x = (unsigned)bs; w.y = (unsigned)(bs >> 32); *(LAS v2u*)(mrow + 2 * i) = w; } }
        }
    }
}

__device__ __forceinline__ void dsa_unit(Frame& F, const Args& args, const int b, const int qb, const float mb2) {
    LAS unsigned char* const L = F.lds;
    const int tid = F.tid, lane = F.lane, wv = F.wave, l31_0 = lane & 31, hh_0 = lane >> 5;
    int l31 = l31_0, hh = hh_0;
    constexpr int PK = 272, PV = 144;
    constexpr int O_K0 = 0, O_V0 = 17408, BUFSZ = 35840, O_MASK = 2 * BUFSZ, O_RS = O_MASK + 16384, O_BT = O_RS + 8192, O_END = O_BT + 2048, O_OA = 0;
    static_assert(O_END <= SCRATCH_BYTES && 4 * 17408 <= 2 * BUFSZ, "dsa LDS map");
    const int t0 = 64 * qb, nk = 64 * (qb + 1);
    const size_t rb = (size_t)b * SEQ;
    LAS unsigned* const MASK = (LAS unsigned*)(L + O_MASK);
    LAS float* const RS = (LAS float*)(L + O_RS);
    LAS float* const BT = (LAS float*)(L + O_BT);
    const float NINF = -__builtin_inff();
    for (int key = tid; key < nk; key += NWAVES * 64) { const f32x4 s4 = *(const f32x4*)(W_KVSS + (rb + key) * 4); RS[key] = rsqf_(((s4.x + s4.y) + (s4.z + s4.w)) * (1.0f / 128.0f) + EPSF); }
    BT[tid] = P_RELB[T5_BUCKET[tid >> 2] * 4 + (tid & 3)] * LOG2E;
    float* const scw = W_SCR + (size_t)(blockIdx.x * NWAVES + wv) * 8 * 2048;
#pragma unroll 1
    for (int rep_a = 0; rep_a < (PROBE_DUP == 41 ? 2 : 1); ++rep_a) {
        bf16x8 aq[2][4]; f32x4 wts[2][4];
#pragma unroll
        for (int rt = 0; rt < 2; ++rt) {
            const bf16* p = W_PROJ + (rb + t0 + 8 * wv + 4 * rt + (l31 >> 3)) * NPROJ + C_IQ + (l31 & 7) * 64 + 8 * hh;
#pragma unroll
            for (int s = 0; s < 4; ++s) aq[rt][s] = *(const GAS bf16x8*)(p + 16 * s);
#pragma unroll
            for (int g = 0; g < 4; ++g) wts[rt][g] = *(const f32x4*)(W_AUX + (rb + t0 + 8 * wv + 4 * rt + g) * 16 + 8 + 4 * hh) * 0.5f;
        }
        constexpr int O_IK = 0, IKB = 9216, PIK = 144;
        v4u sti;
#define IK_GLOAD(kt_) sti = *(const GAS v4u*)(W_PROJ + (rb + 64 * (kt_) + (tid >> 3)) * NPROJ + C_IK + (tid & 7) * 8)
#define IK_SWRITE(buf_) *(LAS v4u*)(L + O_IK + (buf_) * IKB + (tid >> 3) * PIK + (tid & 7) * 16) = sti
        IK_GLOAD(0); IK_SWRITE(0);
        __syncthreads();
#pragma unroll 1
        for (int kt6 = 0; kt6 <= qb; ++kt6) {
          const int ibuf = kt6 & 1;
          if (kt6 < qb) IK_GLOAD(kt6 + 1);
#pragma unroll
          for (int st = 0; st < 2; ++st) {
            bf16x8 bk[4];
#pragma unroll
            for (int s = 0; s < 4; ++s) bk[s] = lds16(L + O_IK + ibuf * IKB + (32 * st + l31) * PIK + (16 * s + 8 * hh) * 2);
            const int kt = 2 * kt6 + st;
            const int key = 32 * kt + l31;
            f32x16 C0, C1;
#pragma unroll
            for (int r = 0; r < 16; ++r) { C0[r] = 0.f; C1[r] = 0.f; }
#pragma unroll
            for (int s = 0; s < 4; ++s) C0 = MFMA32(aq[0][s], bk[s], C0);
#pragma unroll
            for (int s = 0; s < 4; ++s) C1 = MFMA32(aq[1][s], bk[s], C1);
            float pp[2][4];
#pragma unroll
            for (int g = 0; g < 4; ++g) {
                float p0 = 0.f, p1 = 0.f;
#pragma unroll
                for (int e2 = 0; e2 < 4; ++e2) { const float w0 = wts[0][g][e2], w1 = wts[1][g][e2], x0 = C0[4 * g + e2], x1 = C1[4 * g + e2];
                    p0 = __builtin_fmaf(w0, x0, p0); p0 = __builtin_fmaf(w0, __builtin_fabsf(x0), p0); p1 = __builtin_fmaf(w1, x1, p1); p1 = __builtin_fmaf(w1, __builtin_fabsf(x1), p1); }
                pp[0][g] = p0; pp[1][g] = p1;
            }
            float snd[2][2], rcv[2][2];
#pragma unroll
            for (int rt = 0; rt < 2; ++rt)
#pragma unroll
                for (int g2 = 0; g2 < 2; ++g2) snd[rt][g2] = hh ? pp[rt][g2] : pp[rt][g2 + 2];
#pragma unroll
            for (int rt = 0; rt < 2; ++rt)
#pragma unroll
                for (int g2 = 0; g2 < 2; ++g2) rcv[rt][g2] = __shfl_xor(snd[rt][g2], 32);
#pragma unroll
            for (int rt = 0; rt < 2; ++rt)
#pragma unroll
                for (int g2 = 0; g2 < 2; ++g2) { const int ql = 4 * rt + g2 + 2 * hh; float p = (hh ? pp[rt][g2 + 2] : pp[rt][g2]) + rcv[rt][g2];
                    if (key > t0 + 8 * wv + ql) p = NINF;
                    scw[ql * 2048 + key] = p; }
          }
          if (kt6 < qb) IK_SWRITE(ibuf ^ 1);
          __syncthreads();
        }
#undef IK_GLOAD
#undef IK_SWRITE
    }
    __builtin_amdgcn_fence(__ATOMIC_SEQ_CST, "workgroup");
    asm volatile("s_waitcnt vmcnt(0)" ::: "memory");
    int lanev = lane; asm volatile("" : "+v"(lanev));
    if (qb < 8) dsa_select<8>(scw, MASK, wv, lanev, t0, nk);
    else if (qb < 16) dsa_select<16>(scw, MASK, wv, lanev, t0, nk);
    else if (qb < 24) dsa_select<24>(scw, MASK, wv, lanev, t0, nk);
    else dsa_select<32>(scw, MASK, wv, lanev, t0, nk);
    __syncthreads();
    const int qj = l31 >> 2, hd = l31 & 3;
    const int tql = t0 + 8 * wv + qj;
    bf16x8 qf[8]; float qn2 = 0.f;
    {
        const bf16* p = W_PROJ + (rb + tql) * NPROJ + C_QB + hd * 128 + 8 * hh; const float cs = 0.08838834764831845f * LOG2E;
#pragma unroll
        for (int s = 0; s < 8; ++s) { const v4u raw = *(const GAS v4u*)(p + 16 * s); const f32x4 g0 = *(const f32x4*)(P_GKV + 16 * s + 8 * hh), g1 = *(const f32x4*)(P_GKV + 16 * s + 8 * hh + 4);
            v4u o; o.x = cvtpk(bflo(raw.x) * g0.x * cs, bfhi(raw.x) * g0.y * cs); o.y = cvtpk(bflo(raw.y) * g0.z * cs, bfhi(raw.y) * g0.w * cs);
            o.z = cvtpk(bflo(raw.z) * g1.x * cs, bfhi(raw.z) * g1.y * cs); o.w = cvtpk(bflo(raw.w) * g1.z * cs, bfhi(raw.w) * g1.w * cs);
            qn2 += (bflo(o.x) * bflo(o.x) + bfhi(o.x) * bfhi(o.x)) + (bflo(o.y) * bflo(o.y) + bfhi(o.y) * bfhi(o.y)) + (bflo(o.z) * bflo(o.z) + bfhi(o.z) * bfhi(o.z)) + (bflo(o.w) * bflo(o.w) + bfhi(o.w) * bfhi(o.w));
            qf[s] = __builtin_bit_cast(bf16x8, o); }
    }
    qn2 += __shfl_xor(qn2, 32);
    const float c0 = -(sqrtf(qn2) * 11.313708499f * 1.01f + mb2 + 1.0f);
    const float cfar = BT[127 * 4 + hd] + c0;
    f32x16 oacc[4];
#pragma unroll
    for (int d = 0; d < 4; ++d)
#pragma unroll
        for (int r = 0; r < 16; ++r) oacc[d][r] = 0.f;
    float lsum = 0.f;
    v4u st0, st1;
#define DSA_GLOAD(kt) do { const bf16* _p = W_PROJ + (rb + 64 * (kt) + lane) * NPROJ + C_CKV + wv * 16; st0 = *(const GAS v4u*)_p; st1 = *(const GAS v4u*)(_p + 8); } while (0)
#define DSA_SWRITE(buf, ktt) do { LAS unsigned char* _kb = L + (buf) * BUFSZ; const float _r = RS[64 * (ktt) + lane]; \
        v4u _n0, _n1; _n0.x = cvtpk(bflo(st0.x) * _r, bfhi(st0.x) * _r); _n0.y = cvtpk(bflo(st0.y) * _r, bfhi(st0.y) * _r); _n0.z = cvtpk(bflo(st0.z) * _r, bfhi(st0.z) * _r); _n0.w = cvtpk(bflo(st0.w) * _r, bfhi(st0.w) * _r); \
        _n1.x = cvtpk(bflo(st1.x) * _r, bfhi(st1.x) * _r); _n1.y = cvtpk(bflo(st1.y) * _r, bfhi(st1.y) * _r); _n1.z = cvtpk(bflo(st1.z) * _r, bfhi(st1.z) * _r); _n1.w = cvtpk(bflo(st1.w) * _r, bfhi(st1.w) * _r); \
        *(LAS v4u*)(_kb + O_K0 + lane * PK + wv * 32) = _n0; *(LAS v4u*)(_kb + O_K0 + lane * PK + wv * 32 + 16) = _n1; \
        LAS unsigned short* _vt = (LAS unsigned short*)(_kb + O_V0) + (wv * 16) * 72 + lane; \
        _vt[0 * 72] = (unsigned short)_n0.x; _vt[1 * 72] = (unsigned short)(_n0.x >> 16); _vt[2 * 72] = (unsigned short)_n0.y; _vt[3 * 72] = (unsigned short)(_n0.y >> 16); \
        _vt[4 * 72] = (unsigned short)_n0.z; _vt[5 * 72] = (unsigned short)(_n0.z >> 16); _vt[6 * 72] = (unsigned short)_n0.w; _vt[7 * 72] = (unsigned short)(_n0.w >> 16); \
        _vt[8 * 72] = (unsigned short)_n1.x; _vt[9 * 72] = (unsigned short)(_n1.x >> 16); _vt[10 * 72] = (unsigned short)_n1.y; _vt[11 * 72] = (unsigned short)(_n1.y >> 16); \
        _vt[12 * 72] = (unsigned short)_n1.z; _vt[13 * 72] = (unsigned short)(_n1.z >> 16); _vt[14 * 72] = (unsigned short)_n1.w; _vt[15 * 72] = (unsigned short)(_n1.w >> 16); } while (0)
    DSA_GLOAD(0); DSA_SWRITE(0, 0);
    __syncthreads();
    for (int kt = 0; kt <= qb; ++kt) {
        const int buf = kt & 1;
        l31 = l31_0; hh = hh_0; asm volatile("" : "+v"(l31), "+v"(hh));
        if (kt < qb) DSA_GLOAD(kt + 1);
        const LAS unsigned char* kb = L + buf * BUFSZ;
#pragma unroll
        for (int st = 0; st < 2; ++st) {
            f32x16 Sa;
#pragma unroll
            for (int r = 0; r < 16; ++r) Sa[r] = 0.f;
#pragma unroll
            for (int s = 0; s < 8; ++s) Sa = MFMA32(lds16(kb + O_K0 + (32 * st + l31) * PK + (16 * s + 8 * hh) * 2), qf[s], Sa);
            const int kbase = 64 * kt + 32 * st;
            const int mwi = (int)(MASK[(8 * wv + qj) * 64 + 2 * kt + st] >> (4 * hh));
            const bool far = (t0 + 8 * wv) - (kbase + 31) >= 113;
            float pn[16];
            if (far) {
#pragma unroll
                for (int r = 0; r < 16; ++r) { const float p = __builtin_bit_cast(float, __builtin_bit_cast(int, __builtin_amdgcn_exp2f(Sa[r] + cfar)) & __builtin_amdgcn_sbfe(mwi, 8 * (r >> 2) + (r & 3), 1));
                    lsum += p; pn[r] = p; }
            } else {
#pragma unroll
                for (int r = 0; r < 16; ++r) { int dist = tql - (kbase + 8 * (r >> 2) + 4 * hh + (r & 3)); dist = dist < 0 ? 0 : (dist > 127 ? 127 : dist);
                    const float p = __builtin_bit_cast(float, __builtin_bit_cast(int, __builtin_amdgcn_exp2f(Sa[r] + (BT[dist * 4 + hd] + c0))) & __builtin_amdgcn_sbfe(mwi, 8 * (r >> 2) + (r & 3), 1));
                    lsum += p; pn[r] = p; }
            }
            const bf16x8 pf0 = pack8(pn[0], pn[1], pn[2], pn[3], pn[4], pn[5], pn[6], pn[7]), pf1 = pack8(pn[8], pn[9], pn[10], pn[11], pn[12], pn[13], pn[14], pn[15]);
#pragma unroll
            for (int dt = 0; dt < 4; ++dt) { const LAS unsigned char* vp = kb + O_V0 + (32 * dt + l31) * PV + (32 * st + 4 * hh) * 2;
                oacc[dt] = MFMA32(lds8x2(vp), pf0, oacc[dt]); oacc[dt] = MFMA32(lds8x2(vp + 32), pf1, oacc[dt]); }
        }
        if (kt < qb) DSA_SWRITE(buf ^ 1, kt + 1);
        __syncthreads();
    }
#undef DSA_GLOAD
#undef DSA_SWRITE
    lsum += __shfl_xor(lsum, 32);
    {
        const float inv = rcpf_(lsum);
#pragma unroll
        for (int dt = 0; dt < 4; ++dt)
#pragma unroll
            for (int g = 0; g < 4; ++g) { const int d = 32 * dt + 8 * g + 4 * hh; const f32x4 gk = *(const f32x4*)(P_GKV + d);
                *(LAS v2u*)(L + O_OA + hd * 17408 + (8 * wv + qj) * PK + d * 2) = pack4(oacc[dt][4 * g] * inv * gk.x, oacc[dt][4 * g + 1] * inv * gk.y, oacc[dt][4 * g + 2] * inv * gk.z, oacc[dt][4 * g + 3] * inv * gk.w); }
    }
    __syncthreads();
    {
        const int hd2 = wv >> 1, mt2 = wv & 1;
        const size_t row = rb + t0 + 32 * mt2 + l31;
        bf16x8 of[8];
#pragma unroll
        for (int s = 0; s < 8; ++s) of[s] = lds16(L + O_OA + hd2 * 17408 + (32 * mt2 + l31) * PK + (16 * s + 8 * hh) * 2);
#pragma unroll 1
        for (int et = 0; et < 4; ++et) {
            v2u zw[4];
#pragma unroll
            for (int g = 0; g < 4; ++g) zw[g] = *(const GAS v2u*)(W_PROJ + row * NPROJ + C_ZB + hd2 * 128 + 32 * et + 8 * g + 4 * hh);
            f32x16 C;
#pragma unroll
            for (int r = 0; r < 16; ++r) C[r] = 0.f;
            const bf16* wp = W_WUVT + (size_t)hd2 * 16384 + (32 * et + l31) * 128 + 8 * hh;
#pragma unroll
            for (int s = 0; s < 8; ++s) C = MFMA32(*(const GAS bf16x8*)(wp + 16 * s), of[s], C);
#pragma unroll
            for (int g = 0; g < 4; ++g)
                *(GAS v2u*)(W_OAB + row * DM + 512 + hd2 * 128 + 32 * et + 8 * g + 4 * hh) =
                    pack4(C[4 * g] * siluf(bflo(zw[g].x)), C[4 * g + 1] * siluf(bfhi(zw[g].x)), C[4 * g + 2] * siluf(bflo(zw[g].y)), C[4 * g + 3] * siluf(bfhi(zw[g].y)));
        }
    }
    __syncthreads();
}

constexpr int N_GDN = NB * 4, N_DSA = NB * 32, N_ITEMS = N_GDN + N_DSA;
constexpr int N_PHASES = 6;
__global__ void __launch_bounds__(NWAVES * 64, 2) hyb_fwd(Args args) {
    extern __shared__ __attribute__((aligned(16))) unsigned char lds[];
    Frame F;
    F.lds = (LAS unsigned char*)lds;
    F.MISC = (volatile LAS unsigned*)(F.lds + MISC_OFF);
    F.tid = threadIdx.x; F.lane = F.tid & 63; F.wave = __builtin_amdgcn_readfirstlane(F.tid >> 6);
    F.G = gridDim.x; { const int bx = blockIdx.x; F.vcu = (F.G % 8 == 0) ? (bx % 8) * (F.G / 8) + bx / 8 : bx; }
    unsigned char* ws = args.ws;
    F.ctl = (gu32*)(ws + WS_CTL);
    F.ws = ws;
    for (int u = F.tid; u < 64; u += NWAVES * 64) F.MISC[u] = 0u;
    __syncthreads();
    const int lo = args.ph_lo, hi = args.ph_hi;
    const bool multi = (hi - lo) > 1;
    XcdBarrier bar; bar.bar = (unsigned*)(F.ctl + CW_BAR) + args.li * XCD_BAR_WORDS; bar.x = 0; bar.st = nullptr;
    if (multi) bar = xcd_barrier_post((unsigned*)(F.ctl + CW_BAR) + args.li * XCD_BAR_WORDS, F.MISC + 8);
#define IN(k) (lo <= (k) && (k) < hi)
#define BOTH(k) (IN(k) && IN((k) + 1))
    if (IN(0)) { p0_prologue(F, args); if (PROBE_DUP == 7) { __syncthreads(); p0_prologue(F, args); } if (BOTH(0)) xcd_barrier(bar); }
    if (IN(1)) { p1_norm(F, args); if (PROBE_DUP == 1) p1_norm(F, args); if (BOTH(1)) xcd_barrier(bar); }
    if (IN(2)) {
        pg8::Gemm g{W_XN, W_WINT, MROWS, NPROJ, DM}; pg8::StaticOrder S; S.init(MROWS, NPROJ, F.G, (int)blockIdx.x);
        pg8::EpiProj E{W_PROJ, W_AUX, W_KVSS};
        pg8::gemm_phase<pg8::EpiProj, pg8::StaticOrder, true, true>(F.lds, g, S, E);
        if (PROBE_DUP == 2) pg8::gemm_phase<pg8::EpiProj, pg8::StaticOrder, true, true>(F.lds, g, S, E);
        if (BOTH(2)) xcd_barrier(bar);
    }
    if (IN(3)) {
#define NEXT_ITEM(dst, qw) do { if (F.tid == 0) F.MISC[4] = __hip_atomic_fetch_add(F.ctl + (qw), 1u, RLX_AGENT); __syncthreads(); dst = (int)F.MISC[4]; __syncthreads(); } while (0)
        float mb2; { const int hd_ = F.lane & 3; float m_ = P_RELB[hd_]; for (int k = 1; k < 32; ++k) m_ = fmaxf(m_, P_RELB[k * 4 + hd_]); mb2 = m_ * LOG2E; }
        int item; NEXT_ITEM(item, CW_QUEUE);
#pragma unroll 1
        for (int pass = 0; pass < (PROBE_DUP == 3 ? 2 : 1); ++pass) {
            if (pass) NEXT_ITEM(item, CW_QUEUE + 64);
            while (item < N_GDN) { gdn_unit(F, args, item >> 2, item & 3); NEXT_ITEM(item, CW_QUEUE + 64 * pass); }
        }
#pragma unroll 1
        for (int pass = 0; pass < (PROBE_DUP == 4 ? 2 : 1); ++pass) {
            if (pass) NEXT_ITEM(item, CW_QUEUE + 128);
            while (item < N_ITEMS) { if (item >= N_GDN) { const int idx = item - N_GDN; dsa_unit(F, args, idx & 31, 31 - (idx >> 5), mb2); } NEXT_ITEM(item, pass ? CW_QUEUE + 128 : CW_QUEUE); }
        }
#undef NEXT_ITEM
        if (BOTH(3)) xcd_barrier(bar);
    }
    if (IN(4)) {
        pg8::Gemm g{W_OAB, W_WOUTT, MROWS, DM, DM}; pg8::StaticOrder S; S.init(MROWS, DM, F.G, (int)blockIdx.x);
        pg8::EpiMix E{W_MIX, DM};
        pg8::gemm_phase<pg8::EpiMix, pg8::StaticOrder, true, true>(F.lds, g, S, E);
        if (PROBE_DUP == 5) pg8::gemm_phase<pg8::EpiMix, pg8::StaticOrder, true, true>(F.lds, g, S, E);
        if (BOTH(4)) xcd_barrier(bar);
    }
    if (IN(5)) { p5_final(F, args); if (PROBE_DUP == 6) p5_final(F, args); }
#undef IN
#undef BOTH
}

extern "C" void kernel_launch(void* const* d_in, const int* in_sizes, int n_in, void* d_out, int out_size, void* d_ws, size_t ws_size, hipStream_t stream) {
    static int grid = 0;
    if (grid == 0) {
        if (n_in != 15 || in_sizes[0] != MROWS * DM || out_size != MROWS * DM || ws_size < WS_END) { fprintf(stderr, "kernel_launch: unexpected shapes (n_in %d, in0 %d, out %d, ws %zu); nothing launched\n", n_in, n_in > 0 ? in_sizes[0] : -1, out_size, ws_size); grid = -1; return; }
        int dev = 0, cus = 0, per_cu = 0;
        if (hipGetDevice(&dev) != hipSuccess || hipDeviceGetAttribute(&cus, hipDeviceAttributeMultiprocessorCount, dev) != hipSuccess) { fprintf(stderr, "kernel_launch: device query failed\n"); grid = -1; return; }
        if (hipFuncSetAttribute((const void*)hyb_fwd, hipFuncAttributeMaxDynamicSharedMemorySize, LDS_BYTES) != hipSuccess) { fprintf(stderr, "kernel_launch: hipFuncSetAttribute failed\n"); grid = -1; return; }
        if (hipOccupancyMaxActiveBlocksPerMultiprocessor(&per_cu, (const void*)hyb_fwd, NWAVES * 64, LDS_BYTES) != hipSuccess || per_cu < 1)
            fprintf(stderr, "kernel_launch: note: occupancy query reports %d workgroups per CU\n", per_cu);
        (void)hipGetLastError();
        grid = cus < 256 ? cus : 256;
    }
    if (grid < 0) return;
    if (hipMemsetAsync((char*)d_ws + WS_CTL, 0, CTL_ZERO_BYTES, stream) != hipSuccess) { fprintf(stderr, "kernel_launch: memset failed\n"); return; }
    Args a{};
    for (int i = 0; i < 15; ++i) a.in[i] = (const float*)d_in[i];
    a.out = (float*)d_out; a.ws = (unsigned char*)d_ws;
    constexpr int NL = MK_N_LAUNCHES;
    static_assert(NL == 1 || NL == 2 || NL == 3 || NL == N_PHASES, "MK_N_LAUNCHES");
    const int cuts1[2] = {0, 6}, cuts2[3] = {0, 3, 6}, cuts3[4] = {0, 3, 4, 6}, cuts6[7] = {0, 1, 2, 3, 4, 5, 6};
    const int* cuts = NL == 1 ? cuts1 : NL == 2 ? cuts2 : NL == 3 ? cuts3 : cuts6;
    for (int li = 0; li < NL; ++li) {
        a.ph_lo = cuts[li]; a.ph_hi = cuts[li + 1]; a.li = li;
        hipLaunchKernelGGL(hyb_fwd, dim3(grid), dim3(NWAVES * 64), LDS_BYTES, stream, a);
        const hipError_t le = hipPeekAtLastError();
        if (le != hipSuccess) { fprintf(stderr, "kernel_launch: launch %d failed: %s\n", li, hipGetErrorName(le)); break; }
    }
}
```

```cpp
#include <hip/hip_runtime.h>
#include <cstdio>
#include <cstdint>
#ifndef MK_N_LAUNCHES
#define MK_N_LAUNCHES 1
#endif
#ifndef PROBE_DUP
#define PROBE_DUP 0
#endif
namespace pg8 {
#define PG8_LAS __attribute__((address_space(3)))
typedef unsigned short bf16_t;
typedef short bf16x8 __attribute__((ext_vector_type(8)));
typedef float f32x4 __attribute__((ext_vector_type(4)));
typedef unsigned u32x4 __attribute__((ext_vector_type(4)));
constexpr int BM = 256, BK = 64, HALF = 128, HTB = HALF * BK * 2  , STAGE_BYTES = 8 * HTB, NXCD = 8, WGM = 8;

__host__ __device__ __forceinline__ int lds_byte(int r, int c) { const int st = (r >> 4) * 2 + (c >> 5), rr = r & 15, cc = c & 31, ob = rr * 64 + cc * 2; return st * 1024 + (ob ^ (((ob >> 9) & 1) << 5)); }
__host__ __device__ __forceinline__ void stage_rc(int b, int& R, int& C) { const int st = b / 1024, sb = b % 1024, swz = sb ^ (((sb >> 9) & 1) << 5); R = (st >> 1) * 16 + swz / 64; C = (st & 1) * 32 + (swz % 64) / 2; }
__host__ __device__ __forceinline__ int perm32(int rho) { const int n = rho >> 4, i = rho & 15; return 8 * (i >> 2) + 4 * n + (i & 3); }

struct Unit { int pm, pn; };
struct Gemm { const bf16_t* A; const bf16_t* Bt; int M, N, K; };

struct StaticOrder {
    int nM, nN, nwg, G, c;
    __host__ __device__ void init(int M, int N, int G_, int c_) { nM = M / BM; nN = N / BM; nwg = nM * nN; G = G_; c = c_; }
    __host__ __device__ bool next(int i, Unit& u) const {
        const long L = (long)i * G + c; if (L >= nwg) return false;
        int wgid = (int)L; { const int q = nwg / NXCD, r = nwg % NXCD, xcd = wgid % NXCD, off = wgid / NXCD; wgid = (xcd < r ? xcd * (q + 1) : r * (q + 1) + (xcd - r) * q) + off; }
        const int nig = WGM * nN, gid = wgid / nig, fm = gid * WGM, gsz = (nM - fm) < WGM ? (nM - fm) : WGM;
        u.pm = fm + ((wgid % nig) % gsz); u.pn = (wgid % nig) / gsz; return true;
    }
    __device__ __forceinline__ void a_ready(const Unit&) const {}
    __device__ __forceinline__ void done(const Unit&) const {}
};

typedef float f32x2c __attribute__((ext_vector_type(2))); typedef __bf16 b16x2c __attribute__((ext_vector_type(2)));
__device__ __forceinline__ unsigned cvt_pk_bf16(float lo, float hi) { const f32x2c v = {lo, hi}; return __builtin_bit_cast(unsigned, __builtin_convertvector(v, b16x2c)); }
struct EpiProj {
    static constexpr bool PERM = true, AFTER_DRAIN = false;
    bf16_t* O; float* aux; float* kvss;
    __device__ __forceinline__ void operator()(const f32x4 (&acc)[2][2][4][2], const Unit& u, int wr, int wc, int fr, int fq) const {
        const int row0 = u.pm * BM + wr * 64 + fr, col0 = u.pn * BM + wc * 32 + 8 * fq;
        const bool last = (u.pn == 14);
#pragma unroll
        for (int ai = 0; ai < 2; ++ai)
#pragma unroll
            for (int m = 0; m < 4; ++m) {
                const int row = row0 + ai * HALF + m * 16;
                bf16_t* rowp = O + (size_t)row * 3840 + col0;
#pragma unroll
                for (int bj = 0; bj < 2; ++bj) {
                    const f32x4 v0 = acc[ai][bj][m][0], v1 = acc[ai][bj][m][1];
                    u32x4 w; w.x = cvt_pk_bf16(v0[0], v0[1]); w.y = cvt_pk_bf16(v0[2], v0[3]); w.z = cvt_pk_bf16(v1[0], v1[1]); w.w = cvt_pk_bf16(v1[2], v1[3]);
                    *(u32x4*)(rowp + bj * HALF) = w;
                }
                if (last) {
                    const f32x4 a0 = acc[ai][0][m][0], a1 = acc[ai][0][m][1];
                    float ss = (a0[0] * a0[0] + a0[1] * a0[1]) + (a0[2] * a0[2] + a0[3] * a0[3]) + (a1[0] * a1[0] + a1[1] * a1[1]) + (a1[2] * a1[2] + a1[3] * a1[3]);
                    ss += __shfl_xor(ss, 16); ss += __shfl_xor(ss, 32);
                    if (fq == 0) kvss[(size_t)row * 4 + wc] = ss;
                    if (wc == 2 && fq < 2) { float* ap = aux + (size_t)row * 16 + 8 * fq; *(f32x4*)ap = acc[ai][1][m][0]; *(f32x4*)(ap + 4) = acc[ai][1][m][1]; }
                }
            }
    }
};
struct EpiF32 {
    static constexpr bool PERM = false, AFTER_DRAIN = false;
    float* C; int ldc;
    __device__ __forceinline__ void operator()(const f32x4 (&acc)[2][2][4][2], const Unit& u, int wr, int wc, int fr, int fq) const {
        const int row0 = u.pm * BM + wr * 64 + fr, col0 = u.pn * BM + wc * 32 + 4 * fq;
#pragma unroll
        for (int ai = 0; ai < 2; ++ai)
#pragma unroll
            for (int m = 0; m < 4; ++m) { float* rowp = C + (size_t)(row0 + ai * HALF + m * 16) * ldc + col0;
#pragma unroll
                for (int bj = 0; bj < 2; ++bj)
#pragma unroll
                    for (int n = 0; n < 2; ++n) *(f32x4*)(rowp + bj * HALF + n * 16) = acc[ai][bj][m][n]; }
    }
};
struct EpiMix {
    static constexpr bool PERM = true, AFTER_DRAIN = false;
    bf16_t* O; int ldc;
    __device__ __forceinline__ void operator()(const f32x4 (&acc)[2][2][4][2], const Unit& u, int wr, int wc, int fr, int fq) const {
        const int row0 = u.pm * BM + wr * 64 + fr, col0 = u.pn * BM + wc * 32 + 8 * fq;
#pragma unroll
        for (int ai = 0; ai < 2; ++ai)
#pragma unroll
            for (int m = 0; m < 4; ++m) { bf16_t* rowp = O + (size_t)(row0 + ai * HALF + m * 16) * ldc + col0;
#pragma unroll
                for (int bj = 0; bj < 2; ++bj) { const f32x4 v0 = acc[ai][bj][m][0], v1 = acc[ai][bj][m][1];
                    u32x4 w; w.x = cvt_pk_bf16(v0[0], v0[1]); w.y = cvt_pk_bf16(v0[2], v0[3]); w.z = cvt_pk_bf16(v1[0], v1[1]); w.w = cvt_pk_bf16(v1[2], v1[3]);
                    *(u32x4*)(rowp + bj * HALF) = w; } }
    }
};
template <class Epi, class Sched, bool ALIGN_EPI = false, bool SP2 = false>
__device__ __forceinline__ void gemm_phase(PG8_LAS unsigned char* lds, const Gemm g, const Sched& S, const Epi& E) {
    const int tid = threadIdx.x, wid = __builtin_amdgcn_readfirstlane(tid >> 6), lane = tid & 63, wr = wid >> 2, wc = wid & 3, fr = lane & 15, fq = lane >> 4;
    const int K = g.K, nt = K / BK;
    unsigned voffA[2], voffB[2];
#pragma unroll
    for (int i = 0; i < 2; ++i) { int R, C; stage_rc(tid * 16 + i * 8192, R, C); const int Rb = Epi::PERM ? ((R & ~31) + perm32(R & 31)) : R;
        voffA[i] = (unsigned)(R * K + C) * 2u; voffB[i] = (unsigned)(Rb * K + C) * 2u; }
    const size_t kstep = (size_t)(BK * 2);
    const size_t hstep = (size_t)HALF * K * 2;
    const size_t tstep = 2 * hstep;
    const unsigned ldsw = (unsigned)wid * 1024u;
    const int aoff = lds_byte(wr * 64 + fr, fq * 8), boff = lds_byte(wc * 32 + fr, fq * 8);
#define PG8_SA(b, h) (((b) * 2 + (h)) * HTB)
#define PG8_SB(b, h) ((4 + (b) * 2 + (h)) * HTB)
#define PG8_STAGE(bufoff, gbase, voff) do { _Pragma("unroll") for (int _i = 0; _i < 2; ++_i) \
        __builtin_amdgcn_global_load_lds((const unsigned*)((const char*)(gbase) + (voff)[_i]), (PG8_LAS unsigned*)(lds + (bufoff) + ldsw + _i * 8192), 16, 0, 0); } while (0)
#define PG8_LDA(dst, b, h) do { _Pragma("unroll") for (int m = 0; m < 4; ++m) _Pragma("unroll") for (int k = 0; k < 2; ++k) dst[m][k] = *(const PG8_LAS bf16x8*)(lds + PG8_SA(b, h) + aoff + m * 2048 + k * 1024); } while (0)
#define PG8_LDB(dst, b, h) do { _Pragma("unroll") for (int n = 0; n < 2; ++n) _Pragma("unroll") for (int k = 0; k < 2; ++k) dst[n][k] = *(const PG8_LAS bf16x8*)(lds + PG8_SB(b, h) + boff + n * 2048 + k * 1024); } while (0)
#define PG8_MMA(ai, bj, At, Bt) do { __builtin_amdgcn_s_setprio(1); _Pragma("unroll") for (int m = 0; m < 4; ++m) _Pragma("unroll") for (int n = 0; n < 2; ++n) _Pragma("unroll") for (int k = 0; k < 2; ++k) \
        acc[ai][bj][m][n] = __builtin_amdgcn_mfma_f32_16x16x32_bf16(Bt[n][k], At[m][k], acc[ai][bj][m][n], 0, 0, 0); __builtin_amdgcn_s_setprio(0); } while (0)
#define PG8_WAIT_V(n) asm volatile("s_waitcnt vmcnt(" #n ")" ::: "memory")
#define PG8_WAIT_L(n) asm volatile("s_waitcnt lgkmcnt(" #n ")" ::: "memory")
#define PG8_BAR __builtin_amdgcn_s_barrier()
#define PG8_SCHED __builtin_amdgcn_sched_barrier(0)
    Unit cur, nxt; int ui = 0;
    if (!S.next(0, cur)) return;
    f32x4 acc[2][2][4][2];
#pragma unroll
    for (int a = 0; a < 2; ++a)
#pragma unroll
        for (int b = 0; b < 2; ++b)
#pragma unroll
            for (int m = 0; m < 4; ++m)
#pragma unroll
                for (int n = 0; n < 2; ++n) acc[a][b][m][n] = (f32x4){0.f, 0.f, 0.f, 0.f};
    bf16x8 At[4][2], B0[2][2], B1[2][2];
    const char* cA = (const char*)g.A + (size_t)cur.pm * tstep; const char* cB = (const char*)g.Bt + (size_t)cur.pn * tstep;
    S.a_ready(cur);
    if constexpr (SP2) {
        PG8_STAGE(PG8_SB(0, 0), cB, voffB); PG8_STAGE(PG8_SB(0, 1), cB + hstep, voffB); PG8_STAGE(PG8_SA(0, 0), cA, voffA); PG8_STAGE(PG8_SA(0, 1), cA + hstep, voffA);
        if (wr == 1) PG8_BAR;
        PG8_WAIT_V(2); PG8_BAR;
        PG8_STAGE(PG8_SB(1, 0), cB + kstep, voffB); PG8_STAGE(PG8_SA(1, 0), cA + kstep, voffA); PG8_STAGE(PG8_SB(1, 1), cB + hstep + kstep, voffB);
        PG8_WAIT_V(6); PG8_BAR;
    } else {
        PG8_STAGE(PG8_SB(0, 0), cB, voffB); PG8_STAGE(PG8_SA(0, 0), cA, voffA); PG8_STAGE(PG8_SB(0, 1), cB + hstep, voffB); PG8_STAGE(PG8_SA(0, 1), cA + hstep, voffA);
        if (wr == 1) PG8_BAR;
        PG8_WAIT_V(4); PG8_BAR;
        PG8_STAGE(PG8_SB(1, 0), cB + kstep, voffB); PG8_STAGE(PG8_SA(1, 0), cA + kstep, voffA); PG8_STAGE(PG8_SB(1, 1), cB + hstep + kstep, voffB);
        PG8_WAIT_V(6); PG8_BAR;
    }
    for (;;) {
        const bool has_next = S.next(ui + 1, nxt);
        const char* nA = has_next ? (const char*)g.A + (size_t)nxt.pm * tstep : cA; const char* nB = has_next ? (const char*)g.Bt + (size_t)nxt.pn * tstep : cB;
        for (int t = 0; t < nt; t += 2) {
            const bool last = (t == nt - 2);
            const char* a1 = cA + (size_t)(t + 1) * kstep;
            const char* a2 = last ? nA : cA + (size_t)(t + 2) * kstep; const char* b2 = last ? nB : cB + (size_t)(t + 2) * kstep;
            const char* a3 = a2 + kstep; const char* b3 = b2 + kstep;
            if (last && has_next) S.a_ready(nxt);
            if constexpr (SP2) {
            PG8_LDB(B0, 0, 0); PG8_LDB(B1, 0, 1); PG8_SCHED; PG8_LDA(At, 0, 0); PG8_STAGE(PG8_SA(1, 1), a1 + hstep, voffA);
            PG8_WAIT_V(8); PG8_WAIT_L(0); PG8_BAR; PG8_MMA(0, 0, At, B0); PG8_MMA(0, 1, At, B1); PG8_BAR; PG8_SCHED;
            PG8_LDA(At, 0, 1); PG8_STAGE(PG8_SB(0, 0), b2, voffB); PG8_STAGE(PG8_SB(0, 1), b2 + hstep, voffB); PG8_STAGE(PG8_SA(0, 0), a2, voffA);
            PG8_WAIT_V(8); PG8_WAIT_L(0); PG8_BAR; PG8_MMA(1, 0, At, B0); PG8_MMA(1, 1, At, B1); PG8_BAR; PG8_SCHED;
            PG8_LDB(B0, 1, 0); PG8_LDB(B1, 1, 1); PG8_SCHED; PG8_LDA(At, 1, 0); PG8_STAGE(PG8_SA(0, 1), a2 + hstep, voffA);
            PG8_WAIT_V(8); PG8_WAIT_L(0); PG8_BAR; PG8_MMA(0, 0, At, B0); PG8_MMA(0, 1, At, B1); PG8_BAR; PG8_SCHED;
            PG8_LDA(At, 1, 1); PG8_STAGE(PG8_SB(1, 0), b3, voffB); PG8_STAGE(PG8_SB(1, 1), b3 + hstep, voffB); PG8_STAGE(PG8_SA(1, 0), a3, voffA);
            PG8_WAIT_V(8); PG8_WAIT_L(0); PG8_BAR; PG8_MMA(1, 0, At, B0); PG8_MMA(1, 1, At, B1); PG8_BAR; PG8_SCHED;
            } else {
            PG8_LDB(B0, 0, 0); PG8_SCHED; PG8_LDA(At, 0, 0); PG8_STAGE(PG8_SA(1, 1), a1 + hstep, voffA);
            PG8_WAIT_L(8); PG8_BAR; PG8_WAIT_L(0); PG8_MMA(0, 0, At, B0); PG8_BAR; PG8_SCHED;
            PG8_LDB(B1, 0, 1); PG8_STAGE(PG8_SB(0, 0), b2, voffB);
            PG8_BAR; PG8_WAIT_L(0); PG8_MMA(0, 1, At, B1); PG8_BAR;
            PG8_LDA(At, 0, 1); PG8_STAGE(PG8_SA(0, 0), a2, voffA);
            PG8_BAR; PG8_WAIT_L(0); PG8_MMA(1, 0, At, B0); PG8_BAR; PG8_SCHED;
            PG8_STAGE(PG8_SB(0, 1), b2 + hstep, voffB);
            PG8_WAIT_V(6); PG8_BAR; PG8_MMA(1, 1, At, B1); PG8_BAR;
            PG8_LDB(B0, 1, 0); PG8_SCHED; PG8_LDA(At, 1, 0); PG8_STAGE(PG8_SA(0, 1), a2 + hstep, voffA);
            PG8_WAIT_L(8); PG8_BAR; PG8_WAIT_L(0); PG8_MMA(0, 0, At, B0); PG8_BAR; PG8_SCHED;
            PG8_LDB(B1, 1, 1); PG8_STAGE(PG8_SB(1, 0), b3, voffB);
            PG8_BAR; PG8_WAIT_L(0); PG8_MMA(0, 1, At, B1); PG8_BAR;
            PG8_LDA(At, 1, 1); PG8_STAGE(PG8_SA(1, 0), a3, voffA);
            PG8_BAR; PG8_WAIT_L(0); PG8_MMA(1, 0, At, B0); PG8_BAR; PG8_SCHED;
            PG8_STAGE(PG8_SB(1, 1), b3 + hstep, voffB);
            PG8_WAIT_V(6); PG8_BAR; PG8_MMA(1, 1, At, B1); PG8_BAR;
            }
        }
        if constexpr (ALIGN_EPI) { if (wr == 0) PG8_BAR; }
        if constexpr (!Epi::AFTER_DRAIN) { E(acc, cur, wr, wc, fr, fq); S.done(cur); }
        if (!has_next) break;
#pragma unroll
        for (int a = 0; a < 2; ++a)
#pragma unroll
            for (int b = 0; b < 2; ++b)
#pragma unroll
                for (int m = 0; m < 4; ++m)
#pragma unroll
                    for (int n = 0; n < 2; ++n) acc[a][b][m][n] = (f32x4){0.f, 0.f, 0.f, 0.f};
        cur = nxt; cA = nA; cB = nB; ++ui;
        if constexpr (ALIGN_EPI) { if (wr == 1) PG8_BAR; }
    }
    PG8_WAIT_V(0);
    if constexpr (!ALIGN_EPI) { if (wr == 0) PG8_BAR; }
    PG8_BAR;
    if constexpr (Epi::AFTER_DRAIN) { E.fused(acc, cur, wr, wc, fr, fq, lds, wid, lane); S.done(cur); }
#undef PG8_SA
#undef PG8_SB
#undef PG8_STAGE
#undef PG8_LDA
#undef PG8_LDB
#undef PG8_MMA
#undef PG8_WAIT_V
#undef PG8_WAIT_L
#undef PG8_BAR
#undef PG8_SCHED
}
}

constexpr int NWAVES = 8;
constexpr int NB = 32, SEQ = 2048, DM = 1024, MROWS = NB * SEQ;
constexpr int NPROJ = 3840;
constexpr int C_ZA = 1536, C_QB = 2048, C_ZB = 2560, C_IQ = 3072, C_CKV = 3584, C_IK = 3712;
constexpr float EPSF = 1e-6f;
constexpr float LOG2E = 1.4426950408889634f;
__host__ __device__ __forceinline__ int proj_src_col(int n) {
    if (n < 2048) return n;
    if (n < 2560) return n - 2048 + 2056;
    if (n < 3072) return n - 2560 + 2696;
    if (n < 3584) return n - 3072 + 3208;
    if (n < 3712) return n - 3584 + 2568;
    if (n < 3776) return n - 3712 + 3720;
    if (n < 3784) return n - 3776 + 2048;
    if (n < 3792) return n;
    return -1;
}
__device__ const unsigned char T5_BUCKET[128] = {0,1,2,3,4,5,6,7,8,9,10,11,12,13,14,15,16,16,16,17,17,18,18,18,19,19,19,20,20,20,20,21,21,21,21,22,22,22,22,22,23,23,23,23,23,23,24,24,24,24,24,24,25,25,25,25,25,25,25,26,26,26,26,26,26,26,26,27,27,27,27,27,27,27,27,27,27,28,28,28,28,28,28,28,28,28,28,29,29,29,29,29,29,29,29,29,29,29,29,30,30,30,30,30,30,30,30,30,30,30,30,30,30,31,31,31,31,31,31,31,31,31,31,31,31,31,31,31};

constexpr size_t MiB = 1u << 20;
constexpr size_t WS_CTL = 0, CTL_ZERO_BYTES = 1 * MiB;
constexpr size_t WS_MOD = 1 * MiB;
constexpr size_t WS_WUV = 2 * MiB;
constexpr size_t WS_WOUT = 3 * MiB;
constexpr size_t WS_WIN = 5 * MiB;
constexpr size_t WS_KVSS = 13 * MiB;
constexpr size_t WS_AUX = 14 * MiB;
constexpr size_t WS_XN = 32 * MiB;
constexpr size_t WS_PROJ = 160 * MiB;
constexpr size_t WS_SCR = 640 * MiB;
constexpr size_t WS_END = 768 * MiB;
constexpr int CW_TMO = 0, CW_QUEUE = 64, CW_BAR = 4096;

constexpr int LDS_BYTES = 163840;
constexpr int MISC_OFF = LDS_BYTES - 256;
constexpr int SCRATCH_BYTES = MISC_OFF;

#define GAS __attribute__((address_space(1)))
#define LAS __attribute__((address_space(3)))
typedef unsigned short bf16;
typedef unsigned v4u __attribute__((ext_vector_type(4)));
typedef unsigned v2u __attribute__((ext_vector_type(2)));
typedef float f32x4 __attribute__((ext_vector_type(4)));
typedef float f32x16 __attribute__((ext_vector_type(16)));
typedef short bf16x8 __attribute__((ext_vector_type(8)));
typedef GAS unsigned gu32;
#define RLX_AGENT __ATOMIC_RELAXED, __HIP_MEMORY_SCOPE_AGENT
#define LDS_WAIT() asm volatile("s_waitcnt lgkmcnt(0)" ::: "memory")
#define MFMA32(a, b, c) __builtin_amdgcn_mfma_f32_32x32x16_bf16((a), (b), (c), 0, 0, 0)
#define MFMA16F(a, b, c) __builtin_amdgcn_mfma_f32_16x16x4f32((a), (b), (c), 0, 0, 0)
__device__ __forceinline__ unsigned f2bf(float f) { unsigned u = __builtin_bit_cast(unsigned, f); return (u + 0x7fffu + ((u >> 16) & 1u)) >> 16; }
__device__ __forceinline__ unsigned pk2(float lo, float hi) { return f2bf(lo) | (f2bf(hi) << 16); }
__device__ __forceinline__ float bf2f(unsigned short b) { return __builtin_bit_cast(float, ((unsigned)b) << 16); }
__device__ __forceinline__ float bflo(unsigned w) { return __builtin_bit_cast(float, w << 16); }
__device__ __forceinline__ float bfhi(unsigned w) { return __builtin_bit_cast(float, w & 0xffff0000u); }
__device__ __forceinline__ float rcpf_(float x) { return __builtin_amdgcn_rcpf(x); }
__device__ __forceinline__ float rsqf_(float x) { return __builtin_amdgcn_rsqf(x); }
__device__ __forceinline__ float siluf(float x) { return x * __builtin_amdgcn_rcpf(1.0f + __builtin_amdgcn_exp2f(-1.4426950408889634f * x)); }
__device__ __forceinline__ float wave_sum(float v) {
#pragma unroll
    for (int o = 1; o < 64; o <<= 1) v += __shfl_xor(v, o);
    return v;
}

__device__ __forceinline__ int wave_sum_i(int v) {
    v += __builtin_amdgcn_update_dpp(0, v, 0x111, 0xf, 0xf, false);
    v += __builtin_amdgcn_update_dpp(0, v, 0x112, 0xf, 0xf, false);
    v += __builtin_amdgcn_update_dpp(0, v, 0x114, 0xf, 0xe, false);
    v += __builtin_amdgcn_update_dpp(0, v, 0x118, 0xf, 0xc, false);
    v += __builtin_amdgcn_update_dpp(0, v, 0x142, 0xa, 0xf, false);
    v += __builtin_amdgcn_update_dpp(0, v, 0x143, 0xc, 0xf, false);
    return __builtin_amdgcn_readlane(v, 63);
}
__device__ __forceinline__ float wave_max(float v) {
    const int ninf = (int)0xff800000u;
#define WM_STEP(ctrl, rm, bm) v = fmaxf(v, __builtin_bit_cast(float, __builtin_amdgcn_update_dpp(ninf, __builtin_bit_cast(int, v), ctrl, rm, bm, false)))
    WM_STEP(0x111, 0xf, 0xf); WM_STEP(0x112, 0xf, 0xf); WM_STEP(0x114, 0xf, 0xe); WM_STEP(0x118, 0xf, 0xc); WM_STEP(0x142, 0xa, 0xf); WM_STEP(0x143, 0xc, 0xf);
#undef WM_STEP
    return __builtin_bit_cast(float, __builtin_amdgcn_readlane(__builtin_bit_cast(int, v), 63));
}
#define XB_TMO      128
#define XB_XCNT(j)  (256  + 64 * (j))
#define XB_XSUB(j)  (1280 + 64 * (j))
#define XB_XGEN(j)  (2304 + 64 * (j))
#define XB_TOP      3328
#define XB_TOPGEN   3392
#define XCD_BAR_WORDS 3456
#define XB_SPIN_CAP (1u << 18)

__device__ __forceinline__ unsigned xb_ld(unsigned* p)              { return __hip_atomic_load(p, __ATOMIC_RELAXED, __HIP_MEMORY_SCOPE_AGENT); }
__device__ __forceinline__ unsigned xb_add(unsigned* p, unsigned v) { return __hip_atomic_fetch_add(p, v, __ATOMIC_RELAXED, __HIP_MEMORY_SCOPE_AGENT); }
__device__ __forceinline__ unsigned xb_xcc_id() { return (unsigned)__builtin_amdgcn_s_getreg((3 << 11) | 20) & 0xFu; }
#define XB_SPIN(cond, bar) do { unsigned _sp = 0; while (cond) { __builtin_amdgcn_s_sleep(1); \
    if ((++_sp & 255u) == 0u) { if (xb_ld(&(bar)[XB_TMO])) break; if (_sp > XB_SPIN_CAP) { atomicAdd(&(bar)[XB_TMO], 1u); break; } } } } while (0)

struct XcdBarrier {
    unsigned* bar; unsigned x;
    volatile LAS unsigned* st;
};

__device__ __forceinline__ XcdBarrier xcd_barrier_post(unsigned* bar, volatile LAS unsigned* st) {
    XcdBarrier b; b.bar = bar; b.x = xb_xcc_id(); b.st = st;
    if (threadIdx.x == 0) (void)xb_add(&bar[XB_XCNT(b.x)], 1u);
    return b;
}
__device__ __forceinline__ void xcd_barrier_complete(unsigned* bar, unsigned x, unsigned& nloc, unsigned& nx) {
    const unsigned G = gridDim.x * gridDim.y * gridDim.z;
    unsigned sum, cnt, mine, sp = 0u;
    for (;;) {
        sum = 0u; cnt = 0u; mine = 0u;
#pragma unroll
        for (unsigned j = 0; j < 16; ++j) { const unsigned c = xb_ld(&bar[XB_XCNT(j)]); sum += c; cnt += (c > 0u) ? 1u : 0u; mine = (j == x) ? c : mine; }
        if (sum == G) break;
        __builtin_amdgcn_s_sleep(1);
        if ((++sp & 255u) == 0u) { if (xb_ld(&bar[XB_TMO])) break; if (sp > XB_SPIN_CAP) { atomicAdd(&bar[XB_TMO], 1u); break; } }
    }
    nloc = mine > 0u ? mine : 1u; nx = cnt > 0u ? cnt : 1u;
}

__device__ __forceinline__ void xcd_barrier(const XcdBarrier& b) {
    asm volatile("s_waitcnt vmcnt(0)" ::: "memory");
    __syncthreads();
    if (threadIdx.x == 0) {
        unsigned* bar = b.bar;
        __builtin_amdgcn_s_waitcnt(0);
        unsigned nloc = b.st[0], nx = b.st[1];
        if (nloc == 0u) { xcd_barrier_complete(bar, b.x, nloc, nx); b.st[0] = nloc; b.st[1] = nx; }
        const unsigned old = xb_add(&bar[XB_XSUB(b.x)], 1u);
        const unsigned gen = old / nloc;
        if (old + 1u == (gen + 1u) * nloc) {
            __builtin_amdgcn_fence(__ATOMIC_RELEASE, "agent");
            asm volatile("s_waitcnt vmcnt(0)" ::: "memory");
            const unsigned og = xb_add(&bar[XB_TOP], 1u);
            const unsigned tg = og / nx;
            if (og + 1u == (tg + 1u) * nx) xb_add(&bar[XB_TOPGEN], 1u);
            else XB_SPIN(xb_ld(&bar[XB_TOPGEN]) == tg, bar);
            __builtin_amdgcn_fence(__ATOMIC_ACQUIRE, "agent");
            xb_add(&bar[XB_XGEN(b.x)], 1u);
            asm volatile("s_waitcnt vmcnt(0)" ::: "memory");
        } else {
            XB_SPIN(xb_ld(&bar[XB_XGEN(b.x)]) == gen, bar);
            __builtin_amdgcn_fence(__ATOMIC_ACQUIRE, "agent");
            asm volatile("s_waitcnt vmcnt(0)" ::: "memory");
        }
    }
    __syncthreads();
}

struct Frame {
    LAS unsigned char* lds;
    volatile LAS unsigned* MISC;
    gu32* ctl;
    int tid, lane, wave;
    int vcu, G;
    unsigned char* ws;
};
#define P_X        (args.in[0])
#define P_C        (args.in[1])
#define P_WADA     (args.in[2])
#define P_BADA     (args.in[3])
#define P_GPRE     (args.in[4])
#define P_WIN      (args.in[5])
#define P_CONVW    (args.in[6])
#define P_ALOG     (args.in[7])
#define P_DTB      (args.in[8])
#define P_GGDN     (args.in[9])
#define P_GKV      (args.in[10])
#define P_WUV      (args.in[11])
#define P_RELB     (args.in[12])
#define P_WOUT     (args.in[13])
#define P_GPOST    (args.in[14])
#define P_OUT      (args.out)
#define W_MOD      ((float*)(F.ws + WS_MOD))
#define W_WUVT     ((bf16*)(F.ws + WS_WUV))
#define W_WOUTT    ((bf16*)(F.ws + WS_WOUT))
#define W_WINT     ((bf16*)(F.ws + WS_WIN))
#define W_KVSS     ((float*)(F.ws + WS_KVSS))
#define W_AUX      ((float*)(F.ws + WS_AUX))
#define W_XN       ((bf16*)(F.ws + WS_XN))
#define W_OAB      ((bf16*)(F.ws + WS_XN))
#define W_PROJ     ((bf16*)(F.ws + WS_PROJ))
#define W_MIX      ((bf16*)(F.ws + WS_PROJ))
#define W_SCR      ((float*)(F.ws + WS_SCR))
struct Args { const float* in[15]; float* out; unsigned char* ws; int ph_lo, ph_hi, li, pad; };

template <class CM>
__device__ __forceinline__ void transpose_item(const float* W, int ldw, bf16* WT, int K, int k0, int n0, LAS float* scr, int lane, CM cm) {
    const int nn = lane & 31, sc = cm(n0 + nn);
#pragma unroll 8
    for (int i = 0; i < 32; ++i) { const int kk = 2 * i + (lane >> 5); scr[kk * 33 + nn] = sc >= 0 ? W[(size_t)(k0 + kk) * ldw + sc] : 0.f; }
    LDS_WAIT(); asm volatile("" ::: "memory");
    const int c = lane & 7;
#pragma unroll
    for (int j = 0; j < 4; ++j) { const int n = (lane >> 3) + 8 * j; const LAS float* s = scr + (8 * c) * 33 + n;
        v4u o; o.x = pk2(s[0 * 33], s[1 * 33]); o.y = pk2(s[2 * 33], s[3 * 33]); o.z = pk2(s[4 * 33], s[5 * 33]); o.w = pk2(s[6 * 33], s[7 * 33]);
        *(GAS v4u*)(WT + (size_t)(n0 + n) * K + k0 + 8 * c) = o; }
    LDS_WAIT(); asm volatile("" ::: "memory");
}
struct CmIdent { __device__ __forceinline__ int operator()(int n) const { return n; } };
struct CmProj { __device__ __forceinline__ int operator()(int n) const { return proj_src_col(n); } };

__device__ __forceinline__ void p0_prologue(Frame& F, const Args& args) {
    LAS float* scr = (LAS float*)(F.lds + F.wave * 16384);
    const int gw = F.vcu * NWAVES + F.wave, NGW = F.G * NWAVES;
    constexpr int I_IN = 16 * (NPROJ / 32), I_OUT = 16 * 32, I_UV = 4 * 2 * 4;
    for (int it = gw; it < I_IN + I_OUT + I_UV; it += NGW) {
        int r = it;
        if (r < I_IN) { const int kb = r / (NPROJ / 32), nb = r % (NPROJ / 32); transpose_item(P_WIN, 3792, W_WINT, 1024, 64 * kb, 32 * nb, scr, F.lane, CmProj()); continue; }
        r -= I_IN;
        if (r < I_OUT) { const int kb = r / 32, nb = r % 32; transpose_item(P_WOUT, 1024, W_WOUTT, 1024, 64 * kb, 32 * nb, scr, F.lane, CmIdent()); continue; }
        r -= I_OUT;
        { const int hd = r >> 3, kb = (r >> 2) & 1, nb = r & 3; transpose_item(P_WUV + (size_t)hd * 16384, 128, W_WUVT + (size_t)hd * 16384, 128, 64 * kb, 32 * nb, scr, F.lane, CmIdent()); }
    }
    __syncthreads();
    if (F.vcu < 192) {
        LAS float* SC = (LAS float*)F.lds;
        for (int e = F.tid; e < NB * 1024; e += NWAVES * 64) { const int b = e >> 10, k = e & 1023; SC[k * 33 + b] = siluf(P_C[e]); }
        __syncthreads();
        const int col = F.tid & 15, ks = F.tid >> 4, n = F.vcu * 16 + col;
        float acc[32];
#pragma unroll
        for (int b = 0; b < 32; ++b) acc[b] = 0.f;
        for (int kk = 0; kk < 32; ++kk) { const int k = ks * 32 + kk; const float w = P_WADA[(size_t)k * 3072 + n];
#pragma unroll
            for (int b = 0; b < 32; ++b) acc[b] += SC[k * 33 + b] * w; }
        __syncthreads();
        LAS float* RED = (LAS float*)F.lds;
#pragma unroll
        for (int b = 0; b < 32; ++b) RED[(ks * 32 + b) * 16 + col] = acc[b];
        __syncthreads();
        { const int b = F.tid >> 4; float s = 0.f;
            for (int k2 = 0; k2 < 32; ++k2) s += RED[(k2 * 32 + b) * 16 + col];
            W_MOD[b * 3072 + n] = s + P_BADA[n]; }
        __syncthreads();
    }
}

__device__ __forceinline__ void p1_norm(Frame& F, const Args& args) {
    const int gw = F.vcu * NWAVES + F.wave, NGW = F.G * NWAVES;
    for (int m = 2 * gw; m < MROWS; m += 2 * NGW) {
        const int b = m >> 11;
        const GAS f32x4* xr = (const GAS f32x4*)(P_X + (size_t)m * DM) + F.lane;
        f32x4 v[2][4]; float ss[2] = {0.f, 0.f};
#pragma unroll
        for (int q = 0; q < 2; ++q)
#pragma unroll
            for (int j = 0; j < 4; ++j) v[q][j] = xr[q * 256 + 64 * j];
#pragma unroll
        for (int q = 0; q < 2; ++q)
#pragma unroll
            for (int j = 0; j < 4; ++j) ss[q] += (v[q][j].x * v[q][j].x + v[q][j].y * v[q][j].y) + (v[q][j].z * v[q][j].z + v[q][j].w * v[q][j].w);
        const float rstd0 = rsqf_(wave_sum(ss[0]) * (1.0f / DM) + EPSF), rstd1 = rsqf_(wave_sum(ss[1]) * (1.0f / DM) + EPSF);
        const float* mb = W_MOD + b * 3072;
        GAS unsigned long long* o8 = (GAS unsigned long long*)(W_XN + (size_t)m * DM) + F.lane;
#pragma unroll
        for (int j = 0; j < 4; ++j) { const int col = F.lane * 4 + 256 * j;
            const f32x4 g = *(const f32x4*)(P_GPRE + col), sh = *(const f32x4*)(mb + col), sc = *(const f32x4*)(mb + 1024 + col);
            const f32x4 gs = g * (sc + 1.0f);
            const f32x4 o0 = v[0][j] * rstd0 * gs + sh, o1 = v[1][j] * rstd1 * gs + sh;
            o8[64 * j] = (unsigned long long)pg8::cvt_pk_bf16(o0.x, o0.y) | ((unsigned long long)pg8::cvt_pk_bf16(o0.z, o0.w) << 32);
            o8[256 + 64 * j] = (unsigned long long)pg8::cvt_pk_bf16(o1.x, o1.y) | ((unsigned long long)pg8::cvt_pk_bf16(o1.z, o1.w) << 32); }
    }
}

__device__ __forceinline__ void p5_final(Frame& F, const Args& args) {
    const int gw = F.vcu * NWAVES + F.wave, NGW = F.G * NWAVES;
    for (int m = 2 * gw; m < MROWS; m += 2 * NGW) {
        const int b = m >> 11;
        const GAS v2u* mr = (const GAS v2u*)(W_MIX + (size_t)m * DM) + F.lane;
        const GAS f32x4* xr = (const GAS f32x4*)(P_X + (size_t)m * DM) + F.lane;
        GAS f32x4* orow = (GAS f32x4*)(P_OUT + (size_t)m * DM) + F.lane;
        v2u w[2][4]; f32x4 xv[2][4];
#pragma unroll
        for (int q = 0; q < 2; ++q)
#pragma unroll
            for (int j = 0; j < 4; ++j) { w[q][j] = mr[q * 256 + 64 * j]; xv[q][j] = xr[q * 256 + 64 * j]; }
        f32x4 v[2][4]; float ss[2] = {0.f, 0.f};
#pragma unroll
        for (int q = 0; q < 2; ++q)
#pragma unroll
            for (int j = 0; j < 4; ++j) { v[q][j].x = bflo(w[q][j].x); v[q][j].y = bfhi(w[q][j].x); v[q][j].z = bflo(w[q][j].y); v[q][j].w = bfhi(w[q][j].y);
                ss[q] += (v[q][j].x * v[q][j].x + v[q][j].y * v[q][j].y) + (v[q][j].z * v[q][j].z + v[q][j].w * v[q][j].w); }
        const float rstd0 = rsqf_(wave_sum(ss[0]) * (1.0f / DM) + EPSF), rstd1 = rsqf_(wave_sum(ss[1]) * (1.0f / DM) + EPSF);
        const float* gt = W_MOD + b * 3072 + 2048;
#pragma unroll
        for (int j = 0; j < 4; ++j) { const int col = F.lane * 4 + 256 * j;
            const f32x4 g = *(const f32x4*)(P_GPOST + col), ga = *(const f32x4*)(gt + col);
            const f32x4 gg = g * ga;
            orow[64 * j] = xv[0][j] + gg * (v[0][j] * rstd0);
            orow[256 + 64 * j] = xv[1][j] + gg * (v[1][j] * rstd1); }
    }
}

__device__ __forceinline__ unsigned cvtpk(float lo, float hi) { return pg8::cvt_pk_bf16(lo, hi); }
__device__ __forceinline__ v2u pack4(float a, float b, float c, float d) { v2u r; r.x = cvtpk(a, b); r.y = cvtpk(c, d); return r; }
__device__ __forceinline__ bf16x8 pack8(float a, float b, float c, float d, float e, float f, float g, float h) { v4u r; r.x = cvtpk(a, b); r.y = cvtpk(c, d); r.z = cvtpk(e, f); r.w = cvtpk(g, h); return __builtin_bit_cast(bf16x8, r); }
__device__ __forceinline__ bf16x8 lds16(const LAS unsigned char* p) { return *(const LAS bf16x8*)p; }
__device__ __forceinline__ bf16x8 lds8x2(const LAS unsigned char* p) { const v2u lo = *(const LAS v2u*)p, hi = *(const LAS v2u*)(p + 16); v4u r; r.x = lo.x; r.y = lo.y; r.z = hi.x; r.w = hi.y; return __builtin_bit_cast(bf16x8, r); }
template <int S> __device__ __forceinline__ bf16x8 acc_frag(const f32x16& a) { return pack8(a[8 * S + 0], a[8 * S + 1], a[8 * S + 2], a[8 * S + 3], a[8 * S + 4], a[8 * S + 5], a[8 * S + 6], a[8 * S + 7]); }

__device__ __forceinline__ float row16_sum(float v) {
#define R16_STEP(ctrl) v += __builtin_bit_cast(float, __builtin_amdgcn_update_dpp(0, __builtin_bit_cast(int, v), ctrl, 0xf, 0xf, false))
    R16_STEP(0x121); R16_STEP(0x122); R16_STEP(0x124); R16_STEP(0x128);
#undef R16_STEP
    return v;
}

__device__ __forceinline__ void gdn_unit(Frame& F, const Args& args, const int b, const int h) {
    LAS unsigned char* const L = F.lds;
    const int tid = F.tid, lane = F.lane, wv = F.wave, l31_0 = lane & 31, hh_0 = lane >> 5;
    int tidv = tid, lanev = lane;
    constexpr int P128 = 272, P64 = 144;
    constexpr int O_KH = 0, O_QH = O_KH + 17408, O_KGT = O_QH + 17408, O_VBT = O_KGT + 18432, O_KBGT = O_VBT + 18432, O_LM = O_KBGT + 18432, O_T = O_LM + 17408,
                  O_AT = O_T + 17408, O_CW = O_AT + 9216, O_SM = O_CW + 6144, O_PSO = O_SM + 2560, O_OF = O_PSO + 2048, O_END = O_OF + 17408;
    static_assert(O_END <= SCRATCH_BYTES, "gdn LDS map");
    constexpr int O_W = O_LM, O_VNT = O_VBT;
    LAS float* const SMb = (LAS float*)(L + O_SM);
    LAS float* const LM = (LAS float*)(L + O_LM);
    LAS float* const TT = (LAS float*)(L + O_T);
    LAS float* const CW = (LAS float*)(L + O_CW);
    LAS float* const PSO = (LAS float*)(L + O_PSO);
    const int mt = wv >> 2, nt = wv & 3;
    f32x16 S[4];
#pragma unroll
    for (int k = 0; k < 4; ++k)
#pragma unroll
        for (int r = 0; r < 16; ++r) S[k][r] = 0.f;
    const float alog_e = __expf(P_ALOG[h]), dtb = P_DTB[h];
#define GDN_GATES(n_) do { LAS float* _sm = SMb + ((n_) & 1) * 320; const float* _ap = W_AUX + (size_t)(b * SEQ + (n_) * 64 + lanev) * 16; \
        const float _bb = _ap[h], _aa = _ap[4 + h]; const float _beta = rcpf_(1.0f + __expf(-_bb)); const float _xs = _aa + dtb; \
        const float _sp = _xs > 20.f ? _xs : log1pf(__expf(_xs)); float _gc = -alog_e * _sp; \
        _Pragma("unroll") for (int _o = 1; _o < 64; _o <<= 1) { const float _t = __shfl_up(_gc, _o); if (lanev >= _o) _gc += _t; } \
        const float _gl = __shfl(_gc, 63); _sm[lanev] = _gc; _sm[64 + lanev] = _beta; _sm[128 + lanev] = __expf(_gc); _sm[192 + lanev] = __expf(_gl - _gc); \
        if (lanev == 0) _sm[256] = __expf(_gl); } while (0)
    if (wv == 6) GDN_GATES(0);
    for (int e = tidv; e < 3 * 4 * 128; e += NWAVES * 64) { const int ts_ = e >> 9, tap = (e >> 7) & 3, ch = e & 127; CW[e] = P_CONVW[tap * 1536 + ts_ * 512 + h * 128 + ch]; }
    const int ts = tid >> 8;
    int cgv = tid & 15, tpv = (tid >> 4) & 15;
#define GDN_ROWS(dst_, n_, chan_) do { const bf16* _src = W_PROJ + (size_t)(b * SEQ + (n_) * 64 + 4 * tpv - 3) * NPROJ + (chan_); \
        _Pragma("unroll") for (int _i = 0; _i < 7; ++_i) { v4u _z; _z.x = 0u; _z.y = 0u; _z.z = 0u; _z.w = 0u; dst_[_i] = _z; \
            if ((n_) > 0 || 4 * tpv - 3 + _i >= 0) dst_[_i] = *(const GAS v4u*)(_src + (size_t)_i * NPROJ); } } while (0)
#define GDN_OUT(rowb_) do { const int _tok = tidv >> 3, _dv0 = (tidv & 7) * 16; const size_t _row = (size_t)(rowb_) + _tok; \
        const LAS v4u* _op = (const LAS v4u*)(L + O_OF + _tok * P128 + _dv0 * 2); const v4u _o0 = _op[0], _o1 = _op[1]; \
        const LAS f32x4* _pp = (const LAS f32x4*)(PSO + _tok * 8); const f32x4 _a = _pp[0], _c = _pp[1]; \
        const float _rstd = rsqf_((((_a.x + _a.y) + (_a.z + _a.w)) + ((_c.x + _c.y) + (_c.z + _c.w))) * (1.0f / 128.0f) + EPSF); \
        const bf16* _zp = W_PROJ + _row * NPROJ + C_ZA + h * 128 + _dv0; const v4u _z0 = *(const GAS v4u*)_zp, _z1 = *(const GAS v4u*)(_zp + 8); \
        const unsigned _ow[8] = {_o0.x, _o0.y, _o0.z, _o0.w, _o1.x, _o1.y, _o1.z, _o1.w}, _zw[8] = {_z0.x, _z0.y, _z0.z, _z0.w, _z1.x, _z1.y, _z1.z, _z1.w}; unsigned _rw[8]; \
        _Pragma("unroll") for (int _k = 0; _k < 4; ++_k) { const f32x4 _g = *(const f32x4*)(P_GGDN + _dv0 + 4 * _k); \
            _rw[2 * _k] = cvtpk(bflo(_ow[2 * _k]) * _rstd * _g.x * siluf(bflo(_zw[2 * _k])), bfhi(_ow[2 * _k]) * _rstd * _g.y * siluf(bfhi(_zw[2 * _k]))); \
            _rw[2 * _k + 1] = cvtpk(bflo(_ow[2 * _k + 1]) * _rstd * _g.z * siluf(bflo(_zw[2 * _k + 1])), bfhi(_ow[2 * _k + 1]) * _rstd * _g.w * siluf(bfhi(_zw[2 * _k + 1]))); } \
        bf16* _dst = W_OAB + _row * DM + h * 128 + _dv0; v4u _w0, _w1; _w0.x = _rw[0]; _w0.y = _rw[1]; _w0.z = _rw[2]; _w0.w = _rw[3]; _w1.x = _rw[4]; _w1.y = _rw[5]; _w1.z = _rw[6]; _w1.w = _rw[7]; \
        *(GAS v4u*)_dst = _w0; *(GAS v4u*)(_dst + 8) = _w1; } while (0)
    __syncthreads();

    unsigned pf_sink = 0u;
    for (int n = 0; n < 32; ++n) {
        const int rowbase = b * SEQ + n * 64;
        LAS float* const SMf = SMb + (n & 1) * 320;
        tidv = tid; lanev = lane; cgv = tid & 15; tpv = (tid >> 4) & 15;
        asm volatile("" : "+v"(tidv), "+v"(lanev), "+v"(cgv), "+v"(tpv));
        int l31 = lanev & 31, hh = lanev >> 5, cg = cgv, tp = tpv;
        if (wv == 6 && n + 1 < 32) GDN_GATES(n + 1);
        float val[4][8];
#define GDN_CONV(rows_, tsel_) do { \
            _Pragma("unroll") for (int _j = 0; _j < 4; ++_j) _Pragma("unroll") for (int _e = 0; _e < 8; ++_e) val[_j][_e] = 0.f; \
            _Pragma("unroll") for (int _tap = 0; _tap < 4; ++_tap) { const LAS f32x4* _cp = (const LAS f32x4*)(CW + ((tsel_) * 4 + _tap) * 128 + cg * 8); const f32x4 _c0 = _cp[0], _c1 = _cp[1]; \
                const float _cw[8] = {_c0.x, _c0.y, _c0.z, _c0.w, _c1.x, _c1.y, _c1.z, _c1.w}; \
                _Pragma("unroll") for (int _j = 0; _j < 4; ++_j) { const v4u _raw = rows_[_j + _tap]; \
                    const float _in[8] = {bflo(_raw.x), bfhi(_raw.x), bflo(_raw.y), bfhi(_raw.y), bflo(_raw.z), bfhi(_raw.z), bflo(_raw.w), bfhi(_raw.w)}; \
                    _Pragma("unroll") for (int _e = 0; _e < 8; ++_e) val[_j][_e] += _in[_e] * _cw[_e]; } } \
            _Pragma("unroll") for (int _j = 0; _j < 4; ++_j) _Pragma("unroll") for (int _e = 0; _e < 8; ++_e) val[_j][_e] = siluf(val[_j][_e]); } while (0)
        v4u rq[7], rv[7];
        GDN_ROWS(rq, n, ts * 512 + h * 128 + cgv * 8);
        if (wv < 4) GDN_ROWS(rv, n, 1024 + h * 128 + cgv * 8);
        if (wv == 7 && n + 1 < 32) {
#pragma unroll
            for (int i = 0; i < 9; ++i) { const int idx = i * 64 + lanev; const int rr = idx >> 3, ln = idx & 7;
                if (idx < 67 * 8) { const bf16* pt = W_PROJ + (size_t)(rowbase + 61 + rr) * NPROJ + (ln >> 1) * 512 + h * 128 + (ln & 1) * 64;
                    asm volatile("global_load_dword %0, %1, off" : "+v"(pf_sink) : "v"(pt) : "memory"); } }
        }
        {
            GDN_CONV(rq, ts);
#pragma unroll
            for (int j = 0; j < 4; ++j) { float ss = 0.f;
#pragma unroll
                for (int e = 0; e < 8; ++e) ss += val[j][e] * val[j][e];
                ss = row16_sum(ss);
                float r = rsqf_(ss + EPSF); if (ts == 0) r *= 0.08838834764831845f;
#pragma unroll
                for (int e = 0; e < 8; ++e) val[j][e] *= r; }
            if (ts == 0) {
#pragma unroll
                for (int j = 0; j < 4; ++j) *(LAS bf16x8*)(L + O_QH + (4 * tp + j) * P128 + cg * 16) = pack8(val[j][0], val[j][1], val[j][2], val[j][3], val[j][4], val[j][5], val[j][6], val[j][7]);
            } else {
                float ek[4], bg[4];
#pragma unroll
                for (int j = 0; j < 4; ++j) { ek[j] = SMf[192 + 4 * tp + j]; bg[j] = SMf[64 + 4 * tp + j] * SMf[128 + 4 * tp + j]; }
#pragma unroll
                for (int j = 0; j < 4; ++j) *(LAS bf16x8*)(L + O_KH + (4 * tp + j) * P128 + cg * 16) = pack8(val[j][0], val[j][1], val[j][2], val[j][3], val[j][4], val[j][5], val[j][6], val[j][7]);
#pragma unroll
                for (int e = 0; e < 8; ++e) {
                    *(LAS v2u*)(L + O_KGT + (cg * 8 + e) * P64 + tp * 8) = pack4(val[0][e] * ek[0], val[1][e] * ek[1], val[2][e] * ek[2], val[3][e] * ek[3]);
                    *(LAS v2u*)(L + O_KBGT + (cg * 8 + e) * P64 + tp * 8) = pack4(val[0][e] * bg[0], val[1][e] * bg[1], val[2][e] * bg[2], val[3][e] * bg[3]); }
            }
        }
        if (n > 0) GDN_OUT(rowbase - 64);
        if (wv < 4) {
            GDN_CONV(rv, 2);
            float be[4];
#pragma unroll
            for (int j = 0; j < 4; ++j) be[j] = SMf[64 + 4 * tp + j];
#pragma unroll
            for (int e = 0; e < 8; ++e) *(LAS v2u*)(L + O_VBT + (cg * 8 + e) * P64 + tp * 8) = pack4(val[0][e] * be[0], val[1][e] * be[1], val[2][e] * be[2], val[3][e] * be[3]);
        }
        for (int e = tidv; e < 64 * 68; e += NWAVES * 64) TT[e] = 0.f;
        __syncthreads();
        if (wv < 4) {
            const int ti = wv >> 1, tj = wv & 1;
            f32x16 C;
#pragma unroll
            for (int r = 0; r < 16; ++r) C[r] = 0.f;
            if (ti >= tj) {
#pragma unroll
                for (int s = 0; s < 8; ++s) C = MFMA32(lds16(L + O_KH + (32 * ti + l31) * P128 + (16 * s + 8 * hh) * 2), lds16(L + O_KH + (32 * tj + l31) * P128 + (16 * s + 8 * hh) * 2), C);
            }
            const int j = 32 * tj + l31; const float gcj = SMf[j];
#pragma unroll
            for (int g = 0; g < 4; ++g) { const int ib = 32 * ti + 8 * g + 4 * hh; const f32x4 gci = *(const LAS f32x4*)(SMf + ib), bei = *(const LAS f32x4*)(SMf + 64 + ib);
#pragma unroll
                for (int e = 0; e < 4; ++e) { const int i = ib + e; LM[i * 68 + j] = (i > j) ? bei[e] * C[4 * g + e] * __expf(gci[e] - gcj) : 0.f; } }
            if (ti == tj) {
                asm volatile("s_waitcnt lgkmcnt(0)" ::: "memory");
                const int a = 2 * ti, bq = 2 * ti + 1;
                if (lanev < 32) {
                    const int blk = a + (lanev >> 4), c = lanev & 15; float x[16];
    #pragma unroll
                    for (int i = 0; i < 16; ++i) { const LAS float* lr = LM + (16 * blk + i) * 68 + 16 * blk; float acc = (i == c) ? 1.f : 0.f;
    #pragma unroll
                        for (int j = 0; j < i; ++j) acc -= lr[j] * x[j];
                        x[i] = acc; TT[(16 * blk + i) * 68 + 16 * blk + c] = acc; }
                }
                asm volatile("s_waitcnt lgkmcnt(0)" ::: "memory");
                const int m = lanev & 15, q = lanev >> 4;
                f32x4 P = {0.f, 0.f, 0.f, 0.f}, R = {0.f, 0.f, 0.f, 0.f};
    #pragma unroll
                for (int s = 0; s < 4; ++s) { const int k = q + 4 * s; P = MFMA16F(LM[(16 * bq + m) * 68 + 16 * a + k], TT[(16 * a + k) * 68 + 16 * a + m], P); }
    #pragma unroll
                for (int rg = 0; rg < 4; ++rg) { const int k = 4 * q + rg; R = MFMA16F(TT[(16 * bq + m) * 68 + 16 * bq + k], P[rg], R); }
    #pragma unroll
                for (int rg = 0; rg < 4; ++rg) TT[(16 * bq + 4 * q + rg) * 68 + 16 * a + m] = -R[rg];
            }
        } else {
            const int w4 = wv - 4, tj = w4 >> 1, ti = w4 & 1;
            f32x16 C;
#pragma unroll
            for (int r = 0; r < 16; ++r) C[r] = 0.f;
            if (ti >= tj) {
#pragma unroll
                for (int s = 0; s < 8; ++s) C = MFMA32(lds16(L + O_KH + (32 * tj + l31) * P128 + (16 * s + 8 * hh) * 2), lds16(L + O_QH + (32 * ti + l31) * P128 + (16 * s + 8 * hh) * 2), C);
            }
            const int i = 32 * ti + l31; const float gci = SMf[i];
#pragma unroll
            for (int g = 0; g < 4; ++g) { const int jb = 32 * tj + 8 * g + 4 * hh; const f32x4 gcj = *(const LAS f32x4*)(SMf + jb); float v[4];
#pragma unroll
                for (int e = 0; e < 4; ++e) v[e] = (i >= jb + e) ? C[4 * g + e] * __expf(gci - gcj[e]) : 0.f;
                *(LAS v2u*)(L + O_AT + i * P64 + jb * 2) = pack4(v[0], v[1], v[2], v[3]); }
        }
        __syncthreads();
        if (wv < 4) {
            const int m = lanev & 15, q = lanev >> 4, mi = wv >> 1, ni = wv & 1;
            f32x4 P0 = {0.f, 0.f, 0.f, 0.f}, P1 = {0.f, 0.f, 0.f, 0.f}, R = {0.f, 0.f, 0.f, 0.f};
#pragma unroll
            for (int s = 0; s < 8; ++s) { const int k = q + 4 * s; const float bt = TT[k * 68 + 16 * ni + m];
                P0 = MFMA16F(LM[(32 + m) * 68 + k], bt, P0); P1 = MFMA16F(LM[(48 + m) * 68 + k], bt, P1); }
#pragma unroll
            for (int rg = 0; rg < 4; ++rg) { R = MFMA16F(TT[(32 + 16 * mi + m) * 68 + 32 + 4 * q + rg], P0[rg], R); R = MFMA16F(TT[(32 + 16 * mi + m) * 68 + 48 + 4 * q + rg], P1[rg], R); }
#pragma unroll
            for (int rg = 0; rg < 4; ++rg) TT[(32 + 16 * mi + 4 * q + rg) * 68 + 16 * ni + m] = -R[rg];
        }
        __syncthreads();
        f32x16 U, WT_;
#pragma unroll
        for (int r = 0; r < 16; ++r) { U[r] = 0.f; WT_[r] = 0.f; }
#pragma unroll
        for (int s = 0; s < 4; ++s) { const LAS f32x4* tp4 = (const LAS f32x4*)(TT + (32 * mt + l31) * 68 + 16 * s + 8 * hh); const f32x4 t0 = tp4[0], t1 = tp4[1];
            const bf16x8 a = pack8(t0.x, t0.y, t0.z, t0.w, t1.x, t1.y, t1.z, t1.w);
            U = MFMA32(a, lds16(L + O_VBT + (32 * nt + l31) * P64 + (16 * s + 8 * hh) * 2), U);
            WT_ = MFMA32(lds16(L + O_KBGT + (32 * nt + l31) * P64 + (16 * s + 8 * hh) * 2), a, WT_); }
#pragma unroll
        for (int g = 0; g < 4; ++g) *(LAS v2u*)(L + O_W + (32 * mt + l31) * P128 + (32 * nt + 8 * g + 4 * hh) * 2) = pack4(-WT_[4 * g], -WT_[4 * g + 1], -WT_[4 * g + 2], -WT_[4 * g + 3]);
        __syncthreads();
        bf16x8 sf[4][2];
#pragma unroll
        for (int kt = 0; kt < 4; ++kt) { sf[kt][0] = acc_frag<0>(S[kt]); sf[kt][1] = acc_frag<1>(S[kt]); }
#pragma unroll
        for (int kt = 0; kt < 4; ++kt)
#pragma unroll
            for (int s = 0; s < 2; ++s) U = MFMA32(lds8x2(L + O_W + (32 * mt + l31) * P128 + (32 * kt + 16 * s + 4 * hh) * 2), sf[kt][s], U);
#pragma unroll
        for (int g = 0; g < 4; ++g) *(LAS v2u*)(L + O_VNT + (32 * nt + l31) * P64 + (32 * mt + 8 * g + 4 * hh) * 2) = pack4(U[4 * g], U[4 * g + 1], U[4 * g + 2], U[4 * g + 3]);
        __syncthreads();
        {
            f32x16 Oa;
#pragma unroll
            for (int r = 0; r < 16; ++r) Oa[r] = 0.f;
#pragma unroll
            for (int kt = 0; kt < 4; ++kt)
#pragma unroll
                for (int s = 0; s < 2; ++s) Oa = MFMA32(lds8x2(L + O_QH + (32 * mt + l31) * P128 + (32 * kt + 16 * s + 4 * hh) * 2), sf[kt][s], Oa);
#pragma unroll
            for (int g = 0; g < 4; ++g) { const f32x4 e4 = *(const LAS f32x4*)(SMf + 128 + 32 * mt + 8 * g + 4 * hh);
#pragma unroll
                for (int e = 0; e < 4; ++e) Oa[4 * g + e] *= e4[e]; }
            bf16x8 vn[4];
#pragma unroll
            for (int s = 0; s < 4; ++s) vn[s] = lds16(L + O_VNT + (32 * nt + l31) * P64 + (16 * s + 8 * hh) * 2);
#pragma unroll
            for (int s = 0; s < 4; ++s) Oa = MFMA32(lds16(L + O_AT + (32 * mt + l31) * P64 + (16 * s + 8 * hh) * 2), vn[s], Oa);
            const float glast = SMf[256];
#pragma unroll
            for (int kt = 0; kt < 4; ++kt) {
#pragma unroll
                for (int r = 0; r < 16; ++r) S[kt][r] *= glast;
#pragma unroll
                for (int s = 0; s < 4; ++s) S[kt] = MFMA32(lds16(L + O_KGT + (32 * kt + l31) * P64 + (16 * s + 8 * hh) * 2), vn[s], S[kt]);
            }
#pragma unroll
            for (int r = 0; r < 16; ++r) { const float q2 = row16_sum(Oa[r] * Oa[r]);
                if ((lanev & 15) == 0) PSO[(32 * mt + 8 * (r >> 2) + 4 * hh + (r & 3)) * 8 + 2 * nt + ((lanev >> 4) & 1)] = q2;
                *(LAS unsigned short*)(L + O_OF + (32 * mt + 8 * (r >> 2) + 4 * hh + (r & 3)) * P128 + (32 * nt + l31) * 2) = (unsigned short)cvtpk(Oa[r], 0.f); }
        }
        asm volatile("s_waitcnt vmcnt(0)" : "+v"(pf_sink) :: "memory");
        __syncthreads();
    }
    GDN_OUT(b * SEQ + 31 * 64);
    __syncthreads();
#undef GDN_GATES
#undef GDN_CONV
#undef GDN_ROWS
#undef GDN_OUT
}

typedef short s16x4 __attribute__((ext_vector_type(4)));
__device__ __forceinline__ bf16x8 ldstr8(const LAS unsigned char* p0, const LAS unsigned char* p1) {
    const s16x4 a = __builtin_amdgcn_ds_read_tr16_b64_v4i16((LAS s16x4*)p0), b = __builtin_amdgcn_ds_read_tr16_b64_v4i16((LAS s16x4*)p1);
    bf16x8 r; r[0] = a[0]; r[1] = a[1]; r[2] = a[2]; r[3] = a[3]; r[4] = b[0]; r[5] = b[1]; r[6] = b[2]; r[7] = b[3]; return r;
}
template <int NREG>
__device__ __forceinline__ void dsa_select(const float* const scw, LAS unsigned* const MASK, const int wv, const int lane, const int t0, const int nk) {
    const float NINF = -__builtin_inff();
    const unsigned long long lt_mask = (1ull << lane) - 1ull;
    float xn[NREG];
#pragma unroll
    for (int i = 0; i < NREG; ++i) xn[i] = __hip_atomic_load(scw + i * 64 + lane, __ATOMIC_RELAXED, __HIP_MEMORY_SCOPE_AGENT);
#pragma unroll 1
    for (int ql_ = 0; ql_ < 8; ++ql_) {
        const int ql = ql_ & 7;
        const int tq = t0 + 8 * wv + ql;
        LAS unsigned* const mrow = MASK + (8 * wv + ql) * 64;
        float x[NREG];
#pragma unroll
        for (int i = 0; i < NREG; ++i) x[i] = (i * 64 + lane < nk) ? xn[i] : NINF;
        if (ql_ + 1 < 8) {
#pragma unroll
            for (int i = 0; i < NREG; ++i) xn[i] = __hip_atomic_load(scw + ((ql_ + 1) & 7) * 2048 + i * 64 + lane, __ATOMIC_RELAXED, __HIP_MEMORY_SCOPE_AGENT);
        }
        if (tq + 1 > 256) {
            float vmin = __builtin_inff(), vmax = NINF;
#pragma unroll
            for (int i = 0; i < NREG; ++i) { vmax = fmaxf(vmax, x[i]); vmin = fminf(vmin, x[i] == NINF ? __builtin_inff() : x[i]); }
            vmin = -wave_max(-vmin); vmax = wave_max(vmax);
#define CNT_GE(p_, dst_) do { int _c0 = 0, _c1 = 0, _c2 = 0, _c3 = 0; const float _p = (p_); \
                _Pragma("unroll") for (int _i = 0; _i < NREG; _i += 4) \
                    asm volatile("v_cmp_le_f32_e64 s[90:91], %8, %4\n\tv_cmp_le_f32_e64 s[92:93], %8, %5\n\tv_cmp_le_f32_e64 s[94:95], %8, %6\n\tv_cmp_le_f32_e64 s[96:97], %8, %7\n\t" \
                                 "v_addc_co_u32_e64 %0, s[90:91], 0, %0, s[90:91]\n\tv_addc_co_u32_e64 %1, s[92:93], 0, %1, s[92:93]\n\tv_addc_co_u32_e64 %2, s[94:95], 0, %2, s[94:95]\n\tv_addc_co_u32_e64 %3, s[96:97], 0, %3, s[96:97]" \
                                 : "+v"(_c0), "+v"(_c1), "+v"(_c2), "+v"(_c3) : "v"(x[_i]), "v"(x[_i + 1]), "v"(x[_i + 2]), "v"(x[_i + 3]), "s"(_p) : "s90", "s91", "s92", "s93", "s94", "s95", "s96", "s97"); \
                dst_ = wave_sum_i((_c0 + _c1) + (_c2 + _c3)); } while (0)
            float lo = vmin, hi = vmax, thr; int chi; bool tie = false;
            CNT_GE(hi, chi);
            if (chi == 256) thr = hi;
            else if (chi > 256) { tie = true; lo = hi; chi = 0; hi = __builtin_inff(); }
            else {
#pragma unroll 1
                for (;;) {
                    const float mid = 0.5f * (lo + hi);
                    if (!(mid > lo && mid < hi)) { tie = true; break; }
                    int c; CNT_GE(mid, c);
                    if (c == 256) { thr = mid; break; }
                    if (c > 256) lo = mid; else { hi = mid; chi = c; }
                }
            }
#undef CNT_GE
            if (!tie) {
#pragma unroll
                for (int i = 0; i < NREG; ++i) { const unsigned long long bs = __ballot(x[i] >= thr);
                    if (lane == 0) { v2u w; w.x = (unsigned)bs; w.y = (unsigned)(bs >> 32); *(LAS v2u*)(mrow + 2 * i) = w; } }
            } else {
                const int need = 256 - chi; int before = 0;
#pragma unroll
                for (int i = 0; i < NREG; ++i) { const bool eq = (x[i] == lo); const unsigned long long be = __ballot(eq);
                    const int rank = before + __popcll(be & lt_mask); const bool sel = (x[i] >= hi) || (eq && rank < need); before += __popcll(be);
                    const unsigned long long bs = __ballot(sel);
                    if (lane == 0) { v2u w; w.x = (unsigned)bs; w.y = (unsigned)(bs >> 32); *(LAS v2u*)(mrow + 2 * i) = w; } }
            }
        } else {
#pragma unroll
            for (int i = 0; i < NREG; ++i) { const unsigned long long bs = __ballot(i * 64 + lane <= tq);
                if (lane == 0) { v2u w; w.x = (unsigned)bs; w.y = (unsigned)(bs >> 32); *(LAS v2u*)(mrow + 2 * i) = w; } }
        }
    }
}

__device__ __forceinline__ void dsa_unit(Frame& F, const Args& args, const int b, const int qb, const float mb2) {
    LAS unsigned char* const L = F.lds;
    const int tid = F.tid, lane = F.lane, wv = F.wave, l31_0 = lane & 31, hh_0 = lane >> 5;
    int l31 = l31_0, hh = hh_0;
    constexpr int PK = 272, PV = 144;
    constexpr int O_K0 = 0, O_V0 = 17408, BUFSZ = 35840, O_MASK = 2 * BUFSZ, O_RS = O_MASK + 16384, O_BT = O_RS + 8192, O_END = O_BT + 2048, O_OA = 0;
    static_assert(O_END <= SCRATCH_BYTES && 4 * 17408 <= 2 * BUFSZ, "dsa LDS map");
    const int t0 = 64 * qb, nk = 64 * (qb + 1);
    const size_t rb = (size_t)b * SEQ;
    LAS unsigned* const MASK = (LAS unsigned*)(L + O_MASK);
    LAS float* const RS = (LAS float*)(L + O_RS);
    LAS float* const BT = (LAS float*)(L + O_BT);
    const float NINF = -__builtin_inff();
    for (int key = tid; key < nk; key += NWAVES * 64) { const f32x4 s4 = *(const f32x4*)(W_KVSS + (rb + key) * 4); RS[key] = rsqf_(((s4.x + s4.y) + (s4.z + s4.w)) * (1.0f / 128.0f) + EPSF); }
    BT[tid] = P_RELB[T5_BUCKET[tid >> 2] * 4 + (tid & 3)] * LOG2E;
    float* const scw = W_SCR + (size_t)(blockIdx.x * NWAVES + wv) * 8 * 2048;
#pragma unroll 1
    for (int rep_a = 0; rep_a < (PROBE_DUP == 41 ? 2 : 1); ++rep_a) {
        bf16x8 aq[2][4]; f32x4 wts[2][4];
#pragma unroll
        for (int rt = 0; rt < 2; ++rt) {
            const bf16* p = W_PROJ + (rb + t0 + 8 * wv + 4 * rt + (l31 >> 3)) * NPROJ + C_IQ + (l31 & 7) * 64 + 8 * hh;
#pragma unroll
            for (int s = 0; s < 4; ++s) aq[rt][s] = *(const GAS bf16x8*)(p + 16 * s);
#pragma unroll
            for (int g = 0; g < 4; ++g) wts[rt][g] = *(const f32x4*)(W_AUX + (rb + t0 + 8 * wv + 4 * rt + g) * 16 + 8 + 4 * hh) * 0.5f;
        }
        constexpr int O_IK = 0, IKB = 9216, PIK = 144;
        v4u sti;
#define IK_GLOAD(kt_) sti = *(const GAS v4u*)(W_PROJ + (rb + 64 * (kt_) + (tid >> 3)) * NPROJ + C_IK + (tid & 7) * 8)
#define IK_SWRITE(buf_) *(LAS v4u*)(L + O_IK + (buf_) * IKB + (tid >> 3) * PIK + (tid & 7) * 16) = sti
        IK_GLOAD(0); IK_SWRITE(0);
        __syncthreads();
#pragma unroll 1
        for (int kt6 = 0; kt6 <= qb; ++kt6) {
          const int ibuf = kt6 & 1;
          if (kt6 < qb) IK_GLOAD(kt6 + 1);
#pragma unroll
          for (int st = 0; st < 2; ++st) {
            bf16x8 bk[4];
#pragma unroll
            for (int s = 0; s < 4; ++s) bk[s] = lds16(L + O_IK + ibuf * IKB + (32 * st + l31) * PIK + (16 * s + 8 * hh) * 2);
            const int kt = 2 * kt6 + st;
            const int key = 32 * kt + l31;
            f32x16 C0, C1;
#pragma unroll
            for (int r = 0; r < 16; ++r) { C0[r] = 0.f; C1[r] = 0.f; }
#pragma unroll
            for (int s = 0; s < 4; ++s) C0 = MFMA32(aq[0][s], bk[s], C0);
#pragma unroll
            for (int s = 0; s < 4; ++s) C1 = MFMA32(aq[1][s], bk[s], C1);
            float pp[2][4];
#pragma unroll
            for (int g = 0; g < 4; ++g) {
                float p0 = 0.f, p1 = 0.f;
#pragma unroll
                for (int e2 = 0; e2 < 4; ++e2) { const float w0 = wts[0][g][e2], w1 = wts[1][g][e2], x0 = C0[4 * g + e2], x1 = C1[4 * g + e2];
                    p0 = __builtin_fmaf(w0, x0, p0); p0 = __builtin_fmaf(w0, __builtin_fabsf(x0), p0); p1 = __builtin_fmaf(w1, x1, p1); p1 = __builtin_fmaf(w1, __builtin_fabsf(x1), p1); }
                pp[0][g] = p0; pp[1][g] = p1;
            }
            float snd[2][2], rcv[2][2];
#pragma unroll
            for (int rt = 0; rt < 2; ++rt)
#pragma unroll
                for (int g2 = 0; g2 < 2; ++g2) snd[rt][g2] = hh ? pp[rt][g2] : pp[rt][g2 + 2];
#pragma unroll
            for (int rt = 0; rt < 2; ++rt)
#pragma unroll
                for (int g2 = 0; g2 < 2; ++g2) rcv[rt][g2] = __shfl_xor(snd[rt][g2], 32);
#pragma unroll
            for (int rt = 0; rt < 2; ++rt)
#pragma unroll
                for (int g2 = 0; g2 < 2; ++g2) { const int ql = 4 * rt + g2 + 2 * hh; float p = (hh ? pp[rt][g2 + 2] : pp[rt][g2]) + rcv[rt][g2];
                    if (key > t0 + 8 * wv + ql) p = NINF;
                    scw[ql * 2048 + key] = p; }
          }
          if (kt6 < qb) IK_SWRITE(ibuf ^ 1);
          __syncthreads();
        }
#undef IK_GLOAD
#undef IK_SWRITE
    }
    __builtin_amdgcn_fence(__ATOMIC_SEQ_CST, "workgroup");
    asm volatile("s_waitcnt vmcnt(0)" ::: "memory");
    int lanev = lane; asm volatile("" : "+v"(lanev));
    if (qb < 8) dsa_select<8>(scw, MASK, wv, lanev, t0, nk);
    else if (qb < 16) dsa_select<16>(scw, MASK, wv, lanev, t0, nk);
    else if (qb < 24) dsa_select<24>(scw, MASK, wv, lanev, t0, nk);
    else dsa_select<32>(scw, MASK, wv, lanev, t0, nk);
    __syncthreads();
    const int qj = l31 >> 2, hd = l31 & 3;
    const int tql = t0 + 8 * wv + qj;
    bf16x8 qf[8]; float qn2 = 0.f;
    {
        const bf16* p = W_PROJ + (rb + tql) * NPROJ + C_QB + hd * 128 + 8 * hh; const float cs = 0.08838834764831845f * LOG2E;
#pragma unroll
        for (int s = 0; s < 8; ++s) { const v4u raw = *(const GAS v4u*)(p + 16 * s); const f32x4 g0 = *(const f32x4*)(P_GKV + 16 * s + 8 * hh), g1 = *(const f32x4*)(P_GKV + 16 * s + 8 * hh + 4);
            v4u o; o.x = cvtpk(bflo(raw.x) * g0.x * cs, bfhi(raw.x) * g0.y * cs); o.y = cvtpk(bflo(raw.y) * g0.z * cs, bfhi(raw.y) * g0.w * cs);
            o.z = cvtpk(bflo(raw.z) * g1.x * cs, bfhi(raw.z) * g1.y * cs); o.w = cvtpk(bflo(raw.w) * g1.z * cs, bfhi(raw.w) * g1.w * cs);
            qn2 += (bflo(o.x) * bflo(o.x) + bfhi(o.x) * bfhi(o.x)) + (bflo(o.y) * bflo(o.y) + bfhi(o.y) * bfhi(o.y)) + (bflo(o.z) * bflo(o.z) + bfhi(o.z) * bfhi(o.z)) + (bflo(o.w) * bflo(o.w) + bfhi(o.w) * bfhi(o.w));
            qf[s] = __builtin_bit_cast(bf16x8, o); }
    }
    qn2 += __shfl_xor(qn2, 32);
    const float c0 = -(sqrtf(qn2) * 11.313708499f * 1.01f + mb2 + 1.0f);
    const float cfar = BT[127 * 4 + hd] + c0;
    f32x16 oacc[4];
#pragma unroll
    for (int d = 0; d < 4; ++d)
#pragma unroll
        for (int r = 0; r < 16; ++r) oacc[d][r] = 0.f;
    float lsum = 0.f;
    v4u st0, st1;
#define DSA_GLOAD(kt) do { const bf16* _p = W_PROJ + (rb + 64 * (kt) + lane) * NPROJ + C_CKV + wv * 16; st0 = *(const GAS v4u*)_p; st1 = *(const GAS v4u*)(_p + 8); } while (0)
#define DSA_SWRITE(buf, ktt) do { LAS unsigned char* _kb = L + (buf) * BUFSZ; const float _r = RS[64 * (ktt) + lane]; \
        v4u _n0, _n1; _n0.x = cvtpk(bflo(st0.x) * _r, bfhi(st0.x) * _r); _n0.y = cvtpk(bflo(st0.y) * _r, bfhi(st0.y) * _r); _n0.z = cvtpk(bflo(st0.z) * _r, bfhi(st0.z) * _r); _n0.w = cvtpk(bflo(st0.w) * _r, bfhi(st0.w) * _r); \
        _n1.x = cvtpk(bflo(st1.x) * _r, bfhi(st1.x) * _r); _n1.y = cvtpk(bflo(st1.y) * _r, bfhi(st1.y) * _r); _n1.z = cvtpk(bflo(st1.z) * _r, bfhi(st1.z) * _r); _n1.w = cvtpk(bflo(st1.w) * _r, bfhi(st1.w) * _r); \
        *(LAS v4u*)(_kb + O_K0 + lane * PK + wv * 32) = _n0; *(LAS v4u*)(_kb + O_K0 + lane * PK + wv * 32 + 16) = _n1; \
        } while (0)
    DSA_GLOAD(0); DSA_SWRITE(0, 0);
    __syncthreads();
    for (int kt = 0; kt <= qb; ++kt) {
        const int buf = kt & 1;
        l31 = l31_0; hh = hh_0; asm volatile("" : "+v"(l31), "+v"(hh));
        if (kt < qb) DSA_GLOAD(kt + 1);
        const LAS unsigned char* kb = L + buf * BUFSZ;
#pragma unroll
        for (int st = 0; st < 2; ++st) {
            f32x16 Sa;
#pragma unroll
            for (int r = 0; r < 16; ++r) Sa[r] = 0.f;
#pragma unroll
            for (int s = 0; s < 8; ++s) Sa = MFMA32(lds16(kb + O_K0 + (32 * st + l31) * PK + (16 * s + 8 * hh) * 2), qf[s], Sa);
            const int kbase = 64 * kt + 32 * st;
            const int mwi = (int)(MASK[(8 * wv + qj) * 64 + 2 * kt + st] >> (4 * hh));
            const bool far = (t0 + 8 * wv) - (kbase + 31) >= 113;
            float pn[16];
            if (far) {
#pragma unroll
                for (int r = 0; r < 16; ++r) { const float p = __builtin_bit_cast(float, __builtin_bit_cast(int, __builtin_amdgcn_exp2f(Sa[r] + cfar)) & __builtin_amdgcn_sbfe(mwi, 8 * (r >> 2) + (r & 3), 1));
                    lsum += p; pn[r] = p; }
            } else {
#pragma unroll
                for (int r = 0; r < 16; ++r) { int dist = tql - (kbase + 8 * (r >> 2) + 4 * hh + (r & 3)); dist = dist < 0 ? 0 : (dist > 127 ? 127 : dist);
                    const float p = __builtin_bit_cast(float, __builtin_bit_cast(int, __builtin_amdgcn_exp2f(Sa[r] + (BT[dist * 4 + hd] + c0))) & __builtin_amdgcn_sbfe(mwi, 8 * (r >> 2) + (r & 3), 1));
                    lsum += p; pn[r] = p; }
            }
            const bf16x8 pf0 = pack8(pn[0], pn[1], pn[2], pn[3], pn[4], pn[5], pn[6], pn[7]), pf1 = pack8(pn[8], pn[9], pn[10], pn[11], pn[12], pn[13], pn[14], pn[15]);
#pragma unroll
            for (int dt = 0; dt < 4; ++dt) {
                const LAS unsigned char* vp = kb + O_K0 + (32 * st + 4 * hh + ((lane & 15) >> 2)) * PK + (32 * dt + 16 * ((lane >> 4) & 1) + 4 * (lane & 3)) * 2;
                oacc[dt] = MFMA32(ldstr8(vp, vp + 8 * PK), pf0, oacc[dt]); oacc[dt] = MFMA32(ldstr8(vp + 16 * PK, vp + 24 * PK), pf1, oacc[dt]); }
        }
        if (kt < qb) DSA_SWRITE(buf ^ 1, kt + 1);
        __syncthreads();
    }
#undef DSA_GLOAD
#undef DSA_SWRITE
    lsum += __shfl_xor(lsum, 32);
    {
        const float inv = rcpf_(lsum);
#pragma unroll
        for (int dt = 0; dt < 4; ++dt)
#pragma unroll
            for (int g = 0; g < 4; ++g) { const int d = 32 * dt + 8 * g + 4 * hh; const f32x4 gk = *(const f32x4*)(P_GKV + d);
                *(LAS v2u*)(L + O_OA + hd * 17408 + (8 * wv + qj) * PK + d * 2) = pack4(oacc[dt][4 * g] * inv * gk.x, oacc[dt][4 * g + 1] * inv * gk.y, oacc[dt][4 * g + 2] * inv * gk.z, oacc[dt][4 * g + 3] * inv * gk.w); }
    }
    __syncthreads();
    {
        const int hd2 = wv >> 1, mt2 = wv & 1;
        const size_t row = rb + t0 + 32 * mt2 + l31;
        bf16x8 of[8];
#pragma unroll
        for (int s = 0; s < 8; ++s) of[s] = lds16(L + O_OA + hd2 * 17408 + (32 * mt2 + l31) * PK + (16 * s + 8 * hh) * 2);
#pragma unroll 1
        for (int et = 0; et < 4; ++et) {
            v2u zw[4];
#pragma unroll
            for (int g = 0; g < 4; ++g) zw[g] = *(const GAS v2u*)(W_PROJ + row * NPROJ + C_ZB + hd2 * 128 + 32 * et + 8 * g + 4 * hh);
            f32x16 C;
#pragma unroll
            for (int r = 0; r < 16; ++r) C[r] = 0.f;
            const bf16* wp = W_WUVT + (size_t)hd2 * 16384 + (32 * et + l31) * 128 + 8 * hh;
#pragma unroll
            for (int s = 0; s < 8; ++s) C = MFMA32(*(const GAS bf16x8*)(wp + 16 * s), of[s], C);
#pragma unroll
            for (int g = 0; g < 4; ++g)
                *(GAS v2u*)(W_OAB + row * DM + 512 + hd2 * 128 + 32 * et + 8 * g + 4 * hh) =
                    pack4(C[4 * g] * siluf(bflo(zw[g].x)), C[4 * g + 1] * siluf(bfhi(zw[g].x)), C[4 * g + 2] * siluf(bflo(zw[g].y)), C[4 * g + 3] * siluf(bfhi(zw[g].y)));
        }
    }
    __syncthreads();
}

constexpr int N_GDN = NB * 4, N_DSA = NB * 32, N_ITEMS = N_GDN + N_DSA;
constexpr int N_PHASES = 6;
__global__ void __launch_bounds__(NWAVES * 64, 2) hyb_fwd(Args args) {
    extern __shared__ __attribute__((aligned(16))) unsigned char lds[];
    Frame F;
    F.lds = (LAS unsigned char*)lds;
    F.MISC = (volatile LAS unsigned*)(F.lds + MISC_OFF);
    F.tid = threadIdx.x; F.lane = F.tid & 63; F.wave = __builtin_amdgcn_readfirstlane(F.tid >> 6);
    F.G = gridDim.x; { const int bx = blockIdx.x; F.vcu = (F.G % 8 == 0) ? (bx % 8) * (F.G / 8) + bx / 8 : bx; }
    unsigned char* ws = args.ws;
    F.ctl = (gu32*)(ws + WS_CTL);
    F.ws = ws;
    for (int u = F.tid; u < 64; u += NWAVES * 64) F.MISC[u] = 0u;
    __syncthreads();
    const int lo = args.ph_lo, hi = args.ph_hi;
    const bool multi = (hi - lo) > 1;
    XcdBarrier bar; bar.bar = (unsigned*)(F.ctl + CW_BAR) + args.li * XCD_BAR_WORDS; bar.x = 0; bar.st = nullptr;
    if (multi) bar = xcd_barrier_post((unsigned*)(F.ctl + CW_BAR) + args.li * XCD_BAR_WORDS, F.MISC + 8);
#define IN(k) (lo <= (k) && (k) < hi)
#define BOTH(k) (IN(k) && IN((k) + 1))
    if (IN(0)) { p0_prologue(F, args); if (PROBE_DUP == 7) { __syncthreads(); p0_prologue(F, args); } if (BOTH(0)) xcd_barrier(bar); }
    if (IN(1)) { p1_norm(F, args); if (PROBE_DUP == 1) p1_norm(F, args); if (BOTH(1)) xcd_barrier(bar); }
    if (IN(2)) {
        pg8::Gemm g{W_XN, W_WINT, MROWS, NPROJ, DM}; pg8::StaticOrder S; S.init(MROWS, NPROJ, F.G, (int)blockIdx.x);
        pg8::EpiProj E{W_PROJ, W_AUX, W_KVSS};
        pg8::gemm_phase<pg8::EpiProj, pg8::StaticOrder, true, true>(F.lds, g, S, E);
        if (PROBE_DUP == 2) pg8::gemm_phase<pg8::EpiProj, pg8::StaticOrder, true, true>(F.lds, g, S, E);
        if (BOTH(2)) xcd_barrier(bar);
    }
    if (IN(3)) {
#define NEXT_ITEM(dst, qw) do { if (F.tid == 0) F.MISC[4] = __hip_atomic_fetch_add(F.ctl + (qw), 1u, RLX_AGENT); __syncthreads(); dst = (int)F.MISC[4]; __syncthreads(); } while (0)
        float mb2; { const int hd_ = F.lane & 3; float m_ = P_RELB[hd_]; for (int k = 1; k < 32; ++k) m_ = fmaxf(m_, P_RELB[k * 4 + hd_]); mb2 = m_ * LOG2E; }
        int item; NEXT_ITEM(item, CW_QUEUE);
#pragma unroll 1
        for (int pass = 0; pass < (PROBE_DUP == 3 ? 2 : 1); ++pass) {
            if (pass) NEXT_ITEM(item, CW_QUEUE + 64);
            while (item < N_GDN) { gdn_unit(F, args, item >> 2, item & 3); NEXT_ITEM(item, CW_QUEUE + 64 * pass); }
        }
#pragma unroll 1
        for (int pass = 0; pass < (PROBE_DUP == 4 ? 2 : 1); ++pass) {
            if (pass) NEXT_ITEM(item, CW_QUEUE + 128);
            while (item < N_ITEMS) { if (item >= N_GDN) { const int idx = item - N_GDN; dsa_unit(F, args, idx & 31, 31 - (idx >> 5), mb2); } NEXT_ITEM(item, pass ? CW_QUEUE + 128 : CW_QUEUE); }
        }
#undef NEXT_ITEM
        if (BOTH(3)) xcd_barrier(bar);
    }
    if (IN(4)) {
        pg8::Gemm g{W_OAB, W_WOUTT, MROWS, DM, DM}; pg8::StaticOrder S; S.init(MROWS, DM, F.G, (int)blockIdx.x);
        pg8::EpiMix E{W_MIX, DM};
        pg8::gemm_phase<pg8::EpiMix, pg8::StaticOrder, true, true>(F.lds, g, S, E);
        if (PROBE_DUP == 5) pg8::gemm_phase<pg8::EpiMix, pg8::StaticOrder, true, true>(F.lds, g, S, E);
        if (BOTH(4)) xcd_barrier(bar);
    }
    if (IN(5)) { p5_final(F, args); if (PROBE_DUP == 6) p5_final(F, args); }
#undef IN
#undef BOTH
}

extern "C" void kernel_launch(void* const* d_in, const int* in_sizes, int n_in, void* d_out, int out_size, void* d_ws, size_t ws_size, hipStream_t stream) {
    static int grid = 0;
    if (grid == 0) {
        if (n_in != 15 || in_sizes[0] != MROWS * DM || out_size != MROWS * DM || ws_size < WS_END) { fprintf(stderr, "kernel_launch: unexpected shapes (n_in %d, in0 %d, out %d, ws %zu); nothing launched\n", n_in, n_in > 0 ? in_sizes[0] : -1, out_size, ws_size); grid = -1; return; }
        int dev = 0, cus = 0, per_cu = 0;
        if (hipGetDevice(&dev) != hipSuccess || hipDeviceGetAttribute(&cus, hipDeviceAttributeMultiprocessorCount, dev) != hipSuccess) { fprintf(stderr, "kernel_launch: device query failed\n"); grid = -1; return; }
        if (hipFuncSetAttribute((const void*)hyb_fwd, hipFuncAttributeMaxDynamicSharedMemorySize, LDS_BYTES) != hipSuccess) { fprintf(stderr, "kernel_launch: hipFuncSetAttribute failed\n"); grid = -1; return; }
        if (hipOccupancyMaxActiveBlocksPerMultiprocessor(&per_cu, (const void*)hyb_fwd, NWAVES * 64, LDS_BYTES) != hipSuccess || per_cu < 1)
            fprintf(stderr, "kernel_launch: note: occupancy query reports %d workgroups per CU\n", per_cu);
        (void)hipGetLastError();
        grid = cus < 256 ? cus : 256;
    }
    if (grid < 0) return;
    if (hipMemsetAsync((char*)d_ws + WS_CTL, 0, CTL_ZERO_BYTES, stream) != hipSuccess) { fprintf(stderr, "kernel_launch: memset failed\n"); return; }
    Args a{};
    for (int i = 0; i < 15; ++i) a.in[i] = (const float*)d_in[i];
    a.out = (float*)d_out; a.ws = (unsigned char*)d_ws;
    constexpr int NL = MK_N_LAUNCHES;
    static_assert(NL == 1 || NL == 2 || NL == 3 || NL == N_PHASES, "MK_N_LAUNCHES");
    const int cuts1[2] = {0, 6}, cuts2[3] = {0, 3, 6}, cuts3[4] = {0, 3, 4, 6}, cuts6[7] = {0, 1, 2, 3, 4, 5, 6};
    const int* cuts = NL == 1 ? cuts1 : NL == 2 ? cuts2 : NL == 3 ? cuts3 : cuts6;
    for (int li = 0; li < NL; ++li) {
        a.ph_lo = cuts[li]; a.ph_hi = cuts[li + 1]; a.li = li;
        hipLaunchKernelGGL(hyb_fwd, dim3(grid), dim3(NWAVES * 64), LDS_BYTES, stream, a);
        const hipError_t le = hipPeekAtLastError();
        if (le != hipSuccess) { fprintf(stderr, "kernel_launch: launch %d failed: %s\n", li, hipGetErrorName(le)); break; }
    }
}
```

```cpp
#include <hip/hip_runtime.h>
#include <cstdio>
#include <cstdint>
#ifndef MK_N_LAUNCHES
#define MK_N_LAUNCHES 1
#endif
#ifndef PROBE_DUP
#define PROBE_DUP 0
#endif
namespace pg8 {
#define PG8_LAS __attribute__((address_space(3)))
typedef unsigned short bf16_t;
typedef short bf16x8 __attribute__((ext_vector_type(8)));
typedef float f32x4 __attribute__((ext_vector_type(4)));
typedef unsigned u32x4 __attribute__((ext_vector_type(4)));
constexpr int BM = 256, BK = 64, HALF = 128, HTB = HALF * BK * 2  , STAGE_BYTES = 8 * HTB, NXCD = 8, WGM = 8;

__host__ __device__ __forceinline__ int lds_byte(int r, int c) { const int st = (r >> 4) * 2 + (c >> 5), rr = r & 15, cc = c & 31, ob = rr * 64 + cc * 2; return st * 1024 + (ob ^ (((ob >> 9) & 1) << 5)); }
__host__ __device__ __forceinline__ void stage_rc(int b, int& R, int& C) { const int st = b / 1024, sb = b % 1024, swz = sb ^ (((sb >> 9) & 1) << 5); R = (st >> 1) * 16 + swz / 64; C = (st & 1) * 32 + (swz % 64) / 2; }
__host__ __device__ __forceinline__ int perm32(int rho) { const int n = rho >> 4, i = rho & 15; return 8 * (i >> 2) + 4 * n + (i & 3); }

struct Unit { int pm, pn; };
struct Gemm { const bf16_t* A; const bf16_t* Bt; int M, N, K; };

struct StaticOrder {
    int nM, nN, nwg, G, c;
    __host__ __device__ void init(int M, int N, int G_, int c_) { nM = M / BM; nN = N / BM; nwg = nM * nN; G = G_; c = c_; }
    __host__ __device__ bool next(int i, Unit& u) const {
        const long L = (long)i * G + c; if (L >= nwg) return false;
        int wgid = (int)L; { const int q = nwg / NXCD, r = nwg % NXCD, xcd = wgid % NXCD, off = wgid / NXCD; wgid = (xcd < r ? xcd * (q + 1) : r * (q + 1) + (xcd - r) * q) + off; }
        const int nig = WGM * nN, gid = wgid / nig, fm = gid * WGM, gsz = (nM - fm) < WGM ? (nM - fm) : WGM;
        u.pm = fm + ((wgid % nig) % gsz); u.pn = (wgid % nig) / gsz; return true;
    }
    __device__ __forceinline__ void a_ready(const Unit&) const {}
    __device__ __forceinline__ void done(const Unit&) const {}
};

typedef float f32x2c __attribute__((ext_vector_type(2))); typedef __bf16 b16x2c __attribute__((ext_vector_type(2)));
__device__ __forceinline__ unsigned cvt_pk_bf16(float lo, float hi) { const f32x2c v = {lo, hi}; return __builtin_bit_cast(unsigned, __builtin_convertvector(v, b16x2c)); }
struct EpiProj {
    static constexpr bool PERM = true, AFTER_DRAIN = false;
    bf16_t* O; float* aux; float* kvss;
    __device__ __forceinline__ void operator()(const f32x4 (&acc)[2][2][4][2], const Unit& u, int wr, int wc, int fr, int fq) const {
        const int row0 = u.pm * BM + wr * 64 + fr, col0 = u.pn * BM + wc * 32 + 8 * fq;
        const bool last = (u.pn == 14);
#pragma unroll
        for (int ai = 0; ai < 2; ++ai)
#pragma unroll
            for (int m = 0; m < 4; ++m) {
                const int row = row0 + ai * HALF + m * 16;
                bf16_t* rowp = O + (size_t)row * 3840 + col0;
#pragma unroll
                for (int bj = 0; bj < 2; ++bj) {
                    const f32x4 v0 = acc[ai][bj][m][0], v1 = acc[ai][bj][m][1];
                    u32x4 w; w.x = cvt_pk_bf16(v0[0], v0[1]); w.y = cvt_pk_bf16(v0[2], v0[3]); w.z = cvt_pk_bf16(v1[0], v1[1]); w.w = cvt_pk_bf16(v1[2], v1[3]);
                    *(u32x4*)(rowp + bj * HALF) = w;
                }
                if (last) {
                    const f32x4 a0 = acc[ai][0][m][0], a1 = acc[ai][0][m][1];
                    float ss = (a0[0] * a0[0] + a0[1] * a0[1]) + (a0[2] * a0[2] + a0[3] * a0[3]) + (a1[0] * a1[0] + a1[1] * a1[1]) + (a1[2] * a1[2] + a1[3] * a1[3]);
                    ss += __shfl_xor(ss, 16); ss += __shfl_xor(ss, 32);
                    if (fq == 0) kvss[(size_t)row * 4 + wc] = ss;
                    if (wc == 2 && fq < 2) { float* ap = aux + (size_t)row * 16 + 8 * fq; *(f32x4*)ap = acc[ai][1][m][0]; *(f32x4*)(ap + 4) = acc[ai][1][m][1]; }
                }
            }
    }
};
struct EpiF32 {
    static constexpr bool PERM = false, AFTER_DRAIN = false;
    float* C; int ldc;
    __device__ __forceinline__ void operator()(const f32x4 (&acc)[2][2][4][2], const Unit& u, int wr, int wc, int fr, int fq) const {
        const int row0 = u.pm * BM + wr * 64 + fr, col0 = u.pn * BM + wc * 32 + 4 * fq;
#pragma unroll
        for (int ai = 0; ai < 2; ++ai)
#pragma unroll
            for (int m = 0; m < 4; ++m) { float* rowp = C + (size_t)(row0 + ai * HALF + m * 16) * ldc + col0;
#pragma unroll
                for (int bj = 0; bj < 2; ++bj)
#pragma unroll
                    for (int n = 0; n < 2; ++n) *(f32x4*)(rowp + bj * HALF + n * 16) = acc[ai][bj][m][n]; }
    }
};
struct EpiMix {
    static constexpr bool PERM = true, AFTER_DRAIN = false;
    bf16_t* O; int ldc;
    __device__ __forceinline__ void operator()(const f32x4 (&acc)[2][2][4][2], const Unit& u, int wr, int wc, int fr, int fq) const {
        const int row0 = u.pm * BM + wr * 64 + fr, col0 = u.pn * BM + wc * 32 + 8 * fq;
#pragma unroll
        for (int ai = 0; ai < 2; ++ai)
#pragma unroll
            for (int m = 0; m < 4; ++m) { bf16_t* rowp = O + (size_t)(row0 + ai * HALF + m * 16) * ldc + col0;
#pragma unroll
                for (int bj = 0; bj < 2; ++bj) { const f32x4 v0 = acc[ai][bj][m][0], v1 = acc[ai][bj][m][1];
                    u32x4 w; w.x = cvt_pk_bf16(v0[0], v0[1]); w.y = cvt_pk_bf16(v0[2], v0[3]); w.z = cvt_pk_bf16(v1[0], v1[1]); w.w = cvt_pk_bf16(v1[2], v1[3]);
                    *(u32x4*)(rowp + bj * HALF) = w; } }
    }
};
template <class Epi, class Sched, bool ALIGN_EPI = false, bool SP2 = false>
__device__ __forceinline__ void gemm_phase(PG8_LAS unsigned char* lds, const Gemm g, const Sched& S, const Epi& E) {
    const int tid = threadIdx.x, wid = __builtin_amdgcn_readfirstlane(tid >> 6), lane = tid & 63, wr = wid >> 2, wc = wid & 3, fr = lane & 15, fq = lane >> 4;
    const int K = g.K, nt = K / BK;
    unsigned voffA[2], voffB[2];
#pragma unroll
    for (int i = 0; i < 2; ++i) { int R, C; stage_rc(tid * 16 + i * 8192, R, C); const int Rb = Epi::PERM ? ((R & ~31) + perm32(R & 31)) : R;
        voffA[i] = (unsigned)(R * K + C) * 2u; voffB[i] = (unsigned)(Rb * K + C) * 2u; }
    const size_t kstep = (size_t)(BK * 2);
    const size_t hstep = (size_t)HALF * K * 2;
    const size_t tstep = 2 * hstep;
    const unsigned ldsw = (unsigned)wid * 1024u;
    const int aoff = lds_byte(wr * 64 + fr, fq * 8), boff = lds_byte(wc * 32 + fr, fq * 8);
#define PG8_SA(b, h) (((b) * 2 + (h)) * HTB)
#define PG8_SB(b, h) ((4 + (b) * 2 + (h)) * HTB)
#define PG8_STAGE(bufoff, gbase, voff) do { _Pragma("unroll") for (int _i = 0; _i < 2; ++_i) \
        __builtin_amdgcn_global_load_lds((const unsigned*)((const char*)(gbase) + (voff)[_i]), (PG8_LAS unsigned*)(lds + (bufoff) + ldsw + _i * 8192), 16, 0, 0); } while (0)
#define PG8_LDA(dst, b, h) do { _Pragma("unroll") for (int m = 0; m < 4; ++m) _Pragma("unroll") for (int k = 0; k < 2; ++k) dst[m][k] = *(const PG8_LAS bf16x8*)(lds + PG8_SA(b, h) + aoff + m * 2048 + k * 1024); } while (0)
#define PG8_LDB(dst, b, h) do { _Pragma("unroll") for (int n = 0; n < 2; ++n) _Pragma("unroll") for (int k = 0; k < 2; ++k) dst[n][k] = *(const PG8_LAS bf16x8*)(lds + PG8_SB(b, h) + boff + n * 2048 + k * 1024); } while (0)
#define PG8_MMA(ai, bj, At, Bt) do { __builtin_amdgcn_s_setprio(1); _Pragma("unroll") for (int m = 0; m < 4; ++m) _Pragma("unroll") for (int n = 0; n < 2; ++n) _Pragma("unroll") for (int k = 0; k < 2; ++k) \
        acc[ai][bj][m][n] = __builtin_amdgcn_mfma_f32_16x16x32_bf16(Bt[n][k], At[m][k], acc[ai][bj][m][n], 0, 0, 0); __builtin_amdgcn_s_setprio(0); } while (0)
#define PG8_WAIT_V(n) asm volatile("s_waitcnt vmcnt(" #n ")" ::: "memory")
#define PG8_WAIT_L(n) asm volatile("s_waitcnt lgkmcnt(" #n ")" ::: "memory")
#define PG8_BAR __builtin_amdgcn_s_barrier()
#define PG8_SCHED __builtin_amdgcn_sched_barrier(0)
    Unit cur, nxt; int ui = 0;
    if (!S.next(0, cur)) return;
    f32x4 acc[2][2][4][2];
#pragma unroll
    for (int a = 0; a < 2; ++a)
#pragma unroll
        for (int b = 0; b < 2; ++b)
#pragma unroll
            for (int m = 0; m < 4; ++m)
#pragma unroll
                for (int n = 0; n < 2; ++n) acc[a][b][m][n] = (f32x4){0.f, 0.f, 0.f, 0.f};
    bf16x8 At[4][2], B0[2][2], B1[2][2];
    const char* cA = (const char*)g.A + (size_t)cur.pm * tstep; const char* cB = (const char*)g.Bt + (size_t)cur.pn * tstep;
    S.a_ready(cur);
    if constexpr (SP2) {
        PG8_STAGE(PG8_SB(0, 0), cB, voffB); PG8_STAGE(PG8_SB(0, 1), cB + hstep, voffB); PG8_STAGE(PG8_SA(0, 0), cA, voffA); PG8_STAGE(PG8_SA(0, 1), cA + hstep, voffA);
        if (wr == 1) PG8_BAR;
        PG8_WAIT_V(2); PG8_BAR;
        PG8_STAGE(PG8_SB(1, 0), cB + kstep, voffB); PG8_STAGE(PG8_SA(1, 0), cA + kstep, voffA); PG8_STAGE(PG8_SB(1, 1), cB + hstep + kstep, voffB);
        PG8_WAIT_V(6); PG8_BAR;
    } else {
        PG8_STAGE(PG8_SB(0, 0), cB, voffB); PG8_STAGE(PG8_SA(0, 0), cA, voffA); PG8_STAGE(PG8_SB(0, 1), cB + hstep, voffB); PG8_STAGE(PG8_SA(0, 1), cA + hstep, voffA);
        if (wr == 1) PG8_BAR;
        PG8_WAIT_V(4); PG8_BAR;
        PG8_STAGE(PG8_SB(1, 0), cB + kstep, voffB); PG8_STAGE(PG8_SA(1, 0), cA + kstep, voffA); PG8_STAGE(PG8_SB(1, 1), cB + hstep + kstep, voffB);
        PG8_WAIT_V(6); PG8_BAR;
    }
    for (;;) {
        const bool has_next = S.next(ui + 1, nxt);
        const char* nA = has_next ? (const char*)g.A + (size_t)nxt.pm * tstep : cA; const char* nB = has_next ? (const char*)g.Bt + (size_t)nxt.pn * tstep : cB;
        for (int t = 0; t < nt; t += 2) {
            const bool last = (t == nt - 2);
            const char* a1 = cA + (size_t)(t + 1) * kstep;
            const char* a2 = last ? nA : cA + (size_t)(t + 2) * kstep; const char* b2 = last ? nB : cB + (size_t)(t + 2) * kstep;
            const char* a3 = a2 + kstep; const char* b3 = b2 + kstep;
            if (last && has_next) S.a_ready(nxt);
            if constexpr (SP2) {
            PG8_LDB(B0, 0, 0); PG8_LDB(B1, 0, 1); PG8_SCHED; PG8_LDA(At, 0, 0); PG8_STAGE(PG8_SA(1, 1), a1 + hstep, voffA);
            PG8_WAIT_V(8); PG8_WAIT_L(0); PG8_BAR; PG8_MMA(0, 0, At, B0); PG8_MMA(0, 1, At, B1); PG8_BAR; PG8_SCHED;
            PG8_LDA(At, 0, 1); PG8_STAGE(PG8_SB(0, 0), b2, voffB); PG8_STAGE(PG8_SB(0, 1), b2 + hstep, voffB); PG8_STAGE(PG8_SA(0, 0), a2, voffA);
            PG8_WAIT_V(8); PG8_WAIT_L(0); PG8_BAR; PG8_MMA(1, 0, At, B0); PG8_MMA(1, 1, At, B1); PG8_BAR; PG8_SCHED;
            PG8_LDB(B0, 1, 0); PG8_LDB(B1, 1, 1); PG8_SCHED; PG8_LDA(At, 1, 0); PG8_STAGE(PG8_SA(0, 1), a2 + hstep, voffA);
            PG8_WAIT_V(8); PG8_WAIT_L(0); PG8_BAR; PG8_MMA(0, 0, At, B0); PG8_MMA(0, 1, At, B1); PG8_BAR; PG8_SCHED;
            PG8_LDA(At, 1, 1); PG8_STAGE(PG8_SB(1, 0), b3, voffB); PG8_STAGE(PG8_SB(1, 1), b3 + hstep, voffB); PG8_STAGE(PG8_SA(1, 0), a3, voffA);
            PG8_WAIT_V(8); PG8_WAIT_L(0); PG8_BAR; PG8_MMA(1, 0, At, B0); PG8_MMA(1, 1, At, B1); PG8_BAR; PG8_SCHED;
            } else {
            PG8_LDB(B0, 0, 0); PG8_SCHED; PG8_LDA(At, 0, 0); PG8_STAGE(PG8_SA(1, 1), a1 + hstep, voffA);
            PG8_WAIT_L(8); PG8_BAR; PG8_WAIT_L(0); PG8_MMA(0, 0, At, B0); PG8_BAR; PG8_SCHED;
            PG8_LDB(B1, 0, 1); PG8_STAGE(PG8_SB(0, 0), b2, voffB);
            PG8_BAR; PG8_WAIT_L(0); PG8_MMA(0, 1, At, B1); PG8_BAR;
            PG8_LDA(At, 0, 1); PG8_STAGE(PG8_SA(0, 0), a2, voffA);
            PG8_BAR; PG8_WAIT_L(0); PG8_MMA(1, 0, At, B0); PG8_BAR; PG8_SCHED;
            PG8_STAGE(PG8_SB(0, 1), b2 + hstep, voffB);
            PG8_WAIT_V(6); PG8_BAR; PG8_MMA(1, 1, At, B1); PG8_BAR;
            PG8_LDB(B0, 1, 0); PG8_SCHED; PG8_LDA(At, 1, 0); PG8_STAGE(PG8_SA(0, 1), a2 + hstep, voffA);
            PG8_WAIT_L(8); PG8_BAR; PG8_WAIT_L(0); PG8_MMA(0, 0, At, B0); PG8_BAR; PG8_SCHED;
            PG8_LDB(B1, 1, 1); PG8_STAGE(PG8_SB(1, 0), b3, voffB);
            PG8_BAR; PG8_WAIT_L(0); PG8_MMA(0, 1, At, B1); PG8_BAR;
            PG8_LDA(At, 1, 1); PG8_STAGE(PG8_SA(1, 0), a3, voffA);
            PG8_BAR; PG8_WAIT_L(0); PG8_MMA(1, 0, At, B0); PG8_BAR; PG8_SCHED;
            PG8_STAGE(PG8_SB(1, 1), b3 + hstep, voffB);
            PG8_WAIT_V(6); PG8_BAR; PG8_MMA(1, 1, At, B1); PG8_BAR;
            }
        }
        if constexpr (ALIGN_EPI) { if (wr == 0) PG8_BAR; }
        if constexpr (!Epi::AFTER_DRAIN) { E(acc, cur, wr, wc, fr, fq); S.done(cur); }
        if (!has_next) break;
#pragma unroll
        for (int a = 0; a < 2; ++a)
#pragma unroll
            for (int b = 0; b < 2; ++b)
#pragma unroll
                for (int m = 0; m < 4; ++m)
#pragma unroll
                    for (int n = 0; n < 2; ++n) acc[a][b][m][n] = (f32x4){0.f, 0.f, 0.f, 0.f};
        cur = nxt; cA = nA; cB = nB; ++ui;
        if constexpr (ALIGN_EPI) { if (wr == 1) PG8_BAR; }
    }
    PG8_WAIT_V(0);
    if constexpr (!ALIGN_EPI) { if (wr == 0) PG8_BAR; }
    PG8_BAR;
    if constexpr (Epi::AFTER_DRAIN) { E.fused(acc, cur, wr, wc, fr, fq, lds, wid, lane); S.done(cur); }
#undef PG8_SA
#undef PG8_SB
#undef PG8_STAGE
#undef PG8_LDA
#undef PG8_LDB
#undef PG8_MMA
#undef PG8_WAIT_V
#undef PG8_WAIT_L
#undef PG8_BAR
#undef PG8_SCHED
}
}

constexpr int NWAVES = 8;
constexpr int NB = 32, SEQ = 2048, DM = 1024, MROWS = NB * SEQ;
constexpr int NPROJ = 3840;
constexpr int C_ZA = 1536, C_QB = 2048, C_ZB = 2560, C_IQ = 3072, C_CKV = 3584, C_IK = 3712;
constexpr float EPSF = 1e-6f;
constexpr float LOG2E = 1.4426950408889634f;
__host__ __device__ __forceinline__ int proj_src_col(int n) {
    if (n < 2048) return n;
    if (n < 2560) return n - 2048 + 2056;
    if (n < 3072) return n - 2560 + 2696;
    if (n < 3584) return n - 3072 + 3208;
    if (n < 3712) return n - 3584 + 2568;
    if (n < 3776) return n - 3712 + 3720;
    if (n < 3784) return n - 3776 + 2048;
    if (n < 3792) return n;
    return -1;
}
__device__ const unsigned char T5_BUCKET[128] = {0,1,2,3,4,5,6,7,8,9,10,11,12,13,14,15,16,16,16,17,17,18,18,18,19,19,19,20,20,20,20,21,21,21,21,22,22,22,22,22,23,23,23,23,23,23,24,24,24,24,24,24,25,25,25,25,25,25,25,26,26,26,26,26,26,26,26,27,27,27,27,27,27,27,27,27,27,28,28,28,28,28,28,28,28,28,28,29,29,29,29,29,29,29,29,29,29,29,29,30,30,30,30,30,30,30,30,30,30,30,30,30,30,31,31,31,31,31,31,31,31,31,31,31,31,31,31,31};

constexpr size_t MiB = 1u << 20;
constexpr size_t WS_CTL = 0, CTL_ZERO_BYTES = 1 * MiB;
constexpr size_t WS_MOD = 1 * MiB;
constexpr size_t WS_WUV = 2 * MiB;
constexpr size_t WS_WOUT = 3 * MiB;
constexpr size_t WS_WIN = 5 * MiB;
constexpr size_t WS_KVSS = 13 * MiB;
constexpr size_t WS_AUX = 14 * MiB;
constexpr size_t WS_XN = 32 * MiB;
constexpr size_t WS_PROJ = 160 * MiB;
constexpr size_t WS_SCR = 640 * MiB;
constexpr size_t WS_END = 768 * MiB;
constexpr int CW_TMO = 0, CW_QUEUE = 64, CW_BAR = 4096;

constexpr int LDS_BYTES = 163840;
constexpr int MISC_OFF = LDS_BYTES - 256;
constexpr int SCRATCH_BYTES = MISC_OFF;

#define GAS __attribute__((address_space(1)))
#define LAS __attribute__((address_space(3)))
typedef unsigned short bf16;
typedef unsigned v4u __attribute__((ext_vector_type(4)));
typedef unsigned v2u __attribute__((ext_vector_type(2)));
typedef float f32x4 __attribute__((ext_vector_type(4)));
typedef float f32x16 __attribute__((ext_vector_type(16)));
typedef short bf16x8 __attribute__((ext_vector_type(8)));
typedef GAS unsigned gu32;
#define RLX_AGENT __ATOMIC_RELAXED, __HIP_MEMORY_SCOPE_AGENT
#define LDS_WAIT() asm volatile("s_waitcnt lgkmcnt(0)" ::: "memory")
#define MFMA32(a, b, c) __builtin_amdgcn_mfma_f32_32x32x16_bf16((a), (b), (c), 0, 0, 0)
#define MFMA16F(a, b, c) __builtin_amdgcn_mfma_f32_16x16x4f32((a), (b), (c), 0, 0, 0)
__device__ __forceinline__ unsigned f2bf(float f) { unsigned u = __builtin_bit_cast(unsigned, f); return (u + 0x7fffu + ((u >> 16) & 1u)) >> 16; }
__device__ __forceinline__ unsigned pk2(float lo, float hi) { return f2bf(lo) | (f2bf(hi) << 16); }
__device__ __forceinline__ float bf2f(unsigned short b) { return __builtin_bit_cast(float, ((unsigned)b) << 16); }
__device__ __forceinline__ float bflo(unsigned w) { return __builtin_bit_cast(float, w << 16); }
__device__ __forceinline__ float bfhi(unsigned w) { return __builtin_bit_cast(float, w & 0xffff0000u); }
__device__ __forceinline__ float rcpf_(float x) { return __builtin_amdgcn_rcpf(x); }
__device__ __forceinline__ float rsqf_(float x) { return __builtin_amdgcn_rsqf(x); }
__device__ __forceinline__ float siluf(float x) { return x * __builtin_amdgcn_rcpf(1.0f + __builtin_amdgcn_exp2f(-1.4426950408889634f * x)); }
__device__ __forceinline__ float wave_sum(float v) {
#pragma unroll
    for (int o = 1; o < 64; o <<= 1) v += __shfl_xor(v, o);
    return v;
}

__device__ __forceinline__ int wave_sum_i(int v) {
    v += __builtin_amdgcn_update_dpp(0, v, 0x111, 0xf, 0xf, false);
    v += __builtin_amdgcn_update_dpp(0, v, 0x112, 0xf, 0xf, false);
    v += __builtin_amdgcn_update_dpp(0, v, 0x114, 0xf, 0xe, false);
    v += __builtin_amdgcn_update_dpp(0, v, 0x118, 0xf, 0xc, false);
    v += __builtin_amdgcn_update_dpp(0, v, 0x142, 0xa, 0xf, false);
    v += __builtin_amdgcn_update_dpp(0, v, 0x143, 0xc, 0xf, false);
    return __builtin_amdgcn_readlane(v, 63);
}
__device__ __forceinline__ float wave_max(float v) {
    const int ninf = (int)0xff800000u;
#define WM_STEP(ctrl, rm, bm) v = fmaxf(v, __builtin_bit_cast(float, __builtin_amdgcn_update_dpp(ninf, __builtin_bit_cast(int, v), ctrl, rm, bm, false)))
    WM_STEP(0x111, 0xf, 0xf); WM_STEP(0x112, 0xf, 0xf); WM_STEP(0x114, 0xf, 0xe); WM_STEP(0x118, 0xf, 0xc); WM_STEP(0x142, 0xa, 0xf); WM_STEP(0x143, 0xc, 0xf);
#undef WM_STEP
    return __builtin_bit_cast(float, __builtin_amdgcn_readlane(__builtin_bit_cast(int, v), 63));
}
#define XB_TMO      128
#define XB_XCNT(j)  (256  + 64 * (j))
#define XB_XSUB(j)  (1280 + 64 * (j))
#define XB_XGEN(j)  (2304 + 64 * (j))
#define XB_TOP      3328
#define XB_TOPGEN   3392
#define XCD_BAR_WORDS 3456
#define XB_SPIN_CAP (1u << 18)

__device__ __forceinline__ unsigned xb_ld(unsigned* p)              { return __hip_atomic_load(p, __ATOMIC_RELAXED, __HIP_MEMORY_SCOPE_AGENT); }
__device__ __forceinline__ unsigned xb_add(unsigned* p, unsigned v) { return __hip_atomic_fetch_add(p, v, __ATOMIC_RELAXED, __HIP_MEMORY_SCOPE_AGENT); }
__device__ __forceinline__ unsigned xb_xcc_id() { return (unsigned)__builtin_amdgcn_s_getreg((3 << 11) | 20) & 0xFu; }
#define XB_SPIN(cond, bar) do { unsigned _sp = 0; while (cond) { __builtin_amdgcn_s_sleep(1); \
    if ((++_sp & 255u) == 0u) { if (xb_ld(&(bar)[XB_TMO])) break; if (_sp > XB_SPIN_CAP) { atomicAdd(&(bar)[XB_TMO], 1u); break; } } } } while (0)

struct XcdBarrier {
    unsigned* bar; unsigned x;
    volatile LAS unsigned* st;
};

__device__ __forceinline__ XcdBarrier xcd_barrier_post(unsigned* bar, volatile LAS unsigned* st) {
    XcdBarrier b; b.bar = bar; b.x = xb_xcc_id(); b.st = st;
    if (threadIdx.x == 0) (void)xb_add(&bar[XB_XCNT(b.x)], 1u);
    return b;
}
__device__ __forceinline__ void xcd_barrier_complete(unsigned* bar, unsigned x, unsigned& nloc, unsigned& nx) {
    const unsigned G = gridDim.x * gridDim.y * gridDim.z;
    unsigned sum, cnt, mine, sp = 0u;
    for (;;) {
        sum = 0u; cnt = 0u; mine = 0u;
#pragma unroll
        for (unsigned j = 0; j < 16; ++j) { const unsigned c = xb_ld(&bar[XB_XCNT(j)]); sum += c; cnt += (c > 0u) ? 1u : 0u; mine = (j == x) ? c : mine; }
        if (sum == G) break;
        __builtin_amdgcn_s_sleep(1);
        if ((++sp & 255u) == 0u) { if (xb_ld(&bar[XB_TMO])) break; if (sp > XB_SPIN_CAP) { atomicAdd(&bar[XB_TMO], 1u); break; } }
    }
    nloc = mine > 0u ? mine : 1u; nx = cnt > 0u ? cnt : 1u;
}

__device__ __forceinline__ void xcd_barrier(const XcdBarrier& b) {
    asm volatile("s_waitcnt vmcnt(0)" ::: "memory");
    __syncthreads();
    if (threadIdx.x == 0) {
        unsigned* bar = b.bar;
        __builtin_amdgcn_s_waitcnt(0);
        unsigned nloc = b.st[0], nx = b.st[1];
        if (nloc == 0u) { xcd_barrier_complete(bar, b.x, nloc, nx); b.st[0] = nloc; b.st[1] = nx; }
        const unsigned old = xb_add(&bar[XB_XSUB(b.x)], 1u);
        const unsigned gen = old / nloc;
        if (old + 1u == (gen + 1u) * nloc) {
            __builtin_amdgcn_fence(__ATOMIC_RELEASE, "agent");
            asm volatile("s_waitcnt vmcnt(0)" ::: "memory");
            const unsigned og = xb_add(&bar[XB_TOP], 1u);
            const unsigned tg = og / nx;
            if (og + 1u == (tg + 1u) * nx) xb_add(&bar[XB_TOPGEN], 1u);
            else XB_SPIN(xb_ld(&bar[XB_TOPGEN]) == tg, bar);
            __builtin_amdgcn_fence(__ATOMIC_ACQUIRE, "agent");
            xb_add(&bar[XB_XGEN(b.x)], 1u);
            asm volatile("s_waitcnt vmcnt(0)" ::: "memory");
        } else {
            XB_SPIN(xb_ld(&bar[XB_XGEN(b.x)]) == gen, bar);
            __builtin_amdgcn_fence(__ATOMIC_ACQUIRE, "agent");
            asm volatile("s_waitcnt vmcnt(0)" ::: "memory");
        }
    }
    __syncthreads();
}

struct Frame {
    LAS unsigned char* lds;
    volatile LAS unsigned* MISC;
    gu32* ctl;
    int tid, lane, wave;
    int vcu, G;
    unsigned char* ws;
};
#define P_X        (args.in[0])
#define P_C        (args.in[1])
#define P_WADA     (args.in[2])
#define P_BADA     (args.in[3])
#define P_GPRE     (args.in[4])
#define P_WIN      (args.in[5])
#define P_CONVW    (args.in[6])
#define P_ALOG     (args.in[7])
#define P_DTB      (args.in[8])
#define P_GGDN     (args.in[9])
#define P_GKV      (args.in[10])
#define P_WUV      (args.in[11])
#define P_RELB     (args.in[12])
#define P_WOUT     (args.in[13])
#define P_GPOST    (args.in[14])
#define P_OUT      (args.out)
#define W_MOD      ((float*)(F.ws + WS_MOD))
#define W_WUVT     ((bf16*)(F.ws + WS_WUV))
#define W_WOUTT    ((bf16*)(F.ws + WS_WOUT))
#define W_WINT     ((bf16*)(F.ws + WS_WIN))
#define W_KVSS     ((float*)(F.ws + WS_KVSS))
#define W_AUX      ((float*)(F.ws + WS_AUX))
#define W_XN       ((bf16*)(F.ws + WS_XN))
#define W_OAB      ((bf16*)(F.ws + WS_XN))
#define W_PROJ     ((bf16*)(F.ws + WS_PROJ))
#define W_MIX      ((bf16*)(F.ws + WS_PROJ))
#define W_SCR      ((float*)(F.ws + WS_SCR))
struct Args { const float* in[15]; float* out; unsigned char* ws; int ph_lo, ph_hi, li, pad; };

template <class CM>
__device__ __forceinline__ void transpose_item(const float* W, int ldw, bf16* WT, int K, int k0, int n0, LAS float* scr, int lane, CM cm) {
    const int nn = lane & 31, sc = cm(n0 + nn);
#pragma unroll 8
    for (int i = 0; i < 32; ++i) { const int kk = 2 * i + (lane >> 5); scr[kk * 33 + nn] = sc >= 0 ? W[(size_t)(k0 + kk) * ldw + sc] : 0.f; }
    LDS_WAIT(); asm volatile("" ::: "memory");
    const int c = lane & 7;
#pragma unroll
    for (int j = 0; j < 4; ++j) { const int n = (lane >> 3) + 8 * j; const LAS float* s = scr + (8 * c) * 33 + n;
        v4u o; o.x = pk2(s[0 * 33], s[1 * 33]); o.y = pk2(s[2 * 33], s[3 * 33]); o.z = pk2(s[4 * 33], s[5 * 33]); o.w = pk2(s[6 * 33], s[7 * 33]);
        *(GAS v4u*)(WT + (size_t)(n0 + n) * K + k0 + 8 * c) = o; }
    LDS_WAIT(); asm volatile("" ::: "memory");
}
struct CmIdent { __device__ __forceinline__ int operator()(int n) const { return n; } };
struct CmProj { __device__ __forceinline__ int operator()(int n) const { return proj_src_col(n); } };

__device__ __forceinline__ void p0_prologue(Frame& F, const Args& args) {
    LAS float* scr = (LAS float*)(F.lds + F.wave * 16384);
    const int gw = F.vcu * NWAVES + F.wave, NGW = F.G * NWAVES;
    constexpr int I_IN = 16 * (NPROJ / 32), I_OUT = 16 * 32, I_UV = 4 * 2 * 4;
    for (int it = gw; it < I_IN + I_OUT + I_UV; it += NGW) {
        int r = it;
        if (r < I_IN) { const int kb = r / (NPROJ / 32), nb = r % (NPROJ / 32); transpose_item(P_WIN, 3792, W_WINT, 1024, 64 * kb, 32 * nb, scr, F.lane, CmProj()); continue; }
        r -= I_IN;
        if (r < I_OUT) { const int kb = r / 32, nb = r % 32; transpose_item(P_WOUT, 1024, W_WOUTT, 1024, 64 * kb, 32 * nb, scr, F.lane, CmIdent()); continue; }
        r -= I_OUT;
        { const int hd = r >> 3, kb = (r >> 2) & 1, nb = r & 3; transpose_item(P_WUV + (size_t)hd * 16384, 128, W_WUVT + (size_t)hd * 16384, 128, 64 * kb, 32 * nb, scr, F.lane, CmIdent()); }
    }
    __syncthreads();
    if (F.vcu < 192) {
        LAS float* SC = (LAS float*)F.lds;
        for (int e = F.tid; e < NB * 1024; e += NWAVES * 64) { const int b = e >> 10, k = e & 1023; SC[k * 33 + b] = siluf(P_C[e]); }
        __syncthreads();
        const int col = F.tid & 15, ks = F.tid >> 4, n = F.vcu * 16 + col;
        float acc[32];
#pragma unroll
        for (int b = 0; b < 32; ++b) acc[b] = 0.f;
        for (int kk = 0; kk < 32; ++kk) { const int k = ks * 32 + kk; const float w = P_WADA[(size_t)k * 3072 + n];
#pragma unroll
            for (int b = 0; b < 32; ++b) acc[b] += SC[k * 33 + b] * w; }
        __syncthreads();
        LAS float* RED = (LAS float*)F.lds;
#pragma unroll
        for (int b = 0; b < 32; ++b) RED[(ks * 32 + b) * 16 + col] = acc[b];
        __syncthreads();
        { const int b = F.tid >> 4; float s = 0.f;
            for (int k2 = 0; k2 < 32; ++k2) s += RED[(k2 * 32 + b) * 16 + col];
            W_MOD[b * 3072 + n] = s + P_BADA[n]; }
        __syncthreads();
    }
}

__device__ __forceinline__ void p1_norm(Frame& F, const Args& args) {
    const int gw = F.vcu * NWAVES + F.wave, NGW = F.G * NWAVES;
    for (int m = 2 * gw; m < MROWS; m += 2 * NGW) {
        const int b = m >> 11;
        const GAS f32x4* xr = (const GAS f32x4*)(P_X + (size_t)m * DM) + F.lane;
        f32x4 v[2][4]; float ss[2] = {0.f, 0.f};
#pragma unroll
        for (int q = 0; q < 2; ++q)
#pragma unroll
            for (int j = 0; j < 4; ++j) v[q][j] = xr[q * 256 + 64 * j];
#pragma unroll
        for (int q = 0; q < 2; ++q)
#pragma unroll
            for (int j = 0; j < 4; ++j) ss[q] += (v[q][j].x * v[q][j].x + v[q][j].y * v[q][j].y) + (v[q][j].z * v[q][j].z + v[q][j].w * v[q][j].w);
        const float rstd0 = rsqf_(wave_sum(ss[0]) * (1.0f / DM) + EPSF), rstd1 = rsqf_(wave_sum(ss[1]) * (1.0f / DM) + EPSF);
        const float* mb = W_MOD + b * 3072;
        GAS unsigned long long* o8 = (GAS unsigned long long*)(W_XN + (size_t)m * DM) + F.lane;
#pragma unroll
        for (int j = 0; j < 4; ++j) { const int col = F.lane * 4 + 256 * j;
            const f32x4 g = *(const f32x4*)(P_GPRE + col), sh = *(const f32x4*)(mb + col), sc = *(const f32x4*)(mb + 1024 + col);
            const f32x4 gs = g * (sc + 1.0f);
            const f32x4 o0 = v[0][j] * rstd0 * gs + sh, o1 = v[1][j] * rstd1 * gs + sh;
            o8[64 * j] = (unsigned long long)pg8::cvt_pk_bf16(o0.x, o0.y) | ((unsigned long long)pg8::cvt_pk_bf16(o0.z, o0.w) << 32);
            o8[256 + 64 * j] = (unsigned long long)pg8::cvt_pk_bf16(o1.x, o1.y) | ((unsigned long long)pg8::cvt_pk_bf16(o1.z, o1.w) << 32); }
    }
}

__device__ __forceinline__ void p5_final(Frame& F, const Args& args) {
    const int gw = F.vcu * NWAVES + F.wave, NGW = F.G * NWAVES;
    for (int m = 2 * gw; m < MROWS; m += 2 * NGW) {
        const int b = m >> 11;
        const GAS v2u* mr = (const GAS v2u*)(W_MIX + (size_t)m * DM) + F.lane;
        const GAS f32x4* xr = (const GAS f32x4*)(P_X + (size_t)m * DM) + F.lane;
        GAS f32x4* orow = (GAS f32x4*)(P_OUT + (size_t)m * DM) + F.lane;
        v2u w[2][4]; f32x4 xv[2][4];
#pragma unroll
        for (int q = 0; q < 2; ++q)
#pragma unroll
            for (int j = 0; j < 4; ++j) { w[q][j] = mr[q * 256 + 64 * j]; xv[q][j] = xr[q * 256 + 64 * j]; }
        f32x4 v[2][4]; float ss[2] = {0.f, 0.f};
#pragma unroll
        for (int q = 0; q < 2; ++q)
#pragma unroll
            for (int j = 0; j < 4; ++j) { v[q][j].x = bflo(w[q][j].x); v[q][j].y = bfhi(w[q][j].x); v[q][j].z = bflo(w[q][j].y); v[q][j].w = bfhi(w[q][j].y);
                ss[q] += (v[q][j].x * v[q][j].x + v[q][j].y * v[q][j].y) + (v[q][j].z * v[q][j].z + v[q][j].w * v[q][j].w); }
        const float rstd0 = rsqf_(wave_sum(ss[0]) * (1.0f / DM) + EPSF), rstd1 = rsqf_(wave_sum(ss[1]) * (1.0f / DM) + EPSF);
        const float* gt = W_MOD + b * 3072 + 2048;
#pragma unroll
        for (int j = 0; j < 4; ++j) { const int col = F.lane * 4 + 256 * j;
            const f32x4 g = *(const f32x4*)(P_GPOST + col), ga = *(const f32x4*)(gt + col);
            const f32x4 gg = g * ga;
            orow[64 * j] = xv[0][j] + gg * (v[0][j] * rstd0);
            orow[256 + 64 * j] = xv[1][j] + gg * (v[1][j] * rstd1); }
    }
}

__device__ __forceinline__ unsigned cvtpk(float lo, float hi) { return pg8::cvt_pk_bf16(lo, hi); }
__device__ __forceinline__ v2u pack4(float a, float b, float c, float d) { v2u r; r.x = cvtpk(a, b); r.y = cvtpk(c, d); return r; }
__device__ __forceinline__ bf16x8 pack8(float a, float b, float c, float d, float e, float f, float g, float h) { v4u r; r.x = cvtpk(a, b); r.y = cvtpk(c, d); r.z = cvtpk(e, f); r.w = cvtpk(g, h); return __builtin_bit_cast(bf16x8, r); }
__device__ __forceinline__ bf16x8 lds16(const LAS unsigned char* p) { return *(const LAS bf16x8*)p; }
__device__ __forceinline__ bf16x8 lds8x2(const LAS unsigned char* p) { const v2u lo = *(const LAS v2u*)p, hi = *(const LAS v2u*)(p + 16); v4u r; r.x = lo.x; r.y = lo.y; r.z = hi.x; r.w = hi.y; return __builtin_bit_cast(bf16x8, r); }
template <int S> __device__ __forceinline__ bf16x8 acc_frag(const f32x16& a) { return pack8(a[8 * S + 0], a[8 * S + 1], a[8 * S + 2], a[8 * S + 3], a[8 * S + 4], a[8 * S + 5], a[8 * S + 6], a[8 * S + 7]); }

__device__ __forceinline__ float row16_sum(float v) {
#define R16_STEP(ctrl) v += __builtin_bit_cast(float, __builtin_amdgcn_update_dpp(0, __builtin_bit_cast(int, v), ctrl, 0xf, 0xf, false))
    R16_STEP(0x121); R16_STEP(0x122); R16_STEP(0x124); R16_STEP(0x128);
#undef R16_STEP
    return v;
}

__device__ __forceinline__ void gdn_unit(Frame& F, const Args& args, const int b, const int h) {
    LAS unsigned char* const L = F.lds;
    const int tid = F.tid, lane = F.lane, wv = F.wave, l31_0 = lane & 31, hh_0 = lane >> 5;
    int tidv = tid, lanev = lane;
    constexpr int P128 = 272, P64 = 144;
    constexpr int O_KH = 0, O_QH = O_KH + 17408, O_KGT = O_QH + 17408, O_VBT = O_KGT + 18432, O_KBGT = O_VBT + 18432, O_LM = O_KBGT + 18432, O_T = O_LM + 17408,
                  O_AT = O_T + 17408, O_CW = O_AT + 9216, O_SM = O_CW + 6144, O_PSO = O_SM + 2560, O_OF = O_PSO + 2048, O_END = O_OF + 17408;
    static_assert(O_END <= SCRATCH_BYTES, "gdn LDS map");
    constexpr int O_W = O_LM, O_VNT = O_VBT;
    LAS float* const SMb = (LAS float*)(L + O_SM);
    LAS float* const LM = (LAS float*)(L + O_LM);
    LAS float* const TT = (LAS float*)(L + O_T);
    LAS float* const CW = (LAS float*)(L + O_CW);
    LAS float* const PSO = (LAS float*)(L + O_PSO);
    const int mt = wv >> 2, nt = wv & 3;
    f32x16 S[4];
#pragma unroll
    for (int k = 0; k < 4; ++k)
#pragma unroll
        for (int r = 0; r < 16; ++r) S[k][r] = 0.f;
    const float alog_e = __expf(P_ALOG[h]), dtb = P_DTB[h];
#define GDN_GATES(n_) do { LAS float* _sm = SMb + ((n_) & 1) * 320; const float* _ap = W_AUX + (size_t)(b * SEQ + (n_) * 64 + lanev) * 16; \
        const float _bb = _ap[h], _aa = _ap[4 + h]; const float _beta = rcpf_(1.0f + __expf(-_bb)); const float _xs = _aa + dtb; \
        const float _sp = _xs > 20.f ? _xs : log1pf(__expf(_xs)); float _gc = -alog_e * _sp; \
        _Pragma("unroll") for (int _o = 1; _o < 64; _o <<= 1) { const float _t = __shfl_up(_gc, _o); if (lanev >= _o) _gc += _t; } \
        const float _gl = __shfl(_gc, 63); _sm[lanev] = _gc; _sm[64 + lanev] = _beta; _sm[128 + lanev] = __expf(_gc); _sm[192 + lanev] = __expf(_gl - _gc); \
        if (lanev == 0) _sm[256] = __expf(_gl); } while (0)
    if (wv == 6) GDN_GATES(0);
    for (int e = tidv; e < 3 * 4 * 128; e += NWAVES * 64) { const int ts_ = e >> 9, tap = (e >> 7) & 3, ch = e & 127; CW[e] = P_CONVW[tap * 1536 + ts_ * 512 + h * 128 + ch]; }
    const int ts = tid >> 8;
    int cgv = tid & 15, tpv = (tid >> 4) & 15;
#define GDN_ROWS(dst_, n_, chan_) do { const bf16* _src = W_PROJ + (size_t)(b * SEQ + (n_) * 64 + 4 * tpv - 3) * NPROJ + (chan_); \
        _Pragma("unroll") for (int _i = 0; _i < 7; ++_i) { v4u _z; _z.x = 0u; _z.y = 0u; _z.z = 0u; _z.w = 0u; dst_[_i] = _z; \
            if ((n_) > 0 || 4 * tpv - 3 + _i >= 0) dst_[_i] = *(const GAS v4u*)(_src + (size_t)_i * NPROJ); } } while (0)
#define GDN_OUT(rowb_) do { const int _tok = tidv >> 3, _dv0 = (tidv & 7) * 16; const size_t _row = (size_t)(rowb_) + _tok; \
        const LAS v4u* _op = (const LAS v4u*)(L + O_OF + _tok * P128 + _dv0 * 2); const v4u _o0 = _op[0], _o1 = _op[1]; \
        const LAS f32x4* _pp = (const LAS f32x4*)(PSO + _tok * 8); const f32x4 _a = _pp[0], _c = _pp[1]; \
        const float _rstd = rsqf_((((_a.x + _a.y) + (_a.z + _a.w)) + ((_c.x + _c.y) + (_c.z + _c.w))) * (1.0f / 128.0f) + EPSF); \
        const bf16* _zp = W_PROJ + _row * NPROJ + C_ZA + h * 128 + _dv0; const v4u _z0 = *(const GAS v4u*)_zp, _z1 = *(const GAS v4u*)(_zp + 8); \
        const unsigned _ow[8] = {_o0.x, _o0.y, _o0.z, _o0.w, _o1.x, _o1.y, _o1.z, _o1.w}, _zw[8] = {_z0.x, _z0.y, _z0.z, _z0.w, _z1.x, _z1.y, _z1.z, _z1.w}; unsigned _rw[8]; \
        _Pragma("unroll") for (int _k = 0; _k < 4; ++_k) { const f32x4 _g = *(const f32x4*)(P_GGDN + _dv0 + 4 * _k); \
            _rw[2 * _k] = cvtpk(bflo(_ow[2 * _k]) * _rstd * _g.x * siluf(bflo(_zw[2 * _k])), bfhi(_ow[2 * _k]) * _rstd * _g.y * siluf(bfhi(_zw[2 * _k]))); \
            _rw[2 * _k + 1] = cvtpk(bflo(_ow[2 * _k + 1]) * _rstd * _g.z * siluf(bflo(_zw[2 * _k + 1])), bfhi(_ow[2 * _k + 1]) * _rstd * _g.w * siluf(bfhi(_zw[2 * _k + 1]))); } \
        bf16* _dst = W_OAB + _row * DM + h * 128 + _dv0; v4u _w0, _w1; _w0.x = _rw[0]; _w0.y = _rw[1]; _w0.z = _rw[2]; _w0.w = _rw[3]; _w1.x = _rw[4]; _w1.y = _rw[5]; _w1.z = _rw[6]; _w1.w = _rw[7]; \
        *(GAS v4u*)_dst = _w0; *(GAS v4u*)(_dst + 8) = _w1; } while (0)
    __syncthreads();

    unsigned pf_sink = 0u;
    for (int n = 0; n < 32; ++n) {
        const int rowbase = b * SEQ + n * 64;
        LAS float* const SMf = SMb + (n & 1) * 320;
        tidv = tid; lanev = lane; cgv = tid & 15; tpv = (tid >> 4) & 15;
        asm volatile("" : "+v"(tidv), "+v"(lanev), "+v"(cgv), "+v"(tpv));
        int l31 = lanev & 31, hh = lanev >> 5, cg = cgv, tp = tpv;
        if (wv == 6 && n + 1 < 32) GDN_GATES(n + 1);
        float val[4][8];
#define GDN_CONV(rows_, tsel_) do { \
            _Pragma("unroll") for (int _j = 0; _j < 4; ++_j) _Pragma("unroll") for (int _e = 0; _e < 8; ++_e) val[_j][_e] = 0.f; \
            _Pragma("unroll") for (int _tap = 0; _tap < 4; ++_tap) { const LAS f32x4* _cp = (const LAS f32x4*)(CW + ((tsel_) * 4 + _tap) * 128 + cg * 8); const f32x4 _c0 = _cp[0], _c1 = _cp[1]; \
                const float _cw[8] = {_c0.x, _c0.y, _c0.z, _c0.w, _c1.x, _c1.y, _c1.z, _c1.w}; \
                _Pragma("unroll") for (int _j = 0; _j < 4; ++_j) { const v4u _raw = rows_[_j + _tap]; \
                    const float _in[8] = {bflo(_raw.x), bfhi(_raw.x), bflo(_raw.y), bfhi(_raw.y), bflo(_raw.z), bfhi(_raw.z), bflo(_raw.w), bfhi(_raw.w)}; \
                    _Pragma("unroll") for (int _e = 0; _e < 8; ++_e) val[_j][_e] += _in[_e] * _cw[_e]; } } \
            _Pragma("unroll") for (int _j = 0; _j < 4; ++_j) _Pragma("unroll") for (int _e = 0; _e < 8; ++_e) val[_j][_e] = siluf(val[_j][_e]); } while (0)
        v4u rq[7], rv[7];
        GDN_ROWS(rq, n, ts * 512 + h * 128 + cgv * 8);
        if (wv < 4) GDN_ROWS(rv, n, 1024 + h * 128 + cgv * 8);
        if (wv == 7 && n + 1 < 32) {
#pragma unroll
            for (int i = 0; i < 9; ++i) { const int idx = i * 64 + lanev; const int rr = idx >> 3, ln = idx & 7;
                if (idx < 67 * 8) { const bf16* pt = W_PROJ + (size_t)(rowbase + 61 + rr) * NPROJ + (ln >> 1) * 512 + h * 128 + (ln & 1) * 64;
                    asm volatile("global_load_dword %0, %1, off" : "+v"(pf_sink) : "v"(pt) : "memory"); } }
        }
        {
            GDN_CONV(rq, ts);
#pragma unroll
            for (int j = 0; j < 4; ++j) { float ss = 0.f;
#pragma unroll
                for (int e = 0; e < 8; ++e) ss += val[j][e] * val[j][e];
                ss = row16_sum(ss);
                float r = rsqf_(ss + EPSF); if (ts == 0) r *= 0.08838834764831845f;
#pragma unroll
                for (int e = 0; e < 8; ++e) val[j][e] *= r; }
            if (ts == 0) {
#pragma unroll
                for (int j = 0; j < 4; ++j) *(LAS bf16x8*)(L + O_QH + (4 * tp + j) * P128 + cg * 16) = pack8(val[j][0], val[j][1], val[j][2], val[j][3], val[j][4], val[j][5], val[j][6], val[j][7]);
            } else {
                float ek[4], bg[4];
#pragma unroll
                for (int j = 0; j < 4; ++j) { ek[j] = SMf[192 + 4 * tp + j]; bg[j] = SMf[64 + 4 * tp + j] * SMf[128 + 4 * tp + j]; }
#pragma unroll
                for (int j = 0; j < 4; ++j) *(LAS bf16x8*)(L + O_KH + (4 * tp + j) * P128 + cg * 16) = pack8(val[j][0], val[j][1], val[j][2], val[j][3], val[j][4], val[j][5], val[j][6], val[j][7]);
#pragma unroll
                for (int e = 0; e < 8; ++e) {
                    *(LAS v2u*)(L + O_KGT + (cg * 8 + e) * P64 + tp * 8) = pack4(val[0][e] * ek[0], val[1][e] * ek[1], val[2][e] * ek[2], val[3][e] * ek[3]);
                    *(LAS v2u*)(L + O_KBGT + (cg * 8 + e) * P64 + tp * 8) = pack4(val[0][e] * bg[0], val[1][e] * bg[1], val[2][e] * bg[2], val[3][e] * bg[3]); }
            }
        }
        if (n > 0) GDN_OUT(rowbase - 64);
        if (wv < 4) {
            GDN_CONV(rv, 2);
            float be[4];
#pragma unroll
            for (int j = 0; j < 4; ++j) be[j] = SMf[64 + 4 * tp + j];
#pragma unroll
            for (int e = 0; e < 8; ++e) *(LAS v2u*)(L + O_VBT + (cg * 8 + e) * P64 + tp * 8) = pack4(val[0][e] * be[0], val[1][e] * be[1], val[2][e] * be[2], val[3][e] * be[3]);
        }
        for (int e = tidv; e < 64 * 68; e += NWAVES * 64) TT[e] = 0.f;
        __syncthreads();
        if (wv < 4) {
            const int ti = wv >> 1, tj = wv & 1;
            f32x16 C;
#pragma unroll
            for (int r = 0; r < 16; ++r) C[r] = 0.f;
            if (ti >= tj) {
#pragma unroll
                for (int s = 0; s < 8; ++s) C = MFMA32(lds16(L + O_KH + (32 * ti + l31) * P128 + (16 * s + 8 * hh) * 2), lds16(L + O_KH + (32 * tj + l31) * P128 + (16 * s + 8 * hh) * 2), C);
            }
            const int j = 32 * tj + l31; const float gcj = SMf[j];
#pragma unroll
            for (int g = 0; g < 4; ++g) { const int ib = 32 * ti + 8 * g + 4 * hh; const f32x4 gci = *(const LAS f32x4*)(SMf + ib), bei = *(const LAS f32x4*)(SMf + 64 + ib);
#pragma unroll
                for (int e = 0; e < 4; ++e) { const int i = ib + e; LM[i * 68 + j] = (i > j) ? bei[e] * C[4 * g + e] * __expf(gci[e] - gcj) : 0.f; } }
            if (ti == tj) {
                asm volatile("s_waitcnt lgkmcnt(0)" ::: "memory");
                const int a = 2 * ti, bq = 2 * ti + 1;
                if (lanev < 32) {
                    const int blk = a + (lanev >> 4), c = lanev & 15; float x[16];
    #pragma unroll
                    for (int i = 0; i < 16; ++i) { const LAS float* lr = LM + (16 * blk + i) * 68 + 16 * blk; float acc = (i == c) ? 1.f : 0.f;
    #pragma unroll
                        for (int j = 0; j < i; ++j) acc -= lr[j] * x[j];
                        x[i] = acc; TT[(16 * blk + i) * 68 + 16 * blk + c] = acc; }
                }
                asm volatile("s_waitcnt lgkmcnt(0)" ::: "memory");
                const int m = lanev & 15, q = lanev >> 4;
                f32x4 P = {0.f, 0.f, 0.f, 0.f}, R = {0.f, 0.f, 0.f, 0.f};
    #pragma unroll
                for (int s = 0; s < 4; ++s) { const int k = q + 4 * s; P = MFMA16F(LM[(16 * bq + m) * 68 + 16 * a + k], TT[(16 * a + k) * 68 + 16 * a + m], P); }
    #pragma unroll
                for (int rg = 0; rg < 4; ++rg) { const int k = 4 * q + rg; R = MFMA16F(TT[(16 * bq + m) * 68 + 16 * bq + k], P[rg], R); }
    #pragma unroll
                for (int rg = 0; rg < 4; ++rg) TT[(16 * bq + 4 * q + rg) * 68 + 16 * a + m] = -R[rg];
            }
        } else {
            const int w4 = wv - 4, tj = w4 >> 1, ti = w4 & 1;
            f32x16 C;
#pragma unroll
            for (int r = 0; r < 16; ++r) C[r] = 0.f;
            if (ti >= tj) {
#pragma unroll
                for (int s = 0; s < 8; ++s) C = MFMA32(lds16(L + O_KH + (32 * tj + l31) * P128 + (16 * s + 8 * hh) * 2), lds16(L + O_QH + (32 * ti + l31) * P128 + (16 * s + 8 * hh) * 2), C);
            }
            const int i = 32 * ti + l31; const float gci = SMf[i];
#pragma unroll
            for (int g = 0; g < 4; ++g) { const int jb = 32 * tj + 8 * g + 4 * hh; const f32x4 gcj = *(const LAS f32x4*)(SMf + jb); float v[4];
#pragma unroll
                for (int e = 0; e < 4; ++e) v[e] = (i >= jb + e) ? C[4 * g + e] * __expf(gci - gcj[e]) : 0.f;
                *(LAS v2u*)(L + O_AT + i * P64 + jb * 2) = pack4(v[0], v[1], v[2], v[3]); }
        }
        __syncthreads();
        if (wv < 4) {
            const int m = lanev & 15, q = lanev >> 4, mi = wv >> 1, ni = wv & 1;
            f32x4 P0 = {0.f, 0.f, 0.f, 0.f}, P1 = {0.f, 0.f, 0.f, 0.f}, R = {0.f, 0.f, 0.f, 0.f};
#pragma unroll
            for (int s = 0; s < 8; ++s) { const int k = q + 4 * s; const float bt = TT[k * 68 + 16 * ni + m];
                P0 = MFMA16F(LM[(32 + m) * 68 + k], bt, P0); P1 = MFMA16F(LM[(48 + m) * 68 + k], bt, P1); }
#pragma unroll
            for (int rg = 0; rg < 4; ++rg) { R = MFMA16F(TT[(32 + 16 * mi + m) * 68 + 32 + 4 * q + rg], P0[rg], R); R = MFMA16F(TT[(32 + 16 * mi + m) * 68 + 48 + 4 * q + rg], P1[rg], R); }
#pragma unroll
            for (int rg = 0; rg < 4; ++rg) TT[(32 + 16 * mi + 4 * q + rg) * 68 + 16 * ni + m] = -R[rg];
        }
        __syncthreads();
        f32x16 U, WT_;
#pragma unroll
        for (int r = 0; r < 16; ++r) { U[r] = 0.f; WT_[r] = 0.f; }
#pragma unroll
        for (int s = 0; s < 4; ++s) { const LAS f32x4* tp4 = (const LAS f32x4*)(TT + (32 * mt + l31) * 68 + 16 * s + 8 * hh); const f32x4 t0 = tp4[0], t1 = tp4[1];
            const bf16x8 a = pack8(t0.x, t0.y, t0.z, t0.w, t1.x, t1.y, t1.z, t1.w);
            U = MFMA32(a, lds16(L + O_VBT + (32 * nt + l31) * P64 + (16 * s + 8 * hh) * 2), U);
            WT_ = MFMA32(lds16(L + O_KBGT + (32 * nt + l31) * P64 + (16 * s + 8 * hh) * 2), a, WT_); }
#pragma unroll
        for (int g = 0; g < 4; ++g) *(LAS v2u*)(L + O_W + (32 * mt + l31) * P128 + (32 * nt + 8 * g + 4 * hh) * 2) = pack4(-WT_[4 * g], -WT_[4 * g + 1], -WT_[4 * g + 2], -WT_[4 * g + 3]);
        __syncthreads();
        bf16x8 sf[4][2];
#pragma unroll
        for (int kt = 0; kt < 4; ++kt) { sf[kt][0] = acc_frag<0>(S[kt]); sf[kt][1] = acc_frag<1>(S[kt]); }
#pragma unroll
        for (int kt = 0; kt < 4; ++kt)
#pragma unroll
            for (int s = 0; s < 2; ++s) U = MFMA32(lds8x2(L + O_W + (32 * mt + l31) * P128 + (32 * kt + 16 * s + 4 * hh) * 2), sf[kt][s], U);
#pragma unroll
        for (int g = 0; g < 4; ++g) *(LAS v2u*)(L + O_VNT + (32 * nt + l31) * P64 + (32 * mt + 8 * g + 4 * hh) * 2) = pack4(U[4 * g], U[4 * g + 1], U[4 * g + 2], U[4 * g + 3]);
        __syncthreads();
        {
            f32x16 Oa;
#pragma unroll
            for (int r = 0; r < 16; ++r) Oa[r] = 0.f;
#pragma unroll
            for (int kt = 0; kt < 4; ++kt)
#pragma unroll
                for (int s = 0; s < 2; ++s) Oa = MFMA32(lds8x2(L + O_QH + (32 * mt + l31) * P128 + (32 * kt + 16 * s + 4 * hh) * 2), sf[kt][s], Oa);
#pragma unroll
            for (int g = 0; g < 4; ++g) { const f32x4 e4 = *(const LAS f32x4*)(SMf + 128 + 32 * mt + 8 * g + 4 * hh);
#pragma unroll
                for (int e = 0; e < 4; ++e) Oa[4 * g + e] *= e4[e]; }
            bf16x8 vn[4];
#pragma unroll
            for (int s = 0; s < 4; ++s) vn[s] = lds16(L + O_VNT + (32 * nt + l31) * P64 + (16 * s + 8 * hh) * 2);
#pragma unroll
            for (int s = 0; s < 4; ++s) Oa = MFMA32(lds16(L + O_AT + (32 * mt + l31) * P64 + (16 * s + 8 * hh) * 2), vn[s], Oa);
            const float glast = SMf[256];
#pragma unroll
            for (int kt = 0; kt < 4; ++kt) {
#pragma unroll
                for (int r = 0; r < 16; ++r) S[kt][r] *= glast;
#pragma unroll
                for (int s = 0; s < 4; ++s) S[kt] = MFMA32(lds16(L + O_KGT + (32 * kt + l31) * P64 + (16 * s + 8 * hh) * 2), vn[s], S[kt]);
            }
#pragma unroll
            for (int r = 0; r < 16; ++r) { const float q2 = row16_sum(Oa[r] * Oa[r]);
                if ((lanev & 15) == 0) PSO[(32 * mt + 8 * (r >> 2) + 4 * hh + (r & 3)) * 8 + 2 * nt + ((lanev >> 4) & 1)] = q2;
                *(LAS unsigned short*)(L + O_OF + (32 * mt + 8 * (r >> 2) + 4 * hh + (r & 3)) * P128 + (32 * nt + l31) * 2) = (unsigned short)cvtpk(Oa[r], 0.f); }
        }
        asm volatile("s_waitcnt vmcnt(0)" : "+v"(pf_sink) :: "memory");
        __syncthreads();
    }
    GDN_OUT(b * SEQ + 31 * 64);
    __syncthreads();
#undef GDN_GATES
#undef GDN_CONV
#undef GDN_ROWS
#undef GDN_OUT
}

typedef short s16x4 __attribute__((ext_vector_type(4)));
__device__ __forceinline__ bf16x8 ldstr8(const LAS unsigned char* p0, const LAS unsigned char* p1) {
    const s16x4 a = __builtin_amdgcn_ds_read_tr16_b64_v4i16((LAS s16x4*)p0), b = __builtin_amdgcn_ds_read_tr16_b64_v4i16((LAS s16x4*)p1);
    bf16x8 r; r[0] = a[0]; r[1] = a[1]; r[2] = a[2]; r[3] = a[3]; r[4] = b[0]; r[5] = b[1]; r[6] = b[2]; r[7] = b[3]; return r;
}
template <int NREG>
__device__ __forceinline__ void dsa_select(const float* const scw, LAS unsigned* const MASK, const int wv, const int lane, const int t0, const int nk) {
    const float NINF = -__builtin_inff();
    const unsigned long long lt_mask = (1ull << lane) - 1ull;
    float xn[NREG];
#pragma unroll
    for (int i = 0; i < NREG; ++i) xn[i] = __hip_atomic_load(scw + i * 64 + lane, __ATOMIC_RELAXED, __HIP_MEMORY_SCOPE_AGENT);
#pragma unroll 1
    for (int ql_ = 0; ql_ < 8; ++ql_) {
        const int ql = ql_ & 7;
        const int tq = t0 + 8 * wv + ql;
        LAS unsigned* const mrow = MASK + (8 * wv + ql) * 64;
        float x[NREG];
#pragma unroll
        for (int i = 0; i < NREG; ++i) x[i] = (i * 64 + lane < nk) ? xn[i] : NINF;
        if (ql_ + 1 < 8) {
#pragma unroll
            for (int i = 0; i < NREG; ++i) xn[i] = __hip_atomic_load(scw + ((ql_ + 1) & 7) * 2048 + i * 64 + lane, __ATOMIC_RELAXED, __HIP_MEMORY_SCOPE_AGENT);
        }
        if (tq + 1 > 256) {
            float vmin = __builtin_inff(), vmax = NINF;
#pragma unroll
            for (int i = 0; i < NREG; ++i) { vmax = fmaxf(vmax, x[i]); vmin = fminf(vmin, x[i] == NINF ? __builtin_inff() : x[i]); }
            vmin = -wave_max(-vmin); vmax = wave_max(vmax);
#define CNT_GE(p_, dst_) do { int _c0 = 0, _c1 = 0, _c2 = 0, _c3 = 0; const float _p = (p_); \
                _Pragma("unroll") for (int _i = 0; _i < NREG; _i += 4) \
                    asm volatile("v_cmp_le_f32_e64 s[90:91], %8, %4\n\tv_cmp_le_f32_e64 s[92:93], %8, %5\n\tv_cmp_le_f32_e64 s[94:95], %8, %6\n\tv_cmp_le_f32_e64 s[96:97], %8, %7\n\t" \
                                 "v_addc_co_u32_e64 %0, s[90:91], 0, %0, s[90:91]\n\tv_addc_co_u32_e64 %1, s[92:93], 0, %1, s[92:93]\n\tv_addc_co_u32_e64 %2, s[94:95], 0, %2, s[94:95]\n\tv_addc_co_u32_e64 %3, s[96:97], 0, %3, s[96:97]" \
                                 : "+v"(_c0), "+v"(_c1), "+v"(_c2), "+v"(_c3) : "v"(x[_i]), "v"(x[_i + 1]), "v"(x[_i + 2]), "v"(x[_i + 3]), "s"(_p) : "s90", "s91", "s92", "s93", "s94", "s95", "s96", "s97"); \
                dst_ = wave_sum_i((_c0 + _c1) + (_c2 + _c3)); } while (0)
            float lo = vmin, hi = vmax, thr; int chi; bool tie = false;
            CNT_GE(hi, chi);
            if (chi == 256) thr = hi;
            else if (chi > 256) { tie = true; lo = hi; chi = 0; hi = __builtin_inff(); }
            else {
#pragma unroll 1
                for (;;) {
                    const float mid = 0.5f * (lo + hi);
                    if (!(mid > lo && mid < hi)) { tie = true; break; }
                    int c; CNT_GE(mid, c);
                    if (c == 256) { thr = mid; break; }
                    if (c > 256) lo = mid; else { hi = mid; chi = c; }
                }
            }
#undef CNT_GE
            if (!tie) {
#pragma unroll
                for (int i = 0; i < NREG; ++i) { const unsigned long long bs = __ballot(x[i] >= thr);
                    if (lane == 0) { v2u w; w.x = (unsigned)bs; w.y = (unsigned)(bs >> 32); *(LAS v2u*)(mrow + 2 * i) = w; } }
            } else {
                const int need = 256 - chi; int before = 0;
#pragma unroll
                for (int i = 0; i < NREG; ++i) { const bool eq = (x[i] == lo); const unsigned long long be = __ballot(eq);
                    const int rank = before + __popcll(be & lt_mask); const bool sel = (x[i] >= hi) || (eq && rank < need); before += __popcll(be);
                    const unsigned long long bs = __ballot(sel);
                    if (lane == 0) { v2u w; w.x = (unsigned)bs; w.y = (unsigned)(bs >> 32); *(LAS v2u*)(mrow + 2 * i) = w; } }
            }
        } else {
#pragma unroll
            for (int i = 0; i < NREG; ++i) { const unsigned long long bs = __ballot(i * 64 + lane <= tq);
                if (lane == 0) { v2u w; w.x = (unsigned)bs; w.y = (unsigned)(bs >> 32); *(LAS v2u*)(mrow + 2 * i) = w; } }
        }
    }
}

__device__ __forceinline__ void dsa_unit(Frame& F, const Args& args, const int b, const int qb, const float mb2) {
    LAS unsigned char* const L = F.lds;
    const int tid = F.tid, lane = F.lane, wv = F.wave, l31_0 = lane & 31, hh_0 = lane >> 5;
    int l31 = l31_0, hh = hh_0;
    constexpr int PK = 272, PV = 144;
    constexpr int O_K0 = 0, O_V0 = 17408, BUFSZ = 35840, O_MASK = 2 * BUFSZ, O_RS = O_MASK + 16384, O_BT = O_RS + 8192, O_END = O_BT + 2048, O_OA = 0;
    static_assert(O_END <= SCRATCH_BYTES && 4 * 17408 <= 2 * BUFSZ, "dsa LDS map");
    const int t0 = 64 * qb, nk = 64 * (qb + 1);
    const size_t rb = (size_t)b * SEQ;
    LAS unsigned* const MASK = (LAS unsigned*)(L + O_MASK);
    LAS float* const RS = (LAS float*)(L + O_RS);
    LAS float* const BT = (LAS float*)(L + O_BT);
    const float NINF = -__builtin_inff();
    for (int key = tid; key < nk; key += NWAVES * 64) { const f32x4 s4 = *(const f32x4*)(W_KVSS + (rb + key) * 4); RS[key] = rsqf_(((s4.x + s4.y) + (s4.z + s4.w)) * (1.0f / 128.0f) + EPSF); }
    BT[tid] = P_RELB[T5_BUCKET[tid >> 2] * 4 + (tid & 3)] * LOG2E;
    float* const scw = W_SCR + (size_t)(blockIdx.x * NWAVES + wv) * 8 * 2048;
#pragma unroll 1
    for (int rep_a = 0; rep_a < (PROBE_DUP == 41 ? 2 : 1); ++rep_a) {
        bf16x8 aq[2][4]; f32x4 wts[2][4];
#pragma unroll
        for (int rt = 0; rt < 2; ++rt) {
            const bf16* p = W_PROJ + (rb + t0 + 8 * wv + 4 * rt + (l31 >> 3)) * NPROJ + C_IQ + (l31 & 7) * 64 + 8 * hh;
#pragma unroll
            for (int s = 0; s < 4; ++s) aq[rt][s] = *(const GAS bf16x8*)(p + 16 * s);
#pragma unroll
            for (int g = 0; g < 4; ++g) wts[rt][g] = *(const f32x4*)(W_AUX + (rb + t0 + 8 * wv + 4 * rt + g) * 16 + 8 + 4 * hh) * 0.5f;
        }
        constexpr int O_IK = 0, IKB = 9216, PIK = 144;
        v4u sti;
#define IK_GLOAD(kt_) sti = *(const GAS v4u*)(W_PROJ + (rb + 64 * (kt_) + (tid >> 3)) * NPROJ + C_IK + (tid & 7) * 8)
#define IK_SWRITE(buf_) *(LAS v4u*)(L + O_IK + (buf_) * IKB + (tid >> 3) * PIK + (tid & 7) * 16) = sti
        IK_GLOAD(0); IK_SWRITE(0);
        __syncthreads();
#pragma unroll 1
        for (int kt6 = 0; kt6 <= qb; ++kt6) {
          const int ibuf = kt6 & 1;
          if (kt6 < qb) IK_GLOAD(kt6 + 1);
#pragma unroll
          for (int st = 0; st < 2; ++st) {
            bf16x8 bk[4];
#pragma unroll
            for (int s = 0; s < 4; ++s) bk[s] = lds16(L + O_IK + ibuf * IKB + (32 * st + l31) * PIK + (16 * s + 8 * hh) * 2);
            const int kt = 2 * kt6 + st;
            const int key = 32 * kt + l31;
            f32x16 C0, C1;
#pragma unroll
            for (int r = 0; r < 16; ++r) { C0[r] = 0.f; C1[r] = 0.f; }
#pragma unroll
            for (int s = 0; s < 4; ++s) C0 = MFMA32(aq[0][s], bk[s], C0);
#pragma unroll
            for (int s = 0; s < 4; ++s) C1 = MFMA32(aq[1][s], bk[s], C1);
            float pp[2][4];
#pragma unroll
            for (int g = 0; g < 4; ++g) {
                float p0 = 0.f, p1 = 0.f;
#pragma unroll
                for (int e2 = 0; e2 < 4; ++e2) { const float w0 = wts[0][g][e2], w1 = wts[1][g][e2], x0 = C0[4 * g + e2], x1 = C1[4 * g + e2];
                    p0 = __builtin_fmaf(w0, x0, p0); p0 = __builtin_fmaf(w0, __builtin_fabsf(x0), p0); p1 = __builtin_fmaf(w1, x1, p1); p1 = __builtin_fmaf(w1, __builtin_fabsf(x1), p1); }
                pp[0][g] = p0; pp[1][g] = p1;
            }
            float snd[2][2], rcv[2][2];
#pragma unroll
            for (int rt = 0; rt < 2; ++rt)
#pragma unroll
                for (int g2 = 0; g2 < 2; ++g2) snd[rt][g2] = hh ? pp[rt][g2] : pp[rt][g2 + 2];
#pragma unroll
            for (int rt = 0; rt < 2; ++rt)
#pragma unroll
                for (int g2 = 0; g2 < 2; ++g2) rcv[rt][g2] = __shfl_xor(snd[rt][g2], 32);
#pragma unroll
            for (int rt = 0; rt < 2; ++rt)
#pragma unroll
                for (int g2 = 0; g2 < 2; ++g2) { const int ql = 4 * rt + g2 + 2 * hh; float p = (hh ? pp[rt][g2 + 2] : pp[rt][g2]) + rcv[rt][g2];
                    if (key > t0 + 8 * wv + ql) p = NINF;
                    scw[ql * 2048 + key] = p; }
          }
          if (kt6 < qb) IK_SWRITE(ibuf ^ 1);
          __syncthreads();
        }
#undef IK_GLOAD
#undef IK_SWRITE
    }
    __builtin_amdgcn_fence(__ATOMIC_SEQ_CST, "workgroup");
    asm volatile("s_waitcnt vmcnt(0)" ::: "memory");
    const int qj = l31 >> 2, hd = l31 & 3;
    const int tql = t0 + 8 * wv + qj;
    bf16x8 qf[8]; float qn2 = 0.f;
    {
        const bf16* p = W_PROJ + (rb + tql) * NPROJ + C_QB + hd * 128 + 8 * hh; const float cs = 0.08838834764831845f * LOG2E;
#pragma unroll
        for (int s = 0; s < 8; ++s) { const v4u raw = *(const GAS v4u*)(p + 16 * s); const f32x4 g0 = *(const f32x4*)(P_GKV + 16 * s + 8 * hh), g1 = *(const f32x4*)(P_GKV + 16 * s + 8 * hh + 4);
            v4u o; o.x = cvtpk(bflo(raw.x) * g0.x * cs, bfhi(raw.x) * g0.y * cs); o.y = cvtpk(bflo(raw.y) * g0.z * cs, bfhi(raw.y) * g0.w * cs);
            o.z = cvtpk(bflo(raw.z) * g1.x * cs, bfhi(raw.z) * g1.y * cs); o.w = cvtpk(bflo(raw.w) * g1.z * cs, bfhi(raw.w) * g1.w * cs);
            qn2 += (bflo(o.x) * bflo(o.x) + bfhi(o.x) * bfhi(o.x)) + (bflo(o.y) * bflo(o.y) + bfhi(o.y) * bfhi(o.y)) + (bflo(o.z) * bflo(o.z) + bfhi(o.z) * bfhi(o.z)) + (bflo(o.w) * bflo(o.w) + bfhi(o.w) * bfhi(o.w));
            qf[s] = __builtin_bit_cast(bf16x8, o); }
    }
    qn2 += __shfl_xor(qn2, 32);
    int lanev = lane; asm volatile("" : "+v"(lanev));
    if (qb < 8) dsa_select<8>(scw, MASK, wv, lanev, t0, nk);
    else if (qb < 16) dsa_select<16>(scw, MASK, wv, lanev, t0, nk);
    else if (qb < 24) dsa_select<24>(scw, MASK, wv, lanev, t0, nk);
    else dsa_select<32>(scw, MASK, wv, lanev, t0, nk);
    __syncthreads();
    const float c0 = -(sqrtf(qn2) * 11.313708499f * 1.01f + mb2 + 1.0f);
    const float cfar = BT[127 * 4 + hd] + c0;
    f32x16 oacc[4];
#pragma unroll
    for (int d = 0; d < 4; ++d)
#pragma unroll
        for (int r = 0; r < 16; ++r) oacc[d][r] = 0.f;
    float lsum = 0.f;
    v4u st0, st1;
#define DSA_GLOAD(kt) do { const bf16* _p = W_PROJ + (rb + 64 * (kt) + lane) * NPROJ + C_CKV + wv * 16; st0 = *(const GAS v4u*)_p; st1 = *(const GAS v4u*)(_p + 8); } while (0)
#define DSA_SWRITE(buf, ktt) do { LAS unsigned char* _kb = L + (buf) * BUFSZ; const float _r = RS[64 * (ktt) + lane]; \
        v4u _n0, _n1; _n0.x = cvtpk(bflo(st0.x) * _r, bfhi(st0.x) * _r); _n0.y = cvtpk(bflo(st0.y) * _r, bfhi(st0.y) * _r); _n0.z = cvtpk(bflo(st0.z) * _r, bfhi(st0.z) * _r); _n0.w = cvtpk(bflo(st0.w) * _r, bfhi(st0.w) * _r); \
        _n1.x = cvtpk(bflo(st1.x) * _r, bfhi(st1.x) * _r); _n1.y = cvtpk(bflo(st1.y) * _r, bfhi(st1.y) * _r); _n1.z = cvtpk(bflo(st1.z) * _r, bfhi(st1.z) * _r); _n1.w = cvtpk(bflo(st1.w) * _r, bfhi(st1.w) * _r); \
        *(LAS v4u*)(_kb + O_K0 + lane * PK + wv * 32) = _n0; *(LAS v4u*)(_kb + O_K0 + lane * PK + wv * 32 + 16) = _n1; \
        } while (0)
    DSA_GLOAD(0); DSA_SWRITE(0, 0);
    __syncthreads();
    for (int kt = 0; kt <= qb; ++kt) {
        const int buf = kt & 1;
        l31 = l31_0; hh = hh_0; asm volatile("" : "+v"(l31), "+v"(hh));
        if (kt < qb) DSA_GLOAD(kt + 1);
        const LAS unsigned char* kb = L + buf * BUFSZ;
#pragma unroll
        for (int st = 0; st < 2; ++st) {
            f32x16 Sa;
#pragma unroll
            for (int r = 0; r < 16; ++r) Sa[r] = 0.f;
#pragma unroll
            for (int s = 0; s < 8; ++s) Sa = MFMA32(lds16(kb + O_K0 + (32 * st + l31) * PK + (16 * s + 8 * hh) * 2), qf[s], Sa);
            const int kbase = 64 * kt + 32 * st;
            const int mwi = (int)(MASK[(8 * wv + qj) * 64 + 2 * kt + st] >> (4 * hh));
            const bool far = (t0 + 8 * wv) - (kbase + 31) >= 113;
            float pn[16];
            if (far) {
#pragma unroll
                for (int r = 0; r < 16; ++r) { const float p = __builtin_bit_cast(float, __builtin_bit_cast(int, __builtin_amdgcn_exp2f(Sa[r] + cfar)) & __builtin_amdgcn_sbfe(mwi, 8 * (r >> 2) + (r & 3), 1));
                    lsum += p; pn[r] = p; }
            } else {
#pragma unroll
                for (int r = 0; r < 16; ++r) { int dist = tql - (kbase + 8 * (r >> 2) + 4 * hh + (r & 3)); dist = dist < 0 ? 0 : (dist > 127 ? 127 : dist);
                    const float p = __builtin_bit_cast(float, __builtin_bit_cast(int, __builtin_amdgcn_exp2f(Sa[r] + (BT[dist * 4 + hd] + c0))) & __builtin_amdgcn_sbfe(mwi, 8 * (r >> 2) + (r & 3), 1));
                    lsum += p; pn[r] = p; }
            }
            const bf16x8 pf0 = pack8(pn[0], pn[1], pn[2], pn[3], pn[4], pn[5], pn[6], pn[7]), pf1 = pack8(pn[8], pn[9], pn[10], pn[11], pn[12], pn[13], pn[14], pn[15]);
#pragma unroll
            for (int dt = 0; dt < 4; ++dt) {
                const LAS unsigned char* vp = kb + O_K0 + (32 * st + 4 * hh + ((lane & 15) >> 2)) * PK + (32 * dt + 16 * ((lane >> 4) & 1) + 4 * (lane & 3)) * 2;
                oacc[dt] = MFMA32(ldstr8(vp, vp + 8 * PK), pf0, oacc[dt]); oacc[dt] = MFMA32(ldstr8(vp + 16 * PK, vp + 24 * PK), pf1, oacc[dt]); }
        }
        if (kt < qb) DSA_SWRITE(buf ^ 1, kt + 1);
        __syncthreads();
    }
#undef DSA_GLOAD
#undef DSA_SWRITE
    lsum += __shfl_xor(lsum, 32);
    {
        const float inv = rcpf_(lsum);
#pragma unroll
        for (int dt = 0; dt < 4; ++dt)
#pragma unroll
            for (int g = 0; g < 4; ++g) { const int d = 32 * dt + 8 * g + 4 * hh; const f32x4 gk = *(const f32x4*)(P_GKV + d);
                *(LAS v2u*)(L + O_OA + hd * 17408 + (8 * wv + qj) * PK + d * 2) = pack4(oacc[dt][4 * g] * inv * gk.x, oacc[dt][4 * g + 1] * inv * gk.y, oacc[dt][4 * g + 2] * inv * gk.z, oacc[dt][4 * g + 3] * inv * gk.w); }
    }
    __syncthreads();
    {
        const int hd2 = wv >> 1, mt2 = wv & 1;
        const size_t row = rb + t0 + 32 * mt2 + l31;
        bf16x8 of[8];
#pragma unroll
        for (int s = 0; s < 8; ++s) of[s] = lds16(L + O_OA + hd2 * 17408 + (32 * mt2 + l31) * PK + (16 * s + 8 * hh) * 2);
#pragma unroll 1
        for (int et = 0; et < 4; ++et) {
            v2u zw[4];
#pragma unroll
            for (int g = 0; g < 4; ++g) zw[g] = *(const GAS v2u*)(W_PROJ + row * NPROJ + C_ZB + hd2 * 128 + 32 * et + 8 * g + 4 * hh);
            f32x16 C;
#pragma unroll
            for (int r = 0; r < 16; ++r) C[r] = 0.f;
            const bf16* wp = W_WUVT + (size_t)hd2 * 16384 + (32 * et + l31) * 128 + 8 * hh;
#pragma unroll
            for (int s = 0; s < 8; ++s) C = MFMA32(*(const GAS bf16x8*)(wp + 16 * s), of[s], C);
#pragma unroll
            for (int g = 0; g < 4; ++g)
                *(GAS v2u*)(W_OAB + row * DM + 512 + hd2 * 128 + 32 * et + 8 * g + 4 * hh) =
                    pack4(C[4 * g] * siluf(bflo(zw[g].x)), C[4 * g + 1] * siluf(bfhi(zw[g].x)), C[4 * g + 2] * siluf(bflo(zw[g].y)), C[4 * g + 3] * siluf(bfhi(zw[g].y)));
        }
    }
    __syncthreads();
}

constexpr int N_GDN = NB * 4, N_DSA = NB * 32, N_ITEMS = N_GDN + N_DSA;
constexpr int N_PHASES = 6;
__global__ void __launch_bounds__(NWAVES * 64, 2) hyb_fwd(Args args) {
    extern __shared__ __attribute__((aligned(16))) unsigned char lds[];
    Frame F;
    F.lds = (LAS unsigned char*)lds;
    F.MISC = (volatile LAS unsigned*)(F.lds + MISC_OFF);
    F.tid = threadIdx.x; F.lane = F.tid & 63; F.wave = __builtin_amdgcn_readfirstlane(F.tid >> 6);
    F.G = gridDim.x; { const int bx = blockIdx.x; F.vcu = (F.G % 8 == 0) ? (bx % 8) * (F.G / 8) + bx / 8 : bx; }
    unsigned char* ws = args.ws;
    F.ctl = (gu32*)(ws + WS_CTL);
    F.ws = ws;
    for (int u = F.tid; u < 64; u += NWAVES * 64) F.MISC[u] = 0u;
    __syncthreads();
    const int lo = args.ph_lo, hi = args.ph_hi;
    const bool multi = (hi - lo) > 1;
    XcdBarrier bar; bar.bar = (unsigned*)(F.ctl + CW_BAR) + args.li * XCD_BAR_WORDS; bar.x = 0; bar.st = nullptr;
    if (multi) bar = xcd_barrier_post((unsigned*)(F.ctl + CW_BAR) + args.li * XCD_BAR_WORDS, F.MISC + 8);
#define IN(k) (lo <= (k) && (k) < hi)
#define BOTH(k) (IN(k) && IN((k) + 1))
    if (IN(0)) { p0_prologue(F, args); if (PROBE_DUP == 7) { __syncthreads(); p0_prologue(F, args); } if (BOTH(0)) xcd_barrier(bar); }
    if (IN(1)) { p1_norm(F, args); if (PROBE_DUP == 1) p1_norm(F, args); if (BOTH(1)) xcd_barrier(bar); }
    if (IN(2)) {
        pg8::Gemm g{W_XN, W_WINT, MROWS, NPROJ, DM}; pg8::StaticOrder S; S.init(MROWS, NPROJ, F.G, (int)blockIdx.x);
        pg8::EpiProj E{W_PROJ, W_AUX, W_KVSS};
        pg8::gemm_phase<pg8::EpiProj, pg8::StaticOrder, true, true>(F.lds, g, S, E);
        if (PROBE_DUP == 2) pg8::gemm_phase<pg8::EpiProj, pg8::StaticOrder, true, true>(F.lds, g, S, E);
        if (BOTH(2)) xcd_barrier(bar);
    }
    if (IN(3)) {
#define NEXT_ITEM(dst, qw) do { if (F.tid == 0) F.MISC[4] = __hip_atomic_fetch_add(F.ctl + (qw), 1u, RLX_AGENT); __syncthreads(); dst = (int)F.MISC[4]; __syncthreads(); } while (0)
        float mb2; { const int hd_ = F.lane & 3; float m_ = P_RELB[hd_]; for (int k = 1; k < 32; ++k) m_ = fmaxf(m_, P_RELB[k * 4 + hd_]); mb2 = m_ * LOG2E; }
        int item; NEXT_ITEM(item, CW_QUEUE);
#pragma unroll 1
        for (int pass = 0; pass < (PROBE_DUP == 3 ? 2 : 1); ++pass) {
            if (pass) NEXT_ITEM(item, CW_QUEUE + 64);
            while (item < N_GDN) { gdn_unit(F, args, item >> 2, item & 3); NEXT_ITEM(item, CW_QUEUE + 64 * pass); }
        }
#pragma unroll 1
        for (int pass = 0; pass < (PROBE_DUP == 4 ? 2 : 1); ++pass) {
            if (pass) NEXT_ITEM(item, CW_QUEUE + 128);
            while (item < N_ITEMS) { if (item >= N_GDN) { const int idx = item - N_GDN; dsa_unit(F, args, idx & 31, 31 - (idx >> 5), mb2); } NEXT_ITEM(item, pass ? CW_QUEUE + 128 : CW_QUEUE); }
        }
#undef NEXT_ITEM
        if (BOTH(3)) xcd_barrier(bar);
    }
    if (IN(4)) {
        pg8::Gemm g{W_OAB, W_WOUTT, MROWS, DM, DM}; pg8::StaticOrder S; S.init(MROWS, DM, F.G, (int)blockIdx.x);
        pg8::EpiMix E{W_MIX, DM};
        pg8::gemm_phase<pg8::EpiMix, pg8::StaticOrder, true, true>(F.lds, g, S, E);
        if (PROBE_DUP == 5) pg8::gemm_phase<pg8::EpiMix, pg8::StaticOrder, true, true>(F.lds, g, S, E);
        if (BOTH(4)) xcd_barrier(bar);
    }
    if (IN(5)) { p5_final(F, args); if (PROBE_DUP == 6) p5_final(F, args); }
#undef IN
#undef BOTH
}

extern "C" void kernel_launch(void* const* d_in, const int* in_sizes, int n_in, void* d_out, int out_size, void* d_ws, size_t ws_size, hipStream_t stream) {
    static int grid = 0;
    if (grid == 0) {
        if (n_in != 15 || in_sizes[0] != MROWS * DM || out_size != MROWS * DM || ws_size < WS_END) { fprintf(stderr, "kernel_launch: unexpected shapes (n_in %d, in0 %d, out %d, ws %zu); nothing launched\n", n_in, n_in > 0 ? in_sizes[0] : -1, out_size, ws_size); grid = -1; return; }
        int dev = 0, cus = 0, per_cu = 0;
        if (hipGetDevice(&dev) != hipSuccess || hipDeviceGetAttribute(&cus, hipDeviceAttributeMultiprocessorCount, dev) != hipSuccess) { fprintf(stderr, "kernel_launch: device query failed\n"); grid = -1; return; }
        if (hipFuncSetAttribute((const void*)hyb_fwd, hipFuncAttributeMaxDynamicSharedMemorySize, LDS_BYTES) != hipSuccess) { fprintf(stderr, "kernel_launch: hipFuncSetAttribute failed\n"); grid = -1; return; }
        if (hipOccupancyMaxActiveBlocksPerMultiprocessor(&per_cu, (const void*)hyb_fwd, NWAVES * 64, LDS_BYTES) != hipSuccess || per_cu < 1)
            fprintf(stderr, "kernel_launch: note: occupancy query reports %d workgroups per CU\n", per_cu);
        (void)hipGetLastError();
        grid = cus < 256 ? cus : 256;
    }
    if (grid < 0) return;
    if (hipMemsetAsync((char*)d_ws + WS_CTL, 0, CTL_ZERO_BYTES, stream) != hipSuccess) { fprintf(stderr, "kernel_launch: memset failed\n"); return; }
    Args a{};
    for (int i = 0; i < 15; ++i) a.in[i] = (const float*)d_in[i];
    a.out = (float*)d_out; a.ws = (unsigned char*)d_ws;
    constexpr int NL = MK_N_LAUNCHES;
    static_assert(NL == 1 || NL == 2 || NL == 3 || NL == N_PHASES, "MK_N_LAUNCHES");
    const int cuts1[2] = {0, 6}, cuts2[3] = {0, 3, 6}, cuts3[4] = {0, 3, 4, 6}, cuts6[7] = {0, 1, 2, 3, 4, 5, 6};
    const int* cuts = NL == 1 ? cuts1 : NL == 2 ? cuts2 : NL == 3 ? cuts3 : cuts6;
    for (int li = 0; li < NL; ++li) {
        a.ph_lo = cuts[li]; a.ph_hi = cuts[li + 1]; a.li = li;
        hipLaunchKernelGGL(hyb_fwd, dim3(grid), dim3(NWAVES * 64), LDS_BYTES, stream, a);
        const hipError_t le = hipPeekAtLastError();
        if (le != hipSuccess) { fprintf(stderr, "kernel_launch: launch %d failed: %s\n", li, hipGetErrorName(le)); break; }
    }
}
```

```cpp
#include <hip/hip_runtime.h>
#include <cstdio>
#include <cstdint>
#ifndef MK_N_LAUNCHES
#define MK_N_LAUNCHES 1
#endif
#ifndef PROBE_DUP
#define PROBE_DUP 0
#endif
namespace pg8 {
#define PG8_LAS __attribute__((address_space(3)))
typedef unsigned short bf16_t;
typedef short bf16x8 __attribute__((ext_vector_type(8)));
typedef float f32x4 __attribute__((ext_vector_type(4)));
typedef unsigned u32x4 __attribute__((ext_vector_type(4)));
constexpr int BM = 256, BK = 64, HALF = 128, HTB = HALF * BK * 2  , STAGE_BYTES = 8 * HTB, NXCD = 8, WGM = 8;

__host__ __device__ __forceinline__ int lds_byte(int r, int c) { const int st = (r >> 4) * 2 + (c >> 5), rr = r & 15, cc = c & 31, ob = rr * 64 + cc * 2; return st * 1024 + (ob ^ (((ob >> 9) & 1) << 5)); }
__host__ __device__ __forceinline__ void stage_rc(int b, int& R, int& C) { const int st = b / 1024, sb = b % 1024, swz = sb ^ (((sb >> 9) & 1) << 5); R = (st >> 1) * 16 + swz / 64; C = (st & 1) * 32 + (swz % 64) / 2; }
__host__ __device__ __forceinline__ int perm32(int rho) { const int n = rho >> 4, i = rho & 15; return 8 * (i >> 2) + 4 * n + (i & 3); }

struct Unit { int pm, pn; };
struct Gemm { const bf16_t* A; const bf16_t* Bt; int M, N, K; unsigned* sink; };

struct StaticOrder {
    int nM, nN, nwg, G, c;
    __host__ __device__ void init(int M, int N, int G_, int c_) { nM = M / BM; nN = N / BM; nwg = nM * nN; G = G_; c = c_; }
    __host__ __device__ bool next(int i, Unit& u) const {
        const long L = (long)i * G + c; if (L >= nwg) return false;
        int wgid = (int)L; { const int q = nwg / NXCD, r = nwg % NXCD, xcd = wgid % NXCD, off = wgid / NXCD; wgid = (xcd < r ? xcd * (q + 1) : r * (q + 1) + (xcd - r) * q) + off; }
        const int nig = WGM * nN, gid = wgid / nig, fm = gid * WGM, gsz = (nM - fm) < WGM ? (nM - fm) : WGM;
        u.pm = fm + ((wgid % nig) % gsz); u.pn = (wgid % nig) / gsz; return true;
    }
    __device__ __forceinline__ void a_ready(const Unit&) const {}
    __device__ __forceinline__ void done(const Unit&) const {}
};

typedef float f32x2c __attribute__((ext_vector_type(2))); typedef __bf16 b16x2c __attribute__((ext_vector_type(2)));
__device__ __forceinline__ unsigned cvt_pk_bf16(float lo, float hi) { const f32x2c v = {lo, hi}; return __builtin_bit_cast(unsigned, __builtin_convertvector(v, b16x2c)); }
struct EpiProj {
    static constexpr bool PERM = true, AFTER_DRAIN = false; static constexpr int MIN_VM = 16;
    bf16_t* O; float* aux; float* kvss;
    __device__ __forceinline__ void operator()(const f32x4 (&acc)[2][2][4][2], const Unit& u, int wr, int wc, int fr, int fq) const {
        const int row0 = u.pm * BM + wr * 64 + fr, col0 = u.pn * BM + wc * 32 + 8 * fq;
        const bool last = (u.pn == 14);
#pragma unroll
        for (int ai = 0; ai < 2; ++ai)
#pragma unroll
            for (int m = 0; m < 4; ++m) {
                const int row = row0 + ai * HALF + m * 16;
                bf16_t* rowp = O + (size_t)row * 3840 + col0;
#pragma unroll
                for (int bj = 0; bj < 2; ++bj) {
                    const f32x4 v0 = acc[ai][bj][m][0], v1 = acc[ai][bj][m][1];
                    u32x4 w; w.x = cvt_pk_bf16(v0[0], v0[1]); w.y = cvt_pk_bf16(v0[2], v0[3]); w.z = cvt_pk_bf16(v1[0], v1[1]); w.w = cvt_pk_bf16(v1[2], v1[3]);
                    *(u32x4*)(rowp + bj * HALF) = w;
                }
                if (last) {
                    const f32x4 a0 = acc[ai][0][m][0], a1 = acc[ai][0][m][1];
                    float ss = (a0[0] * a0[0] + a0[1] * a0[1]) + (a0[2] * a0[2] + a0[3] * a0[3]) + (a1[0] * a1[0] + a1[1] * a1[1]) + (a1[2] * a1[2] + a1[3] * a1[3]);
                    ss += __shfl_xor(ss, 16); ss += __shfl_xor(ss, 32);
                    if (fq == 0) kvss[(size_t)wc * 65536 + row] = ss;
                    if (wc == 2 && fq < 2) { float* ap = aux + (size_t)row * 16 + 8 * fq; *(f32x4*)ap = acc[ai][1][m][0]; *(f32x4*)(ap + 4) = acc[ai][1][m][1]; }
                }
            }
    }
};
struct EpiF32 {
    static constexpr bool PERM = false, AFTER_DRAIN = false; static constexpr int MIN_VM = 32;
    float* C; int ldc;
    __device__ __forceinline__ void operator()(const f32x4 (&acc)[2][2][4][2], const Unit& u, int wr, int wc, int fr, int fq) const {
        const int row0 = u.pm * BM + wr * 64 + fr, col0 = u.pn * BM + wc * 32 + 4 * fq;
#pragma unroll
        for (int ai = 0; ai < 2; ++ai)
#pragma unroll
            for (int m = 0; m < 4; ++m) { float* rowp = C + (size_t)(row0 + ai * HALF + m * 16) * ldc + col0;
#pragma unroll
                for (int bj = 0; bj < 2; ++bj)
#pragma unroll
                    for (int n = 0; n < 2; ++n) *(f32x4*)(rowp + bj * HALF + n * 16) = acc[ai][bj][m][n]; }
    }
};
struct EpiMix {
    static constexpr bool PERM = true, AFTER_DRAIN = false; static constexpr int MIN_VM = 16;
    bf16_t* O; int ldc;
    __device__ __forceinline__ void operator()(const f32x4 (&acc)[2][2][4][2], const Unit& u, int wr, int wc, int fr, int fq) const {
        const int row0 = u.pm * BM + wr * 64 + fr, col0 = u.pn * BM + wc * 32 + 8 * fq;
#pragma unroll
        for (int ai = 0; ai < 2; ++ai)
#pragma unroll
            for (int m = 0; m < 4; ++m) { bf16_t* rowp = O + (size_t)(row0 + ai * HALF + m * 16) * ldc + col0;
#pragma unroll
                for (int bj = 0; bj < 2; ++bj) { const f32x4 v0 = acc[ai][bj][m][0], v1 = acc[ai][bj][m][1];
                    u32x4 w; w.x = cvt_pk_bf16(v0[0], v0[1]); w.y = cvt_pk_bf16(v0[2], v0[3]); w.z = cvt_pk_bf16(v1[0], v1[1]); w.w = cvt_pk_bf16(v1[2], v1[3]);
                    *(u32x4*)(rowp + bj * HALF) = w; } }
    }
};
struct EpiNull {
    static constexpr bool PERM = true, AFTER_DRAIN = false; static constexpr int MIN_VM = 0;
    float* O;
    __device__ __forceinline__ void operator()(const f32x4 (&acc)[2][2][4][2], const Unit& u, int wr, int wc, int fr, int fq) const {
        f32x4 s = {0.f, 0.f, 0.f, 0.f};
#pragma unroll
        for (int ai = 0; ai < 2; ++ai)
#pragma unroll
            for (int bj = 0; bj < 2; ++bj)
#pragma unroll
                for (int m = 0; m < 4; ++m) { s += acc[ai][bj][m][0]; s += acc[ai][bj][m][1]; }
        if ((s[0] + s[1]) + (s[2] + s[3]) == 1.2345e30f) O[u.pm * 4096 + u.pn * 256 + wr * 128 + wc * 32 + fq * 16 + fr] = s[0];
    }
};
struct EpiHalf {
    static constexpr bool PERM = true, AFTER_DRAIN = false; static constexpr int MIN_VM = 0;
    EpiProj P; EpiNull N;
    __device__ __forceinline__ void operator()(const f32x4 (&acc)[2][2][4][2], const Unit& u, int wr, int wc, int fr, int fq) const {
        if ((blockIdx.x & 7) < 4) P(acc, u, wr, wc, fr, fq); else N(acc, u, wr, wc, fr, fq);
    }
};
template <bool TILE> struct EpiPat {
    static constexpr bool PERM = true, AFTER_DRAIN = false; static constexpr int MIN_VM = 0;
    bf16_t* O; int ld, npn;
    __device__ __forceinline__ void operator()(const f32x4 (&acc)[2][2][4][2], const Unit& u, int wr, int wc, int fr, int fq) const {
        if (u.pn >= npn) return;
        const int r0 = wr * 64 + fr, c0 = wc * 32 + 8 * fq;
#pragma unroll
        for (int ai = 0; ai < 2; ++ai)
#pragma unroll
            for (int m = 0; m < 4; ++m) {
                const int r = r0 + ai * HALF + m * 16;
                bf16_t* rowp = TILE ? O + ((size_t)(u.pm * 12 + u.pn) * 65536 + r * 256 + c0) : O + ((size_t)(u.pm * BM + r) * ld + u.pn * BM + c0);
#pragma unroll
                for (int bj = 0; bj < 2; ++bj) {
                    const f32x4 v0 = acc[ai][bj][m][0], v1 = acc[ai][bj][m][1];
                    u32x4 w; w.x = cvt_pk_bf16(v0[0], v0[1]); w.y = cvt_pk_bf16(v0[2], v0[3]); w.z = cvt_pk_bf16(v1[0], v1[1]); w.w = cvt_pk_bf16(v1[2], v1[3]);
                    *(u32x4*)(rowp + bj * HALF) = w;
                }
            }
    }
};
template <int N> __device__ __forceinline__ void wait_vm() { asm volatile("s_waitcnt vmcnt(%0)" :: "n"(N) : "memory"); }
template <class Epi, class Sched, bool ALIGN_EPI = false, bool SP2 = false>
__device__ __forceinline__ void gemm_phase(PG8_LAS unsigned char* lds, const Gemm g, const Sched& S, const Epi& E) {
    int tid_ = threadIdx.x; asm volatile("" : "+v"(tid_));
    const int tid = tid_, wid = __builtin_amdgcn_readfirstlane(tid >> 6), lane = tid & 63, wr = wid >> 2, wc = wid & 3, fr = lane & 15, fq = lane >> 4;
    const int K = g.K, nt = K / BK;
    constexpr int XV = (SP2 && !Epi::AFTER_DRAIN) ? Epi::MIN_VM : 0;
    unsigned voffA[2], voffB[2];
#pragma unroll
    for (int i = 0; i < 2; ++i) { int R, C; stage_rc(tid * 16 + i * 8192, R, C); const int Rb = Epi::PERM ? ((R & ~31) + perm32(R & 31)) : R;
        voffA[i] = (unsigned)(R * K + C) * 2u; voffB[i] = (unsigned)(Rb * K + C) * 2u; }
    const unsigned kstep = BK * 2;
    const unsigned hstep = (unsigned)HALF * K * 2;
    const unsigned tstep = 2 * hstep;
    const __amdgpu_buffer_rsrc_t srdA = __builtin_amdgcn_make_buffer_rsrc((void*)g.A, (short)0, (int)((size_t)g.M * K * 2), 0x00020000);
    const __amdgpu_buffer_rsrc_t srdB = __builtin_amdgcn_make_buffer_rsrc((void*)g.Bt, (short)0, (int)((size_t)g.N * K * 2), 0x00020000);
    const unsigned ldsb = (unsigned)(size_t)lds;
    const unsigned ldsw = (unsigned)wid * 1024u;
    const int aoff = lds_byte(wr * 64 + fr, fq * 8), boff = lds_byte(wc * 32 + fr, fq * 8);
#define PG8_SA(b, h) (((b) * 2 + (h)) * HTB)
#define PG8_SB(b, h) ((4 + (b) * 2 + (h)) * HTB)
#define PG8_STAGE(bufoff, srd, soff, voff) do { _Pragma("unroll") for (int _i = 0; _i < 2; ++_i) \
        asm volatile("s_mov_b32 m0, %0\n\ts_nop 0\n\tbuffer_load_dwordx4 %1, %2, %3 offen lds" :: "s"(ldsb + (unsigned)(bufoff) + ldsw + _i * 8192u), "v"((voff)[_i]), "s"(srd), "s"((unsigned)(soff)) : "m0", "memory"); } while (0)
#define PG8_LDA(dst, b, h) do { _Pragma("unroll") for (int m = 0; m < 4; ++m) _Pragma("unroll") for (int k = 0; k < 2; ++k) dst[m][k] = *(const PG8_LAS bf16x8*)(lds + PG8_SA(b, h) + aoff + m * 2048 + k * 1024); } while (0)
#define PG8_LDB(dst, b, h) do { _Pragma("unroll") for (int n = 0; n < 2; ++n) _Pragma("unroll") for (int k = 0; k < 2; ++k) dst[n][k] = *(const PG8_LAS bf16x8*)(lds + PG8_SB(b, h) + boff + n * 2048 + k * 1024); } while (0)
#define PG8_MMA(ai, bj, At, Bt) do { __builtin_amdgcn_s_setprio(1); _Pragma("unroll") for (int m = 0; m < 4; ++m) _Pragma("unroll") for (int n = 0; n < 2; ++n) _Pragma("unroll") for (int k = 0; k < 2; ++k) \
        acc[ai][bj][m][n] = __builtin_amdgcn_mfma_f32_16x16x32_bf16(Bt[n][k], At[m][k], acc[ai][bj][m][n], 0, 0, 0); __builtin_amdgcn_s_setprio(0); } while (0)
#define PG8_WAIT_V(n) asm volatile("s_waitcnt vmcnt(" #n ")" ::: "memory")
#define PG8_WAIT_L(n) asm volatile("s_waitcnt lgkmcnt(" #n ")" ::: "memory")
#define PG8_BAR __builtin_amdgcn_s_barrier()
#define PG8_SCHED __builtin_amdgcn_sched_barrier(0)
    Unit cur, nxt; int ui = 0;
    if (!S.next(0, cur)) return;
    f32x4 acc[2][2][4][2];
#pragma unroll
    for (int a = 0; a < 2; ++a)
#pragma unroll
        for (int b = 0; b < 2; ++b)
#pragma unroll
            for (int m = 0; m < 4; ++m)
#pragma unroll
                for (int n = 0; n < 2; ++n) acc[a][b][m][n] = (f32x4){0.f, 0.f, 0.f, 0.f};
    bf16x8 At[4][2], B0[2][2], B1[2][2];
    unsigned cA = (unsigned)cur.pm * tstep, cB = (unsigned)cur.pn * tstep;
    S.a_ready(cur);
    if constexpr (SP2) {
        PG8_STAGE(PG8_SB(0, 0), srdB, cB, voffB); PG8_STAGE(PG8_SB(0, 1), srdB, cB + hstep, voffB); PG8_STAGE(PG8_SA(0, 0), srdA, cA, voffA); PG8_STAGE(PG8_SA(0, 1), srdA, cA + hstep, voffA);
        if (wr == 1) PG8_BAR;
        PG8_WAIT_V(2); PG8_BAR;
        PG8_STAGE(PG8_SB(1, 0), srdB, cB + kstep, voffB); PG8_STAGE(PG8_SA(1, 0), srdA, cA + kstep, voffA); PG8_STAGE(PG8_SB(1, 1), srdB, cB + hstep + kstep, voffB);
        PG8_WAIT_V(6); PG8_BAR;
        PG8_STAGE(PG8_SA(1, 1), srdA, cA + kstep + hstep, voffA);
        if constexpr (XV > 0) {
            unsigned* sp = g.sink + ((size_t)blockIdx.x * 8 + wid) * 64 + lane; const unsigned zero = 0u;
#pragma unroll
            for (int i = 0; i < XV; ++i) asm volatile("global_store_dword %0, %1, off" :: "v"(sp), "v"(zero) : "memory");
        }
    } else {
        PG8_STAGE(PG8_SB(0, 0), srdB, cB, voffB); PG8_STAGE(PG8_SA(0, 0), srdA, cA, voffA); PG8_STAGE(PG8_SB(0, 1), srdB, cB + hstep, voffB); PG8_STAGE(PG8_SA(0, 1), srdA, cA + hstep, voffA);
        if (wr == 1) PG8_BAR;
        PG8_WAIT_V(4); PG8_BAR;
        PG8_STAGE(PG8_SB(1, 0), srdB, cB + kstep, voffB); PG8_STAGE(PG8_SA(1, 0), srdA, cA + kstep, voffA); PG8_STAGE(PG8_SB(1, 1), srdB, cB + hstep + kstep, voffB);
        PG8_WAIT_V(6); PG8_BAR;
    }
    for (;;) {
        const bool has_next = S.next(ui + 1, nxt);
        const unsigned nA = has_next ? (unsigned)nxt.pm * tstep : cA, nB = has_next ? (unsigned)nxt.pn * tstep : cB;
        if constexpr (SP2) {
#define PG8_PAIR(W3) do { \
            const bool last = (t == nt - 2); \
            const unsigned a2 = last ? nA : cA + (unsigned)(t + 2) * kstep, b2 = last ? nB : cB + (unsigned)(t + 2) * kstep;     \
            const unsigned a3 = a2 + kstep, b3 = b2 + kstep;                                \
            if (last && has_next) S.a_ready(nxt); \
              \
            PG8_LDB(B0, 0, 0); PG8_LDB(B1, 0, 1); PG8_SCHED; PG8_LDA(At, 0, 0); \
            W3; PG8_WAIT_L(0); PG8_BAR; PG8_MMA(0, 0, At, B0); PG8_MMA(0, 1, At, B1); PG8_BAR; PG8_SCHED; \
              \
            PG8_LDA(At, 0, 1); PG8_STAGE(PG8_SB(0, 0), srdB, b2, voffB); PG8_STAGE(PG8_SB(0, 1), srdB, b2 + hstep, voffB); PG8_STAGE(PG8_SA(0, 0), srdA, a2, voffA); \
            W3; PG8_WAIT_L(0); PG8_BAR; PG8_MMA(1, 0, At, B0); PG8_MMA(1, 1, At, B1); PG8_BAR; PG8_SCHED; \
              \
            PG8_LDB(B0, 1, 0); PG8_LDB(B1, 1, 1); PG8_SCHED; PG8_LDA(At, 1, 0); PG8_STAGE(PG8_SA(0, 1), srdA, a2 + hstep, voffA); \
            W3; PG8_WAIT_L(0); PG8_BAR; PG8_MMA(0, 0, At, B0); PG8_MMA(0, 1, At, B1); PG8_BAR; PG8_SCHED; \
              \
            PG8_LDA(At, 1, 1); PG8_STAGE(PG8_SB(1, 0), srdB, b3, voffB); PG8_STAGE(PG8_SB(1, 1), srdB, b3 + hstep, voffB); PG8_STAGE(PG8_SA(1, 0), srdA, a3, voffA); \
            PG8_WAIT_V(8); PG8_WAIT_L(0); PG8_BAR; PG8_MMA(1, 0, At, B0); PG8_MMA(1, 1, At, B1); PG8_BAR; PG8_SCHED; \
            PG8_STAGE(PG8_SA(1, 1), srdA, a3 + hstep, voffA); } while (0)
        { const int t = 0; PG8_PAIR(wait_vm<8 + XV>()); }
        for (int t = 2; t < nt; t += 2) PG8_PAIR(PG8_WAIT_V(8));
#undef PG8_PAIR
        } else {
        for (int t = 0; t < nt; t += 2) {
            const bool last = (t == nt - 2);
            const unsigned a1 = cA + (unsigned)(t + 1) * kstep;
            const unsigned a2 = last ? nA : cA + (unsigned)(t + 2) * kstep, b2 = last ? nB : cB + (unsigned)(t + 2) * kstep;
            const unsigned a3 = a2 + kstep, b3 = b2 + kstep;
            if (last && has_next) S.a_ready(nxt);
            PG8_LDB(B0, 0, 0); PG8_SCHED; PG8_LDA(At, 0, 0); PG8_STAGE(PG8_SA(1, 1), srdA, a1 + hstep, voffA);
            PG8_WAIT_L(8); PG8_BAR; PG8_WAIT_L(0); PG8_MMA(0, 0, At, B0); PG8_BAR; PG8_SCHED;
            PG8_LDB(B1, 0, 1); PG8_STAGE(PG8_SB(0, 0), srdB, b2, voffB);
            PG8_BAR; PG8_WAIT_L(0); PG8_MMA(0, 1, At, B1); PG8_BAR;
            PG8_LDA(At, 0, 1); PG8_STAGE(PG8_SA(0, 0), srdA, a2, voffA);
            PG8_BAR; PG8_WAIT_L(0); PG8_MMA(1, 0, At, B0); PG8_BAR; PG8_SCHED;
            PG8_STAGE(PG8_SB(0, 1), srdB, b2 + hstep, voffB);
            PG8_WAIT_V(6); PG8_BAR; PG8_MMA(1, 1, At, B1); PG8_BAR;
            PG8_LDB(B0, 1, 0); PG8_SCHED; PG8_LDA(At, 1, 0); PG8_STAGE(PG8_SA(0, 1), srdA, a2 + hstep, voffA);
            PG8_WAIT_L(8); PG8_BAR; PG8_WAIT_L(0); PG8_MMA(0, 0, At, B0); PG8_BAR; PG8_SCHED;
            PG8_LDB(B1, 1, 1); PG8_STAGE(PG8_SB(1, 0), srdB, b3, voffB);
            PG8_BAR; PG8_WAIT_L(0); PG8_MMA(0, 1, At, B1); PG8_BAR;
            PG8_LDA(At, 1, 1); PG8_STAGE(PG8_SA(1, 0), srdA, a3, voffA);
            PG8_BAR; PG8_WAIT_L(0); PG8_MMA(1, 0, At, B0); PG8_BAR; PG8_SCHED;
            PG8_STAGE(PG8_SB(1, 1), srdB, b3 + hstep, voffB);
            PG8_WAIT_V(6); PG8_BAR; PG8_MMA(1, 1, At, B1); PG8_BAR;
        }
        }
        if constexpr (ALIGN_EPI) { if (wr == 0) PG8_BAR; }
        if constexpr (!Epi::AFTER_DRAIN) { E(acc, cur, wr, wc, fr, fq); S.done(cur); }
        if (!has_next) break;
#pragma unroll
        for (int a = 0; a < 2; ++a)
#pragma unroll
            for (int b = 0; b < 2; ++b)
#pragma unroll
                for (int m = 0; m < 4; ++m)
#pragma unroll
                    for (int n = 0; n < 2; ++n) acc[a][b][m][n] = (f32x4){0.f, 0.f, 0.f, 0.f};
        cur = nxt; cA = nA; cB = nB; ++ui;
        if constexpr (ALIGN_EPI) { if (wr == 1) PG8_BAR; }
    }
    PG8_WAIT_V(0);
    if constexpr (!ALIGN_EPI) { if (wr == 0) PG8_BAR; }
    PG8_BAR;
    if constexpr (Epi::AFTER_DRAIN) { E.fused(acc, cur, wr, wc, fr, fq, lds, wid, lane); S.done(cur); }
#undef PG8_SA
#undef PG8_SB
#undef PG8_STAGE
#undef PG8_LDA
#undef PG8_LDB
#undef PG8_MMA
#undef PG8_WAIT_V
#undef PG8_WAIT_L
#undef PG8_BAR
#undef PG8_SCHED
}
}

constexpr int NWAVES = 8;
constexpr int NB = 32, SEQ = 2048, DM = 1024, MROWS = NB * SEQ;
constexpr int NPROJ = 3840;
constexpr int C_ZA = 1536, C_QB = 2048, C_ZB = 2560, C_IQ = 3072, C_CKV = 3584, C_IK = 3712;
constexpr float EPSF = 1e-6f;
constexpr float LOG2E = 1.4426950408889634f;
__host__ __device__ __forceinline__ int proj_src_col(int n) {
    if (n < 2048) return n;
    if (n < 2560) return n - 2048 + 2056;
    if (n < 3072) return n - 2560 + 2696;
    if (n < 3584) return n - 3072 + 3208;
    if (n < 3712) return n - 3584 + 2568;
    if (n < 3776) return n - 3712 + 3720;
    if (n < 3784) return n - 3776 + 2048;
    if (n < 3792) return n;
    return -1;
}
__device__ const unsigned char T5_BUCKET[128] = {0,1,2,3,4,5,6,7,8,9,10,11,12,13,14,15,16,16,16,17,17,18,18,18,19,19,19,20,20,20,20,21,21,21,21,22,22,22,22,22,23,23,23,23,23,23,24,24,24,24,24,24,25,25,25,25,25,25,25,26,26,26,26,26,26,26,26,27,27,27,27,27,27,27,27,27,27,28,28,28,28,28,28,28,28,28,28,29,29,29,29,29,29,29,29,29,29,29,29,30,30,30,30,30,30,30,30,30,30,30,30,30,30,31,31,31,31,31,31,31,31,31,31,31,31,31,31,31};

constexpr size_t MiB = 1u << 20;
constexpr size_t WS_CTL = 0, CTL_ZERO_BYTES = 1 * MiB;
constexpr size_t WS_MOD = 1 * MiB;
constexpr size_t WS_WUV = 2 * MiB;
constexpr size_t WS_WOUT = 3 * MiB;
constexpr size_t WS_WIN = 5 * MiB;
constexpr size_t WS_KVSS = 13 * MiB;
constexpr size_t WS_AUX = 14 * MiB;
constexpr size_t WS_XN = 32 * MiB;
constexpr size_t WS_PROJ = 160 * MiB;
constexpr size_t WS_SCR = 640 * MiB;
constexpr size_t WS_END = 768 * MiB;
constexpr int CW_TMO = 0, CW_QUEUE = 64, CW_BAR = 4096;

constexpr int LDS_BYTES = 163840;
constexpr int MISC_OFF = LDS_BYTES - 256;
constexpr int SCRATCH_BYTES = MISC_OFF;

#define GAS __attribute__((address_space(1)))
#define LAS __attribute__((address_space(3)))
typedef unsigned short bf16;
typedef unsigned v4u __attribute__((ext_vector_type(4)));
typedef unsigned v2u __attribute__((ext_vector_type(2)));
typedef float f32x4 __attribute__((ext_vector_type(4)));
typedef float f32x16 __attribute__((ext_vector_type(16)));
typedef short bf16x8 __attribute__((ext_vector_type(8)));
typedef GAS unsigned gu32;
#define RLX_AGENT __ATOMIC_RELAXED, __HIP_MEMORY_SCOPE_AGENT
#define LDS_WAIT() asm volatile("s_waitcnt lgkmcnt(0)" ::: "memory")
#define MFMA32(a, b, c) __builtin_amdgcn_mfma_f32_32x32x16_bf16((a), (b), (c), 0, 0, 0)
#define MFMA16F(a, b, c) __builtin_amdgcn_mfma_f32_16x16x4f32((a), (b), (c), 0, 0, 0)
__device__ __forceinline__ unsigned f2bf(float f) { unsigned u = __builtin_bit_cast(unsigned, f); return (u + 0x7fffu + ((u >> 16) & 1u)) >> 16; }
__device__ __forceinline__ unsigned pk2(float lo, float hi) { return f2bf(lo) | (f2bf(hi) << 16); }
__device__ __forceinline__ float bf2f(unsigned short b) { return __builtin_bit_cast(float, ((unsigned)b) << 16); }
__device__ __forceinline__ float bflo(unsigned w) { return __builtin_bit_cast(float, w << 16); }
__device__ __forceinline__ float bfhi(unsigned w) { return __builtin_bit_cast(float, w & 0xffff0000u); }
__device__ __forceinline__ float rcpf_(float x) { return __builtin_amdgcn_rcpf(x); }
__device__ __forceinline__ float rsqf_(float x) { return __builtin_amdgcn_rsqf(x); }
__device__ __forceinline__ float siluf(float x) { return x * __builtin_amdgcn_rcpf(1.0f + __builtin_amdgcn_exp2f(-1.4426950408889634f * x)); }
__device__ __forceinline__ float wave_sum(float v) {
#pragma unroll
    for (int o = 1; o < 64; o <<= 1) v += __shfl_xor(v, o);
    return v;
}

__device__ __forceinline__ float wave_sum_f(float v) {
#define WSF_(ctl, rm, bm) v += __builtin_bit_cast(float, __builtin_amdgcn_update_dpp(0, __builtin_bit_cast(int, v), ctl, rm, bm, false))
    WSF_(0x111, 0xf, 0xf); WSF_(0x112, 0xf, 0xf); WSF_(0x114, 0xf, 0xe); WSF_(0x118, 0xf, 0xc); WSF_(0x142, 0xa, 0xf); WSF_(0x143, 0xc, 0xf);
#undef WSF_
    return __builtin_bit_cast(float, __builtin_amdgcn_readlane(__builtin_bit_cast(int, v), 63));
}
__device__ __forceinline__ int wave_sum_i(int v) {
    v += __builtin_amdgcn_update_dpp(0, v, 0x111, 0xf, 0xf, false);
    v += __builtin_amdgcn_update_dpp(0, v, 0x112, 0xf, 0xf, false);
    v += __builtin_amdgcn_update_dpp(0, v, 0x114, 0xf, 0xe, false);
    v += __builtin_amdgcn_update_dpp(0, v, 0x118, 0xf, 0xc, false);
    v += __builtin_amdgcn_update_dpp(0, v, 0x142, 0xa, 0xf, false);
    v += __builtin_amdgcn_update_dpp(0, v, 0x143, 0xc, 0xf, false);
    return __builtin_amdgcn_readlane(v, 63);
}
__device__ __forceinline__ float wave_max(float v) {
    const int ninf = (int)0xff800000u;
#define WM_STEP(ctrl, rm, bm) v = fmaxf(v, __builtin_bit_cast(float, __builtin_amdgcn_update_dpp(ninf, __builtin_bit_cast(int, v), ctrl, rm, bm, false)))
    WM_STEP(0x111, 0xf, 0xf); WM_STEP(0x112, 0xf, 0xf); WM_STEP(0x114, 0xf, 0xe); WM_STEP(0x118, 0xf, 0xc); WM_STEP(0x142, 0xa, 0xf); WM_STEP(0x143, 0xc, 0xf);
#undef WM_STEP
    return __builtin_bit_cast(float, __builtin_amdgcn_readlane(__builtin_bit_cast(int, v), 63));
}
#define XB_TMO      128
#define XB_XCNT(j)  (256  + 64 * (j))
#define XB_XSUB(j)  (1280 + 64 * (j))
#define XB_XGEN(j)  (2304 + 64 * (j))
#define XB_TOP      3328
#define XB_TOPGEN   3392
#define XCD_BAR_WORDS 3456
#define XB_SPIN_CAP (1u << 18)

__device__ __forceinline__ unsigned xb_ld(unsigned* p)              { return __hip_atomic_load(p, __ATOMIC_RELAXED, __HIP_MEMORY_SCOPE_AGENT); }
__device__ __forceinline__ unsigned xb_add(unsigned* p, unsigned v) { return __hip_atomic_fetch_add(p, v, __ATOMIC_RELAXED, __HIP_MEMORY_SCOPE_AGENT); }
__device__ __forceinline__ unsigned xb_xcc_id() { return (unsigned)__builtin_amdgcn_s_getreg((3 << 11) | 20) & 0xFu; }
#define XB_SPIN(cond, bar) do { unsigned _sp = 0; while (cond) { __builtin_amdgcn_s_sleep(1); \
    if ((++_sp & 255u) == 0u) { if (xb_ld(&(bar)[XB_TMO])) break; if (_sp > XB_SPIN_CAP) { atomicAdd(&(bar)[XB_TMO], 1u); break; } } } } while (0)

struct XcdBarrier {
    unsigned* bar; unsigned x;
    volatile LAS unsigned* st;
};

__device__ __forceinline__ XcdBarrier xcd_barrier_post(unsigned* bar, volatile LAS unsigned* st) {
    XcdBarrier b; b.bar = bar; b.x = xb_xcc_id(); b.st = st;
    if (threadIdx.x == 0) (void)xb_add(&bar[XB_XCNT(b.x)], 1u);
    return b;
}
__device__ __forceinline__ void xcd_barrier_complete(unsigned* bar, unsigned x, unsigned& nloc, unsigned& nx) {
    const unsigned G = gridDim.x * gridDim.y * gridDim.z;
    unsigned sum, cnt, mine, sp = 0u;
    for (;;) {
        sum = 0u; cnt = 0u; mine = 0u;
#pragma unroll
        for (unsigned j = 0; j < 16; ++j) { const unsigned c = xb_ld(&bar[XB_XCNT(j)]); sum += c; cnt += (c > 0u) ? 1u : 0u; mine = (j == x) ? c : mine; }
        if (sum == G) break;
        __builtin_amdgcn_s_sleep(1);
        if ((++sp & 255u) == 0u) { if (xb_ld(&bar[XB_TMO])) break; if (sp > XB_SPIN_CAP) { atomicAdd(&bar[XB_TMO], 1u); break; } }
    }
    nloc = mine > 0u ? mine : 1u; nx = cnt > 0u ? cnt : 1u;
}

__device__ __forceinline__ void xcd_barrier(const XcdBarrier& b) {
    asm volatile("s_waitcnt vmcnt(0)" ::: "memory");
    __syncthreads();
    if (threadIdx.x == 0) {
        unsigned* bar = b.bar;
        __builtin_amdgcn_s_waitcnt(0);
        unsigned nloc = b.st[0], nx = b.st[1];
        if (nloc == 0u) { xcd_barrier_complete(bar, b.x, nloc, nx); b.st[0] = nloc; b.st[1] = nx; }
        const unsigned old = xb_add(&bar[XB_XSUB(b.x)], 1u);
        const unsigned gen = old / nloc;
        if (old + 1u == (gen + 1u) * nloc) {
            __builtin_amdgcn_fence(__ATOMIC_RELEASE, "agent");
            asm volatile("s_waitcnt vmcnt(0)" ::: "memory");
            const unsigned og = xb_add(&bar[XB_TOP], 1u);
            const unsigned tg = og / nx;
            if (og + 1u == (tg + 1u) * nx) xb_add(&bar[XB_TOPGEN], 1u);
            else XB_SPIN(xb_ld(&bar[XB_TOPGEN]) == tg, bar);
            __builtin_amdgcn_fence(__ATOMIC_ACQUIRE, "agent");
            xb_add(&bar[XB_XGEN(b.x)], 1u);
            asm volatile("s_waitcnt vmcnt(0)" ::: "memory");
        } else {
            XB_SPIN(xb_ld(&bar[XB_XGEN(b.x)]) == gen, bar);
            __builtin_amdgcn_fence(__ATOMIC_ACQUIRE, "agent");
            asm volatile("s_waitcnt vmcnt(0)" ::: "memory");
        }
    }
    __syncthreads();
}

struct Frame {
    LAS unsigned char* lds;
    volatile LAS unsigned* MISC;
    gu32* ctl;
    int tid, lane, wave;
    int vcu, G;
    unsigned char* ws;
};
#define P_X        (args.in[0])
#define P_C        (args.in[1])
#define P_WADA     (args.in[2])
#define P_BADA     (args.in[3])
#define P_GPRE     (args.in[4])
#define P_WIN      (args.in[5])
#define P_CONVW    (args.in[6])
#define P_ALOG     (args.in[7])
#define P_DTB      (args.in[8])
#define P_GGDN     (args.in[9])
#define P_GKV      (args.in[10])
#define P_WUV      (args.in[11])
#define P_RELB     (args.in[12])
#define P_WOUT     (args.in[13])
#define P_GPOST    (args.in[14])
#define P_OUT      (args.out)
#define W_MOD      ((float*)(F.ws + WS_MOD))
#define W_WUVT     ((bf16*)(F.ws + WS_WUV))
#define W_WOUTT    ((bf16*)(F.ws + WS_WOUT))
#define W_WINT     ((bf16*)(F.ws + WS_WIN))
#define W_KVSS     ((float*)(F.ws + WS_KVSS))
#define W_AUX      ((float*)(F.ws + WS_AUX))
#define W_XN       ((bf16*)(F.ws + WS_XN))
#define W_OAB      ((bf16*)(F.ws + WS_XN))
#define W_PROJ     ((bf16*)(F.ws + WS_PROJ))
#define W_MIX      ((bf16*)(F.ws + WS_PROJ))
#define W_SCR      ((float*)(F.ws + WS_SCR))
struct Args { const float* in[15]; float* out; unsigned char* ws; int ph_lo, ph_hi, li, pad; };

template <class CM>
__device__ __forceinline__ void transpose_item(const float* W, int ldw, bf16* WT, int K, int k0, int n0, LAS float* scr, int lane, CM cm) {
    const int nn = lane & 31, sc = cm(n0 + nn);
#pragma unroll 8
    for (int i = 0; i < 32; ++i) { const int kk = 2 * i + (lane >> 5); scr[kk * 33 + nn] = sc >= 0 ? __builtin_nontemporal_load(W + (size_t)(k0 + kk) * ldw + sc) : 0.f; }
    LDS_WAIT(); asm volatile("" ::: "memory");
    const int c = lane & 7;
#pragma unroll
    for (int j = 0; j < 4; ++j) { const int n = (lane >> 3) + 8 * j; const LAS float* s = scr + (8 * c) * 33 + n;
        v4u o; o.x = pk2(s[0 * 33], s[1 * 33]); o.y = pk2(s[2 * 33], s[3 * 33]); o.z = pk2(s[4 * 33], s[5 * 33]); o.w = pk2(s[6 * 33], s[7 * 33]);
        *(GAS v4u*)(WT + (size_t)(n0 + n) * K + k0 + 8 * c) = o; }
    LDS_WAIT(); asm volatile("" ::: "memory");
}
struct CmIdent { __device__ __forceinline__ int operator()(int n) const { return n; } };
struct CmProj { __device__ __forceinline__ int operator()(int n) const { return proj_src_col(n); } };

__device__ __forceinline__ void p0_prologue(Frame& F, const Args& args) {
    LAS float* scr = (LAS float*)(F.lds + F.wave * 16384);
    const int gw = F.vcu * NWAVES + F.wave, NGW = F.G * NWAVES;
    constexpr int I_IN = 16 * (NPROJ / 32), I_OUT = 16 * 32, I_UV = 4 * 2 * 4;
    for (int it = gw; it < I_IN + I_OUT + I_UV; it += NGW) {
        int r = it;
        if (r < I_IN) { const int kb = r / (NPROJ / 32), nb = r % (NPROJ / 32); transpose_item(P_WIN, 3792, W_WINT, 1024, 64 * kb, 32 * nb, scr, F.lane, CmProj()); continue; }
        r -= I_IN;
        if (r < I_OUT) { const int kb = r / 32, nb = r % 32; transpose_item(P_WOUT, 1024, W_WOUTT, 1024, 64 * kb, 32 * nb, scr, F.lane, CmIdent()); continue; }
        r -= I_OUT;
        { const int hd = r >> 3, kb = (r >> 2) & 1, nb = r & 3; transpose_item(P_WUV + (size_t)hd * 16384, 128, W_WUVT + (size_t)hd * 16384, 128, 64 * kb, 32 * nb, scr, F.lane, CmIdent()); }
    }
    __syncthreads();
    if (F.vcu < 192) {
        LAS float* SC = (LAS float*)F.lds;
        for (int e = F.tid; e < NB * 1024; e += NWAVES * 64) { const int b = e >> 10, k = e & 1023; SC[k * 33 + b] = siluf(P_C[e]); }
        __syncthreads();
        const int col = F.tid & 15, ks = F.tid >> 4, n = F.vcu * 16 + col;
        float acc[32];
#pragma unroll
        for (int b = 0; b < 32; ++b) acc[b] = 0.f;
        for (int kk = 0; kk < 32; ++kk) { const int k = ks * 32 + kk; const float w = __builtin_nontemporal_load(P_WADA + (size_t)k * 3072 + n);
#pragma unroll
            for (int b = 0; b < 32; ++b) acc[b] += SC[k * 33 + b] * w; }
        __syncthreads();
        LAS float* RED = (LAS float*)F.lds;
#pragma unroll
        for (int b = 0; b < 32; ++b) RED[(ks * 32 + b) * 16 + col] = acc[b];
        __syncthreads();
        { const int b = F.tid >> 4; float s = 0.f;
            for (int k2 = 0; k2 < 32; ++k2) s += RED[(k2 * 32 + b) * 16 + col];
            W_MOD[b * 3072 + n] = s + P_BADA[n]; }
        __syncthreads();
    }
}

__device__ __forceinline__ void p1_norm(Frame& F, const Args& args) {
    const int gw = F.vcu * NWAVES + F.wave, NGW = F.G * NWAVES;
    for (int m = 2 * gw; m < MROWS; m += 2 * NGW) {
        const int b = m >> 11;
        const GAS f32x4* xr = (const GAS f32x4*)(P_X + (size_t)m * DM) + F.lane;
        f32x4 v[2][4]; float ss[2] = {0.f, 0.f};
#pragma unroll
        for (int q = 0; q < 2; ++q)
#pragma unroll
            for (int j = 0; j < 4; ++j) v[q][j] = __builtin_nontemporal_load(xr + q * 256 + 64 * j);
#pragma unroll
        for (int q = 0; q < 2; ++q)
#pragma unroll
            for (int j = 0; j < 4; ++j) ss[q] += (v[q][j].x * v[q][j].x + v[q][j].y * v[q][j].y) + (v[q][j].z * v[q][j].z + v[q][j].w * v[q][j].w);
        const float rstd0 = rsqf_(wave_sum(ss[0]) * (1.0f / DM) + EPSF), rstd1 = rsqf_(wave_sum(ss[1]) * (1.0f / DM) + EPSF);
        const float* mb = W_MOD + b * 3072;
        GAS unsigned long long* o8 = (GAS unsigned long long*)(W_XN + (size_t)m * DM) + F.lane;
#pragma unroll
        for (int j = 0; j < 4; ++j) { const int col = F.lane * 4 + 256 * j;
            const f32x4 g = *(const f32x4*)(P_GPRE + col), sh = *(const f32x4*)(mb + col), sc = *(const f32x4*)(mb + 1024 + col);
            const f32x4 gs = g * (sc + 1.0f);
            const f32x4 o0 = v[0][j] * rstd0 * gs + sh, o1 = v[1][j] * rstd1 * gs + sh;
            o8[64 * j] = (unsigned long long)pg8::cvt_pk_bf16(o0.x, o0.y) | ((unsigned long long)pg8::cvt_pk_bf16(o0.z, o0.w) << 32);
            o8[256 + 64 * j] = (unsigned long long)pg8::cvt_pk_bf16(o1.x, o1.y) | ((unsigned long long)pg8::cvt_pk_bf16(o1.z, o1.w) << 32); }
    }
}

__device__ __forceinline__ void p5_final(Frame& F, const Args& args) {
    const int gw = F.vcu * NWAVES + F.wave, NGW = F.G * NWAVES;
    for (int m = 2 * gw; m < MROWS; m += 2 * NGW) {
        const int b = m >> 11;
        const GAS v2u* mr = (const GAS v2u*)(W_MIX + (size_t)m * DM) + F.lane;
        const GAS f32x4* xr = (const GAS f32x4*)(P_X + (size_t)m * DM) + F.lane;
        GAS f32x4* orow = (GAS f32x4*)(P_OUT + (size_t)m * DM) + F.lane;
        v2u w[2][4]; f32x4 xv[2][4];
#pragma unroll
        for (int q = 0; q < 2; ++q)
#pragma unroll
            for (int j = 0; j < 4; ++j) { w[q][j] = mr[q * 256 + 64 * j]; xv[q][j] = __builtin_nontemporal_load(xr + q * 256 + 64 * j); }
        f32x4 v[2][4]; float ss[2] = {0.f, 0.f};
#pragma unroll
        for (int q = 0; q < 2; ++q)
#pragma unroll
            for (int j = 0; j < 4; ++j) { v[q][j].x = bflo(w[q][j].x); v[q][j].y = bfhi(w[q][j].x); v[q][j].z = bflo(w[q][j].y); v[q][j].w = bfhi(w[q][j].y);
                ss[q] += (v[q][j].x * v[q][j].x + v[q][j].y * v[q][j].y) + (v[q][j].z * v[q][j].z + v[q][j].w * v[q][j].w); }
        const float rstd0 = rsqf_(wave_sum(ss[0]) * (1.0f / DM) + EPSF), rstd1 = rsqf_(wave_sum(ss[1]) * (1.0f / DM) + EPSF);
        const float* gt = W_MOD + b * 3072 + 2048;
#pragma unroll
        for (int j = 0; j < 4; ++j) { const int col = F.lane * 4 + 256 * j;
            const f32x4 g = *(const f32x4*)(P_GPOST + col), ga = *(const f32x4*)(gt + col);
            const f32x4 gg = g * ga;
            __builtin_nontemporal_store(xv[0][j] + gg * (v[0][j] * rstd0), orow + 64 * j);
            __builtin_nontemporal_store(xv[1][j] + gg * (v[1][j] * rstd1), orow + 256 + 64 * j); }
    }
}

__device__ __forceinline__ unsigned cvtpk(float lo, float hi) { return pg8::cvt_pk_bf16(lo, hi); }
__device__ __forceinline__ v2u pack4(float a, float b, float c, float d) { v2u r; r.x = cvtpk(a, b); r.y = cvtpk(c, d); return r; }
__device__ __forceinline__ bf16x8 pack8(float a, float b, float c, float d, float e, float f, float g, float h) { v4u r; r.x = cvtpk(a, b); r.y = cvtpk(c, d); r.z = cvtpk(e, f); r.w = cvtpk(g, h); return __builtin_bit_cast(bf16x8, r); }
__device__ __forceinline__ bf16x8 lds16(const LAS unsigned char* p) { return *(const LAS bf16x8*)p; }
__device__ __forceinline__ bf16x8 lds8x2(const LAS unsigned char* p) { const v2u lo = *(const LAS v2u*)p, hi = *(const LAS v2u*)(p + 16); v4u r; r.x = lo.x; r.y = lo.y; r.z = hi.x; r.w = hi.y; return __builtin_bit_cast(bf16x8, r); }
template <int S> __device__ __forceinline__ bf16x8 acc_frag(const f32x16& a) { return pack8(a[8 * S + 0], a[8 * S + 1], a[8 * S + 2], a[8 * S + 3], a[8 * S + 4], a[8 * S + 5], a[8 * S + 6], a[8 * S + 7]); }

__device__ __forceinline__ float row16_sum(float v) {
#define R16_STEP(ctrl) v += __builtin_bit_cast(float, __builtin_amdgcn_update_dpp(0, __builtin_bit_cast(int, v), ctrl, 0xf, 0xf, false))
    R16_STEP(0x121); R16_STEP(0x122); R16_STEP(0x124); R16_STEP(0x128);
#undef R16_STEP
    return v;
}

__device__ __forceinline__ void gdn_unit(Frame& F, const Args& args, const int b, const int h) {
    LAS unsigned char* const L = F.lds;
    const int tid = F.tid, lane = F.lane, wv = F.wave, l31_0 = lane & 31, hh_0 = lane >> 5;
    int tidv = tid, lanev = lane;
    constexpr int P128 = 272, P64 = 144;
    constexpr int O_KH = 0, O_QH = O_KH + 17408, O_KGT = O_QH + 17408, O_VBT = O_KGT + 18432, O_KBGT = O_VBT + 18432, O_LM = O_KBGT + 18432, O_T = O_LM + 17408,
                  O_AT = O_T + 17408, O_CW = O_AT + 9216, O_SM = O_CW + 6144, O_PSO = O_SM + 2560, O_OF = O_PSO + 2048, O_END = O_OF + 17408;
    static_assert(O_END <= SCRATCH_BYTES, "gdn LDS map");
    constexpr int O_W = O_LM, O_VNT = O_VBT;
    LAS float* const SMb = (LAS float*)(L + O_SM);
    LAS float* const LM = (LAS float*)(L + O_LM);
    LAS float* const TT = (LAS float*)(L + O_T);
    LAS float* const CW = (LAS float*)(L + O_CW);
    LAS float* const PSO = (LAS float*)(L + O_PSO);
    const int mt = wv >> 2, nt = wv & 3;
    f32x16 S[4];
#pragma unroll
    for (int k = 0; k < 4; ++k)
#pragma unroll
        for (int r = 0; r < 16; ++r) S[k][r] = 0.f;
    const float alog_e = __expf(P_ALOG[h]), dtb = P_DTB[h];
#define GDN_GATES(n_) do { LAS float* _sm = SMb + ((n_) & 1) * 320; const float* _ap = W_AUX + (size_t)(b * SEQ + (n_) * 64 + lanev) * 16; \
        const float _bb = _ap[h], _aa = _ap[4 + h]; const float _beta = rcpf_(1.0f + __expf(-_bb)); const float _xs = _aa + dtb; \
        const float _sp = _xs > 20.f ? _xs : log1pf(__expf(_xs)); float _gc = -alog_e * _sp; \
        _Pragma("unroll") for (int _o = 1; _o < 64; _o <<= 1) { const float _t = __shfl_up(_gc, _o); if (lanev >= _o) _gc += _t; } \
        const float _gl = __shfl(_gc, 63); _sm[lanev] = _gc; _sm[64 + lanev] = _beta; _sm[128 + lanev] = __expf(_gc); _sm[192 + lanev] = __expf(_gl - _gc); \
        if (lanev == 0) _sm[256] = __expf(_gl); } while (0)
    if (wv == 6) GDN_GATES(0);
    for (int e = tidv; e < 3 * 4 * 128; e += NWAVES * 64) { const int ts_ = e >> 9, tap = (e >> 7) & 3, ch = e & 127; CW[e] = P_CONVW[tap * 1536 + ts_ * 512 + h * 128 + ch]; }
    const int ts = tid >> 8;
    int cgv = tid & 15, tpv = (tid >> 4) & 15;
#define GDN_ROWS(dst_, n_, chan_) do { const bf16* _src = W_PROJ + (size_t)(b * SEQ + (n_) * 64 + 4 * tpv - 3) * NPROJ + (chan_); \
        _Pragma("unroll") for (int _i = 0; _i < 7; ++_i) { v4u _z; _z.x = 0u; _z.y = 0u; _z.z = 0u; _z.w = 0u; dst_[_i] = _z; \
            if ((n_) > 0 || 4 * tpv - 3 + _i >= 0) dst_[_i] = __builtin_nontemporal_load((const GAS v4u*)(_src + (size_t)_i * NPROJ)); } } while (0)
#define GDN_OUT(rowb_) do { const int _tok = tidv >> 3, _dv0 = (tidv & 7) * 16; const size_t _row = (size_t)(rowb_) + _tok; \
        const LAS v4u* _op = (const LAS v4u*)(L + O_OF + _tok * P128 + _dv0 * 2); const v4u _o0 = _op[0], _o1 = _op[1]; \
        const LAS f32x4* _pp = (const LAS f32x4*)(PSO + _tok * 8); const f32x4 _a = _pp[0], _c = _pp[1]; \
        const float _rstd = rsqf_((((_a.x + _a.y) + (_a.z + _a.w)) + ((_c.x + _c.y) + (_c.z + _c.w))) * (1.0f / 128.0f) + EPSF); \
        const bf16* _zp = W_PROJ + _row * NPROJ + C_ZA + h * 128 + _dv0; const v4u _z0 = __builtin_nontemporal_load((const GAS v4u*)_zp), _z1 = __builtin_nontemporal_load((const GAS v4u*)(_zp + 8)); \
        const unsigned _ow[8] = {_o0.x, _o0.y, _o0.z, _o0.w, _o1.x, _o1.y, _o1.z, _o1.w}, _zw[8] = {_z0.x, _z0.y, _z0.z, _z0.w, _z1.x, _z1.y, _z1.z, _z1.w}; unsigned _rw[8]; \
        _Pragma("unroll") for (int _k = 0; _k < 4; ++_k) { const f32x4 _g = *(const f32x4*)(P_GGDN + _dv0 + 4 * _k); \
            _rw[2 * _k] = cvtpk(bflo(_ow[2 * _k]) * _rstd * _g.x * siluf(bflo(_zw[2 * _k])), bfhi(_ow[2 * _k]) * _rstd * _g.y * siluf(bfhi(_zw[2 * _k]))); \
            _rw[2 * _k + 1] = cvtpk(bflo(_ow[2 * _k + 1]) * _rstd * _g.z * siluf(bflo(_zw[2 * _k + 1])), bfhi(_ow[2 * _k + 1]) * _rstd * _g.w * siluf(bfhi(_zw[2 * _k + 1]))); } \
        bf16* _dst = W_OAB + _row * DM + h * 128 + _dv0; v4u _w0, _w1; _w0.x = _rw[0]; _w0.y = _rw[1]; _w0.z = _rw[2]; _w0.w = _rw[3]; _w1.x = _rw[4]; _w1.y = _rw[5]; _w1.z = _rw[6]; _w1.w = _rw[7]; \
        *(GAS v4u*)_dst = _w0; *(GAS v4u*)(_dst + 8) = _w1; } while (0)
    __syncthreads();

    unsigned pf_sink = 0u;
    for (int n = 0; n < 32; ++n) {
        const int rowbase = b * SEQ + n * 64;
        LAS float* const SMf = SMb + (n & 1) * 320;
        tidv = tid; lanev = lane; cgv = tid & 15; tpv = (tid >> 4) & 15;
        asm volatile("" : "+v"(tidv), "+v"(lanev), "+v"(cgv), "+v"(tpv));
        int l31 = lanev & 31, hh = lanev >> 5, cg = cgv, tp = tpv;
        if (wv == 6 && n + 1 < 32) GDN_GATES(n + 1);
        float val[4][8];
#define GDN_CONV(rows_, tsel_) do { \
            _Pragma("unroll") for (int _j = 0; _j < 4; ++_j) _Pragma("unroll") for (int _e = 0; _e < 8; ++_e) val[_j][_e] = 0.f; \
            _Pragma("unroll") for (int _tap = 0; _tap < 4; ++_tap) { const LAS f32x4* _cp = (const LAS f32x4*)(CW + ((tsel_) * 4 + _tap) * 128 + cg * 8); const f32x4 _c0 = _cp[0], _c1 = _cp[1]; \
                const float _cw[8] = {_c0.x, _c0.y, _c0.z, _c0.w, _c1.x, _c1.y, _c1.z, _c1.w}; \
                _Pragma("unroll") for (int _j = 0; _j < 4; ++_j) { const v4u _raw = rows_[_j + _tap]; \
                    const float _in[8] = {bflo(_raw.x), bfhi(_raw.x), bflo(_raw.y), bfhi(_raw.y), bflo(_raw.z), bfhi(_raw.z), bflo(_raw.w), bfhi(_raw.w)}; \
                    _Pragma("unroll") for (int _e = 0; _e < 8; ++_e) val[_j][_e] += _in[_e] * _cw[_e]; } } \
            _Pragma("unroll") for (int _j = 0; _j < 4; ++_j) _Pragma("unroll") for (int _e = 0; _e < 8; ++_e) val[_j][_e] = siluf(val[_j][_e]); } while (0)
        v4u rq[7], rv[7];
        GDN_ROWS(rq, n, ts * 512 + h * 128 + cgv * 8);
        if (wv < 4) GDN_ROWS(rv, n, 1024 + h * 128 + cgv * 8);
        if (wv == 7 && n + 1 < 32) {
#pragma unroll
            for (int i = 0; i < 9; ++i) { const int idx = i * 64 + lanev; const int rr = idx >> 3, ln = idx & 7;
                if (idx < 67 * 8) { const bf16* pt = W_PROJ + (size_t)(rowbase + 61 + rr) * NPROJ + (ln >> 1) * 512 + h * 128 + (ln & 1) * 64;
                    asm volatile("global_load_dword %0, %1, off" : "+v"(pf_sink) : "v"(pt) : "memory"); } }
        }
        {
            GDN_CONV(rq, ts);
#pragma unroll
            for (int j = 0; j < 4; ++j) { float ss = 0.f;
#pragma unroll
                for (int e = 0; e < 8; ++e) ss += val[j][e] * val[j][e];
                ss = row16_sum(ss);
                float r = rsqf_(ss + EPSF); if (ts == 0) r *= 0.08838834764831845f;
#pragma unroll
                for (int e = 0; e < 8; ++e) val[j][e] *= r; }
            if (ts == 0) {
#pragma unroll
                for (int j = 0; j < 4; ++j) *(LAS bf16x8*)(L + O_QH + (4 * tp + j) * P128 + cg * 16) = pack8(val[j][0], val[j][1], val[j][2], val[j][3], val[j][4], val[j][5], val[j][6], val[j][7]);
            } else {
                float ek[4], bg[4];
#pragma unroll
                for (int j = 0; j < 4; ++j) { ek[j] = SMf[192 + 4 * tp + j]; bg[j] = SMf[64 + 4 * tp + j] * SMf[128 + 4 * tp + j]; }
#pragma unroll
                for (int j = 0; j < 4; ++j) *(LAS bf16x8*)(L + O_KH + (4 * tp + j) * P128 + cg * 16) = pack8(val[j][0], val[j][1], val[j][2], val[j][3], val[j][4], val[j][5], val[j][6], val[j][7]);
#pragma unroll
                for (int e = 0; e < 8; ++e) {
                    *(LAS v2u*)(L + O_KGT + (cg * 8 + e) * P64 + tp * 8) = pack4(val[0][e] * ek[0], val[1][e] * ek[1], val[2][e] * ek[2], val[3][e] * ek[3]);
                    *(LAS v2u*)(L + O_KBGT + (cg * 8 + e) * P64 + tp * 8) = pack4(val[0][e] * bg[0], val[1][e] * bg[1], val[2][e] * bg[2], val[3][e] * bg[3]); }
            }
        }
        if (n > 0) GDN_OUT(rowbase - 64);
        if (wv < 4) {
            GDN_CONV(rv, 2);
            float be[4];
#pragma unroll
            for (int j = 0; j < 4; ++j) be[j] = SMf[64 + 4 * tp + j];
#pragma unroll
            for (int e = 0; e < 8; ++e) *(LAS v2u*)(L + O_VBT + (cg * 8 + e) * P64 + tp * 8) = pack4(val[0][e] * be[0], val[1][e] * be[1], val[2][e] * be[2], val[3][e] * be[3]);
        }
        for (int e = tidv; e < 64 * 68; e += NWAVES * 64) TT[e] = 0.f;
        __syncthreads();
        if (wv < 4) {
            const int ti = wv >> 1, tj = wv & 1;
            f32x16 C;
#pragma unroll
            for (int r = 0; r < 16; ++r) C[r] = 0.f;
            if (ti >= tj) {
                bf16x8 fa[8], fb[8];
#pragma unroll
                for (int s = 0; s < 8; ++s) { fa[s] = lds16(L + O_KH + (32 * ti + l31) * P128 + (16 * s + 8 * hh) * 2); fb[s] = lds16(L + O_KH + (32 * tj + l31) * P128 + (16 * s + 8 * hh) * 2); }
                __builtin_amdgcn_sched_barrier(0);
#pragma unroll
                for (int s = 0; s < 8; ++s) C = MFMA32(fa[s], fb[s], C);
            }
            const int j = 32 * tj + l31; const float gcj = SMf[j];
#pragma unroll
            for (int g = 0; g < 4; ++g) { const int ib = 32 * ti + 8 * g + 4 * hh; const f32x4 gci = *(const LAS f32x4*)(SMf + ib), bei = *(const LAS f32x4*)(SMf + 64 + ib);
#pragma unroll
                for (int e = 0; e < 4; ++e) { const int i = ib + e; LM[i * 68 + j] = (i > j) ? bei[e] * C[4 * g + e] * __expf(gci[e] - gcj) : 0.f; } }
            if (ti == tj) {
                asm volatile("s_waitcnt lgkmcnt(0)" ::: "memory");
                const int a = 2 * ti, bq = 2 * ti + 1;
                if (lanev < 32) {
                    const int blk = a + (lanev >> 4), c = lanev & 15; float x[16];
    #pragma unroll
                    for (int i = 0; i < 16; ++i) { const LAS float* lr = LM + (16 * blk + i) * 68 + 16 * blk; float acc = (i == c) ? 1.f : 0.f;
    #pragma unroll
                        for (int j = 0; j < i; ++j) acc -= lr[j] * x[j];
                        x[i] = acc; TT[(16 * blk + i) * 68 + 16 * blk + c] = acc; }
                }
                asm volatile("s_waitcnt lgkmcnt(0)" ::: "memory");
                const int m = lanev & 15, q = lanev >> 4;
                f32x4 P = {0.f, 0.f, 0.f, 0.f}, R = {0.f, 0.f, 0.f, 0.f};
    #pragma unroll
                for (int s = 0; s < 4; ++s) { const int k = q + 4 * s; P = MFMA16F(LM[(16 * bq + m) * 68 + 16 * a + k], TT[(16 * a + k) * 68 + 16 * a + m], P); }
    #pragma unroll
                for (int rg = 0; rg < 4; ++rg) { const int k = 4 * q + rg; R = MFMA16F(TT[(16 * bq + m) * 68 + 16 * bq + k], P[rg], R); }
    #pragma unroll
                for (int rg = 0; rg < 4; ++rg) TT[(16 * bq + 4 * q + rg) * 68 + 16 * a + m] = -R[rg];
            }
        } else {
            const int w4 = wv - 4, tj = w4 >> 1, ti = w4 & 1;
            f32x16 C;
#pragma unroll
            for (int r = 0; r < 16; ++r) C[r] = 0.f;
            if (ti >= tj) {
                bf16x8 fa[8], fb[8];
#pragma unroll
                for (int s = 0; s < 8; ++s) { fa[s] = lds16(L + O_KH + (32 * tj + l31) * P128 + (16 * s + 8 * hh) * 2); fb[s] = lds16(L + O_QH + (32 * ti + l31) * P128 + (16 * s + 8 * hh) * 2); }
                __builtin_amdgcn_sched_barrier(0);
#pragma unroll
                for (int s = 0; s < 8; ++s) C = MFMA32(fa[s], fb[s], C);
            }
            const int i = 32 * ti + l31; const float gci = SMf[i];
#pragma unroll
            for (int g = 0; g < 4; ++g) { const int jb = 32 * tj + 8 * g + 4 * hh; const f32x4 gcj = *(const LAS f32x4*)(SMf + jb); float v[4];
#pragma unroll
                for (int e = 0; e < 4; ++e) v[e] = (i >= jb + e) ? C[4 * g + e] * __expf(gci - gcj[e]) : 0.f;
                *(LAS v2u*)(L + O_AT + i * P64 + jb * 2) = pack4(v[0], v[1], v[2], v[3]); }
        }
        __syncthreads();
        if (wv < 4) {
            const int m = lanev & 15, q = lanev >> 4, mi = wv >> 1, ni = wv & 1;
            f32x4 P0 = {0.f, 0.f, 0.f, 0.f}, P1 = {0.f, 0.f, 0.f, 0.f}, R = {0.f, 0.f, 0.f, 0.f};
            float bt[8], l0[8], l1[8], t0[4], t1[4];
#pragma unroll
            for (int s = 0; s < 8; ++s) { const int k = q + 4 * s; bt[s] = TT[k * 68 + 16 * ni + m]; l0[s] = LM[(32 + m) * 68 + k]; l1[s] = LM[(48 + m) * 68 + k]; }
#pragma unroll
            for (int rg = 0; rg < 4; ++rg) { t0[rg] = TT[(32 + 16 * mi + m) * 68 + 32 + 4 * q + rg]; t1[rg] = TT[(32 + 16 * mi + m) * 68 + 48 + 4 * q + rg]; }
            __builtin_amdgcn_sched_barrier(0);
#pragma unroll
            for (int s = 0; s < 8; ++s) { P0 = MFMA16F(l0[s], bt[s], P0); P1 = MFMA16F(l1[s], bt[s], P1); }
#pragma unroll
            for (int rg = 0; rg < 4; ++rg) { R = MFMA16F(t0[rg], P0[rg], R); R = MFMA16F(t1[rg], P1[rg], R); }
#pragma unroll
            for (int rg = 0; rg < 4; ++rg) TT[(32 + 16 * mi + 4 * q + rg) * 68 + 16 * ni + m] = -R[rg];
        }
        __syncthreads();
        f32x16 U, WT_;
#pragma unroll
        for (int r = 0; r < 16; ++r) { U[r] = 0.f; WT_[r] = 0.f; }
        {
            f32x4 tq0[4], tq1[4]; bf16x8 fv[4], fk[4];
#pragma unroll
            for (int s = 0; s < 4; ++s) { const LAS f32x4* tp4 = (const LAS f32x4*)(TT + (32 * mt + l31) * 68 + 16 * s + 8 * hh); tq0[s] = tp4[0]; tq1[s] = tp4[1];
                fv[s] = lds16(L + O_VBT + (32 * nt + l31) * P64 + (16 * s + 8 * hh) * 2); fk[s] = lds16(L + O_KBGT + (32 * nt + l31) * P64 + (16 * s + 8 * hh) * 2); }
            __builtin_amdgcn_sched_barrier(0);
#pragma unroll
            for (int s = 0; s < 4; ++s) { const bf16x8 a = pack8(tq0[s].x, tq0[s].y, tq0[s].z, tq0[s].w, tq1[s].x, tq1[s].y, tq1[s].z, tq1[s].w);
                U = MFMA32(a, fv[s], U); WT_ = MFMA32(fk[s], a, WT_); }
        }
#pragma unroll
        for (int g = 0; g < 4; ++g) *(LAS v2u*)(L + O_W + (32 * mt + l31) * P128 + (32 * nt + 8 * g + 4 * hh) * 2) = pack4(-WT_[4 * g], -WT_[4 * g + 1], -WT_[4 * g + 2], -WT_[4 * g + 3]);
        __syncthreads();
        bf16x8 sf[4][2];
#pragma unroll
        for (int kt = 0; kt < 4; ++kt) { sf[kt][0] = acc_frag<0>(S[kt]); sf[kt][1] = acc_frag<1>(S[kt]); }
        {
            bf16x8 fw[4][2];
#pragma unroll
            for (int kt = 0; kt < 4; ++kt)
#pragma unroll
                for (int s = 0; s < 2; ++s) fw[kt][s] = lds8x2(L + O_W + (32 * mt + l31) * P128 + (32 * kt + 16 * s + 4 * hh) * 2);
            __builtin_amdgcn_sched_barrier(0);
#pragma unroll
            for (int kt = 0; kt < 4; ++kt)
#pragma unroll
                for (int s = 0; s < 2; ++s) U = MFMA32(fw[kt][s], sf[kt][s], U);
        }
#pragma unroll
        for (int g = 0; g < 4; ++g) *(LAS v2u*)(L + O_VNT + (32 * nt + l31) * P64 + (32 * mt + 8 * g + 4 * hh) * 2) = pack4(U[4 * g], U[4 * g + 1], U[4 * g + 2], U[4 * g + 3]);
        __syncthreads();
        {
            f32x16 Oa;
#pragma unroll
            for (int r = 0; r < 16; ++r) Oa[r] = 0.f;
            bf16x8 vn[4], fat[4], fg[4]; f32x4 e4[4];
            {
                bf16x8 fq[4][2];
#pragma unroll
                for (int kt = 0; kt < 4; ++kt)
#pragma unroll
                    for (int s = 0; s < 2; ++s) fq[kt][s] = lds8x2(L + O_QH + (32 * mt + l31) * P128 + (32 * kt + 16 * s + 4 * hh) * 2);
                __builtin_amdgcn_sched_barrier(0);
#pragma unroll
                for (int kt = 0; kt < 4; ++kt)
#pragma unroll
                    for (int s = 0; s < 2; ++s) Oa = MFMA32(fq[kt][s], sf[kt][s], Oa);
            }
#pragma unroll
            for (int g = 0; g < 4; ++g) e4[g] = *(const LAS f32x4*)(SMf + 128 + 32 * mt + 8 * g + 4 * hh);
#pragma unroll
            for (int s = 0; s < 4; ++s) { vn[s] = lds16(L + O_VNT + (32 * nt + l31) * P64 + (16 * s + 8 * hh) * 2); fat[s] = lds16(L + O_AT + (32 * mt + l31) * P64 + (16 * s + 8 * hh) * 2); }
            const float glast = SMf[256];
#pragma unroll
            for (int s = 0; s < 4; ++s) fg[s] = lds16(L + O_KGT + l31 * P64 + (16 * s + 8 * hh) * 2);
            __builtin_amdgcn_sched_barrier(0);
#pragma unroll
            for (int g = 0; g < 4; ++g)
#pragma unroll
                for (int e = 0; e < 4; ++e) Oa[4 * g + e] *= e4[g][e];
#pragma unroll
            for (int s = 0; s < 4; ++s) Oa = MFMA32(fat[s], vn[s], Oa);
#pragma unroll
            for (int kt = 0; kt < 4; ++kt) {
#pragma unroll
                for (int r = 0; r < 16; ++r) S[kt][r] *= glast;
#pragma unroll
                for (int s = 0; s < 4; ++s) S[kt] = MFMA32(fg[s], vn[s], S[kt]);
                if (kt < 3) {
#pragma unroll
                    for (int s = 0; s < 4; ++s) fg[s] = lds16(L + O_KGT + (32 * (kt + 1) + l31) * P64 + (16 * s + 8 * hh) * 2);
                }
            }
#pragma unroll
            for (int r = 0; r < 16; ++r) { const float q2 = row16_sum(Oa[r] * Oa[r]);
                if ((lanev & 15) == 0) PSO[(32 * mt + 8 * (r >> 2) + 4 * hh + (r & 3)) * 8 + 2 * nt + ((lanev >> 4) & 1)] = q2;
                *(LAS unsigned short*)(L + O_OF + (32 * mt + 8 * (r >> 2) + 4 * hh + (r & 3)) * P128 + (32 * nt + l31) * 2) = (unsigned short)cvtpk(Oa[r], 0.f); }
        }
        asm volatile("s_waitcnt vmcnt(0)" : "+v"(pf_sink) :: "memory");
        __syncthreads();
    }
    GDN_OUT(b * SEQ + 31 * 64);
    __syncthreads();
#undef GDN_GATES
#undef GDN_CONV
#undef GDN_ROWS
#undef GDN_OUT
}

typedef short s16x4 __attribute__((ext_vector_type(4)));
__device__ __forceinline__ bf16x8 ldstr8(const LAS unsigned char* p0, const LAS unsigned char* p1) {
    const s16x4 a = __builtin_amdgcn_ds_read_tr16_b64_v4i16((LAS s16x4*)p0), b = __builtin_amdgcn_ds_read_tr16_b64_v4i16((LAS s16x4*)p1);
    bf16x8 r; r[0] = a[0]; r[1] = a[1]; r[2] = a[2]; r[3] = a[3]; r[4] = b[0]; r[5] = b[1]; r[6] = b[2]; r[7] = b[3]; return r;
}
__device__ __forceinline__ void wrlane(unsigned& dst, const unsigned val, const int idx) {
    switch (idx) {
    case 0: asm("s_nop 1\n\tv_writelane_b32 %0, %1, 0" : "+v"(dst) : "s"(val)); break;
    case 1: asm("s_nop 1\n\tv_writelane_b32 %0, %1, 1" : "+v"(dst) : "s"(val)); break;
    case 2: asm("s_nop 1\n\tv_writelane_b32 %0, %1, 2" : "+v"(dst) : "s"(val)); break;
    case 3: asm("s_nop 1\n\tv_writelane_b32 %0, %1, 3" : "+v"(dst) : "s"(val)); break;
    case 4: asm("s_nop 1\n\tv_writelane_b32 %0, %1, 4" : "+v"(dst) : "s"(val)); break;
    case 5: asm("s_nop 1\n\tv_writelane_b32 %0, %1, 5" : "+v"(dst) : "s"(val)); break;
    case 6: asm("s_nop 1\n\tv_writelane_b32 %0, %1, 6" : "+v"(dst) : "s"(val)); break;
    case 7: asm("s_nop 1\n\tv_writelane_b32 %0, %1, 7" : "+v"(dst) : "s"(val)); break;
    case 8: asm("s_nop 1\n\tv_writelane_b32 %0, %1, 8" : "+v"(dst) : "s"(val)); break;
    case 9: asm("s_nop 1\n\tv_writelane_b32 %0, %1, 9" : "+v"(dst) : "s"(val)); break;
    case 10: asm("s_nop 1\n\tv_writelane_b32 %0, %1, 10" : "+v"(dst) : "s"(val)); break;
    case 11: asm("s_nop 1\n\tv_writelane_b32 %0, %1, 11" : "+v"(dst) : "s"(val)); break;
    case 12: asm("s_nop 1\n\tv_writelane_b32 %0, %1, 12" : "+v"(dst) : "s"(val)); break;
    case 13: asm("s_nop 1\n\tv_writelane_b32 %0, %1, 13" : "+v"(dst) : "s"(val)); break;
    case 14: asm("s_nop 1\n\tv_writelane_b32 %0, %1, 14" : "+v"(dst) : "s"(val)); break;
    case 15: asm("s_nop 1\n\tv_writelane_b32 %0, %1, 15" : "+v"(dst) : "s"(val)); break;
    case 16: asm("s_nop 1\n\tv_writelane_b32 %0, %1, 16" : "+v"(dst) : "s"(val)); break;
    case 17: asm("s_nop 1\n\tv_writelane_b32 %0, %1, 17" : "+v"(dst) : "s"(val)); break;
    case 18: asm("s_nop 1\n\tv_writelane_b32 %0, %1, 18" : "+v"(dst) : "s"(val)); break;
    case 19: asm("s_nop 1\n\tv_writelane_b32 %0, %1, 19" : "+v"(dst) : "s"(val)); break;
    case 20: asm("s_nop 1\n\tv_writelane_b32 %0, %1, 20" : "+v"(dst) : "s"(val)); break;
    case 21: asm("s_nop 1\n\tv_writelane_b32 %0, %1, 21" : "+v"(dst) : "s"(val)); break;
    case 22: asm("s_nop 1\n\tv_writelane_b32 %0, %1, 22" : "+v"(dst) : "s"(val)); break;
    case 23: asm("s_nop 1\n\tv_writelane_b32 %0, %1, 23" : "+v"(dst) : "s"(val)); break;
    case 24: asm("s_nop 1\n\tv_writelane_b32 %0, %1, 24" : "+v"(dst) : "s"(val)); break;
    case 25: asm("s_nop 1\n\tv_writelane_b32 %0, %1, 25" : "+v"(dst) : "s"(val)); break;
    case 26: asm("s_nop 1\n\tv_writelane_b32 %0, %1, 26" : "+v"(dst) : "s"(val)); break;
    case 27: asm("s_nop 1\n\tv_writelane_b32 %0, %1, 27" : "+v"(dst) : "s"(val)); break;
    case 28: asm("s_nop 1\n\tv_writelane_b32 %0, %1, 28" : "+v"(dst) : "s"(val)); break;
    case 29: asm("s_nop 1\n\tv_writelane_b32 %0, %1, 29" : "+v"(dst) : "s"(val)); break;
    case 30: asm("s_nop 1\n\tv_writelane_b32 %0, %1, 30" : "+v"(dst) : "s"(val)); break;
    case 31: asm("s_nop 1\n\tv_writelane_b32 %0, %1, 31" : "+v"(dst) : "s"(val)); break;
    default: break;
    }
}
__device__ __forceinline__ void ballot4(unsigned& mlo, unsigned& mhi, const float thr, const float x0, const float x1, const float x2, const float x3, const int base) {
    switch (base) {
    case 0: asm("v_cmp_le_f32_e64 s[90:91], %2, %3\n\tv_cmp_le_f32_e64 s[92:93], %2, %4\n\tv_cmp_le_f32_e64 s[94:95], %2, %5\n\tv_cmp_le_f32_e64 s[96:97], %2, %6\n\t"
                 "v_writelane_b32 %0, s90, 0\n\tv_writelane_b32 %1, s91, 0\n\tv_writelane_b32 %0, s92, 1\n\tv_writelane_b32 %1, s93, 1\n\tv_writelane_b32 %0, s94, 2\n\tv_writelane_b32 %1, s95, 2\n\tv_writelane_b32 %0, s96, 3\n\tv_writelane_b32 %1, s97, 3"
                 : "+v"(mlo), "+v"(mhi) : "v"(thr), "v"(x0), "v"(x1), "v"(x2), "v"(x3) : "s90", "s91", "s92", "s93", "s94", "s95", "s96", "s97"); break;
    case 4: asm("v_cmp_le_f32_e64 s[90:91], %2, %3\n\tv_cmp_le_f32_e64 s[92:93], %2, %4\n\tv_cmp_le_f32_e64 s[94:95], %2, %5\n\tv_cmp_le_f32_e64 s[96:97], %2, %6\n\t"
                 "v_writelane_b32 %0, s90, 4\n\tv_writelane_b32 %1, s91, 4\n\tv_writelane_b32 %0, s92, 5\n\tv_writelane_b32 %1, s93, 5\n\tv_writelane_b32 %0, s94, 6\n\tv_writelane_b32 %1, s95, 6\n\tv_writelane_b32 %0, s96, 7\n\tv_writelane_b32 %1, s97, 7"
                 : "+v"(mlo), "+v"(mhi) : "v"(thr), "v"(x0), "v"(x1), "v"(x2), "v"(x3) : "s90", "s91", "s92", "s93", "s94", "s95", "s96", "s97"); break;
    case 8: asm("v_cmp_le_f32_e64 s[90:91], %2, %3\n\tv_cmp_le_f32_e64 s[92:93], %2, %4\n\tv_cmp_le_f32_e64 s[94:95], %2, %5\n\tv_cmp_le_f32_e64 s[96:97], %2, %6\n\t"
                 "v_writelane_b32 %0, s90, 8\n\tv_writelane_b32 %1, s91, 8\n\tv_writelane_b32 %0, s92, 9\n\tv_writelane_b32 %1, s93, 9\n\tv_writelane_b32 %0, s94, 10\n\tv_writelane_b32 %1, s95, 10\n\tv_writelane_b32 %0, s96, 11\n\tv_writelane_b32 %1, s97, 11"
                 : "+v"(mlo), "+v"(mhi) : "v"(thr), "v"(x0), "v"(x1), "v"(x2), "v"(x3) : "s90", "s91", "s92", "s93", "s94", "s95", "s96", "s97"); break;
    case 12: asm("v_cmp_le_f32_e64 s[90:91], %2, %3\n\tv_cmp_le_f32_e64 s[92:93], %2, %4\n\tv_cmp_le_f32_e64 s[94:95], %2, %5\n\tv_cmp_le_f32_e64 s[96:97], %2, %6\n\t"
                 "v_writelane_b32 %0, s90, 12\n\tv_writelane_b32 %1, s91, 12\n\tv_writelane_b32 %0, s92, 13\n\tv_writelane_b32 %1, s93, 13\n\tv_writelane_b32 %0, s94, 14\n\tv_writelane_b32 %1, s95, 14\n\tv_writelane_b32 %0, s96, 15\n\tv_writelane_b32 %1, s97, 15"
                 : "+v"(mlo), "+v"(mhi) : "v"(thr), "v"(x0), "v"(x1), "v"(x2), "v"(x3) : "s90", "s91", "s92", "s93", "s94", "s95", "s96", "s97"); break;
    case 16: asm("v_cmp_le_f32_e64 s[90:91], %2, %3\n\tv_cmp_le_f32_e64 s[92:93], %2, %4\n\tv_cmp_le_f32_e64 s[94:95], %2, %5\n\tv_cmp_le_f32_e64 s[96:97], %2, %6\n\t"
                 "v_writelane_b32 %0, s90, 16\n\tv_writelane_b32 %1, s91, 16\n\tv_writelane_b32 %0, s92, 17\n\tv_writelane_b32 %1, s93, 17\n\tv_writelane_b32 %0, s94, 18\n\tv_writelane_b32 %1, s95, 18\n\tv_writelane_b32 %0, s96, 19\n\tv_writelane_b32 %1, s97, 19"
                 : "+v"(mlo), "+v"(mhi) : "v"(thr), "v"(x0), "v"(x1), "v"(x2), "v"(x3) : "s90", "s91", "s92", "s93", "s94", "s95", "s96", "s97"); break;
    case 20: asm("v_cmp_le_f32_e64 s[90:91], %2, %3\n\tv_cmp_le_f32_e64 s[92:93], %2, %4\n\tv_cmp_le_f32_e64 s[94:95], %2, %5\n\tv_cmp_le_f32_e64 s[96:97], %2, %6\n\t"
                 "v_writelane_b32 %0, s90, 20\n\tv_writelane_b32 %1, s91, 20\n\tv_writelane_b32 %0, s92, 21\n\tv_writelane_b32 %1, s93, 21\n\tv_writelane_b32 %0, s94, 22\n\tv_writelane_b32 %1, s95, 22\n\tv_writelane_b32 %0, s96, 23\n\tv_writelane_b32 %1, s97, 23"
                 : "+v"(mlo), "+v"(mhi) : "v"(thr), "v"(x0), "v"(x1), "v"(x2), "v"(x3) : "s90", "s91", "s92", "s93", "s94", "s95", "s96", "s97"); break;
    case 24: asm("v_cmp_le_f32_e64 s[90:91], %2, %3\n\tv_cmp_le_f32_e64 s[92:93], %2, %4\n\tv_cmp_le_f32_e64 s[94:95], %2, %5\n\tv_cmp_le_f32_e64 s[96:97], %2, %6\n\t"
                 "v_writelane_b32 %0, s90, 24\n\tv_writelane_b32 %1, s91, 24\n\tv_writelane_b32 %0, s92, 25\n\tv_writelane_b32 %1, s93, 25\n\tv_writelane_b32 %0, s94, 26\n\tv_writelane_b32 %1, s95, 26\n\tv_writelane_b32 %0, s96, 27\n\tv_writelane_b32 %1, s97, 27"
                 : "+v"(mlo), "+v"(mhi) : "v"(thr), "v"(x0), "v"(x1), "v"(x2), "v"(x3) : "s90", "s91", "s92", "s93", "s94", "s95", "s96", "s97"); break;
    case 28: asm("v_cmp_le_f32_e64 s[90:91], %2, %3\n\tv_cmp_le_f32_e64 s[92:93], %2, %4\n\tv_cmp_le_f32_e64 s[94:95], %2, %5\n\tv_cmp_le_f32_e64 s[96:97], %2, %6\n\t"
                 "v_writelane_b32 %0, s90, 28\n\tv_writelane_b32 %1, s91, 28\n\tv_writelane_b32 %0, s92, 29\n\tv_writelane_b32 %1, s93, 29\n\tv_writelane_b32 %0, s94, 30\n\tv_writelane_b32 %1, s95, 30\n\tv_writelane_b32 %0, s96, 31\n\tv_writelane_b32 %1, s97, 31"
                 : "+v"(mlo), "+v"(mhi) : "v"(thr), "v"(x0), "v"(x1), "v"(x2), "v"(x3) : "s90", "s91", "s92", "s93", "s94", "s95", "s96", "s97"); break;
    default: break;
    }
}
template <int NREG>
__device__ __forceinline__ void dsa_select(const float* const scw, LAS unsigned* const MASK, LAS const float* const ZT, const int wv, const int lane, const int t0, const int nk) {
    const float NINF = -__builtin_inff(), PINF = __builtin_inff();
    const unsigned long long lt_mask = (1ull << lane) - 1ull;
    const int qb_ = t0 >> 6;
    float xn[NREG];
#pragma unroll
    for (int i = 0; i < NREG; ++i) xn[i] = __hip_atomic_load(scw + i * 64 + lane, __ATOMIC_RELAXED, __HIP_MEMORY_SCOPE_AGENT);
#pragma unroll 1
    for (int ql_ = 0; ql_ < 8; ++ql_) {
        const int ql = ql_ & 7;
        const int tq = t0 + 8 * wv + ql;
        LAS unsigned* const mrow = MASK + (8 * wv + ql) * 64;
        float x[NREG];
#pragma unroll
        for (int i = 0; i < NREG; ++i) x[i] = (i <= qb_) ? xn[i] : NINF;
        if (ql_ + 1 < 8) {
#pragma unroll
            for (int i = 0; i < NREG; ++i) xn[i] = __hip_atomic_load(scw + ((ql_ + 1) & 7) * 2048 + i * 64 + lane, __ATOMIC_RELAXED, __HIP_MEMORY_SCOPE_AGENT);
        }
        unsigned mlo = 0u, mhi = 0u;
        if (tq + 1 > 256) {
#define CNT_GE(p_, dst_) do { int _c0 = 0, _c1 = 0; const float _p = (p_); \
                _Pragma("unroll") for (int _i = 0; _i < NREG; _i += 8) \
                    asm volatile("v_cmp_le_f32_e64 s[90:91], %10, %2\n\tv_cmp_le_f32_e64 s[92:93], %10, %3\n\tv_cmp_le_f32_e64 s[94:95], %10, %4\n\tv_cmp_le_f32_e64 s[96:97], %10, %5\n\t" \
                                 "v_cmp_le_f32_e64 s[82:83], %10, %6\n\ts_bcnt1_i32_b64 s90, s[90:91]\n\ts_add_u32 %0, %0, s90\n\t" \
                                 "v_cmp_le_f32_e64 s[84:85], %10, %7\n\ts_bcnt1_i32_b64 s92, s[92:93]\n\ts_add_u32 %1, %1, s92\n\t" \
                                 "v_cmp_le_f32_e64 s[86:87], %10, %8\n\ts_bcnt1_i32_b64 s94, s[94:95]\n\ts_add_u32 %0, %0, s94\n\t" \
                                 "v_cmp_le_f32_e64 s[88:89], %10, %9\n\ts_bcnt1_i32_b64 s96, s[96:97]\n\ts_add_u32 %1, %1, s96\n\t" \
                                 "s_bcnt1_i32_b64 s82, s[82:83]\n\ts_bcnt1_i32_b64 s84, s[84:85]\n\ts_add_u32 %0, %0, s82\n\ts_bcnt1_i32_b64 s86, s[86:87]\n\ts_add_u32 %1, %1, s84\n\t" \
                                 "s_bcnt1_i32_b64 s88, s[88:89]\n\ts_add_u32 %0, %0, s86\n\ts_add_u32 %1, %1, s88" \
                                 : "+s"(_c0), "+s"(_c1) : "v"(x[_i]), "v"(x[_i + 1]), "v"(x[_i + 2]), "v"(x[_i + 3]), "v"(x[_i + 4]), "v"(x[_i + 5]), "v"(x[_i + 6]), "v"(x[_i + 7]), "s"(_p) \
                                 : "s82", "s83", "s84", "s85", "s86", "s87", "s88", "s89", "s90", "s91", "s92", "s93", "s94", "s95", "s96", "s97", "scc"); \
                dst_ = _c0 + _c1; } while (0)
            float s1 = 0.f, s2 = 0.f;
            constexpr int SS = NREG / 8;
#pragma unroll
            for (int i = 0; i < NREG; i += SS) if (i < qb_) { s1 += x[i]; s2 = fmaf(x[i], x[i], s2); }
            s1 = wave_sum_f(s1); s2 = wave_sum_f(s2);
            const float rm = rcpf_(64.0f * (float)((min(qb_, NREG) + SS - 1) / SS));
            const float mean = s1 * rm, sigma = __builtin_sqrtf(fmaxf(s2 * rm - mean * mean, 0.f));
            const float zq = ZT[2 * (8 * wv + ql)], stepc = sigma * ZT[2 * (8 * wv + ql) + 1];
            float lo = -3.0e38f, hi = PINF, thr = 0.f, vmax = 0.f; int clo = tq + 1, chi = 0; bool tie = false, lo_real = false, have_mm = false;
            float pv = mean + zq * sigma;
#pragma unroll 1
            for (int it = 1;; ++it) {
                if (!(pv > lo && pv < hi)) {
                    if (!have_mm) {
                        float vmin = PINF; vmax = NINF;
#pragma unroll
                        for (int i = 0; i < NREG; ++i) { vmax = fmaxf(vmax, x[i]); vmin = fminf(vmin, x[i] == NINF ? PINF : x[i]); }
                        vmin = -wave_max(-vmin); vmax = wave_max(vmax); have_mm = true;
                        if (!lo_real) lo = vmin;
                    }
                    pv = (hi == PINF) ? vmax : 0.5f * (lo + hi);
                    if (!(pv > lo && pv < hi)) { tie = true; break; }
                }
                int c; CNT_GE(pv, c);
                if (c == 256) { thr = pv; break; }
                if (c > 256) { lo = pv; clo = c; lo_real = true; } else { hi = pv; chi = c; }
                if (it >= 8) pv = __builtin_nanf("");
                else if (lo_real && hi != PINF) pv = lo + (hi - lo) * ((float)(clo - 256) * rcpf_((float)(clo - chi)));
                else pv = pv + (float)(c - 256) * stepc;
            }
#undef CNT_GE
            if (!tie) {
#pragma unroll
                for (int i = 0; i < NREG; i += 4) ballot4(mlo, mhi, thr, x[i], x[i + 1], x[i + 2], x[i + 3], i);
            } else {
                const int need = 256 - chi; int before = 0;
#pragma unroll
                for (int i = 0; i < NREG; ++i) { const bool eq = (x[i] == lo); const unsigned long long be = __ballot(eq);
                    const int rank = before + __popcll(be & lt_mask); const bool sel = (x[i] >= hi) || (eq && rank < need); before += __popcll(be);
                    const unsigned long long bs = __ballot(sel);
                    wrlane(mlo, (unsigned)bs, i); wrlane(mhi, (unsigned)(bs >> 32), i); }
            }
        } else {
#pragma unroll
            for (int i = 0; i < NREG; ++i) { const unsigned long long bs = __ballot(i * 64 + lane <= tq);
                wrlane(mlo, (unsigned)bs, i); wrlane(mhi, (unsigned)(bs >> 32), i); }
        }
        if (lane < NREG) { v2u w; w.x = mlo; w.y = mhi; *(LAS v2u*)(mrow + 2 * lane) = w; }
    }
}

__device__ __forceinline__ void dsa_unit(Frame& F, const Args& args, const int b, const int qb, const float mb2) {
    LAS unsigned char* const L = F.lds;
    const int tid = F.tid, lane = F.lane, wv = F.wave, l31_0 = lane & 31, hh_0 = lane >> 5;
    int l31 = l31_0, hh = hh_0;
    constexpr int PK = 272, PV = 144;
    constexpr int O_K0 = 0, O_V0 = 17408, BUFSZ = 35840, O_MASK = 2 * BUFSZ, O_RS = O_MASK + 16384, O_BT = O_RS + 8192, O_ZT = O_BT + 2048, O_END = O_ZT + 512, O_OA = 0;
    static_assert(O_END <= SCRATCH_BYTES && 4 * 17408 <= 2 * BUFSZ, "dsa LDS map");
    const int t0 = 64 * qb, nk = 64 * (qb + 1);
    const size_t rb = (size_t)b * SEQ;
    LAS unsigned* const MASK = (LAS unsigned*)(L + O_MASK);
    LAS float* const RS = (LAS float*)(L + O_RS);
    LAS float* const BT = (LAS float*)(L + O_BT);
    LAS float* const ZT = (LAS float*)(L + O_ZT);
    const float NINF = -__builtin_inff();
    for (int key = tid; key < nk; key += NWAVES * 64) { const float* kp = W_KVSS + rb + key; RS[key] = rsqf_(((kp[0] + kp[MROWS]) + (kp[2 * MROWS] + kp[3 * MROWS])) * (1.0f / 128.0f) + EPSF); }
    BT[tid] = P_RELB[T5_BUCKET[tid >> 2] * 4 + (tid & 3)] * LOG2E;
    if (tid < 64) {
        const float n_ = (float)(t0 + tid + 1); float f_ = 256.0f * rcpf_(n_); const bool up_ = f_ > 0.5f; if (up_) f_ = 1.0f - f_;
        f_ = fmaxf(f_, 1e-6f);
        const float t_ = __builtin_sqrtf(-1.3862944f * __builtin_log2f(f_));
        float z_ = t_ - (2.515517f + t_ * (0.802853f + t_ * 0.010328f)) * rcpf_(1.0f + t_ * (1.432788f + t_ * (0.189269f + t_ * 0.001308f)));
        if (up_) z_ = -z_;
        ZT[2 * tid] = z_; ZT[2 * tid + 1] = rcpf_(n_ * 0.3989423f * __builtin_exp2f(-0.72134752f * z_ * z_));
    }
    float* const scw = W_SCR + (size_t)(blockIdx.x * NWAVES + wv) * 8 * 2048;
#pragma unroll 1
    for (int rep_a = 0; rep_a < (PROBE_DUP == 41 ? 2 : 1); ++rep_a) {
        bf16x8 aq[2][4]; f32x4 wts[2][4];
#pragma unroll
        for (int rt = 0; rt < 2; ++rt) {
            const bf16* p = W_PROJ + (rb + t0 + 8 * wv + 4 * rt + (l31 >> 3)) * NPROJ + C_IQ + (l31 & 7) * 64 + 8 * hh;
#pragma unroll
            for (int s = 0; s < 4; ++s) aq[rt][s] = *(const GAS bf16x8*)(p + 16 * s);
#pragma unroll
            for (int g = 0; g < 4; ++g) wts[rt][g] = *(const f32x4*)(W_AUX + (rb + t0 + 8 * wv + 4 * rt + g) * 16 + 8 + 4 * hh) * 0.5f;
        }
        constexpr int O_IK = 0, IKB = 9216, PIK = 144;
        v4u sti;
#define IK_GLOAD(kt_) sti = *(const GAS v4u*)(W_PROJ + (rb + 64 * (kt_) + (tid >> 3)) * NPROJ + C_IK + (tid & 7) * 8)
#define IK_SWRITE(buf_) *(LAS v4u*)(L + O_IK + (buf_) * IKB + (tid >> 3) * PIK + (tid & 7) * 16) = sti
        IK_GLOAD(0); IK_SWRITE(0);
        __syncthreads();
#pragma unroll 1
        for (int kt6 = 0; kt6 <= qb; ++kt6) {
          const int ibuf = kt6 & 1;
          if (kt6 < qb) IK_GLOAD(kt6 + 1);
#pragma unroll
          for (int st = 0; st < 2; ++st) {
            bf16x8 bk[4];
#pragma unroll
            for (int s = 0; s < 4; ++s) bk[s] = lds16(L + O_IK + ibuf * IKB + (32 * st + l31) * PIK + (16 * s + 8 * hh) * 2);
            const int kt = 2 * kt6 + st;
            const int key = 32 * kt + l31;
            f32x16 C0, C1;
#pragma unroll
            for (int r = 0; r < 16; ++r) { C0[r] = 0.f; C1[r] = 0.f; }
#pragma unroll
            for (int s = 0; s < 4; ++s) C0 = MFMA32(aq[0][s], bk[s], C0);
#pragma unroll
            for (int s = 0; s < 4; ++s) C1 = MFMA32(aq[1][s], bk[s], C1);
            float pp[2][4];
#pragma unroll
            for (int g = 0; g < 4; ++g) {
                float p0 = 0.f, p1 = 0.f;
#pragma unroll
                for (int e2 = 0; e2 < 4; ++e2) { const float w0 = wts[0][g][e2], w1 = wts[1][g][e2], x0 = C0[4 * g + e2], x1 = C1[4 * g + e2];
                    p0 = __builtin_fmaf(w0, x0, p0); p0 = __builtin_fmaf(w0, __builtin_fabsf(x0), p0); p1 = __builtin_fmaf(w1, x1, p1); p1 = __builtin_fmaf(w1, __builtin_fabsf(x1), p1); }
                pp[0][g] = p0; pp[1][g] = p1;
            }
#pragma unroll
            for (int rt = 0; rt < 2; ++rt)
#pragma unroll
                for (int g2 = 0; g2 < 2; ++g2) { const int ql = 4 * rt + g2 + 2 * hh;
                    float pa = pp[rt][g2], pb = pp[rt][g2 + 2];
                    asm("s_nop 1\n\tv_permlane32_swap_b32 %0, %1" : "+v"(pa), "+v"(pb));
                    float p = pa + pb;
                    if (key > t0 + 8 * wv + ql) p = NINF;
                    scw[ql * 2048 + key] = p; }
          }
          if (kt6 < qb) IK_SWRITE(ibuf ^ 1);
          __syncthreads();
        }
#undef IK_GLOAD
#undef IK_SWRITE
    }
    __builtin_amdgcn_fence(__ATOMIC_SEQ_CST, "workgroup");
    asm volatile("s_waitcnt vmcnt(0)" ::: "memory");
    const int qj = l31 >> 2, hd = l31 & 3;
    const int tql = t0 + 8 * wv + qj;
    bf16x8 qf[8]; float qn2 = 0.f;
    {
        const bf16* p = W_PROJ + (rb + tql) * NPROJ + C_QB + hd * 128 + 8 * hh; const float cs = 0.08838834764831845f * LOG2E;
#pragma unroll
        for (int s = 0; s < 8; ++s) { const v4u raw = *(const GAS v4u*)(p + 16 * s); const f32x4 g0 = *(const f32x4*)(P_GKV + 16 * s + 8 * hh), g1 = *(const f32x4*)(P_GKV + 16 * s + 8 * hh + 4);
            v4u o; o.x = cvtpk(bflo(raw.x) * g0.x * cs, bfhi(raw.x) * g0.y * cs); o.y = cvtpk(bflo(raw.y) * g0.z * cs, bfhi(raw.y) * g0.w * cs);
            o.z = cvtpk(bflo(raw.z) * g1.x * cs, bfhi(raw.z) * g1.y * cs); o.w = cvtpk(bflo(raw.w) * g1.z * cs, bfhi(raw.w) * g1.w * cs);
            qn2 += (bflo(o.x) * bflo(o.x) + bfhi(o.x) * bfhi(o.x)) + (bflo(o.y) * bflo(o.y) + bfhi(o.y) * bfhi(o.y)) + (bflo(o.z) * bflo(o.z) + bfhi(o.z) * bfhi(o.z)) + (bflo(o.w) * bflo(o.w) + bfhi(o.w) * bfhi(o.w));
            qf[s] = __builtin_bit_cast(bf16x8, o); }
    }
    qn2 += __shfl_xor(qn2, 32);
    int lanev = lane; asm volatile("" : "+v"(lanev));
#pragma unroll 1
    for (int rep_b = 0; rep_b < (PROBE_DUP == 42 ? 2 : 1); ++rep_b)
    if (qb < 8) dsa_select<8>(scw, MASK, ZT, wv, lanev, t0, nk);
    else if (qb < 16) dsa_select<16>(scw, MASK, ZT, wv, lanev, t0, nk);
    else if (qb < 24) dsa_select<24>(scw, MASK, ZT, wv, lanev, t0, nk);
    else dsa_select<32>(scw, MASK, ZT, wv, lanev, t0, nk);
    __syncthreads();
    const float c0 = -(sqrtf(qn2) * 11.313708499f * 1.01f + mb2 + 1.0f);
    const float cfar = BT[127 * 4 + hd] + c0;
    f32x16 oacc[4];
#pragma unroll
    for (int d = 0; d < 4; ++d)
#pragma unroll
        for (int r = 0; r < 16; ++r) oacc[d][r] = 0.f;
    float lsum = 0.f;
    v4u st0, st1;
#define DSA_GLOAD(kt) do { const bf16* _p = W_PROJ + (rb + 64 * (kt) + lane) * NPROJ + C_CKV + wv * 16; st0 = *(const GAS v4u*)_p; st1 = *(const GAS v4u*)(_p + 8); } while (0)
#define DSA_SWRITE(buf, ktt) do { LAS unsigned char* _kb = L + (buf) * BUFSZ; const float _r = RS[64 * (ktt) + lane]; \
        v4u _n0, _n1; _n0.x = cvtpk(bflo(st0.x) * _r, bfhi(st0.x) * _r); _n0.y = cvtpk(bflo(st0.y) * _r, bfhi(st0.y) * _r); _n0.z = cvtpk(bflo(st0.z) * _r, bfhi(st0.z) * _r); _n0.w = cvtpk(bflo(st0.w) * _r, bfhi(st0.w) * _r); \
        _n1.x = cvtpk(bflo(st1.x) * _r, bfhi(st1.x) * _r); _n1.y = cvtpk(bflo(st1.y) * _r, bfhi(st1.y) * _r); _n1.z = cvtpk(bflo(st1.z) * _r, bfhi(st1.z) * _r); _n1.w = cvtpk(bflo(st1.w) * _r, bfhi(st1.w) * _r); \
        *(LAS v4u*)(_kb + O_K0 + lane * PK + wv * 32) = _n0; *(LAS v4u*)(_kb + O_K0 + lane * PK + wv * 32 + 16) = _n1; \
        } while (0)
    DSA_GLOAD(0); DSA_SWRITE(0, 0);
    __syncthreads();
    for (int kt = 0; kt <= qb; ++kt) {
        const int buf = kt & 1;
        l31 = l31_0; hh = hh_0; asm volatile("" : "+v"(l31), "+v"(hh));
        if (kt < qb) DSA_GLOAD(kt + 1);
        const LAS unsigned char* kb = L + buf * BUFSZ;
        bf16x8 kf[8];
        int mw0 = (int)MASK[(8 * wv + qj) * 64 + 2 * kt], mw1 = (int)MASK[(8 * wv + qj) * 64 + 2 * kt + 1];
#pragma unroll
        for (int st = 0; st < 2; ++st) {
#pragma unroll
            for (int s = 0; s < 8; ++s) kf[s] = lds16(kb + O_K0 + (32 * st + l31) * PK + (16 * s + 8 * hh) * 2);
            __builtin_amdgcn_sched_barrier(0);
            const int kbase = 64 * kt + 32 * st;
            const bool far = (t0 + 8 * wv) - (kbase + 31) >= 113;
            const float sinit = far ? cfar : 0.f;
            f32x16 Sa;
#pragma unroll
            for (int r = 0; r < 16; ++r) Sa[r] = sinit;
#pragma unroll
            for (int s = 0; s < 8; ++s) Sa = MFMA32(kf[s], qf[s], Sa);
            __builtin_amdgcn_sched_barrier(0);
            bf16x8 vf[8];
#pragma unroll
            for (int dt = 0; dt < 4; ++dt) {
                const LAS unsigned char* vp = kb + O_K0 + (32 * st + 4 * hh + ((lane & 15) >> 2)) * PK + (32 * dt + 16 * ((lane >> 4) & 1) + 4 * (lane & 3)) * 2;
                vf[2 * dt] = ldstr8(vp, vp + 8 * PK); vf[2 * dt + 1] = ldstr8(vp + 16 * PK, vp + 24 * PK); }
            __builtin_amdgcn_sched_barrier(0);
            const int mwi = (st == 0 ? mw0 : mw1) >> (4 * hh);
            float pn[16];
            if (far) {
#pragma unroll
                for (int r = 0; r < 16; ++r) { int mb_ = __builtin_amdgcn_sbfe(mwi, 8 * (r >> 2) + (r & 3), 1); asm("" : "+v"(mb_));
                    pn[r] = __builtin_bit_cast(float, __builtin_bit_cast(int, __builtin_amdgcn_exp2f(Sa[r])) & mb_); lsum += pn[r]; }
            } else {
#pragma unroll
                for (int r = 0; r < 16; ++r) { int dist = tql - (kbase + 8 * (r >> 2) + 4 * hh + (r & 3)); dist = dist < 0 ? 0 : (dist > 127 ? 127 : dist);
                    int mb_ = __builtin_amdgcn_sbfe(mwi, 8 * (r >> 2) + (r & 3), 1); asm("" : "+v"(mb_));
                    pn[r] = __builtin_bit_cast(float, __builtin_bit_cast(int, __builtin_amdgcn_exp2f(Sa[r] + (BT[dist * 4 + hd] + c0))) & mb_); lsum += pn[r]; }
            }
            const bf16x8 pf0 = pack8(pn[0], pn[1], pn[2], pn[3], pn[4], pn[5], pn[6], pn[7]), pf1 = pack8(pn[8], pn[9], pn[10], pn[11], pn[12], pn[13], pn[14], pn[15]);
#pragma unroll
            for (int dt = 0; dt < 4; ++dt) { oacc[dt] = MFMA32(vf[2 * dt], pf0, oacc[dt]); oacc[dt] = MFMA32(vf[2 * dt + 1], pf1, oacc[dt]); }
        }
        if (kt < qb) DSA_SWRITE(buf ^ 1, kt + 1);
        __syncthreads();
    }
#undef DSA_GLOAD
#undef DSA_SWRITE
    lsum += __shfl_xor(lsum, 32);
    {
        const float inv = rcpf_(lsum);
#pragma unroll
        for (int dt = 0; dt < 4; ++dt)
#pragma unroll
            for (int g = 0; g < 4; ++g) { const int d = 32 * dt + 8 * g + 4 * hh; const f32x4 gk = *(const f32x4*)(P_GKV + d);
                *(LAS v2u*)(L + O_OA + hd * 17408 + (8 * wv + qj) * PK + d * 2) = pack4(oacc[dt][4 * g] * inv * gk.x, oacc[dt][4 * g + 1] * inv * gk.y, oacc[dt][4 * g + 2] * inv * gk.z, oacc[dt][4 * g + 3] * inv * gk.w); }
    }
    __syncthreads();
    {
        const int hd2 = wv >> 1, mt2 = wv & 1;
        const size_t row = rb + t0 + 32 * mt2 + l31;
        bf16x8 of[8];
#pragma unroll
        for (int s = 0; s < 8; ++s) of[s] = lds16(L + O_OA + hd2 * 17408 + (32 * mt2 + l31) * PK + (16 * s + 8 * hh) * 2);
#pragma unroll
        for (int et = 0; et < 4; ++et) {
            v2u zw[4];
#pragma unroll
            for (int g = 0; g < 4; ++g) zw[g] = *(const GAS v2u*)(W_PROJ + row * NPROJ + C_ZB + hd2 * 128 + 32 * et + 8 * g + 4 * hh);
            f32x16 C;
#pragma unroll
            for (int r = 0; r < 16; ++r) C[r] = 0.f;
            const bf16* wp = W_WUVT + (size_t)hd2 * 16384 + (32 * et + l31) * 128 + 8 * hh;
#pragma unroll
            for (int s = 0; s < 8; ++s) C = MFMA32(*(const GAS bf16x8*)(wp + 16 * s), of[s], C);
#pragma unroll
            for (int g = 0; g < 4; ++g)
                *(GAS v2u*)(W_OAB + row * DM + 512 + hd2 * 128 + 32 * et + 8 * g + 4 * hh) =
                    pack4(C[4 * g] * siluf(bflo(zw[g].x)), C[4 * g + 1] * siluf(bfhi(zw[g].x)), C[4 * g + 2] * siluf(bflo(zw[g].y)), C[4 * g + 3] * siluf(bfhi(zw[g].y)));
        }
    }
    __syncthreads();
}

constexpr int N_GDN = NB * 4, N_DSA = NB * 32, N_ITEMS = N_GDN + N_DSA;
constexpr int N_PHASES = 6;
#ifndef STAG_P2
#define STAG_P2 0
#endif
#ifndef STAG_P4
#define STAG_P4 0
#endif
__global__ void __launch_bounds__(NWAVES * 64, 2) hyb_fwd(Args args) {
    extern __shared__ __attribute__((aligned(16))) unsigned char lds[];
    Frame F;
    F.lds = (LAS unsigned char*)lds;
    F.MISC = (volatile LAS unsigned*)(F.lds + MISC_OFF);
    F.tid = threadIdx.x; F.lane = F.tid & 63; F.wave = __builtin_amdgcn_readfirstlane(F.tid >> 6);
    F.G = gridDim.x; { const int bx = blockIdx.x; F.vcu = (F.G % 8 == 0) ? (bx % 8) * (F.G / 8) + bx / 8 : bx; }
    unsigned char* ws = args.ws;
    F.ctl = (gu32*)(ws + WS_CTL);
    F.ws = ws;
    for (int u = F.tid; u < 64; u += NWAVES * 64) F.MISC[u] = 0u;
    __syncthreads();
    const int lo = args.ph_lo, hi = args.ph_hi;
    const bool multi = (hi - lo) > 1;
    XcdBarrier bar; bar.bar = (unsigned*)(F.ctl + CW_BAR) + args.li * XCD_BAR_WORDS; bar.x = 0; bar.st = nullptr;
    if (multi) bar = xcd_barrier_post((unsigned*)(F.ctl + CW_BAR) + args.li * XCD_BAR_WORDS, F.MISC + 8);
#define IN(k) (lo <= (k) && (k) < hi)
#define STAGGER(ticks) do { if ((ticks) > 0) { const unsigned long long t0_ = __builtin_amdgcn_s_memrealtime(); const unsigned d_ = ((unsigned)blockIdx.x & 7u) * (unsigned)(ticks); \
        while ((unsigned)(__builtin_amdgcn_s_memrealtime() - t0_) < d_) __builtin_amdgcn_s_sleep(4); } } while (0)
#define BOTH(k) (IN(k) && IN((k) + 1))
    if (IN(0)) { p0_prologue(F, args); if (PROBE_DUP == 7) { __syncthreads(); p0_prologue(F, args); } if (BOTH(0)) xcd_barrier(bar); }
    if (IN(1)) { p1_norm(F, args); if (PROBE_DUP == 1) p1_norm(F, args); if (BOTH(1)) xcd_barrier(bar); }
    if (IN(2)) {
        pg8::Gemm g{W_XN, W_WINT, MROWS, NPROJ, DM, (unsigned*)(F.ws + WS_CTL + 512 * 1024)}; pg8::StaticOrder S; S.init(MROWS, NPROJ, F.G, (int)blockIdx.x);
        pg8::EpiProj E{W_PROJ, W_AUX, W_KVSS};
        STAGGER(STAG_P2);
        pg8::gemm_phase<pg8::EpiProj, pg8::StaticOrder, true, true>(F.lds, g, S, E);
        if (PROBE_DUP == 2) pg8::gemm_phase<pg8::EpiProj, pg8::StaticOrder, true, true>(F.lds, g, S, E);
        if (PROBE_DUP == 22) { pg8::EpiHalf EH{E, pg8::EpiNull{W_SCR}}; pg8::gemm_phase<pg8::EpiHalf, pg8::StaticOrder, true, true>(F.lds, g, S, EH); }
        if (PROBE_DUP == 23) { pg8::EpiPat<true> EP{(bf16*)(F.ws + WS_SCR), 3072, 12}; pg8::gemm_phase<pg8::EpiPat<true>, pg8::StaticOrder, true, true>(F.lds, g, S, EP); }
        if (PROBE_DUP == 24) { pg8::EpiPat<false> EP{(bf16*)(F.ws + WS_SCR), 3072, 12}; pg8::gemm_phase<pg8::EpiPat<false>, pg8::StaticOrder, true, true>(F.lds, g, S, EP); }
        if (PROBE_DUP == 25) { pg8::EpiPat<false> EP{W_PROJ, 3840, 12}; pg8::gemm_phase<pg8::EpiPat<false>, pg8::StaticOrder, true, true>(F.lds, g, S, EP); }
        if (PROBE_DUP == 26) { pg8::EpiPat<false> EP{W_PROJ, 3840, 15}; pg8::gemm_phase<pg8::EpiPat<false>, pg8::StaticOrder, true, true>(F.lds, g, S, EP); }
        if (PROBE_DUP == 21) { pg8::EpiNull EN{W_SCR}; pg8::gemm_phase<pg8::EpiNull, pg8::StaticOrder, true, true>(F.lds, g, S, EN); }
        if (BOTH(2)) xcd_barrier(bar);
    }
    if (IN(3)) {
#define NEXT_ITEM(dst, qw) do { if (F.tid == 0) F.MISC[4] = __hip_atomic_fetch_add(F.ctl + (qw), 1u, RLX_AGENT); __syncthreads(); dst = (int)F.MISC[4]; __syncthreads(); } while (0)
        float mb2; { const int hd_ = F.lane & 3; float m_ = P_RELB[hd_]; for (int k = 1; k < 32; ++k) m_ = fmaxf(m_, P_RELB[k * 4 + hd_]); mb2 = m_ * LOG2E; }
        int item; NEXT_ITEM(item, CW_QUEUE);
#pragma unroll 1
        for (int pass = 0; pass < (PROBE_DUP == 3 ? 2 : 1); ++pass) {
            if (pass) NEXT_ITEM(item, CW_QUEUE + 64);
            while (item < N_GDN) { gdn_unit(F, args, item >> 2, item & 3); NEXT_ITEM(item, CW_QUEUE + 64 * pass); }
        }
#pragma unroll 1
        for (int pass = 0; pass < (PROBE_DUP == 4 ? 2 : 1); ++pass) {
            if (pass) NEXT_ITEM(item, CW_QUEUE + 128);
            while (item < N_ITEMS) { if (item >= N_GDN) { const int idx = item - N_GDN; dsa_unit(F, args, idx & 31, 31 - (idx >> 5), mb2); } NEXT_ITEM(item, pass ? CW_QUEUE + 128 : CW_QUEUE); }
        }
#undef NEXT_ITEM
        if (BOTH(3)) xcd_barrier(bar);
    }
    if (IN(4)) {
        pg8::Gemm g{W_OAB, W_WOUTT, MROWS, DM, DM, (unsigned*)(F.ws + WS_CTL + 512 * 1024)}; pg8::StaticOrder S; S.init(MROWS, DM, F.G, (int)blockIdx.x);
        pg8::EpiMix E{W_MIX, DM};
        STAGGER(STAG_P4);
        pg8::gemm_phase<pg8::EpiMix, pg8::StaticOrder, true, true>(F.lds, g, S, E);
        if (PROBE_DUP == 5) pg8::gemm_phase<pg8::EpiMix, pg8::StaticOrder, true, true>(F.lds, g, S, E);
        if (BOTH(4)) xcd_barrier(bar);
    }
    if (IN(5)) { p5_final(F, args); if (PROBE_DUP == 6) p5_final(F, args); }
#undef IN
#undef BOTH
}

extern "C" void kernel_launch(void* const* d_in, const int* in_sizes, int n_in, void* d_out, int out_size, void* d_ws, size_t ws_size, hipStream_t stream) {
    static int grid = 0;
    if (grid == 0) {
        if (n_in != 15 || in_sizes[0] != MROWS * DM || out_size != MROWS * DM || ws_size < WS_END) { fprintf(stderr, "kernel_launch: unexpected shapes (n_in %d, in0 %d, out %d, ws %zu); nothing launched\n", n_in, n_in > 0 ? in_sizes[0] : -1, out_size, ws_size); grid = -1; return; }
        int dev = 0, cus = 0, per_cu = 0;
        if (hipGetDevice(&dev) != hipSuccess || hipDeviceGetAttribute(&cus, hipDeviceAttributeMultiprocessorCount, dev) != hipSuccess) { fprintf(stderr, "kernel_launch: device query failed\n"); grid = -1; return; }
        if (hipFuncSetAttribute((const void*)hyb_fwd, hipFuncAttributeMaxDynamicSharedMemorySize, LDS_BYTES) != hipSuccess) { fprintf(stderr, "kernel_launch: hipFuncSetAttribute failed\n"); grid = -1; return; }
        if (hipOccupancyMaxActiveBlocksPerMultiprocessor(&per_cu, (const void*)hyb_fwd, NWAVES * 64, LDS_BYTES) != hipSuccess || per_cu < 1)
            fprintf(stderr, "kernel_launch: note: occupancy query reports %d workgroups per CU\n", per_cu);
        (void)hipGetLastError();
        grid = cus < 256 ? cus : 256;
    }
    if (grid < 0) return;
    if (hipMemsetAsync((char*)d_ws + WS_CTL, 0, CTL_ZERO_BYTES, stream) != hipSuccess) { fprintf(stderr, "kernel_launch: memset failed\n"); return; }
    Args a{};
    for (int i = 0; i < 15; ++i) a.in[i] = (const float*)d_in[i];
    a.out = (float*)d_out; a.ws = (unsigned char*)d_ws;
    constexpr int NL = MK_N_LAUNCHES;
    static_assert(NL == 1 || NL == 2 || NL == 3 || NL == N_PHASES, "MK_N_LAUNCHES");
    const int cuts1[2] = {0, 6}, cuts2[3] = {0, 3, 6}, cuts3[4] = {0, 3, 4, 6}, cuts6[7] = {0, 1, 2, 3, 4, 5, 6};
    const int* cuts = NL == 1 ? cuts1 : NL == 2 ? cuts2 : NL == 3 ? cuts3 : cuts6;
    for (int li = 0; li < NL; ++li) {
        a.ph_lo = cuts[li]; a.ph_hi = cuts[li + 1]; a.li = li;
        hipLaunchKernelGGL(hyb_fwd, dim3(grid), dim3(NWAVES * 64), LDS_BYTES, stream, a);
        const hipError_t le = hipPeekAtLastError();
        if (le != hipSuccess) { fprintf(stderr, "kernel_launch: launch %d failed: %s\n", li, hipGetErrorName(le)); break; }
    }
}
```

```cpp
#include <hip/hip_runtime.h>
#include <cstdio>
#include <cstdint>
#ifndef MK_N_LAUNCHES
#define MK_N_LAUNCHES 1
#endif
#ifndef PROBE_DUP
#define PROBE_DUP 0
#endif
namespace pg8 {
#define PG8_LAS __attribute__((address_space(3)))
typedef unsigned short bf16_t;
typedef short bf16x8 __attribute__((ext_vector_type(8)));
typedef float f32x4 __attribute__((ext_vector_type(4)));
typedef unsigned u32x4 __attribute__((ext_vector_type(4)));
constexpr int BM = 256, BK = 64, HALF = 128, HTB = HALF * BK * 2  , STAGE_BYTES = 8 * HTB, NXCD = 8, WGM = 8;

__host__ __device__ __forceinline__ int lds_byte(int r, int c) { const int st = (r >> 4) * 2 + (c >> 5), rr = r & 15, cc = c & 31, ob = rr * 64 + cc * 2; return st * 1024 + (ob ^ (((ob >> 9) & 1) << 5)); }
__host__ __device__ __forceinline__ void stage_rc(int b, int& R, int& C) { const int st = b / 1024, sb = b % 1024, swz = sb ^ (((sb >> 9) & 1) << 5); R = (st >> 1) * 16 + swz / 64; C = (st & 1) * 32 + (swz % 64) / 2; }
__host__ __device__ __forceinline__ int perm32(int rho) { const int n = rho >> 4, i = rho & 15; return 8 * (i >> 2) + 4 * n + (i & 3); }

struct Unit { int pm, pn; };
struct Gemm { const bf16_t* A; const bf16_t* Bt; int M, N, K; unsigned* sink; };

struct StaticOrder {
    int nM, nN, nwg, G, c;
    __host__ __device__ void init(int M, int N, int G_, int c_) { nM = M / BM; nN = N / BM; nwg = nM * nN; G = G_; c = c_; }
    __host__ __device__ bool next(int i, Unit& u) const {
        const long L = (long)i * G + c; if (L >= nwg) return false;
        int wgid = (int)L; { const int q = nwg / NXCD, r = nwg % NXCD, xcd = wgid % NXCD, off = wgid / NXCD; wgid = (xcd < r ? xcd * (q + 1) : r * (q + 1) + (xcd - r) * q) + off; }
        const int nig = WGM * nN, gid = wgid / nig, fm = gid * WGM, gsz = (nM - fm) < WGM ? (nM - fm) : WGM;
        u.pm = fm + ((wgid % nig) % gsz); u.pn = (wgid % nig) / gsz; return true;
    }
    __device__ __forceinline__ void a_ready(const Unit&) const {}
    __device__ __forceinline__ void done(const Unit&) const {}
};

typedef float f32x2c __attribute__((ext_vector_type(2))); typedef __bf16 b16x2c __attribute__((ext_vector_type(2)));
__device__ __forceinline__ unsigned cvt_pk_bf16(float lo, float hi) { const f32x2c v = {lo, hi}; return __builtin_bit_cast(unsigned, __builtin_convertvector(v, b16x2c)); }
struct EpiProj {
    static constexpr bool PERM = true, AFTER_DRAIN = false; static constexpr int MIN_VM = 16;
    bf16_t* O; float* aux; float* kvss;
    __device__ __forceinline__ void operator()(const f32x4 (&acc)[2][2][4][2], const Unit& u, int wr, int wc, int fr, int fq) const {
        const int row0 = u.pm * BM + wr * 64 + fr, col0 = u.pn * BM + wc * 32 + 8 * fq;
        const bool last = (u.pn == 14);
#pragma unroll
        for (int ai = 0; ai < 2; ++ai)
#pragma unroll
            for (int m = 0; m < 4; ++m) {
                const int row = row0 + ai * HALF + m * 16;
                bf16_t* rowp = O + (size_t)row * 3840 + col0;
#pragma unroll
                for (int bj = 0; bj < 2; ++bj) {
                    const f32x4 v0 = acc[ai][bj][m][0], v1 = acc[ai][bj][m][1];
                    u32x4 w; w.x = cvt_pk_bf16(v0[0], v0[1]); w.y = cvt_pk_bf16(v0[2], v0[3]); w.z = cvt_pk_bf16(v1[0], v1[1]); w.w = cvt_pk_bf16(v1[2], v1[3]);
                    *(u32x4*)(rowp + bj * HALF) = w;
                }
                if (last) {
                    const f32x4 a0 = acc[ai][0][m][0], a1 = acc[ai][0][m][1];
                    float ss = (a0[0] * a0[0] + a0[1] * a0[1]) + (a0[2] * a0[2] + a0[3] * a0[3]) + (a1[0] * a1[0] + a1[1] * a1[1]) + (a1[2] * a1[2] + a1[3] * a1[3]);
                    ss += __shfl_xor(ss, 16); ss += __shfl_xor(ss, 32);
                    if (fq == 0) kvss[(size_t)wc * 65536 + row] = ss;
                    if (wc == 2 && fq < 2) { float* ap = aux + (size_t)row * 16 + 8 * fq; *(f32x4*)ap = acc[ai][1][m][0]; *(f32x4*)(ap + 4) = acc[ai][1][m][1]; }
                }
            }
    }
};
struct EpiF32 {
    static constexpr bool PERM = false, AFTER_DRAIN = false; static constexpr int MIN_VM = 32;
    float* C; int ldc;
    __device__ __forceinline__ void operator()(const f32x4 (&acc)[2][2][4][2], const Unit& u, int wr, int wc, int fr, int fq) const {
        const int row0 = u.pm * BM + wr * 64 + fr, col0 = u.pn * BM + wc * 32 + 4 * fq;
#pragma unroll
        for (int ai = 0; ai < 2; ++ai)
#pragma unroll
            for (int m = 0; m < 4; ++m) { float* rowp = C + (size_t)(row0 + ai * HALF + m * 16) * ldc + col0;
#pragma unroll
                for (int bj = 0; bj < 2; ++bj)
#pragma unroll
                    for (int n = 0; n < 2; ++n) *(f32x4*)(rowp + bj * HALF + n * 16) = acc[ai][bj][m][n]; }
    }
};
struct EpiMix {
    static constexpr bool PERM = true, AFTER_DRAIN = false; static constexpr int MIN_VM = 16;
    bf16_t* O; int ldc;
    __device__ __forceinline__ void operator()(const f32x4 (&acc)[2][2][4][2], const Unit& u, int wr, int wc, int fr, int fq) const {
        const int row0 = u.pm * BM + wr * 64 + fr, col0 = u.pn * BM + wc * 32 + 8 * fq;
#pragma unroll
        for (int ai = 0; ai < 2; ++ai)
#pragma unroll
            for (int m = 0; m < 4; ++m) { bf16_t* rowp = O + (size_t)(row0 + ai * HALF + m * 16) * ldc + col0;
#pragma unroll
                for (int bj = 0; bj < 2; ++bj) { const f32x4 v0 = acc[ai][bj][m][0], v1 = acc[ai][bj][m][1];
                    u32x4 w; w.x = cvt_pk_bf16(v0[0], v0[1]); w.y = cvt_pk_bf16(v0[2], v0[3]); w.z = cvt_pk_bf16(v1[0], v1[1]); w.w = cvt_pk_bf16(v1[2], v1[3]);
                    *(u32x4*)(rowp + bj * HALF) = w; } }
    }
};
struct EpiNull {
    static constexpr bool PERM = true, AFTER_DRAIN = false; static constexpr int MIN_VM = 0;
    float* O;
    __device__ __forceinline__ void operator()(const f32x4 (&acc)[2][2][4][2], const Unit& u, int wr, int wc, int fr, int fq) const {
        f32x4 s = {0.f, 0.f, 0.f, 0.f};
#pragma unroll
        for (int ai = 0; ai < 2; ++ai)
#pragma unroll
            for (int bj = 0; bj < 2; ++bj)
#pragma unroll
                for (int m = 0; m < 4; ++m) { s += acc[ai][bj][m][0]; s += acc[ai][bj][m][1]; }
        if ((s[0] + s[1]) + (s[2] + s[3]) == 1.2345e30f) O[u.pm * 4096 + u.pn * 256 + wr * 128 + wc * 32 + fq * 16 + fr] = s[0];
    }
};
struct EpiHalf {
    static constexpr bool PERM = true, AFTER_DRAIN = false; static constexpr int MIN_VM = 0;
    EpiProj P; EpiNull N;
    __device__ __forceinline__ void operator()(const f32x4 (&acc)[2][2][4][2], const Unit& u, int wr, int wc, int fr, int fq) const {
        if ((blockIdx.x & 7) < 4) P(acc, u, wr, wc, fr, fq); else N(acc, u, wr, wc, fr, fq);
    }
};
template <bool TILE> struct EpiPat {
    static constexpr bool PERM = true, AFTER_DRAIN = false; static constexpr int MIN_VM = 0;
    bf16_t* O; int ld, npn;
    __device__ __forceinline__ void operator()(const f32x4 (&acc)[2][2][4][2], const Unit& u, int wr, int wc, int fr, int fq) const {
        if (u.pn >= npn) return;
        const int r0 = wr * 64 + fr, c0 = wc * 32 + 8 * fq;
#pragma unroll
        for (int ai = 0; ai < 2; ++ai)
#pragma unroll
            for (int m = 0; m < 4; ++m) {
                const int r = r0 + ai * HALF + m * 16;
                bf16_t* rowp = TILE ? O + ((size_t)(u.pm * 12 + u.pn) * 65536 + r * 256 + c0) : O + ((size_t)(u.pm * BM + r) * ld + u.pn * BM + c0);
#pragma unroll
                for (int bj = 0; bj < 2; ++bj) {
                    const f32x4 v0 = acc[ai][bj][m][0], v1 = acc[ai][bj][m][1];
                    u32x4 w; w.x = cvt_pk_bf16(v0[0], v0[1]); w.y = cvt_pk_bf16(v0[2], v0[3]); w.z = cvt_pk_bf16(v1[0], v1[1]); w.w = cvt_pk_bf16(v1[2], v1[3]);
                    *(u32x4*)(rowp + bj * HALF) = w;
                }
            }
    }
};
template <int N> __device__ __forceinline__ void wait_vm() { asm volatile("s_waitcnt vmcnt(%0)" :: "n"(N) : "memory"); }
template <class Epi, class Sched, bool ALIGN_EPI = false, bool SP2 = false>
__device__ __forceinline__ void gemm_phase(PG8_LAS unsigned char* lds, const Gemm g, const Sched& S, const Epi& E) {
    int tid_ = threadIdx.x; asm volatile("" : "+v"(tid_));
    const int tid = tid_, wid = __builtin_amdgcn_readfirstlane(tid >> 6), lane = tid & 63, wr = wid >> 2, wc = wid & 3, fr = lane & 15, fq = lane >> 4;
    const int K = g.K, nt = K / BK;
    constexpr int XV = (SP2 && !Epi::AFTER_DRAIN) ? Epi::MIN_VM : 0;
    unsigned voffA[2], voffB[2];
#pragma unroll
    for (int i = 0; i < 2; ++i) { int R, C; stage_rc(tid * 16 + i * 8192, R, C); const int Rb = Epi::PERM ? ((R & ~31) + perm32(R & 31)) : R;
        voffA[i] = (unsigned)(R * K + C) * 2u; voffB[i] = (unsigned)(Rb * K + C) * 2u; }
    const unsigned kstep = BK * 2;
    const unsigned hstep = (unsigned)HALF * K * 2;
    const unsigned tstep = 2 * hstep;
    const __amdgpu_buffer_rsrc_t srdA = __builtin_amdgcn_make_buffer_rsrc((void*)g.A, (short)0, (int)((size_t)g.M * K * 2), 0x00020000);
    const __amdgpu_buffer_rsrc_t srdB = __builtin_amdgcn_make_buffer_rsrc((void*)g.Bt, (short)0, (int)((size_t)g.N * K * 2), 0x00020000);
    const unsigned ldsb = (unsigned)(size_t)lds;
    const unsigned ldsw = (unsigned)wid * 1024u;
    const int aoff = lds_byte(wr * 64 + fr, fq * 8), boff = lds_byte(wc * 32 + fr, fq * 8);
#define PG8_SA(b, h) (((b) * 2 + (h)) * HTB)
#define PG8_SB(b, h) ((4 + (b) * 2 + (h)) * HTB)
#define PG8_STAGE(bufoff, srd, soff, voff) do { _Pragma("unroll") for (int _i = 0; _i < 2; ++_i) \
        asm volatile("s_mov_b32 m0, %0\n\ts_nop 0\n\tbuffer_load_dwordx4 %1, %2, %3 offen lds" :: "s"(ldsb + (unsigned)(bufoff) + ldsw + _i * 8192u), "v"((voff)[_i]), "s"(srd), "s"((unsigned)(soff)) : "m0", "memory"); } while (0)
#define PG8_LDA(dst, b, h) do { _Pragma("unroll") for (int m = 0; m < 4; ++m) _Pragma("unroll") for (int k = 0; k < 2; ++k) dst[m][k] = *(const PG8_LAS bf16x8*)(lds + PG8_SA(b, h) + aoff + m * 2048 + k * 1024); } while (0)
#define PG8_LDB(dst, b, h) do { _Pragma("unroll") for (int n = 0; n < 2; ++n) _Pragma("unroll") for (int k = 0; k < 2; ++k) dst[n][k] = *(const PG8_LAS bf16x8*)(lds + PG8_SB(b, h) + boff + n * 2048 + k * 1024); } while (0)
#define PG8_MMA(ai, bj, At, Bt) do { __builtin_amdgcn_s_setprio(1); _Pragma("unroll") for (int m = 0; m < 4; ++m) _Pragma("unroll") for (int n = 0; n < 2; ++n) _Pragma("unroll") for (int k = 0; k < 2; ++k) \
        acc[ai][bj][m][n] = __builtin_amdgcn_mfma_f32_16x16x32_bf16(Bt[n][k], At[m][k], acc[ai][bj][m][n], 0, 0, 0); __builtin_amdgcn_s_setprio(0); } while (0)
#define PG8_WAIT_V(n) asm volatile("s_waitcnt vmcnt(" #n ")" ::: "memory")
#define PG8_WAIT_L(n) asm volatile("s_waitcnt lgkmcnt(" #n ")" ::: "memory")
#define PG8_BAR __builtin_amdgcn_s_barrier()
#define PG8_SCHED __builtin_amdgcn_sched_barrier(0)
    Unit cur, nxt; int ui = 0;
    if (!S.next(0, cur)) return;
    f32x4 acc[2][2][4][2];
#pragma unroll
    for (int a = 0; a < 2; ++a)
#pragma unroll
        for (int b = 0; b < 2; ++b)
#pragma unroll
            for (int m = 0; m < 4; ++m)
#pragma unroll
                for (int n = 0; n < 2; ++n) acc[a][b][m][n] = (f32x4){0.f, 0.f, 0.f, 0.f};
    bf16x8 At[4][2], B0[2][2], B1[2][2];
    unsigned cA = (unsigned)cur.pm * tstep, cB = (unsigned)cur.pn * tstep;
    S.a_ready(cur);
    if constexpr (SP2) {
        PG8_STAGE(PG8_SB(0, 0), srdB, cB, voffB); PG8_STAGE(PG8_SB(0, 1), srdB, cB + hstep, voffB); PG8_STAGE(PG8_SA(0, 0), srdA, cA, voffA); PG8_STAGE(PG8_SA(0, 1), srdA, cA + hstep, voffA);
        if (wr == 1) PG8_BAR;
        PG8_WAIT_V(2); PG8_BAR;
        PG8_STAGE(PG8_SB(1, 0), srdB, cB + kstep, voffB); PG8_STAGE(PG8_SA(1, 0), srdA, cA + kstep, voffA); PG8_STAGE(PG8_SB(1, 1), srdB, cB + hstep + kstep, voffB);
        PG8_WAIT_V(6); PG8_BAR;
        PG8_STAGE(PG8_SA(1, 1), srdA, cA + kstep + hstep, voffA);
        if constexpr (XV > 0) {
            unsigned* sp = g.sink + ((size_t)blockIdx.x * 8 + wid) * 64 + lane; const unsigned zero = 0u;
#pragma unroll
            for (int i = 0; i < XV; ++i) asm volatile("global_store_dword %0, %1, off" :: "v"(sp), "v"(zero) : "memory");
        }
    } else {
        PG8_STAGE(PG8_SB(0, 0), srdB, cB, voffB); PG8_STAGE(PG8_SA(0, 0), srdA, cA, voffA); PG8_STAGE(PG8_SB(0, 1), srdB, cB + hstep, voffB); PG8_STAGE(PG8_SA(0, 1), srdA, cA + hstep, voffA);
        if (wr == 1) PG8_BAR;
        PG8_WAIT_V(4); PG8_BAR;
        PG8_STAGE(PG8_SB(1, 0), srdB, cB + kstep, voffB); PG8_STAGE(PG8_SA(1, 0), srdA, cA + kstep, voffA); PG8_STAGE(PG8_SB(1, 1), srdB, cB + hstep + kstep, voffB);
        PG8_WAIT_V(6); PG8_BAR;
    }
    for (;;) {
        const bool has_next = S.next(ui + 1, nxt);
        const unsigned nA = has_next ? (unsigned)nxt.pm * tstep : cA, nB = has_next ? (unsigned)nxt.pn * tstep : cB;
        if constexpr (SP2) {
#define PG8_PAIR(W3) do { \
            const bool last = (t == nt - 2); \
            const unsigned a2 = last ? nA : cA + (unsigned)(t + 2) * kstep, b2 = last ? nB : cB + (unsigned)(t + 2) * kstep;     \
            const unsigned a3 = a2 + kstep, b3 = b2 + kstep;                                \
            if (last && has_next) S.a_ready(nxt); \
              \
            PG8_LDB(B0, 0, 0); PG8_LDB(B1, 0, 1); PG8_SCHED; PG8_LDA(At, 0, 0); \
            W3; PG8_WAIT_L(0); PG8_BAR; PG8_MMA(0, 0, At, B0); PG8_MMA(0, 1, At, B1); PG8_BAR; PG8_SCHED; \
              \
            PG8_LDA(At, 0, 1); PG8_STAGE(PG8_SB(0, 0), srdB, b2, voffB); PG8_STAGE(PG8_SB(0, 1), srdB, b2 + hstep, voffB); PG8_STAGE(PG8_SA(0, 0), srdA, a2, voffA); \
            W3; PG8_WAIT_L(0); PG8_BAR; PG8_MMA(1, 0, At, B0); PG8_MMA(1, 1, At, B1); PG8_BAR; PG8_SCHED; \
              \
            PG8_LDB(B0, 1, 0); PG8_LDB(B1, 1, 1); PG8_SCHED; PG8_LDA(At, 1, 0); PG8_STAGE(PG8_SA(0, 1), srdA, a2 + hstep, voffA); \
            W3; PG8_WAIT_L(0); PG8_BAR; PG8_MMA(0, 0, At, B0); PG8_MMA(0, 1, At, B1); PG8_BAR; PG8_SCHED; \
              \
            PG8_LDA(At, 1, 1); PG8_STAGE(PG8_SB(1, 0), srdB, b3, voffB); PG8_STAGE(PG8_SB(1, 1), srdB, b3 + hstep, voffB); PG8_STAGE(PG8_SA(1, 0), srdA, a3, voffA); \
            PG8_WAIT_V(8); PG8_WAIT_L(0); PG8_BAR; PG8_MMA(1, 0, At, B0); PG8_MMA(1, 1, At, B1); PG8_BAR; PG8_SCHED; \
            PG8_STAGE(PG8_SA(1, 1), srdA, a3 + hstep, voffA); } while (0)
        { const int t = 0; PG8_PAIR(wait_vm<8 + XV>()); }
        for (int t = 2; t < nt; t += 2) PG8_PAIR(PG8_WAIT_V(8));
#undef PG8_PAIR
        } else {
        for (int t = 0; t < nt; t += 2) {
            const bool last = (t == nt - 2);
            const unsigned a1 = cA + (unsigned)(t + 1) * kstep;
            const unsigned a2 = last ? nA : cA + (unsigned)(t + 2) * kstep, b2 = last ? nB : cB + (unsigned)(t + 2) * kstep;
            const unsigned a3 = a2 + kstep, b3 = b2 + kstep;
            if (last && has_next) S.a_ready(nxt);
            PG8_LDB(B0, 0, 0); PG8_SCHED; PG8_LDA(At, 0, 0); PG8_STAGE(PG8_SA(1, 1), srdA, a1 + hstep, voffA);
            PG8_WAIT_L(8); PG8_BAR; PG8_WAIT_L(0); PG8_MMA(0, 0, At, B0); PG8_BAR; PG8_SCHED;
            PG8_LDB(B1, 0, 1); PG8_STAGE(PG8_SB(0, 0), srdB, b2, voffB);
            PG8_BAR; PG8_WAIT_L(0); PG8_MMA(0, 1, At, B1); PG8_BAR;
            PG8_LDA(At, 0, 1); PG8_STAGE(PG8_SA(0, 0), srdA, a2, voffA);
            PG8_BAR; PG8_WAIT_L(0); PG8_MMA(1, 0, At, B0); PG8_BAR; PG8_SCHED;
            PG8_STAGE(PG8_SB(0, 1), srdB, b2 + hstep, voffB);
            PG8_WAIT_V(6); PG8_BAR; PG8_MMA(1, 1, At, B1); PG8_BAR;
            PG8_LDB(B0, 1, 0); PG8_SCHED; PG8_LDA(At, 1, 0); PG8_STAGE(PG8_SA(0, 1), srdA, a2 + hstep, voffA);
            PG8_WAIT_L(8); PG8_BAR; PG8_WAIT_L(0); PG8_MMA(0, 0, At, B0); PG8_BAR; PG8_SCHED;
            PG8_LDB(B1, 1, 1); PG8_STAGE(PG8_SB(1, 0), srdB, b3, voffB);
            PG8_BAR; PG8_WAIT_L(0); PG8_MMA(0, 1, At, B1); PG8_BAR;
            PG8_LDA(At, 1, 1); PG8_STAGE(PG8_SA(1, 0), srdA, a3, voffA);
            PG8_BAR; PG8_WAIT_L(0); PG8_MMA(1, 0, At, B0); PG8_BAR; PG8_SCHED;
            PG8_STAGE(PG8_SB(1, 1), srdB, b3 + hstep, voffB);
            PG8_WAIT_V(6); PG8_BAR; PG8_MMA(1, 1, At, B1); PG8_BAR;
        }
        }
        if constexpr (ALIGN_EPI) { if (wr == 0) PG8_BAR; }
        if constexpr (!Epi::AFTER_DRAIN) { E(acc, cur, wr, wc, fr, fq); S.done(cur); }
        if (!has_next) break;
#pragma unroll
        for (int a = 0; a < 2; ++a)
#pragma unroll
            for (int b = 0; b < 2; ++b)
#pragma unroll
                for (int m = 0; m < 4; ++m)
#pragma unroll
                    for (int n = 0; n < 2; ++n) acc[a][b][m][n] = (f32x4){0.f, 0.f, 0.f, 0.f};
        cur = nxt; cA = nA; cB = nB; ++ui;
        if constexpr (ALIGN_EPI) { if (wr == 1) PG8_BAR; }
    }
    PG8_WAIT_V(0);
    if constexpr (!ALIGN_EPI) { if (wr == 0) PG8_BAR; }
    PG8_BAR;
    if constexpr (Epi::AFTER_DRAIN) { E.fused(acc, cur, wr, wc, fr, fq, lds, wid, lane); S.done(cur); }
#undef PG8_SA
#undef PG8_SB
#undef PG8_STAGE
#undef PG8_LDA
#undef PG8_LDB
#undef PG8_MMA
#undef PG8_WAIT_V
#undef PG8_WAIT_L
#undef PG8_BAR
#undef PG8_SCHED
}
}

constexpr int NWAVES = 8;
constexpr int NB = 32, SEQ = 2048, DM = 1024, MROWS = NB * SEQ;
constexpr int NPROJ = 3840;
constexpr int C_ZA = 1536, C_QB = 2048, C_ZB = 2560, C_IQ = 3072, C_CKV = 3584, C_IK = 3712;
constexpr float EPSF = 1e-6f;
constexpr float LOG2E = 1.4426950408889634f;
__host__ __device__ __forceinline__ int proj_src_col(int n) {
    if (n < 2048) return n;
    if (n < 2560) return n - 2048 + 2056;
    if (n < 3072) return n - 2560 + 2696;
    if (n < 3584) return n - 3072 + 3208;
    if (n < 3712) return n - 3584 + 2568;
    if (n < 3776) return n - 3712 + 3720;
    if (n < 3784) return n - 3776 + 2048;
    if (n < 3792) return n;
    return -1;
}
__device__ const unsigned char T5_BUCKET[128] = {0,1,2,3,4,5,6,7,8,9,10,11,12,13,14,15,16,16,16,17,17,18,18,18,19,19,19,20,20,20,20,21,21,21,21,22,22,22,22,22,23,23,23,23,23,23,24,24,24,24,24,24,25,25,25,25,25,25,25,26,26,26,26,26,26,26,26,27,27,27,27,27,27,27,27,27,27,28,28,28,28,28,28,28,28,28,28,29,29,29,29,29,29,29,29,29,29,29,29,30,30,30,30,30,30,30,30,30,30,30,30,30,30,31,31,31,31,31,31,31,31,31,31,31,31,31,31,31};

constexpr size_t MiB = 1u << 20;
constexpr size_t WS_CTL = 0, CTL_ZERO_BYTES = 1 * MiB;
constexpr size_t WS_MOD = 1 * MiB;
constexpr size_t WS_WUV = 2 * MiB;
constexpr size_t WS_WOUT = 3 * MiB;
constexpr size_t WS_WIN = 5 * MiB;
constexpr size_t WS_KVSS = 13 * MiB;
constexpr size_t WS_AUX = 14 * MiB;
constexpr size_t WS_XN = 32 * MiB;
constexpr size_t WS_PROJ = 160 * MiB;
constexpr size_t WS_SCR = 640 * MiB;
constexpr size_t WS_END = 768 * MiB;
constexpr int CW_TMO = 0, CW_QUEUE = 64, CW_BAR = 4096;

constexpr int LDS_BYTES = 163840;
constexpr int MISC_OFF = LDS_BYTES - 256;
constexpr int SCRATCH_BYTES = MISC_OFF;

#define GAS __attribute__((address_space(1)))
#define LAS __attribute__((address_space(3)))
typedef unsigned short bf16;
typedef unsigned v4u __attribute__((ext_vector_type(4)));
typedef unsigned v2u __attribute__((ext_vector_type(2)));
typedef float f32x4 __attribute__((ext_vector_type(4)));
typedef float f32x16 __attribute__((ext_vector_type(16)));
typedef short bf16x8 __attribute__((ext_vector_type(8)));
typedef GAS unsigned gu32;
#define RLX_AGENT __ATOMIC_RELAXED, __HIP_MEMORY_SCOPE_AGENT
#define LDS_WAIT() asm volatile("s_waitcnt lgkmcnt(0)" ::: "memory")
#define MFMA32(a, b, c) __builtin_amdgcn_mfma_f32_32x32x16_bf16((a), (b), (c), 0, 0, 0)
#define MFMA16F(a, b, c) __builtin_amdgcn_mfma_f32_16x16x4f32((a), (b), (c), 0, 0, 0)
__device__ __forceinline__ unsigned f2bf(float f) { unsigned u = __builtin_bit_cast(unsigned, f); return (u + 0x7fffu + ((u >> 16) & 1u)) >> 16; }
__device__ __forceinline__ unsigned pk2(float lo, float hi) { return f2bf(lo) | (f2bf(hi) << 16); }
__device__ __forceinline__ float bf2f(unsigned short b) { return __builtin_bit_cast(float, ((unsigned)b) << 16); }
__device__ __forceinline__ float bflo(unsigned w) { return __builtin_bit_cast(float, w << 16); }
__device__ __forceinline__ float bfhi(unsigned w) { return __builtin_bit_cast(float, w & 0xffff0000u); }
__device__ __forceinline__ float rcpf_(float x) { return __builtin_amdgcn_rcpf(x); }
__device__ __forceinline__ float rsqf_(float x) { return __builtin_amdgcn_rsqf(x); }
__device__ __forceinline__ float siluf(float x) { return x * __builtin_amdgcn_rcpf(1.0f + __builtin_amdgcn_exp2f(-1.4426950408889634f * x)); }
__device__ __forceinline__ float wave_sum(float v) {
#pragma unroll
    for (int o = 1; o < 64; o <<= 1) v += __shfl_xor(v, o);
    return v;
}

__device__ __forceinline__ float wave_sum_f(float v) {
#define WSF_(ctl, rm, bm) v += __builtin_bit_cast(float, __builtin_amdgcn_update_dpp(0, __builtin_bit_cast(int, v), ctl, rm, bm, false))
    WSF_(0x111, 0xf, 0xf); WSF_(0x112, 0xf, 0xf); WSF_(0x114, 0xf, 0xe); WSF_(0x118, 0xf, 0xc); WSF_(0x142, 0xa, 0xf); WSF_(0x143, 0xc, 0xf);
#undef WSF_
    return __builtin_bit_cast(float, __builtin_amdgcn_readlane(__builtin_bit_cast(int, v), 63));
}
__device__ __forceinline__ int wave_sum_i(int v) {
    v += __builtin_amdgcn_update_dpp(0, v, 0x111, 0xf, 0xf, false);
    v += __builtin_amdgcn_update_dpp(0, v, 0x112, 0xf, 0xf, false);
    v += __builtin_amdgcn_update_dpp(0, v, 0x114, 0xf, 0xe, false);
    v += __builtin_amdgcn_update_dpp(0, v, 0x118, 0xf, 0xc, false);
    v += __builtin_amdgcn_update_dpp(0, v, 0x142, 0xa, 0xf, false);
    v += __builtin_amdgcn_update_dpp(0, v, 0x143, 0xc, 0xf, false);
    return __builtin_amdgcn_readlane(v, 63);
}
__device__ __forceinline__ float wave_max(float v) {
    const int ninf = (int)0xff800000u;
#define WM_STEP(ctrl, rm, bm) v = fmaxf(v, __builtin_bit_cast(float, __builtin_amdgcn_update_dpp(ninf, __builtin_bit_cast(int, v), ctrl, rm, bm, false)))
    WM_STEP(0x111, 0xf, 0xf); WM_STEP(0x112, 0xf, 0xf); WM_STEP(0x114, 0xf, 0xe); WM_STEP(0x118, 0xf, 0xc); WM_STEP(0x142, 0xa, 0xf); WM_STEP(0x143, 0xc, 0xf);
#undef WM_STEP
    return __builtin_bit_cast(float, __builtin_amdgcn_readlane(__builtin_bit_cast(int, v), 63));
}
#define XB_TMO      128
#define XB_XCNT(j)  (256  + 64 * (j))
#define XB_XSUB(j)  (1280 + 64 * (j))
#define XB_XGEN(j)  (2304 + 64 * (j))
#define XB_TOP      3328
#define XB_TOPGEN   3392
#define XCD_BAR_WORDS 3456
#define XB_SPIN_CAP (1u << 18)

__device__ __forceinline__ unsigned xb_ld(unsigned* p)              { return __hip_atomic_load(p, __ATOMIC_RELAXED, __HIP_MEMORY_SCOPE_AGENT); }
__device__ __forceinline__ unsigned xb_add(unsigned* p, unsigned v) { return __hip_atomic_fetch_add(p, v, __ATOMIC_RELAXED, __HIP_MEMORY_SCOPE_AGENT); }
__device__ __forceinline__ unsigned xb_xcc_id() { return (unsigned)__builtin_amdgcn_s_getreg((3 << 11) | 20) & 0xFu; }
#define XB_SPIN(cond, bar) do { unsigned _sp = 0; while (cond) { __builtin_amdgcn_s_sleep(1); \
    if ((++_sp & 255u) == 0u) { if (xb_ld(&(bar)[XB_TMO])) break; if (_sp > XB_SPIN_CAP) { atomicAdd(&(bar)[XB_TMO], 1u); break; } } } } while (0)

struct XcdBarrier {
    unsigned* bar; unsigned x;
    volatile LAS unsigned* st;
};

__device__ __forceinline__ XcdBarrier xcd_barrier_post(unsigned* bar, volatile LAS unsigned* st) {
    XcdBarrier b; b.bar = bar; b.x = xb_xcc_id(); b.st = st;
    if (threadIdx.x == 0) (void)xb_add(&bar[XB_XCNT(b.x)], 1u);
    return b;
}
__device__ __forceinline__ void xcd_barrier_complete(unsigned* bar, unsigned x, unsigned& nloc, unsigned& nx) {
    const unsigned G = gridDim.x * gridDim.y * gridDim.z;
    unsigned sum, cnt, mine, sp = 0u;
    for (;;) {
        sum = 0u; cnt = 0u; mine = 0u;
#pragma unroll
        for (unsigned j = 0; j < 16; ++j) { const unsigned c = xb_ld(&bar[XB_XCNT(j)]); sum += c; cnt += (c > 0u) ? 1u : 0u; mine = (j == x) ? c : mine; }
        if (sum == G) break;
        __builtin_amdgcn_s_sleep(1);
        if ((++sp & 255u) == 0u) { if (xb_ld(&bar[XB_TMO])) break; if (sp > XB_SPIN_CAP) { atomicAdd(&bar[XB_TMO], 1u); break; } }
    }
    nloc = mine > 0u ? mine : 1u; nx = cnt > 0u ? cnt : 1u;
}

__device__ __forceinline__ void xcd_barrier(const XcdBarrier& b) {
    asm volatile("s_waitcnt vmcnt(0)" ::: "memory");
    __syncthreads();
    if (threadIdx.x == 0) {
        unsigned* bar = b.bar;
        __builtin_amdgcn_s_waitcnt(0);
        unsigned nloc = b.st[0], nx = b.st[1];
        if (nloc == 0u) { xcd_barrier_complete(bar, b.x, nloc, nx); b.st[0] = nloc; b.st[1] = nx; }
        const unsigned old = xb_add(&bar[XB_XSUB(b.x)], 1u);
        const unsigned gen = old / nloc;
        if (old + 1u == (gen + 1u) * nloc) {
            __builtin_amdgcn_fence(__ATOMIC_RELEASE, "agent");
            asm volatile("s_waitcnt vmcnt(0)" ::: "memory");
            const unsigned og = xb_add(&bar[XB_TOP], 1u);
            const unsigned tg = og / nx;
            if (og + 1u == (tg + 1u) * nx) xb_add(&bar[XB_TOPGEN], 1u);
            else XB_SPIN(xb_ld(&bar[XB_TOPGEN]) == tg, bar);
            __builtin_amdgcn_fence(__ATOMIC_ACQUIRE, "agent");
            xb_add(&bar[XB_XGEN(b.x)], 1u);
            asm volatile("s_waitcnt vmcnt(0)" ::: "memory");
        } else {
            XB_SPIN(xb_ld(&bar[XB_XGEN(b.x)]) == gen, bar);
            __builtin_amdgcn_fence(__ATOMIC_ACQUIRE, "agent");
            asm volatile("s_waitcnt vmcnt(0)" ::: "memory");
        }
    }
    __syncthreads();
}

struct Frame {
    LAS unsigned char* lds;
    volatile LAS unsigned* MISC;
    gu32* ctl;
    int tid, lane, wave;
    int vcu, G;
    unsigned char* ws;
};
#define P_X        (args.in[0])
#define P_C        (args.in[1])
#define P_WADA     (args.in[2])
#define P_BADA     (args.in[3])
#define P_GPRE     (args.in[4])
#define P_WIN      (args.in[5])
#define P_CONVW    (args.in[6])
#define P_ALOG     (args.in[7])
#define P_DTB      (args.in[8])
#define P_GGDN     (args.in[9])
#define P_GKV      (args.in[10])
#define P_WUV      (args.in[11])
#define P_RELB     (args.in[12])
#define P_WOUT     (args.in[13])
#define P_GPOST    (args.in[14])
#define P_OUT      (args.out)
#define W_MOD      ((float*)(F.ws + WS_MOD))
#define W_WUVT     ((bf16*)(F.ws + WS_WUV))
#define W_WOUTT    ((bf16*)(F.ws + WS_WOUT))
#define W_WINT     ((bf16*)(F.ws + WS_WIN))
#define W_KVSS     ((float*)(F.ws + WS_KVSS))
#define W_AUX      ((float*)(F.ws + WS_AUX))
#define W_XN       ((bf16*)(F.ws + WS_XN))
#define W_OAB      ((bf16*)(F.ws + WS_XN))
#define W_PROJ     ((bf16*)(F.ws + WS_PROJ))
#define W_MIX      ((bf16*)(F.ws + WS_PROJ))
#define W_SCR      ((float*)(F.ws + WS_SCR))
struct Args { const float* in[15]; float* out; unsigned char* ws; int ph_lo, ph_hi, li, pad; };

template <class CM>
__device__ __forceinline__ void transpose_item(const float* W, int ldw, bf16* WT, int K, int k0, int n0, LAS float* scr, int lane, CM cm) {
    const int nn = lane & 31, sc = cm(n0 + nn);
#pragma unroll 8
    for (int i = 0; i < 32; ++i) { const int kk = 2 * i + (lane >> 5); scr[kk * 33 + nn] = sc >= 0 ? __builtin_nontemporal_load(W + (size_t)(k0 + kk) * ldw + sc) : 0.f; }
    LDS_WAIT(); asm volatile("" ::: "memory");
    const int c = lane & 7;
#pragma unroll
    for (int j = 0; j < 4; ++j) { const int n = (lane >> 3) + 8 * j; const LAS float* s = scr + (8 * c) * 33 + n;
        v4u o; o.x = pk2(s[0 * 33], s[1 * 33]); o.y = pk2(s[2 * 33], s[3 * 33]); o.z = pk2(s[4 * 33], s[5 * 33]); o.w = pk2(s[6 * 33], s[7 * 33]);
        *(GAS v4u*)(WT + (size_t)(n0 + n) * K + k0 + 8 * c) = o; }
    LDS_WAIT(); asm volatile("" ::: "memory");
}
struct CmIdent { __device__ __forceinline__ int operator()(int n) const { return n; } };
struct CmProj { __device__ __forceinline__ int operator()(int n) const { return proj_src_col(n); } };

__device__ __forceinline__ void p0_prologue(Frame& F, const Args& args) {
    LAS float* scr = (LAS float*)(F.lds + F.wave * 16384);
    const int gw = F.vcu * NWAVES + F.wave, NGW = F.G * NWAVES;
    constexpr int I_IN = 16 * (NPROJ / 32), I_OUT = 16 * 32, I_UV = 4 * 2 * 4;
    for (int it = gw; it < I_IN + I_OUT + I_UV; it += NGW) {
        int r = it;
        if (r < I_IN) { const int kb = r / (NPROJ / 32), nb = r % (NPROJ / 32); transpose_item(P_WIN, 3792, W_WINT, 1024, 64 * kb, 32 * nb, scr, F.lane, CmProj()); continue; }
        r -= I_IN;
        if (r < I_OUT) { const int kb = r / 32, nb = r % 32; transpose_item(P_WOUT, 1024, W_WOUTT, 1024, 64 * kb, 32 * nb, scr, F.lane, CmIdent()); continue; }
        r -= I_OUT;
        { const int hd = r >> 3, kb = (r >> 2) & 1, nb = r & 3; transpose_item(P_WUV + (size_t)hd * 16384, 128, W_WUVT + (size_t)hd * 16384, 128, 64 * kb, 32 * nb, scr, F.lane, CmIdent()); }
    }
    __syncthreads();
    if (F.vcu < 192) {
        LAS float* SC = (LAS float*)F.lds;
        for (int e = F.tid; e < NB * 1024; e += NWAVES * 64) { const int b = e >> 10, k = e & 1023; SC[k * 33 + b] = siluf(P_C[e]); }
        __syncthreads();
        const int col = F.tid & 15, ks = F.tid >> 4, n = F.vcu * 16 + col;
        float acc[32];
#pragma unroll
        for (int b = 0; b < 32; ++b) acc[b] = 0.f;
        for (int kk = 0; kk < 32; ++kk) { const int k = ks * 32 + kk; const float w = __builtin_nontemporal_load(P_WADA + (size_t)k * 3072 + n);
#pragma unroll
            for (int b = 0; b < 32; ++b) acc[b] += SC[k * 33 + b] * w; }
        __syncthreads();
        LAS float* RED = (LAS float*)F.lds;
#pragma unroll
        for (int b = 0; b < 32; ++b) RED[(ks * 32 + b) * 16 + col] = acc[b];
        __syncthreads();
        { const int b = F.tid >> 4; float s = 0.f;
            for (int k2 = 0; k2 < 32; ++k2) s += RED[(k2 * 32 + b) * 16 + col];
            W_MOD[b * 3072 + n] = s + P_BADA[n]; }
        __syncthreads();
    }
}

__device__ __forceinline__ void p1_norm(Frame& F, const Args& args) {
    const int gw = F.vcu * NWAVES + F.wave, NGW = F.G * NWAVES;
    for (int m = 2 * gw; m < MROWS; m += 2 * NGW) {
        const int b = m >> 11;
        const GAS f32x4* xr = (const GAS f32x4*)(P_X + (size_t)m * DM) + F.lane;
        f32x4 v[2][4]; float ss[2] = {0.f, 0.f};
#pragma unroll
        for (int q = 0; q < 2; ++q)
#pragma unroll
            for (int j = 0; j < 4; ++j) v[q][j] = __builtin_nontemporal_load(xr + q * 256 + 64 * j);
#pragma unroll
        for (int q = 0; q < 2; ++q)
#pragma unroll
            for (int j = 0; j < 4; ++j) ss[q] += (v[q][j].x * v[q][j].x + v[q][j].y * v[q][j].y) + (v[q][j].z * v[q][j].z + v[q][j].w * v[q][j].w);
        const float rstd0 = rsqf_(wave_sum(ss[0]) * (1.0f / DM) + EPSF), rstd1 = rsqf_(wave_sum(ss[1]) * (1.0f / DM) + EPSF);
        const float* mb = W_MOD + b * 3072;
        GAS unsigned long long* o8 = (GAS unsigned long long*)(W_XN + (size_t)m * DM) + F.lane;
#pragma unroll
        for (int j = 0; j < 4; ++j) { const int col = F.lane * 4 + 256 * j;
            const f32x4 g = *(const f32x4*)(P_GPRE + col), sh = *(const f32x4*)(mb + col), sc = *(const f32x4*)(mb + 1024 + col);
            const f32x4 gs = g * (sc + 1.0f);
            const f32x4 o0 = v[0][j] * rstd0 * gs + sh, o1 = v[1][j] * rstd1 * gs + sh;
            o8[64 * j] = (unsigned long long)pg8::cvt_pk_bf16(o0.x, o0.y) | ((unsigned long long)pg8::cvt_pk_bf16(o0.z, o0.w) << 32);
            o8[256 + 64 * j] = (unsigned long long)pg8::cvt_pk_bf16(o1.x, o1.y) | ((unsigned long long)pg8::cvt_pk_bf16(o1.z, o1.w) << 32); }
    }
}

__device__ __forceinline__ void p5_final(Frame& F, const Args& args) {
    const int gw = F.vcu * NWAVES + F.wave, NGW = F.G * NWAVES;
    for (int m = 2 * gw; m < MROWS; m += 2 * NGW) {
        const int b = m >> 11;
        const GAS v2u* mr = (const GAS v2u*)(W_MIX + (size_t)m * DM) + F.lane;
        const GAS f32x4* xr = (const GAS f32x4*)(P_X + (size_t)m * DM) + F.lane;
        GAS f32x4* orow = (GAS f32x4*)(P_OUT + (size_t)m * DM) + F.lane;
        v2u w[2][4]; f32x4 xv[2][4];
#pragma unroll
        for (int q = 0; q < 2; ++q)
#pragma unroll
            for (int j = 0; j < 4; ++j) { w[q][j] = mr[q * 256 + 64 * j]; xv[q][j] = __builtin_nontemporal_load(xr + q * 256 + 64 * j); }
        f32x4 v[2][4]; float ss[2] = {0.f, 0.f};
#pragma unroll
        for (int q = 0; q < 2; ++q)
#pragma unroll
            for (int j = 0; j < 4; ++j) { v[q][j].x = bflo(w[q][j].x); v[q][j].y = bfhi(w[q][j].x); v[q][j].z = bflo(w[q][j].y); v[q][j].w = bfhi(w[q][j].y);
                ss[q] += (v[q][j].x * v[q][j].x + v[q][j].y * v[q][j].y) + (v[q][j].z * v[q][j].z + v[q][j].w * v[q][j].w); }
        const float rstd0 = rsqf_(wave_sum(ss[0]) * (1.0f / DM) + EPSF), rstd1 = rsqf_(wave_sum(ss[1]) * (1.0f / DM) + EPSF);
        const float* gt = W_MOD + b * 3072 + 2048;
#pragma unroll
        for (int j = 0; j < 4; ++j) { const int col = F.lane * 4 + 256 * j;
            const f32x4 g = *(const f32x4*)(P_GPOST + col), ga = *(const f32x4*)(gt + col);
            const f32x4 gg = g * ga;
            __builtin_nontemporal_store(xv[0][j] + gg * (v[0][j] * rstd0), orow + 64 * j);
            __builtin_nontemporal_store(xv[1][j] + gg * (v[1][j] * rstd1), orow + 256 + 64 * j); }
    }
}

__device__ __forceinline__ unsigned cvtpk(float lo, float hi) { return pg8::cvt_pk_bf16(lo, hi); }
__device__ __forceinline__ v2u pack4(float a, float b, float c, float d) { v2u r; r.x = cvtpk(a, b); r.y = cvtpk(c, d); return r; }
__device__ __forceinline__ bf16x8 pack8(float a, float b, float c, float d, float e, float f, float g, float h) { v4u r; r.x = cvtpk(a, b); r.y = cvtpk(c, d); r.z = cvtpk(e, f); r.w = cvtpk(g, h); return __builtin_bit_cast(bf16x8, r); }
__device__ __forceinline__ bf16x8 lds16(const LAS unsigned char* p) { return *(const LAS bf16x8*)p; }
__device__ __forceinline__ bf16x8 lds8x2(const LAS unsigned char* p) { const v2u lo = *(const LAS v2u*)p, hi = *(const LAS v2u*)(p + 16); v4u r; r.x = lo.x; r.y = lo.y; r.z = hi.x; r.w = hi.y; return __builtin_bit_cast(bf16x8, r); }
template <int S> __device__ __forceinline__ bf16x8 acc_frag(const f32x16& a) { return pack8(a[8 * S + 0], a[8 * S + 1], a[8 * S + 2], a[8 * S + 3], a[8 * S + 4], a[8 * S + 5], a[8 * S + 6], a[8 * S + 7]); }

__device__ __forceinline__ float row16_sum(float v) {
#define R16_STEP(ctrl) v += __builtin_bit_cast(float, __builtin_amdgcn_update_dpp(0, __builtin_bit_cast(int, v), ctrl, 0xf, 0xf, false))
    R16_STEP(0x121); R16_STEP(0x122); R16_STEP(0x124); R16_STEP(0x128);
#undef R16_STEP
    return v;
}

__device__ __forceinline__ void gdn_unit(Frame& F, const Args& args, const int b, const int h) {
    LAS unsigned char* const L = F.lds;
    const int tid = F.tid, lane = F.lane, wv = F.wave, l31_0 = lane & 31, hh_0 = lane >> 5;
    int tidv = tid, lanev = lane;
    constexpr int P128 = 272, P64 = 144;
    constexpr int O_KH = 0, O_QH = O_KH + 17408, O_KGT = O_QH + 17408, O_VBT = O_KGT + 18432, O_KBGT = O_VBT + 18432, O_LM = O_KBGT + 18432, O_T = O_LM + 17408,
                  O_AT = O_T + 17408, O_CW = O_AT + 9216, O_SM = O_CW + 6144, O_PSO = O_SM + 2560, O_OF = O_PSO + 2048, O_END = O_OF + 17408;
    static_assert(O_END <= SCRATCH_BYTES, "gdn LDS map");
    constexpr int O_W = O_LM, O_VNT = O_VBT;
    LAS float* const SMb = (LAS float*)(L + O_SM);
    LAS float* const LM = (LAS float*)(L + O_LM);
    LAS float* const TT = (LAS float*)(L + O_T);
    LAS float* const CW = (LAS float*)(L + O_CW);
    LAS float* const PSO = (LAS float*)(L + O_PSO);
    const int mt = wv >> 2, nt = wv & 3;
    f32x16 S[4];
#pragma unroll
    for (int k = 0; k < 4; ++k)
#pragma unroll
        for (int r = 0; r < 16; ++r) S[k][r] = 0.f;
    const float alog_e = __expf(P_ALOG[h]), dtb = P_DTB[h];
#define GDN_GATES(n_) do { LAS float* _sm = SMb + ((n_) & 1) * 320; const float* _ap = W_AUX + (size_t)(b * SEQ + (n_) * 64 + lanev) * 16; \
        const float _bb = _ap[h], _aa = _ap[4 + h]; const float _beta = rcpf_(1.0f + __expf(-_bb)); const float _xs = _aa + dtb; \
        const float _sp = _xs > 20.f ? _xs : log1pf(__expf(_xs)); float _gc = -alog_e * _sp; \
        _Pragma("unroll") for (int _o = 1; _o < 64; _o <<= 1) { const float _t = __shfl_up(_gc, _o); if (lanev >= _o) _gc += _t; } \
        const float _gl = __shfl(_gc, 63); _sm[lanev] = _gc; _sm[64 + lanev] = _beta; _sm[128 + lanev] = __expf(_gc); _sm[192 + lanev] = __expf(_gl - _gc); \
        if (lanev == 0) _sm[256] = __expf(_gl); } while (0)
    if (wv == 6) GDN_GATES(0);
    for (int e = tidv; e < 3 * 4 * 128; e += NWAVES * 64) { const int ts_ = e >> 9, tap = (e >> 7) & 3, ch = e & 127; CW[e] = P_CONVW[tap * 1536 + ts_ * 512 + h * 128 + ch]; }
    const int ts = tid >> 8;
    int cgv = tid & 15, tpv = (tid >> 4) & 15;
#define GDN_ROWS(dst_, n_, chan_) do { const bf16* _src = W_PROJ + (size_t)(b * SEQ + (n_) * 64 + 4 * tpv - 3) * NPROJ + (chan_); \
        _Pragma("unroll") for (int _i = 0; _i < 7; ++_i) { v4u _z; _z.x = 0u; _z.y = 0u; _z.z = 0u; _z.w = 0u; dst_[_i] = _z; \
            if ((n_) > 0 || 4 * tpv - 3 + _i >= 0) dst_[_i] = *(const GAS v4u*)(_src + (size_t)_i * NPROJ); } } while (0)
#define GDN_OUT(rowb_) do { const int _tok = tidv >> 3, _dv0 = (tidv & 7) * 16; const size_t _row = (size_t)(rowb_) + _tok; \
        const LAS v4u* _op = (const LAS v4u*)(L + O_OF + _tok * P128 + _dv0 * 2); const v4u _o0 = _op[0], _o1 = _op[1]; \
        const LAS f32x4* _pp = (const LAS f32x4*)(PSO + _tok * 8); const f32x4 _a = _pp[0], _c = _pp[1]; \
        const float _rstd = rsqf_((((_a.x + _a.y) + (_a.z + _a.w)) + ((_c.x + _c.y) + (_c.z + _c.w))) * (1.0f / 128.0f) + EPSF); \
        const bf16* _zp = W_PROJ + _row * NPROJ + C_ZA + h * 128 + _dv0; const v4u _z0 = *(const GAS v4u*)_zp, _z1 = *(const GAS v4u*)(_zp + 8); \
        const unsigned _ow[8] = {_o0.x, _o0.y, _o0.z, _o0.w, _o1.x, _o1.y, _o1.z, _o1.w}, _zw[8] = {_z0.x, _z0.y, _z0.z, _z0.w, _z1.x, _z1.y, _z1.z, _z1.w}; unsigned _rw[8]; \
        _Pragma("unroll") for (int _k = 0; _k < 4; ++_k) { const f32x4 _g = *(const f32x4*)(P_GGDN + _dv0 + 4 * _k); \
            _rw[2 * _k] = cvtpk(bflo(_ow[2 * _k]) * _rstd * _g.x * siluf(bflo(_zw[2 * _k])), bfhi(_ow[2 * _k]) * _rstd * _g.y * siluf(bfhi(_zw[2 * _k]))); \
            _rw[2 * _k + 1] = cvtpk(bflo(_ow[2 * _k + 1]) * _rstd * _g.z * siluf(bflo(_zw[2 * _k + 1])), bfhi(_ow[2 * _k + 1]) * _rstd * _g.w * siluf(bfhi(_zw[2 * _k + 1]))); } \
        bf16* _dst = W_OAB + _row * DM + h * 128 + _dv0; v4u _w0, _w1; _w0.x = _rw[0]; _w0.y = _rw[1]; _w0.z = _rw[2]; _w0.w = _rw[3]; _w1.x = _rw[4]; _w1.y = _rw[5]; _w1.z = _rw[6]; _w1.w = _rw[7]; \
        *(GAS v4u*)_dst = _w0; *(GAS v4u*)(_dst + 8) = _w1; } while (0)
    __syncthreads();

    unsigned pf_sink = 0u;
    for (int n = 0; n < 32; ++n) {
        const int rowbase = b * SEQ + n * 64;
        LAS float* const SMf = SMb + (n & 1) * 320;
        tidv = tid; lanev = lane; cgv = tid & 15; tpv = (tid >> 4) & 15;
        asm volatile("" : "+v"(tidv), "+v"(lanev), "+v"(cgv), "+v"(tpv));
        int l31 = lanev & 31, hh = lanev >> 5, cg = cgv, tp = tpv;
        if (wv == 6 && n + 1 < 32) GDN_GATES(n + 1);
        float val[4][8];
#define GDN_CONV(rows_, tsel_) do { \
            _Pragma("unroll") for (int _j = 0; _j < 4; ++_j) _Pragma("unroll") for (int _e = 0; _e < 8; ++_e) val[_j][_e] = 0.f; \
            _Pragma("unroll") for (int _tap = 0; _tap < 4; ++_tap) { const LAS f32x4* _cp = (const LAS f32x4*)(CW + ((tsel_) * 4 + _tap) * 128 + cg * 8); const f32x4 _c0 = _cp[0], _c1 = _cp[1]; \
                const float _cw[8] = {_c0.x, _c0.y, _c0.z, _c0.w, _c1.x, _c1.y, _c1.z, _c1.w}; \
                _Pragma("unroll") for (int _j = 0; _j < 4; ++_j) { const v4u _raw = rows_[_j + _tap]; \
                    const float _in[8] = {bflo(_raw.x), bfhi(_raw.x), bflo(_raw.y), bfhi(_raw.y), bflo(_raw.z), bfhi(_raw.z), bflo(_raw.w), bfhi(_raw.w)}; \
                    _Pragma("unroll") for (int _e = 0; _e < 8; ++_e) val[_j][_e] += _in[_e] * _cw[_e]; } } \
            _Pragma("unroll") for (int _j = 0; _j < 4; ++_j) _Pragma("unroll") for (int _e = 0; _e < 8; ++_e) val[_j][_e] = siluf(val[_j][_e]); } while (0)
        v4u rq[7], rv[7];
        GDN_ROWS(rq, n, ts * 512 + h * 128 + cgv * 8);
        if (wv < 4) GDN_ROWS(rv, n, 1024 + h * 128 + cgv * 8);
        if (wv == 7 && n + 1 < 32) {
#pragma unroll
            for (int i = 0; i < 9; ++i) { const int idx = i * 64 + lanev; const int rr = idx >> 3, ln = idx & 7;
                if (idx < 67 * 8) { const bf16* pt = W_PROJ + (size_t)(rowbase + 61 + rr) * NPROJ + (ln >> 1) * 512 + h * 128 + (ln & 1) * 64;
                    asm volatile("global_load_dword %0, %1, off" : "+v"(pf_sink) : "v"(pt) : "memory"); } }
        }
        {
            GDN_CONV(rq, ts);
#pragma unroll
            for (int j = 0; j < 4; ++j) { float ss = 0.f;
#pragma unroll
                for (int e = 0; e < 8; ++e) ss += val[j][e] * val[j][e];
                ss = row16_sum(ss);
                float r = rsqf_(ss + EPSF); if (ts == 0) r *= 0.08838834764831845f;
#pragma unroll
                for (int e = 0; e < 8; ++e) val[j][e] *= r; }
            if (ts == 0) {
#pragma unroll
                for (int j = 0; j < 4; ++j) *(LAS bf16x8*)(L + O_QH + (4 * tp + j) * P128 + cg * 16) = pack8(val[j][0], val[j][1], val[j][2], val[j][3], val[j][4], val[j][5], val[j][6], val[j][7]);
            } else {
                float ek[4], bg[4];
#pragma unroll
                for (int j = 0; j < 4; ++j) { ek[j] = SMf[192 + 4 * tp + j]; bg[j] = SMf[64 + 4 * tp + j] * SMf[128 + 4 * tp + j]; }
#pragma unroll
                for (int j = 0; j < 4; ++j) *(LAS bf16x8*)(L + O_KH + (4 * tp + j) * P128 + cg * 16) = pack8(val[j][0], val[j][1], val[j][2], val[j][3], val[j][4], val[j][5], val[j][6], val[j][7]);
#pragma unroll
                for (int e = 0; e < 8; ++e) {
                    *(LAS v2u*)(L + O_KGT + (cg * 8 + e) * P64 + tp * 8) = pack4(val[0][e] * ek[0], val[1][e] * ek[1], val[2][e] * ek[2], val[3][e] * ek[3]);
                    *(LAS v2u*)(L + O_KBGT + (cg * 8 + e) * P64 + tp * 8) = pack4(val[0][e] * bg[0], val[1][e] * bg[1], val[2][e] * bg[2], val[3][e] * bg[3]); }
            }
        }
        if (n > 0) GDN_OUT(rowbase - 64);
        if (wv < 4) {
            GDN_CONV(rv, 2);
            float be[4];
#pragma unroll
            for (int j = 0; j < 4; ++j) be[j] = SMf[64 + 4 * tp + j];
#pragma unroll
            for (int e = 0; e < 8; ++e) *(LAS v2u*)(L + O_VBT + (cg * 8 + e) * P64 + tp * 8) = pack4(val[0][e] * be[0], val[1][e] * be[1], val[2][e] * be[2], val[3][e] * be[3]);
        }
        for (int e = tidv; e < 64 * 68; e += NWAVES * 64) TT[e] = 0.f;
        __syncthreads();
        if (wv < 4) {
            const int ti = wv >> 1, tj = wv & 1;
            f32x16 C;
#pragma unroll
            for (int r = 0; r < 16; ++r) C[r] = 0.f;
            if (ti >= tj) {
                bf16x8 fa[8], fb[8];
#pragma unroll
                for (int s = 0; s < 8; ++s) { fa[s] = lds16(L + O_KH + (32 * ti + l31) * P128 + (16 * s + 8 * hh) * 2); fb[s] = lds16(L + O_KH + (32 * tj + l31) * P128 + (16 * s + 8 * hh) * 2); }
                __builtin_amdgcn_sched_barrier(0);
#pragma unroll
                for (int s = 0; s < 8; ++s) C = MFMA32(fa[s], fb[s], C);
            }
            const int j = 32 * tj + l31; const float gcj = SMf[j];
#pragma unroll
            for (int g = 0; g < 4; ++g) { const int ib = 32 * ti + 8 * g + 4 * hh; const f32x4 gci = *(const LAS f32x4*)(SMf + ib), bei = *(const LAS f32x4*)(SMf + 64 + ib);
#pragma unroll
                for (int e = 0; e < 4; ++e) { const int i = ib + e; LM[i * 68 + j] = (i > j) ? bei[e] * C[4 * g + e] * __expf(gci[e] - gcj) : 0.f; } }
            if (ti == tj) {
                asm volatile("s_waitcnt lgkmcnt(0)" ::: "memory");
                const int a = 2 * ti, bq = 2 * ti + 1;
                if (lanev < 32) {
                    const int blk = a + (lanev >> 4), c = lanev & 15; float x[16];
    #pragma unroll
                    for (int i = 0; i < 16; ++i) { const LAS float* lr = LM + (16 * blk + i) * 68 + 16 * blk; float acc = (i == c) ? 1.f : 0.f;
    #pragma unroll
                        for (int j = 0; j < i; ++j) acc -= lr[j] * x[j];
                        x[i] = acc; TT[(16 * blk + i) * 68 + 16 * blk + c] = acc; }
                }
                asm volatile("s_waitcnt lgkmcnt(0)" ::: "memory");
                const int m = lanev & 15, q = lanev >> 4;
                f32x4 P = {0.f, 0.f, 0.f, 0.f}, R = {0.f, 0.f, 0.f, 0.f};
    #pragma unroll
                for (int s = 0; s < 4; ++s) { const int k = q + 4 * s; P = MFMA16F(LM[(16 * bq + m) * 68 + 16 * a + k], TT[(16 * a + k) * 68 + 16 * a + m], P); }
    #pragma unroll
                for (int rg = 0; rg < 4; ++rg) { const int k = 4 * q + rg; R = MFMA16F(TT[(16 * bq + m) * 68 + 16 * bq + k], P[rg], R); }
    #pragma unroll
                for (int rg = 0; rg < 4; ++rg) TT[(16 * bq + 4 * q + rg) * 68 + 16 * a + m] = -R[rg];
            }
        } else {
            const int w4 = wv - 4, tj = w4 >> 1, ti = w4 & 1;
            f32x16 C;
#pragma unroll
            for (int r = 0; r < 16; ++r) C[r] = 0.f;
            if (ti >= tj) {
                bf16x8 fa[8], fb[8];
#pragma unroll
                for (int s = 0; s < 8; ++s) { fa[s] = lds16(L + O_KH + (32 * tj + l31) * P128 + (16 * s + 8 * hh) * 2); fb[s] = lds16(L + O_QH + (32 * ti + l31) * P128 + (16 * s + 8 * hh) * 2); }
                __builtin_amdgcn_sched_barrier(0);
#pragma unroll
                for (int s = 0; s < 8; ++s) C = MFMA32(fa[s], fb[s], C);
            }
            const int i = 32 * ti + l31; const float gci = SMf[i];
#pragma unroll
            for (int g = 0; g < 4; ++g) { const int jb = 32 * tj + 8 * g + 4 * hh; const f32x4 gcj = *(const LAS f32x4*)(SMf + jb); float v[4];
#pragma unroll
                for (int e = 0; e < 4; ++e) v[e] = (i >= jb + e) ? C[4 * g + e] * __expf(gci - gcj[e]) : 0.f;
                *(LAS v2u*)(L + O_AT + i * P64 + jb * 2) = pack4(v[0], v[1], v[2], v[3]); }
        }
        __syncthreads();
        if (wv < 4) {
            const int m = lanev & 15, q = lanev >> 4, mi = wv >> 1, ni = wv & 1;
            f32x4 P0 = {0.f, 0.f, 0.f, 0.f}, P1 = {0.f, 0.f, 0.f, 0.f}, R = {0.f, 0.f, 0.f, 0.f};
            float bt[8], l0[8], l1[8], t0[4], t1[4];
#pragma unroll
            for (int s = 0; s < 8; ++s) { const int k = q + 4 * s; bt[s] = TT[k * 68 + 16 * ni + m]; l0[s] = LM[(32 + m) * 68 + k]; l1[s] = LM[(48 + m) * 68 + k]; }
#pragma unroll
            for (int rg = 0; rg < 4; ++rg) { t0[rg] = TT[(32 + 16 * mi + m) * 68 + 32 + 4 * q + rg]; t1[rg] = TT[(32 + 16 * mi + m) * 68 + 48 + 4 * q + rg]; }
            __builtin_amdgcn_sched_barrier(0);
#pragma unroll
            for (int s = 0; s < 8; ++s) { P0 = MFMA16F(l0[s], bt[s], P0); P1 = MFMA16F(l1[s], bt[s], P1); }
#pragma unroll
            for (int rg = 0; rg < 4; ++rg) { R = MFMA16F(t0[rg], P0[rg], R); R = MFMA16F(t1[rg], P1[rg], R); }
#pragma unroll
            for (int rg = 0; rg < 4; ++rg) TT[(32 + 16 * mi + 4 * q + rg) * 68 + 16 * ni + m] = -R[rg];
        }
        __syncthreads();
        f32x16 U, WT_;
#pragma unroll
        for (int r = 0; r < 16; ++r) { U[r] = 0.f; WT_[r] = 0.f; }
        {
            f32x4 tq0[4], tq1[4]; bf16x8 fv[4], fk[4];
#pragma unroll
            for (int s = 0; s < 4; ++s) { const LAS f32x4* tp4 = (const LAS f32x4*)(TT + (32 * mt + l31) * 68 + 16 * s + 8 * hh); tq0[s] = tp4[0]; tq1[s] = tp4[1];
                fv[s] = lds16(L + O_VBT + (32 * nt + l31) * P64 + (16 * s + 8 * hh) * 2); fk[s] = lds16(L + O_KBGT + (32 * nt + l31) * P64 + (16 * s + 8 * hh) * 2); }
            __builtin_amdgcn_sched_barrier(0);
#pragma unroll
            for (int s = 0; s < 4; ++s) { const bf16x8 a = pack8(tq0[s].x, tq0[s].y, tq0[s].z, tq0[s].w, tq1[s].x, tq1[s].y, tq1[s].z, tq1[s].w);
                U = MFMA32(a, fv[s], U); WT_ = MFMA32(fk[s], a, WT_); }
        }
#pragma unroll
        for (int g = 0; g < 4; ++g) *(LAS v2u*)(L + O_W + (32 * mt + l31) * P128 + (32 * nt + 8 * g + 4 * hh) * 2) = pack4(-WT_[4 * g], -WT_[4 * g + 1], -WT_[4 * g + 2], -WT_[4 * g + 3]);
        __syncthreads();
        bf16x8 sf[4][2];
#pragma unroll
        for (int kt = 0; kt < 4; ++kt) { sf[kt][0] = acc_frag<0>(S[kt]); sf[kt][1] = acc_frag<1>(S[kt]); }
        {
            bf16x8 fw[4][2];
#pragma unroll
            for (int kt = 0; kt < 4; ++kt)
#pragma unroll
                for (int s = 0; s < 2; ++s) fw[kt][s] = lds8x2(L + O_W + (32 * mt + l31) * P128 + (32 * kt + 16 * s + 4 * hh) * 2);
            __builtin_amdgcn_sched_barrier(0);
#pragma unroll
            for (int kt = 0; kt < 4; ++kt)
#pragma unroll
                for (int s = 0; s < 2; ++s) U = MFMA32(fw[kt][s], sf[kt][s], U);
        }
#pragma unroll
        for (int g = 0; g < 4; ++g) *(LAS v2u*)(L + O_VNT + (32 * nt + l31) * P64 + (32 * mt + 8 * g + 4 * hh) * 2) = pack4(U[4 * g], U[4 * g + 1], U[4 * g + 2], U[4 * g + 3]);
        __syncthreads();
        {
            f32x16 Oa;
#pragma unroll
            for (int r = 0; r < 16; ++r) Oa[r] = 0.f;
            bf16x8 vn[4], fat[4], fg[4]; f32x4 e4[4];
            {
                bf16x8 fq[4][2];
#pragma unroll
                for (int kt = 0; kt < 4; ++kt)
#pragma unroll
                    for (int s = 0; s < 2; ++s) fq[kt][s] = lds8x2(L + O_QH + (32 * mt + l31) * P128 + (32 * kt + 16 * s + 4 * hh) * 2);
                __builtin_amdgcn_sched_barrier(0);
#pragma unroll
                for (int kt = 0; kt < 4; ++kt)
#pragma unroll
                    for (int s = 0; s < 2; ++s) Oa = MFMA32(fq[kt][s], sf[kt][s], Oa);
            }
#pragma unroll
            for (int g = 0; g < 4; ++g) e4[g] = *(const LAS f32x4*)(SMf + 128 + 32 * mt + 8 * g + 4 * hh);
#pragma unroll
            for (int s = 0; s < 4; ++s) { vn[s] = lds16(L + O_VNT + (32 * nt + l31) * P64 + (16 * s + 8 * hh) * 2); fat[s] = lds16(L + O_AT + (32 * mt + l31) * P64 + (16 * s + 8 * hh) * 2); }
            const float glast = SMf[256];
#pragma unroll
            for (int s = 0; s < 4; ++s) fg[s] = lds16(L + O_KGT + l31 * P64 + (16 * s + 8 * hh) * 2);
            __builtin_amdgcn_sched_barrier(0);
#pragma unroll
            for (int g = 0; g < 4; ++g)
#pragma unroll
                for (int e = 0; e < 4; ++e) Oa[4 * g + e] *= e4[g][e];
#pragma unroll
            for (int s = 0; s < 4; ++s) Oa = MFMA32(fat[s], vn[s], Oa);
#pragma unroll
            for (int kt = 0; kt < 4; ++kt) {
#pragma unroll
                for (int r = 0; r < 16; ++r) S[kt][r] *= glast;
#pragma unroll
                for (int s = 0; s < 4; ++s) S[kt] = MFMA32(fg[s], vn[s], S[kt]);
                if (kt < 3) {
#pragma unroll
                    for (int s = 0; s < 4; ++s) fg[s] = lds16(L + O_KGT + (32 * (kt + 1) + l31) * P64 + (16 * s + 8 * hh) * 2);
                }
            }
#pragma unroll
            for (int r = 0; r < 16; ++r) { const float q2 = row16_sum(Oa[r] * Oa[r]);
                if ((lanev & 15) == 0) PSO[(32 * mt + 8 * (r >> 2) + 4 * hh + (r & 3)) * 8 + 2 * nt + ((lanev >> 4) & 1)] = q2;
                *(LAS unsigned short*)(L + O_OF + (32 * mt + 8 * (r >> 2) + 4 * hh + (r & 3)) * P128 + (32 * nt + l31) * 2) = (unsigned short)cvtpk(Oa[r], 0.f); }
        }
        asm volatile("s_waitcnt vmcnt(0)" : "+v"(pf_sink) :: "memory");
        __syncthreads();
    }
    GDN_OUT(b * SEQ + 31 * 64);
    __syncthreads();
#undef GDN_GATES
#undef GDN_CONV
#undef GDN_ROWS
#undef GDN_OUT
}

typedef short s16x4 __attribute__((ext_vector_type(4)));
__device__ __forceinline__ bf16x8 ldstr8(const LAS unsigned char* p0, const LAS unsigned char* p1) {
    const s16x4 a = __builtin_amdgcn_ds_read_tr16_b64_v4i16((LAS s16x4*)p0), b = __builtin_amdgcn_ds_read_tr16_b64_v4i16((LAS s16x4*)p1);
    bf16x8 r; r[0] = a[0]; r[1] = a[1]; r[2] = a[2]; r[3] = a[3]; r[4] = b[0]; r[5] = b[1]; r[6] = b[2]; r[7] = b[3]; return r;
}
__device__ __forceinline__ void wrlane(unsigned& dst, const unsigned val, const int idx) {
    switch (idx) {
    case 0: asm("s_nop 1\n\tv_writelane_b32 %0, %1, 0" : "+v"(dst) : "s"(val)); break;
    case 1: asm("s_nop 1\n\tv_writelane_b32 %0, %1, 1" : "+v"(dst) : "s"(val)); break;
    case 2: asm("s_nop 1\n\tv_writelane_b32 %0, %1, 2" : "+v"(dst) : "s"(val)); break;
    case 3: asm("s_nop 1\n\tv_writelane_b32 %0, %1, 3" : "+v"(dst) : "s"(val)); break;
    case 4: asm("s_nop 1\n\tv_writelane_b32 %0, %1, 4" : "+v"(dst) : "s"(val)); break;
    case 5: asm("s_nop 1\n\tv_writelane_b32 %0, %1, 5" : "+v"(dst) : "s"(val)); break;
    case 6: asm("s_nop 1\n\tv_writelane_b32 %0, %1, 6" : "+v"(dst) : "s"(val)); break;
    case 7: asm("s_nop 1\n\tv_writelane_b32 %0, %1, 7" : "+v"(dst) : "s"(val)); break;
    case 8: asm("s_nop 1\n\tv_writelane_b32 %0, %1, 8" : "+v"(dst) : "s"(val)); break;
    case 9: asm("s_nop 1\n\tv_writelane_b32 %0, %1, 9" : "+v"(dst) : "s"(val)); break;
    case 10: asm("s_nop 1\n\tv_writelane_b32 %0, %1, 10" : "+v"(dst) : "s"(val)); break;
    case 11: asm("s_nop 1\n\tv_writelane_b32 %0, %1, 11" : "+v"(dst) : "s"(val)); break;
    case 12: asm("s_nop 1\n\tv_writelane_b32 %0, %1, 12" : "+v"(dst) : "s"(val)); break;
    case 13: asm("s_nop 1\n\tv_writelane_b32 %0, %1, 13" : "+v"(dst) : "s"(val)); break;
    case 14: asm("s_nop 1\n\tv_writelane_b32 %0, %1, 14" : "+v"(dst) : "s"(val)); break;
    case 15: asm("s_nop 1\n\tv_writelane_b32 %0, %1, 15" : "+v"(dst) : "s"(val)); break;
    case 16: asm("s_nop 1\n\tv_writelane_b32 %0, %1, 16" : "+v"(dst) : "s"(val)); break;
    case 17: asm("s_nop 1\n\tv_writelane_b32 %0, %1, 17" : "+v"(dst) : "s"(val)); break;
    case 18: asm("s_nop 1\n\tv_writelane_b32 %0, %1, 18" : "+v"(dst) : "s"(val)); break;
    case 19: asm("s_nop 1\n\tv_writelane_b32 %0, %1, 19" : "+v"(dst) : "s"(val)); break;
    case 20: asm("s_nop 1\n\tv_writelane_b32 %0, %1, 20" : "+v"(dst) : "s"(val)); break;
    case 21: asm("s_nop 1\n\tv_writelane_b32 %0, %1, 21" : "+v"(dst) : "s"(val)); break;
    case 22: asm("s_nop 1\n\tv_writelane_b32 %0, %1, 22" : "+v"(dst) : "s"(val)); break;
    case 23: asm("s_nop 1\n\tv_writelane_b32 %0, %1, 23" : "+v"(dst) : "s"(val)); break;
    case 24: asm("s_nop 1\n\tv_writelane_b32 %0, %1, 24" : "+v"(dst) : "s"(val)); break;
    case 25: asm("s_nop 1\n\tv_writelane_b32 %0, %1, 25" : "+v"(dst) : "s"(val)); break;
    case 26: asm("s_nop 1\n\tv_writelane_b32 %0, %1, 26" : "+v"(dst) : "s"(val)); break;
    case 27: asm("s_nop 1\n\tv_writelane_b32 %0, %1, 27" : "+v"(dst) : "s"(val)); break;
    case 28: asm("s_nop 1\n\tv_writelane_b32 %0, %1, 28" : "+v"(dst) : "s"(val)); break;
    case 29: asm("s_nop 1\n\tv_writelane_b32 %0, %1, 29" : "+v"(dst) : "s"(val)); break;
    case 30: asm("s_nop 1\n\tv_writelane_b32 %0, %1, 30" : "+v"(dst) : "s"(val)); break;
    case 31: asm("s_nop 1\n\tv_writelane_b32 %0, %1, 31" : "+v"(dst) : "s"(val)); break;
    default: break;
    }
}
__device__ __forceinline__ void ballot4(unsigned& mlo, unsigned& mhi, const float thr, const float x0, const float x1, const float x2, const float x3, const int base) {
    switch (base) {
    case 0: asm("v_cmp_le_f32_e64 s[90:91], %2, %3\n\tv_cmp_le_f32_e64 s[92:93], %2, %4\n\tv_cmp_le_f32_e64 s[94:95], %2, %5\n\tv_cmp_le_f32_e64 s[96:97], %2, %6\n\t"
                 "v_writelane_b32 %0, s90, 0\n\tv_writelane_b32 %1, s91, 0\n\tv_writelane_b32 %0, s92, 1\n\tv_writelane_b32 %1, s93, 1\n\tv_writelane_b32 %0, s94, 2\n\tv_writelane_b32 %1, s95, 2\n\tv_writelane_b32 %0, s96, 3\n\tv_writelane_b32 %1, s97, 3"
                 : "+v"(mlo), "+v"(mhi) : "v"(thr), "v"(x0), "v"(x1), "v"(x2), "v"(x3) : "s90", "s91", "s92", "s93", "s94", "s95", "s96", "s97"); break;
    case 4: asm("v_cmp_le_f32_e64 s[90:91], %2, %3\n\tv_cmp_le_f32_e64 s[92:93], %2, %4\n\tv_cmp_le_f32_e64 s[94:95], %2, %5\n\tv_cmp_le_f32_e64 s[96:97], %2, %6\n\t"
                 "v_writelane_b32 %0, s90, 4\n\tv_writelane_b32 %1, s91, 4\n\tv_writelane_b32 %0, s92, 5\n\tv_writelane_b32 %1, s93, 5\n\tv_writelane_b32 %0, s94, 6\n\tv_writelane_b32 %1, s95, 6\n\tv_writelane_b32 %0, s96, 7\n\tv_writelane_b32 %1, s97, 7"
                 : "+v"(mlo), "+v"(mhi) : "v"(thr), "v"(x0), "v"(x1), "v"(x2), "v"(x3) : "s90", "s91", "s92", "s93", "s94", "s95", "s96", "s97"); break;
    case 8: asm("v_cmp_le_f32_e64 s[90:91], %2, %3\n\tv_cmp_le_f32_e64 s[92:93], %2, %4\n\tv_cmp_le_f32_e64 s[94:95], %2, %5\n\tv_cmp_le_f32_e64 s[96:97], %2, %6\n\t"
                 "v_writelane_b32 %0, s90, 8\n\tv_writelane_b32 %1, s91, 8\n\tv_writelane_b32 %0, s92, 9\n\tv_writelane_b32 %1, s93, 9\n\tv_writelane_b32 %0, s94, 10\n\tv_writelane_b32 %1, s95, 10\n\tv_writelane_b32 %0, s96, 11\n\tv_writelane_b32 %1, s97, 11"
                 : "+v"(mlo), "+v"(mhi) : "v"(thr), "v"(x0), "v"(x1), "v"(x2), "v"(x3) : "s90", "s91", "s92", "s93", "s94", "s95", "s96", "s97"); break;
    case 12: asm("v_cmp_le_f32_e64 s[90:91], %2, %3\n\tv_cmp_le_f32_e64 s[92:93], %2, %4\n\tv_cmp_le_f32_e64 s[94:95], %2, %5\n\tv_cmp_le_f32_e64 s[96:97], %2, %6\n\t"
                 "v_writelane_b32 %0, s90, 12\n\tv_writelane_b32 %1, s91, 12\n\tv_writelane_b32 %0, s92, 13\n\tv_writelane_b32 %1, s93, 13\n\tv_writelane_b32 %0, s94, 14\n\tv_writelane_b32 %1, s95, 14\n\tv_writelane_b32 %0, s96, 15\n\tv_writelane_b32 %1, s97, 15"
                 : "+v"(mlo), "+v"(mhi) : "v"(thr), "v"(x0), "v"(x1), "v"(x2), "v"(x3) : "s90", "s91", "s92", "s93", "s94", "s95", "s96", "s97"); break;
    case 16: asm("v_cmp_le_f32_e64 s[90:91], %2, %3\n\tv_cmp_le_f32_e64 s[92:93], %2, %4\n\tv_cmp_le_f32_e64 s[94:95], %2, %5\n\tv_cmp_le_f32_e64 s[96:97], %2, %6\n\t"
                 "v_writelane_b32 %0, s90, 16\n\tv_writelane_b32 %1, s91, 16\n\tv_writelane_b32 %0, s92, 17\n\tv_writelane_b32 %1, s93, 17\n\tv_writelane_b32 %0, s94, 18\n\tv_writelane_b32 %1, s95, 18\n\tv_writelane_b32 %0, s96, 19\n\tv_writelane_b32 %1, s97, 19"
                 : "+v"(mlo), "+v"(mhi) : "v"(thr), "v"(x0), "v"(x1), "v"(x2), "v"(x3) : "s90", "s91", "s92", "s93", "s94", "s95", "s96", "s97"); break;
    case 20: asm("v_cmp_le_f32_e64 s[90:91], %2, %3\n\tv_cmp_le_f32_e64 s[92:93], %2, %4\n\tv_cmp_le_f32_e64 s[94:95], %2, %5\n\tv_cmp_le_f32_e64 s[96:97], %2, %6\n\t"
                 "v_writelane_b32 %0, s90, 20\n\tv_writelane_b32 %1, s91, 20\n\tv_writelane_b32 %0, s92, 21\n\tv_writelane_b32 %1, s93, 21\n\tv_writelane_b32 %0, s94, 22\n\tv_writelane_b32 %1, s95, 22\n\tv_writelane_b32 %0, s96, 23\n\tv_writelane_b32 %1, s97, 23"
                 : "+v"(mlo), "+v"(mhi) : "v"(thr), "v"(x0), "v"(x1), "v"(x2), "v"(x3) : "s90", "s91", "s92", "s93", "s94", "s95", "s96", "s97"); break;
    case 24: asm("v_cmp_le_f32_e64 s[90:91], %2, %3\n\tv_cmp_le_f32_e64 s[92:93], %2, %4\n\tv_cmp_le_f32_e64 s[94:95], %2, %5\n\tv_cmp_le_f32_e64 s[96:97], %2, %6\n\t"
                 "v_writelane_b32 %0, s90, 24\n\tv_writelane_b32 %1, s91, 24\n\tv_writelane_b32 %0, s92, 25\n\tv_writelane_b32 %1, s93, 25\n\tv_writelane_b32 %0, s94, 26\n\tv_writelane_b32 %1, s95, 26\n\tv_writelane_b32 %0, s96, 27\n\tv_writelane_b32 %1, s97, 27"
                 : "+v"(mlo), "+v"(mhi) : "v"(thr), "v"(x0), "v"(x1), "v"(x2), "v"(x3) : "s90", "s91", "s92", "s93", "s94", "s95", "s96", "s97"); break;
    case 28: asm("v_cmp_le_f32_e64 s[90:91], %2, %3\n\tv_cmp_le_f32_e64 s[92:93], %2, %4\n\tv_cmp_le_f32_e64 s[94:95], %2, %5\n\tv_cmp_le_f32_e64 s[96:97], %2, %6\n\t"
                 "v_writelane_b32 %0, s90, 28\n\tv_writelane_b32 %1, s91, 28\n\tv_writelane_b32 %0, s92, 29\n\tv_writelane_b32 %1, s93, 29\n\tv_writelane_b32 %0, s94, 30\n\tv_writelane_b32 %1, s95, 30\n\tv_writelane_b32 %0, s96, 31\n\tv_writelane_b32 %1, s97, 31"
                 : "+v"(mlo), "+v"(mhi) : "v"(thr), "v"(x0), "v"(x1), "v"(x2), "v"(x3) : "s90", "s91", "s92", "s93", "s94", "s95", "s96", "s97"); break;
    default: break;
    }
}
template <int NREG>
__device__ __forceinline__ void dsa_select(const float* const scw, LAS unsigned* const MASK, LAS const float* const ZT, const int wv, const int lane, const int t0, const int nk) {
    const float NINF = -__builtin_inff(), PINF = __builtin_inff();
    const unsigned long long lt_mask = (1ull << lane) - 1ull;
    const int qb_ = t0 >> 6;
    float xn[NREG];
#pragma unroll
    for (int i = 0; i < NREG; ++i) xn[i] = __hip_atomic_load(scw + i * 64 + lane, __ATOMIC_RELAXED, __HIP_MEMORY_SCOPE_AGENT);
#pragma unroll 1
    for (int ql_ = 0; ql_ < 8; ++ql_) {
        const int ql = ql_ & 7;
        const int tq = t0 + 8 * wv + ql;
        LAS unsigned* const mrow = MASK + (8 * wv + ql) * 64;
        float x[NREG];
#pragma unroll
        for (int i = 0; i < NREG; ++i) x[i] = (i <= qb_) ? xn[i] : NINF;
        if (ql_ + 1 < 8) {
#pragma unroll
            for (int i = 0; i < NREG; ++i) xn[i] = __hip_atomic_load(scw + ((ql_ + 1) & 7) * 2048 + i * 64 + lane, __ATOMIC_RELAXED, __HIP_MEMORY_SCOPE_AGENT);
        }
        unsigned mlo = 0u, mhi = 0u;
        if (tq + 1 > 256) {
#define CNT_GE(p_, dst_) do { int _c0 = 0, _c1 = 0; const float _p = (p_); \
                _Pragma("unroll") for (int _i = 0; _i < NREG; _i += 8) \
                    asm volatile("v_cmp_le_f32_e64 s[90:91], %10, %2\n\tv_cmp_le_f32_e64 s[92:93], %10, %3\n\tv_cmp_le_f32_e64 s[94:95], %10, %4\n\tv_cmp_le_f32_e64 s[96:97], %10, %5\n\t" \
                                 "v_cmp_le_f32_e64 s[82:83], %10, %6\n\ts_bcnt1_i32_b64 s90, s[90:91]\n\ts_add_u32 %0, %0, s90\n\t" \
                                 "v_cmp_le_f32_e64 s[84:85], %10, %7\n\ts_bcnt1_i32_b64 s92, s[92:93]\n\ts_add_u32 %1, %1, s92\n\t" \
                                 "v_cmp_le_f32_e64 s[86:87], %10, %8\n\ts_bcnt1_i32_b64 s94, s[94:95]\n\ts_add_u32 %0, %0, s94\n\t" \
                                 "v_cmp_le_f32_e64 s[88:89], %10, %9\n\ts_bcnt1_i32_b64 s96, s[96:97]\n\ts_add_u32 %1, %1, s96\n\t" \
                                 "s_bcnt1_i32_b64 s82, s[82:83]\n\ts_bcnt1_i32_b64 s84, s[84:85]\n\ts_add_u32 %0, %0, s82\n\ts_bcnt1_i32_b64 s86, s[86:87]\n\ts_add_u32 %1, %1, s84\n\t" \
                                 "s_bcnt1_i32_b64 s88, s[88:89]\n\ts_add_u32 %0, %0, s86\n\ts_add_u32 %1, %1, s88" \
                                 : "+s"(_c0), "+s"(_c1) : "v"(x[_i]), "v"(x[_i + 1]), "v"(x[_i + 2]), "v"(x[_i + 3]), "v"(x[_i + 4]), "v"(x[_i + 5]), "v"(x[_i + 6]), "v"(x[_i + 7]), "s"(_p) \
                                 : "s82", "s83", "s84", "s85", "s86", "s87", "s88", "s89", "s90", "s91", "s92", "s93", "s94", "s95", "s96", "s97", "scc"); \
                dst_ = _c0 + _c1; } while (0)
            float s1 = 0.f, s2 = 0.f;
            constexpr int SS = NREG / 8;
#pragma unroll
            for (int i = 0; i < NREG; i += SS) if (i < qb_) { s1 += x[i]; s2 = fmaf(x[i], x[i], s2); }
            s1 = wave_sum_f(s1); s2 = wave_sum_f(s2);
            const float rm = rcpf_(64.0f * (float)((min(qb_, NREG) + SS - 1) / SS));
            const float mean = s1 * rm, sigma = __builtin_sqrtf(fmaxf(s2 * rm - mean * mean, 0.f));
            const float zq = ZT[2 * (8 * wv + ql)], stepc = sigma * ZT[2 * (8 * wv + ql) + 1];
            float lo = -3.0e38f, hi = PINF, thr = 0.f, vmax = 0.f; int clo = tq + 1, chi = 0; bool tie = false, lo_real = false, have_mm = false;
            float pv = mean + zq * sigma;
#pragma unroll 1
            for (int it = 1;; ++it) {
                if (!(pv > lo && pv < hi)) {
                    if (!have_mm) {
                        float vmin = PINF; vmax = NINF;
#pragma unroll
                        for (int i = 0; i < NREG; ++i) { vmax = fmaxf(vmax, x[i]); vmin = fminf(vmin, x[i] == NINF ? PINF : x[i]); }
                        vmin = -wave_max(-vmin); vmax = wave_max(vmax); have_mm = true;
                        if (!lo_real) lo = vmin;
                    }
                    pv = (hi == PINF) ? vmax : 0.5f * (lo + hi);
                    if (!(pv > lo && pv < hi)) { tie = true; break; }
                }
                int c; CNT_GE(pv, c);
                if (c == 256) { thr = pv; break; }
                if (c > 256) { lo = pv; clo = c; lo_real = true; } else { hi = pv; chi = c; }
                if (it >= 8) pv = __builtin_nanf("");
                else if (lo_real && hi != PINF) pv = lo + (hi - lo) * ((float)(clo - 256) * rcpf_((float)(clo - chi)));
                else pv = pv + (float)(c - 256) * stepc;
            }
#undef CNT_GE
            if (!tie) {
#pragma unroll
                for (int i = 0; i < NREG; i += 4) ballot4(mlo, mhi, thr, x[i], x[i + 1], x[i + 2], x[i + 3], i);
            } else {
                const int need = 256 - chi; int before = 0;
#pragma unroll
                for (int i = 0; i < NREG; ++i) { const bool eq = (x[i] == lo); const unsigned long long be = __ballot(eq);
                    const int rank = before + __popcll(be & lt_mask); const bool sel = (x[i] >= hi) || (eq && rank < need); before += __popcll(be);
                    const unsigned long long bs = __ballot(sel);
                    wrlane(mlo, (unsigned)bs, i); wrlane(mhi, (unsigned)(bs >> 32), i); }
            }
        } else {
#pragma unroll
            for (int i = 0; i < NREG; ++i) { const unsigned long long bs = __ballot(i * 64 + lane <= tq);
                wrlane(mlo, (unsigned)bs, i); wrlane(mhi, (unsigned)(bs >> 32), i); }
        }
        if (lane < NREG) { v2u w; w.x = mlo; w.y = mhi; *(LAS v2u*)(mrow + 2 * lane) = w; }
    }
}

__device__ __forceinline__ void dsa_unit(Frame& F, const Args& args, const int b, const int qb, const float mb2) {
    LAS unsigned char* const L = F.lds;
    const int tid = F.tid, lane = F.lane, wv = F.wave, l31_0 = lane & 31, hh_0 = lane >> 5;
    int l31 = l31_0, hh = hh_0;
    constexpr int PK = 272, PV = 144;
    constexpr int O_K0 = 0, O_V0 = 17408, BUFSZ = 35840, O_MASK = 2 * BUFSZ, O_RS = O_MASK + 16384, O_BT = O_RS + 8192, O_ZT = O_BT + 2048, O_END = O_ZT + 512, O_OA = 0;
    static_assert(O_END <= SCRATCH_BYTES && 4 * 17408 <= 2 * BUFSZ, "dsa LDS map");
    const int t0 = 64 * qb, nk = 64 * (qb + 1);
    const size_t rb = (size_t)b * SEQ;
    LAS unsigned* const MASK = (LAS unsigned*)(L + O_MASK);
    LAS float* const RS = (LAS float*)(L + O_RS);
    LAS float* const BT = (LAS float*)(L + O_BT);
    LAS float* const ZT = (LAS float*)(L + O_ZT);
    const float NINF = -__builtin_inff();
    for (int key = tid; key < nk; key += NWAVES * 64) { const float* kp = W_KVSS + rb + key; RS[key] = rsqf_(((kp[0] + kp[MROWS]) + (kp[2 * MROWS] + kp[3 * MROWS])) * (1.0f / 128.0f) + EPSF); }
    BT[tid] = P_RELB[T5_BUCKET[tid >> 2] * 4 + (tid & 3)] * LOG2E;
    if (tid < 64) {
        const float n_ = (float)(t0 + tid + 1); float f_ = 256.0f * rcpf_(n_); const bool up_ = f_ > 0.5f; if (up_) f_ = 1.0f - f_;
        f_ = fmaxf(f_, 1e-6f);
        const float t_ = __builtin_sqrtf(-1.3862944f * __builtin_log2f(f_));
        float z_ = t_ - (2.515517f + t_ * (0.802853f + t_ * 0.010328f)) * rcpf_(1.0f + t_ * (1.432788f + t_ * (0.189269f + t_ * 0.001308f)));
        if (up_) z_ = -z_;
        ZT[2 * tid] = z_; ZT[2 * tid + 1] = rcpf_(n_ * 0.3989423f * __builtin_exp2f(-0.72134752f * z_ * z_));
    }
    float* const scw = W_SCR + (size_t)(blockIdx.x * NWAVES + wv) * 8 * 2048;
#pragma unroll 1
    for (int rep_a = 0; rep_a < (PROBE_DUP == 41 ? 2 : 1); ++rep_a) {
        bf16x8 aq[2][4]; f32x4 wts[2][4];
#pragma unroll
        for (int rt = 0; rt < 2; ++rt) {
            const bf16* p = W_PROJ + (rb + t0 + 8 * wv + 4 * rt + (l31 >> 3)) * NPROJ + C_IQ + (l31 & 7) * 64 + 8 * hh;
#pragma unroll
            for (int s = 0; s < 4; ++s) aq[rt][s] = *(const GAS bf16x8*)(p + 16 * s);
#pragma unroll
            for (int g = 0; g < 4; ++g) wts[rt][g] = *(const f32x4*)(W_AUX + (rb + t0 + 8 * wv + 4 * rt + g) * 16 + 8 + 4 * hh) * 0.5f;
        }
        constexpr int O_IK = 0, IKB = 9216, PIK = 144;
        v4u sti;
#define IK_GLOAD(kt_) sti = *(const GAS v4u*)(W_PROJ + (rb + 64 * (kt_) + (tid >> 3)) * NPROJ + C_IK + (tid & 7) * 8)
#define IK_SWRITE(buf_) *(LAS v4u*)(L + O_IK + (buf_) * IKB + (tid >> 3) * PIK + (tid & 7) * 16) = sti
        IK_GLOAD(0); IK_SWRITE(0);
        __syncthreads();
#pragma unroll 1
        for (int kt6 = 0; kt6 <= qb; ++kt6) {
          const int ibuf = kt6 & 1;
          if (kt6 < qb) IK_GLOAD(kt6 + 1);
#pragma unroll
          for (int st = 0; st < 2; ++st) {
            bf16x8 bk[4];
#pragma unroll
            for (int s = 0; s < 4; ++s) bk[s] = lds16(L + O_IK + ibuf * IKB + (32 * st + l31) * PIK + (16 * s + 8 * hh) * 2);
            const int kt = 2 * kt6 + st;
            const int key = 32 * kt + l31;
            f32x16 C0, C1;
#pragma unroll
            for (int r = 0; r < 16; ++r) { C0[r] = 0.f; C1[r] = 0.f; }
#pragma unroll
            for (int s = 0; s < 4; ++s) C0 = MFMA32(aq[0][s], bk[s], C0);
#pragma unroll
            for (int s = 0; s < 4; ++s) C1 = MFMA32(aq[1][s], bk[s], C1);
            float pp[2][4];
#pragma unroll
            for (int g = 0; g < 4; ++g) {
                float p0 = 0.f, p1 = 0.f;
#pragma unroll
                for (int e2 = 0; e2 < 4; ++e2) { const float w0 = wts[0][g][e2], w1 = wts[1][g][e2], x0 = C0[4 * g + e2], x1 = C1[4 * g + e2];
                    p0 = __builtin_fmaf(w0, x0, p0); p0 = __builtin_fmaf(w0, __builtin_fabsf(x0), p0); p1 = __builtin_fmaf(w1, x1, p1); p1 = __builtin_fmaf(w1, __builtin_fabsf(x1), p1); }
                pp[0][g] = p0; pp[1][g] = p1;
            }
#pragma unroll
            for (int rt = 0; rt < 2; ++rt)
#pragma unroll
                for (int g2 = 0; g2 < 2; ++g2) { const int ql = 4 * rt + g2 + 2 * hh;
                    float pa = pp[rt][g2], pb = pp[rt][g2 + 2];
                    asm("s_nop 1\n\tv_permlane32_swap_b32 %0, %1" : "+v"(pa), "+v"(pb));
                    float p = pa + pb;
                    if (key > t0 + 8 * wv + ql) p = NINF;
                    scw[ql * 2048 + key] = p; }
          }
          if (kt6 < qb) IK_SWRITE(ibuf ^ 1);
          __syncthreads();
        }
#undef IK_GLOAD
#undef IK_SWRITE
    }
    __builtin_amdgcn_fence(__ATOMIC_SEQ_CST, "workgroup");
    asm volatile("s_waitcnt vmcnt(0)" ::: "memory");
    const int qj = l31 >> 2, hd = l31 & 3;
    const int tql = t0 + 8 * wv + qj;
    bf16x8 qf[8]; float qn2 = 0.f;
    {
        const bf16* p = W_PROJ + (rb + tql) * NPROJ + C_QB + hd * 128 + 8 * hh; const float cs = 0.08838834764831845f * LOG2E;
#pragma unroll
        for (int s = 0; s < 8; ++s) { const v4u raw = *(const GAS v4u*)(p + 16 * s); const f32x4 g0 = *(const f32x4*)(P_GKV + 16 * s + 8 * hh), g1 = *(const f32x4*)(P_GKV + 16 * s + 8 * hh + 4);
            v4u o; o.x = cvtpk(bflo(raw.x) * g0.x * cs, bfhi(raw.x) * g0.y * cs); o.y = cvtpk(bflo(raw.y) * g0.z * cs, bfhi(raw.y) * g0.w * cs);
            o.z = cvtpk(bflo(raw.z) * g1.x * cs, bfhi(raw.z) * g1.y * cs); o.w = cvtpk(bflo(raw.w) * g1.z * cs, bfhi(raw.w) * g1.w * cs);
            qn2 += (bflo(o.x) * bflo(o.x) + bfhi(o.x) * bfhi(o.x)) + (bflo(o.y) * bflo(o.y) + bfhi(o.y) * bfhi(o.y)) + (bflo(o.z) * bflo(o.z) + bfhi(o.z) * bfhi(o.z)) + (bflo(o.w) * bflo(o.w) + bfhi(o.w) * bfhi(o.w));
            qf[s] = __builtin_bit_cast(bf16x8, o); }
    }
    qn2 += __shfl_xor(qn2, 32);
    int lanev = lane; asm volatile("" : "+v"(lanev));
#pragma unroll 1
    for (int rep_b = 0; rep_b < (PROBE_DUP == 42 ? 2 : 1); ++rep_b)
    if (qb < 8) dsa_select<8>(scw, MASK, ZT, wv, lanev, t0, nk);
    else if (qb < 16) dsa_select<16>(scw, MASK, ZT, wv, lanev, t0, nk);
    else if (qb < 24) dsa_select<24>(scw, MASK, ZT, wv, lanev, t0, nk);
    else dsa_select<32>(scw, MASK, ZT, wv, lanev, t0, nk);
    __syncthreads();
    const float c0 = -(sqrtf(qn2) * 11.313708499f * 1.01f + mb2 + 1.0f);
    const float cfar = BT[127 * 4 + hd] + c0;
    f32x16 oacc[4];
#pragma unroll
    for (int d = 0; d < 4; ++d)
#pragma unroll
        for (int r = 0; r < 16; ++r) oacc[d][r] = 0.f;
    float lsum = 0.f;
    v4u st0, st1;
#define DSA_GLOAD(kt) do { const bf16* _p = W_PROJ + (rb + 64 * (kt) + lane) * NPROJ + C_CKV + wv * 16; st0 = *(const GAS v4u*)_p; st1 = *(const GAS v4u*)(_p + 8); } while (0)
#define DSA_SWRITE(buf, ktt) do { LAS unsigned char* _kb = L + (buf) * BUFSZ; const float _r = RS[64 * (ktt) + lane]; \
        v4u _n0, _n1; _n0.x = cvtpk(bflo(st0.x) * _r, bfhi(st0.x) * _r); _n0.y = cvtpk(bflo(st0.y) * _r, bfhi(st0.y) * _r); _n0.z = cvtpk(bflo(st0.z) * _r, bfhi(st0.z) * _r); _n0.w = cvtpk(bflo(st0.w) * _r, bfhi(st0.w) * _r); \
        _n1.x = cvtpk(bflo(st1.x) * _r, bfhi(st1.x) * _r); _n1.y = cvtpk(bflo(st1.y) * _r, bfhi(st1.y) * _r); _n1.z = cvtpk(bflo(st1.z) * _r, bfhi(st1.z) * _r); _n1.w = cvtpk(bflo(st1.w) * _r, bfhi(st1.w) * _r); \
        *(LAS v4u*)(_kb + O_K0 + lane * PK + wv * 32) = _n0; *(LAS v4u*)(_kb + O_K0 + lane * PK + wv * 32 + 16) = _n1; \
        } while (0)
    DSA_GLOAD(0); DSA_SWRITE(0, 0);
    __syncthreads();
    for (int kt = 0; kt <= qb; ++kt) {
        const int buf = kt & 1;
        l31 = l31_0; hh = hh_0; asm volatile("" : "+v"(l31), "+v"(hh));
        if (kt < qb) DSA_GLOAD(kt + 1);
        const LAS unsigned char* kb = L + buf * BUFSZ;
        bf16x8 kf[8];
        int mw0 = (int)MASK[(8 * wv + qj) * 64 + 2 * kt], mw1 = (int)MASK[(8 * wv + qj) * 64 + 2 * kt + 1];
#pragma unroll
        for (int st = 0; st < 2; ++st) {
#pragma unroll
            for (int s = 0; s < 8; ++s) kf[s] = lds16(kb + O_K0 + (32 * st + l31) * PK + (16 * s + 8 * hh) * 2);
            __builtin_amdgcn_sched_barrier(0);
            const int kbase = 64 * kt + 32 * st;
            const bool far = (t0 + 8 * wv) - (kbase + 31) >= 113;
            const float sinit = far ? cfar : 0.f;
            f32x16 Sa;
#pragma unroll
            for (int r = 0; r < 16; ++r) Sa[r] = sinit;
#pragma unroll
            for (int s = 0; s < 8; ++s) Sa = MFMA32(kf[s], qf[s], Sa);
            __builtin_amdgcn_sched_barrier(0);
            bf16x8 vf[8];
#pragma unroll
            for (int dt = 0; dt < 4; ++dt) {
                const LAS unsigned char* vp = kb + O_K0 + (32 * st + 4 * hh + ((lane & 15) >> 2)) * PK + (32 * dt + 16 * ((lane >> 4) & 1) + 4 * (lane & 3)) * 2;
                vf[2 * dt] = ldstr8(vp, vp + 8 * PK); vf[2 * dt + 1] = ldstr8(vp + 16 * PK, vp + 24 * PK); }
            __builtin_amdgcn_sched_barrier(0);
            const int mwi = (st == 0 ? mw0 : mw1) >> (4 * hh);
            float pn[16];
            if (far) {
#pragma unroll
                for (int r = 0; r < 16; ++r) { int mb_ = __builtin_amdgcn_sbfe(mwi, 8 * (r >> 2) + (r & 3), 1); asm("" : "+v"(mb_));
                    pn[r] = __builtin_bit_cast(float, __builtin_bit_cast(int, __builtin_amdgcn_exp2f(Sa[r])) & mb_); lsum += pn[r]; }
            } else {
#pragma unroll
                for (int r = 0; r < 16; ++r) { int dist = tql - (kbase + 8 * (r >> 2) + 4 * hh + (r & 3)); dist = dist < 0 ? 0 : (dist > 127 ? 127 : dist);
                    int mb_ = __builtin_amdgcn_sbfe(mwi, 8 * (r >> 2) + (r & 3), 1); asm("" : "+v"(mb_));
                    pn[r] = __builtin_bit_cast(float, __builtin_bit_cast(int, __builtin_amdgcn_exp2f(Sa[r] + (BT[dist * 4 + hd] + c0))) & mb_); lsum += pn[r]; }
            }
            const bf16x8 pf0 = pack8(pn[0], pn[1], pn[2], pn[3], pn[4], pn[5], pn[6], pn[7]), pf1 = pack8(pn[8], pn[9], pn[10], pn[11], pn[12], pn[13], pn[14], pn[15]);
#pragma unroll
            for (int dt = 0; dt < 4; ++dt) { oacc[dt] = MFMA32(vf[2 * dt], pf0, oacc[dt]); oacc[dt] = MFMA32(vf[2 * dt + 1], pf1, oacc[dt]); }
        }
        if (kt < qb) DSA_SWRITE(buf ^ 1, kt + 1);
        __syncthreads();
    }
#undef DSA_GLOAD
#undef DSA_SWRITE
    lsum += __shfl_xor(lsum, 32);
    {
        const float inv = rcpf_(lsum);
#pragma unroll
        for (int dt = 0; dt < 4; ++dt)
#pragma unroll
            for (int g = 0; g < 4; ++g) { const int d = 32 * dt + 8 * g + 4 * hh; const f32x4 gk = *(const f32x4*)(P_GKV + d);
                *(LAS v2u*)(L + O_OA + hd * 17408 + (8 * wv + qj) * PK + d * 2) = pack4(oacc[dt][4 * g] * inv * gk.x, oacc[dt][4 * g + 1] * inv * gk.y, oacc[dt][4 * g + 2] * inv * gk.z, oacc[dt][4 * g + 3] * inv * gk.w); }
    }
    __syncthreads();
    {
        const int hd2 = wv >> 1, mt2 = wv & 1;
        const size_t row = rb + t0 + 32 * mt2 + l31;
        bf16x8 of[8];
#pragma unroll
        for (int s = 0; s < 8; ++s) of[s] = lds16(L + O_OA + hd2 * 17408 + (32 * mt2 + l31) * PK + (16 * s + 8 * hh) * 2);
        const int erow = 16 * ((l31 >> 2) & 1) + 4 * (l31 >> 3) + (l31 & 3);
#pragma unroll
        for (int et = 0; et < 4; ++et) {
            const bf16* zp = W_PROJ + row * NPROJ + C_ZB + hd2 * 128 + 32 * et + 16 * hh;
            const v4u z0 = *(const GAS v4u*)zp, z1 = *(const GAS v4u*)(zp + 8);
            f32x16 C;
#pragma unroll
            for (int r = 0; r < 16; ++r) C[r] = 0.f;
            const bf16* wp = W_WUVT + (size_t)hd2 * 16384 + (32 * et + erow) * 128 + 8 * hh;
#pragma unroll
            for (int s = 0; s < 8; ++s) C = MFMA32(*(const GAS bf16x8*)(wp + 16 * s), of[s], C);
            const unsigned zw[8] = {z0.x, z0.y, z0.z, z0.w, z1.x, z1.y, z1.z, z1.w}; unsigned ow[8];
#pragma unroll
            for (int k = 0; k < 8; ++k) ow[k] = cvtpk(C[2 * k] * siluf(bflo(zw[k])), C[2 * k + 1] * siluf(bfhi(zw[k])));
            bf16* op = W_OAB + row * DM + 512 + hd2 * 128 + 32 * et + 16 * hh;
            v4u o0, o1; o0.x = ow[0]; o0.y = ow[1]; o0.z = ow[2]; o0.w = ow[3]; o1.x = ow[4]; o1.y = ow[5]; o1.z = ow[6]; o1.w = ow[7];
            *(GAS v4u*)op = o0; *(GAS v4u*)(op + 8) = o1;
        }
    }
    __syncthreads();
}

constexpr int N_GDN = NB * 4, N_DSA = NB * 32, N_ITEMS = N_GDN + N_DSA;
constexpr int N_PHASES = 6;
#ifndef STAG_P2
#define STAG_P2 0
#endif
#ifndef STAG_P4
#define STAG_P4 0
#endif
__global__ void __launch_bounds__(NWAVES * 64, 2) hyb_fwd(Args args) {
    extern __shared__ __attribute__((aligned(16))) unsigned char lds[];
    Frame F;
    F.lds = (LAS unsigned char*)lds;
    F.MISC = (volatile LAS unsigned*)(F.lds + MISC_OFF);
    F.tid = threadIdx.x; F.lane = F.tid & 63; F.wave = __builtin_amdgcn_readfirstlane(F.tid >> 6);
    F.G = gridDim.x; { const int bx = blockIdx.x; F.vcu = (F.G % 8 == 0) ? (bx % 8) * (F.G / 8) + bx / 8 : bx; }
    unsigned char* ws = args.ws;
    F.ctl = (gu32*)(ws + WS_CTL);
    F.ws = ws;
    for (int u = F.tid; u < 64; u += NWAVES * 64) F.MISC[u] = 0u;
    __syncthreads();
    const int lo = args.ph_lo, hi = args.ph_hi;
    const bool multi = (hi - lo) > 1;
    XcdBarrier bar; bar.bar = (unsigned*)(F.ctl + CW_BAR) + args.li * XCD_BAR_WORDS; bar.x = 0; bar.st = nullptr;
    if (multi) bar = xcd_barrier_post((unsigned*)(F.ctl + CW_BAR) + args.li * XCD_BAR_WORDS, F.MISC + 8);
#define IN(k) (lo <= (k) && (k) < hi)
#define STAGGER(ticks) do { if ((ticks) > 0) { const unsigned long long t0_ = __builtin_amdgcn_s_memrealtime(); const unsigned d_ = ((unsigned)blockIdx.x & 7u) * (unsigned)(ticks); \
        while ((unsigned)(__builtin_amdgcn_s_memrealtime() - t0_) < d_) __builtin_amdgcn_s_sleep(4); } } while (0)
#define BOTH(k) (IN(k) && IN((k) + 1))
    if (IN(0)) { p0_prologue(F, args); if (PROBE_DUP == 7) { __syncthreads(); p0_prologue(F, args); } if (BOTH(0)) xcd_barrier(bar); }
    if (IN(1)) { p1_norm(F, args); if (PROBE_DUP == 1) p1_norm(F, args); if (BOTH(1)) xcd_barrier(bar); }
    if (IN(2)) {
        pg8::Gemm g{W_XN, W_WINT, MROWS, NPROJ, DM, (unsigned*)(F.ws + WS_CTL + 512 * 1024)}; pg8::StaticOrder S; S.init(MROWS, NPROJ, F.G, (int)blockIdx.x);
        pg8::EpiProj E{W_PROJ, W_AUX, W_KVSS};
        STAGGER(STAG_P2);
        pg8::gemm_phase<pg8::EpiProj, pg8::StaticOrder, true, true>(F.lds, g, S, E);
        if (PROBE_DUP == 2) pg8::gemm_phase<pg8::EpiProj, pg8::StaticOrder, true, true>(F.lds, g, S, E);
        if (PROBE_DUP == 22) { pg8::EpiHalf EH{E, pg8::EpiNull{W_SCR}}; pg8::gemm_phase<pg8::EpiHalf, pg8::StaticOrder, true, true>(F.lds, g, S, EH); }
        if (PROBE_DUP == 23) { pg8::EpiPat<true> EP{(bf16*)(F.ws + WS_SCR), 3072, 12}; pg8::gemm_phase<pg8::EpiPat<true>, pg8::StaticOrder, true, true>(F.lds, g, S, EP); }
        if (PROBE_DUP == 24) { pg8::EpiPat<false> EP{(bf16*)(F.ws + WS_SCR), 3072, 12}; pg8::gemm_phase<pg8::EpiPat<false>, pg8::StaticOrder, true, true>(F.lds, g, S, EP); }
        if (PROBE_DUP == 25) { pg8::EpiPat<false> EP{W_PROJ, 3840, 12}; pg8::gemm_phase<pg8::EpiPat<false>, pg8::StaticOrder, true, true>(F.lds, g, S, EP); }
        if (PROBE_DUP == 26) { pg8::EpiPat<false> EP{W_PROJ, 3840, 15}; pg8::gemm_phase<pg8::EpiPat<false>, pg8::StaticOrder, true, true>(F.lds, g, S, EP); }
        if (PROBE_DUP == 21) { pg8::EpiNull EN{W_SCR}; pg8::gemm_phase<pg8::EpiNull, pg8::StaticOrder, true, true>(F.lds, g, S, EN); }
        if (BOTH(2)) xcd_barrier(bar);
    }
    if (IN(3)) {
#define NEXT_ITEM(dst, qw) do { if (F.tid == 0) F.MISC[4] = __hip_atomic_fetch_add(F.ctl + (qw), 1u, RLX_AGENT); __syncthreads(); dst = (int)F.MISC[4]; __syncthreads(); } while (0)
        float mb2; { const int hd_ = F.lane & 3; float m_ = P_RELB[hd_]; for (int k = 1; k < 32; ++k) m_ = fmaxf(m_, P_RELB[k * 4 + hd_]); mb2 = m_ * LOG2E; }
        int item; NEXT_ITEM(item, CW_QUEUE);
#pragma unroll 1
        for (int pass = 0; pass < (PROBE_DUP == 3 ? 2 : 1); ++pass) {
            if (pass) NEXT_ITEM(item, CW_QUEUE + 64);
            while (item < N_GDN) { gdn_unit(F, args, item >> 2, item & 3); NEXT_ITEM(item, CW_QUEUE + 64 * pass); }
        }
#pragma unroll 1
        for (int pass = 0; pass < (PROBE_DUP == 4 ? 2 : 1); ++pass) {
            if (pass) NEXT_ITEM(item, CW_QUEUE + 128);
            while (item < N_ITEMS) { if (item >= N_GDN) { const int idx = item - N_GDN; dsa_unit(F, args, idx & 31, 31 - (idx >> 5), mb2); } NEXT_ITEM(item, pass ? CW_QUEUE + 128 : CW_QUEUE); }
        }
#undef NEXT_ITEM
        if (BOTH(3)) xcd_barrier(bar);
    }
    if (IN(4)) {
        pg8::Gemm g{W_OAB, W_WOUTT, MROWS, DM, DM, (unsigned*)(F.ws + WS_CTL + 512 * 1024)}; pg8::StaticOrder S; S.init(MROWS, DM, F.G, (int)blockIdx.x);
        pg8::EpiMix E{W_MIX, DM};
        STAGGER(STAG_P4);
        pg8::gemm_phase<pg8::EpiMix, pg8::StaticOrder, true, true>(F.lds, g, S, E);
        if (PROBE_DUP == 5) pg8::gemm_phase<pg8::EpiMix, pg8::StaticOrder, true, true>(F.lds, g, S, E);
        if (BOTH(4)) xcd_barrier(bar);
    }
    if (IN(5)) { p5_final(F, args); if (PROBE_DUP == 6) p5_final(F, args); }
#undef IN
#undef BOTH
}

extern "C" void kernel_launch(void* const* d_in, const int* in_sizes, int n_in, void* d_out, int out_size, void* d_ws, size_t ws_size, hipStream_t stream) {
    static int grid = 0;
    if (grid == 0) {
        if (n_in != 15 || in_sizes[0] != MROWS * DM || out_size != MROWS * DM || ws_size < WS_END) { fprintf(stderr, "kernel_launch: unexpected shapes (n_in %d, in0 %d, out %d, ws %zu); nothing launched\n", n_in, n_in > 0 ? in_sizes[0] : -1, out_size, ws_size); grid = -1; return; }
        int dev = 0, cus = 0, per_cu = 0;
        if (hipGetDevice(&dev) != hipSuccess || hipDeviceGetAttribute(&cus, hipDeviceAttributeMultiprocessorCount, dev) != hipSuccess) { fprintf(stderr, "kernel_launch: device query failed\n"); grid = -1; return; }
        if (hipFuncSetAttribute((const void*)hyb_fwd, hipFuncAttributeMaxDynamicSharedMemorySize, LDS_BYTES) != hipSuccess) { fprintf(stderr, "kernel_launch: hipFuncSetAttribute failed\n"); grid = -1; return; }
        if (hipOccupancyMaxActiveBlocksPerMultiprocessor(&per_cu, (const void*)hyb_fwd, NWAVES * 64, LDS_BYTES) != hipSuccess || per_cu < 1)
            fprintf(stderr, "kernel_launch: note: occupancy query reports %d workgroups per CU\n", per_cu);
        (void)hipGetLastError();
        grid = cus < 256 ? cus : 256;
    }
    if (grid < 0) return;
    if (hipMemsetAsync((char*)d_ws + WS_CTL, 0, CTL_ZERO_BYTES, stream) != hipSuccess) { fprintf(stderr, "kernel_launch: memset failed\n"); return; }
    Args a{};
    for (int i = 0; i < 15; ++i) a.in[i] = (const float*)d_in[i];
    a.out = (float*)d_out; a.ws = (unsigned char*)d_ws;
    constexpr int NL = MK_N_LAUNCHES;
    static_assert(NL == 1 || NL == 2 || NL == 3 || NL == N_PHASES, "MK_N_LAUNCHES");
    const int cuts1[2] = {0, 6}, cuts2[3] = {0, 3, 6}, cuts3[4] = {0, 3, 4, 6}, cuts6[7] = {0, 1, 2, 3, 4, 5, 6};
    const int* cuts = NL == 1 ? cuts1 : NL == 2 ? cuts2 : NL == 3 ? cuts3 : cuts6;
    for (int li = 0; li < NL; ++li) {
        a.ph_lo = cuts[li]; a.ph_hi = cuts[li + 1]; a.li = li;
        hipLaunchKernelGGL(hyb_fwd, dim3(grid), dim3(NWAVES * 64), LDS_BYTES, stream, a);
        const hipError_t le = hipPeekAtLastError();
        if (le != hipSuccess) { fprintf(stderr, "kernel_launch: launch %d failed: %s\n", li, hipGetErrorName(le)); break; }
    }
}
```

```cpp
#include <hip/hip_runtime.h>
#include <cstdio>
#include <cstdint>
#ifndef MK_N_LAUNCHES
#define MK_N_LAUNCHES 1
#endif
#ifndef PROBE_DUP
#define PROBE_DUP 0
#endif
namespace pg8 {
#define PG8_LAS __attribute__((address_space(3)))
typedef unsigned short bf16_t;
typedef short bf16x8 __attribute__((ext_vector_type(8)));
typedef float f32x4 __attribute__((ext_vector_type(4)));
typedef unsigned u32x4 __attribute__((ext_vector_type(4)));
constexpr int BM = 256, BK = 64, HALF = 128, HTB = HALF * BK * 2  , STAGE_BYTES = 8 * HTB, NXCD = 8, WGM = 8;

__host__ __device__ __forceinline__ int lds_byte(int r, int c) { const int st = (r >> 4) * 2 + (c >> 5), rr = r & 15, cc = c & 31, ob = rr * 64 + cc * 2; return st * 1024 + (ob ^ (((ob >> 9) & 1) << 5)); }
__host__ __device__ __forceinline__ void stage_rc(int b, int& R, int& C) { const int st = b / 1024, sb = b % 1024, swz = sb ^ (((sb >> 9) & 1) << 5); R = (st >> 1) * 16 + swz / 64; C = (st & 1) * 32 + (swz % 64) / 2; }
__host__ __device__ __forceinline__ int perm32(int rho) { const int n = rho >> 4, i = rho & 15; return 8 * (i >> 2) + 4 * n + (i & 3); }

struct Unit { int pm, pn; };
struct Gemm { const bf16_t* A; const bf16_t* Bt; int M, N, K; unsigned* sink; };

struct StaticOrder {
    int nM, nN, nwg, G, c;
    __host__ __device__ void init(int M, int N, int G_, int c_) { nM = M / BM; nN = N / BM; nwg = nM * nN; G = G_; c = c_; }
    __host__ __device__ bool next(int i, Unit& u) const {
        const long L = (long)i * G + c; if (L >= nwg) return false;
        int wgid = (int)L; { const int q = nwg / NXCD, r = nwg % NXCD, xcd = wgid % NXCD, off = wgid / NXCD; wgid = (xcd < r ? xcd * (q + 1) : r * (q + 1) + (xcd - r) * q) + off; }
        const int nig = WGM * nN, gid = wgid / nig, fm = gid * WGM, gsz = (nM - fm) < WGM ? (nM - fm) : WGM;
        u.pm = fm + ((wgid % nig) % gsz); u.pn = (wgid % nig) / gsz; return true;
    }
    __device__ __forceinline__ void a_ready(const Unit&) const {}
    __device__ __forceinline__ void done(const Unit&) const {}
};

typedef float f32x2c __attribute__((ext_vector_type(2))); typedef __bf16 b16x2c __attribute__((ext_vector_type(2)));
__device__ __forceinline__ unsigned cvt_pk_bf16(float lo, float hi) { const f32x2c v = {lo, hi}; return __builtin_bit_cast(unsigned, __builtin_convertvector(v, b16x2c)); }
struct EpiProj {
    static constexpr bool PERM = true, AFTER_DRAIN = false; static constexpr int MIN_VM = 16;
    bf16_t* O; float* aux; float* kvss;
    __device__ __forceinline__ void operator()(const f32x4 (&acc)[2][2][4][2], const Unit& u, int wr, int wc, int fr, int fq) const {
        const int row0 = u.pm * BM + wr * 64 + fr, col0 = u.pn * BM + wc * 32 + 8 * fq;
        const bool last = (u.pn == 14);
#pragma unroll
        for (int ai = 0; ai < 2; ++ai)
#pragma unroll
            for (int m = 0; m < 4; ++m) {
                const int row = row0 + ai * HALF + m * 16;
                bf16_t* rowp = O + (size_t)row * 3840 + col0;
#pragma unroll
                for (int bj = 0; bj < 2; ++bj) {
                    const f32x4 v0 = acc[ai][bj][m][0], v1 = acc[ai][bj][m][1];
                    u32x4 w; w.x = cvt_pk_bf16(v0[0], v0[1]); w.y = cvt_pk_bf16(v0[2], v0[3]); w.z = cvt_pk_bf16(v1[0], v1[1]); w.w = cvt_pk_bf16(v1[2], v1[3]);
                    *(u32x4*)(rowp + bj * HALF) = w;
                }
                if (last) {
                    const f32x4 a0 = acc[ai][0][m][0], a1 = acc[ai][0][m][1];
                    float ss = (a0[0] * a0[0] + a0[1] * a0[1]) + (a0[2] * a0[2] + a0[3] * a0[3]) + (a1[0] * a1[0] + a1[1] * a1[1]) + (a1[2] * a1[2] + a1[3] * a1[3]);
                    ss += __shfl_xor(ss, 16); ss += __shfl_xor(ss, 32);
                    if (fq == 0) kvss[(size_t)wc * 65536 + row] = ss;
                    if (wc == 2 && fq < 2) { float* ap = aux + (size_t)row * 16 + 8 * fq; *(f32x4*)ap = acc[ai][1][m][0]; *(f32x4*)(ap + 4) = acc[ai][1][m][1]; }
                }
            }
    }
};
struct EpiF32 {
    static constexpr bool PERM = false, AFTER_DRAIN = false; static constexpr int MIN_VM = 32;
    float* C; int ldc;
    __device__ __forceinline__ void operator()(const f32x4 (&acc)[2][2][4][2], const Unit& u, int wr, int wc, int fr, int fq) const {
        const int row0 = u.pm * BM + wr * 64 + fr, col0 = u.pn * BM + wc * 32 + 4 * fq;
#pragma unroll
        for (int ai = 0; ai < 2; ++ai)
#pragma unroll
            for (int m = 0; m < 4; ++m) { float* rowp = C + (size_t)(row0 + ai * HALF + m * 16) * ldc + col0;
#pragma unroll
                for (int bj = 0; bj < 2; ++bj)
#pragma unroll
                    for (int n = 0; n < 2; ++n) *(f32x4*)(rowp + bj * HALF + n * 16) = acc[ai][bj][m][n]; }
    }
};
struct EpiMix {
    static constexpr bool PERM = true, AFTER_DRAIN = false; static constexpr int MIN_VM = 16;
    bf16_t* O; int ldc;
    __device__ __forceinline__ void operator()(const f32x4 (&acc)[2][2][4][2], const Unit& u, int wr, int wc, int fr, int fq) const {
        const int row0 = u.pm * BM + wr * 64 + fr, col0 = u.pn * BM + wc * 32 + 8 * fq;
#pragma unroll
        for (int ai = 0; ai < 2; ++ai)
#pragma unroll
            for (int m = 0; m < 4; ++m) { bf16_t* rowp = O + (size_t)(row0 + ai * HALF + m * 16) * ldc + col0;
#pragma unroll
                for (int bj = 0; bj < 2; ++bj) { const f32x4 v0 = acc[ai][bj][m][0], v1 = acc[ai][bj][m][1];
                    u32x4 w; w.x = cvt_pk_bf16(v0[0], v0[1]); w.y = cvt_pk_bf16(v0[2], v0[3]); w.z = cvt_pk_bf16(v1[0], v1[1]); w.w = cvt_pk_bf16(v1[2], v1[3]);
                    *(u32x4*)(rowp + bj * HALF) = w; } }
    }
};
struct EpiNull {
    static constexpr bool PERM = true, AFTER_DRAIN = false; static constexpr int MIN_VM = 0;
    float* O;
    __device__ __forceinline__ void operator()(const f32x4 (&acc)[2][2][4][2], const Unit& u, int wr, int wc, int fr, int fq) const {
        f32x4 s = {0.f, 0.f, 0.f, 0.f};
#pragma unroll
        for (int ai = 0; ai < 2; ++ai)
#pragma unroll
            for (int bj = 0; bj < 2; ++bj)
#pragma unroll
                for (int m = 0; m < 4; ++m) { s += acc[ai][bj][m][0]; s += acc[ai][bj][m][1]; }
        if ((s[0] + s[1]) + (s[2] + s[3]) == 1.2345e30f) O[u.pm * 4096 + u.pn * 256 + wr * 128 + wc * 32 + fq * 16 + fr] = s[0];
    }
};
struct EpiHalf {
    static constexpr bool PERM = true, AFTER_DRAIN = false; static constexpr int MIN_VM = 0;
    EpiProj P; EpiNull N;
    __device__ __forceinline__ void operator()(const f32x4 (&acc)[2][2][4][2], const Unit& u, int wr, int wc, int fr, int fq) const {
        if ((blockIdx.x & 7) < 4) P(acc, u, wr, wc, fr, fq); else N(acc, u, wr, wc, fr, fq);
    }
};
template <bool TILE> struct EpiPat {
    static constexpr bool PERM = true, AFTER_DRAIN = false; static constexpr int MIN_VM = 0;
    bf16_t* O; int ld, npn;
    __device__ __forceinline__ void operator()(const f32x4 (&acc)[2][2][4][2], const Unit& u, int wr, int wc, int fr, int fq) const {
        if (u.pn >= npn) return;
        const int r0 = wr * 64 + fr, c0 = wc * 32 + 8 * fq;
#pragma unroll
        for (int ai = 0; ai < 2; ++ai)
#pragma unroll
            for (int m = 0; m < 4; ++m) {
                const int r = r0 + ai * HALF + m * 16;
                bf16_t* rowp = TILE ? O + ((size_t)(u.pm * 12 + u.pn) * 65536 + r * 256 + c0) : O + ((size_t)(u.pm * BM + r) * ld + u.pn * BM + c0);
#pragma unroll
                for (int bj = 0; bj < 2; ++bj) {
                    const f32x4 v0 = acc[ai][bj][m][0], v1 = acc[ai][bj][m][1];
                    u32x4 w; w.x = cvt_pk_bf16(v0[0], v0[1]); w.y = cvt_pk_bf16(v0[2], v0[3]); w.z = cvt_pk_bf16(v1[0], v1[1]); w.w = cvt_pk_bf16(v1[2], v1[3]);
                    *(u32x4*)(rowp + bj * HALF) = w;
                }
            }
    }
};
template <int N> __device__ __forceinline__ void wait_vm() { asm volatile("s_waitcnt vmcnt(%0)" :: "n"(N) : "memory"); }
template <class Epi, class Sched, bool ALIGN_EPI = false, bool SP2 = false>
__device__ __forceinline__ void gemm_phase(PG8_LAS unsigned char* lds, const Gemm g, const Sched& S, const Epi& E) {
    int tid_ = threadIdx.x; asm volatile("" : "+v"(tid_));
    const int tid = tid_, wid = __builtin_amdgcn_readfirstlane(tid >> 6), lane = tid & 63, wr = wid >> 2, wc = wid & 3, fr = lane & 15, fq = lane >> 4;
    const int K = g.K, nt = K / BK;
    constexpr int XV = (SP2 && !Epi::AFTER_DRAIN) ? Epi::MIN_VM : 0;
    unsigned voffA[2], voffB[2];
#pragma unroll
    for (int i = 0; i < 2; ++i) { int R, C; stage_rc(tid * 16 + i * 8192, R, C); const int Rb = Epi::PERM ? ((R & ~31) + perm32(R & 31)) : R;
        voffA[i] = (unsigned)(R * K + C) * 2u; voffB[i] = (unsigned)(Rb * K + C) * 2u; }
    const unsigned kstep = BK * 2;
    const unsigned hstep = (unsigned)HALF * K * 2;
    const unsigned tstep = 2 * hstep;
    const __amdgpu_buffer_rsrc_t srdA = __builtin_amdgcn_make_buffer_rsrc((void*)g.A, (short)0, (int)((size_t)g.M * K * 2), 0x00020000);
    const __amdgpu_buffer_rsrc_t srdB = __builtin_amdgcn_make_buffer_rsrc((void*)g.Bt, (short)0, (int)((size_t)g.N * K * 2), 0x00020000);
    const unsigned ldsb = (unsigned)(size_t)lds;
    const unsigned ldsw = (unsigned)wid * 1024u;
    const int aoff = lds_byte(wr * 64 + fr, fq * 8), boff = lds_byte(wc * 32 + fr, fq * 8);
#define PG8_SA(b, h) (((b) * 2 + (h)) * HTB)
#define PG8_SB(b, h) ((4 + (b) * 2 + (h)) * HTB)
#define PG8_STAGE(bufoff, srd, soff, voff) do { _Pragma("unroll") for (int _i = 0; _i < 2; ++_i) \
        asm volatile("s_mov_b32 m0, %0\n\ts_nop 0\n\tbuffer_load_dwordx4 %1, %2, %3 offen lds" :: "s"(ldsb + (unsigned)(bufoff) + ldsw + _i * 8192u), "v"((voff)[_i]), "s"(srd), "s"((unsigned)(soff)) : "m0", "memory"); } while (0)
#define PG8_LDA(dst, b, h) do { _Pragma("unroll") for (int m = 0; m < 4; ++m) _Pragma("unroll") for (int k = 0; k < 2; ++k) dst[m][k] = *(const PG8_LAS bf16x8*)(lds + PG8_SA(b, h) + aoff + m * 2048 + k * 1024); } while (0)
#define PG8_LDB(dst, b, h) do { _Pragma("unroll") for (int n = 0; n < 2; ++n) _Pragma("unroll") for (int k = 0; k < 2; ++k) dst[n][k] = *(const PG8_LAS bf16x8*)(lds + PG8_SB(b, h) + boff + n * 2048 + k * 1024); } while (0)
#define PG8_MMA(ai, bj, At, Bt) do { __builtin_amdgcn_s_setprio(1); _Pragma("unroll") for (int m = 0; m < 4; ++m) _Pragma("unroll") for (int n = 0; n < 2; ++n) _Pragma("unroll") for (int k = 0; k < 2; ++k) \
        acc[ai][bj][m][n] = __builtin_amdgcn_mfma_f32_16x16x32_bf16(Bt[n][k], At[m][k], acc[ai][bj][m][n], 0, 0, 0); __builtin_amdgcn_s_setprio(0); } while (0)
#define PG8_WAIT_V(n) asm volatile("s_waitcnt vmcnt(" #n ")" ::: "memory")
#define PG8_WAIT_L(n) asm volatile("s_waitcnt lgkmcnt(" #n ")" ::: "memory")
#define PG8_BAR __builtin_amdgcn_s_barrier()
#define PG8_SCHED __builtin_amdgcn_sched_barrier(0)
    Unit cur, nxt; int ui = 0;
    if (!S.next(0, cur)) return;
    f32x4 acc[2][2][4][2];
#pragma unroll
    for (int a = 0; a < 2; ++a)
#pragma unroll
        for (int b = 0; b < 2; ++b)
#pragma unroll
            for (int m = 0; m < 4; ++m)
#pragma unroll
                for (int n = 0; n < 2; ++n) acc[a][b][m][n] = (f32x4){0.f, 0.f, 0.f, 0.f};
    bf16x8 At[4][2], B0[2][2], B1[2][2];
    unsigned cA = (unsigned)cur.pm * tstep, cB = (unsigned)cur.pn * tstep;
    S.a_ready(cur);
    if constexpr (SP2) {
        PG8_STAGE(PG8_SB(0, 0), srdB, cB, voffB); PG8_STAGE(PG8_SB(0, 1), srdB, cB + hstep, voffB); PG8_STAGE(PG8_SA(0, 0), srdA, cA, voffA); PG8_STAGE(PG8_SA(0, 1), srdA, cA + hstep, voffA);
        if (wr == 1) PG8_BAR;
        PG8_WAIT_V(2); PG8_BAR;
        PG8_STAGE(PG8_SB(1, 0), srdB, cB + kstep, voffB); PG8_STAGE(PG8_SA(1, 0), srdA, cA + kstep, voffA); PG8_STAGE(PG8_SB(1, 1), srdB, cB + hstep + kstep, voffB);
        PG8_WAIT_V(6); PG8_BAR;
        PG8_STAGE(PG8_SA(1, 1), srdA, cA + kstep + hstep, voffA);
        if constexpr (XV > 0) {
            unsigned* sp = g.sink + ((size_t)blockIdx.x * 8 + wid) * 64 + lane; const unsigned zero = 0u;
#pragma unroll
            for (int i = 0; i < XV; ++i) asm volatile("global_store_dword %0, %1, off" :: "v"(sp), "v"(zero) : "memory");
        }
    } else {
        PG8_STAGE(PG8_SB(0, 0), srdB, cB, voffB); PG8_STAGE(PG8_SA(0, 0), srdA, cA, voffA); PG8_STAGE(PG8_SB(0, 1), srdB, cB + hstep, voffB); PG8_STAGE(PG8_SA(0, 1), srdA, cA + hstep, voffA);
        if (wr == 1) PG8_BAR;
        PG8_WAIT_V(4); PG8_BAR;
        PG8_STAGE(PG8_SB(1, 0), srdB, cB + kstep, voffB); PG8_STAGE(PG8_SA(1, 0), srdA, cA + kstep, voffA); PG8_STAGE(PG8_SB(1, 1), srdB, cB + hstep + kstep, voffB);
        PG8_WAIT_V(6); PG8_BAR;
    }
    for (;;) {
        const bool has_next = S.next(ui + 1, nxt);
        const unsigned nA = has_next ? (unsigned)nxt.pm * tstep : cA, nB = has_next ? (unsigned)nxt.pn * tstep : cB;
        if constexpr (SP2) {
#define PG8_PAIR(W3) do { \
            const bool last = (t == nt - 2); \
            const unsigned a2 = last ? nA : cA + (unsigned)(t + 2) * kstep, b2 = last ? nB : cB + (unsigned)(t + 2) * kstep;     \
            const unsigned a3 = a2 + kstep, b3 = b2 + kstep;                                \
            if (last && has_next) S.a_ready(nxt); \
              \
            PG8_LDB(B0, 0, 0); PG8_LDB(B1, 0, 1); PG8_SCHED; PG8_LDA(At, 0, 0); \
            W3; PG8_WAIT_L(0); PG8_BAR; PG8_MMA(0, 0, At, B0); PG8_MMA(0, 1, At, B1); PG8_BAR; PG8_SCHED; \
              \
            PG8_LDA(At, 0, 1); PG8_STAGE(PG8_SB(0, 0), srdB, b2, voffB); PG8_STAGE(PG8_SB(0, 1), srdB, b2 + hstep, voffB); PG8_STAGE(PG8_SA(0, 0), srdA, a2, voffA); \
            W3; PG8_WAIT_L(0); PG8_BAR; PG8_MMA(1, 0, At, B0); PG8_MMA(1, 1, At, B1); PG8_BAR; PG8_SCHED; \
              \
            PG8_LDB(B0, 1, 0); PG8_LDB(B1, 1, 1); PG8_SCHED; PG8_LDA(At, 1, 0); PG8_STAGE(PG8_SA(0, 1), srdA, a2 + hstep, voffA); \
            W3; PG8_WAIT_L(0); PG8_BAR; PG8_MMA(0, 0, At, B0); PG8_MMA(0, 1, At, B1); PG8_BAR; PG8_SCHED; \
              \
            PG8_LDA(At, 1, 1); PG8_STAGE(PG8_SB(1, 0), srdB, b3, voffB); PG8_STAGE(PG8_SB(1, 1), srdB, b3 + hstep, voffB); PG8_STAGE(PG8_SA(1, 0), srdA, a3, voffA); \
            PG8_WAIT_V(8); PG8_WAIT_L(0); PG8_BAR; PG8_MMA(1, 0, At, B0); PG8_MMA(1, 1, At, B1); PG8_BAR; PG8_SCHED; \
            PG8_STAGE(PG8_SA(1, 1), srdA, a3 + hstep, voffA); } while (0)
        { const int t = 0; PG8_PAIR(wait_vm<8 + XV>()); }
        for (int t = 2; t < nt; t += 2) PG8_PAIR(PG8_WAIT_V(8));
#undef PG8_PAIR
        } else {
        for (int t = 0; t < nt; t += 2) {
            const bool last = (t == nt - 2);
            const unsigned a1 = cA + (unsigned)(t + 1) * kstep;
            const unsigned a2 = last ? nA : cA + (unsigned)(t + 2) * kstep, b2 = last ? nB : cB + (unsigned)(t + 2) * kstep;
            const unsigned a3 = a2 + kstep, b3 = b2 + kstep;
            if (last && has_next) S.a_ready(nxt);
            PG8_LDB(B0, 0, 0); PG8_SCHED; PG8_LDA(At, 0, 0); PG8_STAGE(PG8_SA(1, 1), srdA, a1 + hstep, voffA);
            PG8_WAIT_L(8); PG8_BAR; PG8_WAIT_L(0); PG8_MMA(0, 0, At, B0); PG8_BAR; PG8_SCHED;
            PG8_LDB(B1, 0, 1); PG8_STAGE(PG8_SB(0, 0), srdB, b2, voffB);
            PG8_BAR; PG8_WAIT_L(0); PG8_MMA(0, 1, At, B1); PG8_BAR;
            PG8_LDA(At, 0, 1); PG8_STAGE(PG8_SA(0, 0), srdA, a2, voffA);
            PG8_BAR; PG8_WAIT_L(0); PG8_MMA(1, 0, At, B0); PG8_BAR; PG8_SCHED;
            PG8_STAGE(PG8_SB(0, 1), srdB, b2 + hstep, voffB);
            PG8_WAIT_V(6); PG8_BAR; PG8_MMA(1, 1, At, B1); PG8_BAR;
            PG8_LDB(B0, 1, 0); PG8_SCHED; PG8_LDA(At, 1, 0); PG8_STAGE(PG8_SA(0, 1), srdA, a2 + hstep, voffA);
            PG8_WAIT_L(8); PG8_BAR; PG8_WAIT_L(0); PG8_MMA(0, 0, At, B0); PG8_BAR; PG8_SCHED;
            PG8_LDB(B1, 1, 1); PG8_STAGE(PG8_SB(1, 0), srdB, b3, voffB);
            PG8_BAR; PG8_WAIT_L(0); PG8_MMA(0, 1, At, B1); PG8_BAR;
            PG8_LDA(At, 1, 1); PG8_STAGE(PG8_SA(1, 0), srdA, a3, voffA);
            PG8_BAR; PG8_WAIT_L(0); PG8_MMA(1, 0, At, B0); PG8_BAR; PG8_SCHED;
            PG8_STAGE(PG8_SB(1, 1), srdB, b3 + hstep, voffB);
            PG8_WAIT_V(6); PG8_BAR; PG8_MMA(1, 1, At, B1); PG8_BAR;
        }
        }
        if constexpr (ALIGN_EPI) { if (wr == 0) PG8_BAR; }
        if constexpr (!Epi::AFTER_DRAIN) { E(acc, cur, wr, wc, fr, fq); S.done(cur); }
        if (!has_next) break;
#pragma unroll
        for (int a = 0; a < 2; ++a)
#pragma unroll
            for (int b = 0; b < 2; ++b)
#pragma unroll
                for (int m = 0; m < 4; ++m)
#pragma unroll
                    for (int n = 0; n < 2; ++n) acc[a][b][m][n] = (f32x4){0.f, 0.f, 0.f, 0.f};
        cur = nxt; cA = nA; cB = nB; ++ui;
        if constexpr (ALIGN_EPI) { if (wr == 1) PG8_BAR; }
    }
    PG8_WAIT_V(0);
    if constexpr (!ALIGN_EPI) { if (wr == 0) PG8_BAR; }
    PG8_BAR;
    if constexpr (Epi::AFTER_DRAIN) { E.fused(acc, cur, wr, wc, fr, fq, lds, wid, lane); S.done(cur); }
#undef PG8_SA
#undef PG8_SB
#undef PG8_STAGE
#undef PG8_LDA
#undef PG8_LDB
#undef PG8_MMA
#undef PG8_WAIT_V
#undef PG8_WAIT_L
#undef PG8_BAR
#undef PG8_SCHED
}
}

constexpr int NWAVES = 8;
constexpr int NB = 32, SEQ = 2048, DM = 1024, MROWS = NB * SEQ;
constexpr int NPROJ = 3840;
constexpr int C_ZA = 1536, C_QB = 2048, C_ZB = 2560, C_IQ = 3072, C_CKV = 3584, C_IK = 3712;
constexpr float EPSF = 1e-6f;
constexpr float LOG2E = 1.4426950408889634f;
__host__ __device__ __forceinline__ int proj_src_col(int n) {
    if (n < 2048) return n;
    if (n < 2560) return n - 2048 + 2056;
    if (n < 3072) return n - 2560 + 2696;
    if (n < 3584) return n - 3072 + 3208;
    if (n < 3712) return n - 3584 + 2568;
    if (n < 3776) return n - 3712 + 3720;
    if (n < 3784) return n - 3776 + 2048;
    if (n < 3792) return n;
    return -1;
}
__device__ const unsigned char T5_BUCKET[128] = {0,1,2,3,4,5,6,7,8,9,10,11,12,13,14,15,16,16,16,17,17,18,18,18,19,19,19,20,20,20,20,21,21,21,21,22,22,22,22,22,23,23,23,23,23,23,24,24,24,24,24,24,25,25,25,25,25,25,25,26,26,26,26,26,26,26,26,27,27,27,27,27,27,27,27,27,27,28,28,28,28,28,28,28,28,28,28,29,29,29,29,29,29,29,29,29,29,29,29,30,30,30,30,30,30,30,30,30,30,30,30,30,30,31,31,31,31,31,31,31,31,31,31,31,31,31,31,31};

constexpr size_t MiB = 1u << 20;
constexpr size_t WS_CTL = 0, CTL_ZERO_BYTES = 1 * MiB;
constexpr size_t WS_MOD = 1 * MiB;
constexpr size_t WS_WUV = 2 * MiB;
constexpr size_t WS_WOUT = 3 * MiB;
constexpr size_t WS_WIN = 5 * MiB;
constexpr size_t WS_KVSS = 13 * MiB;
constexpr size_t WS_AUX = 14 * MiB;
constexpr size_t WS_XN = 32 * MiB;
constexpr size_t WS_PROJ = 160 * MiB;
constexpr size_t WS_SCR = 640 * MiB;
constexpr size_t WS_END = 768 * MiB;
constexpr int CW_TMO = 0, CW_QUEUE = 64, CW_BAR = 4096;

constexpr int LDS_BYTES = 163840;
constexpr int MISC_OFF = LDS_BYTES - 256;
constexpr int SCRATCH_BYTES = MISC_OFF;

#define GAS __attribute__((address_space(1)))
#define LAS __attribute__((address_space(3)))
typedef unsigned short bf16;
typedef unsigned v4u __attribute__((ext_vector_type(4)));
typedef unsigned v2u __attribute__((ext_vector_type(2)));
typedef float f32x4 __attribute__((ext_vector_type(4)));
typedef float f32x16 __attribute__((ext_vector_type(16)));
typedef short bf16x8 __attribute__((ext_vector_type(8)));
typedef GAS unsigned gu32;
#define RLX_AGENT __ATOMIC_RELAXED, __HIP_MEMORY_SCOPE_AGENT
#define LDS_WAIT() asm volatile("s_waitcnt lgkmcnt(0)" ::: "memory")
#define MFMA32(a, b, c) __builtin_amdgcn_mfma_f32_32x32x16_bf16((a), (b), (c), 0, 0, 0)
#define MFMA16F(a, b, c) __builtin_amdgcn_mfma_f32_16x16x4f32((a), (b), (c), 0, 0, 0)
__device__ __forceinline__ unsigned f2bf(float f) { unsigned u = __builtin_bit_cast(unsigned, f); return (u + 0x7fffu + ((u >> 16) & 1u)) >> 16; }
__device__ __forceinline__ unsigned pk2(float lo, float hi) { return f2bf(lo) | (f2bf(hi) << 16); }
__device__ __forceinline__ float bf2f(unsigned short b) { return __builtin_bit_cast(float, ((unsigned)b) << 16); }
__device__ __forceinline__ float bflo(unsigned w) { return __builtin_bit_cast(float, w << 16); }
__device__ __forceinline__ float bfhi(unsigned w) { return __builtin_bit_cast(float, w & 0xffff0000u); }
__device__ __forceinline__ float rcpf_(float x) { return __builtin_amdgcn_rcpf(x); }
__device__ __forceinline__ float rsqf_(float x) { return __builtin_amdgcn_rsqf(x); }
__device__ __forceinline__ float siluf(float x) { return x * __builtin_amdgcn_rcpf(1.0f + __builtin_amdgcn_exp2f(-1.4426950408889634f * x)); }
__device__ __forceinline__ float wave_sum(float v) {
#pragma unroll
    for (int o = 1; o < 64; o <<= 1) v += __shfl_xor(v, o);
    return v;
}

__device__ __forceinline__ float wave_sum_f(float v) {
#define WSF_(ctl, rm, bm) v += __builtin_bit_cast(float, __builtin_amdgcn_update_dpp(0, __builtin_bit_cast(int, v), ctl, rm, bm, false))
    WSF_(0x111, 0xf, 0xf); WSF_(0x112, 0xf, 0xf); WSF_(0x114, 0xf, 0xe); WSF_(0x118, 0xf, 0xc); WSF_(0x142, 0xa, 0xf); WSF_(0x143, 0xc, 0xf);
#undef WSF_
    return __builtin_bit_cast(float, __builtin_amdgcn_readlane(__builtin_bit_cast(int, v), 63));
}
__device__ __forceinline__ int wave_sum_i(int v) {
    v += __builtin_amdgcn_update_dpp(0, v, 0x111, 0xf, 0xf, false);
    v += __builtin_amdgcn_update_dpp(0, v, 0x112, 0xf, 0xf, false);
    v += __builtin_amdgcn_update_dpp(0, v, 0x114, 0xf, 0xe, false);
    v += __builtin_amdgcn_update_dpp(0, v, 0x118, 0xf, 0xc, false);
    v += __builtin_amdgcn_update_dpp(0, v, 0x142, 0xa, 0xf, false);
    v += __builtin_amdgcn_update_dpp(0, v, 0x143, 0xc, 0xf, false);
    return __builtin_amdgcn_readlane(v, 63);
}
__device__ __forceinline__ float wave_max(float v) {
    const int ninf = (int)0xff800000u;
#define WM_STEP(ctrl, rm, bm) v = fmaxf(v, __builtin_bit_cast(float, __builtin_amdgcn_update_dpp(ninf, __builtin_bit_cast(int, v), ctrl, rm, bm, false)))
    WM_STEP(0x111, 0xf, 0xf); WM_STEP(0x112, 0xf, 0xf); WM_STEP(0x114, 0xf, 0xe); WM_STEP(0x118, 0xf, 0xc); WM_STEP(0x142, 0xa, 0xf); WM_STEP(0x143, 0xc, 0xf);
#undef WM_STEP
    return __builtin_bit_cast(float, __builtin_amdgcn_readlane(__builtin_bit_cast(int, v), 63));
}
#define XB_TMO      128
#define XB_XCNT(j)  (256  + 64 * (j))
#define XB_XSUB(j)  (1280 + 64 * (j))
#define XB_XGEN(j)  (2304 + 64 * (j))
#define XB_TOP      3328
#define XB_TOPGEN   3392
#define XCD_BAR_WORDS 3456
#define XB_SPIN_CAP (1u << 18)

__device__ __forceinline__ unsigned xb_ld(unsigned* p)              { return __hip_atomic_load(p, __ATOMIC_RELAXED, __HIP_MEMORY_SCOPE_AGENT); }
__device__ __forceinline__ unsigned xb_add(unsigned* p, unsigned v) { return __hip_atomic_fetch_add(p, v, __ATOMIC_RELAXED, __HIP_MEMORY_SCOPE_AGENT); }
__device__ __forceinline__ unsigned xb_xcc_id() { return (unsigned)__builtin_amdgcn_s_getreg((3 << 11) | 20) & 0xFu; }
#define XB_SPIN(cond, bar) do { unsigned _sp = 0; while (cond) { __builtin_amdgcn_s_sleep(1); \
    if ((++_sp & 255u) == 0u) { if (xb_ld(&(bar)[XB_TMO])) break; if (_sp > XB_SPIN_CAP) { atomicAdd(&(bar)[XB_TMO], 1u); break; } } } } while (0)

struct XcdBarrier {
    unsigned* bar; unsigned x;
    volatile LAS unsigned* st;
};

__device__ __forceinline__ XcdBarrier xcd_barrier_post(unsigned* bar, volatile LAS unsigned* st) {
    XcdBarrier b; b.bar = bar; b.x = xb_xcc_id(); b.st = st;
    if (threadIdx.x == 0) (void)xb_add(&bar[XB_XCNT(b.x)], 1u);
    return b;
}
__device__ __forceinline__ void xcd_barrier_complete(unsigned* bar, unsigned x, unsigned& nloc, unsigned& nx) {
    const unsigned G = gridDim.x * gridDim.y * gridDim.z;
    unsigned sum, cnt, mine, sp = 0u;
    for (;;) {
        sum = 0u; cnt = 0u; mine = 0u;
#pragma unroll
        for (unsigned j = 0; j < 16; ++j) { const unsigned c = xb_ld(&bar[XB_XCNT(j)]); sum += c; cnt += (c > 0u) ? 1u : 0u; mine = (j == x) ? c : mine; }
        if (sum == G) break;
        __builtin_amdgcn_s_sleep(1);
        if ((++sp & 255u) == 0u) { if (xb_ld(&bar[XB_TMO])) break; if (sp > XB_SPIN_CAP) { atomicAdd(&bar[XB_TMO], 1u); break; } }
    }
    nloc = mine > 0u ? mine : 1u; nx = cnt > 0u ? cnt : 1u;
}

__device__ __forceinline__ void xcd_barrier(const XcdBarrier& b) {
    asm volatile("s_waitcnt vmcnt(0)" ::: "memory");
    __syncthreads();
    if (threadIdx.x == 0) {
        unsigned* bar = b.bar;
        __builtin_amdgcn_s_waitcnt(0);
        unsigned nloc = b.st[0], nx = b.st[1];
        if (nloc == 0u) { xcd_barrier_complete(bar, b.x, nloc, nx); b.st[0] = nloc; b.st[1] = nx; }
        const unsigned old = xb_add(&bar[XB_XSUB(b.x)], 1u);
        const unsigned gen = old / nloc;
        if (old + 1u == (gen + 1u) * nloc) {
            __builtin_amdgcn_fence(__ATOMIC_RELEASE, "agent");
            asm volatile("s_waitcnt vmcnt(0)" ::: "memory");
            const unsigned og = xb_add(&bar[XB_TOP], 1u);
            const unsigned tg = og / nx;
            if (og + 1u == (tg + 1u) * nx) xb_add(&bar[XB_TOPGEN], 1u);
            else XB_SPIN(xb_ld(&bar[XB_TOPGEN]) == tg, bar);
            __builtin_amdgcn_fence(__ATOMIC_ACQUIRE, "agent");
            xb_add(&bar[XB_XGEN(b.x)], 1u);
            asm volatile("s_waitcnt vmcnt(0)" ::: "memory");
        } else {
            XB_SPIN(xb_ld(&bar[XB_XGEN(b.x)]) == gen, bar);
            __builtin_amdgcn_fence(__ATOMIC_ACQUIRE, "agent");
            asm volatile("s_waitcnt vmcnt(0)" ::: "memory");
        }
    }
    __syncthreads();
}

struct Frame {
    LAS unsigned char* lds;
    volatile LAS unsigned* MISC;
    gu32* ctl;
    int tid, lane, wave;
    int vcu, G;
    unsigned char* ws;
};
#define P_X        (args.in[0])
#define P_C        (args.in[1])
#define P_WADA     (args.in[2])
#define P_BADA     (args.in[3])
#define P_GPRE     (args.in[4])
#define P_WIN      (args.in[5])
#define P_CONVW    (args.in[6])
#define P_ALOG     (args.in[7])
#define P_DTB      (args.in[8])
#define P_GGDN     (args.in[9])
#define P_GKV      (args.in[10])
#define P_WUV      (args.in[11])
#define P_RELB     (args.in[12])
#define P_WOUT     (args.in[13])
#define P_GPOST    (args.in[14])
#define P_OUT      (args.out)
#define W_MOD      ((float*)(F.ws + WS_MOD))
#define W_WUVT     ((bf16*)(F.ws + WS_WUV))
#define W_WOUTT    ((bf16*)(F.ws + WS_WOUT))
#define W_WINT     ((bf16*)(F.ws + WS_WIN))
#define W_KVSS     ((float*)(F.ws + WS_KVSS))
#define W_AUX      ((float*)(F.ws + WS_AUX))
#define W_XN       ((bf16*)(F.ws + WS_XN))
#define W_OAB      ((bf16*)(F.ws + WS_XN))
#define W_PROJ     ((bf16*)(F.ws + WS_PROJ))
#define W_MIX      ((bf16*)(F.ws + WS_PROJ))
#define W_SCR      ((float*)(F.ws + WS_SCR))
struct Args { const float* in[15]; float* out; unsigned char* ws; int ph_lo, ph_hi, li, pad; };

template <class CM>
__device__ __forceinline__ void transpose_item(const float* W, int ldw, bf16* WT, int K, int k0, int n0, LAS float* scr, int lane, CM cm) {
    const int nn = lane & 31, sc = cm(n0 + nn);
#pragma unroll 8
    for (int i = 0; i < 32; ++i) { const int kk = 2 * i + (lane >> 5); scr[kk * 33 + nn] = sc >= 0 ? __builtin_nontemporal_load(W + (size_t)(k0 + kk) * ldw + sc) : 0.f; }
    LDS_WAIT(); asm volatile("" ::: "memory");
    const int c = lane & 7;
#pragma unroll
    for (int j = 0; j < 4; ++j) { const int n = (lane >> 3) + 8 * j; const LAS float* s = scr + (8 * c) * 33 + n;
        v4u o; o.x = pk2(s[0 * 33], s[1 * 33]); o.y = pk2(s[2 * 33], s[3 * 33]); o.z = pk2(s[4 * 33], s[5 * 33]); o.w = pk2(s[6 * 33], s[7 * 33]);
        *(GAS v4u*)(WT + (size_t)(n0 + n) * K + k0 + 8 * c) = o; }
    LDS_WAIT(); asm volatile("" ::: "memory");
}
struct CmIdent { __device__ __forceinline__ int operator()(int n) const { return n; } };
struct CmProj { __device__ __forceinline__ int operator()(int n) const { return proj_src_col(n); } };

__device__ __forceinline__ void p0_prologue(Frame& F, const Args& args) {
    LAS float* scr = (LAS float*)(F.lds + F.wave * 16384);
    const int gw = F.vcu * NWAVES + F.wave, NGW = F.G * NWAVES;
    constexpr int I_IN = 16 * (NPROJ / 32), I_OUT = 16 * 32, I_UV = 4 * 2 * 4;
    for (int it = gw; it < I_IN + I_OUT + I_UV; it += NGW) {
        int r = it;
        if (r < I_IN) { const int kb = r / (NPROJ / 32), nb = r % (NPROJ / 32); transpose_item(P_WIN, 3792, W_WINT, 1024, 64 * kb, 32 * nb, scr, F.lane, CmProj()); continue; }
        r -= I_IN;
        if (r < I_OUT) { const int kb = r / 32, nb = r % 32; transpose_item(P_WOUT, 1024, W_WOUTT, 1024, 64 * kb, 32 * nb, scr, F.lane, CmIdent()); continue; }
        r -= I_OUT;
        { const int hd = r >> 3, kb = (r >> 2) & 1, nb = r & 3; transpose_item(P_WUV + (size_t)hd * 16384, 128, W_WUVT + (size_t)hd * 16384, 128, 64 * kb, 32 * nb, scr, F.lane, CmIdent()); }
    }
    __syncthreads();
    if (F.vcu < 192) {
        LAS float* SC = (LAS float*)F.lds;
        for (int e = F.tid; e < NB * 1024; e += NWAVES * 64) { const int b = e >> 10, k = e & 1023; SC[k * 33 + b] = siluf(P_C[e]); }
        __syncthreads();
        const int col = F.tid & 15, ks = F.tid >> 4, n = F.vcu * 16 + col;
        float acc[32];
#pragma unroll
        for (int b = 0; b < 32; ++b) acc[b] = 0.f;
        for (int kk = 0; kk < 32; ++kk) { const int k = ks * 32 + kk; const float w = __builtin_nontemporal_load(P_WADA + (size_t)k * 3072 + n);
#pragma unroll
            for (int b = 0; b < 32; ++b) acc[b] += SC[k * 33 + b] * w; }
        __syncthreads();
        LAS float* RED = (LAS float*)F.lds;
#pragma unroll
        for (int b = 0; b < 32; ++b) RED[(ks * 32 + b) * 16 + col] = acc[b];
        __syncthreads();
        { const int b = F.tid >> 4; float s = 0.f;
            for (int k2 = 0; k2 < 32; ++k2) s += RED[(k2 * 32 + b) * 16 + col];
            W_MOD[b * 3072 + n] = s + P_BADA[n]; }
        __syncthreads();
    }
}

__device__ __forceinline__ void p1_norm(Frame& F, const Args& args) {
    const int gw = F.vcu * NWAVES + F.wave, NGW = F.G * NWAVES;
    for (int m = 2 * gw; m < MROWS; m += 2 * NGW) {
        const int b = m >> 11;
        const GAS f32x4* xr = (const GAS f32x4*)(P_X + (size_t)m * DM) + F.lane;
        f32x4 v[2][4]; float ss[2] = {0.f, 0.f};
#pragma unroll
        for (int q = 0; q < 2; ++q)
#pragma unroll
            for (int j = 0; j < 4; ++j) v[q][j] = __builtin_nontemporal_load(xr + q * 256 + 64 * j);
#pragma unroll
        for (int q = 0; q < 2; ++q)
#pragma unroll
            for (int j = 0; j < 4; ++j) ss[q] += (v[q][j].x * v[q][j].x + v[q][j].y * v[q][j].y) + (v[q][j].z * v[q][j].z + v[q][j].w * v[q][j].w);
        const float rstd0 = rsqf_(wave_sum(ss[0]) * (1.0f / DM) + EPSF), rstd1 = rsqf_(wave_sum(ss[1]) * (1.0f / DM) + EPSF);
        const float* mb = W_MOD + b * 3072;
        GAS unsigned long long* o8 = (GAS unsigned long long*)(W_XN + (size_t)m * DM) + F.lane;
#pragma unroll
        for (int j = 0; j < 4; ++j) { const int col = F.lane * 4 + 256 * j;
            const f32x4 g = *(const f32x4*)(P_GPRE + col), sh = *(const f32x4*)(mb + col), sc = *(const f32x4*)(mb + 1024 + col);
            const f32x4 gs = g * (sc + 1.0f);
            const f32x4 o0 = v[0][j] * rstd0 * gs + sh, o1 = v[1][j] * rstd1 * gs + sh;
            o8[64 * j] = (unsigned long long)pg8::cvt_pk_bf16(o0.x, o0.y) | ((unsigned long long)pg8::cvt_pk_bf16(o0.z, o0.w) << 32);
            o8[256 + 64 * j] = (unsigned long long)pg8::cvt_pk_bf16(o1.x, o1.y) | ((unsigned long long)pg8::cvt_pk_bf16(o1.z, o1.w) << 32); }
    }
}

__device__ __forceinline__ void p5_final(Frame& F, const Args& args) {
    const int gw = F.vcu * NWAVES + F.wave, NGW = F.G * NWAVES;
    for (int m = 2 * gw; m < MROWS; m += 2 * NGW) {
        const int b = m >> 11;
        const GAS v2u* mr = (const GAS v2u*)(W_MIX + (size_t)m * DM) + F.lane;
        const GAS f32x4* xr = (const GAS f32x4*)(P_X + (size_t)m * DM) + F.lane;
        GAS f32x4* orow = (GAS f32x4*)(P_OUT + (size_t)m * DM) + F.lane;
        v2u w[2][4]; f32x4 xv[2][4];
#pragma unroll
        for (int q = 0; q < 2; ++q)
#pragma unroll
            for (int j = 0; j < 4; ++j) { w[q][j] = mr[q * 256 + 64 * j]; xv[q][j] = __builtin_nontemporal_load(xr + q * 256 + 64 * j); }
        f32x4 v[2][4]; float ss[2] = {0.f, 0.f};
#pragma unroll
        for (int q = 0; q < 2; ++q)
#pragma unroll
            for (int j = 0; j < 4; ++j) { v[q][j].x = bflo(w[q][j].x); v[q][j].y = bfhi(w[q][j].x); v[q][j].z = bflo(w[q][j].y); v[q][j].w = bfhi(w[q][j].y);
                ss[q] += (v[q][j].x * v[q][j].x + v[q][j].y * v[q][j].y) + (v[q][j].z * v[q][j].z + v[q][j].w * v[q][j].w); }
        const float rstd0 = rsqf_(wave_sum(ss[0]) * (1.0f / DM) + EPSF), rstd1 = rsqf_(wave_sum(ss[1]) * (1.0f / DM) + EPSF);
        const float* gt = W_MOD + b * 3072 + 2048;
#pragma unroll
        for (int j = 0; j < 4; ++j) { const int col = F.lane * 4 + 256 * j;
            const f32x4 g = *(const f32x4*)(P_GPOST + col), ga = *(const f32x4*)(gt + col);
            const f32x4 gg = g * ga;
            __builtin_nontemporal_store(xv[0][j] + gg * (v[0][j] * rstd0), orow + 64 * j);
            __builtin_nontemporal_store(xv[1][j] + gg * (v[1][j] * rstd1), orow + 256 + 64 * j); }
    }
}

__device__ __forceinline__ unsigned cvtpk(float lo, float hi) { return pg8::cvt_pk_bf16(lo, hi); }
__device__ __forceinline__ v2u pack4(float a, float b, float c, float d) { v2u r; r.x = cvtpk(a, b); r.y = cvtpk(c, d); return r; }
__device__ __forceinline__ bf16x8 pack8(float a, float b, float c, float d, float e, float f, float g, float h) { v4u r; r.x = cvtpk(a, b); r.y = cvtpk(c, d); r.z = cvtpk(e, f); r.w = cvtpk(g, h); return __builtin_bit_cast(bf16x8, r); }
__device__ __forceinline__ bf16x8 lds16(const LAS unsigned char* p) { return *(const LAS bf16x8*)p; }
__device__ __forceinline__ bf16x8 lds8x2(const LAS unsigned char* p) { const v2u lo = *(const LAS v2u*)p, hi = *(const LAS v2u*)(p + 16); v4u r; r.x = lo.x; r.y = lo.y; r.z = hi.x; r.w = hi.y; return __builtin_bit_cast(bf16x8, r); }
template <int S> __device__ __forceinline__ bf16x8 acc_frag(const f32x16& a) { return pack8(a[8 * S + 0], a[8 * S + 1], a[8 * S + 2], a[8 * S + 3], a[8 * S + 4], a[8 * S + 5], a[8 * S + 6], a[8 * S + 7]); }

__device__ __forceinline__ float row16_sum(float v) {
#define R16_STEP(ctrl) v += __builtin_bit_cast(float, __builtin_amdgcn_update_dpp(0, __builtin_bit_cast(int, v), ctrl, 0xf, 0xf, false))
    R16_STEP(0x121); R16_STEP(0x122); R16_STEP(0x124); R16_STEP(0x128);
#undef R16_STEP
    return v;
}

__device__ __forceinline__ void gdn_unit(Frame& F, const Args& args, const int b, const int h) {
    LAS unsigned char* const L = F.lds;
    const int tid = F.tid, lane = F.lane, wv = F.wave, l31_0 = lane & 31, hh_0 = lane >> 5;
    int tidv = tid, lanev = lane;
    constexpr int P128 = 272, P64 = 144;
    constexpr int O_KH = 0, O_QH = O_KH + 17408, O_KGT = O_QH + 17408, O_VBT = O_KGT + 18432, O_KBGT = O_VBT + 18432, O_LM = O_KBGT + 18432, O_T = O_LM + 17408,
                  O_AT = O_T + 17408, O_CW = O_AT + 9216, O_SM = O_CW + 6144, O_PSO = O_SM + 2560, O_OF = O_PSO + 2048, O_END = O_OF + 17408;
    static_assert(O_END <= SCRATCH_BYTES, "gdn LDS map");
    constexpr int O_W = O_LM, O_VNT = O_VBT;
    LAS float* const SMb = (LAS float*)(L + O_SM);
    LAS float* const LM = (LAS float*)(L + O_LM);
    LAS float* const TT = (LAS float*)(L + O_T);
    LAS float* const CW = (LAS float*)(L + O_CW);
    LAS float* const PSO = (LAS float*)(L + O_PSO);
    const int mt = wv >> 2, nt = wv & 3;
    f32x16 S[4];
#pragma unroll
    for (int k = 0; k < 4; ++k)
#pragma unroll
        for (int r = 0; r < 16; ++r) S[k][r] = 0.f;
    const float alog_e = __expf(P_ALOG[h]), dtb = P_DTB[h];
#define GDN_GATES(n_) do { LAS float* _sm = SMb + ((n_) & 1) * 320; const float* _ap = W_AUX + (size_t)(b * SEQ + (n_) * 64 + lanev) * 16; \
        const float _bb = _ap[h], _aa = _ap[4 + h]; const float _beta = rcpf_(1.0f + __expf(-_bb)); const float _xs = _aa + dtb; \
        const float _sp = _xs > 20.f ? _xs : log1pf(__expf(_xs)); float _gc = -alog_e * _sp; \
        _Pragma("unroll") for (int _o = 1; _o < 64; _o <<= 1) { const float _t = __shfl_up(_gc, _o); if (lanev >= _o) _gc += _t; } \
        const float _gl = __shfl(_gc, 63); _sm[lanev] = _gc; _sm[64 + lanev] = _beta; _sm[128 + lanev] = __expf(_gc); _sm[192 + lanev] = __expf(_gl - _gc); \
        if (lanev == 0) _sm[256] = __expf(_gl); } while (0)
    if (wv == 6) GDN_GATES(0);
    for (int e = tidv; e < 3 * 4 * 128; e += NWAVES * 64) { const int ts_ = e >> 9, tap = (e >> 7) & 3, ch = e & 127; CW[e] = P_CONVW[tap * 1536 + ts_ * 512 + h * 128 + ch]; }
    const int ts = tid >> 8;
    int cgv = tid & 15, tpv = (tid >> 4) & 15;
#define GDN_ROWS(dst_, n_, chan_) do { const bf16* _src = W_PROJ + (size_t)(b * SEQ + (n_) * 64 + 4 * tpv - 3) * NPROJ + (chan_); \
        _Pragma("unroll") for (int _i = 0; _i < 7; ++_i) { v4u _z; _z.x = 0u; _z.y = 0u; _z.z = 0u; _z.w = 0u; dst_[_i] = _z; \
            if ((n_) > 0 || 4 * tpv - 3 + _i >= 0) dst_[_i] = *(const GAS v4u*)(_src + (size_t)_i * NPROJ); } } while (0)
#define GDN_OUT(rowb_) do { const int _tok = tidv >> 3, _dv0 = (tidv & 7) * 16; const size_t _row = (size_t)(rowb_) + _tok; \
        const LAS v4u* _op = (const LAS v4u*)(L + O_OF + _tok * P128 + _dv0 * 2); const v4u _o0 = _op[0], _o1 = _op[1]; \
        const LAS f32x4* _pp = (const LAS f32x4*)(PSO + _tok * 8); const f32x4 _a = _pp[0], _c = _pp[1]; \
        const float _rstd = rsqf_((((_a.x + _a.y) + (_a.z + _a.w)) + ((_c.x + _c.y) + (_c.z + _c.w))) * (1.0f / 128.0f) + EPSF); \
        const bf16* _zp = W_PROJ + _row * NPROJ + C_ZA + h * 128 + _dv0; const v4u _z0 = *(const GAS v4u*)_zp, _z1 = *(const GAS v4u*)(_zp + 8); \
        const unsigned _ow[8] = {_o0.x, _o0.y, _o0.z, _o0.w, _o1.x, _o1.y, _o1.z, _o1.w}, _zw[8] = {_z0.x, _z0.y, _z0.z, _z0.w, _z1.x, _z1.y, _z1.z, _z1.w}; unsigned _rw[8]; \
        _Pragma("unroll") for (int _k = 0; _k < 4; ++_k) { const f32x4 _g = *(const f32x4*)(P_GGDN + _dv0 + 4 * _k); \
            _rw[2 * _k] = cvtpk(bflo(_ow[2 * _k]) * _rstd * _g.x * siluf(bflo(_zw[2 * _k])), bfhi(_ow[2 * _k]) * _rstd * _g.y * siluf(bfhi(_zw[2 * _k]))); \
            _rw[2 * _k + 1] = cvtpk(bflo(_ow[2 * _k + 1]) * _rstd * _g.z * siluf(bflo(_zw[2 * _k + 1])), bfhi(_ow[2 * _k + 1]) * _rstd * _g.w * siluf(bfhi(_zw[2 * _k + 1]))); } \
        bf16* _dst = W_OAB + _row * DM + h * 128 + _dv0; v4u _w0, _w1; _w0.x = _rw[0]; _w0.y = _rw[1]; _w0.z = _rw[2]; _w0.w = _rw[3]; _w1.x = _rw[4]; _w1.y = _rw[5]; _w1.z = _rw[6]; _w1.w = _rw[7]; \
        *(GAS v4u*)_dst = _w0; *(GAS v4u*)(_dst + 8) = _w1; } while (0)
    __syncthreads();

    unsigned pf_sink = 0u;
    for (int n = 0; n < 32; ++n) {
        const int rowbase = b * SEQ + n * 64;
        LAS float* const SMf = SMb + (n & 1) * 320;
        tidv = tid; lanev = lane; cgv = tid & 15; tpv = (tid >> 4) & 15;
        asm volatile("" : "+v"(tidv), "+v"(lanev), "+v"(cgv), "+v"(tpv));
        int l31 = lanev & 31, hh = lanev >> 5, cg = cgv, tp = tpv;
        if (wv == 6 && n + 1 < 32) GDN_GATES(n + 1);
        float val[4][8];
#define GDN_CONV(rows_, tsel_) do { \
            _Pragma("unroll") for (int _j = 0; _j < 4; ++_j) _Pragma("unroll") for (int _e = 0; _e < 8; ++_e) val[_j][_e] = 0.f; \
            _Pragma("unroll") for (int _tap = 0; _tap < 4; ++_tap) { const LAS f32x4* _cp = (const LAS f32x4*)(CW + ((tsel_) * 4 + _tap) * 128 + cg * 8); const f32x4 _c0 = _cp[0], _c1 = _cp[1]; \
                const float _cw[8] = {_c0.x, _c0.y, _c0.z, _c0.w, _c1.x, _c1.y, _c1.z, _c1.w}; \
                _Pragma("unroll") for (int _j = 0; _j < 4; ++_j) { const v4u _raw = rows_[_j + _tap]; \
                    const float _in[8] = {bflo(_raw.x), bfhi(_raw.x), bflo(_raw.y), bfhi(_raw.y), bflo(_raw.z), bfhi(_raw.z), bflo(_raw.w), bfhi(_raw.w)}; \
                    _Pragma("unroll") for (int _e = 0; _e < 8; ++_e) val[_j][_e] += _in[_e] * _cw[_e]; } } \
            _Pragma("unroll") for (int _j = 0; _j < 4; ++_j) _Pragma("unroll") for (int _e = 0; _e < 8; ++_e) val[_j][_e] = siluf(val[_j][_e]); } while (0)
        v4u rq[7], rv[7];
        GDN_ROWS(rq, n, ts * 512 + h * 128 + cgv * 8);
        if (wv < 4) GDN_ROWS(rv, n, 1024 + h * 128 + cgv * 8);
        if (wv == 7 && n + 1 < 32) {
#pragma unroll
            for (int i = 0; i < 9; ++i) { const int idx = i * 64 + lanev; const int rr = idx >> 3, ln = idx & 7;
                if (idx < 67 * 8) { const bf16* pt = W_PROJ + (size_t)(rowbase + 61 + rr) * NPROJ + (ln >> 1) * 512 + h * 128 + (ln & 1) * 64;
                    asm volatile("global_load_dword %0, %1, off" : "+v"(pf_sink) : "v"(pt) : "memory"); } }
        }
        {
            GDN_CONV(rq, ts);
#pragma unroll
            for (int j = 0; j < 4; ++j) { float ss = 0.f;
#pragma unroll
                for (int e = 0; e < 8; ++e) ss += val[j][e] * val[j][e];
                ss = row16_sum(ss);
                float r = rsqf_(ss + EPSF); if (ts == 0) r *= 0.08838834764831845f;
#pragma unroll
                for (int e = 0; e < 8; ++e) val[j][e] *= r; }
            if (ts == 0) {
#pragma unroll
                for (int j = 0; j < 4; ++j) *(LAS bf16x8*)(L + O_QH + (4 * tp + j) * P128 + cg * 16) = pack8(val[j][0], val[j][1], val[j][2], val[j][3], val[j][4], val[j][5], val[j][6], val[j][7]);
            } else {
                float ek[4], bg[4];
#pragma unroll
                for (int j = 0; j < 4; ++j) { ek[j] = SMf[192 + 4 * tp + j]; bg[j] = SMf[64 + 4 * tp + j] * SMf[128 + 4 * tp + j]; }
#pragma unroll
                for (int j = 0; j < 4; ++j) *(LAS bf16x8*)(L + O_KH + (4 * tp + j) * P128 + cg * 16) = pack8(val[j][0], val[j][1], val[j][2], val[j][3], val[j][4], val[j][5], val[j][6], val[j][7]);
#pragma unroll
                for (int e = 0; e < 8; ++e) {
                    *(LAS v2u*)(L + O_KGT + (cg * 8 + e) * P64 + tp * 8) = pack4(val[0][e] * ek[0], val[1][e] * ek[1], val[2][e] * ek[2], val[3][e] * ek[3]);
                    *(LAS v2u*)(L + O_KBGT + (cg * 8 + e) * P64 + tp * 8) = pack4(val[0][e] * bg[0], val[1][e] * bg[1], val[2][e] * bg[2], val[3][e] * bg[3]); }
            }
        }
        if (n > 0) GDN_OUT(rowbase - 64);
        if (wv < 4) {
            GDN_CONV(rv, 2);
            float be[4];
#pragma unroll
            for (int j = 0; j < 4; ++j) be[j] = SMf[64 + 4 * tp + j];
#pragma unroll
            for (int e = 0; e < 8; ++e) *(LAS v2u*)(L + O_VBT + (cg * 8 + e) * P64 + tp * 8) = pack4(val[0][e] * be[0], val[1][e] * be[1], val[2][e] * be[2], val[3][e] * be[3]);
        }
        for (int e = tidv; e < 64 * 68; e += NWAVES * 64) TT[e] = 0.f;
        __syncthreads();
        if (wv < 4) {
            const int ti = wv >> 1, tj = wv & 1;
            f32x16 C;
#pragma unroll
            for (int r = 0; r < 16; ++r) C[r] = 0.f;
            if (ti >= tj) {
                bf16x8 fa[8], fb[8];
#pragma unroll
                for (int s = 0; s < 8; ++s) { fa[s] = lds16(L + O_KH + (32 * ti + l31) * P128 + (16 * s + 8 * hh) * 2); fb[s] = lds16(L + O_KH + (32 * tj + l31) * P128 + (16 * s + 8 * hh) * 2); }
                __builtin_amdgcn_sched_barrier(0);
#pragma unroll
                for (int s = 0; s < 8; ++s) C = MFMA32(fa[s], fb[s], C);
            }
            const int j = 32 * tj + l31; const float gcj = SMf[j];
#pragma unroll
            for (int g = 0; g < 4; ++g) { const int ib = 32 * ti + 8 * g + 4 * hh; const f32x4 gci = *(const LAS f32x4*)(SMf + ib), bei = *(const LAS f32x4*)(SMf + 64 + ib);
#pragma unroll
                for (int e = 0; e < 4; ++e) { const int i = ib + e; LM[i * 68 + j] = (i > j) ? bei[e] * C[4 * g + e] * __expf(gci[e] - gcj) : 0.f; } }
            if (ti == tj) {
                asm volatile("s_waitcnt lgkmcnt(0)" ::: "memory");
                const int a = 2 * ti, bq = 2 * ti + 1;
                if (lanev < 32) {
                    const int blk = a + (lanev >> 4), c = lanev & 15; float x[16];
    #pragma unroll
                    for (int i = 0; i < 16; ++i) { const LAS float* lr = LM + (16 * blk + i) * 68 + 16 * blk; float acc = (i == c) ? 1.f : 0.f;
    #pragma unroll
                        for (int j = 0; j < i; ++j) acc -= lr[j] * x[j];
                        x[i] = acc; TT[(16 * blk + i) * 68 + 16 * blk + c] = acc; }
                }
                asm volatile("s_waitcnt lgkmcnt(0)" ::: "memory");
                const int m = lanev & 15, q = lanev >> 4;
                f32x4 P = {0.f, 0.f, 0.f, 0.f}, R = {0.f, 0.f, 0.f, 0.f};
    #pragma unroll
                for (int s = 0; s < 4; ++s) { const int k = q + 4 * s; P = MFMA16F(LM[(16 * bq + m) * 68 + 16 * a + k], TT[(16 * a + k) * 68 + 16 * a + m], P); }
    #pragma unroll
                for (int rg = 0; rg < 4; ++rg) { const int k = 4 * q + rg; R = MFMA16F(TT[(16 * bq + m) * 68 + 16 * bq + k], P[rg], R); }
    #pragma unroll
                for (int rg = 0; rg < 4; ++rg) TT[(16 * bq + 4 * q + rg) * 68 + 16 * a + m] = -R[rg];
            }
        } else {
            const int w4 = wv - 4, tj = w4 >> 1, ti = w4 & 1;
            f32x16 C;
#pragma unroll
            for (int r = 0; r < 16; ++r) C[r] = 0.f;
            if (ti >= tj) {
                bf16x8 fa[8], fb[8];
#pragma unroll
                for (int s = 0; s < 8; ++s) { fa[s] = lds16(L + O_KH + (32 * tj + l31) * P128 + (16 * s + 8 * hh) * 2); fb[s] = lds16(L + O_QH + (32 * ti + l31) * P128 + (16 * s + 8 * hh) * 2); }
                __builtin_amdgcn_sched_barrier(0);
#pragma unroll
                for (int s = 0; s < 8; ++s) C = MFMA32(fa[s], fb[s], C);
            }
            const int i = 32 * ti + l31; const float gci = SMf[i];
#pragma unroll
            for (int g = 0; g < 4; ++g) { const int jb = 32 * tj + 8 * g + 4 * hh; const f32x4 gcj = *(const LAS f32x4*)(SMf + jb); float v[4];
#pragma unroll
                for (int e = 0; e < 4; ++e) v[e] = (i >= jb + e) ? C[4 * g + e] * __expf(gci - gcj[e]) : 0.f;
                *(LAS v2u*)(L + O_AT + i * P64 + jb * 2) = pack4(v[0], v[1], v[2], v[3]); }
        }
        __syncthreads();
        if (wv < 4) {
            const int m = lanev & 15, q = lanev >> 4, mi = wv >> 1, ni = wv & 1;
            f32x4 P0 = {0.f, 0.f, 0.f, 0.f}, P1 = {0.f, 0.f, 0.f, 0.f}, R = {0.f, 0.f, 0.f, 0.f};
            float bt[8], l0[8], l1[8], t0[4], t1[4];
#pragma unroll
            for (int s = 0; s < 8; ++s) { const int k = q + 4 * s; bt[s] = TT[k * 68 + 16 * ni + m]; l0[s] = LM[(32 + m) * 68 + k]; l1[s] = LM[(48 + m) * 68 + k]; }
#pragma unroll
            for (int rg = 0; rg < 4; ++rg) { t0[rg] = TT[(32 + 16 * mi + m) * 68 + 32 + 4 * q + rg]; t1[rg] = TT[(32 + 16 * mi + m) * 68 + 48 + 4 * q + rg]; }
            __builtin_amdgcn_sched_barrier(0);
#pragma unroll
            for (int s = 0; s < 8; ++s) { P0 = MFMA16F(l0[s], bt[s], P0); P1 = MFMA16F(l1[s], bt[s], P1); }
#pragma unroll
            for (int rg = 0; rg < 4; ++rg) { R = MFMA16F(t0[rg], P0[rg], R); R = MFMA16F(t1[rg], P1[rg], R); }
#pragma unroll
            for (int rg = 0; rg < 4; ++rg) TT[(32 + 16 * mi + 4 * q + rg) * 68 + 16 * ni + m] = -R[rg];
        }
        __syncthreads();
        f32x16 U, WT_;
#pragma unroll
        for (int r = 0; r < 16; ++r) { U[r] = 0.f; WT_[r] = 0.f; }
        {
            f32x4 tq0[4], tq1[4]; bf16x8 fv[4], fk[4];
#pragma unroll
            for (int s = 0; s < 4; ++s) { const LAS f32x4* tp4 = (const LAS f32x4*)(TT + (32 * mt + l31) * 68 + 16 * s + 8 * hh); tq0[s] = tp4[0]; tq1[s] = tp4[1];
                fv[s] = lds16(L + O_VBT + (32 * nt + l31) * P64 + (16 * s + 8 * hh) * 2); fk[s] = lds16(L + O_KBGT + (32 * nt + l31) * P64 + (16 * s + 8 * hh) * 2); }
            __builtin_amdgcn_sched_barrier(0);
#pragma unroll
            for (int s = 0; s < 4; ++s) { const bf16x8 a = pack8(tq0[s].x, tq0[s].y, tq0[s].z, tq0[s].w, tq1[s].x, tq1[s].y, tq1[s].z, tq1[s].w);
                U = MFMA32(a, fv[s], U); WT_ = MFMA32(fk[s], a, WT_); }
        }
#pragma unroll
        for (int g = 0; g < 4; ++g) *(LAS v2u*)(L + O_W + (32 * mt + l31) * P128 + (32 * nt + 8 * g + 4 * hh) * 2) = pack4(-WT_[4 * g], -WT_[4 * g + 1], -WT_[4 * g + 2], -WT_[4 * g + 3]);
        __syncthreads();
        bf16x8 sf[4][2];
#pragma unroll
        for (int kt = 0; kt < 4; ++kt) { sf[kt][0] = acc_frag<0>(S[kt]); sf[kt][1] = acc_frag<1>(S[kt]); }
        {
            bf16x8 fw[4][2];
#pragma unroll
            for (int kt = 0; kt < 4; ++kt)
#pragma unroll
                for (int s = 0; s < 2; ++s) fw[kt][s] = lds8x2(L + O_W + (32 * mt + l31) * P128 + (32 * kt + 16 * s + 4 * hh) * 2);
            __builtin_amdgcn_sched_barrier(0);
#pragma unroll
            for (int kt = 0; kt < 4; ++kt)
#pragma unroll
                for (int s = 0; s < 2; ++s) U = MFMA32(fw[kt][s], sf[kt][s], U);
        }
#pragma unroll
        for (int g = 0; g < 4; ++g) *(LAS v2u*)(L + O_VNT + (32 * nt + l31) * P64 + (32 * mt + 8 * g + 4 * hh) * 2) = pack4(U[4 * g], U[4 * g + 1], U[4 * g + 2], U[4 * g + 3]);
        __syncthreads();
        {
            f32x16 Oa;
#pragma unroll
            for (int r = 0; r < 16; ++r) Oa[r] = 0.f;
            bf16x8 vn[4], fat[4], fg[4]; f32x4 e4[4];
            {
                bf16x8 fq[4][2];
#pragma unroll
                for (int kt = 0; kt < 4; ++kt)
#pragma unroll
                    for (int s = 0; s < 2; ++s) fq[kt][s] = lds8x2(L + O_QH + (32 * mt + l31) * P128 + (32 * kt + 16 * s + 4 * hh) * 2);
                __builtin_amdgcn_sched_barrier(0);
#pragma unroll
                for (int kt = 0; kt < 4; ++kt)
#pragma unroll
                    for (int s = 0; s < 2; ++s) Oa = MFMA32(fq[kt][s], sf[kt][s], Oa);
            }
#pragma unroll
            for (int g = 0; g < 4; ++g) e4[g] = *(const LAS f32x4*)(SMf + 128 + 32 * mt + 8 * g + 4 * hh);
#pragma unroll
            for (int s = 0; s < 4; ++s) { vn[s] = lds16(L + O_VNT + (32 * nt + l31) * P64 + (16 * s + 8 * hh) * 2); fat[s] = lds16(L + O_AT + (32 * mt + l31) * P64 + (16 * s + 8 * hh) * 2); }
            const float glast = SMf[256];
#pragma unroll
            for (int s = 0; s < 4; ++s) fg[s] = lds16(L + O_KGT + l31 * P64 + (16 * s + 8 * hh) * 2);
            __builtin_amdgcn_sched_barrier(0);
#pragma unroll
            for (int g = 0; g < 4; ++g)
#pragma unroll
                for (int e = 0; e < 4; ++e) Oa[4 * g + e] *= e4[g][e];
#pragma unroll
            for (int s = 0; s < 4; ++s) Oa = MFMA32(fat[s], vn[s], Oa);
#pragma unroll
            for (int kt = 0; kt < 4; ++kt) {
#pragma unroll
                for (int r = 0; r < 16; ++r) S[kt][r] *= glast;
#pragma unroll
                for (int s = 0; s < 4; ++s) S[kt] = MFMA32(fg[s], vn[s], S[kt]);
                if (kt < 3) {
#pragma unroll
                    for (int s = 0; s < 4; ++s) fg[s] = lds16(L + O_KGT + (32 * (kt + 1) + l31) * P64 + (16 * s + 8 * hh) * 2);
                }
            }
#pragma unroll
            for (int r = 0; r < 16; ++r) { const float q2 = row16_sum(Oa[r] * Oa[r]);
                if ((lanev & 15) == 0) PSO[(32 * mt + 8 * (r >> 2) + 4 * hh + (r & 3)) * 8 + 2 * nt + ((lanev >> 4) & 1)] = q2;
                *(LAS unsigned short*)(L + O_OF + (32 * mt + 8 * (r >> 2) + 4 * hh + (r & 3)) * P128 + (32 * nt + l31) * 2) = (unsigned short)cvtpk(Oa[r], 0.f); }
        }
        asm volatile("s_waitcnt vmcnt(0)" : "+v"(pf_sink) :: "memory");
        __syncthreads();
    }
    GDN_OUT(b * SEQ + 31 * 64);
    __syncthreads();
#undef GDN_GATES
#undef GDN_CONV
#undef GDN_ROWS
#undef GDN_OUT
}

typedef short s16x4 __attribute__((ext_vector_type(4)));
__device__ __forceinline__ bf16x8 ldstr8(const LAS unsigned char* p0, const LAS unsigned char* p1) {
    const s16x4 a = __builtin_amdgcn_ds_read_tr16_b64_v4i16((LAS s16x4*)p0), b = __builtin_amdgcn_ds_read_tr16_b64_v4i16((LAS s16x4*)p1);
    bf16x8 r; r[0] = a[0]; r[1] = a[1]; r[2] = a[2]; r[3] = a[3]; r[4] = b[0]; r[5] = b[1]; r[6] = b[2]; r[7] = b[3]; return r;
}
__device__ __forceinline__ void wrlane(unsigned& dst, const unsigned val, const int idx) {
    switch (idx) {
    case 0: asm("s_nop 1\n\tv_writelane_b32 %0, %1, 0" : "+v"(dst) : "s"(val)); break;
    case 1: asm("s_nop 1\n\tv_writelane_b32 %0, %1, 1" : "+v"(dst) : "s"(val)); break;
    case 2: asm("s_nop 1\n\tv_writelane_b32 %0, %1, 2" : "+v"(dst) : "s"(val)); break;
    case 3: asm("s_nop 1\n\tv_writelane_b32 %0, %1, 3" : "+v"(dst) : "s"(val)); break;
    case 4: asm("s_nop 1\n\tv_writelane_b32 %0, %1, 4" : "+v"(dst) : "s"(val)); break;
    case 5: asm("s_nop 1\n\tv_writelane_b32 %0, %1, 5" : "+v"(dst) : "s"(val)); break;
    case 6: asm("s_nop 1\n\tv_writelane_b32 %0, %1, 6" : "+v"(dst) : "s"(val)); break;
    case 7: asm("s_nop 1\n\tv_writelane_b32 %0, %1, 7" : "+v"(dst) : "s"(val)); break;
    case 8: asm("s_nop 1\n\tv_writelane_b32 %0, %1, 8" : "+v"(dst) : "s"(val)); break;
    case 9: asm("s_nop 1\n\tv_writelane_b32 %0, %1, 9" : "+v"(dst) : "s"(val)); break;
    case 10: asm("s_nop 1\n\tv_writelane_b32 %0, %1, 10" : "+v"(dst) : "s"(val)); break;
    case 11: asm("s_nop 1\n\tv_writelane_b32 %0, %1, 11" : "+v"(dst) : "s"(val)); break;
    case 12: asm("s_nop 1\n\tv_writelane_b32 %0, %1, 12" : "+v"(dst) : "s"(val)); break;
    case 13: asm("s_nop 1\n\tv_writelane_b32 %0, %1, 13" : "+v"(dst) : "s"(val)); break;
    case 14: asm("s_nop 1\n\tv_writelane_b32 %0, %1, 14" : "+v"(dst) : "s"(val)); break;
    case 15: asm("s_nop 1\n\tv_writelane_b32 %0, %1, 15" : "+v"(dst) : "s"(val)); break;
    case 16: asm("s_nop 1\n\tv_writelane_b32 %0, %1, 16" : "+v"(dst) : "s"(val)); break;
    case 17: asm("s_nop 1\n\tv_writelane_b32 %0, %1, 17" : "+v"(dst) : "s"(val)); break;
    case 18: asm("s_nop 1\n\tv_writelane_b32 %0, %1, 18" : "+v"(dst) : "s"(val)); break;
    case 19: asm("s_nop 1\n\tv_writelane_b32 %0, %1, 19" : "+v"(dst) : "s"(val)); break;
    case 20: asm("s_nop 1\n\tv_writelane_b32 %0, %1, 20" : "+v"(dst) : "s"(val)); break;
    case 21: asm("s_nop 1\n\tv_writelane_b32 %0, %1, 21" : "+v"(dst) : "s"(val)); break;
    case 22: asm("s_nop 1\n\tv_writelane_b32 %0, %1, 22" : "+v"(dst) : "s"(val)); break;
    case 23: asm("s_nop 1\n\tv_writelane_b32 %0, %1, 23" : "+v"(dst) : "s"(val)); break;
    case 24: asm("s_nop 1\n\tv_writelane_b32 %0, %1, 24" : "+v"(dst) : "s"(val)); break;
    case 25: asm("s_nop 1\n\tv_writelane_b32 %0, %1, 25" : "+v"(dst) : "s"(val)); break;
    case 26: asm("s_nop 1\n\tv_writelane_b32 %0, %1, 26" : "+v"(dst) : "s"(val)); break;
    case 27: asm("s_nop 1\n\tv_writelane_b32 %0, %1, 27" : "+v"(dst) : "s"(val)); break;
    case 28: asm("s_nop 1\n\tv_writelane_b32 %0, %1, 28" : "+v"(dst) : "s"(val)); break;
    case 29: asm("s_nop 1\n\tv_writelane_b32 %0, %1, 29" : "+v"(dst) : "s"(val)); break;
    case 30: asm("s_nop 1\n\tv_writelane_b32 %0, %1, 30" : "+v"(dst) : "s"(val)); break;
    case 31: asm("s_nop 1\n\tv_writelane_b32 %0, %1, 31" : "+v"(dst) : "s"(val)); break;
    default: break;
    }
}
__device__ __forceinline__ void ballot4(unsigned& mlo, unsigned& mhi, const float thr, const float x0, const float x1, const float x2, const float x3, const int base) {
    switch (base) {
    case 0: asm("v_cmp_le_f32_e64 s[90:91], %2, %3\n\tv_cmp_le_f32_e64 s[92:93], %2, %4\n\tv_cmp_le_f32_e64 s[94:95], %2, %5\n\tv_cmp_le_f32_e64 s[96:97], %2, %6\n\t"
                 "v_writelane_b32 %0, s90, 0\n\tv_writelane_b32 %1, s91, 0\n\tv_writelane_b32 %0, s92, 1\n\tv_writelane_b32 %1, s93, 1\n\tv_writelane_b32 %0, s94, 2\n\tv_writelane_b32 %1, s95, 2\n\tv_writelane_b32 %0, s96, 3\n\tv_writelane_b32 %1, s97, 3"
                 : "+v"(mlo), "+v"(mhi) : "v"(thr), "v"(x0), "v"(x1), "v"(x2), "v"(x3) : "s90", "s91", "s92", "s93", "s94", "s95", "s96", "s97"); break;
    case 4: asm("v_cmp_le_f32_e64 s[90:91], %2, %3\n\tv_cmp_le_f32_e64 s[92:93], %2, %4\n\tv_cmp_le_f32_e64 s[94:95], %2, %5\n\tv_cmp_le_f32_e64 s[96:97], %2, %6\n\t"
                 "v_writelane_b32 %0, s90, 4\n\tv_writelane_b32 %1, s91, 4\n\tv_writelane_b32 %0, s92, 5\n\tv_writelane_b32 %1, s93, 5\n\tv_writelane_b32 %0, s94, 6\n\tv_writelane_b32 %1, s95, 6\n\tv_writelane_b32 %0, s96, 7\n\tv_writelane_b32 %1, s97, 7"
                 : "+v"(mlo), "+v"(mhi) : "v"(thr), "v"(x0), "v"(x1), "v"(x2), "v"(x3) : "s90", "s91", "s92", "s93", "s94", "s95", "s96", "s97"); break;
    case 8: asm("v_cmp_le_f32_e64 s[90:91], %2, %3\n\tv_cmp_le_f32_e64 s[92:93], %2, %4\n\tv_cmp_le_f32_e64 s[94:95], %2, %5\n\tv_cmp_le_f32_e64 s[96:97], %2, %6\n\t"
                 "v_writelane_b32 %0, s90, 8\n\tv_writelane_b32 %1, s91, 8\n\tv_writelane_b32 %0, s92, 9\n\tv_writelane_b32 %1, s93, 9\n\tv_writelane_b32 %0, s94, 10\n\tv_writelane_b32 %1, s95, 10\n\tv_writelane_b32 %0, s96, 11\n\tv_writelane_b32 %1, s97, 11"
                 : "+v"(mlo), "+v"(mhi) : "v"(thr), "v"(x0), "v"(x1), "v"(x2), "v"(x3) : "s90", "s91", "s92", "s93", "s94", "s95", "s96", "s97"); break;
    case 12: asm("v_cmp_le_f32_e64 s[90:91], %2, %3\n\tv_cmp_le_f32_e64 s[92:93], %2, %4\n\tv_cmp_le_f32_e64 s[94:95], %2, %5\n\tv_cmp_le_f32_e64 s[96:97], %2, %6\n\t"
                 "v_writelane_b32 %0, s90, 12\n\tv_writelane_b32 %1, s91, 12\n\tv_writelane_b32 %0, s92, 13\n\tv_writelane_b32 %1, s93, 13\n\tv_writelane_b32 %0, s94, 14\n\tv_writelane_b32 %1, s95, 14\n\tv_writelane_b32 %0, s96, 15\n\tv_writelane_b32 %1, s97, 15"
                 : "+v"(mlo), "+v"(mhi) : "v"(thr), "v"(x0), "v"(x1), "v"(x2), "v"(x3) : "s90", "s91", "s92", "s93", "s94", "s95", "s96", "s97"); break;
    case 16: asm("v_cmp_le_f32_e64 s[90:91], %2, %3\n\tv_cmp_le_f32_e64 s[92:93], %2, %4\n\tv_cmp_le_f32_e64 s[94:95], %2, %5\n\tv_cmp_le_f32_e64 s[96:97], %2, %6\n\t"
                 "v_writelane_b32 %0, s90, 16\n\tv_writelane_b32 %1, s91, 16\n\tv_writelane_b32 %0, s92, 17\n\tv_writelane_b32 %1, s93, 17\n\tv_writelane_b32 %0, s94, 18\n\tv_writelane_b32 %1, s95, 18\n\tv_writelane_b32 %0, s96, 19\n\tv_writelane_b32 %1, s97, 19"
                 : "+v"(mlo), "+v"(mhi) : "v"(thr), "v"(x0), "v"(x1), "v"(x2), "v"(x3) : "s90", "s91", "s92", "s93", "s94", "s95", "s96", "s97"); break;
    case 20: asm("v_cmp_le_f32_e64 s[90:91], %2, %3\n\tv_cmp_le_f32_e64 s[92:93], %2, %4\n\tv_cmp_le_f32_e64 s[94:95], %2, %5\n\tv_cmp_le_f32_e64 s[96:97], %2, %6\n\t"
                 "v_writelane_b32 %0, s90, 20\n\tv_writelane_b32 %1, s91, 20\n\tv_writelane_b32 %0, s92, 21\n\tv_writelane_b32 %1, s93, 21\n\tv_writelane_b32 %0, s94, 22\n\tv_writelane_b32 %1, s95, 22\n\tv_writelane_b32 %0, s96, 23\n\tv_writelane_b32 %1, s97, 23"
                 : "+v"(mlo), "+v"(mhi) : "v"(thr), "v"(x0), "v"(x1), "v"(x2), "v"(x3) : "s90", "s91", "s92", "s93", "s94", "s95", "s96", "s97"); break;
    case 24: asm("v_cmp_le_f32_e64 s[90:91], %2, %3\n\tv_cmp_le_f32_e64 s[92:93], %2, %4\n\tv_cmp_le_f32_e64 s[94:95], %2, %5\n\tv_cmp_le_f32_e64 s[96:97], %2, %6\n\t"
                 "v_writelane_b32 %0, s90, 24\n\tv_writelane_b32 %1, s91, 24\n\tv_writelane_b32 %0, s92, 25\n\tv_writelane_b32 %1, s93, 25\n\tv_writelane_b32 %0, s94, 26\n\tv_writelane_b32 %1, s95, 26\n\tv_writelane_b32 %0, s96, 27\n\tv_writelane_b32 %1, s97, 27"
                 : "+v"(mlo), "+v"(mhi) : "v"(thr), "v"(x0), "v"(x1), "v"(x2), "v"(x3) : "s90", "s91", "s92", "s93", "s94", "s95", "s96", "s97"); break;
    case 28: asm("v_cmp_le_f32_e64 s[90:91], %2, %3\n\tv_cmp_le_f32_e64 s[92:93], %2, %4\n\tv_cmp_le_f32_e64 s[94:95], %2, %5\n\tv_cmp_le_f32_e64 s[96:97], %2, %6\n\t"
                 "v_writelane_b32 %0, s90, 28\n\tv_writelane_b32 %1, s91, 28\n\tv_writelane_b32 %0, s92, 29\n\tv_writelane_b32 %1, s93, 29\n\tv_writelane_b32 %0, s94, 30\n\tv_writelane_b32 %1, s95, 30\n\tv_writelane_b32 %0, s96, 31\n\tv_writelane_b32 %1, s97, 31"
                 : "+v"(mlo), "+v"(mhi) : "v"(thr), "v"(x0), "v"(x1), "v"(x2), "v"(x3) : "s90", "s91", "s92", "s93", "s94", "s95", "s96", "s97"); break;
    default: break;
    }
}
template <int NREG>
__device__ __forceinline__ void dsa_select_one(float (&xn)[NREG], const int ql, const int qnext, const float* const scw, LAS unsigned* const MASK, LAS const float* const ZT, const int wv, const int lane, const int t0, const int qb_) {
    const float NINF = -__builtin_inff(), PINF = __builtin_inff();
    const unsigned long long lt_mask = (1ull << lane) - 1ull;
    {
        const int tq = t0 + 8 * wv + ql;
        LAS unsigned* const mrow = MASK + (8 * wv + ql) * 64;
        float x[NREG];
#pragma unroll
        for (int i = 0; i < NREG; ++i) x[i] = (i <= qb_) ? xn[i] : NINF;
        if (qnext < 8) {
#pragma unroll
            for (int i = 0; i < NREG; ++i) xn[i] = __hip_atomic_load(scw + (qnext & 7) * 2048 + i * 64 + lane, __ATOMIC_RELAXED, __HIP_MEMORY_SCOPE_AGENT);
        }
        unsigned mlo = 0u, mhi = 0u;
        if (tq + 1 > 256) {
#define CNT_GE(p_, dst_) do { int _c0 = 0, _c1 = 0, _c2 = 0, _c3 = 0; const float _p = (p_); \
                _Pragma("unroll") for (int _i = 0; _i < NREG; _i += 4) \
                    asm volatile("v_cmp_le_f32_e64 s[90:91], %8, %4\n\tv_cmp_le_f32_e64 s[92:93], %8, %5\n\tv_cmp_le_f32_e64 s[94:95], %8, %6\n\tv_cmp_le_f32_e64 s[96:97], %8, %7\n\t" \
                                 "v_addc_co_u32_e64 %0, s[90:91], 0, %0, s[90:91]\n\tv_addc_co_u32_e64 %1, s[92:93], 0, %1, s[92:93]\n\tv_addc_co_u32_e64 %2, s[94:95], 0, %2, s[94:95]\n\tv_addc_co_u32_e64 %3, s[96:97], 0, %3, s[96:97]" \
                                 : "+v"(_c0), "+v"(_c1), "+v"(_c2), "+v"(_c3) : "v"(x[_i]), "v"(x[_i + 1]), "v"(x[_i + 2]), "v"(x[_i + 3]), "v"(_p) : "s90", "s91", "s92", "s93", "s94", "s95", "s96", "s97"); \
                dst_ = wave_sum_i((_c0 + _c1) + (_c2 + _c3)); } while (0)
            float s1 = 0.f, s2 = 0.f;
            constexpr int SS = NREG / 8;
#pragma unroll
            for (int i = 0; i < NREG; i += SS) if (i < qb_) { s1 += x[i]; s2 = fmaf(x[i], x[i], s2); }
            s1 = wave_sum_f(s1); s2 = wave_sum_f(s2);
            const float rm = rcpf_(64.0f * (float)((min(qb_, NREG) + SS - 1) / SS));
            const float mean = s1 * rm, sigma = __builtin_sqrtf(fmaxf(s2 * rm - mean * mean, 0.f));
            const float zq = ZT[2 * (8 * wv + ql)], stepc = sigma * ZT[2 * (8 * wv + ql) + 1];
            float lo = -3.0e38f, hi = PINF, thr = 0.f, vmax = 0.f; int clo = tq + 1, chi = 0; bool tie = false, lo_real = false, have_mm = false;
            float pv = mean + zq * sigma;
#pragma unroll 1
            for (int it = 1;; ++it) {
                if (!(pv > lo && pv < hi)) {
                    if (!have_mm) {
                        float vmin = PINF; vmax = NINF;
#pragma unroll
                        for (int i = 0; i < NREG; ++i) { vmax = fmaxf(vmax, x[i]); vmin = fminf(vmin, x[i] == NINF ? PINF : x[i]); }
                        vmin = -wave_max(-vmin); vmax = wave_max(vmax); have_mm = true;
                        if (!lo_real) lo = vmin;
                    }
                    pv = (hi == PINF) ? vmax : 0.5f * (lo + hi);
                    if (!(pv > lo && pv < hi)) { tie = true; break; }
                }
                int c; CNT_GE(pv, c);
                if (c == 256) { thr = pv; break; }
                if (c > 256) { lo = pv; clo = c; lo_real = true; } else { hi = pv; chi = c; }
                if (it >= 8) pv = __builtin_nanf("");
                else if (lo_real && hi != PINF) pv = lo + (hi - lo) * ((float)(clo - 256) * rcpf_((float)(clo - chi)));
                else pv = pv + (float)(c - 256) * stepc;
            }
#undef CNT_GE
            if (!tie) {
#pragma unroll
                for (int i = 0; i < NREG; i += 4) ballot4(mlo, mhi, thr, x[i], x[i + 1], x[i + 2], x[i + 3], i);
            } else {
                const int need = 256 - chi; int before = 0;
#pragma unroll
                for (int i = 0; i < NREG; ++i) { const bool eq = (x[i] == lo); const unsigned long long be = __ballot(eq);
                    const int rank = before + __popcll(be & lt_mask); const bool sel = (x[i] >= hi) || (eq && rank < need); before += __popcll(be);
                    const unsigned long long bs = __ballot(sel);
                    wrlane(mlo, (unsigned)bs, i); wrlane(mhi, (unsigned)(bs >> 32), i); }
            }
        } else {
#pragma unroll
            for (int i = 0; i < NREG; ++i) { const unsigned long long bs = __ballot(i * 64 + lane <= tq);
                wrlane(mlo, (unsigned)bs, i); wrlane(mhi, (unsigned)(bs >> 32), i); }
        }
        if (lane < NREG) { v2u w; w.x = mlo; w.y = mhi; *(LAS v2u*)(mrow + 2 * lane) = w; }
    }
}
template <int NREG>
__device__ __forceinline__ void dsa_select(const float* const scw, LAS unsigned* const MASK, LAS const float* const ZT, const int wv, const int lane, const int t0, const int nk) {
    const int qb_ = t0 >> 6;
    float xa[NREG], xb[NREG];
#pragma unroll
    for (int i = 0; i < NREG; ++i) xa[i] = __hip_atomic_load(scw + i * 64 + lane, __ATOMIC_RELAXED, __HIP_MEMORY_SCOPE_AGENT);
#pragma unroll
    for (int i = 0; i < NREG; ++i) xb[i] = __hip_atomic_load(scw + 2048 + i * 64 + lane, __ATOMIC_RELAXED, __HIP_MEMORY_SCOPE_AGENT);
#pragma unroll 1
    for (int qp = 0; qp < 8; qp += 2) {
        dsa_select_one<NREG>(xa, qp, qp + 2, scw, MASK, ZT, wv, lane, t0, qb_);
        dsa_select_one<NREG>(xb, qp + 1, qp + 3, scw, MASK, ZT, wv, lane, t0, qb_);
    }
}

__device__ __forceinline__ void dsa_unit(Frame& F, const Args& args, const int b, const int qb, const float mb2) {
    LAS unsigned char* const L = F.lds;
    const int tid = F.tid, lane = F.lane, wv = F.wave, l31_0 = lane & 31, hh_0 = lane >> 5;
    int l31 = l31_0, hh = hh_0;
    constexpr int PK = 272, PV = 144;
    constexpr int O_K0 = 0, O_V0 = 17408, BUFSZ = 35840, O_MASK = 2 * BUFSZ, O_RS = O_MASK + 16384, O_BT = O_RS + 8192, O_ZT = O_BT + 2048, O_END = O_ZT + 512, O_OA = 0;
    static_assert(O_END <= SCRATCH_BYTES && 4 * 17408 <= 2 * BUFSZ, "dsa LDS map");
    const int t0 = 64 * qb, nk = 64 * (qb + 1);
    const size_t rb = (size_t)b * SEQ;
    LAS unsigned* const MASK = (LAS unsigned*)(L + O_MASK);
    LAS float* const RS = (LAS float*)(L + O_RS);
    LAS float* const BT = (LAS float*)(L + O_BT);
    LAS float* const ZT = (LAS float*)(L + O_ZT);
    const float NINF = -__builtin_inff();
    for (int key = tid; key < nk; key += NWAVES * 64) { const float* kp = W_KVSS + rb + key; RS[key] = rsqf_(((kp[0] + kp[MROWS]) + (kp[2 * MROWS] + kp[3 * MROWS])) * (1.0f / 128.0f) + EPSF); }
    BT[tid] = P_RELB[T5_BUCKET[tid >> 2] * 4 + (tid & 3)] * LOG2E;
    if (tid < 64) {
        const float n_ = (float)(t0 + tid + 1); float f_ = 256.0f * rcpf_(n_); const bool up_ = f_ > 0.5f; if (up_) f_ = 1.0f - f_;
        f_ = fmaxf(f_, 1e-6f);
        const float t_ = __builtin_sqrtf(-1.3862944f * __builtin_log2f(f_));
        float z_ = t_ - (2.515517f + t_ * (0.802853f + t_ * 0.010328f)) * rcpf_(1.0f + t_ * (1.432788f + t_ * (0.189269f + t_ * 0.001308f)));
        if (up_) z_ = -z_;
        ZT[2 * tid] = z_; ZT[2 * tid + 1] = rcpf_(n_ * 0.3989423f * __builtin_exp2f(-0.72134752f * z_ * z_));
    }
    float* const scw = W_SCR + (size_t)(blockIdx.x * NWAVES + wv) * 8 * 2048;
#pragma unroll 1
    for (int rep_a = 0; rep_a < (PROBE_DUP == 41 ? 2 : 1); ++rep_a) {
        bf16x8 aq[2][4]; f32x4 wts[2][4];
#pragma unroll
        for (int rt = 0; rt < 2; ++rt) {
            const bf16* p = W_PROJ + (rb + t0 + 8 * wv + 4 * rt + (l31 >> 3)) * NPROJ + C_IQ + (l31 & 7) * 64 + 8 * hh;
#pragma unroll
            for (int s = 0; s < 4; ++s) aq[rt][s] = *(const GAS bf16x8*)(p + 16 * s);
#pragma unroll
            for (int g = 0; g < 4; ++g) wts[rt][g] = *(const f32x4*)(W_AUX + (rb + t0 + 8 * wv + 4 * rt + g) * 16 + 8 + 4 * hh) * 0.5f;
        }
        constexpr int O_IK = 0, IKB = 9216, PIK = 144;
        v4u sti;
#define IK_GLOAD(kt_) sti = *(const GAS v4u*)(W_PROJ + (rb + 64 * (kt_) + (tid >> 3)) * NPROJ + C_IK + (tid & 7) * 8)
#define IK_SWRITE(buf_) *(LAS v4u*)(L + O_IK + (buf_) * IKB + (tid >> 3) * PIK + (tid & 7) * 16) = sti
        IK_GLOAD(0); IK_SWRITE(0);
        __syncthreads();
#pragma unroll 1
        for (int kt6 = 0; kt6 <= qb; ++kt6) {
          const int ibuf = kt6 & 1;
          if (kt6 < qb) IK_GLOAD(kt6 + 1);
#pragma unroll
          for (int st = 0; st < 2; ++st) {
            bf16x8 bk[4];
#pragma unroll
            for (int s = 0; s < 4; ++s) bk[s] = lds16(L + O_IK + ibuf * IKB + (32 * st + l31) * PIK + (16 * s + 8 * hh) * 2);
            const int kt = 2 * kt6 + st;
            const int key = 32 * kt + l31;
            f32x16 C0, C1;
#pragma unroll
            for (int r = 0; r < 16; ++r) { C0[r] = 0.f; C1[r] = 0.f; }
#pragma unroll
            for (int s = 0; s < 4; ++s) C0 = MFMA32(aq[0][s], bk[s], C0);
#pragma unroll
            for (int s = 0; s < 4; ++s) C1 = MFMA32(aq[1][s], bk[s], C1);
            float pp[2][4];
#pragma unroll
            for (int g = 0; g < 4; ++g) {
                float p0 = 0.f, p1 = 0.f;
#pragma unroll
                for (int e2 = 0; e2 < 4; ++e2) { const float w0 = wts[0][g][e2], w1 = wts[1][g][e2], x0 = C0[4 * g + e2], x1 = C1[4 * g + e2];
                    p0 = __builtin_fmaf(w0, x0, p0); p0 = __builtin_fmaf(w0, __builtin_fabsf(x0), p0); p1 = __builtin_fmaf(w1, x1, p1); p1 = __builtin_fmaf(w1, __builtin_fabsf(x1), p1); }
                pp[0][g] = p0; pp[1][g] = p1;
            }
#pragma unroll
            for (int rt = 0; rt < 2; ++rt)
#pragma unroll
                for (int g2 = 0; g2 < 2; ++g2) { const int ql = 4 * rt + g2 + 2 * hh;
                    float pa = pp[rt][g2], pb = pp[rt][g2 + 2];
                    asm("s_nop 1\n\tv_permlane32_swap_b32 %0, %1" : "+v"(pa), "+v"(pb));
                    float p = pa + pb;
                    if (key > t0 + 8 * wv + ql) p = NINF;
                    scw[ql * 2048 + key] = p; }
          }
          if (kt6 < qb) IK_SWRITE(ibuf ^ 1);
          __syncthreads();
        }
#undef IK_GLOAD
#undef IK_SWRITE
    }
    __builtin_amdgcn_fence(__ATOMIC_SEQ_CST, "workgroup");
    asm volatile("s_waitcnt vmcnt(0)" ::: "memory");
    int lanev = lane; asm volatile("" : "+v"(lanev));
#pragma unroll 1
    for (int rep_b = 0; rep_b < (PROBE_DUP == 42 ? 2 : 1); ++rep_b)
    if (qb < 8) dsa_select<8>(scw, MASK, ZT, wv, lanev, t0, nk);
    else if (qb < 16) dsa_select<16>(scw, MASK, ZT, wv, lanev, t0, nk);
    else if (qb < 24) dsa_select<24>(scw, MASK, ZT, wv, lanev, t0, nk);
    else dsa_select<32>(scw, MASK, ZT, wv, lanev, t0, nk);
    __syncthreads();
    const int qj = l31 >> 2, hd = l31 & 3;
    const int tql = t0 + 8 * wv + qj;
    bf16x8 qf[8]; float qn2 = 0.f;
    {
        const bf16* p = W_PROJ + (rb + tql) * NPROJ + C_QB + hd * 128 + 8 * hh; const float cs = 0.08838834764831845f * LOG2E;
#pragma unroll
        for (int s = 0; s < 8; ++s) { const v4u raw = *(const GAS v4u*)(p + 16 * s); const f32x4 g0 = *(const f32x4*)(P_GKV + 16 * s + 8 * hh), g1 = *(const f32x4*)(P_GKV + 16 * s + 8 * hh + 4);
            v4u o; o.x = cvtpk(bflo(raw.x) * g0.x * cs, bfhi(raw.x) * g0.y * cs); o.y = cvtpk(bflo(raw.y) * g0.z * cs, bfhi(raw.y) * g0.w * cs);
            o.z = cvtpk(bflo(raw.z) * g1.x * cs, bfhi(raw.z) * g1.y * cs); o.w = cvtpk(bflo(raw.w) * g1.z * cs, bfhi(raw.w) * g1.w * cs);
            qn2 += (bflo(o.x) * bflo(o.x) + bfhi(o.x) * bfhi(o.x)) + (bflo(o.y) * bflo(o.y) + bfhi(o.y) * bfhi(o.y)) + (bflo(o.z) * bflo(o.z) + bfhi(o.z) * bfhi(o.z)) + (bflo(o.w) * bflo(o.w) + bfhi(o.w) * bfhi(o.w));
            qf[s] = __builtin_bit_cast(bf16x8, o); }
    }
    qn2 += __shfl_xor(qn2, 32);
    const float c0 = -(sqrtf(qn2) * 11.313708499f * 1.01f + mb2 + 1.0f);
    const float cfar = BT[127 * 4 + hd] + c0;
    f32x16 oacc[4];
#pragma unroll
    for (int d = 0; d < 4; ++d)
#pragma unroll
        for (int r = 0; r < 16; ++r) oacc[d][r] = 0.f;
    float lsum = 0.f;
    v4u st0, st1;
#define DSA_GLOAD(kt) do { const bf16* _p = W_PROJ + (rb + 64 * (kt) + lane) * NPROJ + C_CKV + wv * 16; st0 = *(const GAS v4u*)_p; st1 = *(const GAS v4u*)(_p + 8); } while (0)
#define DSA_SWRITE(buf, ktt) do { LAS unsigned char* _kb = L + (buf) * BUFSZ; const float _r = RS[64 * (ktt) + lane]; \
        v4u _n0, _n1; _n0.x = cvtpk(bflo(st0.x) * _r, bfhi(st0.x) * _r); _n0.y = cvtpk(bflo(st0.y) * _r, bfhi(st0.y) * _r); _n0.z = cvtpk(bflo(st0.z) * _r, bfhi(st0.z) * _r); _n0.w = cvtpk(bflo(st0.w) * _r, bfhi(st0.w) * _r); \
        _n1.x = cvtpk(bflo(st1.x) * _r, bfhi(st1.x) * _r); _n1.y = cvtpk(bflo(st1.y) * _r, bfhi(st1.y) * _r); _n1.z = cvtpk(bflo(st1.z) * _r, bfhi(st1.z) * _r); _n1.w = cvtpk(bflo(st1.w) * _r, bfhi(st1.w) * _r); \
        *(LAS v4u*)(_kb + O_K0 + lane * PK + wv * 32) = _n0; *(LAS v4u*)(_kb + O_K0 + lane * PK + wv * 32 + 16) = _n1; \
        } while (0)
    DSA_GLOAD(0); DSA_SWRITE(0, 0);
    __syncthreads();
    for (int kt = 0; kt <= qb; ++kt) {
        const int buf = kt & 1;
        l31 = l31_0; hh = hh_0; asm volatile("" : "+v"(l31), "+v"(hh));
        if (kt < qb) DSA_GLOAD(kt + 1);
        const LAS unsigned char* kb = L + buf * BUFSZ;
        bf16x8 kf[8];
        int mw0 = (int)MASK[(8 * wv + qj) * 64 + 2 * kt], mw1 = (int)MASK[(8 * wv + qj) * 64 + 2 * kt + 1];
#pragma unroll
        for (int st = 0; st < 2; ++st) {
#pragma unroll
            for (int s = 0; s < 8; ++s) kf[s] = lds16(kb + O_K0 + (32 * st + l31) * PK + (16 * s + 8 * hh) * 2);
            __builtin_amdgcn_sched_barrier(0);
            const int kbase = 64 * kt + 32 * st;
            const bool far = (t0 + 8 * wv) - (kbase + 31) >= 113;
            const float sinit = far ? cfar : 0.f;
            f32x16 Sa;
#pragma unroll
            for (int r = 0; r < 16; ++r) Sa[r] = sinit;
#pragma unroll
            for (int s = 0; s < 8; ++s) Sa = MFMA32(kf[s], qf[s], Sa);
            __builtin_amdgcn_sched_barrier(0);
            bf16x8 vf[8];
#pragma unroll
            for (int dt = 0; dt < 4; ++dt) {
                const LAS unsigned char* vp = kb + O_K0 + (32 * st + 4 * hh + ((lane & 15) >> 2)) * PK + (32 * dt + 16 * ((lane >> 4) & 1) + 4 * (lane & 3)) * 2;
                vf[2 * dt] = ldstr8(vp, vp + 8 * PK); vf[2 * dt + 1] = ldstr8(vp + 16 * PK, vp + 24 * PK); }
            __builtin_amdgcn_sched_barrier(0);
            const int mwi = (st == 0 ? mw0 : mw1) >> (4 * hh);
            float pn[16];
            if (far) {
#pragma unroll
                for (int r = 0; r < 16; ++r) { int mb_ = __builtin_amdgcn_sbfe(mwi, 8 * (r >> 2) + (r & 3), 1); asm("" : "+v"(mb_));
                    pn[r] = __builtin_bit_cast(float, __builtin_bit_cast(int, __builtin_amdgcn_exp2f(Sa[r])) & mb_); lsum += pn[r]; }
            } else {
#pragma unroll
                for (int r = 0; r < 16; ++r) { int dist = tql - (kbase + 8 * (r >> 2) + 4 * hh + (r & 3)); dist = dist < 0 ? 0 : (dist > 127 ? 127 : dist);
                    int mb_ = __builtin_amdgcn_sbfe(mwi, 8 * (r >> 2) + (r & 3), 1); asm("" : "+v"(mb_));
                    pn[r] = __builtin_bit_cast(float, __builtin_bit_cast(int, __builtin_amdgcn_exp2f(Sa[r] + (BT[dist * 4 + hd] + c0))) & mb_); lsum += pn[r]; }
            }
            const bf16x8 pf0 = pack8(pn[0], pn[1], pn[2], pn[3], pn[4], pn[5], pn[6], pn[7]), pf1 = pack8(pn[8], pn[9], pn[10], pn[11], pn[12], pn[13], pn[14], pn[15]);
#pragma unroll
            for (int dt = 0; dt < 4; ++dt) { oacc[dt] = MFMA32(vf[2 * dt], pf0, oacc[dt]); oacc[dt] = MFMA32(vf[2 * dt + 1], pf1, oacc[dt]); }
        }
        if (kt < qb) DSA_SWRITE(buf ^ 1, kt + 1);
        __syncthreads();
    }
#undef DSA_GLOAD
#undef DSA_SWRITE
    lsum += __shfl_xor(lsum, 32);
    {
        const float inv = rcpf_(lsum);
#pragma unroll
        for (int dt = 0; dt < 4; ++dt)
#pragma unroll
            for (int g = 0; g < 4; ++g) { const int d = 32 * dt + 8 * g + 4 * hh; const f32x4 gk = *(const f32x4*)(P_GKV + d);
                *(LAS v2u*)(L + O_OA + hd * 17408 + (8 * wv + qj) * PK + d * 2) = pack4(oacc[dt][4 * g] * inv * gk.x, oacc[dt][4 * g + 1] * inv * gk.y, oacc[dt][4 * g + 2] * inv * gk.z, oacc[dt][4 * g + 3] * inv * gk.w); }
    }
    __syncthreads();
    {
        const int hd2 = wv >> 1, mt2 = wv & 1;
        const size_t row = rb + t0 + 32 * mt2 + l31;
        bf16x8 of[8];
#pragma unroll
        for (int s = 0; s < 8; ++s) of[s] = lds16(L + O_OA + hd2 * 17408 + (32 * mt2 + l31) * PK + (16 * s + 8 * hh) * 2);
        const int erow = 16 * ((l31 >> 2) & 1) + 4 * (l31 >> 3) + (l31 & 3);
#pragma unroll
        for (int et = 0; et < 4; ++et) {
            const bf16* zp = W_PROJ + row * NPROJ + C_ZB + hd2 * 128 + 32 * et + 16 * hh;
            const v4u z0 = *(const GAS v4u*)zp, z1 = *(const GAS v4u*)(zp + 8);
            f32x16 C;
#pragma unroll
            for (int r = 0; r < 16; ++r) C[r] = 0.f;
            const bf16* wp = W_WUVT + (size_t)hd2 * 16384 + (32 * et + erow) * 128 + 8 * hh;
#pragma unroll
            for (int s = 0; s < 8; ++s) C = MFMA32(*(const GAS bf16x8*)(wp + 16 * s), of[s], C);
            const unsigned zw[8] = {z0.x, z0.y, z0.z, z0.w, z1.x, z1.y, z1.z, z1.w}; unsigned ow[8];
#pragma unroll
            for (int k = 0; k < 8; ++k) ow[k] = cvtpk(C[2 * k] * siluf(bflo(zw[k])), C[2 * k + 1] * siluf(bfhi(zw[k])));
            bf16* op = W_OAB + row * DM + 512 + hd2 * 128 + 32 * et + 16 * hh;
            v4u o0, o1; o0.x = ow[0]; o0.y = ow[1]; o0.z = ow[2]; o0.w = ow[3]; o1.x = ow[4]; o1.y = ow[5]; o1.z = ow[6]; o1.w = ow[7];
            *(GAS v4u*)op = o0; *(GAS v4u*)(op + 8) = o1;
        }
    }
    __syncthreads();
}

constexpr int N_GDN = NB * 4, N_DSA = NB * 32, N_ITEMS = N_GDN + N_DSA;
constexpr int N_PHASES = 6;
#ifndef STAG_P2
#define STAG_P2 0
#endif
#ifndef STAG_P4
#define STAG_P4 0
#endif
__global__ void __launch_bounds__(NWAVES * 64, 2) hyb_fwd(Args args) {
    extern __shared__ __attribute__((aligned(16))) unsigned char lds[];
    Frame F;
    F.lds = (LAS unsigned char*)lds;
    F.MISC = (volatile LAS unsigned*)(F.lds + MISC_OFF);
    F.tid = threadIdx.x; F.lane = F.tid & 63; F.wave = __builtin_amdgcn_readfirstlane(F.tid >> 6);
    F.G = gridDim.x; { const int bx = blockIdx.x; F.vcu = (F.G % 8 == 0) ? (bx % 8) * (F.G / 8) + bx / 8 : bx; }
    unsigned char* ws = args.ws;
    F.ctl = (gu32*)(ws + WS_CTL);
    F.ws = ws;
    for (int u = F.tid; u < 64; u += NWAVES * 64) F.MISC[u] = 0u;
    __syncthreads();
    const int lo = args.ph_lo, hi = args.ph_hi;
    const bool multi = (hi - lo) > 1;
    XcdBarrier bar; bar.bar = (unsigned*)(F.ctl + CW_BAR) + args.li * XCD_BAR_WORDS; bar.x = 0; bar.st = nullptr;
    if (multi) bar = xcd_barrier_post((unsigned*)(F.ctl + CW_BAR) + args.li * XCD_BAR_WORDS, F.MISC + 8);
#define IN(k) (lo <= (k) && (k) < hi)
#define STAGGER(ticks) do { if ((ticks) > 0) { const unsigned long long t0_ = __builtin_amdgcn_s_memrealtime(); const unsigned d_ = ((unsigned)blockIdx.x & 7u) * (unsigned)(ticks); \
        while ((unsigned)(__builtin_amdgcn_s_memrealtime() - t0_) < d_) __builtin_amdgcn_s_sleep(4); } } while (0)
#define BOTH(k) (IN(k) && IN((k) + 1))
    if (IN(0)) { p0_prologue(F, args); if (PROBE_DUP == 7) { __syncthreads(); p0_prologue(F, args); } if (BOTH(0)) xcd_barrier(bar); }
    if (IN(1)) { p1_norm(F, args); if (PROBE_DUP == 1) p1_norm(F, args); if (BOTH(1)) xcd_barrier(bar); }
    if (IN(2)) {
        pg8::Gemm g{W_XN, W_WINT, MROWS, NPROJ, DM, (unsigned*)(F.ws + WS_CTL + 512 * 1024)}; pg8::StaticOrder S; S.init(MROWS, NPROJ, F.G, (int)blockIdx.x);
        pg8::EpiProj E{W_PROJ, W_AUX, W_KVSS};
        STAGGER(STAG_P2);
        pg8::gemm_phase<pg8::EpiProj, pg8::StaticOrder, true, true>(F.lds, g, S, E);
        if (PROBE_DUP == 2) pg8::gemm_phase<pg8::EpiProj, pg8::StaticOrder, true, true>(F.lds, g, S, E);
        if (PROBE_DUP == 22) { pg8::EpiHalf EH{E, pg8::EpiNull{W_SCR}}; pg8::gemm_phase<pg8::EpiHalf, pg8::StaticOrder, true, true>(F.lds, g, S, EH); }
        if (PROBE_DUP == 23) { pg8::EpiPat<true> EP{(bf16*)(F.ws + WS_SCR), 3072, 12}; pg8::gemm_phase<pg8::EpiPat<true>, pg8::StaticOrder, true, true>(F.lds, g, S, EP); }
        if (PROBE_DUP == 24) { pg8::EpiPat<false> EP{(bf16*)(F.ws + WS_SCR), 3072, 12}; pg8::gemm_phase<pg8::EpiPat<false>, pg8::StaticOrder, true, true>(F.lds, g, S, EP); }
        if (PROBE_DUP == 25) { pg8::EpiPat<false> EP{W_PROJ, 3840, 12}; pg8::gemm_phase<pg8::EpiPat<false>, pg8::StaticOrder, true, true>(F.lds, g, S, EP); }
        if (PROBE_DUP == 26) { pg8::EpiPat<false> EP{W_PROJ, 3840, 15}; pg8::gemm_phase<pg8::EpiPat<false>, pg8::StaticOrder, true, true>(F.lds, g, S, EP); }
        if (PROBE_DUP == 21) { pg8::EpiNull EN{W_SCR}; pg8::gemm_phase<pg8::EpiNull, pg8::StaticOrder, true, true>(F.lds, g, S, EN); }
        if (BOTH(2)) xcd_barrier(bar);
    }
    if (IN(3)) {
#define NEXT_ITEM(dst, qw) do { if (F.tid == 0) F.MISC[4] = __hip_atomic_fetch_add(F.ctl + (qw), 1u, RLX_AGENT); __syncthreads(); dst = (int)F.MISC[4]; __syncthreads(); } while (0)
        float mb2; { const int hd_ = F.lane & 3; float m_ = P_RELB[hd_]; for (int k = 1; k < 32; ++k) m_ = fmaxf(m_, P_RELB[k * 4 + hd_]); mb2 = m_ * LOG2E; }
        int item; NEXT_ITEM(item, CW_QUEUE);
#pragma unroll 1
        for (int pass = 0; pass < (PROBE_DUP == 3 ? 2 : 1); ++pass) {
            if (pass) NEXT_ITEM(item, CW_QUEUE + 64);
            while (item < N_GDN) { gdn_unit(F, args, item >> 2, item & 3); NEXT_ITEM(item, CW_QUEUE + 64 * pass); }
        }
#pragma unroll 1
        for (int pass = 0; pass < (PROBE_DUP == 4 ? 2 : 1); ++pass) {
            if (pass) NEXT_ITEM(item, CW_QUEUE + 128);
            while (item < N_ITEMS) { if (item >= N_GDN) { const int idx = item - N_GDN; dsa_unit(F, args, idx & 31, 31 - (idx >> 5), mb2); } NEXT_ITEM(item, pass ? CW_QUEUE + 128 : CW_QUEUE); }
        }
#undef NEXT_ITEM
        if (BOTH(3)) xcd_barrier(bar);
    }
    if (IN(4)) {
        pg8::Gemm g{W_OAB, W_WOUTT, MROWS, DM, DM, (unsigned*)(F.ws + WS_CTL + 512 * 1024)}; pg8::StaticOrder S; S.init(MROWS, DM, F.G, (int)blockIdx.x);
        pg8::EpiMix E{W_MIX, DM};
        STAGGER(STAG_P4);
        pg8::gemm_phase<pg8::EpiMix, pg8::StaticOrder, true, true>(F.lds, g, S, E);
        if (PROBE_DUP == 5) pg8::gemm_phase<pg8::EpiMix, pg8::StaticOrder, true, true>(F.lds, g, S, E);
        if (BOTH(4)) xcd_barrier(bar);
    }
    if (IN(5)) { p5_final(F, args); if (PROBE_DUP == 6) p5_final(F, args); }
#undef IN
#undef BOTH
}

extern "C" void kernel_launch(void* const* d_in, const int* in_sizes, int n_in, void* d_out, int out_size, void* d_ws, size_t ws_size, hipStream_t stream) {
    static int grid = 0;
    if (grid == 0) {
        if (n_in != 15 || in_sizes[0] != MROWS * DM || out_size != MROWS * DM || ws_size < WS_END) { fprintf(stderr, "kernel_launch: unexpected shapes (n_in %d, in0 %d, out %d, ws %zu); nothing launched\n", n_in, n_in > 0 ? in_sizes[0] : -1, out_size, ws_size); grid = -1; return; }
        int dev = 0, cus = 0, per_cu = 0;
        if (hipGetDevice(&dev) != hipSuccess || hipDeviceGetAttribute(&cus, hipDeviceAttributeMultiprocessorCount, dev) != hipSuccess) { fprintf(stderr, "kernel_launch: device query failed\n"); grid = -1; return; }
        if (hipFuncSetAttribute((const void*)hyb_fwd, hipFuncAttributeMaxDynamicSharedMemorySize, LDS_BYTES) != hipSuccess) { fprintf(stderr, "kernel_launch: hipFuncSetAttribute failed\n"); grid = -1; return; }
        if (hipOccupancyMaxActiveBlocksPerMultiprocessor(&per_cu, (const void*)hyb_fwd, NWAVES * 64, LDS_BYTES) != hipSuccess || per_cu < 1)
            fprintf(stderr, "kernel_launch: note: occupancy query reports %d workgroups per CU\n", per_cu);
        (void)hipGetLastError();
        grid = cus < 256 ? cus : 256;
    }
    if (grid < 0) return;
    if (hipMemsetAsync((char*)d_ws + WS_CTL, 0, CTL_ZERO_BYTES, stream) != hipSuccess) { fprintf(stderr, "kernel_launch: memset failed\n"); return; }
    Args a{};
    for (int i = 0; i < 15; ++i) a.in[i] = (const float*)d_in[i];
    a.out = (float*)d_out; a.ws = (unsigned char*)d_ws;
    constexpr int NL = MK_N_LAUNCHES;
    static_assert(NL == 1 || NL == 2 || NL == 3 || NL == N_PHASES, "MK_N_LAUNCHES");
    const int cuts1[2] = {0, 6}, cuts2[3] = {0, 3, 6}, cuts3[4] = {0, 3, 4, 6}, cuts6[7] = {0, 1, 2, 3, 4, 5, 6};
    const int* cuts = NL == 1 ? cuts1 : NL == 2 ? cuts2 : NL == 3 ? cuts3 : cuts6;
    for (int li = 0; li < NL; ++li) {
        a.ph_lo = cuts[li]; a.ph_hi = cuts[li + 1]; a.li = li;
        hipLaunchKernelGGL(hyb_fwd, dim3(grid), dim3(NWAVES * 64), LDS_BYTES, stream, a);
        const hipError_t le = hipPeekAtLastError();
        if (le != hipSuccess) { fprintf(stderr, "kernel_launch: launch %d failed: %s\n", li, hipGetErrorName(le)); break; }
    }
}
```

```cpp
#include <hip/hip_runtime.h>
#include <cstdio>
#include <cstdint>
#ifndef MK_N_LAUNCHES
#define MK_N_LAUNCHES 1
#endif
#ifndef PROBE_DUP
#define PROBE_DUP 0
#endif
namespace pg8 {
#define PG8_LAS __attribute__((address_space(3)))
typedef unsigned short bf16_t;
typedef short bf16x8 __attribute__((ext_vector_type(8)));
typedef float f32x4 __attribute__((ext_vector_type(4)));
typedef unsigned u32x4 __attribute__((ext_vector_type(4)));
constexpr int BM = 256, BK = 64, HALF = 128, HTB = HALF * BK * 2  , STAGE_BYTES = 8 * HTB, NXCD = 8, WGM = 8;

__host__ __device__ __forceinline__ int lds_byte(int r, int c) { const int st = (r >> 4) * 2 + (c >> 5), rr = r & 15, cc = c & 31, ob = rr * 64 + cc * 2; return st * 1024 + (ob ^ (((ob >> 9) & 1) << 5)); }
__host__ __device__ __forceinline__ void stage_rc(int b, int& R, int& C) { const int st = b / 1024, sb = b % 1024, swz = sb ^ (((sb >> 9) & 1) << 5); R = (st >> 1) * 16 + swz / 64; C = (st & 1) * 32 + (swz % 64) / 2; }
__host__ __device__ __forceinline__ int perm32(int rho) { const int n = rho >> 4, i = rho & 15; return 8 * (i >> 2) + 4 * n + (i & 3); }

struct Unit { int pm, pn; };
struct Gemm { const bf16_t* A; const bf16_t* Bt; int M, N, K; unsigned* sink; };

struct StaticOrder {
    int nM, nN, nwg, G, c;
    __host__ __device__ void init(int M, int N, int G_, int c_) { nM = M / BM; nN = N / BM; nwg = nM * nN; G = G_; c = c_; }
    __host__ __device__ bool next(int i, Unit& u) const {
        const long L = (long)i * G + c; if (L >= nwg) return false;
        int wgid = (int)L; { const int q = nwg / NXCD, r = nwg % NXCD, xcd = wgid % NXCD, off = wgid / NXCD; wgid = (xcd < r ? xcd * (q + 1) : r * (q + 1) + (xcd - r) * q) + off; }
        const int nig = WGM * nN, gid = wgid / nig, fm = gid * WGM, gsz = (nM - fm) < WGM ? (nM - fm) : WGM;
        u.pm = fm + ((wgid % nig) % gsz); u.pn = (wgid % nig) / gsz; return true;
    }
    __device__ __forceinline__ void a_ready(const Unit&) const {}
    __device__ __forceinline__ void done(const Unit&) const {}
};

typedef float f32x2c __attribute__((ext_vector_type(2))); typedef __bf16 b16x2c __attribute__((ext_vector_type(2)));
__device__ __forceinline__ unsigned cvt_pk_bf16(float lo, float hi) { const f32x2c v = {lo, hi}; return __builtin_bit_cast(unsigned, __builtin_convertvector(v, b16x2c)); }
struct EpiProj {
    static constexpr bool PERM = true, AFTER_DRAIN = false; static constexpr int MIN_VM = 16;
    bf16_t* O; float* aux; float* kvss;
    __device__ __forceinline__ void operator()(const f32x4 (&acc)[2][2][4][2], const Unit& u, int wr, int wc, int fr, int fq) const {
        const int row0 = u.pm * BM + wr * 64 + fr, col0 = u.pn * BM + wc * 32 + 8 * fq;
        const bool last = (u.pn == 14);
#pragma unroll
        for (int ai = 0; ai < 2; ++ai)
#pragma unroll
            for (int m = 0; m < 4; ++m) {
                const int row = row0 + ai * HALF + m * 16;
                bf16_t* rowp = O + (size_t)row * 3840 + col0;
#pragma unroll
                for (int bj = 0; bj < 2; ++bj) {
                    const f32x4 v0 = acc[ai][bj][m][0], v1 = acc[ai][bj][m][1];
                    u32x4 w; w.x = cvt_pk_bf16(v0[0], v0[1]); w.y = cvt_pk_bf16(v0[2], v0[3]); w.z = cvt_pk_bf16(v1[0], v1[1]); w.w = cvt_pk_bf16(v1[2], v1[3]);
                    *(u32x4*)(rowp + bj * HALF) = w;
                }
                if (last) {
                    const f32x4 a0 = acc[ai][0][m][0], a1 = acc[ai][0][m][1];
                    float ss = (a0[0] * a0[0] + a0[1] * a0[1]) + (a0[2] * a0[2] + a0[3] * a0[3]) + (a1[0] * a1[0] + a1[1] * a1[1]) + (a1[2] * a1[2] + a1[3] * a1[3]);
                    ss += __shfl_xor(ss, 16); ss += __shfl_xor(ss, 32);
                    if (fq == 0) kvss[(size_t)wc * 65536 + row] = ss;
                    if (wc == 2 && fq < 2) { float* ap = aux + (size_t)row * 16 + 8 * fq; *(f32x4*)ap = acc[ai][1][m][0]; *(f32x4*)(ap + 4) = acc[ai][1][m][1]; }
                }
            }
    }
};
struct EpiF32 {
    static constexpr bool PERM = false, AFTER_DRAIN = false; static constexpr int MIN_VM = 32;
    float* C; int ldc;
    __device__ __forceinline__ void operator()(const f32x4 (&acc)[2][2][4][2], const Unit& u, int wr, int wc, int fr, int fq) const {
        const int row0 = u.pm * BM + wr * 64 + fr, col0 = u.pn * BM + wc * 32 + 4 * fq;
#pragma unroll
        for (int ai = 0; ai < 2; ++ai)
#pragma unroll
            for (int m = 0; m < 4; ++m) { float* rowp = C + (size_t)(row0 + ai * HALF + m * 16) * ldc + col0;
#pragma unroll
                for (int bj = 0; bj < 2; ++bj)
#pragma unroll
                    for (int n = 0; n < 2; ++n) *(f32x4*)(rowp + bj * HALF + n * 16) = acc[ai][bj][m][n]; }
    }
};
struct EpiMix {
    static constexpr bool PERM = true, AFTER_DRAIN = false; static constexpr int MIN_VM = 16;
    bf16_t* O; int ldc;
    __device__ __forceinline__ void operator()(const f32x4 (&acc)[2][2][4][2], const Unit& u, int wr, int wc, int fr, int fq) const {
        const int row0 = u.pm * BM + wr * 64 + fr, col0 = u.pn * BM + wc * 32 + 8 * fq;
#pragma unroll
        for (int ai = 0; ai < 2; ++ai)
#pragma unroll
            for (int m = 0; m < 4; ++m) { bf16_t* rowp = O + (size_t)(row0 + ai * HALF + m * 16) * ldc + col0;
#pragma unroll
                for (int bj = 0; bj < 2; ++bj) { const f32x4 v0 = acc[ai][bj][m][0], v1 = acc[ai][bj][m][1];
                    u32x4 w; w.x = cvt_pk_bf16(v0[0], v0[1]); w.y = cvt_pk_bf16(v0[2], v0[3]); w.z = cvt_pk_bf16(v1[0], v1[1]); w.w = cvt_pk_bf16(v1[2], v1[3]);
                    *(u32x4*)(rowp + bj * HALF) = w; } }
    }
};
struct EpiNull {
    static constexpr bool PERM = true, AFTER_DRAIN = false; static constexpr int MIN_VM = 0;
    float* O;
    __device__ __forceinline__ void operator()(const f32x4 (&acc)[2][2][4][2], const Unit& u, int wr, int wc, int fr, int fq) const {
        f32x4 s = {0.f, 0.f, 0.f, 0.f};
#pragma unroll
        for (int ai = 0; ai < 2; ++ai)
#pragma unroll
            for (int bj = 0; bj < 2; ++bj)
#pragma unroll
                for (int m = 0; m < 4; ++m) { s += acc[ai][bj][m][0]; s += acc[ai][bj][m][1]; }
        if ((s[0] + s[1]) + (s[2] + s[3]) == 1.2345e30f) O[u.pm * 4096 + u.pn * 256 + wr * 128 + wc * 32 + fq * 16 + fr] = s[0];
    }
};
struct EpiHalf {
    static constexpr bool PERM = true, AFTER_DRAIN = false; static constexpr int MIN_VM = 0;
    EpiProj P; EpiNull N;
    __device__ __forceinline__ void operator()(const f32x4 (&acc)[2][2][4][2], const Unit& u, int wr, int wc, int fr, int fq) const {
        if ((blockIdx.x & 7) < 4) P(acc, u, wr, wc, fr, fq); else N(acc, u, wr, wc, fr, fq);
    }
};
template <bool TILE> struct EpiPat {
    static constexpr bool PERM = true, AFTER_DRAIN = false; static constexpr int MIN_VM = 0;
    bf16_t* O; int ld, npn;
    __device__ __forceinline__ void operator()(const f32x4 (&acc)[2][2][4][2], const Unit& u, int wr, int wc, int fr, int fq) const {
        if (u.pn >= npn) return;
        const int r0 = wr * 64 + fr, c0 = wc * 32 + 8 * fq;
#pragma unroll
        for (int ai = 0; ai < 2; ++ai)
#pragma unroll
            for (int m = 0; m < 4; ++m) {
                const int r = r0 + ai * HALF + m * 16;
                bf16_t* rowp = TILE ? O + ((size_t)(u.pm * 12 + u.pn) * 65536 + r * 256 + c0) : O + ((size_t)(u.pm * BM + r) * ld + u.pn * BM + c0);
#pragma unroll
                for (int bj = 0; bj < 2; ++bj) {
                    const f32x4 v0 = acc[ai][bj][m][0], v1 = acc[ai][bj][m][1];
                    u32x4 w; w.x = cvt_pk_bf16(v0[0], v0[1]); w.y = cvt_pk_bf16(v0[2], v0[3]); w.z = cvt_pk_bf16(v1[0], v1[1]); w.w = cvt_pk_bf16(v1[2], v1[3]);
                    *(u32x4*)(rowp + bj * HALF) = w;
                }
            }
    }
};
template <int N> __device__ __forceinline__ void wait_vm() { asm volatile("s_waitcnt vmcnt(%0)" :: "n"(N) : "memory"); }
template <class Epi, class Sched, bool ALIGN_EPI = false, bool SP2 = false>
__device__ __forceinline__ void gemm_phase(PG8_LAS unsigned char* lds, const Gemm g, const Sched& S, const Epi& E) {
    int tid_ = threadIdx.x; asm volatile("" : "+v"(tid_));
    const int tid = tid_, wid = __builtin_amdgcn_readfirstlane(tid >> 6), lane = tid & 63, wr = wid >> 2, wc = wid & 3, fr = lane & 15, fq = lane >> 4;
    const int K = g.K, nt = K / BK;
    constexpr int XV = (SP2 && !Epi::AFTER_DRAIN) ? Epi::MIN_VM : 0;
    unsigned voffA[2], voffB[2];
#pragma unroll
    for (int i = 0; i < 2; ++i) { int R, C; stage_rc(tid * 16 + i * 8192, R, C); const int Rb = Epi::PERM ? ((R & ~31) + perm32(R & 31)) : R;
        voffA[i] = (unsigned)(R * K + C) * 2u; voffB[i] = (unsigned)(Rb * K + C) * 2u; }
    const unsigned kstep = BK * 2;
    const unsigned hstep = (unsigned)HALF * K * 2;
    const unsigned tstep = 2 * hstep;
    const __amdgpu_buffer_rsrc_t srdA = __builtin_amdgcn_make_buffer_rsrc((void*)g.A, (short)0, (int)((size_t)g.M * K * 2), 0x00020000);
    const __amdgpu_buffer_rsrc_t srdB = __builtin_amdgcn_make_buffer_rsrc((void*)g.Bt, (short)0, (int)((size_t)g.N * K * 2), 0x00020000);
    const unsigned ldsb = (unsigned)(size_t)lds;
    const unsigned ldsw = (unsigned)wid * 1024u;
    const int aoff = lds_byte(wr * 64 + fr, fq * 8), boff = lds_byte(wc * 32 + fr, fq * 8);
#define PG8_SA(b, h) (((b) * 2 + (h)) * HTB)
#define PG8_SB(b, h) ((4 + (b) * 2 + (h)) * HTB)
#define PG8_STAGE(bufoff, srd, soff, voff) do { _Pragma("unroll") for (int _i = 0; _i < 2; ++_i) \
        asm volatile("s_mov_b32 m0, %0\n\ts_nop 0\n\tbuffer_load_dwordx4 %1, %2, %3 offen lds" :: "s"(ldsb + (unsigned)(bufoff) + ldsw + _i * 8192u), "v"((voff)[_i]), "s"(srd), "s"((unsigned)(soff)) : "m0", "memory"); } while (0)
#define PG8_LDA(dst, b, h) do { _Pragma("unroll") for (int m = 0; m < 4; ++m) _Pragma("unroll") for (int k = 0; k < 2; ++k) dst[m][k] = *(const PG8_LAS bf16x8*)(lds + PG8_SA(b, h) + aoff + m * 2048 + k * 1024); } while (0)
#define PG8_LDB(dst, b, h) do { _Pragma("unroll") for (int n = 0; n < 2; ++n) _Pragma("unroll") for (int k = 0; k < 2; ++k) dst[n][k] = *(const PG8_LAS bf16x8*)(lds + PG8_SB(b, h) + boff + n * 2048 + k * 1024); } while (0)
#define PG8_MMA(ai, bj, At, Bt) do { __builtin_amdgcn_s_setprio(1); _Pragma("unroll") for (int m = 0; m < 4; ++m) _Pragma("unroll") for (int n = 0; n < 2; ++n) _Pragma("unroll") for (int k = 0; k < 2; ++k) \
        acc[ai][bj][m][n] = __builtin_amdgcn_mfma_f32_16x16x32_bf16(Bt[n][k], At[m][k], acc[ai][bj][m][n], 0, 0, 0); __builtin_amdgcn_s_setprio(0); } while (0)
#define PG8_WAIT_V(n) asm volatile("s_waitcnt vmcnt(" #n ")" ::: "memory")
#define PG8_WAIT_L(n) asm volatile("s_waitcnt lgkmcnt(" #n ")" ::: "memory")
#define PG8_BAR __builtin_amdgcn_s_barrier()
#define PG8_SCHED __builtin_amdgcn_sched_barrier(0)
    Unit cur, nxt; int ui = 0;
    if (!S.next(0, cur)) return;
    f32x4 acc[2][2][4][2];
#pragma unroll
    for (int a = 0; a < 2; ++a)
#pragma unroll
        for (int b = 0; b < 2; ++b)
#pragma unroll
            for (int m = 0; m < 4; ++m)
#pragma unroll
                for (int n = 0; n < 2; ++n) acc[a][b][m][n] = (f32x4){0.f, 0.f, 0.f, 0.f};
    bf16x8 At[4][2], B0[2][2], B1[2][2];
    unsigned cA = (unsigned)cur.pm * tstep, cB = (unsigned)cur.pn * tstep;
    S.a_ready(cur);
    if constexpr (SP2) {
        PG8_STAGE(PG8_SB(0, 0), srdB, cB, voffB); PG8_STAGE(PG8_SB(0, 1), srdB, cB + hstep, voffB); PG8_STAGE(PG8_SA(0, 0), srdA, cA, voffA); PG8_STAGE(PG8_SA(0, 1), srdA, cA + hstep, voffA);
        if (wr == 1) PG8_BAR;
        PG8_WAIT_V(2); PG8_BAR;
        PG8_STAGE(PG8_SB(1, 0), srdB, cB + kstep, voffB); PG8_STAGE(PG8_SA(1, 0), srdA, cA + kstep, voffA); PG8_STAGE(PG8_SB(1, 1), srdB, cB + hstep + kstep, voffB);
        PG8_WAIT_V(6); PG8_BAR;
        PG8_STAGE(PG8_SA(1, 1), srdA, cA + kstep + hstep, voffA);
        if constexpr (XV > 0) {
            unsigned* sp = g.sink + ((size_t)blockIdx.x * 8 + wid) * 64 + lane; const unsigned zero = 0u;
#pragma unroll
            for (int i = 0; i < XV; ++i) asm volatile("global_store_dword %0, %1, off" :: "v"(sp), "v"(zero) : "memory");
        }
    } else {
        PG8_STAGE(PG8_SB(0, 0), srdB, cB, voffB); PG8_STAGE(PG8_SA(0, 0), srdA, cA, voffA); PG8_STAGE(PG8_SB(0, 1), srdB, cB + hstep, voffB); PG8_STAGE(PG8_SA(0, 1), srdA, cA + hstep, voffA);
        if (wr == 1) PG8_BAR;
        PG8_WAIT_V(4); PG8_BAR;
        PG8_STAGE(PG8_SB(1, 0), srdB, cB + kstep, voffB); PG8_STAGE(PG8_SA(1, 0), srdA, cA + kstep, voffA); PG8_STAGE(PG8_SB(1, 1), srdB, cB + hstep + kstep, voffB);
        PG8_WAIT_V(6); PG8_BAR;
    }
    for (;;) {
        const bool has_next = S.next(ui + 1, nxt);
        const unsigned nA = has_next ? (unsigned)nxt.pm * tstep : cA, nB = has_next ? (unsigned)nxt.pn * tstep : cB;
        if constexpr (SP2) {
#define PG8_PAIR(W3) do { \
            const bool last = (t == nt - 2); \
            const unsigned a2 = last ? nA : cA + (unsigned)(t + 2) * kstep, b2 = last ? nB : cB + (unsigned)(t + 2) * kstep;     \
            const unsigned a3 = a2 + kstep, b3 = b2 + kstep;                                \
            if (last && has_next) S.a_ready(nxt); \
              \
            PG8_LDB(B0, 0, 0); PG8_LDB(B1, 0, 1); PG8_SCHED; PG8_LDA(At, 0, 0); \
            W3; PG8_WAIT_L(0); PG8_BAR; PG8_MMA(0, 0, At, B0); PG8_MMA(0, 1, At, B1); PG8_BAR; PG8_SCHED; \
              \
            PG8_LDA(At, 0, 1); PG8_STAGE(PG8_SB(0, 0), srdB, b2, voffB); PG8_STAGE(PG8_SB(0, 1), srdB, b2 + hstep, voffB); PG8_STAGE(PG8_SA(0, 0), srdA, a2, voffA); \
            W3; PG8_WAIT_L(0); PG8_BAR; PG8_MMA(1, 0, At, B0); PG8_MMA(1, 1, At, B1); PG8_BAR; PG8_SCHED; \
              \
            PG8_LDB(B0, 1, 0); PG8_LDB(B1, 1, 1); PG8_SCHED; PG8_LDA(At, 1, 0); PG8_STAGE(PG8_SA(0, 1), srdA, a2 + hstep, voffA); \
            W3; PG8_WAIT_L(0); PG8_BAR; PG8_MMA(0, 0, At, B0); PG8_MMA(0, 1, At, B1); PG8_BAR; PG8_SCHED; \
              \
            PG8_LDA(At, 1, 1); PG8_STAGE(PG8_SB(1, 0), srdB, b3, voffB); PG8_STAGE(PG8_SB(1, 1), srdB, b3 + hstep, voffB); PG8_STAGE(PG8_SA(1, 0), srdA, a3, voffA); \
            PG8_WAIT_V(8); PG8_WAIT_L(0); PG8_BAR; PG8_MMA(1, 0, At, B0); PG8_MMA(1, 1, At, B1); PG8_BAR; PG8_SCHED; \
            PG8_STAGE(PG8_SA(1, 1), srdA, a3 + hstep, voffA); } while (0)
        { const int t = 0; PG8_PAIR(wait_vm<8 + XV>()); }
        for (int t = 2; t < nt; t += 2) PG8_PAIR(PG8_WAIT_V(8));
#undef PG8_PAIR
        } else {
        for (int t = 0; t < nt; t += 2) {
            const bool last = (t == nt - 2);
            const unsigned a1 = cA + (unsigned)(t + 1) * kstep;
            const unsigned a2 = last ? nA : cA + (unsigned)(t + 2) * kstep, b2 = last ? nB : cB + (unsigned)(t + 2) * kstep;
            const unsigned a3 = a2 + kstep, b3 = b2 + kstep;
            if (last && has_next) S.a_ready(nxt);
            PG8_LDB(B0, 0, 0); PG8_SCHED; PG8_LDA(At, 0, 0); PG8_STAGE(PG8_SA(1, 1), srdA, a1 + hstep, voffA);
            PG8_WAIT_L(8); PG8_BAR; PG8_WAIT_L(0); PG8_MMA(0, 0, At, B0); PG8_BAR; PG8_SCHED;
            PG8_LDB(B1, 0, 1); PG8_STAGE(PG8_SB(0, 0), srdB, b2, voffB);
            PG8_BAR; PG8_WAIT_L(0); PG8_MMA(0, 1, At, B1); PG8_BAR;
            PG8_LDA(At, 0, 1); PG8_STAGE(PG8_SA(0, 0), srdA, a2, voffA);
            PG8_BAR; PG8_WAIT_L(0); PG8_MMA(1, 0, At, B0); PG8_BAR; PG8_SCHED;
            PG8_STAGE(PG8_SB(0, 1), srdB, b2 + hstep, voffB);
            PG8_WAIT_V(6); PG8_BAR; PG8_MMA(1, 1, At, B1); PG8_BAR;
            PG8_LDB(B0, 1, 0); PG8_SCHED; PG8_LDA(At, 1, 0); PG8_STAGE(PG8_SA(0, 1), srdA, a2 + hstep, voffA);
            PG8_WAIT_L(8); PG8_BAR; PG8_WAIT_L(0); PG8_MMA(0, 0, At, B0); PG8_BAR; PG8_SCHED;
            PG8_LDB(B1, 1, 1); PG8_STAGE(PG8_SB(1, 0), srdB, b3, voffB);
            PG8_BAR; PG8_WAIT_L(0); PG8_MMA(0, 1, At, B1); PG8_BAR;
            PG8_LDA(At, 1, 1); PG8_STAGE(PG8_SA(1, 0), srdA, a3, voffA);
            PG8_BAR; PG8_WAIT_L(0); PG8_MMA(1, 0, At, B0); PG8_BAR; PG8_SCHED;
            PG8_STAGE(PG8_SB(1, 1), srdB, b3 + hstep, voffB);
            PG8_WAIT_V(6); PG8_BAR; PG8_MMA(1, 1, At, B1); PG8_BAR;
        }
        }
        if constexpr (ALIGN_EPI) { if (wr == 0) PG8_BAR; }
        if constexpr (!Epi::AFTER_DRAIN) { E(acc, cur, wr, wc, fr, fq); S.done(cur); }
        if (!has_next) break;
#pragma unroll
        for (int a = 0; a < 2; ++a)
#pragma unroll
            for (int b = 0; b < 2; ++b)
#pragma unroll
                for (int m = 0; m < 4; ++m)
#pragma unroll
                    for (int n = 0; n < 2; ++n) acc[a][b][m][n] = (f32x4){0.f, 0.f, 0.f, 0.f};
        cur = nxt; cA = nA; cB = nB; ++ui;
        if constexpr (ALIGN_EPI) { if (wr == 1) PG8_BAR; }
    }
    PG8_WAIT_V(0);
    if constexpr (!ALIGN_EPI) { if (wr == 0) PG8_BAR; }
    PG8_BAR;
    if constexpr (Epi::AFTER_DRAIN) { E.fused(acc, cur, wr, wc, fr, fq, lds, wid, lane); S.done(cur); }
#undef PG8_SA
#undef PG8_SB
#undef PG8_STAGE
#undef PG8_LDA
#undef PG8_LDB
#undef PG8_MMA
#undef PG8_WAIT_V
#undef PG8_WAIT_L
#undef PG8_BAR
#undef PG8_SCHED
}
}

constexpr int NWAVES = 8;
constexpr int NB = 32, SEQ = 2048, DM = 1024, MROWS = NB * SEQ;
constexpr int NPROJ = 3840;
constexpr int C_ZA = 1536, C_QB = 2048, C_ZB = 2560, C_IQ = 3072, C_CKV = 3584, C_IK = 3712;
constexpr float EPSF = 1e-6f;
constexpr float LOG2E = 1.4426950408889634f;
__host__ __device__ __forceinline__ int proj_src_col(int n) {
    if (n < 2048) return n;
    if (n < 2560) return n - 2048 + 2056;
    if (n < 3072) return n - 2560 + 2696;
    if (n < 3584) return n - 3072 + 3208;
    if (n < 3712) return n - 3584 + 2568;
    if (n < 3776) return n - 3712 + 3720;
    if (n < 3784) return n - 3776 + 2048;
    if (n < 3792) return n;
    return -1;
}
__device__ const unsigned char T5_BUCKET[128] = {0,1,2,3,4,5,6,7,8,9,10,11,12,13,14,15,16,16,16,17,17,18,18,18,19,19,19,20,20,20,20,21,21,21,21,22,22,22,22,22,23,23,23,23,23,23,24,24,24,24,24,24,25,25,25,25,25,25,25,26,26,26,26,26,26,26,26,27,27,27,27,27,27,27,27,27,27,28,28,28,28,28,28,28,28,28,28,29,29,29,29,29,29,29,29,29,29,29,29,30,30,30,30,30,30,30,30,30,30,30,30,30,30,31,31,31,31,31,31,31,31,31,31,31,31,31,31,31};

constexpr size_t MiB = 1u << 20;
constexpr size_t WS_CTL = 0, CTL_ZERO_BYTES = 1 * MiB;
constexpr size_t WS_MOD = 1 * MiB;
constexpr size_t WS_WUV = 2 * MiB;
constexpr size_t WS_WOUT = 3 * MiB;
constexpr size_t WS_WIN = 5 * MiB;
constexpr size_t WS_KVSS = 13 * MiB;
constexpr size_t WS_AUX = 14 * MiB;
constexpr size_t WS_XN = 32 * MiB;
constexpr size_t WS_PROJ = 160 * MiB;
constexpr size_t WS_SCR = 640 * MiB;
constexpr size_t WS_END = 768 * MiB;
constexpr int CW_TMO = 0, CW_QUEUE = 64, CW_BAR = 4096;

constexpr int LDS_BYTES = 163840;
constexpr int MISC_OFF = LDS_BYTES - 256;
constexpr int SCRATCH_BYTES = MISC_OFF;

#define GAS __attribute__((address_space(1)))
#define LAS __attribute__((address_space(3)))
typedef unsigned short bf16;
typedef unsigned v4u __attribute__((ext_vector_type(4)));
typedef unsigned v2u __attribute__((ext_vector_type(2)));
typedef float f32x4 __attribute__((ext_vector_type(4)));
typedef float f32x16 __attribute__((ext_vector_type(16)));
typedef short bf16x8 __attribute__((ext_vector_type(8)));
typedef GAS unsigned gu32;
#define RLX_AGENT __ATOMIC_RELAXED, __HIP_MEMORY_SCOPE_AGENT
#define LDS_WAIT() asm volatile("s_waitcnt lgkmcnt(0)" ::: "memory")
#define MFMA32(a, b, c) __builtin_amdgcn_mfma_f32_32x32x16_bf16((a), (b), (c), 0, 0, 0)
#define MFMA16F(a, b, c) __builtin_amdgcn_mfma_f32_16x16x4f32((a), (b), (c), 0, 0, 0)
__device__ __forceinline__ unsigned f2bf(float f) { unsigned u = __builtin_bit_cast(unsigned, f); return (u + 0x7fffu + ((u >> 16) & 1u)) >> 16; }
__device__ __forceinline__ unsigned pk2(float lo, float hi) { return f2bf(lo) | (f2bf(hi) << 16); }
__device__ __forceinline__ float bf2f(unsigned short b) { return __builtin_bit_cast(float, ((unsigned)b) << 16); }
__device__ __forceinline__ float bflo(unsigned w) { return __builtin_bit_cast(float, w << 16); }
__device__ __forceinline__ float bfhi(unsigned w) { return __builtin_bit_cast(float, w & 0xffff0000u); }
__device__ __forceinline__ float rcpf_(float x) { return __builtin_amdgcn_rcpf(x); }
__device__ __forceinline__ float rsqf_(float x) { return __builtin_amdgcn_rsqf(x); }
__device__ __forceinline__ float siluf(float x) { return x * __builtin_amdgcn_rcpf(1.0f + __builtin_amdgcn_exp2f(-1.4426950408889634f * x)); }
__device__ __forceinline__ float wave_sum(float v) {
#pragma unroll
    for (int o = 1; o < 64; o <<= 1) v += __shfl_xor(v, o);
    return v;
}

__device__ __forceinline__ float wave_sum_f(float v) {
#define WSF_(ctl, rm, bm) v += __builtin_bit_cast(float, __builtin_amdgcn_update_dpp(0, __builtin_bit_cast(int, v), ctl, rm, bm, false))
    WSF_(0x111, 0xf, 0xf); WSF_(0x112, 0xf, 0xf); WSF_(0x114, 0xf, 0xe); WSF_(0x118, 0xf, 0xc); WSF_(0x142, 0xa, 0xf); WSF_(0x143, 0xc, 0xf);
#undef WSF_
    return __builtin_bit_cast(float, __builtin_amdgcn_readlane(__builtin_bit_cast(int, v), 63));
}
__device__ __forceinline__ int wave_sum_i(int v) {
    v += __builtin_amdgcn_update_dpp(0, v, 0x111, 0xf, 0xf, false);
    v += __builtin_amdgcn_update_dpp(0, v, 0x112, 0xf, 0xf, false);
    v += __builtin_amdgcn_update_dpp(0, v, 0x114, 0xf, 0xe, false);
    v += __builtin_amdgcn_update_dpp(0, v, 0x118, 0xf, 0xc, false);
    v += __builtin_amdgcn_update_dpp(0, v, 0x142, 0xa, 0xf, false);
    v += __builtin_amdgcn_update_dpp(0, v, 0x143, 0xc, 0xf, false);
    return __builtin_amdgcn_readlane(v, 63);
}
__device__ __forceinline__ float wave_max(float v) {
    const int ninf = (int)0xff800000u;
#define WM_STEP(ctrl, rm, bm) v = fmaxf(v, __builtin_bit_cast(float, __builtin_amdgcn_update_dpp(ninf, __builtin_bit_cast(int, v), ctrl, rm, bm, false)))
    WM_STEP(0x111, 0xf, 0xf); WM_STEP(0x112, 0xf, 0xf); WM_STEP(0x114, 0xf, 0xe); WM_STEP(0x118, 0xf, 0xc); WM_STEP(0x142, 0xa, 0xf); WM_STEP(0x143, 0xc, 0xf);
#undef WM_STEP
    return __builtin_bit_cast(float, __builtin_amdgcn_readlane(__builtin_bit_cast(int, v), 63));
}
#define XB_TMO      128
#define XB_XCNT(j)  (256  + 64 * (j))
#define XB_XSUB(j)  (1280 + 64 * (j))
#define XB_XGEN(j)  (2304 + 64 * (j))
#define XB_TOP      3328
#define XB_TOPGEN   3392
#define XCD_BAR_WORDS 3456
#define XB_SPIN_CAP (1u << 18)

__device__ __forceinline__ unsigned xb_ld(unsigned* p)              { return __hip_atomic_load(p, __ATOMIC_RELAXED, __HIP_MEMORY_SCOPE_AGENT); }
__device__ __forceinline__ unsigned xb_add(unsigned* p, unsigned v) { return __hip_atomic_fetch_add(p, v, __ATOMIC_RELAXED, __HIP_MEMORY_SCOPE_AGENT); }
__device__ __forceinline__ unsigned xb_xcc_id() { return (unsigned)__builtin_amdgcn_s_getreg((3 << 11) | 20) & 0xFu; }
#define XB_SPIN(cond, bar) do { unsigned _sp = 0; while (cond) { __builtin_amdgcn_s_sleep(1); \
    if ((++_sp & 255u) == 0u) { if (xb_ld(&(bar)[XB_TMO])) break; if (_sp > XB_SPIN_CAP) { atomicAdd(&(bar)[XB_TMO], 1u); break; } } } } while (0)

struct XcdBarrier {
    unsigned* bar; unsigned x;
    volatile LAS unsigned* st;
};

__device__ __forceinline__ XcdBarrier xcd_barrier_post(unsigned* bar, volatile LAS unsigned* st) {
    XcdBarrier b; b.bar = bar; b.x = xb_xcc_id(); b.st = st;
    if (threadIdx.x == 0) (void)xb_add(&bar[XB_XCNT(b.x)], 1u);
    return b;
}
__device__ __forceinline__ void xcd_barrier_complete(unsigned* bar, unsigned x, unsigned& nloc, unsigned& nx) {
    const unsigned G = gridDim.x * gridDim.y * gridDim.z;
    unsigned sum, cnt, mine, sp = 0u;
    for (;;) {
        sum = 0u; cnt = 0u; mine = 0u;
#pragma unroll
        for (unsigned j = 0; j < 16; ++j) { const unsigned c = xb_ld(&bar[XB_XCNT(j)]); sum += c; cnt += (c > 0u) ? 1u : 0u; mine = (j == x) ? c : mine; }
        if (sum == G) break;
        __builtin_amdgcn_s_sleep(1);
        if ((++sp & 255u) == 0u) { if (xb_ld(&bar[XB_TMO])) break; if (sp > XB_SPIN_CAP) { atomicAdd(&bar[XB_TMO], 1u); break; } }
    }
    nloc = mine > 0u ? mine : 1u; nx = cnt > 0u ? cnt : 1u;
}

__device__ __forceinline__ void xcd_barrier(const XcdBarrier& b) {
    asm volatile("s_waitcnt vmcnt(0)" ::: "memory");
    __syncthreads();
    if (threadIdx.x == 0) {
        unsigned* bar = b.bar;
        __builtin_amdgcn_s_waitcnt(0);
        unsigned nloc = b.st[0], nx = b.st[1];
        if (nloc == 0u) { xcd_barrier_complete(bar, b.x, nloc, nx); b.st[0] = nloc; b.st[1] = nx; }
        const unsigned old = xb_add(&bar[XB_XSUB(b.x)], 1u);
        const unsigned gen = old / nloc;
        if (old + 1u == (gen + 1u) * nloc) {
            __builtin_amdgcn_fence(__ATOMIC_RELEASE, "agent");
            asm volatile("s_waitcnt vmcnt(0)" ::: "memory");
            const unsigned og = xb_add(&bar[XB_TOP], 1u);
            const unsigned tg = og / nx;
            if (og + 1u == (tg + 1u) * nx) xb_add(&bar[XB_TOPGEN], 1u);
            else XB_SPIN(xb_ld(&bar[XB_TOPGEN]) == tg, bar);
            __builtin_amdgcn_fence(__ATOMIC_ACQUIRE, "agent");
            xb_add(&bar[XB_XGEN(b.x)], 1u);
            asm volatile("s_waitcnt vmcnt(0)" ::: "memory");
        } else {
            XB_SPIN(xb_ld(&bar[XB_XGEN(b.x)]) == gen, bar);
            __builtin_amdgcn_fence(__ATOMIC_ACQUIRE, "agent");
            asm volatile("s_waitcnt vmcnt(0)" ::: "memory");
        }
    }
    __syncthreads();
}

struct Frame {
    LAS unsigned char* lds;
    volatile LAS unsigned* MISC;
    gu32* ctl;
    int tid, lane, wave;
    int vcu, G;
    unsigned char* ws;
};
#define P_X        (args.in[0])
#define P_C        (args.in[1])
#define P_WADA     (args.in[2])
#define P_BADA     (args.in[3])
#define P_GPRE     (args.in[4])
#define P_WIN      (args.in[5])
#define P_CONVW    (args.in[6])
#define P_ALOG     (args.in[7])
#define P_DTB      (args.in[8])
#define P_GGDN     (args.in[9])
#define P_GKV      (args.in[10])
#define P_WUV      (args.in[11])
#define P_RELB     (args.in[12])
#define P_WOUT     (args.in[13])
#define P_GPOST    (args.in[14])
#define P_OUT      (args.out)
#define W_MOD      ((float*)(F.ws + WS_MOD))
#define W_WUVT     ((bf16*)(F.ws + WS_WUV))
#define W_WOUTT    ((bf16*)(F.ws + WS_WOUT))
#define W_WINT     ((bf16*)(F.ws + WS_WIN))
#define W_KVSS     ((float*)(F.ws + WS_KVSS))
#define W_AUX      ((float*)(F.ws + WS_AUX))
#define W_XN       ((bf16*)(F.ws + WS_XN))
#define W_OAB      ((bf16*)(F.ws + WS_XN))
#define W_PROJ     ((bf16*)(F.ws + WS_PROJ))
#define W_MIX      ((bf16*)(F.ws + WS_PROJ))
#define W_SCR      ((float*)(F.ws + WS_SCR))
struct Args { const float* in[15]; float* out; unsigned char* ws; int ph_lo, ph_hi, li, pad; };

template <class CM>
__device__ __forceinline__ void transpose_item(const float* W, int ldw, bf16* WT, int K, int k0, int n0, LAS float* scr, int lane, CM cm) {
    const int nn = lane & 31, sc = cm(n0 + nn);
#pragma unroll 8
    for (int i = 0; i < 32; ++i) { const int kk = 2 * i + (lane >> 5); scr[kk * 33 + nn] = sc >= 0 ? __builtin_nontemporal_load(W + (size_t)(k0 + kk) * ldw + sc) : 0.f; }
    LDS_WAIT(); asm volatile("" ::: "memory");
    const int c = lane & 7;
#pragma unroll
    for (int j = 0; j < 4; ++j) { const int n = (lane >> 3) + 8 * j; const LAS float* s = scr + (8 * c) * 33 + n;
        v4u o; o.x = pk2(s[0 * 33], s[1 * 33]); o.y = pk2(s[2 * 33], s[3 * 33]); o.z = pk2(s[4 * 33], s[5 * 33]); o.w = pk2(s[6 * 33], s[7 * 33]);
        *(GAS v4u*)(WT + (size_t)(n0 + n) * K + k0 + 8 * c) = o; }
    LDS_WAIT(); asm volatile("" ::: "memory");
}
struct CmIdent { __device__ __forceinline__ int operator()(int n) const { return n; } };
struct CmProj { __device__ __forceinline__ int operator()(int n) const { return proj_src_col(n); } };

__device__ __forceinline__ void p0_prologue(Frame& F, const Args& args) {
    LAS float* scr = (LAS float*)(F.lds + F.wave * 16384);
    const int gw = F.vcu * NWAVES + F.wave, NGW = F.G * NWAVES;
    constexpr int I_IN = 16 * (NPROJ / 32), I_OUT = 16 * 32, I_UV = 4 * 2 * 4;
    for (int it = gw; it < I_IN + I_OUT + I_UV; it += NGW) {
        int r = it;
        if (r < I_IN) { const int kb = r / (NPROJ / 32), nb = r % (NPROJ / 32); transpose_item(P_WIN, 3792, W_WINT, 1024, 64 * kb, 32 * nb, scr, F.lane, CmProj()); continue; }
        r -= I_IN;
        if (r < I_OUT) { const int kb = r / 32, nb = r % 32; transpose_item(P_WOUT, 1024, W_WOUTT, 1024, 64 * kb, 32 * nb, scr, F.lane, CmIdent()); continue; }
        r -= I_OUT;
        { const int hd = r >> 3, kb = (r >> 2) & 1, nb = r & 3; transpose_item(P_WUV + (size_t)hd * 16384, 128, W_WUVT + (size_t)hd * 16384, 128, 64 * kb, 32 * nb, scr, F.lane, CmIdent()); }
    }
    __syncthreads();
    if (F.vcu < 192) {
        LAS float* SC = (LAS float*)F.lds;
        for (int e = F.tid; e < NB * 1024; e += NWAVES * 64) { const int b = e >> 10, k = e & 1023; SC[k * 33 + b] = siluf(P_C[e]); }
        __syncthreads();
        const int col = F.tid & 15, ks = F.tid >> 4, n = F.vcu * 16 + col;
        float acc[32];
#pragma unroll
        for (int b = 0; b < 32; ++b) acc[b] = 0.f;
        for (int kk = 0; kk < 32; ++kk) { const int k = ks * 32 + kk; const float w = __builtin_nontemporal_load(P_WADA + (size_t)k * 3072 + n);
#pragma unroll
            for (int b = 0; b < 32; ++b) acc[b] += SC[k * 33 + b] * w; }
        __syncthreads();
        LAS float* RED = (LAS float*)F.lds;
#pragma unroll
        for (int b = 0; b < 32; ++b) RED[(ks * 32 + b) * 16 + col] = acc[b];
        __syncthreads();
        { const int b = F.tid >> 4; float s = 0.f;
            for (int k2 = 0; k2 < 32; ++k2) s += RED[(k2 * 32 + b) * 16 + col];
            W_MOD[b * 3072 + n] = s + P_BADA[n]; }
        __syncthreads();
    }
}

__device__ __forceinline__ void p1_norm(Frame& F, const Args& args) {
    const int gw = F.vcu * NWAVES + F.wave, NGW = F.G * NWAVES;
    for (int m = 2 * gw; m < MROWS; m += 2 * NGW) {
        const int b = m >> 11;
        const GAS f32x4* xr = (const GAS f32x4*)(P_X + (size_t)m * DM) + F.lane;
        f32x4 v[2][4]; float ss[2] = {0.f, 0.f};
#pragma unroll
        for (int q = 0; q < 2; ++q)
#pragma unroll
            for (int j = 0; j < 4; ++j) v[q][j] = __builtin_nontemporal_load(xr + q * 256 + 64 * j);
#pragma unroll
        for (int q = 0; q < 2; ++q)
#pragma unroll
            for (int j = 0; j < 4; ++j) ss[q] += (v[q][j].x * v[q][j].x + v[q][j].y * v[q][j].y) + (v[q][j].z * v[q][j].z + v[q][j].w * v[q][j].w);
        const float rstd0 = rsqf_(wave_sum(ss[0]) * (1.0f / DM) + EPSF), rstd1 = rsqf_(wave_sum(ss[1]) * (1.0f / DM) + EPSF);
        const float* mb = W_MOD + b * 3072;
        GAS unsigned long long* o8 = (GAS unsigned long long*)(W_XN + (size_t)m * DM) + F.lane;
#pragma unroll
        for (int j = 0; j < 4; ++j) { const int col = F.lane * 4 + 256 * j;
            const f32x4 g = *(const f32x4*)(P_GPRE + col), sh = *(const f32x4*)(mb + col), sc = *(const f32x4*)(mb + 1024 + col);
            const f32x4 gs = g * (sc + 1.0f);
            const f32x4 o0 = v[0][j] * rstd0 * gs + sh, o1 = v[1][j] * rstd1 * gs + sh;
            o8[64 * j] = (unsigned long long)pg8::cvt_pk_bf16(o0.x, o0.y) | ((unsigned long long)pg8::cvt_pk_bf16(o0.z, o0.w) << 32);
            o8[256 + 64 * j] = (unsigned long long)pg8::cvt_pk_bf16(o1.x, o1.y) | ((unsigned long long)pg8::cvt_pk_bf16(o1.z, o1.w) << 32); }
    }
}

__device__ __forceinline__ void p5_final(Frame& F, const Args& args) {
    const int gw = F.vcu * NWAVES + F.wave, NGW = F.G * NWAVES;
    for (int m = 2 * gw; m < MROWS; m += 2 * NGW) {
        const int b = m >> 11;
        const GAS v2u* mr = (const GAS v2u*)(W_MIX + (size_t)m * DM) + F.lane;
        const GAS f32x4* xr = (const GAS f32x4*)(P_X + (size_t)m * DM) + F.lane;
        GAS f32x4* orow = (GAS f32x4*)(P_OUT + (size_t)m * DM) + F.lane;
        v2u w[2][4]; f32x4 xv[2][4];
#pragma unroll
        for (int q = 0; q < 2; ++q)
#pragma unroll
            for (int j = 0; j < 4; ++j) { w[q][j] = mr[q * 256 + 64 * j]; xv[q][j] = __builtin_nontemporal_load(xr + q * 256 + 64 * j); }
        f32x4 v[2][4]; float ss[2] = {0.f, 0.f};
#pragma unroll
        for (int q = 0; q < 2; ++q)
#pragma unroll
            for (int j = 0; j < 4; ++j) { v[q][j].x = bflo(w[q][j].x); v[q][j].y = bfhi(w[q][j].x); v[q][j].z = bflo(w[q][j].y); v[q][j].w = bfhi(w[q][j].y);
                ss[q] += (v[q][j].x * v[q][j].x + v[q][j].y * v[q][j].y) + (v[q][j].z * v[q][j].z + v[q][j].w * v[q][j].w); }
        const float rstd0 = rsqf_(wave_sum(ss[0]) * (1.0f / DM) + EPSF), rstd1 = rsqf_(wave_sum(ss[1]) * (1.0f / DM) + EPSF);
        const float* gt = W_MOD + b * 3072 + 2048;
#pragma unroll
        for (int j = 0; j < 4; ++j) { const int col = F.lane * 4 + 256 * j;
            const f32x4 g = *(const f32x4*)(P_GPOST + col), ga = *(const f32x4*)(gt + col);
            const f32x4 gg = g * ga;
            __builtin_nontemporal_store(xv[0][j] + gg * (v[0][j] * rstd0), orow + 64 * j);
            __builtin_nontemporal_store(xv[1][j] + gg * (v[1][j] * rstd1), orow + 256 + 64 * j); }
    }
}

__device__ __forceinline__ unsigned cvtpk(float lo, float hi) { return pg8::cvt_pk_bf16(lo, hi); }
__device__ __forceinline__ v2u pack4(float a, float b, float c, float d) { v2u r; r.x = cvtpk(a, b); r.y = cvtpk(c, d); return r; }
__device__ __forceinline__ bf16x8 pack8(float a, float b, float c, float d, float e, float f, float g, float h) { v4u r; r.x = cvtpk(a, b); r.y = cvtpk(c, d); r.z = cvtpk(e, f); r.w = cvtpk(g, h); return __builtin_bit_cast(bf16x8, r); }
__device__ __forceinline__ bf16x8 lds16(const LAS unsigned char* p) { return *(const LAS bf16x8*)p; }
__device__ __forceinline__ bf16x8 lds8x2(const LAS unsigned char* p) { const v2u lo = *(const LAS v2u*)p, hi = *(const LAS v2u*)(p + 16); v4u r; r.x = lo.x; r.y = lo.y; r.z = hi.x; r.w = hi.y; return __builtin_bit_cast(bf16x8, r); }
template <int S> __device__ __forceinline__ bf16x8 acc_frag(const f32x16& a) { return pack8(a[8 * S + 0], a[8 * S + 1], a[8 * S + 2], a[8 * S + 3], a[8 * S + 4], a[8 * S + 5], a[8 * S + 6], a[8 * S + 7]); }

__device__ __forceinline__ float row16_sum(float v) {
#define R16_STEP(ctrl) v += __builtin_bit_cast(float, __builtin_amdgcn_update_dpp(0, __builtin_bit_cast(int, v), ctrl, 0xf, 0xf, false))
    R16_STEP(0x121); R16_STEP(0x122); R16_STEP(0x124); R16_STEP(0x128);
#undef R16_STEP
    return v;
}

__device__ __forceinline__ void gdn_unit(Frame& F, const Args& args, const int b, const int h) {
    LAS unsigned char* const L = F.lds;
    const int tid = F.tid, lane = F.lane, wv = F.wave, l31_0 = lane & 31, hh_0 = lane >> 5;
    int tidv = tid, lanev = lane;
    constexpr int P128 = 272, P64 = 144;
    constexpr int O_KH = 0, O_QH = O_KH + 17408, O_KGT = O_QH + 17408, O_VBT = O_KGT + 18432, O_KBGT = O_VBT + 18432, O_LM = O_KBGT + 18432, O_T = O_LM + 17408,
                  O_AT = O_T + 17408, O_CW = O_AT + 9216, O_SM = O_CW + 6144, O_PSO = O_SM + 2560, O_OF = O_PSO + 2048, O_END = O_OF + 17408;
    static_assert(O_END <= SCRATCH_BYTES, "gdn LDS map");
    constexpr int O_W = O_LM, O_VNT = O_VBT;
    LAS float* const SMb = (LAS float*)(L + O_SM);
    LAS float* const LM = (LAS float*)(L + O_LM);
    LAS float* const TT = (LAS float*)(L + O_T);
    LAS float* const CW = (LAS float*)(L + O_CW);
    LAS float* const PSO = (LAS float*)(L + O_PSO);
    const int mt = wv >> 2, nt = wv & 3;
    f32x16 S[4];
#pragma unroll
    for (int k = 0; k < 4; ++k)
#pragma unroll
        for (int r = 0; r < 16; ++r) S[k][r] = 0.f;
    const float alog_e = __expf(P_ALOG[h]), dtb = P_DTB[h];
#define GDN_GATES(n_) do { LAS float* _sm = SMb + ((n_) & 1) * 320; const float* _ap = W_AUX + (size_t)(b * SEQ + (n_) * 64 + lanev) * 16; \
        const float _bb = _ap[h], _aa = _ap[4 + h]; const float _beta = rcpf_(1.0f + __expf(-_bb)); const float _xs = _aa + dtb; \
        const float _sp = _xs > 20.f ? _xs : log1pf(__expf(_xs)); float _gc = -alog_e * _sp; \
        _Pragma("unroll") for (int _o = 1; _o < 64; _o <<= 1) { const float _t = __shfl_up(_gc, _o); if (lanev >= _o) _gc += _t; } \
        const float _gl = __shfl(_gc, 63); _sm[lanev] = _gc; _sm[64 + lanev] = _beta; _sm[128 + lanev] = __expf(_gc); _sm[192 + lanev] = __expf(_gl - _gc); \
        if (lanev == 0) _sm[256] = __expf(_gl); } while (0)
    if (wv == 6) GDN_GATES(0);
    for (int e = tidv; e < 3 * 4 * 128; e += NWAVES * 64) { const int ts_ = e >> 9, tap = (e >> 7) & 3, ch = e & 127; CW[e] = P_CONVW[tap * 1536 + ts_ * 512 + h * 128 + ch]; }
    const int ts = tid >> 8;
    int cgv = tid & 15, tpv = (tid >> 4) & 15;
#define GDN_ROWS(dst_, n_, chan_) do { const bf16* _src = W_PROJ + (size_t)(b * SEQ + (n_) * 64 + 4 * tpv - 3) * NPROJ + (chan_); \
        _Pragma("unroll") for (int _i = 0; _i < 7; ++_i) { v4u _z; _z.x = 0u; _z.y = 0u; _z.z = 0u; _z.w = 0u; dst_[_i] = _z; \
            if ((n_) > 0 || 4 * tpv - 3 + _i >= 0) dst_[_i] = *(const GAS v4u*)(_src + (size_t)_i * NPROJ); } } while (0)
#define GDN_OUT(rowb_) do { const int _tok = tidv >> 3, _dv0 = (tidv & 7) * 16; const size_t _row = (size_t)(rowb_) + _tok; \
        const LAS v4u* _op = (const LAS v4u*)(L + O_OF + _tok * P128 + _dv0 * 2); const v4u _o0 = _op[0], _o1 = _op[1]; \
        const LAS f32x4* _pp = (const LAS f32x4*)(PSO + _tok * 8); const f32x4 _a = _pp[0], _c = _pp[1]; \
        const float _rstd = rsqf_((((_a.x + _a.y) + (_a.z + _a.w)) + ((_c.x + _c.y) + (_c.z + _c.w))) * (1.0f / 128.0f) + EPSF); \
        const bf16* _zp = W_PROJ + _row * NPROJ + C_ZA + h * 128 + _dv0; const v4u _z0 = *(const GAS v4u*)_zp, _z1 = *(const GAS v4u*)(_zp + 8); \
        const unsigned _ow[8] = {_o0.x, _o0.y, _o0.z, _o0.w, _o1.x, _o1.y, _o1.z, _o1.w}, _zw[8] = {_z0.x, _z0.y, _z0.z, _z0.w, _z1.x, _z1.y, _z1.z, _z1.w}; unsigned _rw[8]; \
        _Pragma("unroll") for (int _k = 0; _k < 4; ++_k) { const f32x4 _g = *(const f32x4*)(P_GGDN + _dv0 + 4 * _k); \
            _rw[2 * _k] = cvtpk(bflo(_ow[2 * _k]) * _rstd * _g.x * siluf(bflo(_zw[2 * _k])), bfhi(_ow[2 * _k]) * _rstd * _g.y * siluf(bfhi(_zw[2 * _k]))); \
            _rw[2 * _k + 1] = cvtpk(bflo(_ow[2 * _k + 1]) * _rstd * _g.z * siluf(bflo(_zw[2 * _k + 1])), bfhi(_ow[2 * _k + 1]) * _rstd * _g.w * siluf(bfhi(_zw[2 * _k + 1]))); } \
        bf16* _dst = W_OAB + _row * DM + h * 128 + _dv0; v4u _w0, _w1; _w0.x = _rw[0]; _w0.y = _rw[1]; _w0.z = _rw[2]; _w0.w = _rw[3]; _w1.x = _rw[4]; _w1.y = _rw[5]; _w1.z = _rw[6]; _w1.w = _rw[7]; \
        *(GAS v4u*)_dst = _w0; *(GAS v4u*)(_dst + 8) = _w1; } while (0)
    __syncthreads();

    unsigned pf_sink = 0u;
    for (int n = 0; n < 32; ++n) {
        const int rowbase = b * SEQ + n * 64;
        LAS float* const SMf = SMb + (n & 1) * 320;
        tidv = tid; lanev = lane; cgv = tid & 15; tpv = (tid >> 4) & 15;
        asm volatile("" : "+v"(tidv), "+v"(lanev), "+v"(cgv), "+v"(tpv));
        int l31 = lanev & 31, hh = lanev >> 5, cg = cgv, tp = tpv;
        if (wv == 6 && n + 1 < 32) GDN_GATES(n + 1);
        float val[4][8];
#define GDN_CONV(rows_, tsel_) do { \
            _Pragma("unroll") for (int _j = 0; _j < 4; ++_j) _Pragma("unroll") for (int _e = 0; _e < 8; ++_e) val[_j][_e] = 0.f; \
            _Pragma("unroll") for (int _tap = 0; _tap < 4; ++_tap) { const LAS f32x4* _cp = (const LAS f32x4*)(CW + ((tsel_) * 4 + _tap) * 128 + cg * 8); const f32x4 _c0 = _cp[0], _c1 = _cp[1]; \
                const float _cw[8] = {_c0.x, _c0.y, _c0.z, _c0.w, _c1.x, _c1.y, _c1.z, _c1.w}; \
                _Pragma("unroll") for (int _j = 0; _j < 4; ++_j) { const v4u _raw = rows_[_j + _tap]; \
                    const float _in[8] = {bflo(_raw.x), bfhi(_raw.x), bflo(_raw.y), bfhi(_raw.y), bflo(_raw.z), bfhi(_raw.z), bflo(_raw.w), bfhi(_raw.w)}; \
                    _Pragma("unroll") for (int _e = 0; _e < 8; ++_e) val[_j][_e] += _in[_e] * _cw[_e]; } } \
            _Pragma("unroll") for (int _j = 0; _j < 4; ++_j) _Pragma("unroll") for (int _e = 0; _e < 8; ++_e) val[_j][_e] = siluf(val[_j][_e]); } while (0)
        v4u rq[7], rv[7];
        GDN_ROWS(rq, n, ts * 512 + h * 128 + cgv * 8);
        if (wv < 4) GDN_ROWS(rv, n, 1024 + h * 128 + cgv * 8);
        if (wv == 7 && n + 1 < 32) {
#pragma unroll
            for (int i = 0; i < 9; ++i) { const int idx = i * 64 + lanev; const int rr = idx >> 3, ln = idx & 7;
                if (idx < 67 * 8) { const bf16* pt = W_PROJ + (size_t)(rowbase + 61 + rr) * NPROJ + (ln >> 1) * 512 + h * 128 + (ln & 1) * 64;
                    asm volatile("global_load_dword %0, %1, off" : "+v"(pf_sink) : "v"(pt) : "memory"); } }
        }
        {
            GDN_CONV(rq, ts);
#pragma unroll
            for (int j = 0; j < 4; ++j) { float ss = 0.f;
#pragma unroll
                for (int e = 0; e < 8; ++e) ss += val[j][e] * val[j][e];
                ss = row16_sum(ss);
                float r = rsqf_(ss + EPSF); if (ts == 0) r *= 0.08838834764831845f;
#pragma unroll
                for (int e = 0; e < 8; ++e) val[j][e] *= r; }
            if (ts == 0) {
#pragma unroll
                for (int j = 0; j < 4; ++j) *(LAS bf16x8*)(L + O_QH + (4 * tp + j) * P128 + cg * 16) = pack8(val[j][0], val[j][1], val[j][2], val[j][3], val[j][4], val[j][5], val[j][6], val[j][7]);
            } else {
                float ek[4], bg[4];
#pragma unroll
                for (int j = 0; j < 4; ++j) { ek[j] = SMf[192 + 4 * tp + j]; bg[j] = SMf[64 + 4 * tp + j] * SMf[128 + 4 * tp + j]; }
#pragma unroll
                for (int j = 0; j < 4; ++j) *(LAS bf16x8*)(L + O_KH + (4 * tp + j) * P128 + cg * 16) = pack8(val[j][0], val[j][1], val[j][2], val[j][3], val[j][4], val[j][5], val[j][6], val[j][7]);
#pragma unroll
                for (int e = 0; e < 8; ++e) {
                    *(LAS v2u*)(L + O_KGT + (cg * 8 + e) * P64 + tp * 8) = pack4(val[0][e] * ek[0], val[1][e] * ek[1], val[2][e] * ek[2], val[3][e] * ek[3]);
                    *(LAS v2u*)(L + O_KBGT + (cg * 8 + e) * P64 + tp * 8) = pack4(val[0][e] * bg[0], val[1][e] * bg[1], val[2][e] * bg[2], val[3][e] * bg[3]); }
            }
        }
        if (n > 0) GDN_OUT(rowbase - 64);
        if (wv < 4) {
            GDN_CONV(rv, 2);
            float be[4];
#pragma unroll
            for (int j = 0; j < 4; ++j) be[j] = SMf[64 + 4 * tp + j];
#pragma unroll
            for (int e = 0; e < 8; ++e) *(LAS v2u*)(L + O_VBT + (cg * 8 + e) * P64 + tp * 8) = pack4(val[0][e] * be[0], val[1][e] * be[1], val[2][e] * be[2], val[3][e] * be[3]);
        }
        for (int e = tidv; e < 64 * 68; e += NWAVES * 64) TT[e] = 0.f;
        __syncthreads();
        if (wv < 4) {
            const int ti = wv >> 1, tj = wv & 1;
            f32x16 C;
#pragma unroll
            for (int r = 0; r < 16; ++r) C[r] = 0.f;
            if (ti >= tj) {
                bf16x8 fa[8], fb[8];
#pragma unroll
                for (int s = 0; s < 8; ++s) { fa[s] = lds16(L + O_KH + (32 * ti + l31) * P128 + (16 * s + 8 * hh) * 2); fb[s] = lds16(L + O_KH + (32 * tj + l31) * P128 + (16 * s + 8 * hh) * 2); }
                __builtin_amdgcn_sched_barrier(0);
#pragma unroll
                for (int s = 0; s < 8; ++s) C = MFMA32(fa[s], fb[s], C);
            }
            const int j = 32 * tj + l31; const float gcj = SMf[j];
#pragma unroll
            for (int g = 0; g < 4; ++g) { const int ib = 32 * ti + 8 * g + 4 * hh; const f32x4 gci = *(const LAS f32x4*)(SMf + ib), bei = *(const LAS f32x4*)(SMf + 64 + ib);
#pragma unroll
                for (int e = 0; e < 4; ++e) { const int i = ib + e; LM[i * 68 + j] = (i > j) ? bei[e] * C[4 * g + e] * __expf(gci[e] - gcj) : 0.f; } }
            if (ti == tj) {
                asm volatile("s_waitcnt lgkmcnt(0)" ::: "memory");
                const int a = 2 * ti, bq = 2 * ti + 1;
                if (lanev < 32) {
                    const int blk = a + (lanev >> 4), c = lanev & 15; float x[16];
    #pragma unroll
                    for (int i = 0; i < 16; ++i) { const LAS float* lr = LM + (16 * blk + i) * 68 + 16 * blk; float acc = (i == c) ? 1.f : 0.f;
    #pragma unroll
                        for (int j = 0; j < i; ++j) acc -= lr[j] * x[j];
                        x[i] = acc; TT[(16 * blk + i) * 68 + 16 * blk + c] = acc; }
                }
                asm volatile("s_waitcnt lgkmcnt(0)" ::: "memory");
                const int m = lanev & 15, q = lanev >> 4;
                f32x4 P = {0.f, 0.f, 0.f, 0.f}, R = {0.f, 0.f, 0.f, 0.f};
    #pragma unroll
                for (int s = 0; s < 4; ++s) { const int k = q + 4 * s; P = MFMA16F(LM[(16 * bq + m) * 68 + 16 * a + k], TT[(16 * a + k) * 68 + 16 * a + m], P); }
    #pragma unroll
                for (int rg = 0; rg < 4; ++rg) { const int k = 4 * q + rg; R = MFMA16F(TT[(16 * bq + m) * 68 + 16 * bq + k], P[rg], R); }
    #pragma unroll
                for (int rg = 0; rg < 4; ++rg) TT[(16 * bq + 4 * q + rg) * 68 + 16 * a + m] = -R[rg];
            }
        } else {
            const int w4 = wv - 4, tj = w4 >> 1, ti = w4 & 1;
            f32x16 C;
#pragma unroll
            for (int r = 0; r < 16; ++r) C[r] = 0.f;
            if (ti >= tj) {
                bf16x8 fa[8], fb[8];
#pragma unroll
                for (int s = 0; s < 8; ++s) { fa[s] = lds16(L + O_KH + (32 * tj + l31) * P128 + (16 * s + 8 * hh) * 2); fb[s] = lds16(L + O_QH + (32 * ti + l31) * P128 + (16 * s + 8 * hh) * 2); }
                __builtin_amdgcn_sched_barrier(0);
#pragma unroll
                for (int s = 0; s < 8; ++s) C = MFMA32(fa[s], fb[s], C);
            }
            const int i = 32 * ti + l31; const float gci = SMf[i];
#pragma unroll
            for (int g = 0; g < 4; ++g) { const int jb = 32 * tj + 8 * g + 4 * hh; const f32x4 gcj = *(const LAS f32x4*)(SMf + jb); float v[4];
#pragma unroll
                for (int e = 0; e < 4; ++e) v[e] = (i >= jb + e) ? C[4 * g + e] * __expf(gci - gcj[e]) : 0.f;
                *(LAS v2u*)(L + O_AT + i * P64 + jb * 2) = pack4(v[0], v[1], v[2], v[3]); }
        }
        __syncthreads();
        if (wv < 4) {
            const int m = lanev & 15, q = lanev >> 4, mi = wv >> 1, ni = wv & 1;
            f32x4 P0 = {0.f, 0.f, 0.f, 0.f}, P1 = {0.f, 0.f, 0.f, 0.f}, R = {0.f, 0.f, 0.f, 0.f};
            float bt[8], l0[8], l1[8], t0[4], t1[4];
#pragma unroll
            for (int s = 0; s < 8; ++s) { const int k = q + 4 * s; bt[s] = TT[k * 68 + 16 * ni + m]; l0[s] = LM[(32 + m) * 68 + k]; l1[s] = LM[(48 + m) * 68 + k]; }
#pragma unroll
            for (int rg = 0; rg < 4; ++rg) { t0[rg] = TT[(32 + 16 * mi + m) * 68 + 32 + 4 * q + rg]; t1[rg] = TT[(32 + 16 * mi + m) * 68 + 48 + 4 * q + rg]; }
            __builtin_amdgcn_sched_barrier(0);
#pragma unroll
            for (int s = 0; s < 8; ++s) { P0 = MFMA16F(l0[s], bt[s], P0); P1 = MFMA16F(l1[s], bt[s], P1); }
#pragma unroll
            for (int rg = 0; rg < 4; ++rg) { R = MFMA16F(t0[rg], P0[rg], R); R = MFMA16F(t1[rg], P1[rg], R); }
#pragma unroll
            for (int rg = 0; rg < 4; ++rg) TT[(32 + 16 * mi + 4 * q + rg) * 68 + 16 * ni + m] = -R[rg];
        }
        __syncthreads();
        f32x16 U, WT_;
#pragma unroll
        for (int r = 0; r < 16; ++r) { U[r] = 0.f; WT_[r] = 0.f; }
        {
            f32x4 tq0[4], tq1[4]; bf16x8 fv[4], fk[4];
#pragma unroll
            for (int s = 0; s < 4; ++s) { const LAS f32x4* tp4 = (const LAS f32x4*)(TT + (32 * mt + l31) * 68 + 16 * s + 8 * hh); tq0[s] = tp4[0]; tq1[s] = tp4[1];
                fv[s] = lds16(L + O_VBT + (32 * nt + l31) * P64 + (16 * s + 8 * hh) * 2); fk[s] = lds16(L + O_KBGT + (32 * nt + l31) * P64 + (16 * s + 8 * hh) * 2); }
            __builtin_amdgcn_sched_barrier(0);
#pragma unroll
            for (int s = 0; s < 4; ++s) { const bf16x8 a = pack8(tq0[s].x, tq0[s].y, tq0[s].z, tq0[s].w, tq1[s].x, tq1[s].y, tq1[s].z, tq1[s].w);
                U = MFMA32(a, fv[s], U); WT_ = MFMA32(fk[s], a, WT_); }
        }
#pragma unroll
        for (int g = 0; g < 4; ++g) *(LAS v2u*)(L + O_W + (32 * mt + l31) * P128 + (32 * nt + 8 * g + 4 * hh) * 2) = pack4(-WT_[4 * g], -WT_[4 * g + 1], -WT_[4 * g + 2], -WT_[4 * g + 3]);
        __syncthreads();
        bf16x8 sf[4][2];
#pragma unroll
        for (int kt = 0; kt < 4; ++kt) { sf[kt][0] = acc_frag<0>(S[kt]); sf[kt][1] = acc_frag<1>(S[kt]); }
        {
            bf16x8 fw[4][2];
#pragma unroll
            for (int kt = 0; kt < 4; ++kt)
#pragma unroll
                for (int s = 0; s < 2; ++s) fw[kt][s] = lds8x2(L + O_W + (32 * mt + l31) * P128 + (32 * kt + 16 * s + 4 * hh) * 2);
            __builtin_amdgcn_sched_barrier(0);
#pragma unroll
            for (int kt = 0; kt < 4; ++kt)
#pragma unroll
                for (int s = 0; s < 2; ++s) U = MFMA32(fw[kt][s], sf[kt][s], U);
        }
#pragma unroll
        for (int g = 0; g < 4; ++g) *(LAS v2u*)(L + O_VNT + (32 * nt + l31) * P64 + (32 * mt + 8 * g + 4 * hh) * 2) = pack4(U[4 * g], U[4 * g + 1], U[4 * g + 2], U[4 * g + 3]);
        __syncthreads();
        {
            f32x16 Oa;
#pragma unroll
            for (int r = 0; r < 16; ++r) Oa[r] = 0.f;
            bf16x8 vn[4], fat[4], fg[4]; f32x4 e4[4];
            {
                bf16x8 fq[4][2];
#pragma unroll
                for (int kt = 0; kt < 4; ++kt)
#pragma unroll
                    for (int s = 0; s < 2; ++s) fq[kt][s] = lds8x2(L + O_QH + (32 * mt + l31) * P128 + (32 * kt + 16 * s + 4 * hh) * 2);
                __builtin_amdgcn_sched_barrier(0);
#pragma unroll
                for (int kt = 0; kt < 4; ++kt)
#pragma unroll
                    for (int s = 0; s < 2; ++s) Oa = MFMA32(fq[kt][s], sf[kt][s], Oa);
            }
#pragma unroll
            for (int g = 0; g < 4; ++g) e4[g] = *(const LAS f32x4*)(SMf + 128 + 32 * mt + 8 * g + 4 * hh);
#pragma unroll
            for (int s = 0; s < 4; ++s) { vn[s] = lds16(L + O_VNT + (32 * nt + l31) * P64 + (16 * s + 8 * hh) * 2); fat[s] = lds16(L + O_AT + (32 * mt + l31) * P64 + (16 * s + 8 * hh) * 2); }
            const float glast = SMf[256];
#pragma unroll
            for (int s = 0; s < 4; ++s) fg[s] = lds16(L + O_KGT + l31 * P64 + (16 * s + 8 * hh) * 2);
            __builtin_amdgcn_sched_barrier(0);
#pragma unroll
            for (int g = 0; g < 4; ++g)
#pragma unroll
                for (int e = 0; e < 4; ++e) Oa[4 * g + e] *= e4[g][e];
#pragma unroll
            for (int s = 0; s < 4; ++s) Oa = MFMA32(fat[s], vn[s], Oa);
#pragma unroll
            for (int kt = 0; kt < 4; ++kt) {
#pragma unroll
                for (int r = 0; r < 16; ++r) S[kt][r] *= glast;
#pragma unroll
                for (int s = 0; s < 4; ++s) S[kt] = MFMA32(fg[s], vn[s], S[kt]);
                if (kt < 3) {
#pragma unroll
                    for (int s = 0; s < 4; ++s) fg[s] = lds16(L + O_KGT + (32 * (kt + 1) + l31) * P64 + (16 * s + 8 * hh) * 2);
                }
            }
#pragma unroll
            for (int r = 0; r < 16; ++r) { const float q2 = row16_sum(Oa[r] * Oa[r]);
                if ((lanev & 15) == 0) PSO[(32 * mt + 8 * (r >> 2) + 4 * hh + (r & 3)) * 8 + 2 * nt + ((lanev >> 4) & 1)] = q2;
                *(LAS unsigned short*)(L + O_OF + (32 * mt + 8 * (r >> 2) + 4 * hh + (r & 3)) * P128 + (32 * nt + l31) * 2) = (unsigned short)cvtpk(Oa[r], 0.f); }
        }
        asm volatile("s_waitcnt vmcnt(0)" : "+v"(pf_sink) :: "memory");
        __syncthreads();
    }
    GDN_OUT(b * SEQ + 31 * 64);
    __syncthreads();
#undef GDN_GATES
#undef GDN_CONV
#undef GDN_ROWS
#undef GDN_OUT
}

typedef short s16x4 __attribute__((ext_vector_type(4)));
__device__ __forceinline__ bf16x8 ldstr8(const LAS unsigned char* p0, const LAS unsigned char* p1) {
    const s16x4 a = __builtin_amdgcn_ds_read_tr16_b64_v4i16((LAS s16x4*)p0), b = __builtin_amdgcn_ds_read_tr16_b64_v4i16((LAS s16x4*)p1);
    bf16x8 r; r[0] = a[0]; r[1] = a[1]; r[2] = a[2]; r[3] = a[3]; r[4] = b[0]; r[5] = b[1]; r[6] = b[2]; r[7] = b[3]; return r;
}
__device__ __forceinline__ void wrlane(unsigned& dst, const unsigned val, const int idx) {
    switch (idx) {
    case 0: asm("s_nop 1\n\tv_writelane_b32 %0, %1, 0" : "+v"(dst) : "s"(val)); break;
    case 1: asm("s_nop 1\n\tv_writelane_b32 %0, %1, 1" : "+v"(dst) : "s"(val)); break;
    case 2: asm("s_nop 1\n\tv_writelane_b32 %0, %1, 2" : "+v"(dst) : "s"(val)); break;
    case 3: asm("s_nop 1\n\tv_writelane_b32 %0, %1, 3" : "+v"(dst) : "s"(val)); break;
    case 4: asm("s_nop 1\n\tv_writelane_b32 %0, %1, 4" : "+v"(dst) : "s"(val)); break;
    case 5: asm("s_nop 1\n\tv_writelane_b32 %0, %1, 5" : "+v"(dst) : "s"(val)); break;
    case 6: asm("s_nop 1\n\tv_writelane_b32 %0, %1, 6" : "+v"(dst) : "s"(val)); break;
    case 7: asm("s_nop 1\n\tv_writelane_b32 %0, %1, 7" : "+v"(dst) : "s"(val)); break;
    case 8: asm("s_nop 1\n\tv_writelane_b32 %0, %1, 8" : "+v"(dst) : "s"(val)); break;
    case 9: asm("s_nop 1\n\tv_writelane_b32 %0, %1, 9" : "+v"(dst) : "s"(val)); break;
    case 10: asm("s_nop 1\n\tv_writelane_b32 %0, %1, 10" : "+v"(dst) : "s"(val)); break;
    case 11: asm("s_nop 1\n\tv_writelane_b32 %0, %1, 11" : "+v"(dst) : "s"(val)); break;
    case 12: asm("s_nop 1\n\tv_writelane_b32 %0, %1, 12" : "+v"(dst) : "s"(val)); break;
    case 13: asm("s_nop 1\n\tv_writelane_b32 %0, %1, 13" : "+v"(dst) : "s"(val)); break;
    case 14: asm("s_nop 1\n\tv_writelane_b32 %0, %1, 14" : "+v"(dst) : "s"(val)); break;
    case 15: asm("s_nop 1\n\tv_writelane_b32 %0, %1, 15" : "+v"(dst) : "s"(val)); break;
    case 16: asm("s_nop 1\n\tv_writelane_b32 %0, %1, 16" : "+v"(dst) : "s"(val)); break;
    case 17: asm("s_nop 1\n\tv_writelane_b32 %0, %1, 17" : "+v"(dst) : "s"(val)); break;
    case 18: asm("s_nop 1\n\tv_writelane_b32 %0, %1, 18" : "+v"(dst) : "s"(val)); break;
    case 19: asm("s_nop 1\n\tv_writelane_b32 %0, %1, 19" : "+v"(dst) : "s"(val)); break;
    case 20: asm("s_nop 1\n\tv_writelane_b32 %0, %1, 20" : "+v"(dst) : "s"(val)); break;
    case 21: asm("s_nop 1\n\tv_writelane_b32 %0, %1, 21" : "+v"(dst) : "s"(val)); break;
    case 22: asm("s_nop 1\n\tv_writelane_b32 %0, %1, 22" : "+v"(dst) : "s"(val)); break;
    case 23: asm("s_nop 1\n\tv_writelane_b32 %0, %1, 23" : "+v"(dst) : "s"(val)); break;
    case 24: asm("s_nop 1\n\tv_writelane_b32 %0, %1, 24" : "+v"(dst) : "s"(val)); break;
    case 25: asm("s_nop 1\n\tv_writelane_b32 %0, %1, 25" : "+v"(dst) : "s"(val)); break;
    case 26: asm("s_nop 1\n\tv_writelane_b32 %0, %1, 26" : "+v"(dst) : "s"(val)); break;
    case 27: asm("s_nop 1\n\tv_writelane_b32 %0, %1, 27" : "+v"(dst) : "s"(val)); break;
    case 28: asm("s_nop 1\n\tv_writelane_b32 %0, %1, 28" : "+v"(dst) : "s"(val)); break;
    case 29: asm("s_nop 1\n\tv_writelane_b32 %0, %1, 29" : "+v"(dst) : "s"(val)); break;
    case 30: asm("s_nop 1\n\tv_writelane_b32 %0, %1, 30" : "+v"(dst) : "s"(val)); break;
    case 31: asm("s_nop 1\n\tv_writelane_b32 %0, %1, 31" : "+v"(dst) : "s"(val)); break;
    default: break;
    }
}
__device__ __forceinline__ void ballot4(unsigned& mlo, unsigned& mhi, const float thr, const float x0, const float x1, const float x2, const float x3, const int base) {
    switch (base) {
    case 0: asm("v_cmp_le_f32_e64 s[90:91], %2, %3\n\tv_cmp_le_f32_e64 s[92:93], %2, %4\n\tv_cmp_le_f32_e64 s[94:95], %2, %5\n\tv_cmp_le_f32_e64 s[96:97], %2, %6\n\t"
                 "v_writelane_b32 %0, s90, 0\n\tv_writelane_b32 %1, s91, 0\n\tv_writelane_b32 %0, s92, 1\n\tv_writelane_b32 %1, s93, 1\n\tv_writelane_b32 %0, s94, 2\n\tv_writelane_b32 %1, s95, 2\n\tv_writelane_b32 %0, s96, 3\n\tv_writelane_b32 %1, s97, 3"
                 : "+v"(mlo), "+v"(mhi) : "v"(thr), "v"(x0), "v"(x1), "v"(x2), "v"(x3) : "s90", "s91", "s92", "s93", "s94", "s95", "s96", "s97"); break;
    case 4: asm("v_cmp_le_f32_e64 s[90:91], %2, %3\n\tv_cmp_le_f32_e64 s[92:93], %2, %4\n\tv_cmp_le_f32_e64 s[94:95], %2, %5\n\tv_cmp_le_f32_e64 s[96:97], %2, %6\n\t"
                 "v_writelane_b32 %0, s90, 4\n\tv_writelane_b32 %1, s91, 4\n\tv_writelane_b32 %0, s92, 5\n\tv_writelane_b32 %1, s93, 5\n\tv_writelane_b32 %0, s94, 6\n\tv_writelane_b32 %1, s95, 6\n\tv_writelane_b32 %0, s96, 7\n\tv_writelane_b32 %1, s97, 7"
                 : "+v"(mlo), "+v"(mhi) : "v"(thr), "v"(x0), "v"(x1), "v"(x2), "v"(x3) : "s90", "s91", "s92", "s93", "s94", "s95", "s96", "s97"); break;
    case 8: asm("v_cmp_le_f32_e64 s[90:91], %2, %3\n\tv_cmp_le_f32_e64 s[92:93], %2, %4\n\tv_cmp_le_f32_e64 s[94:95], %2, %5\n\tv_cmp_le_f32_e64 s[96:97], %2, %6\n\t"
                 "v_writelane_b32 %0, s90, 8\n\tv_writelane_b32 %1, s91, 8\n\tv_writelane_b32 %0, s92, 9\n\tv_writelane_b32 %1, s93, 9\n\tv_writelane_b32 %0, s94, 10\n\tv_writelane_b32 %1, s95, 10\n\tv_writelane_b32 %0, s96, 11\n\tv_writelane_b32 %1, s97, 11"
                 : "+v"(mlo), "+v"(mhi) : "v"(thr), "v"(x0), "v"(x1), "v"(x2), "v"(x3) : "s90", "s91", "s92", "s93", "s94", "s95", "s96", "s97"); break;
    case 12: asm("v_cmp_le_f32_e64 s[90:91], %2, %3\n\tv_cmp_le_f32_e64 s[92:93], %2, %4\n\tv_cmp_le_f32_e64 s[94:95], %2, %5\n\tv_cmp_le_f32_e64 s[96:97], %2, %6\n\t"
                 "v_writelane_b32 %0, s90, 12\n\tv_writelane_b32 %1, s91, 12\n\tv_writelane_b32 %0, s92, 13\n\tv_writelane_b32 %1, s93, 13\n\tv_writelane_b32 %0, s94, 14\n\tv_writelane_b32 %1, s95, 14\n\tv_writelane_b32 %0, s96, 15\n\tv_writelane_b32 %1, s97, 15"
                 : "+v"(mlo), "+v"(mhi) : "v"(thr), "v"(x0), "v"(x1), "v"(x2), "v"(x3) : "s90", "s91", "s92", "s93", "s94", "s95", "s96", "s97"); break;
    case 16: asm("v_cmp_le_f32_e64 s[90:91], %2, %3\n\tv_cmp_le_f32_e64 s[92:93], %2, %4\n\tv_cmp_le_f32_e64 s[94:95], %2, %5\n\tv_cmp_le_f32_e64 s[96:97], %2, %6\n\t"
                 "v_writelane_b32 %0, s90, 16\n\tv_writelane_b32 %1, s91, 16\n\tv_writelane_b32 %0, s92, 17\n\tv_writelane_b32 %1, s93, 17\n\tv_writelane_b32 %0, s94, 18\n\tv_writelane_b32 %1, s95, 18\n\tv_writelane_b32 %0, s96, 19\n\tv_writelane_b32 %1, s97, 19"
                 : "+v"(mlo), "+v"(mhi) : "v"(thr), "v"(x0), "v"(x1), "v"(x2), "v"(x3) : "s90", "s91", "s92", "s93", "s94", "s95", "s96", "s97"); break;
    case 20: asm("v_cmp_le_f32_e64 s[90:91], %2, %3\n\tv_cmp_le_f32_e64 s[92:93], %2, %4\n\tv_cmp_le_f32_e64 s[94:95], %2, %5\n\tv_cmp_le_f32_e64 s[96:97], %2, %6\n\t"
                 "v_writelane_b32 %0, s90, 20\n\tv_writelane_b32 %1, s91, 20\n\tv_writelane_b32 %0, s92, 21\n\tv_writelane_b32 %1, s93, 21\n\tv_writelane_b32 %0, s94, 22\n\tv_writelane_b32 %1, s95, 22\n\tv_writelane_b32 %0, s96, 23\n\tv_writelane_b32 %1, s97, 23"
                 : "+v"(mlo), "+v"(mhi) : "v"(thr), "v"(x0), "v"(x1), "v"(x2), "v"(x3) : "s90", "s91", "s92", "s93", "s94", "s95", "s96", "s97"); break;
    case 24: asm("v_cmp_le_f32_e64 s[90:91], %2, %3\n\tv_cmp_le_f32_e64 s[92:93], %2, %4\n\tv_cmp_le_f32_e64 s[94:95], %2, %5\n\tv_cmp_le_f32_e64 s[96:97], %2, %6\n\t"
                 "v_writelane_b32 %0, s90, 24\n\tv_writelane_b32 %1, s91, 24\n\tv_writelane_b32 %0, s92, 25\n\tv_writelane_b32 %1, s93, 25\n\tv_writelane_b32 %0, s94, 26\n\tv_writelane_b32 %1, s95, 26\n\tv_writelane_b32 %0, s96, 27\n\tv_writelane_b32 %1, s97, 27"
                 : "+v"(mlo), "+v"(mhi) : "v"(thr), "v"(x0), "v"(x1), "v"(x2), "v"(x3) : "s90", "s91", "s92", "s93", "s94", "s95", "s96", "s97"); break;
    case 28: asm("v_cmp_le_f32_e64 s[90:91], %2, %3\n\tv_cmp_le_f32_e64 s[92:93], %2, %4\n\tv_cmp_le_f32_e64 s[94:95], %2, %5\n\tv_cmp_le_f32_e64 s[96:97], %2, %6\n\t"
                 "v_writelane_b32 %0, s90, 28\n\tv_writelane_b32 %1, s91, 28\n\tv_writelane_b32 %0, s92, 29\n\tv_writelane_b32 %1, s93, 29\n\tv_writelane_b32 %0, s94, 30\n\tv_writelane_b32 %1, s95, 30\n\tv_writelane_b32 %0, s96, 31\n\tv_writelane_b32 %1, s97, 31"
                 : "+v"(mlo), "+v"(mhi) : "v"(thr), "v"(x0), "v"(x1), "v"(x2), "v"(x3) : "s90", "s91", "s92", "s93", "s94", "s95", "s96", "s97"); break;
    default: break;
    }
}
template <int NREG>
__device__ __forceinline__ void dsa_select(const float* const scw, LAS unsigned* const MASK, LAS const float* const ZT, const int wv, const int lane, const int t0, const int nk) {
    const float NINF = -__builtin_inff(), PINF = __builtin_inff();
    const unsigned long long lt_mask = (1ull << lane) - 1ull;
    const int qb_ = t0 >> 6;
    float xn[NREG];
#pragma unroll
    for (int i = 0; i < NREG; ++i) xn[i] = __hip_atomic_load(scw + i * 64 + lane, __ATOMIC_RELAXED, __HIP_MEMORY_SCOPE_AGENT);
#pragma unroll 1
    for (int ql_ = 0; ql_ < 8; ++ql_) {
        const int ql = ql_ & 7;
        const int tq = t0 + 8 * wv + ql;
        LAS unsigned* const mrow = MASK + (8 * wv + ql) * 64;
        float x[NREG];
#pragma unroll
        for (int i = 0; i < NREG; ++i) x[i] = (i <= qb_) ? xn[i] : NINF;
        if (ql_ + 1 < 8) {
#pragma unroll
            for (int i = 0; i < NREG; ++i) xn[i] = __hip_atomic_load(scw + ((ql_ + 1) & 7) * 2048 + i * 64 + lane, __ATOMIC_RELAXED, __HIP_MEMORY_SCOPE_AGENT);
        }
        unsigned mlo = 0u, mhi = 0u;
        if (tq + 1 > 256) {
#define CNT_GE(p_, dst_) do { int _c0 = 0, _c1 = 0; const float _p = (p_); \
                _Pragma("unroll") for (int _i = 0; _i < NREG; _i += 8) \
                    asm volatile("v_cmp_le_f32_e64 s[90:91], %10, %2\n\tv_cmp_le_f32_e64 s[92:93], %10, %3\n\tv_cmp_le_f32_e64 s[94:95], %10, %4\n\tv_cmp_le_f32_e64 s[96:97], %10, %5\n\t" \
                                 "v_cmp_le_f32_e64 s[82:83], %10, %6\n\ts_bcnt1_i32_b64 s90, s[90:91]\n\ts_add_u32 %0, %0, s90\n\t" \
                                 "v_cmp_le_f32_e64 s[84:85], %10, %7\n\ts_bcnt1_i32_b64 s92, s[92:93]\n\ts_add_u32 %1, %1, s92\n\t" \
                                 "v_cmp_le_f32_e64 s[86:87], %10, %8\n\ts_bcnt1_i32_b64 s94, s[94:95]\n\ts_add_u32 %0, %0, s94\n\t" \
                                 "v_cmp_le_f32_e64 s[88:89], %10, %9\n\ts_bcnt1_i32_b64 s96, s[96:97]\n\ts_add_u32 %1, %1, s96\n\t" \
                                 "s_bcnt1_i32_b64 s82, s[82:83]\n\ts_bcnt1_i32_b64 s84, s[84:85]\n\ts_add_u32 %0, %0, s82\n\ts_bcnt1_i32_b64 s86, s[86:87]\n\ts_add_u32 %1, %1, s84\n\t" \
                                 "s_bcnt1_i32_b64 s88, s[88:89]\n\ts_add_u32 %0, %0, s86\n\ts_add_u32 %1, %1, s88" \
                                 : "+s"(_c0), "+s"(_c1) : "v"(x[_i]), "v"(x[_i + 1]), "v"(x[_i + 2]), "v"(x[_i + 3]), "v"(x[_i + 4]), "v"(x[_i + 5]), "v"(x[_i + 6]), "v"(x[_i + 7]), "s"(_p) \
                                 : "s82", "s83", "s84", "s85", "s86", "s87", "s88", "s89", "s90", "s91", "s92", "s93", "s94", "s95", "s96", "s97", "scc"); \
                dst_ = _c0 + _c1; } while (0)
            float s1 = 0.f, s2 = 0.f;
            constexpr int SS = NREG / 8;
#pragma unroll
            for (int i = 0; i < NREG; i += SS) if (i < qb_) { s1 += x[i]; s2 = fmaf(x[i], x[i], s2); }
            s1 = wave_sum_f(s1); s2 = wave_sum_f(s2);
            const float rm = rcpf_(64.0f * (float)((min(qb_, NREG) + SS - 1) / SS));
            const float mean = s1 * rm, sigma = __builtin_sqrtf(fmaxf(s2 * rm - mean * mean, 0.f));
            const float zq = ZT[2 * (8 * wv + ql)], stepc = sigma * ZT[2 * (8 * wv + ql) + 1];
            float lo = -3.0e38f, hi = PINF, thr = 0.f, vmax = 0.f; int clo = tq + 1, chi = 0; bool tie = false, lo_real = false, have_mm = false;
            float pv = mean + zq * sigma;
#pragma unroll 1
            for (int it = 1;; ++it) {
                if (!(pv > lo && pv < hi)) {
                    if (!have_mm) {
                        float vmin = PINF; vmax = NINF;
#pragma unroll
                        for (int i = 0; i < NREG; ++i) { vmax = fmaxf(vmax, x[i]); vmin = fminf(vmin, x[i] == NINF ? PINF : x[i]); }
                        vmin = -wave_max(-vmin); vmax = wave_max(vmax); have_mm = true;
                        if (!lo_real) lo = vmin;
                    }
                    pv = (hi == PINF) ? vmax : 0.5f * (lo + hi);
                    if (!(pv > lo && pv < hi)) { tie = true; break; }
                }
                int c; CNT_GE(pv, c);
                if (c == 256) { thr = pv; break; }
                if (c > 256) { lo = pv; clo = c; lo_real = true; } else { hi = pv; chi = c; }
                if (it >= 8) pv = __builtin_nanf("");
                else if (lo_real && hi != PINF) pv = lo + (hi - lo) * ((float)(clo - 256) * rcpf_((float)(clo - chi)));
                else pv = pv + (float)(c - 256) * stepc;
            }
#undef CNT_GE
            if (!tie) {
#pragma unroll
                for (int i = 0; i < NREG; i += 4) ballot4(mlo, mhi, thr, x[i], x[i + 1], x[i + 2], x[i + 3], i);
            } else {
                const int need = 256 - chi; int before = 0;
#pragma unroll
                for (int i = 0; i < NREG; ++i) { const bool eq = (x[i] == lo); const unsigned long long be = __ballot(eq);
                    const int rank = before + __popcll(be & lt_mask); const bool sel = (x[i] >= hi) || (eq && rank < need); before += __popcll(be);
                    const unsigned long long bs = __ballot(sel);
                    wrlane(mlo, (unsigned)bs, i); wrlane(mhi, (unsigned)(bs >> 32), i); }
            }
        } else {
#pragma unroll
            for (int i = 0; i < NREG; ++i) { const unsigned long long bs = __ballot(i * 64 + lane <= tq);
                wrlane(mlo, (unsigned)bs, i); wrlane(mhi, (unsigned)(bs >> 32), i); }
        }
        if (lane < NREG) { v2u w; w.x = mlo; w.y = mhi; *(LAS v2u*)(mrow + 2 * lane) = w; }
    }
}

__device__ __forceinline__ void dsa_unit(Frame& F, const Args& args, const int b, const int qb, const float mb2) {
    LAS unsigned char* const L = F.lds;
    const int tid = F.tid, lane = F.lane, wv = F.wave, l31_0 = lane & 31, hh_0 = lane >> 5;
    int l31 = l31_0, hh = hh_0;
    constexpr int PK = 272, PV = 144;
    constexpr int O_K0 = 0, O_V0 = 17408, BUFSZ = 35840, O_MASK = 2 * BUFSZ, O_RS = O_MASK + 16384, O_BT = O_RS + 8192, O_ZT = O_BT + 2048, O_END = O_ZT + 512, O_OA = 0;
    static_assert(O_END <= SCRATCH_BYTES && 4 * 17408 <= 2 * BUFSZ, "dsa LDS map");
    const int t0 = 64 * qb, nk = 64 * (qb + 1);
    const size_t rb = (size_t)b * SEQ;
    LAS unsigned* const MASK = (LAS unsigned*)(L + O_MASK);
    LAS float* const RS = (LAS float*)(L + O_RS);
    LAS float* const BT = (LAS float*)(L + O_BT);
    LAS float* const ZT = (LAS float*)(L + O_ZT);
    const float NINF = -__builtin_inff();
    for (int key = tid; key < nk; key += NWAVES * 64) { const float* kp = W_KVSS + rb + key; RS[key] = rsqf_(((kp[0] + kp[MROWS]) + (kp[2 * MROWS] + kp[3 * MROWS])) * (1.0f / 128.0f) + EPSF); }
    BT[tid] = P_RELB[T5_BUCKET[tid >> 2] * 4 + (tid & 3)] * LOG2E;
    if (tid < 64) {
        const float n_ = (float)(t0 + tid + 1); float f_ = 256.0f * rcpf_(n_); const bool up_ = f_ > 0.5f; if (up_) f_ = 1.0f - f_;
        f_ = fmaxf(f_, 1e-6f);
        const float t_ = __builtin_sqrtf(-1.3862944f * __builtin_log2f(f_));
        float z_ = t_ - (2.515517f + t_ * (0.802853f + t_ * 0.010328f)) * rcpf_(1.0f + t_ * (1.432788f + t_ * (0.189269f + t_ * 0.001308f)));
        if (up_) z_ = -z_;
        ZT[2 * tid] = z_; ZT[2 * tid + 1] = rcpf_(n_ * 0.3989423f * __builtin_exp2f(-0.72134752f * z_ * z_));
    }
    float* const scw = W_SCR + (size_t)(blockIdx.x * NWAVES + wv) * 8 * 2048;
#pragma unroll 1
    for (int rep_a = 0; rep_a < (PROBE_DUP == 41 ? 2 : 1); ++rep_a) {
        bf16x8 aq[2][4]; f32x4 wts[2][4];
#pragma unroll
        for (int rt = 0; rt < 2; ++rt) {
            const bf16* p = W_PROJ + (rb + t0 + 8 * wv + 4 * rt + (l31 >> 3)) * NPROJ + C_IQ + (l31 & 7) * 64 + 8 * hh;
#pragma unroll
            for (int s = 0; s < 4; ++s) aq[rt][s] = *(const GAS bf16x8*)(p + 16 * s);
#pragma unroll
            for (int g = 0; g < 4; ++g) wts[rt][g] = *(const f32x4*)(W_AUX + (rb + t0 + 8 * wv + 4 * rt + g) * 16 + 8 + 4 * hh) * 0.5f;
        }
        constexpr int O_IK = 0, IKB = 9216, PIK = 144;
        v4u sti;
#define IK_GLOAD(kt_) sti = *(const GAS v4u*)(W_PROJ + (rb + 64 * (kt_) + (tid >> 3)) * NPROJ + C_IK + (tid & 7) * 8)
#define IK_SWRITE(buf_) *(LAS v4u*)(L + O_IK + (buf_) * IKB + (tid >> 3) * PIK + (tid & 7) * 16) = sti
        IK_GLOAD(0); IK_SWRITE(0);
        __syncthreads();
#pragma unroll 1
        for (int kt6 = 0; kt6 <= qb; ++kt6) {
          const int ibuf = kt6 & 1;
          if (kt6 < qb) IK_GLOAD(kt6 + 1);
#pragma unroll
          for (int st = 0; st < 2; ++st) {
            bf16x8 bk[4];
#pragma unroll
            for (int s = 0; s < 4; ++s) bk[s] = lds16(L + O_IK + ibuf * IKB + (32 * st + l31) * PIK + (16 * s + 8 * hh) * 2);
            const int kt = 2 * kt6 + st;
            const int key = 32 * kt + l31;
            f32x16 C0, C1;
#pragma unroll
            for (int r = 0; r < 16; ++r) { C0[r] = 0.f; C1[r] = 0.f; }
#pragma unroll
            for (int s = 0; s < 4; ++s) C0 = MFMA32(aq[0][s], bk[s], C0);
#pragma unroll
            for (int s = 0; s < 4; ++s) C1 = MFMA32(aq[1][s], bk[s], C1);
            float pp[2][4];
#pragma unroll
            for (int g = 0; g < 4; ++g) {
                float p0 = 0.f, p1 = 0.f;
#pragma unroll
                for (int e2 = 0; e2 < 4; ++e2) { const float w0 = wts[0][g][e2], w1 = wts[1][g][e2], x0 = C0[4 * g + e2], x1 = C1[4 * g + e2];
                    p0 = __builtin_fmaf(w0, x0, p0); p0 = __builtin_fmaf(w0, __builtin_fabsf(x0), p0); p1 = __builtin_fmaf(w1, x1, p1); p1 = __builtin_fmaf(w1, __builtin_fabsf(x1), p1); }
                pp[0][g] = p0; pp[1][g] = p1;
            }
#pragma unroll
            for (int rt = 0; rt < 2; ++rt)
#pragma unroll
                for (int g2 = 0; g2 < 2; ++g2) { const int ql = 4 * rt + g2 + 2 * hh;
                    float pa = pp[rt][g2], pb = pp[rt][g2 + 2];
                    asm("s_nop 1\n\tv_permlane32_swap_b32 %0, %1" : "+v"(pa), "+v"(pb));
                    float p = pa + pb;
                    if (key > t0 + 8 * wv + ql) p = NINF;
                    scw[ql * 2048 + key] = p; }
          }
          if (kt6 < qb) IK_SWRITE(ibuf ^ 1);
          __syncthreads();
        }
#undef IK_GLOAD
#undef IK_SWRITE
    }
    __builtin_amdgcn_fence(__ATOMIC_SEQ_CST, "workgroup");
    asm volatile("s_waitcnt vmcnt(0)" ::: "memory");
    const int qj = l31 >> 2, hd = l31 & 3;
    const int tql = t0 + 8 * wv + qj;
    bf16x8 qf[8]; float qn2 = 0.f;
    {
        const bf16* p = W_PROJ + (rb + tql) * NPROJ + C_QB + hd * 128 + 8 * hh; const float cs = 0.08838834764831845f * LOG2E;
#pragma unroll
        for (int s = 0; s < 8; ++s) { const v4u raw = *(const GAS v4u*)(p + 16 * s); const f32x4 g0 = *(const f32x4*)(P_GKV + 16 * s + 8 * hh), g1 = *(const f32x4*)(P_GKV + 16 * s + 8 * hh + 4);
            v4u o; o.x = cvtpk(bflo(raw.x) * g0.x * cs, bfhi(raw.x) * g0.y * cs); o.y = cvtpk(bflo(raw.y) * g0.z * cs, bfhi(raw.y) * g0.w * cs);
            o.z = cvtpk(bflo(raw.z) * g1.x * cs, bfhi(raw.z) * g1.y * cs); o.w = cvtpk(bflo(raw.w) * g1.z * cs, bfhi(raw.w) * g1.w * cs);
            qn2 += (bflo(o.x) * bflo(o.x) + bfhi(o.x) * bfhi(o.x)) + (bflo(o.y) * bflo(o.y) + bfhi(o.y) * bfhi(o.y)) + (bflo(o.z) * bflo(o.z) + bfhi(o.z) * bfhi(o.z)) + (bflo(o.w) * bflo(o.w) + bfhi(o.w) * bfhi(o.w));
            qf[s] = __builtin_bit_cast(bf16x8, o); }
    }
    qn2 += __shfl_xor(qn2, 32);
    int lanev = lane; asm volatile("" : "+v"(lanev));
#pragma unroll 1
    for (int rep_b = 0; rep_b < (PROBE_DUP == 42 ? 2 : 1); ++rep_b)
    if (qb < 8) dsa_select<8>(scw, MASK, ZT, wv, lanev, t0, nk);
    else if (qb < 16) dsa_select<16>(scw, MASK, ZT, wv, lanev, t0, nk);
    else if (qb < 24) dsa_select<24>(scw, MASK, ZT, wv, lanev, t0, nk);
    else dsa_select<32>(scw, MASK, ZT, wv, lanev, t0, nk);
    __syncthreads();
    const float c0 = -(sqrtf(qn2) * 11.313708499f * 1.01f + mb2 + 1.0f);
    const float cfar = BT[127 * 4 + hd] + c0;
    f32x16 oacc[4];
#pragma unroll
    for (int d = 0; d < 4; ++d)
#pragma unroll
        for (int r = 0; r < 16; ++r) oacc[d][r] = 0.f;
    float lsum = 0.f;
    v4u st0, st1;
#define DSA_GLOAD(kt) do { const bf16* _p = W_PROJ + (rb + 64 * (kt) + lane) * NPROJ + C_CKV + wv * 16; st0 = *(const GAS v4u*)_p; st1 = *(const GAS v4u*)(_p + 8); } while (0)
#define DSA_SWRITE(buf, ktt) do { LAS unsigned char* _kb = L + (buf) * BUFSZ; const float _r = RS[64 * (ktt) + lane]; \
        v4u _n0, _n1; _n0.x = cvtpk(bflo(st0.x) * _r, bfhi(st0.x) * _r); _n0.y = cvtpk(bflo(st0.y) * _r, bfhi(st0.y) * _r); _n0.z = cvtpk(bflo(st0.z) * _r, bfhi(st0.z) * _r); _n0.w = cvtpk(bflo(st0.w) * _r, bfhi(st0.w) * _r); \
        _n1.x = cvtpk(bflo(st1.x) * _r, bfhi(st1.x) * _r); _n1.y = cvtpk(bflo(st1.y) * _r, bfhi(st1.y) * _r); _n1.z = cvtpk(bflo(st1.z) * _r, bfhi(st1.z) * _r); _n1.w = cvtpk(bflo(st1.w) * _r, bfhi(st1.w) * _r); \
        *(LAS v4u*)(_kb + O_K0 + lane * PK + wv * 32) = _n0; *(LAS v4u*)(_kb + O_K0 + lane * PK + wv * 32 + 16) = _n1; \
        } while (0)
    DSA_GLOAD(0); DSA_SWRITE(0, 0);
    __syncthreads();
    for (int kt = 0; kt <= qb; ++kt) {
        const int buf = kt & 1;
        l31 = l31_0; hh = hh_0; asm volatile("" : "+v"(l31), "+v"(hh));
        if (kt < qb) DSA_GLOAD(kt + 1);
        const LAS unsigned char* kb = L + buf * BUFSZ;
        bf16x8 kf[8];
        int mw0 = (int)MASK[(8 * wv + qj) * 64 + 2 * kt], mw1 = (int)MASK[(8 * wv + qj) * 64 + 2 * kt + 1];
#pragma unroll
        for (int st = 0; st < 2; ++st) {
#pragma unroll
            for (int s = 0; s < 8; ++s) kf[s] = lds16(kb + O_K0 + (32 * st + l31) * PK + (16 * s + 8 * hh) * 2);
            __builtin_amdgcn_sched_barrier(0);
            const int kbase = 64 * kt + 32 * st;
            const bool far = (t0 + 8 * wv) - (kbase + 31) >= 113;
            const float sinit = far ? cfar : 0.f;
            f32x16 Sa;
#pragma unroll
            for (int r = 0; r < 16; ++r) Sa[r] = sinit;
#pragma unroll
            for (int s = 0; s < 8; ++s) Sa = MFMA32(kf[s], qf[s], Sa);
            __builtin_amdgcn_sched_barrier(0);
            bf16x8 vf[8];
#pragma unroll
            for (int dt = 0; dt < 4; ++dt) {
                const LAS unsigned char* vp = kb + O_K0 + (32 * st + 4 * hh + ((lane & 15) >> 2)) * PK + (32 * dt + 16 * ((lane >> 4) & 1) + 4 * (lane & 3)) * 2;
                vf[2 * dt] = ldstr8(vp, vp + 8 * PK); vf[2 * dt + 1] = ldstr8(vp + 16 * PK, vp + 24 * PK); }
            __builtin_amdgcn_sched_barrier(0);
            const int mwi = (st == 0 ? mw0 : mw1) >> (4 * hh);
            float pn[16];
            if (far) {
#pragma unroll
                for (int r = 0; r < 16; ++r) { int mb_ = __builtin_amdgcn_sbfe(mwi, 8 * (r >> 2) + (r & 3), 1); asm("" : "+v"(mb_));
                    pn[r] = __builtin_bit_cast(float, __builtin_bit_cast(int, __builtin_amdgcn_exp2f(Sa[r])) & mb_); lsum += pn[r]; }
            } else {
#pragma unroll
                for (int r = 0; r < 16; ++r) { int dist = tql - (kbase + 8 * (r >> 2) + 4 * hh + (r & 3)); dist = dist < 0 ? 0 : (dist > 127 ? 127 : dist);
                    int mb_ = __builtin_amdgcn_sbfe(mwi, 8 * (r >> 2) + (r & 3), 1); asm("" : "+v"(mb_));
                    pn[r] = __builtin_bit_cast(float, __builtin_bit_cast(int, __builtin_amdgcn_exp2f(Sa[r] + (BT[dist * 4 + hd] + c0))) & mb_); lsum += pn[r]; }
            }
            const bf16x8 pf0 = pack8(pn[0], pn[1], pn[2], pn[3], pn[4], pn[5], pn[6], pn[7]), pf1 = pack8(pn[8], pn[9], pn[10], pn[11], pn[12], pn[13], pn[14], pn[15]);
#pragma unroll
            for (int dt = 0; dt < 4; ++dt) { oacc[dt] = MFMA32(vf[2 * dt], pf0, oacc[dt]); oacc[dt] = MFMA32(vf[2 * dt + 1], pf1, oacc[dt]); }
        }
        if (kt < qb) DSA_SWRITE(buf ^ 1, kt + 1);
        __syncthreads();
    }
#undef DSA_GLOAD
#undef DSA_SWRITE
    lsum += __shfl_xor(lsum, 32);
    {
        const float inv = rcpf_(lsum);
#pragma unroll
        for (int dt = 0; dt < 4; ++dt)
#pragma unroll
            for (int g = 0; g < 4; ++g) { const int d = 32 * dt + 8 * g + 4 * hh; const f32x4 gk = *(const f32x4*)(P_GKV + d);
                *(LAS v2u*)(L + O_OA + hd * 17408 + (8 * wv + qj) * PK + d * 2) = pack4(oacc[dt][4 * g] * inv * gk.x, oacc[dt][4 * g + 1] * inv * gk.y, oacc[dt][4 * g + 2] * inv * gk.z, oacc[dt][4 * g + 3] * inv * gk.w); }
    }
    __syncthreads();
    {
        const int hd2 = wv >> 1, mt2 = wv & 1;
        const size_t row = rb + t0 + 32 * mt2 + l31;
        bf16x8 of[8];
#pragma unroll
        for (int s = 0; s < 8; ++s) of[s] = lds16(L + O_OA + hd2 * 17408 + (32 * mt2 + l31) * PK + (16 * s + 8 * hh) * 2);
        const int erow = 16 * ((l31 >> 2) & 1) + 4 * (l31 >> 3) + (l31 & 3);
#pragma unroll
        for (int et = 0; et < 4; ++et) {
            const bf16* zp = W_PROJ + row * NPROJ + C_ZB + hd2 * 128 + 32 * et + 16 * hh;
            const v4u z0 = *(const GAS v4u*)zp, z1 = *(const GAS v4u*)(zp + 8);
            f32x16 C;
#pragma unroll
            for (int r = 0; r < 16; ++r) C[r] = 0.f;
            const bf16* wp = W_WUVT + (size_t)hd2 * 16384 + (32 * et + erow) * 128 + 8 * hh;
#pragma unroll
            for (int s = 0; s < 8; ++s) C = MFMA32(*(const GAS bf16x8*)(wp + 16 * s), of[s], C);
            const unsigned zw[8] = {z0.x, z0.y, z0.z, z0.w, z1.x, z1.y, z1.z, z1.w}; unsigned ow[8];
#pragma unroll
            for (int k = 0; k < 8; ++k) ow[k] = cvtpk(C[2 * k] * siluf(bflo(zw[k])), C[2 * k + 1] * siluf(bfhi(zw[k])));
            bf16* op = W_OAB + row * DM + 512 + hd2 * 128 + 32 * et + 16 * hh;
            v4u o0, o1; o0.x = ow[0]; o0.y = ow[1]; o0.z = ow[2]; o0.w = ow[3]; o1.x = ow[4]; o1.y = ow[5]; o1.z = ow[6]; o1.w = ow[7];
            *(GAS v4u*)op = o0; *(GAS v4u*)(op + 8) = o1;
        }
    }
    __syncthreads();
}

constexpr int N_GDN = NB * 4, N_DSA = NB * 32, N_ITEMS = N_GDN + N_DSA;
constexpr int N_PHASES = 6;
#ifndef STAG_P2
#define STAG_P2 0
#endif
#ifndef STAG_P4
#define STAG_P4 0
#endif
__global__ void __launch_bounds__(NWAVES * 64, 2) hyb_fwd(Args args) {
    extern __shared__ __attribute__((aligned(16))) unsigned char lds[];
    Frame F;
    F.lds = (LAS unsigned char*)lds;
    F.MISC = (volatile LAS unsigned*)(F.lds + MISC_OFF);
    F.tid = threadIdx.x; F.lane = F.tid & 63; F.wave = __builtin_amdgcn_readfirstlane(F.tid >> 6);
    F.G = gridDim.x; { const int bx = blockIdx.x; F.vcu = (F.G % 8 == 0) ? (bx % 8) * (F.G / 8) + bx / 8 : bx; }
    unsigned char* ws = args.ws;
    F.ctl = (gu32*)(ws + WS_CTL);
    F.ws = ws;
    for (int u = F.tid; u < 64; u += NWAVES * 64) F.MISC[u] = 0u;
    __syncthreads();
    const int lo = args.ph_lo, hi = args.ph_hi;
    const bool multi = (hi - lo) > 1;
    XcdBarrier bar; bar.bar = (unsigned*)(F.ctl + CW_BAR) + args.li * XCD_BAR_WORDS; bar.x = 0; bar.st = nullptr;
    if (multi) bar = xcd_barrier_post((unsigned*)(F.ctl + CW_BAR) + args.li * XCD_BAR_WORDS, F.MISC + 8);
#define IN(k) (lo <= (k) && (k) < hi)
#define STAGGER(ticks) do { if ((ticks) > 0) { const unsigned long long t0_ = __builtin_amdgcn_s_memrealtime(); const unsigned d_ = ((unsigned)blockIdx.x & 7u) * (unsigned)(ticks); \
        while ((unsigned)(__builtin_amdgcn_s_memrealtime() - t0_) < d_) __builtin_amdgcn_s_sleep(4); } } while (0)
#define BOTH(k) (IN(k) && IN((k) + 1))
    if (IN(0)) { p0_prologue(F, args); if (PROBE_DUP == 7) { __syncthreads(); p0_prologue(F, args); } if (BOTH(0)) xcd_barrier(bar); }
    if (IN(1)) { p1_norm(F, args); if (PROBE_DUP == 1) p1_norm(F, args); if (BOTH(1)) xcd_barrier(bar); }
    if (IN(2)) {
        pg8::Gemm g{W_XN, W_WINT, MROWS, NPROJ, DM, (unsigned*)(F.ws + WS_CTL + 512 * 1024)}; pg8::StaticOrder S; S.init(MROWS, NPROJ, F.G, (int)blockIdx.x);
        pg8::EpiProj E{W_PROJ, W_AUX, W_KVSS};
        STAGGER(STAG_P2);
        pg8::gemm_phase<pg8::EpiProj, pg8::StaticOrder, true, true>(F.lds, g, S, E);
        if (PROBE_DUP == 2) pg8::gemm_phase<pg8::EpiProj, pg8::StaticOrder, true, true>(F.lds, g, S, E);
        if (PROBE_DUP == 22) { pg8::EpiHalf EH{E, pg8::EpiNull{W_SCR}}; pg8::gemm_phase<pg8::EpiHalf, pg8::StaticOrder, true, true>(F.lds, g, S, EH); }
        if (PROBE_DUP == 23) { pg8::EpiPat<true> EP{(bf16*)(F.ws + WS_SCR), 3072, 12}; pg8::gemm_phase<pg8::EpiPat<true>, pg8::StaticOrder, true, true>(F.lds, g, S, EP); }
        if (PROBE_DUP == 24) { pg8::EpiPat<false> EP{(bf16*)(F.ws + WS_SCR), 3072, 12}; pg8::gemm_phase<pg8::EpiPat<false>, pg8::StaticOrder, true, true>(F.lds, g, S, EP); }
        if (PROBE_DUP == 25) { pg8::EpiPat<false> EP{W_PROJ, 3840, 12}; pg8::gemm_phase<pg8::EpiPat<false>, pg8::StaticOrder, true, true>(F.lds, g, S, EP); }
        if (PROBE_DUP == 26) { pg8::EpiPat<false> EP{W_PROJ, 3840, 15}; pg8::gemm_phase<pg8::EpiPat<false>, pg8::StaticOrder, true, true>(F.lds, g, S, EP); }
        if (PROBE_DUP == 21) { pg8::EpiNull EN{W_SCR}; pg8::gemm_phase<pg8::EpiNull, pg8::StaticOrder, true, true>(F.lds, g, S, EN); }
        if (BOTH(2)) xcd_barrier(bar);
    }
    if (IN(3)) {
#define NEXT_ITEM(dst, qw) do { if (F.tid == 0) F.MISC[4] = __hip_atomic_fetch_add(F.ctl + (qw), 1u, RLX_AGENT); __syncthreads(); dst = (int)F.MISC[4]; __syncthreads(); } while (0)
        float mb2; { const int hd_ = F.lane & 3; float m_ = P_RELB[hd_]; for (int k = 1; k < 32; ++k) m_ = fmaxf(m_, P_RELB[k * 4 + hd_]); mb2 = m_ * LOG2E; }
        const bool placed = (F.G == 256) && PROBE_DUP != 3;
        int item;
        if (placed) {
            if ((((int)blockIdx.x >> 3) & 1) == 0) { const int gi = ((int)blockIdx.x >> 4) * 8 + ((int)blockIdx.x & 7); gdn_unit(F, args, gi >> 2, gi & 3); }
            NEXT_ITEM(item, CW_QUEUE); item += N_GDN;
        } else NEXT_ITEM(item, CW_QUEUE);
#pragma unroll 1
        for (int pass = 0; pass < (PROBE_DUP == 3 ? 2 : 1); ++pass) {
            if (pass) NEXT_ITEM(item, CW_QUEUE + 64);
            while (item < N_GDN) { gdn_unit(F, args, item >> 2, item & 3); NEXT_ITEM(item, CW_QUEUE + 64 * pass); }
        }
#pragma unroll 1
        for (int pass = 0; pass < (PROBE_DUP == 4 ? 2 : 1); ++pass) {
            if (pass) NEXT_ITEM(item, CW_QUEUE + 128);
            while (item < N_ITEMS) { if (item >= N_GDN) { const int idx = item - N_GDN; dsa_unit(F, args, idx & 31, 31 - (idx >> 5), mb2); } NEXT_ITEM(item, pass ? CW_QUEUE + 128 : CW_QUEUE); if (placed && !pass) item += N_GDN; }
        }
#undef NEXT_ITEM
        if (BOTH(3)) xcd_barrier(bar);
    }
    if (IN(4)) {
        pg8::Gemm g{W_OAB, W_WOUTT, MROWS, DM, DM, (unsigned*)(F.ws + WS_CTL + 512 * 1024)}; pg8::StaticOrder S; S.init(MROWS, DM, F.G, (int)blockIdx.x);
        pg8::EpiMix E{W_MIX, DM};
        STAGGER(STAG_P4);
        pg8::gemm_phase<pg8::EpiMix, pg8::StaticOrder, true, true>(F.lds, g, S, E);
        if (PROBE_DUP == 5) pg8::gemm_phase<pg8::EpiMix, pg8::StaticOrder, true, true>(F.lds, g, S, E);
        if (BOTH(4)) xcd_barrier(bar);
    }
    if (IN(5)) { p5_final(F, args); if (PROBE_DUP == 6) p5_final(F, args); }
#undef IN
#undef BOTH
}

extern "C" void kernel_launch(void* const* d_in, const int* in_sizes, int n_in, void* d_out, int out_size, void* d_ws, size_t ws_size, hipStream_t stream) {
    static int grid = 0;
    if (grid == 0) {
        if (n_in != 15 || in_sizes[0] != MROWS * DM || out_size != MROWS * DM || ws_size < WS_END) { fprintf(stderr, "kernel_launch: unexpected shapes (n_in %d, in0 %d, out %d, ws %zu); nothing launched\n", n_in, n_in > 0 ? in_sizes[0] : -1, out_size, ws_size); grid = -1; return; }
        int dev = 0, cus = 0, per_cu = 0;
        if (hipGetDevice(&dev) != hipSuccess || hipDeviceGetAttribute(&cus, hipDeviceAttributeMultiprocessorCount, dev) != hipSuccess) { fprintf(stderr, "kernel_launch: device query failed\n"); grid = -1; return; }
        if (hipFuncSetAttribute((const void*)hyb_fwd, hipFuncAttributeMaxDynamicSharedMemorySize, LDS_BYTES) != hipSuccess) { fprintf(stderr, "kernel_launch: hipFuncSetAttribute failed\n"); grid = -1; return; }
        if (hipOccupancyMaxActiveBlocksPerMultiprocessor(&per_cu, (const void*)hyb_fwd, NWAVES * 64, LDS_BYTES) != hipSuccess || per_cu < 1)
            fprintf(stderr, "kernel_launch: note: occupancy query reports %d workgroups per CU\n", per_cu);
        (void)hipGetLastError();
        grid = cus < 256 ? cus : 256;
    }
    if (grid < 0) return;
    if (hipMemsetAsync((char*)d_ws + WS_CTL, 0, CTL_ZERO_BYTES, stream) != hipSuccess) { fprintf(stderr, "kernel_launch: memset failed\n"); return; }
    Args a{};
    for (int i = 0; i < 15; ++i) a.in[i] = (const float*)d_in[i];
    a.out = (float*)d_out; a.ws = (unsigned char*)d_ws;
    constexpr int NL = MK_N_LAUNCHES;
    static_assert(NL == 1 || NL == 2 || NL == 3 || NL == N_PHASES, "MK_N_LAUNCHES");
    const int cuts1[2] = {0, 6}, cuts2[3] = {0, 3, 6}, cuts3[4] = {0, 3, 4, 6}, cuts6[7] = {0, 1, 2, 3, 4, 5, 6};
    const int* cuts = NL == 1 ? cuts1 : NL == 2 ? cuts2 : NL == 3 ? cuts3 : cuts6;
    for (int li = 0; li < NL; ++li) {
        a.ph_lo = cuts[li]; a.ph_hi = cuts[li + 1]; a.li = li;
        hipLaunchKernelGGL(hyb_fwd, dim3(grid), dim3(NWAVES * 64), LDS_BYTES, stream, a);
        const hipError_t le = hipPeekAtLastError();
        if (le != hipSuccess) { fprintf(stderr, "kernel_launch: launch %d failed: %s\n", li, hipGetErrorName(le)); break; }
    }
}
```

```cpp
#include <hip/hip_runtime.h>
#include <cstdio>
#include <cstdint>
#ifndef MK_N_LAUNCHES
#define MK_N_LAUNCHES 1
#endif
#ifndef PROBE_DUP
#define PROBE_DUP 0
#endif
namespace pg8 {
#define PG8_LAS __attribute__((address_space(3)))
typedef unsigned short bf16_t;
typedef short bf16x8 __attribute__((ext_vector_type(8)));
typedef float f32x4 __attribute__((ext_vector_type(4)));
typedef unsigned u32x4 __attribute__((ext_vector_type(4)));
constexpr int BM = 256, BK = 64, HALF = 128, HTB = HALF * BK * 2  , STAGE_BYTES = 8 * HTB, NXCD = 8, WGM = 8;

__host__ __device__ __forceinline__ int lds_byte(int r, int c) { const int st = (r >> 4) * 2 + (c >> 5), rr = r & 15, cc = c & 31, ob = rr * 64 + cc * 2; return st * 1024 + (ob ^ (((ob >> 9) & 1) << 5)); }
__host__ __device__ __forceinline__ void stage_rc(int b, int& R, int& C) { const int st = b / 1024, sb = b % 1024, swz = sb ^ (((sb >> 9) & 1) << 5); R = (st >> 1) * 16 + swz / 64; C = (st & 1) * 32 + (swz % 64) / 2; }
__host__ __device__ __forceinline__ int perm32(int rho) { const int n = rho >> 4, i = rho & 15; return 8 * (i >> 2) + 4 * n + (i & 3); }

struct Unit { int pm, pn; };
struct Gemm { const bf16_t* A; const bf16_t* Bt; int M, N, K; unsigned* sink; };

struct StaticOrder {
    int nM, nN, nwg, G, c;
    __host__ __device__ void init(int M, int N, int G_, int c_) { nM = M / BM; nN = N / BM; nwg = nM * nN; G = G_; c = c_; }
    __host__ __device__ bool next(int i, Unit& u) const {
        const long L = (long)i * G + c; if (L >= nwg) return false;
        int wgid = (int)L; { const int q = nwg / NXCD, r = nwg % NXCD, xcd = wgid % NXCD, off = wgid / NXCD; wgid = (xcd < r ? xcd * (q + 1) : r * (q + 1) + (xcd - r) * q) + off; }
        const int nig = WGM * nN, gid = wgid / nig, fm = gid * WGM, gsz = (nM - fm) < WGM ? (nM - fm) : WGM;
        u.pm = fm + ((wgid % nig) % gsz); u.pn = (wgid % nig) / gsz; return true;
    }
    __device__ __forceinline__ void a_ready(const Unit&) const {}
    __device__ __forceinline__ void done(const Unit&) const {}
};

typedef float f32x2c __attribute__((ext_vector_type(2))); typedef __bf16 b16x2c __attribute__((ext_vector_type(2)));
__device__ __forceinline__ unsigned cvt_pk_bf16(float lo, float hi) { const f32x2c v = {lo, hi}; return __builtin_bit_cast(unsigned, __builtin_convertvector(v, b16x2c)); }
struct EpiProj {
    static constexpr bool PERM = true, AFTER_DRAIN = false; static constexpr int MIN_VM = 16;
    bf16_t* O; float* aux; PG8_LAS float* ssl;
    __device__ __forceinline__ void operator()(const f32x4 (&acc)[2][2][4][2], const Unit& u, int wr, int wc, int fr, int fq) const {
        const int row0 = u.pm * BM + wr * 64 + fr, col0 = u.pn * BM + wc * 32 + 8 * fq;
        const bool last = (u.pn == 14);
        float rs[2][4];
#pragma unroll
        for (int ai = 0; ai < 2; ++ai)
#pragma unroll
            for (int m = 0; m < 4; ++m) rs[ai][m] = 1.0f;
        if (last) {
#pragma unroll
            for (int ai = 0; ai < 2; ++ai)
#pragma unroll
                for (int m = 0; m < 4; ++m) {
                    const f32x4 a0 = acc[ai][0][m][0], a1 = acc[ai][0][m][1];
                    float ss = (a0[0] * a0[0] + a0[1] * a0[1]) + (a0[2] * a0[2] + a0[3] * a0[3]) + (a1[0] * a1[0] + a1[1] * a1[1]) + (a1[2] * a1[2] + a1[3] * a1[3]);
                    ss += __shfl_xor(ss, 16); ss += __shfl_xor(ss, 32);
                    if (fq == 0) ssl[(wr * 64 + fr + ai * HALF + m * 16) * 4 + wc] = ss;
                }
            asm volatile("s_waitcnt lgkmcnt(0)" ::: "memory");
            __builtin_amdgcn_s_barrier();
#pragma unroll
            for (int ai = 0; ai < 2; ++ai)
#pragma unroll
                for (int m = 0; m < 4; ++m) { const f32x4 p = *(const PG8_LAS f32x4*)(ssl + (wr * 64 + fr + ai * HALF + m * 16) * 4);
                    rs[ai][m] = __builtin_amdgcn_rsqf(((p[0] + p[1]) + (p[2] + p[3])) * (1.0f / 128.0f) + 1e-6f); }
        }
#pragma unroll
        for (int ai = 0; ai < 2; ++ai)
#pragma unroll
            for (int m = 0; m < 4; ++m) {
                const int row = row0 + ai * HALF + m * 16;
                bf16_t* rowp = O + (size_t)row * 3840 + col0;
#pragma unroll
                for (int bj = 0; bj < 2; ++bj) {
                    f32x4 v0 = acc[ai][bj][m][0], v1 = acc[ai][bj][m][1];
                    if (bj == 0 && last) { v0 = v0 * rs[ai][m]; v1 = v1 * rs[ai][m]; }
                    u32x4 w; w.x = cvt_pk_bf16(v0[0], v0[1]); w.y = cvt_pk_bf16(v0[2], v0[3]); w.z = cvt_pk_bf16(v1[0], v1[1]); w.w = cvt_pk_bf16(v1[2], v1[3]);
                    *(u32x4*)(rowp + bj * HALF) = w;
                }
                if (last) {
                    if (wc == 2 && fq < 2) { float* ap = aux + (size_t)row * 16 + 8 * fq; *(f32x4*)ap = acc[ai][1][m][0]; *(f32x4*)(ap + 4) = acc[ai][1][m][1]; }
                }
            }
    }
};
struct EpiF32 {
    static constexpr bool PERM = false, AFTER_DRAIN = false; static constexpr int MIN_VM = 32;
    float* C; int ldc;
    __device__ __forceinline__ void operator()(const f32x4 (&acc)[2][2][4][2], const Unit& u, int wr, int wc, int fr, int fq) const {
        const int row0 = u.pm * BM + wr * 64 + fr, col0 = u.pn * BM + wc * 32 + 4 * fq;
#pragma unroll
        for (int ai = 0; ai < 2; ++ai)
#pragma unroll
            for (int m = 0; m < 4; ++m) { float* rowp = C + (size_t)(row0 + ai * HALF + m * 16) * ldc + col0;
#pragma unroll
                for (int bj = 0; bj < 2; ++bj)
#pragma unroll
                    for (int n = 0; n < 2; ++n) *(f32x4*)(rowp + bj * HALF + n * 16) = acc[ai][bj][m][n]; }
    }
};
struct EpiMix {
    static constexpr bool PERM = true, AFTER_DRAIN = false; static constexpr int MIN_VM = 16;
    bf16_t* O; int ldc;
    __device__ __forceinline__ void operator()(const f32x4 (&acc)[2][2][4][2], const Unit& u, int wr, int wc, int fr, int fq) const {
        const int row0 = u.pm * BM + wr * 64 + fr, col0 = u.pn * BM + wc * 32 + 8 * fq;
#pragma unroll
        for (int ai = 0; ai < 2; ++ai)
#pragma unroll
            for (int m = 0; m < 4; ++m) { bf16_t* rowp = O + (size_t)(row0 + ai * HALF + m * 16) * ldc + col0;
#pragma unroll
                for (int bj = 0; bj < 2; ++bj) { const f32x4 v0 = acc[ai][bj][m][0], v1 = acc[ai][bj][m][1];
                    u32x4 w; w.x = cvt_pk_bf16(v0[0], v0[1]); w.y = cvt_pk_bf16(v0[2], v0[3]); w.z = cvt_pk_bf16(v1[0], v1[1]); w.w = cvt_pk_bf16(v1[2], v1[3]);
                    *(u32x4*)(rowp + bj * HALF) = w; } }
    }
};
struct EpiNull {
    static constexpr bool PERM = true, AFTER_DRAIN = false; static constexpr int MIN_VM = 0;
    float* O;
    __device__ __forceinline__ void operator()(const f32x4 (&acc)[2][2][4][2], const Unit& u, int wr, int wc, int fr, int fq) const {
        f32x4 s = {0.f, 0.f, 0.f, 0.f};
#pragma unroll
        for (int ai = 0; ai < 2; ++ai)
#pragma unroll
            for (int bj = 0; bj < 2; ++bj)
#pragma unroll
                for (int m = 0; m < 4; ++m) { s += acc[ai][bj][m][0]; s += acc[ai][bj][m][1]; }
        if ((s[0] + s[1]) + (s[2] + s[3]) == 1.2345e30f) O[u.pm * 4096 + u.pn * 256 + wr * 128 + wc * 32 + fq * 16 + fr] = s[0];
    }
};
struct EpiHalf {
    static constexpr bool PERM = true, AFTER_DRAIN = false; static constexpr int MIN_VM = 0;
    EpiProj P; EpiNull N;
    __device__ __forceinline__ void operator()(const f32x4 (&acc)[2][2][4][2], const Unit& u, int wr, int wc, int fr, int fq) const {
        if ((blockIdx.x & 7) < 4) P(acc, u, wr, wc, fr, fq); else N(acc, u, wr, wc, fr, fq);
    }
};
template <bool TILE> struct EpiPat {
    static constexpr bool PERM = true, AFTER_DRAIN = false; static constexpr int MIN_VM = 0;
    bf16_t* O; int ld, npn;
    __device__ __forceinline__ void operator()(const f32x4 (&acc)[2][2][4][2], const Unit& u, int wr, int wc, int fr, int fq) const {
        if (u.pn >= npn) return;
        const int r0 = wr * 64 + fr, c0 = wc * 32 + 8 * fq;
#pragma unroll
        for (int ai = 0; ai < 2; ++ai)
#pragma unroll
            for (int m = 0; m < 4; ++m) {
                const int r = r0 + ai * HALF + m * 16;
                bf16_t* rowp = TILE ? O + ((size_t)(u.pm * 12 + u.pn) * 65536 + r * 256 + c0) : O + ((size_t)(u.pm * BM + r) * ld + u.pn * BM + c0);
#pragma unroll
                for (int bj = 0; bj < 2; ++bj) {
                    const f32x4 v0 = acc[ai][bj][m][0], v1 = acc[ai][bj][m][1];
                    u32x4 w; w.x = cvt_pk_bf16(v0[0], v0[1]); w.y = cvt_pk_bf16(v0[2], v0[3]); w.z = cvt_pk_bf16(v1[0], v1[1]); w.w = cvt_pk_bf16(v1[2], v1[3]);
                    *(u32x4*)(rowp + bj * HALF) = w;
                }
            }
    }
};
template <int N> __device__ __forceinline__ void wait_vm() { asm volatile("s_waitcnt vmcnt(%0)" :: "n"(N) : "memory"); }
template <class Epi, class Sched, bool ALIGN_EPI = false, bool SP2 = false>
__device__ __forceinline__ void gemm_phase(PG8_LAS unsigned char* lds, const Gemm g, const Sched& S, const Epi& E) {
    int tid_ = threadIdx.x; asm volatile("" : "+v"(tid_));
    const int tid = tid_, wid = __builtin_amdgcn_readfirstlane(tid >> 6), lane = tid & 63, wr = wid >> 2, wc = wid & 3, fr = lane & 15, fq = lane >> 4;
    const int K = g.K, nt = K / BK;
    constexpr int XV = (SP2 && !Epi::AFTER_DRAIN) ? Epi::MIN_VM : 0;
    unsigned voffA[2], voffB[2];
#pragma unroll
    for (int i = 0; i < 2; ++i) { int R, C; stage_rc(tid * 16 + i * 8192, R, C); const int Rb = Epi::PERM ? ((R & ~31) + perm32(R & 31)) : R;
        voffA[i] = (unsigned)(R * K + C) * 2u; voffB[i] = (unsigned)(Rb * K + C) * 2u; }
    const unsigned kstep = BK * 2;
    const unsigned hstep = (unsigned)HALF * K * 2;
    const unsigned tstep = 2 * hstep;
    const __amdgpu_buffer_rsrc_t srdA = __builtin_amdgcn_make_buffer_rsrc((void*)g.A, (short)0, (int)((size_t)g.M * K * 2), 0x00020000);
    const __amdgpu_buffer_rsrc_t srdB = __builtin_amdgcn_make_buffer_rsrc((void*)g.Bt, (short)0, (int)((size_t)g.N * K * 2), 0x00020000);
    const unsigned ldsb = (unsigned)(size_t)lds;
    const unsigned ldsw = (unsigned)wid * 1024u;
    const int aoff = lds_byte(wr * 64 + fr, fq * 8), boff = lds_byte(wc * 32 + fr, fq * 8);
#define PG8_SA(b, h) (((b) * 2 + (h)) * HTB)
#define PG8_SB(b, h) ((4 + (b) * 2 + (h)) * HTB)
#define PG8_STAGE(bufoff, srd, soff, voff) do { _Pragma("unroll") for (int _i = 0; _i < 2; ++_i) \
        asm volatile("s_mov_b32 m0, %0\n\ts_nop 0\n\tbuffer_load_dwordx4 %1, %2, %3 offen lds" :: "s"(ldsb + (unsigned)(bufoff) + ldsw + _i * 8192u), "v"((voff)[_i]), "s"(srd), "s"((unsigned)(soff)) : "m0", "memory"); } while (0)
#define PG8_LDA(dst, b, h) do { _Pragma("unroll") for (int m = 0; m < 4; ++m) _Pragma("unroll") for (int k = 0; k < 2; ++k) dst[m][k] = *(const PG8_LAS bf16x8*)(lds + PG8_SA(b, h) + aoff + m * 2048 + k * 1024); } while (0)
#define PG8_LDB(dst, b, h) do { _Pragma("unroll") for (int n = 0; n < 2; ++n) _Pragma("unroll") for (int k = 0; k < 2; ++k) dst[n][k] = *(const PG8_LAS bf16x8*)(lds + PG8_SB(b, h) + boff + n * 2048 + k * 1024); } while (0)
#define PG8_MMA(ai, bj, At, Bt) do { __builtin_amdgcn_s_setprio(1); _Pragma("unroll") for (int m = 0; m < 4; ++m) _Pragma("unroll") for (int n = 0; n < 2; ++n) _Pragma("unroll") for (int k = 0; k < 2; ++k) \
        acc[ai][bj][m][n] = __builtin_amdgcn_mfma_f32_16x16x32_bf16(Bt[n][k], At[m][k], acc[ai][bj][m][n], 0, 0, 0); __builtin_amdgcn_s_setprio(0); } while (0)
#define PG8_WAIT_V(n) asm volatile("s_waitcnt vmcnt(" #n ")" ::: "memory")
#define PG8_WAIT_L(n) asm volatile("s_waitcnt lgkmcnt(" #n ")" ::: "memory")
#define PG8_BAR __builtin_amdgcn_s_barrier()
#define PG8_SCHED __builtin_amdgcn_sched_barrier(0)
    Unit cur, nxt; int ui = 0;
    if (!S.next(0, cur)) return;
    f32x4 acc[2][2][4][2];
#pragma unroll
    for (int a = 0; a < 2; ++a)
#pragma unroll
        for (int b = 0; b < 2; ++b)
#pragma unroll
            for (int m = 0; m < 4; ++m)
#pragma unroll
                for (int n = 0; n < 2; ++n) acc[a][b][m][n] = (f32x4){0.f, 0.f, 0.f, 0.f};
    bf16x8 At[4][2], B0[2][2], B1[2][2];
    unsigned cA = (unsigned)cur.pm * tstep, cB = (unsigned)cur.pn * tstep;
    S.a_ready(cur);
    if constexpr (SP2) {
        PG8_STAGE(PG8_SB(0, 0), srdB, cB, voffB); PG8_STAGE(PG8_SB(0, 1), srdB, cB + hstep, voffB); PG8_STAGE(PG8_SA(0, 0), srdA, cA, voffA); PG8_STAGE(PG8_SA(0, 1), srdA, cA + hstep, voffA);
        if (wr == 1) PG8_BAR;
        PG8_WAIT_V(2); PG8_BAR;
        PG8_STAGE(PG8_SB(1, 0), srdB, cB + kstep, voffB); PG8_STAGE(PG8_SA(1, 0), srdA, cA + kstep, voffA); PG8_STAGE(PG8_SB(1, 1), srdB, cB + hstep + kstep, voffB);
        PG8_WAIT_V(6); PG8_BAR;
        PG8_STAGE(PG8_SA(1, 1), srdA, cA + kstep + hstep, voffA);
        if constexpr (XV > 0) {
            unsigned* sp = g.sink + ((size_t)blockIdx.x * 8 + wid) * 64 + lane; const unsigned zero = 0u;
#pragma unroll
            for (int i = 0; i < XV; ++i) asm volatile("global_store_dword %0, %1, off" :: "v"(sp), "v"(zero) : "memory");
        }
    } else {
        PG8_STAGE(PG8_SB(0, 0), srdB, cB, voffB); PG8_STAGE(PG8_SA(0, 0), srdA, cA, voffA); PG8_STAGE(PG8_SB(0, 1), srdB, cB + hstep, voffB); PG8_STAGE(PG8_SA(0, 1), srdA, cA + hstep, voffA);
        if (wr == 1) PG8_BAR;
        PG8_WAIT_V(4); PG8_BAR;
        PG8_STAGE(PG8_SB(1, 0), srdB, cB + kstep, voffB); PG8_STAGE(PG8_SA(1, 0), srdA, cA + kstep, voffA); PG8_STAGE(PG8_SB(1, 1), srdB, cB + hstep + kstep, voffB);
        PG8_WAIT_V(6); PG8_BAR;
    }
    for (;;) {
        const bool has_next = S.next(ui + 1, nxt);
        const unsigned nA = has_next ? (unsigned)nxt.pm * tstep : cA, nB = has_next ? (unsigned)nxt.pn * tstep : cB;
        if constexpr (SP2) {
#define PG8_PAIR(W3) do { \
            const bool last = (t == nt - 2); \
            const unsigned a2 = last ? nA : cA + (unsigned)(t + 2) * kstep, b2 = last ? nB : cB + (unsigned)(t + 2) * kstep;     \
            const unsigned a3 = a2 + kstep, b3 = b2 + kstep;                                \
            if (last && has_next) S.a_ready(nxt); \
              \
            PG8_LDB(B0, 0, 0); PG8_LDB(B1, 0, 1); PG8_SCHED; PG8_LDA(At, 0, 0); \
            W3; PG8_WAIT_L(0); PG8_BAR; PG8_MMA(0, 0, At, B0); PG8_MMA(0, 1, At, B1); PG8_BAR; PG8_SCHED; \
              \
            PG8_LDA(At, 0, 1); PG8_STAGE(PG8_SB(0, 0), srdB, b2, voffB); PG8_STAGE(PG8_SB(0, 1), srdB, b2 + hstep, voffB); PG8_STAGE(PG8_SA(0, 0), srdA, a2, voffA); \
            W3; PG8_WAIT_L(0); PG8_BAR; PG8_MMA(1, 0, At, B0); PG8_MMA(1, 1, At, B1); PG8_BAR; PG8_SCHED; \
              \
            PG8_LDB(B0, 1, 0); PG8_LDB(B1, 1, 1); PG8_SCHED; PG8_LDA(At, 1, 0); PG8_STAGE(PG8_SA(0, 1), srdA, a2 + hstep, voffA); \
            W3; PG8_WAIT_L(0); PG8_BAR; PG8_MMA(0, 0, At, B0); PG8_MMA(0, 1, At, B1); PG8_BAR; PG8_SCHED; \
              \
            PG8_LDA(At, 1, 1); PG8_STAGE(PG8_SB(1, 0), srdB, b3, voffB); PG8_STAGE(PG8_SB(1, 1), srdB, b3 + hstep, voffB); PG8_STAGE(PG8_SA(1, 0), srdA, a3, voffA); \
            PG8_WAIT_V(8); PG8_WAIT_L(0); PG8_BAR; PG8_MMA(1, 0, At, B0); PG8_MMA(1, 1, At, B1); PG8_BAR; PG8_SCHED; \
            PG8_STAGE(PG8_SA(1, 1), srdA, a3 + hstep, voffA); } while (0)
        { const int t = 0; PG8_PAIR(wait_vm<8 + XV>()); }
        for (int t = 2; t < nt; t += 2) PG8_PAIR(PG8_WAIT_V(8));
#undef PG8_PAIR
        } else {
        for (int t = 0; t < nt; t += 2) {
            const bool last = (t == nt - 2);
            const unsigned a1 = cA + (unsigned)(t + 1) * kstep;
            const unsigned a2 = last ? nA : cA + (unsigned)(t + 2) * kstep, b2 = last ? nB : cB + (unsigned)(t + 2) * kstep;
            const unsigned a3 = a2 + kstep, b3 = b2 + kstep;
            if (last && has_next) S.a_ready(nxt);
            PG8_LDB(B0, 0, 0); PG8_SCHED; PG8_LDA(At, 0, 0); PG8_STAGE(PG8_SA(1, 1), srdA, a1 + hstep, voffA);
            PG8_WAIT_L(8); PG8_BAR; PG8_WAIT_L(0); PG8_MMA(0, 0, At, B0); PG8_BAR; PG8_SCHED;
            PG8_LDB(B1, 0, 1); PG8_STAGE(PG8_SB(0, 0), srdB, b2, voffB);
            PG8_BAR; PG8_WAIT_L(0); PG8_MMA(0, 1, At, B1); PG8_BAR;
            PG8_LDA(At, 0, 1); PG8_STAGE(PG8_SA(0, 0), srdA, a2, voffA);
            PG8_BAR; PG8_WAIT_L(0); PG8_MMA(1, 0, At, B0); PG8_BAR; PG8_SCHED;
            PG8_STAGE(PG8_SB(0, 1), srdB, b2 + hstep, voffB);
            PG8_WAIT_V(6); PG8_BAR; PG8_MMA(1, 1, At, B1); PG8_BAR;
            PG8_LDB(B0, 1, 0); PG8_SCHED; PG8_LDA(At, 1, 0); PG8_STAGE(PG8_SA(0, 1), srdA, a2 + hstep, voffA);
            PG8_WAIT_L(8); PG8_BAR; PG8_WAIT_L(0); PG8_MMA(0, 0, At, B0); PG8_BAR; PG8_SCHED;
            PG8_LDB(B1, 1, 1); PG8_STAGE(PG8_SB(1, 0), srdB, b3, voffB);
            PG8_BAR; PG8_WAIT_L(0); PG8_MMA(0, 1, At, B1); PG8_BAR;
            PG8_LDA(At, 1, 1); PG8_STAGE(PG8_SA(1, 0), srdA, a3, voffA);
            PG8_BAR; PG8_WAIT_L(0); PG8_MMA(1, 0, At, B0); PG8_BAR; PG8_SCHED;
            PG8_STAGE(PG8_SB(1, 1), srdB, b3 + hstep, voffB);
            PG8_WAIT_V(6); PG8_BAR; PG8_MMA(1, 1, At, B1); PG8_BAR;
        }
        }
        if constexpr (ALIGN_EPI) { if (wr == 0) PG8_BAR; }
        if constexpr (!Epi::AFTER_DRAIN) { E(acc, cur, wr, wc, fr, fq); S.done(cur); }
        if (!has_next) break;
#pragma unroll
        for (int a = 0; a < 2; ++a)
#pragma unroll
            for (int b = 0; b < 2; ++b)
#pragma unroll
                for (int m = 0; m < 4; ++m)
#pragma unroll
                    for (int n = 0; n < 2; ++n) acc[a][b][m][n] = (f32x4){0.f, 0.f, 0.f, 0.f};
        cur = nxt; cA = nA; cB = nB; ++ui;
        if constexpr (ALIGN_EPI) { if (wr == 1) PG8_BAR; }
    }
    PG8_WAIT_V(0);
    if constexpr (!ALIGN_EPI) { if (wr == 0) PG8_BAR; }
    PG8_BAR;
    if constexpr (Epi::AFTER_DRAIN) { E.fused(acc, cur, wr, wc, fr, fq, lds, wid, lane); S.done(cur); }
#undef PG8_SA
#undef PG8_SB
#undef PG8_STAGE
#undef PG8_LDA
#undef PG8_LDB
#undef PG8_MMA
#undef PG8_WAIT_V
#undef PG8_WAIT_L
#undef PG8_BAR
#undef PG8_SCHED
}
}

constexpr int NWAVES = 8;
constexpr int NB = 32, SEQ = 2048, DM = 1024, MROWS = NB * SEQ;
constexpr int NPROJ = 3840;
constexpr int C_ZA = 1536, C_QB = 2048, C_ZB = 2560, C_IQ = 3072, C_CKV = 3584, C_IK = 3712;
constexpr float EPSF = 1e-6f;
constexpr float LOG2E = 1.4426950408889634f;
__host__ __device__ __forceinline__ int proj_src_col(int n) {
    if (n < 2048) return n;
    if (n < 2560) return n - 2048 + 2056;
    if (n < 3072) return n - 2560 + 2696;
    if (n < 3584) return n - 3072 + 3208;
    if (n < 3712) return n - 3584 + 2568;
    if (n < 3776) return n - 3712 + 3720;
    if (n < 3784) return n - 3776 + 2048;
    if (n < 3792) return n;
    return -1;
}
__device__ const unsigned char T5_BUCKET[128] = {0,1,2,3,4,5,6,7,8,9,10,11,12,13,14,15,16,16,16,17,17,18,18,18,19,19,19,20,20,20,20,21,21,21,21,22,22,22,22,22,23,23,23,23,23,23,24,24,24,24,24,24,25,25,25,25,25,25,25,26,26,26,26,26,26,26,26,27,27,27,27,27,27,27,27,27,27,28,28,28,28,28,28,28,28,28,28,29,29,29,29,29,29,29,29,29,29,29,29,30,30,30,30,30,30,30,30,30,30,30,30,30,30,31,31,31,31,31,31,31,31,31,31,31,31,31,31,31};

constexpr size_t MiB = 1u << 20;
constexpr size_t WS_CTL = 0, CTL_ZERO_BYTES = 64 * 1024;
constexpr size_t WS_MOD = 1 * MiB;
constexpr size_t WS_WUV = 2 * MiB;
constexpr size_t WS_WOUT = 3 * MiB;
constexpr size_t WS_WIN = 5 * MiB;
constexpr size_t WS_KVSS = 13 * MiB;
constexpr size_t WS_AUX = 14 * MiB;
constexpr size_t WS_XN = 32 * MiB;
constexpr size_t WS_PROJ = 160 * MiB;
constexpr size_t WS_SCR = 640 * MiB;
constexpr size_t WS_END = 768 * MiB;
constexpr int CW_TMO = 0, CW_QUEUE = 64, CW_BAR = 4096;

constexpr int LDS_BYTES = 163840;
constexpr int MISC_OFF = LDS_BYTES - 256;
constexpr int SCRATCH_BYTES = MISC_OFF;

#define GAS __attribute__((address_space(1)))
#define LAS __attribute__((address_space(3)))
typedef unsigned short bf16;
typedef unsigned v4u __attribute__((ext_vector_type(4)));
typedef unsigned v2u __attribute__((ext_vector_type(2)));
typedef float f32x4 __attribute__((ext_vector_type(4)));
typedef float f32x16 __attribute__((ext_vector_type(16)));
typedef short bf16x8 __attribute__((ext_vector_type(8)));
typedef GAS unsigned gu32;
#define RLX_AGENT __ATOMIC_RELAXED, __HIP_MEMORY_SCOPE_AGENT
#define LDS_WAIT() asm volatile("s_waitcnt lgkmcnt(0)" ::: "memory")
#define MFMA32(a, b, c) __builtin_amdgcn_mfma_f32_32x32x16_bf16((a), (b), (c), 0, 0, 0)
#define MFMA16F(a, b, c) __builtin_amdgcn_mfma_f32_16x16x4f32((a), (b), (c), 0, 0, 0)
__device__ __forceinline__ unsigned f2bf(float f) { unsigned u = __builtin_bit_cast(unsigned, f); return (u + 0x7fffu + ((u >> 16) & 1u)) >> 16; }
__device__ __forceinline__ unsigned pk2(float lo, float hi) { return f2bf(lo) | (f2bf(hi) << 16); }
__device__ __forceinline__ float bf2f(unsigned short b) { return __builtin_bit_cast(float, ((unsigned)b) << 16); }
__device__ __forceinline__ float bflo(unsigned w) { return __builtin_bit_cast(float, w << 16); }
__device__ __forceinline__ float bfhi(unsigned w) { return __builtin_bit_cast(float, w & 0xffff0000u); }
__device__ __forceinline__ float rcpf_(float x) { return __builtin_amdgcn_rcpf(x); }
__device__ __forceinline__ float rsqf_(float x) { return __builtin_amdgcn_rsqf(x); }
__device__ __forceinline__ float siluf(float x) { return x * __builtin_amdgcn_rcpf(1.0f + __builtin_amdgcn_exp2f(-1.4426950408889634f * x)); }
__device__ __forceinline__ float wave_sum(float v) {
#pragma unroll
    for (int o = 1; o < 64; o <<= 1) v += __shfl_xor(v, o);
    return v;
}

__device__ __forceinline__ float wave_sum_f(float v) {
#define WSF_(ctl, rm, bm) v += __builtin_bit_cast(float, __builtin_amdgcn_update_dpp(0, __builtin_bit_cast(int, v), ctl, rm, bm, false))
    WSF_(0x111, 0xf, 0xf); WSF_(0x112, 0xf, 0xf); WSF_(0x114, 0xf, 0xe); WSF_(0x118, 0xf, 0xc); WSF_(0x142, 0xa, 0xf); WSF_(0x143, 0xc, 0xf);
#undef WSF_
    return __builtin_bit_cast(float, __builtin_amdgcn_readlane(__builtin_bit_cast(int, v), 63));
}
__device__ __forceinline__ int wave_sum_i(int v) {
    v += __builtin_amdgcn_update_dpp(0, v, 0x111, 0xf, 0xf, false);
    v += __builtin_amdgcn_update_dpp(0, v, 0x112, 0xf, 0xf, false);
    v += __builtin_amdgcn_update_dpp(0, v, 0x114, 0xf, 0xe, false);
    v += __builtin_amdgcn_update_dpp(0, v, 0x118, 0xf, 0xc, false);
    v += __builtin_amdgcn_update_dpp(0, v, 0x142, 0xa, 0xf, false);
    v += __builtin_amdgcn_update_dpp(0, v, 0x143, 0xc, 0xf, false);
    return __builtin_amdgcn_readlane(v, 63);
}
__device__ __forceinline__ float wave_max(float v) {
    const int ninf = (int)0xff800000u;
#define WM_STEP(ctrl, rm, bm) v = fmaxf(v, __builtin_bit_cast(float, __builtin_amdgcn_update_dpp(ninf, __builtin_bit_cast(int, v), ctrl, rm, bm, false)))
    WM_STEP(0x111, 0xf, 0xf); WM_STEP(0x112, 0xf, 0xf); WM_STEP(0x114, 0xf, 0xe); WM_STEP(0x118, 0xf, 0xc); WM_STEP(0x142, 0xa, 0xf); WM_STEP(0x143, 0xc, 0xf);
#undef WM_STEP
    return __builtin_bit_cast(float, __builtin_amdgcn_readlane(__builtin_bit_cast(int, v), 63));
}
#define XB_TMO      128
#define XB_XCNT(j)  (256  + 64 * (j))
#define XB_XSUB(j)  (1280 + 64 * (j))
#define XB_XGEN(j)  (2304 + 64 * (j))
#define XB_TOP      3328
#define XB_TOPGEN   3392
#define XCD_BAR_WORDS 3456
#define XB_SPIN_CAP (1u << 18)

__device__ __forceinline__ unsigned xb_ld(unsigned* p)              { return __hip_atomic_load(p, __ATOMIC_RELAXED, __HIP_MEMORY_SCOPE_AGENT); }
__device__ __forceinline__ unsigned xb_add(unsigned* p, unsigned v) { return __hip_atomic_fetch_add(p, v, __ATOMIC_RELAXED, __HIP_MEMORY_SCOPE_AGENT); }
__device__ __forceinline__ unsigned xb_xcc_id() { return (unsigned)__builtin_amdgcn_s_getreg((3 << 11) | 20) & 0xFu; }
#define XB_SPIN(cond, bar) do { unsigned _sp = 0; while (cond) { __builtin_amdgcn_s_sleep(1); \
    if ((++_sp & 255u) == 0u) { if (xb_ld(&(bar)[XB_TMO])) break; if (_sp > XB_SPIN_CAP) { atomicAdd(&(bar)[XB_TMO], 1u); break; } } } } while (0)

struct XcdBarrier {
    unsigned* bar; unsigned x;
    volatile LAS unsigned* st;
};

__device__ __forceinline__ XcdBarrier xcd_barrier_post(unsigned* bar, volatile LAS unsigned* st) {
    XcdBarrier b; b.bar = bar; b.x = xb_xcc_id(); b.st = st;
    if (threadIdx.x == 0) (void)xb_add(&bar[XB_XCNT(b.x)], 1u);
    return b;
}
__device__ __forceinline__ void xcd_barrier_complete(unsigned* bar, unsigned x, unsigned& nloc, unsigned& nx) {
    const unsigned G = gridDim.x * gridDim.y * gridDim.z;
    unsigned sum, cnt, mine, sp = 0u;
    for (;;) {
        sum = 0u; cnt = 0u; mine = 0u;
#pragma unroll
        for (unsigned j = 0; j < 16; ++j) { const unsigned c = xb_ld(&bar[XB_XCNT(j)]); sum += c; cnt += (c > 0u) ? 1u : 0u; mine = (j == x) ? c : mine; }
        if (sum == G) break;
        __builtin_amdgcn_s_sleep(1);
        if ((++sp & 255u) == 0u) { if (xb_ld(&bar[XB_TMO])) break; if (sp > XB_SPIN_CAP) { atomicAdd(&bar[XB_TMO], 1u); break; } }
    }
    nloc = mine > 0u ? mine : 1u; nx = cnt > 0u ? cnt : 1u;
}

__device__ __forceinline__ void xcd_barrier(const XcdBarrier& b) {
    asm volatile("s_waitcnt vmcnt(0)" ::: "memory");
    __syncthreads();
    if (threadIdx.x == 0) {
        unsigned* bar = b.bar;
        __builtin_amdgcn_s_waitcnt(0);
        unsigned nloc = b.st[0], nx = b.st[1];
        if (nloc == 0u) { xcd_barrier_complete(bar, b.x, nloc, nx); b.st[0] = nloc; b.st[1] = nx; }
        const unsigned old = xb_add(&bar[XB_XSUB(b.x)], 1u);
        const unsigned gen = old / nloc;
        if (old + 1u == (gen + 1u) * nloc) {
            __builtin_amdgcn_fence(__ATOMIC_RELEASE, "agent");
            asm volatile("s_waitcnt vmcnt(0)" ::: "memory");
            const unsigned og = xb_add(&bar[XB_TOP], 1u);
            const unsigned tg = og / nx;
            if (og + 1u == (tg + 1u) * nx) xb_add(&bar[XB_TOPGEN], 1u);
            else XB_SPIN(xb_ld(&bar[XB_TOPGEN]) == tg, bar);
            __builtin_amdgcn_fence(__ATOMIC_ACQUIRE, "agent");
            xb_add(&bar[XB_XGEN(b.x)], 1u);
            asm volatile("s_waitcnt vmcnt(0)" ::: "memory");
        } else {
            XB_SPIN(xb_ld(&bar[XB_XGEN(b.x)]) == gen, bar);
            __builtin_amdgcn_fence(__ATOMIC_ACQUIRE, "agent");
            asm volatile("s_waitcnt vmcnt(0)" ::: "memory");
        }
    }
    __syncthreads();
}

struct Frame {
    LAS unsigned char* lds;
    volatile LAS unsigned* MISC;
    gu32* ctl;
    int tid, lane, wave;
    int vcu, G;
    unsigned char* ws;
};
#define P_X        (args.in[0])
#define P_C        (args.in[1])
#define P_WADA     (args.in[2])
#define P_BADA     (args.in[3])
#define P_GPRE     (args.in[4])
#define P_WIN      (args.in[5])
#define P_CONVW    (args.in[6])
#define P_ALOG     (args.in[7])
#define P_DTB      (args.in[8])
#define P_GGDN     (args.in[9])
#define P_GKV      (args.in[10])
#define P_WUV      (args.in[11])
#define P_RELB     (args.in[12])
#define P_WOUT     (args.in[13])
#define P_GPOST    (args.in[14])
#define P_OUT      (args.out)
#define W_MOD      ((float*)(F.ws + WS_MOD))
#define W_BT       ((float*)(F.ws + WS_MOD + 512 * 1024))
#define W_WUVT     ((bf16*)(F.ws + WS_WUV))
#define W_WOUTT    ((bf16*)(F.ws + WS_WOUT))
#define W_WINT     ((bf16*)(F.ws + WS_WIN))
#define W_KVSS     ((float*)(F.ws + WS_KVSS))
#define W_AUX      ((float*)(F.ws + WS_AUX))
#define W_XN       ((bf16*)(F.ws + WS_XN))
#define W_OAB      ((bf16*)(F.ws + WS_XN))
#define W_PROJ     ((bf16*)(F.ws + WS_PROJ))
#define W_MIX      ((bf16*)(F.ws + WS_PROJ))
#define W_SCR      ((float*)(F.ws + WS_SCR))
struct Args { const float* in[15]; float* out; unsigned char* ws; int ph_lo, ph_hi, li, pad; };

template <class CM>
__device__ __forceinline__ void transpose_item(const float* W, int ldw, bf16* WT, int K, int k0, int n0, LAS float* scr, int lane, CM cm, const float* ksc = nullptr) {
    const int nn = lane & 31, sc = cm(n0 + nn); const float ns = cm.scale(n0 + nn);
    float wl[32];
#pragma unroll
    for (int i = 0; i < 32; ++i) { const int kk = 2 * i + (lane >> 5); wl[i] = sc >= 0 ? __builtin_nontemporal_load(W + (size_t)(k0 + kk) * ldw + sc) : 0.f; }
#pragma unroll
    for (int i = 0; i < 32; ++i) { const int kk = 2 * i + (lane >> 5); scr[kk * 33 + nn] = (ksc ? wl[i] * ksc[k0 + kk] : wl[i]) * ns; }
    LDS_WAIT(); asm volatile("" ::: "memory");
    const int c = lane & 7;
#pragma unroll
    for (int j = 0; j < 4; ++j) { const int n = (lane >> 3) + 8 * j; const LAS float* s = scr + (8 * c) * 33 + n;
        v4u o; o.x = pk2(s[0 * 33], s[1 * 33]); o.y = pk2(s[2 * 33], s[3 * 33]); o.z = pk2(s[4 * 33], s[5 * 33]); o.w = pk2(s[6 * 33], s[7 * 33]);
        *(GAS v4u*)(WT + (size_t)(n0 + n) * K + k0 + 8 * c) = o; }
    LDS_WAIT(); asm volatile("" ::: "memory");
}
struct CmIdent { __device__ __forceinline__ int operator()(int n) const { return n; } __device__ __forceinline__ float scale(int) const { return 1.0f; } };
struct CmProj { const float* gkv; __device__ __forceinline__ int operator()(int n) const { return proj_src_col(n); }
    __device__ __forceinline__ float scale(int n) const { return (n >= C_QB && n < C_QB + 512) ? gkv[(n - C_QB) & 127] * (0.08838834764831845f * LOG2E) : 1.0f; } };

__device__ __forceinline__ void p0_prologue(Frame& F, const Args& args, const int parts = 3) {
    LAS float* scr = (LAS float*)(F.lds + F.wave * 16384);
    const int gw = F.vcu * NWAVES + F.wave, NGW = F.G * NWAVES;
    constexpr int I_IN = 16 * (NPROJ / 32), I_OUT = 16 * 32, I_UV = 4 * 2 * 4;
    if (parts & 1)
    for (int it = gw; it < I_IN + I_OUT + I_UV; it += NGW) {
        int r = it;
        if (r < I_IN) { const int kb = r / (NPROJ / 32), nb = r % (NPROJ / 32); transpose_item(P_WIN, 3792, W_WINT, 1024, 64 * kb, 32 * nb, scr, F.lane, CmProj{P_GKV}); continue; }
        r -= I_IN;
        if (r < I_OUT) { const int kb = r / 32, nb = r % 32; transpose_item(P_WOUT, 1024, W_WOUTT, 1024, 64 * kb, 32 * nb, scr, F.lane, CmIdent()); continue; }
        r -= I_OUT;
        { const int hd = r >> 3, kb = (r >> 2) & 1, nb = r & 3; transpose_item(P_WUV + (size_t)hd * 16384, 128, W_WUVT + (size_t)hd * 16384, 128, 64 * kb, 32 * nb, scr, F.lane, CmIdent(), P_GKV); }
    }
    __syncthreads();
    if ((parts & 2) && F.vcu == F.G - 1) W_BT[F.tid] = P_RELB[T5_BUCKET[F.tid >> 2] * 4 + (F.tid & 3)] * LOG2E;
    if ((parts & 2) && F.vcu < 192) {
        LAS float* SC = (LAS float*)F.lds;
        const int li = F.lane & 15, lq = F.lane >> 4, n = F.vcu * 16 + li, kw = F.wave * 128;
        float wv_[32];
#pragma unroll
        for (int s2 = 0; s2 < 32; ++s2) wv_[s2] = __builtin_nontemporal_load(P_WADA + (size_t)(kw + 4 * s2 + lq) * 3072 + n);
        {
            f32x4 cv[16];
#pragma unroll
            for (int i = 0; i < 16; ++i) cv[i] = *(const f32x4*)(P_C + 4 * (F.tid + i * NWAVES * 64));
#pragma unroll
            for (int i = 0; i < 16; ++i) { const int e = 4 * (F.tid + i * NWAVES * 64), bb = e >> 10, k = e & 1023;
                SC[k * 33 + bb] = siluf(cv[i].x); SC[(k + 1) * 33 + bb] = siluf(cv[i].y); SC[(k + 2) * 33 + bb] = siluf(cv[i].z); SC[(k + 3) * 33 + bb] = siluf(cv[i].w); }
        }
        __syncthreads();
        f32x4 C0 = {0.f, 0.f, 0.f, 0.f}, C1 = {0.f, 0.f, 0.f, 0.f};
#pragma unroll
        for (int s2 = 0; s2 < 32; ++s2) { const LAS float* ap = SC + (kw + 4 * s2 + lq) * 33 + li;
            C0 = MFMA16F(ap[0], wv_[s2], C0); C1 = MFMA16F(ap[16], wv_[s2], C1); }
        __syncthreads();
        LAS float* RED = (LAS float*)F.lds;
#pragma unroll
        for (int r = 0; r < 4; ++r) { RED[((F.wave * 2 + 0) * 4 + r) * 64 + F.lane] = C0[r]; RED[((F.wave * 2 + 1) * 4 + r) * 64 + F.lane] = C1[r]; }
        __syncthreads();
        { const int e = F.tid, mt = e >> 8, r = (e >> 6) & 3, ln = e & 63; float sum = 0.f;
#pragma unroll
            for (int w = 0; w < 8; ++w) sum += RED[w * 512 + e];
            const int bb = 16 * mt + 4 * (ln >> 4) + r, nn = F.vcu * 16 + (ln & 15);
            W_MOD[bb * 3072 + nn] = sum + P_BADA[nn]; }
        __syncthreads();
    }
}

__device__ __forceinline__ void p1_norm(Frame& F, const Args& args) {
    const int gw = F.vcu * NWAVES + F.wave, NGW = F.G * NWAVES;
    for (int m = 2 * gw; m < MROWS; m += 2 * NGW) {
        const int b = m >> 11;
        const GAS f32x4* xr = (const GAS f32x4*)(P_X + (size_t)m * DM) + F.lane;
        f32x4 v[2][4]; float ss[2] = {0.f, 0.f};
#pragma unroll
        for (int q = 0; q < 2; ++q)
#pragma unroll
            for (int j = 0; j < 4; ++j) v[q][j] = __builtin_nontemporal_load(xr + q * 256 + 64 * j);
#pragma unroll
        for (int q = 0; q < 2; ++q)
#pragma unroll
            for (int j = 0; j < 4; ++j) ss[q] += (v[q][j].x * v[q][j].x + v[q][j].y * v[q][j].y) + (v[q][j].z * v[q][j].z + v[q][j].w * v[q][j].w);
        const float rstd0 = rsqf_(wave_sum(ss[0]) * (1.0f / DM) + EPSF), rstd1 = rsqf_(wave_sum(ss[1]) * (1.0f / DM) + EPSF);
        const float* mb = W_MOD + b * 3072;
        GAS unsigned long long* o8 = (GAS unsigned long long*)(W_XN + (size_t)m * DM) + F.lane;
#pragma unroll
        for (int j = 0; j < 4; ++j) { const int col = F.lane * 4 + 256 * j;
            const f32x4 g = *(const f32x4*)(P_GPRE + col), sh = *(const f32x4*)(mb + col), sc = *(const f32x4*)(mb + 1024 + col);
            const f32x4 gs = g * (sc + 1.0f);
            const f32x4 o0 = v[0][j] * rstd0 * gs + sh, o1 = v[1][j] * rstd1 * gs + sh;
            o8[64 * j] = (unsigned long long)pg8::cvt_pk_bf16(o0.x, o0.y) | ((unsigned long long)pg8::cvt_pk_bf16(o0.z, o0.w) << 32);
            o8[256 + 64 * j] = (unsigned long long)pg8::cvt_pk_bf16(o1.x, o1.y) | ((unsigned long long)pg8::cvt_pk_bf16(o1.z, o1.w) << 32); }
    }
}

__device__ __forceinline__ void p5_final(Frame& F, const Args& args) {
    const int gw = F.vcu * NWAVES + F.wave, NGW = F.G * NWAVES;
    for (int m = 2 * gw; m < MROWS; m += 2 * NGW) {
        const int b = m >> 11;
        const GAS v2u* mr = (const GAS v2u*)(W_MIX + (size_t)m * DM) + F.lane;
        const GAS f32x4* xr = (const GAS f32x4*)(P_X + (size_t)m * DM) + F.lane;
        GAS f32x4* orow = (GAS f32x4*)(P_OUT + (size_t)m * DM) + F.lane;
        v2u w[2][4]; f32x4 xv[2][4];
#pragma unroll
        for (int q = 0; q < 2; ++q)
#pragma unroll
            for (int j = 0; j < 4; ++j) { w[q][j] = mr[q * 256 + 64 * j]; xv[q][j] = __builtin_nontemporal_load(xr + q * 256 + 64 * j); }
        f32x4 v[2][4]; float ss[2] = {0.f, 0.f};
#pragma unroll
        for (int q = 0; q < 2; ++q)
#pragma unroll
            for (int j = 0; j < 4; ++j) { v[q][j].x = bflo(w[q][j].x); v[q][j].y = bfhi(w[q][j].x); v[q][j].z = bflo(w[q][j].y); v[q][j].w = bfhi(w[q][j].y);
                ss[q] += (v[q][j].x * v[q][j].x + v[q][j].y * v[q][j].y) + (v[q][j].z * v[q][j].z + v[q][j].w * v[q][j].w); }
        const float rstd0 = rsqf_(wave_sum(ss[0]) * (1.0f / DM) + EPSF), rstd1 = rsqf_(wave_sum(ss[1]) * (1.0f / DM) + EPSF);
        const float* gt = W_MOD + b * 3072 + 2048;
#pragma unroll
        for (int j = 0; j < 4; ++j) { const int col = F.lane * 4 + 256 * j;
            const f32x4 g = *(const f32x4*)(P_GPOST + col), ga = *(const f32x4*)(gt + col);
            const f32x4 gg = g * ga;
            __builtin_nontemporal_store(xv[0][j] + gg * (v[0][j] * rstd0), orow + 64 * j);
            __builtin_nontemporal_store(xv[1][j] + gg * (v[1][j] * rstd1), orow + 256 + 64 * j); }
    }
}

__device__ __forceinline__ unsigned cvtpk(float lo, float hi) { return pg8::cvt_pk_bf16(lo, hi); }
__device__ __forceinline__ v2u pack4(float a, float b, float c, float d) { v2u r; r.x = cvtpk(a, b); r.y = cvtpk(c, d); return r; }
__device__ __forceinline__ bf16x8 pack8(float a, float b, float c, float d, float e, float f, float g, float h) { v4u r; r.x = cvtpk(a, b); r.y = cvtpk(c, d); r.z = cvtpk(e, f); r.w = cvtpk(g, h); return __builtin_bit_cast(bf16x8, r); }
__device__ __forceinline__ bf16x8 lds16(const LAS unsigned char* p) { return *(const LAS bf16x8*)p; }
__device__ __forceinline__ bf16x8 lds8x2(const LAS unsigned char* p) { const v2u lo = *(const LAS v2u*)p, hi = *(const LAS v2u*)(p + 16); v4u r; r.x = lo.x; r.y = lo.y; r.z = hi.x; r.w = hi.y; return __builtin_bit_cast(bf16x8, r); }
template <int S> __device__ __forceinline__ bf16x8 acc_frag(const f32x16& a) { return pack8(a[8 * S + 0], a[8 * S + 1], a[8 * S + 2], a[8 * S + 3], a[8 * S + 4], a[8 * S + 5], a[8 * S + 6], a[8 * S + 7]); }

__device__ __forceinline__ float row16_sum(float v) {
#define R16_STEP(ctrl) v += __builtin_bit_cast(float, __builtin_amdgcn_update_dpp(0, __builtin_bit_cast(int, v), ctrl, 0xf, 0xf, false))
    R16_STEP(0x121); R16_STEP(0x122); R16_STEP(0x124); R16_STEP(0x128);
#undef R16_STEP
    return v;
}

__device__ __forceinline__ void gdn_unit(Frame& F, const Args& args, const int b, const int h) {
    LAS unsigned char* const L = F.lds;
    const int tid = F.tid, lane = F.lane, wv = F.wave, l31_0 = lane & 31, hh_0 = lane >> 5;
    int tidv = tid, lanev = lane;
    constexpr int P128 = 272, P64 = 144;
    constexpr int O_KH = 0, O_QH = O_KH + 17408, O_KGT = O_QH + 17408, O_VBT = O_KGT + 18432, O_KBGT = O_VBT + 18432, O_LM = O_KBGT + 18432, O_T = O_LM + 17408,
                  O_AT = O_T + 17408, O_CW = O_AT + 9216, O_SM = O_CW + 6144, O_PSO = O_SM + 2560, O_OF = O_PSO + 2048, O_GG = O_OF + 17408, O_END = O_GG + 512;
    static_assert(O_END <= SCRATCH_BYTES, "gdn LDS map");
    constexpr int O_W = O_LM, O_VNT = O_VBT;
    LAS float* const SMb = (LAS float*)(L + O_SM);
    LAS float* const LM = (LAS float*)(L + O_LM);
    LAS float* const TT = (LAS float*)(L + O_T);
    LAS float* const CW = (LAS float*)(L + O_CW);
    LAS float* const GG = (LAS float*)(L + O_GG);
    LAS float* const PSO = (LAS float*)(L + O_PSO);
    const int mt = wv >> 2, nt = wv & 3;
    f32x16 S[4];
#pragma unroll
    for (int k = 0; k < 4; ++k)
#pragma unroll
        for (int r = 0; r < 16; ++r) S[k][r] = 0.f;
    const float alog_e = __expf(P_ALOG[h]), dtb = P_DTB[h];
#define GDN_SCAN_STEP(ctl, rm, bm) _gc += __builtin_bit_cast(float, __builtin_amdgcn_update_dpp(0, __builtin_bit_cast(int, _gc), ctl, rm, bm, false))
#define GDN_GATES(n_) do { LAS float* _sm = SMb + ((n_) & 1) * 320; const float* _ap = W_AUX + (size_t)(b * SEQ + (n_) * 64 + lanev) * 16; \
        const float _bb = _ap[h], _aa = _ap[4 + h]; const float _beta = rcpf_(1.0f + __expf(-_bb)); const float _xs = _aa + dtb; \
        const float _sp = _xs > 20.f ? _xs : 0.6931471805599453f * __builtin_amdgcn_logf(1.0f + __builtin_amdgcn_exp2f(1.4426950408889634f * _xs)); float _gc = -alog_e * _sp; \
        GDN_SCAN_STEP(0x111, 0xf, 0xf); GDN_SCAN_STEP(0x112, 0xf, 0xf); GDN_SCAN_STEP(0x114, 0xf, 0xe); GDN_SCAN_STEP(0x118, 0xf, 0xc); GDN_SCAN_STEP(0x142, 0xa, 0xf); GDN_SCAN_STEP(0x143, 0xc, 0xf); \
        const float _gl = __builtin_bit_cast(float, __builtin_amdgcn_readlane(__builtin_bit_cast(int, _gc), 63)); _sm[lanev] = _gc * 1.4426950408889634f; _sm[64 + lanev] = _beta; _sm[128 + lanev] = __expf(_gc); _sm[192 + lanev] = __expf(_gl - _gc); \
        if (lanev == 0) _sm[256] = __expf(_gl); } while (0)
    if (wv == 6) GDN_GATES(0);
    if (tidv < 128) GG[tidv] = P_GGDN[tidv];
    for (int e = tidv; e < 3 * 4 * 128; e += NWAVES * 64) { const int ts_ = e >> 9, tap = (e >> 7) & 3, ch = e & 127; CW[(e & ~127) + ((ch >> 2) & 1) * 64 + (ch >> 3) * 4 + (ch & 3)] = P_CONVW[tap * 1536 + ts_ * 512 + h * 128 + ch]; }
    const int ts = tid >> 8;
    int cgv = tid & 15, tpv = (tid >> 4) & 15;
#define GDN_ROWS(dst_, n_, chan_) do { const bf16* _src = W_PROJ + (size_t)(b * SEQ + (n_) * 64 + 4 * tpv - 3) * NPROJ + (chan_); \
        _Pragma("unroll") for (int _i = 0; _i < 7; ++_i) { v4u _z; _z.x = 0u; _z.y = 0u; _z.z = 0u; _z.w = 0u; dst_[_i] = _z; \
            if ((n_) > 0 || 4 * tpv - 3 + _i >= 0) dst_[_i] = *(const GAS v4u*)(_src + (size_t)_i * NPROJ); } } while (0)
#define GDN_OUT_LOAD(rowb_) do { const int _tok = tidv >> 3, _dv0 = (tidv & 7) * 16; const size_t _row = (size_t)(rowb_) + _tok; \
        const bf16* _zp = W_PROJ + _row * NPROJ + C_ZA + h * 128 + _dv0; oz0 = *(const GAS v4u*)_zp; oz1 = *(const GAS v4u*)(_zp + 8); } while (0)
#define GDN_OUT_DO(rowb_) do { const int _tok = tidv >> 3, _dv0 = (tidv & 7) * 16; const size_t _row = (size_t)(rowb_) + _tok; \
        const LAS v4u* _op = (const LAS v4u*)(L + O_OF + _tok * P128 + _dv0 * 2); const v4u _o0 = _op[0], _o1 = _op[1]; \
        const LAS f32x4* _pp = (const LAS f32x4*)(PSO + _tok * 8); const f32x4 _a = _pp[0], _c = _pp[1]; \
        const float _rstd = rsqf_((((_a.x + _a.y) + (_a.z + _a.w)) + ((_c.x + _c.y) + (_c.z + _c.w))) * (1.0f / 128.0f) + EPSF); \
        const unsigned _ow[8] = {_o0.x, _o0.y, _o0.z, _o0.w, _o1.x, _o1.y, _o1.z, _o1.w}, _zw[8] = {oz0.x, oz0.y, oz0.z, oz0.w, oz1.x, oz1.y, oz1.z, oz1.w}; unsigned _rw[8]; \
        _Pragma("unroll") for (int _k = 0; _k < 4; ++_k) { const f32x4 _g = *(const LAS f32x4*)(GG + _dv0 + 4 * _k); \
            _rw[2 * _k] = cvtpk(bflo(_ow[2 * _k]) * _rstd * _g.x * siluf(bflo(_zw[2 * _k])), bfhi(_ow[2 * _k]) * _rstd * _g.y * siluf(bfhi(_zw[2 * _k]))); \
            _rw[2 * _k + 1] = cvtpk(bflo(_ow[2 * _k + 1]) * _rstd * _g.z * siluf(bflo(_zw[2 * _k + 1])), bfhi(_ow[2 * _k + 1]) * _rstd * _g.w * siluf(bfhi(_zw[2 * _k + 1]))); } \
        bf16* _dst = W_OAB + _row * DM + h * 128 + _dv0; v4u _w0, _w1; _w0.x = _rw[0]; _w0.y = _rw[1]; _w0.z = _rw[2]; _w0.w = _rw[3]; _w1.x = _rw[4]; _w1.y = _rw[5]; _w1.z = _rw[6]; _w1.w = _rw[7]; \
        *(GAS v4u*)_dst = _w0; *(GAS v4u*)(_dst + 8) = _w1; } while (0)
    for (int e = tidv; e < 64 * 68; e += NWAVES * 64) TT[e] = 0.f;
    __syncthreads();

    unsigned pf_sink = 0u;
    v4u rq[7];
    GDN_ROWS(rq, 0, ts * 512 + h * 128 + cgv * 8);
    for (int n = 0; n < 32; ++n) {
        const int rowbase = b * SEQ + n * 64;
        LAS float* const SMf = SMb + (n & 1) * 320;
        tidv = tid; lanev = lane; cgv = tid & 15; tpv = (tid >> 4) & 15;
        asm volatile("" : "+v"(tidv), "+v"(lanev), "+v"(cgv), "+v"(tpv));
        int l31 = lanev & 31, hh = lanev >> 5, cg = cgv, tp = tpv;
        const int tsw = tp ^ (4 * (cg >> 2));
        if (wv == 6 && n + 1 < 32) GDN_GATES(n + 1);
        float val[4][8];
#define GDN_CONV(rows_, tsel_) do { \
            _Pragma("unroll") for (int _j = 0; _j < 4; ++_j) _Pragma("unroll") for (int _e = 0; _e < 8; ++_e) val[_j][_e] = 0.f; \
            _Pragma("unroll") for (int _tap = 0; _tap < 4; ++_tap) { const LAS f32x4* _cp = (const LAS f32x4*)(CW + ((tsel_) * 4 + _tap) * 128 + cg * 4); const f32x4 _c0 = _cp[0], _c1 = _cp[16]; \
                const float _cw[8] = {_c0.x, _c0.y, _c0.z, _c0.w, _c1.x, _c1.y, _c1.z, _c1.w}; \
                _Pragma("unroll") for (int _j = 0; _j < 4; ++_j) { const v4u _raw = rows_[_j + _tap]; \
                    const float _in[8] = {bflo(_raw.x), bfhi(_raw.x), bflo(_raw.y), bfhi(_raw.y), bflo(_raw.z), bfhi(_raw.z), bflo(_raw.w), bfhi(_raw.w)}; \
                    _Pragma("unroll") for (int _e = 0; _e < 8; ++_e) val[_j][_e] += _in[_e] * _cw[_e]; } } \
            _Pragma("unroll") for (int _j = 0; _j < 4; ++_j) _Pragma("unroll") for (int _e = 0; _e < 8; ++_e) val[_j][_e] = siluf(val[_j][_e]); } while (0)
        v4u oz0, oz1;
        if (n > 0) GDN_OUT_LOAD(rowbase - 64);
        v4u rv[5];
        { const int tp2_ = tidv >> 4; const bf16* _src = W_PROJ + (size_t)(rowbase + 2 * tp2_ - 3) * NPROJ + 1024 + h * 128 + cgv * 8;
#pragma unroll
            for (int _i = 0; _i < 5; ++_i) { v4u _z; _z.x = 0u; _z.y = 0u; _z.z = 0u; _z.w = 0u; rv[_i] = _z;
                if (n > 0 || 2 * tp2_ - 3 + _i >= 0) rv[_i] = *(const GAS v4u*)(_src + (size_t)_i * NPROJ); } }
        if (wv == 7 && n + 1 < 32) {
#pragma unroll
            for (int i = 0; i < 9; ++i) { const int idx = i * 64 + lanev; const int rr = idx >> 3, ln = idx & 7;
                if (idx < 67 * 8) { const bf16* pt = W_PROJ + (size_t)(rowbase + 61 + rr) * NPROJ + (ln >> 1) * 512 + h * 128 + (ln & 1) * 64;
                    asm volatile("global_load_dword %0, %1, off" : "+v"(pf_sink) : "v"(pt) : "memory"); } }
        }
        {
            GDN_CONV(rq, ts);
#pragma unroll
            for (int j = 0; j < 4; ++j) { float ss = 0.f;
#pragma unroll
                for (int e = 0; e < 8; ++e) ss += val[j][e] * val[j][e];
                ss = row16_sum(ss);
                float r = rsqf_(ss + EPSF); if (ts == 0) r *= 0.08838834764831845f;
#pragma unroll
                for (int e = 0; e < 8; ++e) val[j][e] *= r; }
            if (ts == 0) {
#pragma unroll
                for (int j = 0; j < 4; ++j) *(LAS bf16x8*)(L + O_QH + (4 * tp + j) * P128 + cg * 16) = pack8(val[j][0], val[j][1], val[j][2], val[j][3], val[j][4], val[j][5], val[j][6], val[j][7]);
            } else {
                float ek[4], bg[4];
#pragma unroll
                for (int j = 0; j < 4; ++j) { ek[j] = SMf[192 + 4 * tp + j]; bg[j] = SMf[64 + 4 * tp + j] * SMf[128 + 4 * tp + j]; }
#pragma unroll
                for (int j = 0; j < 4; ++j) *(LAS bf16x8*)(L + O_KH + (4 * tp + j) * P128 + cg * 16) = pack8(val[j][0], val[j][1], val[j][2], val[j][3], val[j][4], val[j][5], val[j][6], val[j][7]);
#pragma unroll
                for (int e = 0; e < 8; ++e) {
                    *(LAS v2u*)(L + O_KGT + (cg * 8 + e) * P64 + tsw * 8) = pack4(val[0][e] * ek[0], val[1][e] * ek[1], val[2][e] * ek[2], val[3][e] * ek[3]);
                    *(LAS v2u*)(L + O_KBGT + (cg * 8 + e) * P64 + tsw * 8) = pack4(val[0][e] * bg[0], val[1][e] * bg[1], val[2][e] * bg[2], val[3][e] * bg[3]); }
            }
        }
        if (n > 0) GDN_OUT_DO(rowbase - 64);
        {
            const int tp2 = tidv >> 4;
            float v2[2][8];
#pragma unroll
            for (int j = 0; j < 2; ++j)
#pragma unroll
                for (int e = 0; e < 8; ++e) v2[j][e] = 0.f;
#pragma unroll
            for (int tap = 0; tap < 4; ++tap) { const LAS f32x4* cp = (const LAS f32x4*)(CW + (2 * 4 + tap) * 128 + cg * 4); const f32x4 c0 = cp[0], c1 = cp[16];
                const float cw[8] = {c0.x, c0.y, c0.z, c0.w, c1.x, c1.y, c1.z, c1.w};
#pragma unroll
                for (int j = 0; j < 2; ++j) { const v4u raw = rv[j + tap];
                    const float in[8] = {bflo(raw.x), bfhi(raw.x), bflo(raw.y), bfhi(raw.y), bflo(raw.z), bfhi(raw.z), bflo(raw.w), bfhi(raw.w)};
#pragma unroll
                    for (int e = 0; e < 8; ++e) v2[j][e] += in[e] * cw[e]; } }
            const float be0 = SMf[64 + 2 * tp2], be1 = SMf[64 + 2 * tp2 + 1];
            const int vsw = (((tp2 >> 1) ^ (4 * (cg >> 2))) * 8) + (tp2 & 1) * 4;
#pragma unroll
            for (int e = 0; e < 8; ++e) *(LAS unsigned*)(L + O_VBT + (cg * 8 + e) * P64 + vsw) = cvtpk(siluf(v2[0][e]) * be0, siluf(v2[1][e]) * be1);
        }
        __syncthreads();
        if (wv < 4) {
            const int ti = wv >> 1, tj = wv & 1;
            const float gcj = SMf[32 * tj + l31];
            f32x4 gci4[4], bei4[4];
#pragma unroll
            for (int g = 0; g < 4; ++g) { gci4[g] = *(const LAS f32x4*)(SMf + 32 * ti + 8 * g + 4 * hh); bei4[g] = *(const LAS f32x4*)(SMf + 64 + 32 * ti + 8 * g + 4 * hh); }
            f32x16 C;
#pragma unroll
            for (int r = 0; r < 16; ++r) C[r] = 0.f;
            if (ti >= tj) {
                bf16x8 fa[8], fb[8];
#pragma unroll
                for (int s = 0; s < 8; ++s) { fa[s] = lds16(L + O_KH + (32 * ti + l31) * P128 + (16 * s + 8 * hh) * 2); fb[s] = lds16(L + O_KH + (32 * tj + l31) * P128 + (16 * s + 8 * hh) * 2); }
                __builtin_amdgcn_sched_barrier(0);
#pragma unroll
                for (int s = 0; s < 8; ++s) C = MFMA32(fa[s], fb[s], C);
            }
            const int j = 32 * tj + l31;
#pragma unroll
            for (int g = 0; g < 4; ++g) { const int ib = 32 * ti + 8 * g + 4 * hh; const f32x4 gci = gci4[g], bei = bei4[g];
#pragma unroll
                for (int e = 0; e < 4; ++e) { const int i = ib + e; LM[i * 68 + j] = (i > j) ? bei[e] * C[4 * g + e] * __builtin_amdgcn_exp2f(gci[e] - gcj) : 0.f; } }
            if (ti == tj) {
                asm volatile("s_waitcnt lgkmcnt(0)" ::: "memory");
                const int a = 2 * ti, bq = 2 * ti + 1;
                if (lanev < 32) {
                    const int blk = a + (lanev >> 4), c = lanev & 15; float x[16];
                    const LAS float* lb = LM + (16 * blk) * 68 + 16 * blk;
                    f32x4 r1[6][2], r2[4][3], r3[3][4], r4[2][4];
#define INVA_RD(dst_, i0_, i1_) _Pragma("unroll") for (int i = i0_; i <= i1_; ++i) _Pragma("unroll") for (int q = 0; q < (i + 3) / 4; ++q) dst_[i - i0_][q] = *(const LAS f32x4*)(lb + i * 68 + 4 * q)
#define INVA_DO(src_, i0_, i1_) _Pragma("unroll") for (int i = i0_; i <= i1_; ++i) { float acc = (i == c) ? 1.f : 0.f; \
                        _Pragma("unroll") for (int j = 0; j < i; ++j) acc -= src_[i - i0_][j >> 2][j & 3] * x[j]; \
                        x[i] = acc; }
                    INVA_RD(r1, 1, 6); INVA_RD(r2, 7, 10);
                    __builtin_amdgcn_sched_barrier(0);
                    x[0] = (c == 0) ? 1.f : 0.f;
                    INVA_DO(r1, 1, 6);
                    INVA_RD(r3, 11, 13);
                    __builtin_amdgcn_sched_barrier(0);
                    INVA_DO(r2, 7, 10);
                    INVA_RD(r4, 14, 15);
                    __builtin_amdgcn_sched_barrier(0);
                    INVA_DO(r3, 11, 13);
                    INVA_DO(r4, 14, 15);
#undef INVA_RD
#undef INVA_DO
    #pragma unroll
                    for (int i = 0; i < 16; ++i) TT[(16 * blk + i) * 68 + 16 * blk + c] = x[i];
                }
                asm volatile("s_waitcnt lgkmcnt(0)" ::: "memory");
                const int m = lanev & 15, q = lanev >> 4;
                f32x4 P = {0.f, 0.f, 0.f, 0.f}, R = {0.f, 0.f, 0.f, 0.f};
    #pragma unroll
                for (int s = 0; s < 4; ++s) { const int k = q + 4 * s; P = MFMA16F(LM[(16 * bq + m) * 68 + 16 * a + k], TT[(16 * a + k) * 68 + 16 * a + m], P); }
    #pragma unroll
                for (int rg = 0; rg < 4; ++rg) { const int k = 4 * q + rg; R = MFMA16F(TT[(16 * bq + m) * 68 + 16 * bq + k], P[rg], R); }
    #pragma unroll
                for (int rg = 0; rg < 4; ++rg) TT[(16 * bq + 4 * q + rg) * 68 + 16 * a + m] = -R[rg];
            }
        } else {
            const int w4 = wv - 4, tj = w4 >> 1, ti = w4 & 1;
            const float gci = SMf[32 * ti + l31];
            f32x4 gcj4[4];
#pragma unroll
            for (int g = 0; g < 4; ++g) gcj4[g] = *(const LAS f32x4*)(SMf + 32 * tj + 8 * g + 4 * hh);
            f32x16 C;
#pragma unroll
            for (int r = 0; r < 16; ++r) C[r] = 0.f;
            if (ti >= tj) {
                bf16x8 fa[8], fb[8];
#pragma unroll
                for (int s = 0; s < 8; ++s) { fa[s] = lds16(L + O_KH + (32 * tj + l31) * P128 + (16 * s + 8 * hh) * 2); fb[s] = lds16(L + O_QH + (32 * ti + l31) * P128 + (16 * s + 8 * hh) * 2); }
                __builtin_amdgcn_sched_barrier(0);
#pragma unroll
                for (int s = 0; s < 8; ++s) C = MFMA32(fa[s], fb[s], C);
            }
            const int i = 32 * ti + l31;
#pragma unroll
            for (int g = 0; g < 4; ++g) { const int jb = 32 * tj + 8 * g + 4 * hh; const f32x4 gcj = gcj4[g]; float v[4];
#pragma unroll
                for (int e = 0; e < 4; ++e) v[e] = (i >= jb + e) ? C[4 * g + e] * __builtin_amdgcn_exp2f(gci - gcj[e]) : 0.f;
                *(LAS v2u*)(L + O_AT + i * P64 + jb * 2) = pack4(v[0], v[1], v[2], v[3]); }
        }
        __syncthreads();
        if (wv < 4) {
            const int m = lanev & 15, q = lanev >> 4, mi = wv >> 1, ni = wv & 1;
            f32x4 P0 = {0.f, 0.f, 0.f, 0.f}, P1 = {0.f, 0.f, 0.f, 0.f}, R = {0.f, 0.f, 0.f, 0.f};
            float bt[8], l0[8], l1[8], t0[4], t1[4];
#pragma unroll
            for (int s = 0; s < 8; ++s) { const int k = q + 4 * s; bt[s] = TT[k * 68 + 16 * ni + m]; l0[s] = LM[(32 + m) * 68 + k]; l1[s] = LM[(48 + m) * 68 + k]; }
#pragma unroll
            for (int rg = 0; rg < 4; ++rg) { t0[rg] = TT[(32 + 16 * mi + m) * 68 + 32 + 4 * q + rg]; t1[rg] = TT[(32 + 16 * mi + m) * 68 + 48 + 4 * q + rg]; }
            __builtin_amdgcn_sched_barrier(0);
#pragma unroll
            for (int s = 0; s < 8; ++s) { P0 = MFMA16F(l0[s], bt[s], P0); P1 = MFMA16F(l1[s], bt[s], P1); }
#pragma unroll
            for (int rg = 0; rg < 4; ++rg) { R = MFMA16F(t0[rg], P0[rg], R); R = MFMA16F(t1[rg], P1[rg], R); }
#pragma unroll
            for (int rg = 0; rg < 4; ++rg) TT[(32 + 16 * mi + 4 * q + rg) * 68 + 16 * ni + m] = -R[rg];
        }
        __syncthreads();
        f32x16 U, WT_;
#pragma unroll
        for (int r = 0; r < 16; ++r) { U[r] = 0.f; WT_[r] = 0.f; }
        {
            f32x4 tq0[4], tq1[4]; bf16x8 fv[4], fk[4];
#pragma unroll
            for (int s = 0; s < 4; ++s) { const LAS f32x4* tp4 = (const LAS f32x4*)(TT + (32 * mt + l31) * 68 + 16 * s + 8 * hh); tq0[s] = tp4[0]; tq1[s] = tp4[1];
                fv[s] = lds16(L + O_VBT + (32 * nt + l31) * P64 + (16 * (s ^ nt) + 8 * hh) * 2); fk[s] = lds16(L + O_KBGT + (32 * nt + l31) * P64 + (16 * (s ^ nt) + 8 * hh) * 2); }
            __builtin_amdgcn_sched_barrier(0);
#pragma unroll
            for (int s = 0; s < 4; ++s) { const bf16x8 a = pack8(tq0[s].x, tq0[s].y, tq0[s].z, tq0[s].w, tq1[s].x, tq1[s].y, tq1[s].z, tq1[s].w);
                U = MFMA32(a, fv[s], U); WT_ = MFMA32(fk[s], a, WT_); }
        }
#pragma unroll
        for (int g = 0; g < 4; ++g) *(LAS v2u*)(L + O_W + (32 * mt + l31) * P128 + (32 * nt + 8 * g + 4 * hh) * 2) = pack4(-WT_[4 * g], -WT_[4 * g + 1], -WT_[4 * g + 2], -WT_[4 * g + 3]);
        __syncthreads();
        bf16x8 sf[4][2];
        {
            bf16x8 fw[4][2];
#pragma unroll
            for (int kt = 0; kt < 4; ++kt)
#pragma unroll
                for (int s = 0; s < 2; ++s) fw[kt][s] = lds8x2(L + O_W + (32 * mt + l31) * P128 + (32 * kt + 16 * s + 4 * hh) * 2);
            __builtin_amdgcn_sched_barrier(0);
#pragma unroll
            for (int kt = 0; kt < 4; ++kt) { sf[kt][0] = acc_frag<0>(S[kt]); sf[kt][1] = acc_frag<1>(S[kt]); }
            __builtin_amdgcn_sched_barrier(0);
#pragma unroll
            for (int kt = 0; kt < 4; ++kt)
#pragma unroll
                for (int s = 0; s < 2; ++s) U = MFMA32(fw[kt][s], sf[kt][s], U);
        }
#pragma unroll
        for (int g = 0; g < 4; ++g) *(LAS v2u*)(L + O_VNT + (32 * nt + l31) * P64 + (32 * mt + 8 * g + 4 * hh) * 2) = pack4(U[4 * g], U[4 * g + 1], U[4 * g + 2], U[4 * g + 3]);
        __syncthreads();
        {
            f32x16 Oa;
#pragma unroll
            for (int r = 0; r < 16; ++r) Oa[r] = 0.f;
            bf16x8 vn[4], fat[4], fg[4]; f32x4 e4[4];
            {
                bf16x8 fq[4][2];
#pragma unroll
                for (int kt = 0; kt < 4; ++kt)
#pragma unroll
                    for (int s = 0; s < 2; ++s) fq[kt][s] = lds8x2(L + O_QH + (32 * mt + l31) * P128 + (32 * kt + 16 * s + 4 * hh) * 2);
                __builtin_amdgcn_sched_barrier(0);
#pragma unroll
                for (int kt = 0; kt < 4; ++kt)
#pragma unroll
                    for (int s = 0; s < 2; ++s) Oa = MFMA32(fq[kt][s], sf[kt][s], Oa);
            }
#pragma unroll
            for (int g = 0; g < 4; ++g) e4[g] = *(const LAS f32x4*)(SMf + 128 + 32 * mt + 8 * g + 4 * hh);
#pragma unroll
            for (int s = 0; s < 4; ++s) { vn[s] = lds16(L + O_VNT + (32 * nt + l31) * P64 + (16 * s + 8 * hh) * 2); fat[s] = lds16(L + O_AT + (32 * mt + l31) * P64 + (16 * s + 8 * hh) * 2); }
            const float glast = SMf[256];
#pragma unroll
            for (int s = 0; s < 4; ++s) fg[s] = lds16(L + O_KGT + l31 * P64 + (16 * s + 8 * hh) * 2);
            __builtin_amdgcn_sched_barrier(0);
#pragma unroll
            for (int g = 0; g < 4; ++g)
#pragma unroll
                for (int e = 0; e < 4; ++e) Oa[4 * g + e] *= e4[g][e];
#pragma unroll
            for (int s = 0; s < 4; ++s) Oa = MFMA32(fat[s], vn[s], Oa);
#pragma unroll
            for (int kt = 0; kt < 4; ++kt) {
                bf16x8 fgn[4];
                if (kt < 3) {
#pragma unroll
                    for (int s = 0; s < 4; ++s) fgn[s] = lds16(L + O_KGT + (32 * (kt + 1) + l31) * P64 + (16 * (s ^ (kt + 1)) + 8 * hh) * 2);
                }
                __builtin_amdgcn_sched_barrier(0);
#pragma unroll
                for (int r = 0; r < 16; ++r) S[kt][r] *= glast;
#pragma unroll
                for (int s = 0; s < 4; ++s) S[kt] = MFMA32(fg[s], vn[s], S[kt]);
                if (kt < 3) {
#pragma unroll
                    for (int s = 0; s < 4; ++s) fg[s] = fgn[s];
                }
            }
            float q2v[16];
#pragma unroll
            for (int r = 0; r < 16; ++r) q2v[r] = row16_sum(Oa[r] * Oa[r]);
            LAS unsigned char* const ofb = (LAS unsigned char*)(((unsigned)(size_t)(L + O_OF) + (unsigned)((32 * mt + 4 * hh) * P128 + (32 * nt + l31) * 2)) & 0x3ffffu);
#pragma unroll
            for (int r = 0; r < 16; ++r) *(LAS unsigned short*)(ofb + (8 * (r >> 2) + (r & 3)) * P128) = (unsigned short)cvtpk(Oa[r], 0.f);
            if ((lanev & 15) == 0) {
                LAS float* const psb = (LAS float*)(((unsigned)(size_t)PSO + (unsigned)(((32 * mt + 4 * hh) * 8 + 2 * nt + ((lanev >> 4) & 1)) * 4)) & 0x3ffffu);
#pragma unroll
                for (int r = 0; r < 16; ++r) psb[(8 * (r >> 2) + (r & 3)) * 8] = q2v[r];
            }
        }
        asm volatile("s_waitcnt vmcnt(0)" : "+v"(pf_sink) :: "memory");
        if (n + 1 < 32) GDN_ROWS(rq, n + 1, ts * 512 + h * 128 + cgv * 8);
        __syncthreads();
    }
    { v4u oz0, oz1; GDN_OUT_LOAD(b * SEQ + 31 * 64); GDN_OUT_DO(b * SEQ + 31 * 64); }
    __syncthreads();
#undef GDN_GATES
#undef GDN_SCAN_STEP
#undef GDN_CONV
#undef GDN_ROWS
#undef GDN_OUT_LOAD
#undef GDN_OUT_DO
}

typedef short s16x4 __attribute__((ext_vector_type(4)));
__device__ __forceinline__ bf16x8 ldstr8(const LAS unsigned char* p0, const LAS unsigned char* p1) {
    const s16x4 a = __builtin_amdgcn_ds_read_tr16_b64_v4i16((LAS s16x4*)p0), b = __builtin_amdgcn_ds_read_tr16_b64_v4i16((LAS s16x4*)p1);
    bf16x8 r; r[0] = a[0]; r[1] = a[1]; r[2] = a[2]; r[3] = a[3]; r[4] = b[0]; r[5] = b[1]; r[6] = b[2]; r[7] = b[3]; return r;
}
__device__ __forceinline__ void wrlane(unsigned& dst, const unsigned val, const int idx) {
    switch (idx) {
    case 0: asm("s_nop 1\n\tv_writelane_b32 %0, %1, 0" : "+v"(dst) : "s"(val)); break;
    case 1: asm("s_nop 1\n\tv_writelane_b32 %0, %1, 1" : "+v"(dst) : "s"(val)); break;
    case 2: asm("s_nop 1\n\tv_writelane_b32 %0, %1, 2" : "+v"(dst) : "s"(val)); break;
    case 3: asm("s_nop 1\n\tv_writelane_b32 %0, %1, 3" : "+v"(dst) : "s"(val)); break;
    case 4: asm("s_nop 1\n\tv_writelane_b32 %0, %1, 4" : "+v"(dst) : "s"(val)); break;
    case 5: asm("s_nop 1\n\tv_writelane_b32 %0, %1, 5" : "+v"(dst) : "s"(val)); break;
    case 6: asm("s_nop 1\n\tv_writelane_b32 %0, %1, 6" : "+v"(dst) : "s"(val)); break;
    case 7: asm("s_nop 1\n\tv_writelane_b32 %0, %1, 7" : "+v"(dst) : "s"(val)); break;
    case 8: asm("s_nop 1\n\tv_writelane_b32 %0, %1, 8" : "+v"(dst) : "s"(val)); break;
    case 9: asm("s_nop 1\n\tv_writelane_b32 %0, %1, 9" : "+v"(dst) : "s"(val)); break;
    case 10: asm("s_nop 1\n\tv_writelane_b32 %0, %1, 10" : "+v"(dst) : "s"(val)); break;
    case 11: asm("s_nop 1\n\tv_writelane_b32 %0, %1, 11" : "+v"(dst) : "s"(val)); break;
    case 12: asm("s_nop 1\n\tv_writelane_b32 %0, %1, 12" : "+v"(dst) : "s"(val)); break;
    case 13: asm("s_nop 1\n\tv_writelane_b32 %0, %1, 13" : "+v"(dst) : "s"(val)); break;
    case 14: asm("s_nop 1\n\tv_writelane_b32 %0, %1, 14" : "+v"(dst) : "s"(val)); break;
    case 15: asm("s_nop 1\n\tv_writelane_b32 %0, %1, 15" : "+v"(dst) : "s"(val)); break;
    case 16: asm("s_nop 1\n\tv_writelane_b32 %0, %1, 16" : "+v"(dst) : "s"(val)); break;
    case 17: asm("s_nop 1\n\tv_writelane_b32 %0, %1, 17" : "+v"(dst) : "s"(val)); break;
    case 18: asm("s_nop 1\n\tv_writelane_b32 %0, %1, 18" : "+v"(dst) : "s"(val)); break;
    case 19: asm("s_nop 1\n\tv_writelane_b32 %0, %1, 19" : "+v"(dst) : "s"(val)); break;
    case 20: asm("s_nop 1\n\tv_writelane_b32 %0, %1, 20" : "+v"(dst) : "s"(val)); break;
    case 21: asm("s_nop 1\n\tv_writelane_b32 %0, %1, 21" : "+v"(dst) : "s"(val)); break;
    case 22: asm("s_nop 1\n\tv_writelane_b32 %0, %1, 22" : "+v"(dst) : "s"(val)); break;
    case 23: asm("s_nop 1\n\tv_writelane_b32 %0, %1, 23" : "+v"(dst) : "s"(val)); break;
    case 24: asm("s_nop 1\n\tv_writelane_b32 %0, %1, 24" : "+v"(dst) : "s"(val)); break;
    case 25: asm("s_nop 1\n\tv_writelane_b32 %0, %1, 25" : "+v"(dst) : "s"(val)); break;
    case 26: asm("s_nop 1\n\tv_writelane_b32 %0, %1, 26" : "+v"(dst) : "s"(val)); break;
    case 27: asm("s_nop 1\n\tv_writelane_b32 %0, %1, 27" : "+v"(dst) : "s"(val)); break;
    case 28: asm("s_nop 1\n\tv_writelane_b32 %0, %1, 28" : "+v"(dst) : "s"(val)); break;
    case 29: asm("s_nop 1\n\tv_writelane_b32 %0, %1, 29" : "+v"(dst) : "s"(val)); break;
    case 30: asm("s_nop 1\n\tv_writelane_b32 %0, %1, 30" : "+v"(dst) : "s"(val)); break;
    case 31: asm("s_nop 1\n\tv_writelane_b32 %0, %1, 31" : "+v"(dst) : "s"(val)); break;
    case 32: asm("s_nop 1\n\tv_writelane_b32 %0, %1, 32" : "+v"(dst) : "s"(val)); break;
    case 33: asm("s_nop 1\n\tv_writelane_b32 %0, %1, 33" : "+v"(dst) : "s"(val)); break;
    case 34: asm("s_nop 1\n\tv_writelane_b32 %0, %1, 34" : "+v"(dst) : "s"(val)); break;
    case 35: asm("s_nop 1\n\tv_writelane_b32 %0, %1, 35" : "+v"(dst) : "s"(val)); break;
    case 36: asm("s_nop 1\n\tv_writelane_b32 %0, %1, 36" : "+v"(dst) : "s"(val)); break;
    case 37: asm("s_nop 1\n\tv_writelane_b32 %0, %1, 37" : "+v"(dst) : "s"(val)); break;
    case 38: asm("s_nop 1\n\tv_writelane_b32 %0, %1, 38" : "+v"(dst) : "s"(val)); break;
    case 39: asm("s_nop 1\n\tv_writelane_b32 %0, %1, 39" : "+v"(dst) : "s"(val)); break;
    case 40: asm("s_nop 1\n\tv_writelane_b32 %0, %1, 40" : "+v"(dst) : "s"(val)); break;
    case 41: asm("s_nop 1\n\tv_writelane_b32 %0, %1, 41" : "+v"(dst) : "s"(val)); break;
    case 42: asm("s_nop 1\n\tv_writelane_b32 %0, %1, 42" : "+v"(dst) : "s"(val)); break;
    case 43: asm("s_nop 1\n\tv_writelane_b32 %0, %1, 43" : "+v"(dst) : "s"(val)); break;
    case 44: asm("s_nop 1\n\tv_writelane_b32 %0, %1, 44" : "+v"(dst) : "s"(val)); break;
    case 45: asm("s_nop 1\n\tv_writelane_b32 %0, %1, 45" : "+v"(dst) : "s"(val)); break;
    case 46: asm("s_nop 1\n\tv_writelane_b32 %0, %1, 46" : "+v"(dst) : "s"(val)); break;
    case 47: asm("s_nop 1\n\tv_writelane_b32 %0, %1, 47" : "+v"(dst) : "s"(val)); break;
    case 48: asm("s_nop 1\n\tv_writelane_b32 %0, %1, 48" : "+v"(dst) : "s"(val)); break;
    case 49: asm("s_nop 1\n\tv_writelane_b32 %0, %1, 49" : "+v"(dst) : "s"(val)); break;
    case 50: asm("s_nop 1\n\tv_writelane_b32 %0, %1, 50" : "+v"(dst) : "s"(val)); break;
    case 51: asm("s_nop 1\n\tv_writelane_b32 %0, %1, 51" : "+v"(dst) : "s"(val)); break;
    case 52: asm("s_nop 1\n\tv_writelane_b32 %0, %1, 52" : "+v"(dst) : "s"(val)); break;
    case 53: asm("s_nop 1\n\tv_writelane_b32 %0, %1, 53" : "+v"(dst) : "s"(val)); break;
    case 54: asm("s_nop 1\n\tv_writelane_b32 %0, %1, 54" : "+v"(dst) : "s"(val)); break;
    case 55: asm("s_nop 1\n\tv_writelane_b32 %0, %1, 55" : "+v"(dst) : "s"(val)); break;
    case 56: asm("s_nop 1\n\tv_writelane_b32 %0, %1, 56" : "+v"(dst) : "s"(val)); break;
    case 57: asm("s_nop 1\n\tv_writelane_b32 %0, %1, 57" : "+v"(dst) : "s"(val)); break;
    case 58: asm("s_nop 1\n\tv_writelane_b32 %0, %1, 58" : "+v"(dst) : "s"(val)); break;
    case 59: asm("s_nop 1\n\tv_writelane_b32 %0, %1, 59" : "+v"(dst) : "s"(val)); break;
    case 60: asm("s_nop 1\n\tv_writelane_b32 %0, %1, 60" : "+v"(dst) : "s"(val)); break;
    case 61: asm("s_nop 1\n\tv_writelane_b32 %0, %1, 61" : "+v"(dst) : "s"(val)); break;
    case 62: asm("s_nop 1\n\tv_writelane_b32 %0, %1, 62" : "+v"(dst) : "s"(val)); break;
    case 63: asm("s_nop 1\n\tv_writelane_b32 %0, %1, 63" : "+v"(dst) : "s"(val)); break;
    default: break;
    }
}
__device__ __forceinline__ void ballot4(unsigned& mlo, unsigned& mhi, const float thr, const float x0, const float x1, const float x2, const float x3, const int base) {
    switch (base) {
    case 0: asm("v_cmp_le_f32_e64 s[90:91], %2, %3\n\tv_cmp_le_f32_e64 s[92:93], %2, %4\n\tv_cmp_le_f32_e64 s[94:95], %2, %5\n\tv_cmp_le_f32_e64 s[96:97], %2, %6\n\t"
                 "v_writelane_b32 %0, s90, 0\n\tv_writelane_b32 %1, s91, 0\n\tv_writelane_b32 %0, s92, 1\n\tv_writelane_b32 %1, s93, 1\n\tv_writelane_b32 %0, s94, 2\n\tv_writelane_b32 %1, s95, 2\n\tv_writelane_b32 %0, s96, 3\n\tv_writelane_b32 %1, s97, 3"
                 : "+v"(mlo), "+v"(mhi) : "v"(thr), "v"(x0), "v"(x1), "v"(x2), "v"(x3) : "s90", "s91", "s92", "s93", "s94", "s95", "s96", "s97"); break;
    case 4: asm("v_cmp_le_f32_e64 s[90:91], %2, %3\n\tv_cmp_le_f32_e64 s[92:93], %2, %4\n\tv_cmp_le_f32_e64 s[94:95], %2, %5\n\tv_cmp_le_f32_e64 s[96:97], %2, %6\n\t"
                 "v_writelane_b32 %0, s90, 4\n\tv_writelane_b32 %1, s91, 4\n\tv_writelane_b32 %0, s92, 5\n\tv_writelane_b32 %1, s93, 5\n\tv_writelane_b32 %0, s94, 6\n\tv_writelane_b32 %1, s95, 6\n\tv_writelane_b32 %0, s96, 7\n\tv_writelane_b32 %1, s97, 7"
                 : "+v"(mlo), "+v"(mhi) : "v"(thr), "v"(x0), "v"(x1), "v"(x2), "v"(x3) : "s90", "s91", "s92", "s93", "s94", "s95", "s96", "s97"); break;
    case 8: asm("v_cmp_le_f32_e64 s[90:91], %2, %3\n\tv_cmp_le_f32_e64 s[92:93], %2, %4\n\tv_cmp_le_f32_e64 s[94:95], %2, %5\n\tv_cmp_le_f32_e64 s[96:97], %2, %6\n\t"
                 "v_writelane_b32 %0, s90, 8\n\tv_writelane_b32 %1, s91, 8\n\tv_writelane_b32 %0, s92, 9\n\tv_writelane_b32 %1, s93, 9\n\tv_writelane_b32 %0, s94, 10\n\tv_writelane_b32 %1, s95, 10\n\tv_writelane_b32 %0, s96, 11\n\tv_writelane_b32 %1, s97, 11"
                 : "+v"(mlo), "+v"(mhi) : "v"(thr), "v"(x0), "v"(x1), "v"(x2), "v"(x3) : "s90", "s91", "s92", "s93", "s94", "s95", "s96", "s97"); break;
    case 12: asm("v_cmp_le_f32_e64 s[90:91], %2, %3\n\tv_cmp_le_f32_e64 s[92:93], %2, %4\n\tv_cmp_le_f32_e64 s[94:95], %2, %5\n\tv_cmp_le_f32_e64 s[96:97], %2, %6\n\t"
                 "v_writelane_b32 %0, s90, 12\n\tv_writelane_b32 %1, s91, 12\n\tv_writelane_b32 %0, s92, 13\n\tv_writelane_b32 %1, s93, 13\n\tv_writelane_b32 %0, s94, 14\n\tv_writelane_b32 %1, s95, 14\n\tv_writelane_b32 %0, s96, 15\n\tv_writelane_b32 %1, s97, 15"
                 : "+v"(mlo), "+v"(mhi) : "v"(thr), "v"(x0), "v"(x1), "v"(x2), "v"(x3) : "s90", "s91", "s92", "s93", "s94", "s95", "s96", "s97"); break;
    case 16: asm("v_cmp_le_f32_e64 s[90:91], %2, %3\n\tv_cmp_le_f32_e64 s[92:93], %2, %4\n\tv_cmp_le_f32_e64 s[94:95], %2, %5\n\tv_cmp_le_f32_e64 s[96:97], %2, %6\n\t"
                 "v_writelane_b32 %0, s90, 16\n\tv_writelane_b32 %1, s91, 16\n\tv_writelane_b32 %0, s92, 17\n\tv_writelane_b32 %1, s93, 17\n\tv_writelane_b32 %0, s94, 18\n\tv_writelane_b32 %1, s95, 18\n\tv_writelane_b32 %0, s96, 19\n\tv_writelane_b32 %1, s97, 19"
                 : "+v"(mlo), "+v"(mhi) : "v"(thr), "v"(x0), "v"(x1), "v"(x2), "v"(x3) : "s90", "s91", "s92", "s93", "s94", "s95", "s96", "s97"); break;
    case 20: asm("v_cmp_le_f32_e64 s[90:91], %2, %3\n\tv_cmp_le_f32_e64 s[92:93], %2, %4\n\tv_cmp_le_f32_e64 s[94:95], %2, %5\n\tv_cmp_le_f32_e64 s[96:97], %2, %6\n\t"
                 "v_writelane_b32 %0, s90, 20\n\tv_writelane_b32 %1, s91, 20\n\tv_writelane_b32 %0, s92, 21\n\tv_writelane_b32 %1, s93, 21\n\tv_writelane_b32 %0, s94, 22\n\tv_writelane_b32 %1, s95, 22\n\tv_writelane_b32 %0, s96, 23\n\tv_writelane_b32 %1, s97, 23"
                 : "+v"(mlo), "+v"(mhi) : "v"(thr), "v"(x0), "v"(x1), "v"(x2), "v"(x3) : "s90", "s91", "s92", "s93", "s94", "s95", "s96", "s97"); break;
    case 24: asm("v_cmp_le_f32_e64 s[90:91], %2, %3\n\tv_cmp_le_f32_e64 s[92:93], %2, %4\n\tv_cmp_le_f32_e64 s[94:95], %2, %5\n\tv_cmp_le_f32_e64 s[96:97], %2, %6\n\t"
                 "v_writelane_b32 %0, s90, 24\n\tv_writelane_b32 %1, s91, 24\n\tv_writelane_b32 %0, s92, 25\n\tv_writelane_b32 %1, s93, 25\n\tv_writelane_b32 %0, s94, 26\n\tv_writelane_b32 %1, s95, 26\n\tv_writelane_b32 %0, s96, 27\n\tv_writelane_b32 %1, s97, 27"
                 : "+v"(mlo), "+v"(mhi) : "v"(thr), "v"(x0), "v"(x1), "v"(x2), "v"(x3) : "s90", "s91", "s92", "s93", "s94", "s95", "s96", "s97"); break;
    case 28: asm("v_cmp_le_f32_e64 s[90:91], %2, %3\n\tv_cmp_le_f32_e64 s[92:93], %2, %4\n\tv_cmp_le_f32_e64 s[94:95], %2, %5\n\tv_cmp_le_f32_e64 s[96:97], %2, %6\n\t"
                 "v_writelane_b32 %0, s90, 28\n\tv_writelane_b32 %1, s91, 28\n\tv_writelane_b32 %0, s92, 29\n\tv_writelane_b32 %1, s93, 29\n\tv_writelane_b32 %0, s94, 30\n\tv_writelane_b32 %1, s95, 30\n\tv_writelane_b32 %0, s96, 31\n\tv_writelane_b32 %1, s97, 31"
                 : "+v"(mlo), "+v"(mhi) : "v"(thr), "v"(x0), "v"(x1), "v"(x2), "v"(x3) : "s90", "s91", "s92", "s93", "s94", "s95", "s96", "s97"); break;
    case 32: asm("v_cmp_le_f32_e64 s[90:91], %2, %3\n\tv_cmp_le_f32_e64 s[92:93], %2, %4\n\tv_cmp_le_f32_e64 s[94:95], %2, %5\n\tv_cmp_le_f32_e64 s[96:97], %2, %6\n\t"
                 "v_writelane_b32 %0, s90, 32\n\tv_writelane_b32 %1, s91, 32\n\tv_writelane_b32 %0, s92, 33\n\tv_writelane_b32 %1, s93, 33\n\tv_writelane_b32 %0, s94, 34\n\tv_writelane_b32 %1, s95, 34\n\tv_writelane_b32 %0, s96, 35\n\tv_writelane_b32 %1, s97, 35"
                 : "+v"(mlo), "+v"(mhi) : "v"(thr), "v"(x0), "v"(x1), "v"(x2), "v"(x3) : "s90", "s91", "s92", "s93", "s94", "s95", "s96", "s97"); break;
    case 36: asm("v_cmp_le_f32_e64 s[90:91], %2, %3\n\tv_cmp_le_f32_e64 s[92:93], %2, %4\n\tv_cmp_le_f32_e64 s[94:95], %2, %5\n\tv_cmp_le_f32_e64 s[96:97], %2, %6\n\t"
                 "v_writelane_b32 %0, s90, 36\n\tv_writelane_b32 %1, s91, 36\n\tv_writelane_b32 %0, s92, 37\n\tv_writelane_b32 %1, s93, 37\n\tv_writelane_b32 %0, s94, 38\n\tv_writelane_b32 %1, s95, 38\n\tv_writelane_b32 %0, s96, 39\n\tv_writelane_b32 %1, s97, 39"
                 : "+v"(mlo), "+v"(mhi) : "v"(thr), "v"(x0), "v"(x1), "v"(x2), "v"(x3) : "s90", "s91", "s92", "s93", "s94", "s95", "s96", "s97"); break;
    case 40: asm("v_cmp_le_f32_e64 s[90:91], %2, %3\n\tv_cmp_le_f32_e64 s[92:93], %2, %4\n\tv_cmp_le_f32_e64 s[94:95], %2, %5\n\tv_cmp_le_f32_e64 s[96:97], %2, %6\n\t"
                 "v_writelane_b32 %0, s90, 40\n\tv_writelane_b32 %1, s91, 40\n\tv_writelane_b32 %0, s92, 41\n\tv_writelane_b32 %1, s93, 41\n\tv_writelane_b32 %0, s94, 42\n\tv_writelane_b32 %1, s95, 42\n\tv_writelane_b32 %0, s96, 43\n\tv_writelane_b32 %1, s97, 43"
                 : "+v"(mlo), "+v"(mhi) : "v"(thr), "v"(x0), "v"(x1), "v"(x2), "v"(x3) : "s90", "s91", "s92", "s93", "s94", "s95", "s96", "s97"); break;
    case 44: asm("v_cmp_le_f32_e64 s[90:91], %2, %3\n\tv_cmp_le_f32_e64 s[92:93], %2, %4\n\tv_cmp_le_f32_e64 s[94:95], %2, %5\n\tv_cmp_le_f32_e64 s[96:97], %2, %6\n\t"
                 "v_writelane_b32 %0, s90, 44\n\tv_writelane_b32 %1, s91, 44\n\tv_writelane_b32 %0, s92, 45\n\tv_writelane_b32 %1, s93, 45\n\tv_writelane_b32 %0, s94, 46\n\tv_writelane_b32 %1, s95, 46\n\tv_writelane_b32 %0, s96, 47\n\tv_writelane_b32 %1, s97, 47"
                 : "+v"(mlo), "+v"(mhi) : "v"(thr), "v"(x0), "v"(x1), "v"(x2), "v"(x3) : "s90", "s91", "s92", "s93", "s94", "s95", "s96", "s97"); break;
    case 48: asm("v_cmp_le_f32_e64 s[90:91], %2, %3\n\tv_cmp_le_f32_e64 s[92:93], %2, %4\n\tv_cmp_le_f32_e64 s[94:95], %2, %5\n\tv_cmp_le_f32_e64 s[96:97], %2, %6\n\t"
                 "v_writelane_b32 %0, s90, 48\n\tv_writelane_b32 %1, s91, 48\n\tv_writelane_b32 %0, s92, 49\n\tv_writelane_b32 %1, s93, 49\n\tv_writelane_b32 %0, s94, 50\n\tv_writelane_b32 %1, s95, 50\n\tv_writelane_b32 %0, s96, 51\n\tv_writelane_b32 %1, s97, 51"
                 : "+v"(mlo), "+v"(mhi) : "v"(thr), "v"(x0), "v"(x1), "v"(x2), "v"(x3) : "s90", "s91", "s92", "s93", "s94", "s95", "s96", "s97"); break;
    case 52: asm("v_cmp_le_f32_e64 s[90:91], %2, %3\n\tv_cmp_le_f32_e64 s[92:93], %2, %4\n\tv_cmp_le_f32_e64 s[94:95], %2, %5\n\tv_cmp_le_f32_e64 s[96:97], %2, %6\n\t"
                 "v_writelane_b32 %0, s90, 52\n\tv_writelane_b32 %1, s91, 52\n\tv_writelane_b32 %0, s92, 53\n\tv_writelane_b32 %1, s93, 53\n\tv_writelane_b32 %0, s94, 54\n\tv_writelane_b32 %1, s95, 54\n\tv_writelane_b32 %0, s96, 55\n\tv_writelane_b32 %1, s97, 55"
                 : "+v"(mlo), "+v"(mhi) : "v"(thr), "v"(x0), "v"(x1), "v"(x2), "v"(x3) : "s90", "s91", "s92", "s93", "s94", "s95", "s96", "s97"); break;
    case 56: asm("v_cmp_le_f32_e64 s[90:91], %2, %3\n\tv_cmp_le_f32_e64 s[92:93], %2, %4\n\tv_cmp_le_f32_e64 s[94:95], %2, %5\n\tv_cmp_le_f32_e64 s[96:97], %2, %6\n\t"
                 "v_writelane_b32 %0, s90, 56\n\tv_writelane_b32 %1, s91, 56\n\tv_writelane_b32 %0, s92, 57\n\tv_writelane_b32 %1, s93, 57\n\tv_writelane_b32 %0, s94, 58\n\tv_writelane_b32 %1, s95, 58\n\tv_writelane_b32 %0, s96, 59\n\tv_writelane_b32 %1, s97, 59"
                 : "+v"(mlo), "+v"(mhi) : "v"(thr), "v"(x0), "v"(x1), "v"(x2), "v"(x3) : "s90", "s91", "s92", "s93", "s94", "s95", "s96", "s97"); break;
    case 60: asm("v_cmp_le_f32_e64 s[90:91], %2, %3\n\tv_cmp_le_f32_e64 s[92:93], %2, %4\n\tv_cmp_le_f32_e64 s[94:95], %2, %5\n\tv_cmp_le_f32_e64 s[96:97], %2, %6\n\t"
                 "v_writelane_b32 %0, s90, 60\n\tv_writelane_b32 %1, s91, 60\n\tv_writelane_b32 %0, s92, 61\n\tv_writelane_b32 %1, s93, 61\n\tv_writelane_b32 %0, s94, 62\n\tv_writelane_b32 %1, s95, 62\n\tv_writelane_b32 %0, s96, 63\n\tv_writelane_b32 %1, s97, 63"
                 : "+v"(mlo), "+v"(mhi) : "v"(thr), "v"(x0), "v"(x1), "v"(x2), "v"(x3) : "s90", "s91", "s92", "s93", "s94", "s95", "s96", "s97"); break;
    default: break;
    }
}
template <int NREG>
__device__ __forceinline__ void dsa_select(const float* const scw, LAS unsigned* const MASK, LAS const float* const ZT, const int wv, const int lane, const int t0, const int nk) {
    const float NINF = -__builtin_inff(), PINF = __builtin_inff();
    const unsigned long long lt_mask = (1ull << lane) - 1ull;
    const int qb_ = t0 >> 6;
    float xn[NREG];
#pragma unroll
    for (int i = 0; i < NREG; ++i) xn[i] = __hip_atomic_load(scw + i * 64 + lane, __ATOMIC_RELAXED, __HIP_MEMORY_SCOPE_AGENT);
#pragma unroll 1
    for (int ql_ = 0; ql_ < 8; ++ql_) {
        const int ql = ql_ & 7;
        const int tq = t0 + 8 * wv + ql;
        LAS unsigned* const mrow = MASK + (8 * wv + ql) * 64;
        float x[NREG];
#pragma unroll
        for (int i = 0; i < NREG; ++i) x[i] = (i <= qb_) ? xn[i] : NINF;
        if (ql_ + 1 < 8) {
#pragma unroll
            for (int i = 0; i < NREG; ++i) xn[i] = __hip_atomic_load(scw + ((ql_ + 1) & 7) * 2048 + i * 64 + lane, __ATOMIC_RELAXED, __HIP_MEMORY_SCOPE_AGENT);
        }
        unsigned mlo = 0u, mhi = 0u;
        if (tq + 1 > 256) {
#define CNT_GE(p_, dst_) do { int _c0 = 0, _c1 = 0; const float _p = (p_); \
                _Pragma("unroll") for (int _i = 0; _i < NREG; _i += 8) \
                    asm volatile("v_cmp_le_f32_e64 s[90:91], %10, %2\n\tv_cmp_le_f32_e64 s[92:93], %10, %3\n\tv_cmp_le_f32_e64 s[94:95], %10, %4\n\tv_cmp_le_f32_e64 s[96:97], %10, %5\n\t" \
                                 "v_cmp_le_f32_e64 s[82:83], %10, %6\n\ts_bcnt1_i32_b64 s90, s[90:91]\n\ts_add_u32 %0, %0, s90\n\t" \
                                 "v_cmp_le_f32_e64 s[84:85], %10, %7\n\ts_bcnt1_i32_b64 s92, s[92:93]\n\ts_add_u32 %1, %1, s92\n\t" \
                                 "v_cmp_le_f32_e64 s[86:87], %10, %8\n\ts_bcnt1_i32_b64 s94, s[94:95]\n\ts_add_u32 %0, %0, s94\n\t" \
                                 "v_cmp_le_f32_e64 s[88:89], %10, %9\n\ts_bcnt1_i32_b64 s96, s[96:97]\n\ts_add_u32 %1, %1, s96\n\t" \
                                 "s_bcnt1_i32_b64 s82, s[82:83]\n\ts_bcnt1_i32_b64 s84, s[84:85]\n\ts_add_u32 %0, %0, s82\n\ts_bcnt1_i32_b64 s86, s[86:87]\n\ts_add_u32 %1, %1, s84\n\t" \
                                 "s_bcnt1_i32_b64 s88, s[88:89]\n\ts_add_u32 %0, %0, s86\n\ts_add_u32 %1, %1, s88" \
                                 : "+s"(_c0), "+s"(_c1) : "v"(x[_i]), "v"(x[_i + 1]), "v"(x[_i + 2]), "v"(x[_i + 3]), "v"(x[_i + 4]), "v"(x[_i + 5]), "v"(x[_i + 6]), "v"(x[_i + 7]), "s"(_p) \
                                 : "s82", "s83", "s84", "s85", "s86", "s87", "s88", "s89", "s90", "s91", "s92", "s93", "s94", "s95", "s96", "s97", "scc"); \
                dst_ = _c0 + _c1; } while (0)
            float s1 = 0.f, s2 = 0.f;
            constexpr int SS = NREG / 8;
#pragma unroll
            for (int i = 0; i < NREG; i += SS) if (i < qb_) { s1 += x[i]; s2 = fmaf(x[i], x[i], s2); }
            s1 = wave_sum_f(s1); s2 = wave_sum_f(s2);
            const float rm = rcpf_(64.0f * (float)((min(qb_, NREG) + SS - 1) / SS));
            const float mean = s1 * rm, sigma = __builtin_sqrtf(fmaxf(s2 * rm - mean * mean, 0.f));
            const float zq = ZT[2 * (8 * wv + ql)], stepc = sigma * ZT[2 * (8 * wv + ql) + 1];
            float lo = -3.0e38f, hi = PINF, thr = 0.f, vmax = 0.f; int clo = tq + 1, chi = 0; bool tie = false, lo_real = false, have_mm = false;
            float pv = mean + zq * sigma;
#pragma unroll 1
            for (int it = 1;; ++it) {
                if (!(pv > lo && pv < hi)) {
                    if (!have_mm) {
                        float vmin = PINF; vmax = NINF;
#pragma unroll
                        for (int i = 0; i < NREG; ++i) { vmax = fmaxf(vmax, x[i]); vmin = fminf(vmin, x[i] == NINF ? PINF : x[i]); }
                        vmin = -wave_max(-vmin); vmax = wave_max(vmax); have_mm = true;
                        if (!lo_real) lo = vmin;
                    }
                    pv = (hi == PINF) ? vmax : 0.5f * (lo + hi);
                    if (!(pv > lo && pv < hi)) { tie = true; break; }
                }
                int c; CNT_GE(pv, c);
                if (c == 256) { thr = pv; break; }
                if (c > 256) { lo = pv; clo = c; lo_real = true; } else { hi = pv; chi = c; }
                if (it >= 8) pv = __builtin_nanf("");
                else if (lo_real && hi != PINF) pv = lo + (hi - lo) * ((float)(clo - 256) * rcpf_((float)(clo - chi)));
                else pv = pv + (float)(c - 256) * stepc;
            }
#undef CNT_GE
            if (!tie) {
#pragma unroll
                for (int i = 0; i < NREG; i += 4) ballot4(mlo, mhi, thr, x[i], x[i + 1], x[i + 2], x[i + 3], i);
            } else {
                const int need = 256 - chi; int before = 0;
#pragma unroll
                for (int i = 0; i < NREG; ++i) { const bool eq = (x[i] == lo); const unsigned long long be = __ballot(eq);
                    const int rank = before + __popcll(be & lt_mask); const bool sel = (x[i] >= hi) || (eq && rank < need); before += __popcll(be);
                    const unsigned long long bs = __ballot(sel);
                    wrlane(mlo, (unsigned)bs, i); wrlane(mhi, (unsigned)(bs >> 32), i); }
            }
        } else {
#pragma unroll
            for (int i = 0; i < NREG; ++i) { const unsigned long long bs = __ballot(i * 64 + lane <= tq);
                wrlane(mlo, (unsigned)bs, i); wrlane(mhi, (unsigned)(bs >> 32), i); }
        }
        if (lane < NREG) { v2u w; w.x = mlo; w.y = mhi; *(LAS v2u*)(mrow + 2 * lane) = w; }
    }
}

__device__ __forceinline__ float half_pick(const float a, const float b, const bool hi_half) { return hi_half ? b : a; }
__device__ __forceinline__ float half_sum_f(float v, const bool hi_half) {
#define HS_(ctl, rm, bm) v += __builtin_bit_cast(float, __builtin_amdgcn_update_dpp(0, __builtin_bit_cast(int, v), ctl, rm, bm, false))
    HS_(0x111, 0xf, 0xf); HS_(0x112, 0xf, 0xf); HS_(0x114, 0xf, 0xe); HS_(0x118, 0xf, 0xc); HS_(0x142, 0xa, 0xf);
#undef HS_
    const float a = __builtin_bit_cast(float, __builtin_amdgcn_readlane(__builtin_bit_cast(int, v), 31)), b = __builtin_bit_cast(float, __builtin_amdgcn_readlane(__builtin_bit_cast(int, v), 63));
    return hi_half ? b : a;
}
__device__ __forceinline__ int half_sum_i(int v, const bool hi_half) {
#define HS_(ctl, rm, bm) v += __builtin_amdgcn_update_dpp(0, v, ctl, rm, bm, false)
    HS_(0x111, 0xf, 0xf); HS_(0x112, 0xf, 0xf); HS_(0x114, 0xf, 0xe); HS_(0x118, 0xf, 0xc); HS_(0x142, 0xa, 0xf);
#undef HS_
    const int a = __builtin_amdgcn_readlane(v, 31), b = __builtin_amdgcn_readlane(v, 63);
    return hi_half ? b : a;
}
__device__ __forceinline__ float half_max_f(float v, const bool hi_half) {
    const int ninf = (int)0xff800000u;
#define HM_(ctrl, rm, bm) v = fmaxf(v, __builtin_bit_cast(float, __builtin_amdgcn_update_dpp(ninf, __builtin_bit_cast(int, v), ctrl, rm, bm, false)))
    HM_(0x111, 0xf, 0xf); HM_(0x112, 0xf, 0xf); HM_(0x114, 0xf, 0xe); HM_(0x118, 0xf, 0xc); HM_(0x142, 0xa, 0xf);
#undef HM_
    const float a = __builtin_bit_cast(float, __builtin_amdgcn_readlane(__builtin_bit_cast(int, v), 31)), b = __builtin_bit_cast(float, __builtin_amdgcn_readlane(__builtin_bit_cast(int, v), 63));
    return hi_half ? b : a;
}
constexpr int MASKP = 66;
template <int NR>
__device__ __forceinline__ void dsa_select2(const float* const scw, LAS unsigned* const MASK, LAS const float* const ZT, const int wv, const int lane, const int t0) {
    const float NINF = -__builtin_inff(), PINF = __builtin_inff();
    const bool hb = lane >= 32; const int l31 = lane & 31, hsel = lane >> 5;
    const int nslot = 2 * ((t0 >> 6) + 1);
    constexpr bool PF = NR <= 32;
    float xn[PF ? NR : 1];
    if (PF) {
#pragma unroll
        for (int i = 0; i < NR; ++i) xn[PF ? i : 0] = __hip_atomic_load(scw + hsel * 2048 + i * 32 + l31, __ATOMIC_RELAXED, __HIP_MEMORY_SCOPE_AGENT);
    }
#pragma unroll 1
    for (int qp = 0; qp < 4; ++qp) {
        const int ql = 2 * qp + hsel;
        const int tq = t0 + 8 * wv + ql, n = tq + 1;
        float x[NR];
        if (PF) {
#pragma unroll
            for (int i = 0; i < NR; ++i) x[i] = (i < nslot) ? xn[PF ? i : 0] : NINF;
            if (qp + 1 < 4) {
#pragma unroll
                for (int i = 0; i < NR; ++i) xn[PF ? i : 0] = __hip_atomic_load(scw + (2 * (qp + 1) + hsel) * 2048 + i * 32 + l31, __ATOMIC_RELAXED, __HIP_MEMORY_SCOPE_AGENT);
            }
        } else {
#pragma unroll
            for (int i = 0; i < NR; ++i) { const float v_ = __hip_atomic_load(scw + ql * 2048 + i * 32 + l31, __ATOMIC_RELAXED, __HIP_MEMORY_SCOPE_AGENT); x[i] = (i < nslot) ? v_ : NINF; }
        }
#define CNT2(p_, dst_) do { int _c0 = 0, _c1 = 0, _c2 = 0, _c3 = 0; const float _p = (p_); \
            _Pragma("unroll") for (int _i = 0; _i < NR; _i += 4) \
                asm volatile("v_cmp_le_f32_e64 s[90:91], %8, %4\n\tv_cmp_le_f32_e64 s[92:93], %8, %5\n\tv_cmp_le_f32_e64 s[94:95], %8, %6\n\tv_cmp_le_f32_e64 s[96:97], %8, %7\n\t" \
                             "v_addc_co_u32_e64 %0, s[90:91], 0, %0, s[90:91]\n\tv_addc_co_u32_e64 %1, s[92:93], 0, %1, s[92:93]\n\tv_addc_co_u32_e64 %2, s[94:95], 0, %2, s[94:95]\n\tv_addc_co_u32_e64 %3, s[96:97], 0, %3, s[96:97]" \
                             : "+v"(_c0), "+v"(_c1), "+v"(_c2), "+v"(_c3) : "v"(x[_i]), "v"(x[_i + 1]), "v"(x[_i + 2]), "v"(x[_i + 3]), "v"(_p) : "s90", "s91", "s92", "s93", "s94", "s95", "s96", "s97"); \
            dst_ = half_sum_i((_c0 + _c1) + (_c2 + _c3), hb); } while (0)
        float s1 = 0.f, s2 = 0.f;
        constexpr int SS = NR / 8;
        const int nfull = 2 * (t0 >> 6);
#pragma unroll
        for (int i = 0; i < NR; i += SS) if (i < nfull) { s1 += x[i]; s2 = fmaf(x[i], x[i], s2); }
        s1 = half_sum_f(s1, hb); s2 = half_sum_f(s2, hb);
        const float rm = rcpf_(32.0f * (float)((min(nfull, NR) + SS - 1) / SS));
        const float mean = s1 * rm, sigma = __builtin_sqrtf(fmaxf(s2 * rm - mean * mean, 0.f));
        const float zq = ZT[2 * (8 * wv + ql)], stepc = sigma * ZT[2 * (8 * wv + ql) + 1];
        float lo = -3.0e38f, hi = PINF, thr = -3.0e38f, pv = mean + zq * sigma, vmax = 0.f;
        int clo = n, chi = 0;
        bool done = n <= 256, tie = false, lo_real = false, have_mm = false;
#pragma unroll 1
        for (int it = 1;; ++it) {
            const bool bad = !done && !(pv > lo && pv < hi);
            if (__any(bad)) {
                if (!have_mm) {
                    float vmin = PINF; vmax = NINF;
#pragma unroll
                    for (int i = 0; i < NR; ++i) { vmax = fmaxf(vmax, x[i]); vmin = fminf(vmin, x[i] == NINF ? PINF : x[i]); }
                    vmin = -half_max_f(-vmin, hb); vmax = half_max_f(vmax, hb); have_mm = true;
                    if (!lo_real) lo = fmaxf(lo, vmin);
                }
                const float pf_ = (hi == PINF) ? vmax : 0.5f * (lo + hi);
                const bool ok = pf_ > lo && pf_ < hi;
                if (bad) { if (ok) pv = pf_; else { tie = true; done = true; } }
            }
            if (!__any(!done)) break;
            int c; CNT2(pv, c);
            if (!done) {
                if (c == 256) { thr = pv; done = true; }
                else if (c > 256) { lo = pv; clo = c; lo_real = true; }
                else { hi = pv; chi = c; }
                if (it >= 8) pv = __builtin_nanf("");
                else if (lo_real && hi != PINF) pv = lo + (hi - lo) * ((float)(clo - 256) * rcpf_((float)(clo - chi)));
                else pv = pv + (float)(c - 256) * stepc;
            }
            if (!__any(!done)) break;
        }
#undef CNT2
        if (!__any(tie)) {
            unsigned mA = 0u, mB = 0u;
#pragma unroll
            for (int i = 0; i < NR; i += 4) ballot4(mA, mB, thr, x[i], x[i + 1], x[i + 2], x[i + 3], i);
            if (lane < NR) { MASK[(8 * wv + 2 * qp) * MASKP + lane] = mA; MASK[(8 * wv + 2 * qp + 1) * MASKP + lane] = mB; }
        } else {
            const int need = 256 - chi; int before = 0; const unsigned ltm = (1u << l31) - 1u;
#pragma unroll 1
            for (int i = 0; i < nslot; ++i) { const float xv = __hip_atomic_load(scw + ql * 2048 + i * 32 + l31, __ATOMIC_RELAXED, __HIP_MEMORY_SCOPE_AGENT);
                const bool eq = tie && (xv == lo); const unsigned long long be = __ballot(eq);
                const unsigned mybe = hb ? (unsigned)(be >> 32) : (unsigned)be;
                const int rank = before + __popc(mybe & ltm); before += __popc(mybe);
                const bool sel = tie ? ((xv >= hi) || (eq && rank < need)) : (xv >= thr);
                const unsigned long long bs = __ballot(sel);
                if (l31 == 0) MASK[(8 * wv + ql) * MASKP + i] = hb ? (unsigned)(bs >> 32) : (unsigned)bs; }
        }
    }
}

__device__ __forceinline__ void dsa_unit(Frame& F, const Args& args, const int b, const int qb, const float mb2) {
    LAS unsigned char* const L = F.lds;
    const int tid = F.tid, lane = F.lane, wv = F.wave, l31_0 = lane & 31, hh_0 = lane >> 5;
    int l31 = l31_0, hh = hh_0;
    constexpr int PK = 272, PV = 144;
    constexpr int O_K0 = 0, O_V0 = 17408, BUFSZ = 35840, O_MASK = 2 * BUFSZ, O_RS = O_MASK + 64 * MASKP * 4, O_BT = O_RS + 8192, O_ZT = O_BT + 2048, O_END = O_ZT + 512, O_OA = 0;
    static_assert(O_END <= SCRATCH_BYTES && 4 * 17408 <= 2 * BUFSZ, "dsa LDS map");
    const int t0 = 64 * qb, nk = 64 * (qb + 1);
    const size_t rb = (size_t)b * SEQ;
    LAS unsigned* const MASK = (LAS unsigned*)(L + O_MASK);
    LAS float* const RS = (LAS float*)(L + O_RS);
    LAS float* const BT = (LAS float*)(L + O_RS);
    LAS float* const ZT = (LAS float*)(L + O_ZT);
    const float NINF = -__builtin_inff();
    float* const scw = W_SCR + (size_t)(blockIdx.x * NWAVES + wv) * 8 * 2048;
    {
        const int be0_ = tid, be1_ = tid + 512;
        const int bd0_ = (be0_ >> 2) - 64, bd1_ = (be1_ >> 2) - 64;
        const float btv = W_BT[(bd0_ < 0 ? 0 : bd0_ > 127 ? 127 : bd0_) * 4 + (be0_ & 3)], btv1 = W_BT[(bd1_ < 0 ? 0 : bd1_ > 127 ? 127 : bd1_) * 4 + (be1_ & 3)];
        v4u aqr[8]; f32x4 wts[2][2][2];
#pragma unroll
        for (int r = 0; r < 8; ++r) aqr[r] = *(const GAS v4u*)(W_PROJ + (rb + t0 + 8 * wv + r) * NPROJ + C_IQ + lane * 8);
#pragma unroll
        for (int rt = 0; rt < 2; ++rt)
#pragma unroll
            for (int a = 0; a < 2; ++a)
#pragma unroll
                for (int gb = 0; gb < 2; ++gb) wts[rt][a][gb] = *(const f32x4*)(W_AUX + (rb + t0 + 8 * wv + 4 * rt + 2 * hh + a) * 16 + 8 + 4 * gb) * 0.5f;
        LAS unsigned char* const AQL = L + (wv < 4 ? 18432 + wv * 9216 : O_END + (wv - 4) * 9216);
        constexpr int O_IK = 0, IKB = 9216, PIK = 144;
        v4u sti;
#define IK_GLOAD(kt_) sti = *(const GAS v4u*)(W_PROJ + (rb + 64 * (kt_) + (tid >> 3)) * NPROJ + C_IK + (tid & 7) * 8)
#define IK_SWRITE(buf_) *(LAS v4u*)(L + O_IK + (buf_) * IKB + (tid >> 3) * PIK + (tid & 7) * 16) = sti
        IK_GLOAD(0);
        __builtin_amdgcn_sched_barrier(0);
        BT[be0_] = btv; if (be1_ < 216 * 4) BT[be1_] = btv1;
        if (tid < 64) {
            const float n_ = (float)(t0 + tid + 1); float f_ = 256.0f * rcpf_(n_); const bool up_ = f_ > 0.5f; if (up_) f_ = 1.0f - f_;
            f_ = fmaxf(f_, 1e-6f);
            const float t_ = __builtin_sqrtf(-1.3862944f * __builtin_log2f(f_));
            float z_ = t_ - (2.515517f + t_ * (0.802853f + t_ * 0.010328f)) * rcpf_(1.0f + t_ * (1.432788f + t_ * (0.189269f + t_ * 0.001308f)));
            if (up_) z_ = -z_;
            ZT[2 * tid] = z_; ZT[2 * tid + 1] = rcpf_(n_ * 0.3989423f * __builtin_exp2f(-0.72134752f * z_ * z_));
        }
        IK_SWRITE(0);
#pragma unroll
        for (int r = 0; r < 8; ++r) *(LAS v4u*)(AQL + r * 1152 + (lane >> 3) * 144 + (lane & 7) * 16) = aqr[r];
        LDS_WAIT();
        bf16x8 aq[2][4];
#pragma unroll
        for (int rt = 0; rt < 2; ++rt)
#pragma unroll
            for (int s = 0; s < 4; ++s) aq[rt][s] = lds16(AQL + (4 * rt + 2 * ((l31 >> 2) & 1) + (l31 >> 4)) * 1152 + (4 * ((l31 >> 3) & 1) + (l31 & 3)) * 144 + (16 * s + 8 * hh) * 2);
        __syncthreads();
#pragma unroll 1
        for (int kt6 = 0; kt6 <= qb; ++kt6) {
          const int ibuf = kt6 & 1;
          if (kt6 < qb) IK_GLOAD(kt6 + 1);
#pragma unroll
          for (int st = 0; st < 2; ++st) {
            bf16x8 bk[4];
#pragma unroll
            for (int s = 0; s < 4; ++s) bk[s] = lds16(L + O_IK + ibuf * IKB + (32 * st + l31) * PIK + (16 * s + 8 * hh) * 2);
            const int kt = 2 * kt6 + st;
            const int key = 32 * kt + l31;
            f32x16 C0, C1;
#pragma unroll
            for (int r = 0; r < 16; ++r) { C0[r] = 0.f; C1[r] = 0.f; }
#pragma unroll
            for (int s = 0; s < 4; ++s) C0 = MFMA32(aq[0][s], bk[s], C0);
#pragma unroll
            for (int s = 0; s < 4; ++s) C1 = MFMA32(aq[1][s], bk[s], C1);
#pragma unroll
            for (int rt = 0; rt < 2; ++rt)
#pragma unroll
                for (int a = 0; a < 2; ++a) { float p = 0.f;
#pragma unroll
                    for (int gb = 0; gb < 2; ++gb)
#pragma unroll
                        for (int e2 = 0; e2 < 4; ++e2) { const float w = wts[rt][a][gb][e2], x = rt == 0 ? C0[4 * (2 * a + gb) + e2] : C1[4 * (2 * a + gb) + e2];
                            p = __builtin_fmaf(w, x, p); p = __builtin_fmaf(w, __builtin_fabsf(x), p); }
                    const int ql = 4 * rt + a + 2 * hh;
                    if (key > t0 + 8 * wv + ql) p = NINF;
                    scw[ql * 2048 + key] = p; }
          }
          if (kt6 < qb) IK_SWRITE(ibuf ^ 1);
          __syncthreads();
        }
#undef IK_GLOAD
#undef IK_SWRITE
    }
    __builtin_amdgcn_fence(__ATOMIC_SEQ_CST, "workgroup");
    asm volatile("s_waitcnt vmcnt(0)" ::: "memory");
    int lanev = lane; asm volatile("" : "+v"(lanev));
#pragma unroll 1
    for (int rep_b = 0; rep_b < (PROBE_DUP == 42 ? 2 : 1); ++rep_b)
    if (qb < 8) dsa_select2<16>(scw, MASK, ZT, wv, lanev, t0);
    else if (qb < 16) dsa_select2<32>(scw, MASK, ZT, wv, lanev, t0);
    else if (qb < 24) dsa_select2<48>(scw, MASK, ZT, wv, lanev, t0);
    else dsa_select2<64>(scw, MASK, ZT, wv, lanev, t0);
    v4u st0, st1;
    { const bf16* p0_ = W_PROJ + (rb + lane) * NPROJ + C_CKV + wv * 16; st0 = *(const GAS v4u*)p0_; st1 = *(const GAS v4u*)(p0_ + 8); }
    const int qj = l31 >> 2, hd = l31 & 3;
    const int tql = t0 + 8 * wv + qj;
    bf16x8 qf[8]; float qn2 = 0.f;
    {
        v4u qr[8];
#pragma unroll
        for (int r = 0; r < 8; ++r) qr[r] = *(const GAS v4u*)(W_PROJ + (rb + t0 + 8 * wv + r) * NPROJ + C_QB + lane * 8);
        LAS unsigned char* const QLS = L + (wv < 4 ? 18432 + wv * 9216 : O_END + (wv - 4) * 9216);
#pragma unroll
        for (int r = 0; r < 8; ++r) *(LAS v4u*)(QLS + r * 1088 + (lane >> 4) * 272 + (lane & 15) * 16) = qr[r];
        LDS_WAIT();
#pragma unroll
        for (int s = 0; s < 8; ++s) qf[s] = lds16(QLS + qj * 1088 + hd * 272 + (16 * s + 8 * hh) * 2);
    }
#pragma unroll
    for (int s = 0; s < 8; ++s) { const v4u o = __builtin_bit_cast(v4u, qf[s]);
        qn2 += (bflo(o.x) * bflo(o.x) + bfhi(o.x) * bfhi(o.x)) + (bflo(o.y) * bflo(o.y) + bfhi(o.y) * bfhi(o.y)) + (bflo(o.z) * bflo(o.z) + bfhi(o.z) * bfhi(o.z)) + (bflo(o.w) * bflo(o.w) + bfhi(o.w) * bfhi(o.w)); }
    qn2 += __shfl_xor(qn2, 32);
    const float c0 = -(sqrtf(qn2) * 11.313708499f * 1.01f + mb2 + 1.0f);
    const float cfar = BT[(127 + 64) * 4 + hd] + c0;
    f32x16 oacc[4];
#pragma unroll
    for (int d = 0; d < 4; ++d)
#pragma unroll
        for (int r = 0; r < 16; ++r) oacc[d][r] = 0.f;
    float lsum = 0.f;
    const int krow = (lane & 48) | ((lane & 3) << 2) | ((lane >> 2) & 3);
#define DSA_GLOAD(kt) do { const bf16* _p = W_PROJ + (rb + 64 * (kt) + lane) * NPROJ + C_CKV + wv * 16; st0 = *(const GAS v4u*)_p; st1 = *(const GAS v4u*)(_p + 8); } while (0)
#define DSA_SWRITE(buf, ktt) do { LAS unsigned char* _kb = L + (buf) * BUFSZ; \
        *(LAS v4u*)(_kb + O_K0 + krow * PK + wv * 32) = st0; *(LAS v4u*)(_kb + O_K0 + krow * PK + wv * 32 + 16) = st1; \
        } while (0)
    DSA_SWRITE(0, 0);
    __syncthreads();
    for (int kt = 0; kt <= qb; ++kt) {
        const int buf = kt & 1;
        l31 = l31_0; hh = hh_0; asm volatile("" : "+v"(l31), "+v"(hh));
        if (kt < qb) DSA_GLOAD(kt + 1);
        const LAS unsigned char* kb = L + buf * BUFSZ;
        bf16x8 kf[8];
        int mw0 = (int)MASK[(8 * wv + qj) * MASKP + 2 * kt], mw1 = (int)MASK[(8 * wv + qj) * MASKP + 2 * kt + 1];
#pragma unroll
        for (int st = 0; st < 2; ++st) {
#pragma unroll
            for (int s = 0; s < 8; ++s) kf[s] = lds16(kb + O_K0 + (32 * st + ((l31 & 16) | ((l31 & 3) << 2) | ((l31 >> 2) & 3))) * PK + (16 * s + 8 * hh) * 2);
            __builtin_amdgcn_sched_barrier(0);
            const int kbase = 64 * kt + 32 * st;
            const bool far = (t0 + 8 * wv) - (kbase + 31) >= 113;
            const int mwi = (st == 0 ? mw0 : mw1) >> (4 * hh);
            const int selb = __builtin_bit_cast(int, far ? cfar : c0), negb = (int)0xf149f2cau;
            f32x16 Sa;
#pragma unroll
            for (int r = 0; r < 16; ++r) { int mb_ = __builtin_amdgcn_sbfe(mwi, 8 * (r >> 2) + (r & 3), 1); asm("" : "+v"(mb_)); Sa[r] = __builtin_bit_cast(float, (mb_ & selb) | (~mb_ & negb)); }
#pragma unroll
            for (int s = 0; s < 8; ++s) Sa = MFMA32(kf[s], qf[s], Sa);
            __builtin_amdgcn_sched_barrier(0);
            bf16x8 vf[8];
#pragma unroll
            for (int dt = 0; dt < 4; ++dt) {
                const LAS unsigned char* vp = kb + O_K0 + (32 * st + 4 * ((lane & 15) >> 2) + hh) * PK + (32 * dt + 16 * ((lane >> 4) & 1) + 4 * (lane & 3)) * 2;
                vf[2 * dt] = ldstr8(vp, vp + 2 * PK); vf[2 * dt + 1] = ldstr8(vp + 16 * PK, vp + 18 * PK); }
            __builtin_amdgcn_sched_barrier(0);
            float pn[16];
            if (far) {
#pragma unroll
                for (int r = 0; r < 16; ++r) { pn[r] = __builtin_amdgcn_exp2f(Sa[r]); lsum += pn[r]; }
            } else {
                const LAS float* bp = (const LAS float*)(((unsigned)(size_t)BT + (unsigned)((tql - kbase - 4 * hh + 64 - 27) * 16 + hd * 4)) & 0x3ffffu);
#pragma unroll
                for (int r = 0; r < 16; ++r) { pn[r] = __builtin_amdgcn_exp2f(Sa[r] + bp[(27 - (8 * (r >> 2) + (r & 3))) * 4]); lsum += pn[r]; }
            }
            const bf16x8 pf0 = pack8(pn[0], pn[1], pn[2], pn[3], pn[4], pn[5], pn[6], pn[7]), pf1 = pack8(pn[8], pn[9], pn[10], pn[11], pn[12], pn[13], pn[14], pn[15]);
#pragma unroll
            for (int dt = 0; dt < 4; ++dt) { oacc[dt] = MFMA32(vf[2 * dt], pf0, oacc[dt]); oacc[dt] = MFMA32(vf[2 * dt + 1], pf1, oacc[dt]); }
        }
        if (kt < qb) DSA_SWRITE(buf ^ 1, kt + 1);
        __syncthreads();
    }
#undef DSA_GLOAD
#undef DSA_SWRITE
    lsum += __shfl_xor(lsum, 32);
    {
        const float inv = rcpf_(lsum);
#pragma unroll
        for (int dt = 0; dt < 4; ++dt)
#pragma unroll
            for (int g = 0; g < 4; ++g) { const int d = 32 * dt + 8 * g + 4 * hh;
                *(LAS v2u*)(L + O_OA + hd * 17408 + (8 * wv + qj) * PK + d * 2) = pack4(oacc[dt][4 * g] * inv, oacc[dt][4 * g + 1] * inv, oacc[dt][4 * g + 2] * inv, oacc[dt][4 * g + 3] * inv); }
    }
    __syncthreads();
    {
        const int hd2 = wv >> 1, mt2 = wv & 1;
        const size_t row = rb + t0 + 32 * mt2 + l31;
        bf16x8 of[8];
#pragma unroll
        for (int s = 0; s < 8; ++s) of[s] = lds16(L + O_OA + hd2 * 17408 + (32 * mt2 + l31) * PK + (16 * s + 8 * hh) * 2);
        int tw = tid; asm volatile("" : "+v"(tw));
        v4u wst[16];
#pragma unroll
        for (int j = 0; j < 16; ++j) wst[j] = *(const GAS v4u*)(W_WUVT + 8 * (tw + NWAVES * 64 * j));
        LDS_WAIT();
        __syncthreads();
#pragma unroll
        for (int j = 0; j < 16; ++j) { const int i = tw + NWAVES * 64 * j; *(LAS v4u*)(L + (i >> 4) * PK + (i & 15) * 16) = wst[j]; }
        const bf16* zp0 = W_PROJ + row * NPROJ + C_ZB + hd2 * 128 + 16 * hh;
        v4u zq[4][2];
#pragma unroll
        for (int et = 0; et < 4; ++et) { zq[et][0] = *(const GAS v4u*)(zp0 + 32 * et); zq[et][1] = *(const GAS v4u*)(zp0 + 32 * et + 8); }
        __syncthreads();
        const int erow = 16 * ((l31 >> 2) & 1) + 4 * (l31 >> 3) + (l31 & 3);
        bf16x8 wf[8];
        { const LAS unsigned char* wl0 = L + (hd2 * 128 + erow) * PK + 16 * hh;
#pragma unroll
            for (int s = 0; s < 8; ++s) wf[s] = lds16(wl0 + 32 * s); }
#pragma unroll
        for (int et = 0; et < 4; ++et) {
            const v4u z0 = zq[et][0], z1 = zq[et][1];
            f32x16 C;
#pragma unroll
            for (int r = 0; r < 16; ++r) C[r] = 0.f;
            bf16x8 wn[8];
            if (et < 3) { const LAS unsigned char* wl = L + (hd2 * 128 + 32 * (et + 1) + erow) * PK + 16 * hh;
#pragma unroll
                for (int s = 0; s < 8; ++s) wn[s] = lds16(wl + 32 * s); }
            __builtin_amdgcn_sched_barrier(0);
#pragma unroll
            for (int s = 0; s < 8; ++s) C = MFMA32(wf[s], of[s], C);
            if (et < 3) {
#pragma unroll
                for (int s = 0; s < 8; ++s) wf[s] = wn[s]; }
            const unsigned zw[8] = {z0.x, z0.y, z0.z, z0.w, z1.x, z1.y, z1.z, z1.w}; unsigned ow[8];
#pragma unroll
            for (int k = 0; k < 8; ++k) ow[k] = cvtpk(C[2 * k] * siluf(bflo(zw[k])), C[2 * k + 1] * siluf(bfhi(zw[k])));
            bf16* op = W_OAB + row * DM + 512 + hd2 * 128 + 32 * et + 16 * hh;
            v4u o0, o1; o0.x = ow[0]; o0.y = ow[1]; o0.z = ow[2]; o0.w = ow[3]; o1.x = ow[4]; o1.y = ow[5]; o1.z = ow[6]; o1.w = ow[7];
            *(GAS v4u*)op = o0; *(GAS v4u*)(op + 8) = o1;
        }
    }
    __syncthreads();
}

constexpr int N_GDN = NB * 4, N_DSA = NB * 32, N_ITEMS = N_GDN + N_DSA;
constexpr int N_PHASES = 6;
#ifndef STAG_P2
#define STAG_P2 0
#endif
#ifndef STAG_P4
#define STAG_P4 0
#endif
__global__ void __launch_bounds__(NWAVES * 64, 2) hyb_fwd(Args args) {
    extern __shared__ __attribute__((aligned(16))) unsigned char lds[];
    Frame F;
    F.lds = (LAS unsigned char*)lds;
    F.MISC = (volatile LAS unsigned*)(F.lds + MISC_OFF);
    F.tid = threadIdx.x; F.lane = F.tid & 63; F.wave = __builtin_amdgcn_readfirstlane(F.tid >> 6);
    F.G = gridDim.x; { const int bx = blockIdx.x; F.vcu = (F.G % 8 == 0) ? (bx % 8) * (F.G / 8) + bx / 8 : bx; }
    unsigned char* ws = args.ws;
    F.ctl = (gu32*)(ws + WS_CTL);
    F.ws = ws;
    for (int u = F.tid; u < 64; u += NWAVES * 64) F.MISC[u] = 0u;
    __syncthreads();
    const int lo = args.ph_lo, hi = args.ph_hi;
    const bool multi = (hi - lo) > 1;
    XcdBarrier bar; bar.bar = (unsigned*)(F.ctl + CW_BAR) + args.li * XCD_BAR_WORDS; bar.x = 0; bar.st = nullptr;
    if (multi) bar = xcd_barrier_post((unsigned*)(F.ctl + CW_BAR) + args.li * XCD_BAR_WORDS, F.MISC + 8);
#define IN(k) (lo <= (k) && (k) < hi)
#define STAGGER(ticks) do { if ((ticks) > 0) { const unsigned long long t0_ = __builtin_amdgcn_s_memrealtime(); const unsigned d_ = ((unsigned)blockIdx.x & 7u) * (unsigned)(ticks); \
        while ((unsigned)(__builtin_amdgcn_s_memrealtime() - t0_) < d_) __builtin_amdgcn_s_sleep(4); } } while (0)
#define BOTH(k) (IN(k) && IN((k) + 1))
    if (IN(0)) { p0_prologue(F, args); if (PROBE_DUP == 7) { __syncthreads(); p0_prologue(F, args); } if (PROBE_DUP == 71) { __syncthreads(); p0_prologue(F, args, 1); } if (PROBE_DUP == 72) { __syncthreads(); p0_prologue(F, args, 2); } if (BOTH(0)) xcd_barrier(bar); }
    if (IN(1)) { p1_norm(F, args); if (PROBE_DUP == 1) p1_norm(F, args); if (BOTH(1)) xcd_barrier(bar); }
    if (IN(2)) {
        pg8::Gemm g{W_XN, W_WINT, MROWS, NPROJ, DM, (unsigned*)(F.ws + WS_CTL + 512 * 1024)}; pg8::StaticOrder S; S.init(MROWS, NPROJ, F.G, (int)blockIdx.x);
        pg8::EpiProj E{W_PROJ, W_AUX, (LAS float*)(F.lds + pg8::STAGE_BYTES)};
        STAGGER(STAG_P2);
        pg8::gemm_phase<pg8::EpiProj, pg8::StaticOrder, true, true>(F.lds, g, S, E);
        if (PROBE_DUP == 2) pg8::gemm_phase<pg8::EpiProj, pg8::StaticOrder, true, true>(F.lds, g, S, E);
        if (PROBE_DUP == 22) { pg8::EpiHalf EH{E, pg8::EpiNull{W_SCR}}; pg8::gemm_phase<pg8::EpiHalf, pg8::StaticOrder, true, true>(F.lds, g, S, EH); }
        if (PROBE_DUP == 23) { pg8::EpiPat<true> EP{(bf16*)(F.ws + WS_SCR), 3072, 12}; pg8::gemm_phase<pg8::EpiPat<true>, pg8::StaticOrder, true, true>(F.lds, g, S, EP); }
        if (PROBE_DUP == 24) { pg8::EpiPat<false> EP{(bf16*)(F.ws + WS_SCR), 3072, 12}; pg8::gemm_phase<pg8::EpiPat<false>, pg8::StaticOrder, true, true>(F.lds, g, S, EP); }
        if (PROBE_DUP == 25) { pg8::EpiPat<false> EP{W_PROJ, 3840, 12}; pg8::gemm_phase<pg8::EpiPat<false>, pg8::StaticOrder, true, true>(F.lds, g, S, EP); }
        if (PROBE_DUP == 26) { pg8::EpiPat<false> EP{W_PROJ, 3840, 15}; pg8::gemm_phase<pg8::EpiPat<false>, pg8::StaticOrder, true, true>(F.lds, g, S, EP); }
        if (PROBE_DUP == 21) { pg8::EpiNull EN{W_SCR}; pg8::gemm_phase<pg8::EpiNull, pg8::StaticOrder, true, true>(F.lds, g, S, EN); }
        if (BOTH(2)) xcd_barrier(bar);
    }
    if (IN(3)) {
#define NEXT_ITEM(dst, qw) do { if (F.tid == 0) F.MISC[4] = __hip_atomic_fetch_add(F.ctl + (qw), 1u, RLX_AGENT); __syncthreads(); dst = (int)F.MISC[4]; __syncthreads(); } while (0)
        const bool placed = (F.G == 256) && PROBE_DUP != 3;
        int item;
        if (placed) item = ((((int)blockIdx.x >> 3) & 1) == 0) ? ((int)blockIdx.x >> 4) * 8 + ((int)blockIdx.x & 7) : N_GDN;
        else NEXT_ITEM(item, CW_QUEUE);
#pragma unroll 1
        for (int pass = 0; pass < (PROBE_DUP == 3 ? 2 : 1); ++pass) {
            if (pass) NEXT_ITEM(item, CW_QUEUE + 64);
            while (item < N_GDN) { gdn_unit(F, args, item >> 2, item & 3); if (placed) item = N_GDN; else NEXT_ITEM(item, CW_QUEUE + 64 * pass); }
        }
        if (placed) { NEXT_ITEM(item, CW_QUEUE); item += N_GDN; }
        float mb2; { const int hd_ = F.lane & 3; float m_ = P_RELB[hd_]; for (int k = 1; k < 32; ++k) m_ = fmaxf(m_, P_RELB[k * 4 + hd_]); mb2 = m_ * LOG2E; }
#pragma unroll 1
        for (int pass = 0; pass < (PROBE_DUP == 4 ? 2 : 1); ++pass) {
            if (pass) NEXT_ITEM(item, CW_QUEUE + 128);
            while (item < N_ITEMS) { if (item >= N_GDN) { const int idx = item - N_GDN; dsa_unit(F, args, idx & 31, 31 - (idx >> 5), mb2); } NEXT_ITEM(item, pass ? CW_QUEUE + 128 : CW_QUEUE); if (placed && !pass) item += N_GDN; }
        }
#undef NEXT_ITEM
        if (BOTH(3)) xcd_barrier(bar);
    }
    if (IN(4)) {
        pg8::Gemm g{W_OAB, W_WOUTT, MROWS, DM, DM, (unsigned*)(F.ws + WS_CTL + 512 * 1024)}; pg8::StaticOrder S; S.init(MROWS, DM, F.G, (int)blockIdx.x);
        pg8::EpiMix E{W_MIX, DM};
        STAGGER(STAG_P4);
        pg8::gemm_phase<pg8::EpiMix, pg8::StaticOrder, true, true>(F.lds, g, S, E);
        if (PROBE_DUP == 5) pg8::gemm_phase<pg8::EpiMix, pg8::StaticOrder, true, true>(F.lds, g, S, E);
        if (BOTH(4)) xcd_barrier(bar);
    }
    if (IN(5)) { p5_final(F, args); if (PROBE_DUP == 6) p5_final(F, args); }
#undef IN
#undef BOTH
}

extern "C" void kernel_launch(void* const* d_in, const int* in_sizes, int n_in, void* d_out, int out_size, void* d_ws, size_t ws_size, hipStream_t stream) {
    static int grid = 0;
    if (grid == 0) {
        if (n_in != 15 || in_sizes[0] != MROWS * DM || out_size != MROWS * DM || ws_size < WS_END) { fprintf(stderr, "kernel_launch: unexpected shapes (n_in %d, in0 %d, out %d, ws %zu); nothing launched\n", n_in, n_in > 0 ? in_sizes[0] : -1, out_size, ws_size); grid = -1; return; }
        int dev = 0, cus = 0, per_cu = 0;
        if (hipGetDevice(&dev) != hipSuccess || hipDeviceGetAttribute(&cus, hipDeviceAttributeMultiprocessorCount, dev) != hipSuccess) { fprintf(stderr, "kernel_launch: device query failed\n"); grid = -1; return; }
        if (hipFuncSetAttribute((const void*)hyb_fwd, hipFuncAttributeMaxDynamicSharedMemorySize, LDS_BYTES) != hipSuccess) { fprintf(stderr, "kernel_launch: hipFuncSetAttribute failed\n"); grid = -1; return; }
        if (hipOccupancyMaxActiveBlocksPerMultiprocessor(&per_cu, (const void*)hyb_fwd, NWAVES * 64, LDS_BYTES) != hipSuccess || per_cu < 1)
            fprintf(stderr, "kernel_launch: note: occupancy query reports %d workgroups per CU\n", per_cu);
        (void)hipGetLastError();
        grid = cus < 256 ? cus : 256;
    }
    if (grid < 0) return;
    if (hipMemsetAsync((char*)d_ws + WS_CTL, 0, CTL_ZERO_BYTES, stream) != hipSuccess) { fprintf(stderr, "kernel_launch: memset failed\n"); return; }
    Args a{};
    for (int i = 0; i < 15; ++i) a.in[i] = (const float*)d_in[i];
    a.out = (float*)d_out; a.ws = (unsigned char*)d_ws;
    constexpr int NL = MK_N_LAUNCHES;
    static_assert(NL == 1 || NL == 2 || NL == 3 || NL == N_PHASES, "MK_N_LAUNCHES");
    const int cuts1[2] = {0, 6}, cuts2[3] = {0, 3, 6}, cuts3[4] = {0, 3, 4, 6}, cuts6[7] = {0, 1, 2, 3, 4, 5, 6};
    const int* cuts = NL == 1 ? cuts1 : NL == 2 ? cuts2 : NL == 3 ? cuts3 : cuts6;
    for (int li = 0; li < NL; ++li) {
        a.ph_lo = cuts[li]; a.ph_hi = cuts[li + 1]; a.li = li;
        hipLaunchKernelGGL(hyb_fwd, dim3(grid), dim3(NWAVES * 64), LDS_BYTES, stream, a);
        const hipError_t le = hipPeekAtLastError();
        if (le != hipSuccess) { fprintf(stderr, "kernel_launch: launch %d failed: %s\n", li, hipGetErrorName(le)); break; }
    }
}
```
